# Optimizing an MI355X kernel written in HIP

```python
import math
import jax, jax.numpy as jnp
from jax import lax
import numpy as np

D_MODEL = 2048
BATCH = 2
SEQ = 8192
DEPTH = 4

CHUNK = 64
Q_BLOCK = 128
EPS = 1e-6

DA_HEADS = 6
DA_QK = 64
DA_V = 128
MLA_HEADS = 6
MLA_Q_RANK = 512
MLA_KV_RANK = 256
MLA_NOPE = 128
MLA_ROPE = 64
MLA_V = 128
ROPE_THETA = 10000.0
SG_GROUPS = 4
SG_CH = 128
SG_LEN = 128
D_FF = 5632
CONV_W = 3

DA_WIDTH = DA_HEADS * DA_V
MLA_WIDTH = MLA_HEADS * MLA_V
SG_WIDTH = SG_GROUPS * SG_CH
D_MIX = DA_WIDTH + MLA_WIDTH + SG_WIDTH

SPLITS = (DA_HEADS * 2 * DA_QK, DA_HEADS * 2 * DA_QK, DA_WIDTH,
          MLA_Q_RANK, MLA_KV_RANK, MLA_ROPE, SG_WIDTH, SG_WIDTH)
IN_COLS = sum(SPLITS)
SPLIT_IDX = tuple(int(i) for i in np.cumsum(SPLITS)[:-1])
ALIBI_SLOPES = tuple(2.0 ** (-8.0 * (h + 1) / DA_HEADS) for h in range(DA_HEADS))

kernel_name = 'hymba_style_diffattn_mla_sgu_convffn_adaln'


def rms_norm(x, gain=None):
    xf = x.astype(jnp.float32)
    y = xf * lax.rsqrt(jnp.mean(xf * xf, axis=-1, keepdims=True) + EPS)
    if gain is not None:
        y = y * gain.astype(jnp.float32)
    return y.astype(x.dtype)


def rope_cos_sin(pos):
    half = MLA_ROPE // 2
    inv = ROPE_THETA ** (-jnp.arange(half, dtype=jnp.float32) / half)
    ang = pos.astype(jnp.float32)[..., None] * inv
    return jnp.cos(ang)[:, :, None, :], jnp.sin(ang)[:, :, None, :]


def apply_rope(x, cos, sin):
    xf = x.astype(jnp.float32)
    x1, x2 = jnp.split(xf, 2, axis=-1)
    return jnp.concatenate([x1 * cos - x2 * sin, x2 * cos + x1 * sin], axis=-1).astype(x.dtype)


def to_heads(t):
    return t.transpose(0, 2, 1, 3)


def chunk_causal_attention(qs, ks, v, coefs, alibi=None):
    B, H, S, _ = v.shape
    nb = S // Q_BLOCK
    scale = qs[0].shape[-1] ** -0.5
    key_chunk = jnp.arange(S) // CHUNK
    blocks = lambda t: t.reshape(B, H, nb, Q_BLOCK, t.shape[-1]).transpose(2, 0, 1, 3, 4)
    q_blocks = tuple(blocks(q) for q in qs)
    if alibi is not None:
        slopes, pos = alibi
        posf = pos.astype(jnp.float32)
        pos_blocks = posf.reshape(B, nb, Q_BLOCK).transpose(1, 0, 2)
    else:
        pos_blocks = jnp.zeros((nb, B, Q_BLOCK), jnp.float32)

    def step(args):
        qb, pb, ib = args
        q_chunk = (ib * Q_BLOCK + jnp.arange(Q_BLOCK)) // CHUNK
        mask = key_chunk[None, :] <= q_chunk[:, None]
        bias = 0.0
        if alibi is not None:
            dist = jnp.abs(pb[:, :, None] - posf[:, None, :])
            bias = -slopes[None, :, None, None] * dist[:, None]
        probs = 0.0
        for q_i, k_i, c_i in zip(qb, ks, coefs):
            s = jnp.einsum('bhqd,bhkd->bhqk', q_i, k_i).astype(jnp.float32) * scale + bias
            s = jnp.where(mask, s, -jnp.inf)
            probs = probs + c_i * jax.nn.softmax(s, axis=-1)
        return jnp.einsum('bhqk,bhkd->bhqd', probs.astype(v.dtype), v)

    out = lax.map(step, (q_blocks, pos_blocks, jnp.arange(nb)))
    return out.transpose(1, 2, 0, 3, 4).reshape(B, H, S, v.shape[-1])


def diff_attention(q, k, v, pos, slopes, q_gain, k_gain, lq1, lk1, lq2, lk2, head_gain, lam_init):
    B, S, _ = q.shape
    q = rms_norm(q.reshape(B, S, DA_HEADS, 2, DA_QK), q_gain)
    k = rms_norm(k.reshape(B, S, DA_HEADS, 2, DA_QK), k_gain)
    v = v.reshape(B, S, DA_HEADS, DA_V)
    lam = (jnp.exp(jnp.sum(lq1 * lk1)) - jnp.exp(jnp.sum(lq2 * lk2)) + lam_init).astype(jnp.float32)
    o = chunk_causal_attention(
        (to_heads(q[..., 0, :]), to_heads(q[..., 1, :])),
        (to_heads(k[..., 0, :]), to_heads(k[..., 1, :])),
        to_heads(v), (1.0, -lam), alibi=(slopes, pos))
    o = rms_norm(o, head_gain[:, None, :]) * (1.0 - lam_init)
    return o.transpose(0, 2, 1, 3).reshape(B, S, DA_WIDTH)


def latent_attention(q_a, kv_a, k_rope, cos, sin, q_a_gain, w_uq, kv_a_gain, w_ukv, q_gain, k_gain):
    B, S, _ = q_a.shape
    q = (rms_norm(q_a, q_a_gain) @ w_uq).reshape(B, S, MLA_HEADS, MLA_NOPE + MLA_ROPE)
    kv = (rms_norm(kv_a, kv_a_gain) @ w_ukv).reshape(B, S, MLA_HEADS, MLA_NOPE + MLA_V)
    k_nope, v = kv[..., :MLA_NOPE], kv[..., MLA_NOPE:]
    k_r = jnp.broadcast_to(k_rope[:, :, None, :], (B, S, MLA_HEADS, MLA_ROPE))
    k = jnp.concatenate([k_nope, k_r], axis=-1)
    q = rms_norm(q, q_gain)
    k = rms_norm(k, k_gain)
    q = jnp.concatenate([q[..., :MLA_NOPE], apply_rope(q[..., MLA_NOPE:], cos, sin)], axis=-1)
    k = jnp.concatenate([k[..., :MLA_NOPE], apply_rope(k[..., MLA_NOPE:], cos, sin)], axis=-1)
    o = chunk_causal_attention((to_heads(q),), (to_heads(k),), to_heads(v), (1.0,))
    return o.transpose(0, 2, 1, 3).reshape(B, S, MLA_WIDTH)


def spatial_gating(u, v, v_gain, w_s, b_s):
    B, S, _ = u.shape
    u = jax.nn.gelu(u).reshape(B, S, SG_GROUPS, SG_CH)
    v = rms_norm(jax.nn.gelu(v).reshape(B, S, SG_GROUPS, SG_CH), v_gain)
    v = v.reshape(B, S // SG_LEN, SG_LEN, SG_GROUPS, SG_CH)
    w = w_s * jnp.tril(jnp.ones((SG_LEN, SG_LEN), w_s.dtype))
    s = jnp.einsum('gts,bnsgc->bntgc', w, v) + b_s.T[None, None, :, :, None]
    return (u * s.reshape(B, S, SG_GROUPS, SG_CH)).reshape(B, S, SG_WIDTH)


def conv_ffn(h, w_up, conv_w, conv_b, w_down):
    a = h @ w_up
    S = a.shape[1]
    ap = jnp.pad(a, ((0, 0), (CONV_W - 1, 0), (0, 0)))
    y = conv_b + a * conv_w[CONV_W - 1]
    for j in range(CONV_W - 1):
        y = y + ap[:, j:j + S] * conv_w[j]
    g, val = jnp.split(y, 2, axis=-1)
    return (jax.nn.silu(g) * val) @ w_down


def setup_inputs(seed: int = 0) -> dict:
    key = jax.random.key(seed)
    keys = jax.random.split(key, 32)
    counter = [0]

    def nxt():
        k = keys[counter[0]]
        counter[0] += 1
        return k

    def nrm(shape, scale):
        return jax.random.normal(nxt(), shape, jnp.float32) * scale

    def gain(shape):
        return 1.0 + nrm(shape, 0.02)

    L, D = DEPTH, D_MODEL
    x = nrm((BATCH, SEQ, D), 1.0)
    c = nrm((BATCH, D), 1.0)
    offset = jax.random.randint(nxt(), (BATCH, 1), 0, 1024, jnp.int32)
    positions = offset + jnp.arange(SEQ, dtype=jnp.int32)[None, :]
    return {
        'x': x,
        'c': c,
        'positions': positions,
        'w_ada': nrm((L, D, 6 * D), 0.01),
        'b_ada': nrm((L, 6 * D), 0.01),
        'w_in': nrm((L, D, IN_COLS), D ** -0.5),
        'da_q_gain': gain((L, DA_QK)),
        'da_k_gain': gain((L, DA_QK)),
        'da_lq1': nrm((L, DA_QK), 0.1),
        'da_lk1': nrm((L, DA_QK), 0.1),
        'da_lq2': nrm((L, DA_QK), 0.1),
        'da_lk2': nrm((L, DA_QK), 0.1),
        'da_head_gain': gain((L, DA_HEADS, DA_V)),
        'mla_q_a_gain': gain((L, MLA_Q_RANK)),
        'mla_w_uq': nrm((L, MLA_Q_RANK, MLA_HEADS * (MLA_NOPE + MLA_ROPE)), MLA_Q_RANK ** -0.5),
        'mla_kv_a_gain': gain((L, MLA_KV_RANK)),
        'mla_w_ukv': nrm((L, MLA_KV_RANK, MLA_HEADS * (MLA_NOPE + MLA_V)), MLA_KV_RANK ** -0.5),
        'mla_q_gain': gain((L, MLA_NOPE + MLA_ROPE)),
        'mla_k_gain': gain((L, MLA_NOPE + MLA_ROPE)),
        'sg_v_gain': gain((L, SG_GROUPS, SG_CH)),
        'sg_w': nrm((L, SG_GROUPS, SG_LEN, SG_LEN), SG_LEN ** -0.5),
        'sg_b': gain((L, SG_GROUPS, SG_LEN)),
        'w_out': nrm((L, D_MIX, D), D_MIX ** -0.5),
        'ffn_w_up': nrm((L, D, 2 * D_FF), D ** -0.5),
        'ffn_conv_w': nrm((L, CONV_W, 2 * D_FF), CONV_W ** -0.5),
        'ffn_conv_b': nrm((L, 2 * D_FF), 0.01),
        'ffn_w_down': nrm((L, D_FF, D), D_FF ** -0.5),
    }


def reference(x, c, positions, w_ada, b_ada, w_in, da_q_gain, da_k_gain, da_lq1, da_lk1,
              da_lq2, da_lk2, da_head_gain, mla_q_a_gain, mla_w_uq, mla_kv_a_gain, mla_w_ukv,
              mla_q_gain, mla_k_gain, sg_v_gain, sg_w, sg_b, w_out, ffn_w_up, ffn_conv_w,
              ffn_conv_b, ffn_w_down):
    cond = jax.nn.silu(c)
    slopes = jnp.asarray(ALIBI_SLOPES, jnp.float32)
    cos, sin = rope_cos_sin(positions)
    for l in range(DEPTH):
        mod = (cond @ w_ada[l] + b_ada[l])[:, None, :]
        sh1, sc1, g1, sh2, sc2, g2 = jnp.split(mod, 6, axis=-1)
        h = rms_norm(x) * (1.0 + sc1) + sh1
        z = h @ w_in[l]
        da_q, da_k, da_v, q_a, kv_a, k_rope, sg_u, sg_v = jnp.split(z, SPLIT_IDX, axis=-1)
        lam_init = 0.8 - 0.6 * math.exp(-0.3 * l)
        out_a = diff_attention(da_q, da_k, da_v, positions, slopes, da_q_gain[l], da_k_gain[l],
                               da_lq1[l], da_lk1[l], da_lq2[l], da_lk2[l], da_head_gain[l], lam_init)
        out_b = latent_attention(q_a, kv_a, k_rope, cos, sin, mla_q_a_gain[l], mla_w_uq[l],
                                 mla_kv_a_gain[l], mla_w_ukv[l], mla_q_gain[l], mla_k_gain[l])
        out_c = spatial_gating(sg_u, sg_v, sg_v_gain[l], sg_w[l], sg_b[l])
        mix = jnp.concatenate([out_a, out_b, out_c], axis=-1) @ w_out[l]
        x = x + g1 * mix
        h = rms_norm(x) * (1.0 + sc2) + sh2
        x = x + g2 * conv_ffn(h, ffn_w_up[l], ffn_conv_w[l], ffn_conv_b[l], ffn_w_down[l])
    return x
```

```cpp
#include <hip/hip_runtime.h>
#include <cstdio>
#include <cstdint>
#include <cmath>
#define GAS __attribute__((address_space(1)))
#define LAS __attribute__((address_space(3)))
namespace pg8 {
#define PG8_LAS __attribute__((address_space(3)))
typedef unsigned short bf16_t;
typedef short bf16x8 __attribute__((ext_vector_type(8)));
typedef float f32x4 __attribute__((ext_vector_type(4)));
typedef unsigned u32x4 __attribute__((ext_vector_type(4)));
constexpr int BM = 256, BK = 64, HALF = 128, HTB = HALF * BK * 2  , STAGE_BYTES = 8 * HTB, NXCD = 8, WGM = 8;

__host__ __device__ __forceinline__ int lds_byte(int r, int c) { const int st = (r >> 4) * 2 + (c >> 5), rr = r & 15, cc = c & 31, ob = rr * 64 + cc * 2; return st * 1024 + (ob ^ (((ob >> 9) & 1) << 5)); }
__host__ __device__ __forceinline__ void stage_rc(int b, int& R, int& C) { const int st = b / 1024, sb = b % 1024, swz = sb ^ (((sb >> 9) & 1) << 5); R = (st >> 1) * 16 + swz / 64; C = (st & 1) * 32 + (swz % 64) / 2; }
__host__ __device__ __forceinline__ int perm32(int rho) { const int n = rho >> 4, i = rho & 15; return 8 * (i >> 2) + 4 * n + (i & 3); }

struct Unit { int pm, pn; };
struct Gemm { const bf16_t* A; const bf16_t* Bt; int M, N, K; };

struct StaticOrder {
    int nM, nN, nwg, G, c;
    __host__ __device__ void init(int M, int N, int G_, int c_) { nM = M / BM; nN = N / BM; nwg = nM * nN; G = G_; c = c_; }
    __host__ __device__ bool next(int i, Unit& u) const {
        const long L = (long)i * G + c; if (L >= nwg) return false;
        int wgid = (int)L; { const int q = nwg / NXCD, r = nwg % NXCD, xcd = wgid % NXCD, off = wgid / NXCD; wgid = (xcd < r ? xcd * (q + 1) : r * (q + 1) + (xcd - r) * q) + off; }
        const int nig = WGM * nN, gid = wgid / nig, fm = gid * WGM, gsz = (nM - fm) < WGM ? (nM - fm) : WGM;
        u.pm = fm + ((wgid % nig) % gsz); u.pn = (wgid % nig) / gsz; return true;
    }
    __device__ __forceinline__ void a_ready(const Unit&) const {}
    __device__ __forceinline__ void done(const Unit&) const {}
};

__device__ __forceinline__ unsigned cvt_pk_bf16(float lo, float hi) { unsigned r; asm volatile("v_cvt_pk_bf16_f32 %0, %1, %2" : "=v"(r) : "v"(lo), "v"(hi)); return r; }
typedef float f32x2 __attribute__((ext_vector_type(2)));

template <class Epi, class Sched, bool ALIGN_EPI = false, bool SP2 = false>
__device__ __forceinline__ void gemm_phase(PG8_LAS unsigned char* lds, const Gemm g, const Sched& S, const Epi& E, int tid_in) {
    int tid_ = tid_in; asm volatile("" : "+v"(tid_));
    const int tid = tid_, wid = __builtin_amdgcn_readfirstlane(tid >> 6), lane = tid & 63, wr = wid >> 2, wc = wid & 3, fr = lane & 15, fq = lane >> 4;
    const int K = g.K, nt = K / BK;
    unsigned voffA[2], voffB[2];
#pragma unroll
    for (int i = 0; i < 2; ++i) { int R, C; stage_rc(tid * 16 + i * 8192, R, C); const int Rb = Epi::PERM ? ((R & ~31) + perm32(R & 31)) : R;
        voffA[i] = (unsigned)(R * K + C) * 2u; voffB[i] = (unsigned)(Rb * K + C) * 2u; }
    const size_t kstep = (size_t)(BK * 2);
    const size_t hstep = (size_t)HALF * K * 2;
    const size_t tstep = 2 * hstep;
    const unsigned ldsw = (unsigned)wid * 1024u;
    const int aoff = lds_byte(wr * 64 + fr, fq * 8), boff = lds_byte(wc * 32 + fr, fq * 8);
#define PG8_SA(b, h) (((b) * 2 + (h)) * HTB)
#define PG8_SB(b, h) ((4 + (b) * 2 + (h)) * HTB)
#define PG8_STAGE(bufoff, gbase, voff) do { _Pragma("unroll") for (int _i = 0; _i < 2; ++_i) \
        __builtin_amdgcn_global_load_lds((const unsigned*)((const char*)(gbase) + (voff)[_i]), (PG8_LAS unsigned*)(lds + (bufoff) + ldsw + _i * 8192), 16, 0, 0); } while (0)
#define PG8_LDA(dst, b, h) do { _Pragma("unroll") for (int m = 0; m < 4; ++m) _Pragma("unroll") for (int k = 0; k < 2; ++k) dst[m][k] = *(const PG8_LAS bf16x8*)(lds + PG8_SA(b, h) + aoff + m * 2048 + k * 1024); } while (0)
#define PG8_LDB(dst, b, h) do { _Pragma("unroll") for (int n = 0; n < 2; ++n) _Pragma("unroll") for (int k = 0; k < 2; ++k) dst[n][k] = *(const PG8_LAS bf16x8*)(lds + PG8_SB(b, h) + boff + n * 2048 + k * 1024); } while (0)
#define PG8_MMA(ai, bj, At, Bt) do { __builtin_amdgcn_s_setprio(1); _Pragma("unroll") for (int m = 0; m < 4; ++m) _Pragma("unroll") for (int n = 0; n < 2; ++n) _Pragma("unroll") for (int k = 0; k < 2; ++k) \
        acc[ai][bj][m][n] = __builtin_amdgcn_mfma_f32_16x16x32_bf16(Bt[n][k], At[m][k], acc[ai][bj][m][n], 0, 0, 0); __builtin_amdgcn_s_setprio(0); } while (0)
#define PG8_WAIT_V(n) asm volatile("s_waitcnt vmcnt(" #n ")" ::: "memory")
#define PG8_WAIT_L(n) asm volatile("s_waitcnt lgkmcnt(" #n ")" ::: "memory")
#define PG8_BAR __builtin_amdgcn_s_barrier()
#define PG8_SCHED __builtin_amdgcn_sched_barrier(0)
    Unit cur, nxt; int ui = 0;
    if (!S.next(0, cur)) return;
    f32x4 acc[2][2][4][2];
#pragma unroll
    for (int a = 0; a < 2; ++a)
#pragma unroll
        for (int b = 0; b < 2; ++b)
#pragma unroll
            for (int m = 0; m < 4; ++m)
#pragma unroll
                for (int n = 0; n < 2; ++n) acc[a][b][m][n] = (f32x4){0.f, 0.f, 0.f, 0.f};
    bf16x8 At[4][2], B0[2][2], B1[2][2];
    const char* cA = (const char*)g.A + (size_t)cur.pm * tstep; const char* cB = (const char*)g.Bt + (size_t)cur.pn * tstep;
    S.a_ready(cur);
    if constexpr (SP2) {
        PG8_STAGE(PG8_SB(0, 0), cB, voffB); PG8_STAGE(PG8_SB(0, 1), cB + hstep, voffB); PG8_STAGE(PG8_SA(0, 0), cA, voffA); PG8_STAGE(PG8_SA(0, 1), cA + hstep, voffA);
        if (wr == 1) PG8_BAR;
        PG8_WAIT_V(2); PG8_BAR;
        PG8_STAGE(PG8_SB(1, 0), cB + kstep, voffB); PG8_STAGE(PG8_SA(1, 0), cA + kstep, voffA); PG8_STAGE(PG8_SB(1, 1), cB + hstep + kstep, voffB);
        PG8_WAIT_V(6); PG8_BAR;
    } else {
        PG8_STAGE(PG8_SB(0, 0), cB, voffB); PG8_STAGE(PG8_SA(0, 0), cA, voffA); PG8_STAGE(PG8_SB(0, 1), cB + hstep, voffB); PG8_STAGE(PG8_SA(0, 1), cA + hstep, voffA);
        if (wr == 1) PG8_BAR;
        PG8_WAIT_V(4); PG8_BAR;
        PG8_STAGE(PG8_SB(1, 0), cB + kstep, voffB); PG8_STAGE(PG8_SA(1, 0), cA + kstep, voffA); PG8_STAGE(PG8_SB(1, 1), cB + hstep + kstep, voffB);
        PG8_WAIT_V(6); PG8_BAR;
    }
    for (;;) {
        const bool has_next = S.next(ui + 1, nxt);
        const char* nA = has_next ? (const char*)g.A + (size_t)nxt.pm * tstep : cA; const char* nB = has_next ? (const char*)g.Bt + (size_t)nxt.pn * tstep : cB;
        for (int t = 0; t < nt; t += 2) {
            const bool last = (t == nt - 2);
            const char* a1 = cA + (size_t)(t + 1) * kstep;
            const char* a2 = last ? nA : cA + (size_t)(t + 2) * kstep; const char* b2 = last ? nB : cB + (size_t)(t + 2) * kstep;
            const char* a3 = a2 + kstep; const char* b3 = b2 + kstep;
            if (last && has_next) S.a_ready(nxt);
            if constexpr (SP2) {
            PG8_LDB(B0, 0, 0); PG8_LDB(B1, 0, 1); PG8_SCHED; PG8_LDA(At, 0, 0); PG8_STAGE(PG8_SA(1, 1), a1 + hstep, voffA);
            PG8_WAIT_V(8); PG8_WAIT_L(0); PG8_BAR; PG8_MMA(0, 0, At, B0); PG8_MMA(0, 1, At, B1); PG8_BAR; PG8_SCHED;
            PG8_LDA(At, 0, 1); PG8_STAGE(PG8_SB(0, 0), b2, voffB); PG8_STAGE(PG8_SB(0, 1), b2 + hstep, voffB); PG8_STAGE(PG8_SA(0, 0), a2, voffA);
            PG8_WAIT_V(8); PG8_WAIT_L(0); PG8_BAR; PG8_MMA(1, 0, At, B0); PG8_MMA(1, 1, At, B1); PG8_BAR; PG8_SCHED;
            PG8_LDB(B0, 1, 0); PG8_LDB(B1, 1, 1); PG8_SCHED; PG8_LDA(At, 1, 0); PG8_STAGE(PG8_SA(0, 1), a2 + hstep, voffA);
            PG8_WAIT_V(8); PG8_WAIT_L(0); PG8_BAR; PG8_MMA(0, 0, At, B0); PG8_MMA(0, 1, At, B1); PG8_BAR; PG8_SCHED;
            PG8_LDA(At, 1, 1); PG8_STAGE(PG8_SB(1, 0), b3, voffB); PG8_STAGE(PG8_SB(1, 1), b3 + hstep, voffB); PG8_STAGE(PG8_SA(1, 0), a3, voffA);
            PG8_WAIT_V(8); PG8_WAIT_L(0); PG8_BAR; PG8_MMA(1, 0, At, B0); PG8_MMA(1, 1, At, B1); PG8_BAR; PG8_SCHED;
            } else {
            PG8_LDB(B0, 0, 0); PG8_SCHED; PG8_LDA(At, 0, 0); PG8_STAGE(PG8_SA(1, 1), a1 + hstep, voffA);
            PG8_WAIT_L(8); PG8_BAR; PG8_WAIT_L(0); PG8_MMA(0, 0, At, B0); PG8_BAR; PG8_SCHED;
            PG8_LDB(B1, 0, 1); PG8_STAGE(PG8_SB(0, 0), b2, voffB);
            PG8_BAR; PG8_WAIT_L(0); PG8_MMA(0, 1, At, B1); PG8_BAR;
            PG8_LDA(At, 0, 1); PG8_STAGE(PG8_SA(0, 0), a2, voffA);
            PG8_BAR; PG8_WAIT_L(0); PG8_MMA(1, 0, At, B0); PG8_BAR; PG8_SCHED;
            PG8_STAGE(PG8_SB(0, 1), b2 + hstep, voffB);
            PG8_WAIT_V(6); PG8_BAR; PG8_MMA(1, 1, At, B1); PG8_BAR;
            PG8_LDB(B0, 1, 0); PG8_SCHED; PG8_LDA(At, 1, 0); PG8_STAGE(PG8_SA(0, 1), a2 + hstep, voffA);
            PG8_WAIT_L(8); PG8_BAR; PG8_WAIT_L(0); PG8_MMA(0, 0, At, B0); PG8_BAR; PG8_SCHED;
            PG8_LDB(B1, 1, 1); PG8_STAGE(PG8_SB(1, 0), b3, voffB);
            PG8_BAR; PG8_WAIT_L(0); PG8_MMA(0, 1, At, B1); PG8_BAR;
            PG8_LDA(At, 1, 1); PG8_STAGE(PG8_SA(1, 0), a3, voffA);
            PG8_BAR; PG8_WAIT_L(0); PG8_MMA(1, 0, At, B0); PG8_BAR; PG8_SCHED;
            PG8_STAGE(PG8_SB(1, 1), b3 + hstep, voffB);
            PG8_WAIT_V(6); PG8_BAR; PG8_MMA(1, 1, At, B1); PG8_BAR;
            }
        }
        if constexpr (ALIGN_EPI) { if (wr == 0) PG8_BAR; }
        if constexpr (!Epi::AFTER_DRAIN) { E(acc, cur, wr, wc, fr, fq); S.done(cur); }
        if (!has_next) break;
#pragma unroll
        for (int a = 0; a < 2; ++a)
#pragma unroll
            for (int b = 0; b < 2; ++b)
#pragma unroll
                for (int m = 0; m < 4; ++m)
#pragma unroll
                    for (int n = 0; n < 2; ++n) acc[a][b][m][n] = (f32x4){0.f, 0.f, 0.f, 0.f};
        cur = nxt; cA = nA; cB = nB; ++ui;
        if constexpr (ALIGN_EPI) { if (wr == 1) PG8_BAR; }
    }
    PG8_WAIT_V(0);
    if constexpr (!ALIGN_EPI) { if (wr == 0) PG8_BAR; }
    PG8_BAR;
    if constexpr (Epi::AFTER_DRAIN) { E.fused(acc, cur, wr, wc, fr, fq, lds, wid, lane); S.done(cur); }
#undef PG8_SA
#undef PG8_SB
#undef PG8_STAGE
#undef PG8_LDA
#undef PG8_LDB
#undef PG8_MMA
#undef PG8_WAIT_V
#undef PG8_WAIT_L
#undef PG8_BAR
#undef PG8_SCHED
}
}
#define XB_TMO      128
#define XB_XCNT(j)  (256  + 64 * (j))
#define XB_XSUB(j)  (1280 + 64 * (j))
#define XB_XGEN(j)  (2304 + 64 * (j))
#define XB_TOP      3328
#define XB_TOPGEN   3392
#define XCD_BAR_WORDS 3456
#define XB_SPIN_CAP (1u << 18)

__device__ __forceinline__ unsigned xb_ld(unsigned* p)              { return __hip_atomic_load(p, __ATOMIC_RELAXED, __HIP_MEMORY_SCOPE_AGENT); }
__device__ __forceinline__ unsigned xb_add(unsigned* p, unsigned v) { return __hip_atomic_fetch_add(p, v, __ATOMIC_RELAXED, __HIP_MEMORY_SCOPE_AGENT); }
__device__ __forceinline__ unsigned xb_xcc_id() { return (unsigned)__builtin_amdgcn_s_getreg((3 << 11) | 20) & 0xFu; }
#define XB_SPIN(cond, bar) do { unsigned _sp = 0; while (cond) { __builtin_amdgcn_s_sleep(1); \
    if ((++_sp & 255u) == 0u) { if (xb_ld(&(bar)[XB_TMO])) break; if (_sp > XB_SPIN_CAP) { atomicAdd(&(bar)[XB_TMO], 1u); break; } } } } while (0)

struct XcdBarrier {
    unsigned* bar; unsigned x;
    volatile LAS unsigned* st;
};

__device__ __forceinline__ XcdBarrier xcd_barrier_post(unsigned* bar, volatile LAS unsigned* st) {
    XcdBarrier b; b.bar = bar; b.x = xb_xcc_id(); b.st = st;
    if (threadIdx.x == 0) (void)xb_add(&bar[XB_XCNT(b.x)], 1u);
    return b;
}
__device__ __forceinline__ void xcd_barrier_complete(unsigned* bar, unsigned x, unsigned& nloc, unsigned& nx) {
    const unsigned G = gridDim.x * gridDim.y * gridDim.z;
    unsigned sum, cnt, mine, sp = 0u;
    for (;;) {
        sum = 0u; cnt = 0u; mine = 0u;
#pragma unroll
        for (unsigned j = 0; j < 16; ++j) { const unsigned c = xb_ld(&bar[XB_XCNT(j)]); sum += c; cnt += (c > 0u) ? 1u : 0u; mine = (j == x) ? c : mine; }
        if (sum == G) break;
        __builtin_amdgcn_s_sleep(1);
        if ((++sp & 255u) == 0u) { if (xb_ld(&bar[XB_TMO])) break; if (sp > XB_SPIN_CAP) { atomicAdd(&bar[XB_TMO], 1u); break; } }
    }
    nloc = mine > 0u ? mine : 1u; nx = cnt > 0u ? cnt : 1u;
}

__device__ __forceinline__ void xcd_barrier(const XcdBarrier& b, bool leader) {
    asm volatile("s_waitcnt vmcnt(0)" ::: "memory");
    __syncthreads();
    if (leader) {
        unsigned* bar = b.bar;
        __builtin_amdgcn_s_waitcnt(0);
        unsigned nloc = b.st[0], nx = b.st[1];
        if (nloc == 0u) { xcd_barrier_complete(bar, b.x, nloc, nx); b.st[0] = nloc; b.st[1] = nx; }
        const unsigned old = xb_add(&bar[XB_XSUB(b.x)], 1u);
        const unsigned gen = old / nloc;
        if (old + 1u == (gen + 1u) * nloc) {
            __builtin_amdgcn_fence(__ATOMIC_RELEASE, "agent");
            asm volatile("s_waitcnt vmcnt(0)" ::: "memory");
            const unsigned og = xb_add(&bar[XB_TOP], 1u);
            const unsigned tg = og / nx;
            if (og + 1u == (tg + 1u) * nx) xb_add(&bar[XB_TOPGEN], 1u);
            else XB_SPIN(xb_ld(&bar[XB_TOPGEN]) == tg, bar);
            __builtin_amdgcn_fence(__ATOMIC_ACQUIRE, "agent");
            xb_add(&bar[XB_XGEN(b.x)], 1u);
            asm volatile("s_waitcnt vmcnt(0)" ::: "memory");
        } else {
            XB_SPIN(xb_ld(&bar[XB_XGEN(b.x)]) == gen, bar);
            __builtin_amdgcn_fence(__ATOMIC_ACQUIRE, "agent");
            asm volatile("s_waitcnt vmcnt(0)" ::: "memory");
        }
    }
    __syncthreads();
}

typedef unsigned short bf16;
typedef unsigned v4u __attribute__((ext_vector_type(4)));
typedef unsigned v2u __attribute__((ext_vector_type(2)));
typedef float f32x4 __attribute__((ext_vector_type(4)));
typedef float f32x16 __attribute__((ext_vector_type(16)));
typedef short bf16x8 __attribute__((ext_vector_type(8)));
#define LDS_WAIT() asm volatile("s_waitcnt lgkmcnt(0)" ::: "memory")
#define VM_WAIT() asm volatile("s_waitcnt vmcnt(0)" ::: "memory")

constexpr int NWAVES = 8, NTHREADS = 512;
constexpr int BATCH = 2, SEQ = 8192, M = BATCH * SEQ, D = 2048, DEPTH = 4;
constexpr int IN_COLS = 4160, IN_PAD = 4352;
constexpr int C_DAQ = 0, C_DAK = 768, C_DAV = 1536, C_QA = 2304, C_KVA = 2816, C_KR = 3072, C_SGU = 3136, C_SGV = 3648;
constexpr int DFF = 5632, NUP = 2 * DFF;
constexpr int UQ_N = 1152, UQ_PAD = 1536, UKV_N = 1536, QRANK = 512, KVRANK = 256;
constexpr int NH = 6;
constexpr float EPS = 1e-6f;
constexpr float LOG2E = 1.4426950408889634f;
constexpr float QS_DA = 0.125f * LOG2E;
constexpr float QS_MLA = 0.07216878364870322f * LOG2E;

enum { I_X = 0, I_C, I_POS, I_WADA, I_BADA, I_WIN, I_DAQG, I_DAKG, I_LQ1, I_LK1, I_LQ2, I_LK2, I_DAHG, I_QAG, I_WUQ, I_KVAG, I_WUKV, I_MQG, I_MKG, I_SGVG, I_SGW, I_SGB, I_WOUT, I_WUP, I_CONVW, I_CONVB, I_WDOWN, N_IN };

constexpr size_t MiB = 1u << 20;
constexpr size_t WS_CTL = 0, CTL_ZERO_BYTES = 1 * MiB;
constexpr size_t WS_MOD = 1 * MiB;
constexpr size_t WS_POSMM = 1 * MiB + 512 * 1024;
constexpr size_t WS_MODP = 2 * MiB;
constexpr size_t WS_W = 8 * MiB;
constexpr size_t WL_IN = 0, WL_UQ = 17 * MiB, WL_UKV = WL_UQ + 1572864, WL_OUT = 20 * MiB, WL_UP = 28 * MiB, WL_DOWN = 72 * MiB, WL_STRIDE = 94 * MiB;
constexpr size_t WS_H = 384 * MiB;
constexpr size_t WS_MIX = 448 * MiB;
constexpr size_t WS_U = 512 * MiB;
constexpr size_t WS_R = 688 * MiB;
constexpr size_t WS_KR = WS_R;
constexpr size_t WS_SSQ_QA = WS_R + 4 * MiB, WS_SSQ_KVA = WS_R + 5 * MiB, WS_SSQ_SGV = WS_R + 6 * MiB, WS_SSQ_KR = WS_R + 7 * MiB;
constexpr size_t WS_QD = WS_R + 272 * MiB, WS_KD = WS_R + 296 * MiB, WS_VD = WS_R + 320 * MiB;
constexpr size_t WS_QM = WS_R + 344 * MiB, WS_KM = WS_R + 380 * MiB, WS_VM = WS_R + 416 * MiB;
constexpr size_t WS_QA = WS_R + 440 * MiB, WS_KVA = WS_R + 456 * MiB;
constexpr size_t WS_MLQ = WS_R + 464 * MiB, WS_MLKV = WS_R + 544 * MiB;
constexpr size_t WS_UU = WS_R + 640 * MiB, WS_GV = WS_R + 672 * MiB;
constexpr size_t WS_EDGE = WS_R;
constexpr size_t WS_A = WS_R;
constexpr size_t WS_O1 = WS_R + 704 * MiB;
constexpr size_t WS_COS = WS_R + 752 * MiB, WS_SIN = WS_R + 754 * MiB;
constexpr size_t WS_END = WS_R + 756 * MiB;

constexpr int RING_BYTES = 131072;
constexpr int LDSCTL_OFF = RING_BYTES;
constexpr int LDS_BYTES = 147456;

__device__ const float ROPE_INV[32] = {1.000000000e+00f, 7.498942614e-01f, 5.623413324e-01f, 4.216965139e-01f, 3.162277639e-01f, 2.371373773e-01f, 1.778279394e-01f, 1.333521307e-01f, 1.000000015e-01f, 7.498941571e-02f, 5.623413250e-02f, 4.216965288e-02f, 3.162277490e-02f, 2.371373773e-02f, 1.778279431e-02f, 1.333521493e-02f, 9.999999776e-03f, 7.498941850e-03f, 5.623413250e-03f, 4.216964822e-03f, 3.162277630e-03f, 2.371373586e-03f, 1.778279431e-03f, 1.333521446e-03f, 1.000000047e-03f, 7.498942432e-04f, 5.623413017e-04f, 4.216965172e-04f, 3.162277571e-04f, 2.371373703e-04f, 1.778279402e-04f, 1.333521504e-04f};
__device__ const float ALIBI_SLOPE[6] = {0.3968502629920499f, 0.15749013123685915f, 0.0625f, 0.024803141437003122f, 0.0098431332023036951f, 0.00390625f};
__device__ const float LAM_INIT[4] = {0.20000000000000007f, 0.35550906759096934f, 0.4707130183435842f, 0.5560582041556406f};

struct Args { const void* in[N_IN]; float* out; unsigned char* ws; int ph; int l; };

__device__ __forceinline__ unsigned f2bf(float f) { unsigned u = __builtin_bit_cast(unsigned, f); return (u + 0x7fffu + ((u >> 16) & 1u)) >> 16; }
__device__ __forceinline__ unsigned pk2(float lo, float hi) { return f2bf(lo) | (f2bf(hi) << 16); }
__device__ __forceinline__ float bf2f(unsigned short h) { return __builtin_bit_cast(float, (unsigned)h << 16); }
template <int CTRL> __device__ __forceinline__ float dpp_mov(float v) { return __builtin_bit_cast(float, __builtin_amdgcn_update_dpp(0, __builtin_bit_cast(int, v), CTRL, 0xF, 0xF, true)); }
__device__ __forceinline__ float sum16(float v) { v += dpp_mov<0xB1>(v); v += dpp_mov<0x4E>(v); v += dpp_mov<0x141>(v); v += dpp_mov<0x140>(v); return v; }
__device__ __forceinline__ float sum32(float v) { v = sum16(v); auto r = __builtin_amdgcn_permlane16_swap(__float_as_uint(v), __float_as_uint(v), false, false); return __uint_as_float(r[0]) + __uint_as_float(r[1]); }
__device__ __forceinline__ float wave_sum(float v) { v = sum32(v); auto r = __builtin_amdgcn_permlane32_swap(__float_as_uint(v), __float_as_uint(v), false, false); return __uint_as_float(r[0]) + __uint_as_float(r[1]); }
__device__ __forceinline__ float wave_max(float v) { v = fmaxf(v, dpp_mov<0xB1>(v)); v = fmaxf(v, dpp_mov<0x4E>(v)); v = fmaxf(v, dpp_mov<0x141>(v)); v = fmaxf(v, dpp_mov<0x140>(v));
    { auto r = __builtin_amdgcn_permlane16_swap(__float_as_uint(v), __float_as_uint(v), false, false); v = fmaxf(__uint_as_float(r[0]), __uint_as_float(r[1])); }
    { auto r = __builtin_amdgcn_permlane32_swap(__float_as_uint(v), __float_as_uint(v), false, false); v = fmaxf(__uint_as_float(r[0]), __uint_as_float(r[1])); } return v; }
__device__ __forceinline__ float xor32(float v, int lane) { auto r = __builtin_amdgcn_permlane32_swap(__float_as_uint(v), __float_as_uint(v), false, false); return lane < 32 ? __uint_as_float(r[1]) : __uint_as_float(r[0]); }
__device__ __forceinline__ float gelu_tanh(float x) {
    const float u = 0.7978845608028654f * (x + 0.044715f * x * x * x);
    const float e = __expf(2.0f * u);
    const float th = 1.0f - 2.0f / (e + 1.0f);
    return 0.5f * x * (1.0f + th);
}
__device__ __forceinline__ float silu_f(float x) { return x / (1.0f + __expf(-x)); }
__device__ __forceinline__ int crow(int r, int hi) { return (r & 3) + 8 * (r >> 2) + 4 * hi; }

namespace pg8 {
struct EpiF32 {
    static constexpr bool PERM = false, AFTER_DRAIN = false;
    float* C; int ldc;
    __device__ __forceinline__ void operator()(const f32x4 (&acc)[2][2][4][2], const Unit& u, int wr, int wc, int fr, int fq) const {
        const int row0 = u.pm * BM + wr * 64 + fr, col0 = u.pn * BM + wc * 32 + 4 * fq;
#pragma unroll
        for (int ai = 0; ai < 2; ++ai)
#pragma unroll
            for (int m = 0; m < 4; ++m) { float* rowp = C + (size_t)(row0 + ai * HALF + m * 16) * ldc + col0;
#pragma unroll
                for (int bj = 0; bj < 2; ++bj)
#pragma unroll
                    for (int n = 0; n < 2; ++n) *(f32x4*)(rowp + bj * HALF + n * 16) = acc[ai][bj][m][n]; }
    }
};
struct EpiNull {
    static constexpr bool PERM = true, AFTER_DRAIN = false;
    float* C;
    __device__ __forceinline__ void operator()(const f32x4 (&acc)[2][2][4][2], const Unit& u, int wr, int wc, int fr, int fq) const {
        f32x4 s = {0.f, 0.f, 0.f, 0.f};
#pragma unroll
        for (int ai = 0; ai < 2; ++ai)
#pragma unroll
            for (int bj = 0; bj < 2; ++bj)
#pragma unroll
                for (int m = 0; m < 4; ++m)
#pragma unroll
                    for (int n = 0; n < 2; ++n) s += acc[ai][bj][m][n];
        C[(size_t)(u.pm * 44 + u.pn) * 512 + (wr * 4 + wc) * 64 + fq * 16 + fr] = (s[0] + s[1]) + (s[2] + s[3]);
    }
};
struct EpiResid {
    static constexpr bool PERM = false, AFTER_DRAIN = false;
    const float* xin; float* out; int ldc; const float* gate; int gate_stride;
    __device__ __forceinline__ void operator()(const f32x4 (&acc)[2][2][4][2], const Unit& u, int wr, int wc, int fr, int fq) const {
        const int row0 = u.pm * BM + wr * 64 + fr, col0 = u.pn * BM + wc * 32 + 4 * fq;
        const float* gp = gate + (size_t)((u.pm * BM) / SEQ) * gate_stride + col0;
        f32x4 gv[2][2];
#pragma unroll
        for (int bj = 0; bj < 2; ++bj)
#pragma unroll
            for (int n = 0; n < 2; ++n) gv[bj][n] = *(const f32x4*)(gp + bj * HALF + n * 16);
#pragma unroll
        for (int ai = 0; ai < 2; ++ai) {
            f32x4 xv[4][2][2];
#pragma unroll
            for (int m = 0; m < 4; ++m) { const size_t off = (size_t)(row0 + ai * HALF + m * 16) * ldc + col0;
#pragma unroll
                for (int bj = 0; bj < 2; ++bj)
#pragma unroll
                    for (int n = 0; n < 2; ++n) xv[m][bj][n] = *(const f32x4*)(xin + off + bj * HALF + n * 16); }
#pragma unroll
            for (int m = 0; m < 4; ++m) { const size_t off = (size_t)(row0 + ai * HALF + m * 16) * ldc + col0;
#pragma unroll
                for (int bj = 0; bj < 2; ++bj)
#pragma unroll
                    for (int n = 0; n < 2; ++n) *(f32x4*)(out + off + bj * HALF + n * 16) = xv[m][bj][n] + gv[bj][n] * acc[ai][bj][m][n]; }
        }
    }
};
struct EpiBf16S {
    static constexpr bool PERM = true, AFTER_DRAIN = false;
    bf16_t* O; int ldc;
    __device__ __forceinline__ void operator()(const f32x4 (&acc)[2][2][4][2], const Unit& u, int wr, int wc, int fr, int fq) const {
        const int row0 = u.pm * BM + wr * 64 + fr, col0 = u.pn * BM + wc * 32 + 8 * fq;
#pragma unroll
        for (int ai = 0; ai < 2; ++ai)
#pragma unroll
            for (int m = 0; m < 4; ++m) { bf16_t* rowp = O + (size_t)(row0 + ai * HALF + m * 16) * ldc + col0;
#pragma unroll
                for (int bj = 0; bj < 2; ++bj) { const f32x4 v0 = acc[ai][bj][m][0], v1 = acc[ai][bj][m][1]; u32x4 w;
                    w.x = cvt_pk_bf16(v0[0], v0[1]); w.y = cvt_pk_bf16(v0[2], v0[3]); w.z = cvt_pk_bf16(v1[0], v1[1]); w.w = cvt_pk_bf16(v1[2], v1[3]);
                    *(u32x4*)(rowp + bj * HALF) = w; } }
    }
};
template <int CTRL> __device__ __forceinline__ float dppf(float old, float src) { return __builtin_bit_cast(float, __builtin_amdgcn_update_dpp(__builtin_bit_cast(int, old), __builtin_bit_cast(int, src), CTRL, 0xF, 0xF, false)); }
struct EpiConvGate {
    static constexpr bool PERM = true, AFTER_DRAIN = false;
    bf16_t* U; float* EDGE; const float* cw; const float* cb;
    __device__ __forceinline__ void operator()(const f32x4 (&acc)[2][2][4][2], const Unit& u, int wr, int wc, int fr, int fq) const {
        const int ch0 = u.pn * 128 + wc * 32 + 8 * fq, rowb = u.pm * BM + wr * 64;
#pragma unroll
        for (int ai = 0; ai < 2; ++ai) { const int blk = (rowb + ai * HALF) >> 6;
            if (fr < 2) { float* e = EDGE + ((size_t)(blk * 4 + fr) * 2) * DFF + ch0;
#pragma unroll
                for (int bj = 0; bj < 2; ++bj) { *(f32x4*)(e + bj * DFF) = acc[ai][bj][0][0]; *(f32x4*)(e + bj * DFF + 4) = acc[ai][bj][0][1]; } }
            if (fr >= 14) { float* e = EDGE + ((size_t)(blk * 4 + fr - 12) * 2) * DFF + ch0;
#pragma unroll
                for (int bj = 0; bj < 2; ++bj) { *(f32x4*)(e + bj * DFF) = acc[ai][bj][3][0]; *(f32x4*)(e + bj * DFF + 4) = acc[ai][bj][3][1]; } }
        }
#pragma unroll
        for (int n = 0; n < 2; ++n) {
            const int ch = ch0 + 4 * n;
            f32x4 w[2][3], bb[2];
#pragma unroll
            for (int bj = 0; bj < 2; ++bj) { bb[bj] = *(const f32x4*)(cb + bj * DFF + ch);
#pragma unroll
                for (int j = 0; j < 3; ++j) w[bj][j] = *(const f32x4*)(cw + (size_t)j * (2 * DFF) + bj * DFF + ch); }
#pragma unroll
            for (int ai = 0; ai < 2; ++ai)
#pragma unroll
                for (int m = 0; m < 4; ++m) {
                    f32x4 y[2];
#pragma unroll
                    for (int bj = 0; bj < 2; ++bj) { const f32x4 cur = acc[ai][bj][m][n]; const f32x4 prv = m > 0 ? acc[ai][bj][m - 1][n] : (f32x4){0.f, 0.f, 0.f, 0.f};
                        f32x4 s1, s2;
#pragma unroll
                        for (int e = 0; e < 4; ++e) {
                            if (m > 0) { s1[e] = dppf<0x111>(dpp_mov<0x121>(prv[e]), cur[e]); s2[e] = dppf<0x112>(dpp_mov<0x122>(prv[e]), cur[e]); }
                            else { s1[e] = dpp_mov<0x111>(cur[e]); s2[e] = dpp_mov<0x112>(cur[e]); } }
                        y[bj] = bb[bj] + w[bj][2] * cur + w[bj][1] * s1 + w[bj][0] * s2; }
                    const f32x4 tg = y[0] * -1.4426950408889634f;
                    f32x4 ev; ev[0] = __builtin_amdgcn_exp2f(tg[0]); ev[1] = __builtin_amdgcn_exp2f(tg[1]); ev[2] = __builtin_amdgcn_exp2f(tg[2]); ev[3] = __builtin_amdgcn_exp2f(tg[3]);
                    const f32x4 dn = ev + 1.0f;
                    f32x4 rc; rc[0] = __builtin_amdgcn_rcpf(dn[0]); rc[1] = __builtin_amdgcn_rcpf(dn[1]); rc[2] = __builtin_amdgcn_rcpf(dn[2]); rc[3] = __builtin_amdgcn_rcpf(dn[3]);
                    const f32x4 o = (y[0] * rc) * y[1];
                    unsigned long long pk = (unsigned long long)cvt_pk_bf16(o[0], o[1]) | ((unsigned long long)cvt_pk_bf16(o[2], o[3]) << 32);
                    *(unsigned long long*)(U + (size_t)(rowb + ai * HALF + m * 16 + fr) * DFF + ch) = pk;
                }
        }
    }
};
__device__ __forceinline__ float lane_xor16_sum(float v) { auto r = __builtin_amdgcn_permlane16_swap(__float_as_uint(v), __float_as_uint(v), false, false); return __uint_as_float(r[0]) + __uint_as_float(r[1]); }
__device__ __forceinline__ float lane_xor32_sum(float v) { auto r = __builtin_amdgcn_permlane32_swap(__float_as_uint(v), __float_as_uint(v), false, false); return __uint_as_float(r[0]) + __uint_as_float(r[1]); }
__device__ __forceinline__ float sq4(f32x4 v) { return (v[0] * v[0] + v[1] * v[1]) + (v[2] * v[2] + v[3] * v[3]); }
__device__ __forceinline__ u32x4 pk8(f32x4 a, f32x4 b) { u32x4 w; w.x = cvt_pk_bf16(a[0], a[1]); w.y = cvt_pk_bf16(a[2], a[3]); w.z = cvt_pk_bf16(b[0], b[1]); w.w = cvt_pk_bf16(b[2], b[3]); return w; }
__device__ __forceinline__ float gelu_t(float x) { const float u = 0.7978845608028654f * (x + 0.044715f * x * x * x); const float e = __expf(2.0f * u); return 0.5f * x * (2.0f - 2.0f * __builtin_amdgcn_rcpf(e + 1.0f)); }
__device__ __forceinline__ f32x4 gelu4(f32x4 v) { return (f32x4){gelu_t(v[0]), gelu_t(v[1]), gelu_t(v[2]), gelu_t(v[3])}; }
struct EpiInProj {
    static constexpr bool PERM = true, AFTER_DRAIN = false;
    bf16_t *QD, *KD, *VD, *QA, *KVA, *GV; float *UU, *KR, *SSQ_QA, *SSQ_KVA, *SSQ_SGV, *SSQ_KR;
    const float *qg, *kg, *qag, *kvag, *sgvg;
    __device__ __forceinline__ void operator()(const f32x4 (&acc)[2][2][4][2], const Unit& u, int wr, int wc, int fr, int fq) const {
        const int pn = u.pn, rowb = u.pm * BM + wr * 64 + fr, b = (u.pm * BM) / SEQ, c8 = wc * 32 + 8 * fq;
        if (pn < 6) {
            const bool isk = pn >= 3; const int G = 4 * (isk ? pn - 3 : pn) + wc;
            const float* gp = isk ? kg : qg;
            const f32x4 g00 = *(const f32x4*)(gp + 8 * fq), g01 = *(const f32x4*)(gp + 8 * fq + 4), g10 = *(const f32x4*)(gp + 32 + 8 * fq), g11 = *(const f32x4*)(gp + 32 + 8 * fq + 4);
            bf16_t* dst = (isk ? KD : QD) + ((size_t)(b * 12 + G) * SEQ) * 64 + 8 * fq;
            const float post = isk ? 1.0f : QS_DA;
#pragma unroll
            for (int ai = 0; ai < 2; ++ai)
#pragma unroll
                for (int m = 0; m < 4; ++m) { const f32x4 v00 = acc[ai][0][m][0], v01 = acc[ai][0][m][1], v10 = acc[ai][1][m][0], v11 = acc[ai][1][m][1];
                    float ss = (sq4(v00) + sq4(v01)) + (sq4(v10) + sq4(v11)); ss = lane_xor16_sum(ss); ss = lane_xor32_sum(ss);
                    const float r = rsqrtf(ss * (1.f / 64) + EPS) * post;
                    bf16_t* d = dst + (size_t)((rowb + ai * HALF + m * 16) & (SEQ - 1)) * 64;
                    *(u32x4*)d = pk8(v00 * g00 * r, v01 * g01 * r); *(u32x4*)(d + 32) = pk8(v10 * g10 * r, v11 * g11 * r); }
        } else if (pn < 9) {
#pragma unroll
            for (int bj = 0; bj < 2; ++bj) { bf16_t* dst = VD + ((size_t)(b * NH + 2 * (pn - 6) + bj) * SEQ) * 128 + c8;
#pragma unroll
                for (int ai = 0; ai < 2; ++ai)
#pragma unroll
                    for (int m = 0; m < 4; ++m) *(u32x4*)(dst + (size_t)((rowb + ai * HALF + m * 16) & (SEQ - 1)) * 128) = pk8(acc[ai][bj][m][0], acc[ai][bj][m][1]); }
        } else if (pn < 12) {
            const bool iskv = pn == 11; const int ct = iskv ? 0 : 256 * (pn - 9);
            const float* gp = (iskv ? kvag : qag) + ct + c8;
            const f32x4 g00 = *(const f32x4*)gp, g01 = *(const f32x4*)(gp + 4), g10 = *(const f32x4*)(gp + HALF), g11 = *(const f32x4*)(gp + HALF + 4);
            bf16_t* dst = (iskv ? KVA : QA) + ct + c8; const int ld = iskv ? KVRANK : QRANK;
            float* sq = iskv ? SSQ_KVA + wc : SSQ_QA + (pn - 9) * 4 + wc; const int sld = iskv ? 4 : 8;
#pragma unroll
            for (int ai = 0; ai < 2; ++ai)
#pragma unroll
                for (int m = 0; m < 4; ++m) { const int row = rowb + ai * HALF + m * 16;
                    const f32x4 v00 = acc[ai][0][m][0], v01 = acc[ai][0][m][1], v10 = acc[ai][1][m][0], v11 = acc[ai][1][m][1];
                    float ss = (sq4(v00) + sq4(v01)) + (sq4(v10) + sq4(v11)); ss = lane_xor16_sum(ss); ss = lane_xor32_sum(ss);
                    if (fq == 0) sq[(size_t)row * sld] = ss;
                    *(u32x4*)(dst + (size_t)row * ld) = pk8(v00 * g00, v01 * g01); *(u32x4*)(dst + (size_t)row * ld + HALF) = pk8(v10 * g10, v11 * g11); }
        } else if (pn < 14) {
            float* dst = UU + 256 * (pn - 12) + c8;
#pragma unroll
            for (int ai = 0; ai < 2; ++ai)
#pragma unroll
                for (int m = 0; m < 4; ++m) { float* d = dst + (size_t)(rowb + ai * HALF + m * 16) * 512;
#pragma unroll
                    for (int bj = 0; bj < 2; ++bj) { *(f32x4*)(d + bj * HALF) = gelu4(acc[ai][bj][m][0]); *(f32x4*)(d + bj * HALF + 4) = gelu4(acc[ai][bj][m][1]); } }
        } else if (pn < 16) {
            const int g0 = 2 * (pn - 14);
#pragma unroll
            for (int bj = 0; bj < 2; ++bj) { const float* gp = sgvg + (g0 + bj) * 128 + c8; const f32x4 ga = *(const f32x4*)gp, gb = *(const f32x4*)(gp + 4);
                bf16_t* dst = GV + (g0 + bj) * 128 + c8; float* sq = SSQ_SGV + (g0 + bj) * 4 + wc;
#pragma unroll
                for (int ai = 0; ai < 2; ++ai)
#pragma unroll
                    for (int m = 0; m < 4; ++m) { const int row = rowb + ai * HALF + m * 16; const f32x4 a = gelu4(acc[ai][bj][m][0]), c = gelu4(acc[ai][bj][m][1]);
                        float ss = sq4(a) + sq4(c); ss = lane_xor16_sum(ss); ss = lane_xor32_sum(ss);
                        if (fq == 0) sq[(size_t)row * 16] = ss;
                        *(u32x4*)(dst + (size_t)row * 512) = pk8(a * ga, c * gb); } }
        } else {
            if (wc < 2) {
#pragma unroll
                for (int ai = 0; ai < 2; ++ai)
#pragma unroll
                    for (int m = 0; m < 4; ++m) { const int row = rowb + ai * HALF + m * 16; float* d = KR + (size_t)row * 64 + c8; *(f32x4*)d = acc[ai][0][m][0]; *(f32x4*)(d + 4) = acc[ai][0][m][1];
                        float ss = sq4(acc[ai][0][m][0]) + sq4(acc[ai][0][m][1]); ss = lane_xor16_sum(ss); ss = lane_xor32_sum(ss); if (fq == 0) SSQ_KR[(size_t)row * 2 + wc] = ss; } }
        }
    }
};
struct EpiMlaQ {
    static constexpr bool PERM = true, AFTER_DRAIN = false;
    bf16_t* QM; const float *SSQ_QA, *COS, *SIN, *qg; PG8_LAS float* X;
    __device__ __forceinline__ void operator()(const f32x4 (&acc)[2][2][4][2], const Unit& u, int wr, int wc, int fr_, int fq_) const {
        float eps_ = EPS, k192 = 1.f / 192; asm volatile("" : "+s"(eps_), "+s"(k192));
        int fr = fr_, fq = fq_; asm volatile("" : "+v"(fr), "+v"(fq));
        const int h = u.pn, rowb = u.pm * BM + wr * 64 + fr, b = (u.pm * BM) / SEQ, c8 = wc * 32 + 8 * fq, rt = wr * 64 + fr;
#pragma unroll
        for (int ai = 0; ai < 2; ++ai)
#pragma unroll
            for (int m = 0; m < 4; ++m) { float ss = (sq4(acc[ai][0][m][0]) + sq4(acc[ai][0][m][1])) + (sq4(acc[ai][1][m][0]) + sq4(acc[ai][1][m][1])); ss = lane_xor16_sum(ss); ss = lane_xor32_sum(ss);
                if (fq == 0) X[(ai * HALF + m * 16 + rt) * 4 + wc] = ss; }
        asm volatile("s_waitcnt lgkmcnt(0)" ::: "memory"); __builtin_amdgcn_s_barrier(); asm volatile("" ::: "memory");
        const f32x4 g0a = *(const f32x4*)(qg + c8), g0b = *(const f32x4*)(qg + c8 + 4);
        const int i0 = 16 * wc + 4 * fq;
        f32x4 g1 = {0.f, 0.f, 0.f, 0.f}, g2 = g1; if (wc < 2) { g1 = *(const f32x4*)(qg + 128 + i0); g2 = *(const f32x4*)(qg + 160 + i0); }
        bf16_t* dst = QM + ((size_t)(b * NH + h) * SEQ) * 192;
#pragma unroll
        for (int ai = 0; ai < 2; ++ai)
#pragma unroll
        for (int mh = 0; mh < 4; mh += 2) {
        float rr[2][4]; f32x4 csv[2][4], snv[2][4];
#pragma unroll
            for (int m = mh; m < mh + 2; ++m) { const int row = rowb + ai * HALF + m * 16; const f32x4 xs = *(const PG8_LAS f32x4*)(X + (ai * HALF + m * 16 + rt) * 4);
                const f32x4 pa = *(const f32x4*)(SSQ_QA + (size_t)row * 8), pb = *(const f32x4*)(SSQ_QA + (size_t)row * 8 + 4);
                const float msq = (((pa[0] + pa[1]) + (pa[2] + pa[3])) + ((pb[0] + pb[1]) + (pb[2] + pb[3]))) * (1.f / 512) + eps_;
                rr[ai][m] = rsqrtf(((xs[0] + xs[1]) + (xs[2] + xs[3])) * k192 + eps_ * msq) * QS_MLA;
                if (wc < 2) { csv[ai][m] = *(const f32x4*)(COS + (size_t)row * 32 + i0); snv[ai][m] = *(const f32x4*)(SIN + (size_t)row * 32 + i0); } }
#pragma unroll
            for (int m = mh; m < mh + 2; ++m) { const int row = rowb + ai * HALF + m * 16; const float r = rr[ai][m];
                bf16_t* d = dst + (size_t)(row & (SEQ - 1)) * 192;
                *(u32x4*)(d + c8) = pk8(acc[ai][0][m][0] * g0a * r, acc[ai][0][m][1] * g0b * r);
                if (wc < 2) { const f32x4 cs = csv[ai][m], sn = snv[ai][m];
                    const f32x4 va = acc[ai][1][m][0], vb = acc[ai][1][m][1];
                    const f32x4 y1 = (f32x4){va[0], va[2], vb[0], vb[2]} * g1 * r, y2 = (f32x4){va[1], va[3], vb[1], vb[3]} * g2 * r;
                    const f32x4 o1 = y1 * cs - y2 * sn, o2 = y2 * cs + y1 * sn;
                    *(u32x4*)(d + 128 + c8) = pk8((f32x4){o1[0], o2[0], o1[1], o2[1]}, (f32x4){o1[2], o2[2], o1[3], o2[3]}); } }
        }
        asm volatile("s_waitcnt lgkmcnt(0)" ::: "memory"); __builtin_amdgcn_s_barrier(); asm volatile("" ::: "memory");
    }
};
struct EpiMlaKV {
    static constexpr bool PERM = true, AFTER_DRAIN = false;
    bf16_t *KM, *VM; const float *SSQ_KVA, *SSQ_KR, *KR, *COS, *SIN, *kg; PG8_LAS float* X;
    __device__ __forceinline__ void operator()(const f32x4 (&acc)[2][2][4][2], const Unit& u, int wr, int wc, int fr_, int fq_) const {
        float eps_ = EPS, k192 = 1.f / 192; asm volatile("" : "+s"(eps_), "+s"(k192));
        int fr = fr_, fq = fq_; asm volatile("" : "+v"(fr), "+v"(fq));
        const int h = u.pn, rowb = u.pm * BM + wr * 64 + fr, b = (u.pm * BM) / SEQ, c8 = wc * 32 + 8 * fq, rt = wr * 64 + fr;
#pragma unroll
        for (int ai = 0; ai < 2; ++ai)
#pragma unroll
            for (int m = 0; m < 4; ++m) { float ss = sq4(acc[ai][0][m][0]) + sq4(acc[ai][0][m][1]); ss = lane_xor16_sum(ss); ss = lane_xor32_sum(ss);
                if (fq == 0) X[(ai * HALF + m * 16 + rt) * 4 + wc] = ss; }
        asm volatile("s_waitcnt lgkmcnt(0)" ::: "memory"); __builtin_amdgcn_s_barrier(); asm volatile("" ::: "memory");
        const f32x4 g0a = *(const f32x4*)(kg + c8), g0b = *(const f32x4*)(kg + c8 + 4);
        const int i0 = 8 * wc + 2 * fq;
        const float g1a = kg[128 + i0], g1b = kg[128 + i0 + 1], g2a = kg[160 + i0], g2b = kg[160 + i0 + 1];
        bf16_t* kd = KM + ((size_t)(b * NH + h) * SEQ) * 192; bf16_t* vd = VM + ((size_t)(b * NH + h) * SEQ) * 128;
#pragma unroll
        for (int ai = 0; ai < 2; ++ai) {
        float rr[2][4], cv[2][4]; float2 k1v[2][4], k2v[2][4], cpv[2][4], spv[2][4];
#pragma unroll
            for (int m = 0; m < 4; ++m) { const int row = rowb + ai * HALF + m * 16; const f32x4 xs = *(const PG8_LAS f32x4*)(X + (ai * HALF + m * 16 + rt) * 4);
                const f32x4 pc = *(const f32x4*)(SSQ_KVA + (size_t)row * 4);
                const float c2 = 1.0f / (((pc[0] + pc[1]) + (pc[2] + pc[3])) * (1.f / 256) + eps_);
                const float2 sk = *(const float2*)(SSQ_KR + (size_t)row * 2);
                cv[ai][m] = sqrtf(c2); rr[ai][m] = rsqrtf((c2 * ((xs[0] + xs[1]) + (xs[2] + xs[3])) + (sk.x + sk.y)) * k192 + eps_);
                const float* kr = KR + (size_t)row * 64 + i0;
                k1v[ai][m] = *(const float2*)kr; k2v[ai][m] = *(const float2*)(kr + 32); cpv[ai][m] = *(const float2*)(COS + (size_t)row * 32 + i0); spv[ai][m] = *(const float2*)(SIN + (size_t)row * 32 + i0); }
#pragma unroll
            for (int m = 0; m < 4; ++m) { const int row = rowb + ai * HALF + m * 16; const float r = rr[ai][m], ckv = cv[ai][m];
                const int srow = row & (SEQ - 1);
                *(u32x4*)(kd + (size_t)srow * 192 + c8) = pk8(acc[ai][0][m][0] * g0a * (ckv * r), acc[ai][0][m][1] * g0b * (ckv * r));
                *(u32x4*)(vd + (size_t)srow * 128 + c8) = pk8(acc[ai][1][m][0] * ckv, acc[ai][1][m][1] * ckv);
                const float2 cp = cpv[ai][m], sp = spv[ai][m];
                const float y1a = k1v[ai][m].x * r * g1a, y1b = k1v[ai][m].y * r * g1b, y2a = k2v[ai][m].x * r * g2a, y2b = k2v[ai][m].y * r * g2b;
                const float oa1 = y1a * cp.x - y2a * sp.x, oa2 = y2a * cp.x + y1a * sp.x, ob1 = y1b * cp.y - y2b * sp.y, ob2 = y2b * cp.y + y1b * sp.y;
                *(unsigned long long*)(kd + (size_t)srow * 192 + 128 + 2 * i0) = (unsigned long long)cvt_pk_bf16(oa1, oa2) | ((unsigned long long)cvt_pk_bf16(ob1, ob2) << 32); }
        }
        asm volatile("s_waitcnt lgkmcnt(0)" ::: "memory"); __builtin_amdgcn_s_barrier(); asm volatile("" ::: "memory");
    }
};
}

struct Frame {
    LAS unsigned char* lds;
    int tid, lane, wave, wave0, gw, ngw, bid, G;
    const __attribute__((address_space(4))) Args* ka; const int* pos;
    float* out; unsigned char* ws;
};
__device__ __forceinline__ size_t opq(size_t v) { asm volatile("" : "+s"(v)); return v; }
#define WSP(T, off) ((T*)(F.ws + opq(off)))
#define FIN(i) ((const float*)F.ka->in[i])
__device__ __forceinline__ const bf16* wptr(const Frame& F, int l, size_t off) { return (const bf16*)(F.ws + WS_W + (size_t)l * WL_STRIDE + off); }

__device__ __forceinline__ void p0_transpose_item(const float* W, int K, int N, bf16* WT, int row_off, LAS float* scr, int item, int lane, int rstride = 1) {
    const int nblk = N / 32, kb = item / nblk, nb = item % nblk, k0 = 64 * kb, n0 = 32 * nb;
    float wv_[32];
#pragma unroll
    for (int i = 0; i < 32; ++i) { const int kk = 2 * i + (lane >> 5); wv_[i] = W[(size_t)(k0 + kk) * N + n0 + (lane & 31)]; }
#pragma unroll
    for (int i = 0; i < 32; ++i) { const int kk = 2 * i + (lane >> 5); scr[kk * 33 + (lane & 31)] = wv_[i]; }
    LDS_WAIT(); asm volatile("" ::: "memory");
    const int c = lane & 7;
#pragma unroll
    for (int j = 0; j < 4; ++j) { const int n = (lane >> 3) + 8 * j; const LAS float* s = scr + (8 * c) * 33 + n;
        v4u o; o.x = pk2(s[0 * 33], s[1 * 33]); o.y = pk2(s[2 * 33], s[3 * 33]); o.z = pk2(s[4 * 33], s[5 * 33]); o.w = pk2(s[6 * 33], s[7 * 33]);
        *(v4u*)(WT + (size_t)(row_off + n0 + rstride * n) * K + k0 + 8 * c) = o; }
    LDS_WAIT(); asm volatile("" ::: "memory");
}
__device__ __forceinline__ void ph_prologue(Frame& F) {
    LAS float* scr = (LAS float*)(F.lds + F.wave * 16384);
    constexpr int I_IN = (D / 64) * (IN_COLS / 32), I_UQ = (QRANK / 64) * (UQ_N / 32), I_UKV = (KVRANK / 64) * (UKV_N / 32), I_OUT = (D / 64) * (D / 32), I_UP = (D / 64) * (NUP / 32), I_DN = (DFF / 64) * (D / 32);
    constexpr int I_L = I_IN + I_UQ + I_UKV + I_OUT + I_UP + I_DN;
    for (int it = F.gw; it < DEPTH * I_L; it += F.ngw) {
        const int l = it / I_L; int r = it % I_L;
        bf16* wl = (bf16*)(F.ws + WS_W + (size_t)l * WL_STRIDE);
        if (r < I_IN) { const int n0 = 32 * (r % (IN_COLS / 32)); int dst;
            if (n0 < C_DAV) { const int q = n0 % 768, G = q / 64, e = q % 64; dst = (n0 - q) + 256 * (G / 4) + 128 * (e / 32) + 32 * (G % 4) + (e % 32); }
            else if (n0 < C_KR) dst = n0;
            else if (n0 < C_SGU) dst = 4096 + (n0 - C_KR);
            else dst = n0 - 64;
            p0_transpose_item(FIN(I_WIN) + (size_t)l * D * IN_COLS, D, IN_COLS, (bf16*)((unsigned char*)wl + WL_IN), dst - n0, scr, r, F.lane); continue; } r -= I_IN;
        if (r < I_UQ) { const int n0 = 32 * (r % (UQ_N / 32)), hh = n0 / 192, e = n0 % 192;
            const int dst = 256 * hh + (e < 128 ? e : 128 + (e - 128) / 32);
            p0_transpose_item(FIN(I_WUQ) + (size_t)l * QRANK * UQ_N, QRANK, UQ_N, (bf16*)((unsigned char*)wl + WL_UQ), dst - n0, scr, r, F.lane, e < 128 ? 1 : 2); continue; } r -= I_UQ;
        if (r < I_UKV) { p0_transpose_item(FIN(I_WUKV) + (size_t)l * KVRANK * UKV_N, KVRANK, UKV_N, (bf16*)((unsigned char*)wl + WL_UKV), 0, scr, r, F.lane); continue; } r -= I_UKV;
        if (r < I_OUT) { p0_transpose_item(FIN(I_WOUT) + (size_t)l * D * D, D, D, (bf16*)((unsigned char*)wl + WL_OUT), 0, scr, r, F.lane); continue; } r -= I_OUT;
        if (r < I_UP) { const int n0 = 32 * (r % (NUP / 32)), chn = n0 % DFF, dst = 256 * (chn / 128) + 128 * (n0 / DFF) + (chn % 128);
            p0_transpose_item(FIN(I_WUP) + (size_t)l * D * NUP, D, NUP, (bf16*)((unsigned char*)wl + WL_UP), dst - n0, scr, r, F.lane); continue; } r -= I_UP;
        p0_transpose_item(FIN(I_WDOWN) + (size_t)l * DFF * D, DFF, D, (bf16*)((unsigned char*)wl + WL_DOWN), 0, scr, r, F.lane);
    }
    {
        const int gt = F.bid * NTHREADS + F.tid, nt = F.G * NTHREADS;
        constexpr int Z_IN = (IN_PAD - IN_COLS) * D / 8, Z_UQ = NH * 64 * QRANK / 8;
        for (int i = gt; i < DEPTH * (Z_IN + Z_UQ); i += nt) { const int l = i / (Z_IN + Z_UQ); int r = i % (Z_IN + Z_UQ);
            unsigned char* wl = F.ws + WS_W + (size_t)l * WL_STRIDE;
            v4u z = {0u, 0u, 0u, 0u};
            if (r < Z_IN) *(v4u*)(wl + WL_IN + (size_t)IN_COLS * D * 2 + (size_t)r * 16) = z;
            else { r -= Z_IN; const int hh = r / (64 * QRANK / 8), q = r % (64 * QRANK / 8); *(v4u*)(wl + WL_UQ + ((size_t)(256 * hh + 192) * QRANK) * 2 + (size_t)q * 16) = z; } }
    }
    __syncthreads();
    LAS float* cond = (LAS float*)F.lds;
    for (int i = F.tid; i < 2 * D; i += NTHREADS) cond[i] = silu_f(FIN(I_C)[i]);
    __syncthreads();
    {
        const int gt = F.bid * NTHREADS + F.tid, nt = F.G * NTHREADS;
        float* part = WSP(float, WS_MODP);
        for (int it = gt; it < DEPTH * 16 * 3072; it += nt) {
            const int n4 = it % 3072, ks = (it / 3072) % 16, l = it / (3072 * 16);
            const float* w = FIN(I_WADA) + ((size_t)l * D + ks * 128) * (6 * D) + n4 * 4;
            f32x4 a0 = {0.f, 0.f, 0.f, 0.f}, a1 = {0.f, 0.f, 0.f, 0.f};
#pragma unroll 8
            for (int k = 0; k < 128; ++k) { const f32x4 wv = *(const f32x4*)(w + (size_t)k * (6 * D)); a0 += cond[ks * 128 + k] * wv; a1 += cond[D + ks * 128 + k] * wv; }
            *(f32x4*)(part + ((size_t)(l * 16 + ks) * 2 + 0) * (6 * D) + n4 * 4) = a0;
            *(f32x4*)(part + ((size_t)(l * 16 + ks) * 2 + 1) * (6 * D) + n4 * 4) = a1;
        }
    }
    __syncthreads();
}
__device__ __forceinline__ void ph_modreduce(Frame& F) {
    const int gt = F.bid * NTHREADS + F.tid, nt = F.G * NTHREADS;
    const float* part = WSP(float, WS_MODP); float* mod = WSP(float, WS_MOD);
    for (int i = gt; i < DEPTH * 2 * 6 * D; i += nt) { const int n = i % (6 * D), b = (i / (6 * D)) & 1, l = i / (12 * D);
        float s = FIN(I_BADA)[l * 6 * D + n];
#pragma unroll
        for (int ks = 0; ks < 16; ++ks) s += part[((size_t)(l * 16 + ks) * 2 + b) * (6 * D) + n];
        mod[i] = s; }
    { float* ct = WSP(float, WS_COS); float* st = WSP(float, WS_SIN);
      for (int i = gt; i < M * 32; i += nt) { const float ang = (float)F.pos[i >> 5] * ROPE_INV[i & 31];
          const double rev = (double)ang * 0.15915494309189535; const float fr = (float)(rev - floor(rev));
          ct[i] = __builtin_amdgcn_cosf(fr); st[i] = __builtin_amdgcn_sinf(fr); } }
    if (gt < M / 64) { int mn = 0x7fffffff, mx = -0x7fffffff - 1;
        for (int i = 0; i < 64; ++i) { const int p = F.pos[gt * 64 + i]; mn = p < mn ? p : mn; mx = p > mx ? p : mx; }
        int* mm = WSP(int, WS_POSMM); mm[gt * 2] = mn; mm[gt * 2 + 1] = mx; }
}
__device__ __forceinline__ void ph_norm(Frame& F, int l, const float* xsrc, int sh_off, int sc_off) {
    const float* mod = WSP(float, WS_MOD) + (size_t)l * 12 * D; bf16* H = WSP(bf16, WS_H);
    for (int row = F.gw; row < M; row += F.ngw) {
        const int b = row >> 13;
        const f32x4* xr = (const f32x4*)(xsrc + (size_t)row * D) + F.lane;
        f32x4 v[8]; float s = 0.f;
#pragma unroll
        for (int j = 0; j < 8; ++j) { v[j] = xr[64 * j]; s += (v[j].x * v[j].x + v[j].y * v[j].y) + (v[j].z * v[j].z + v[j].w * v[j].w); }
        const float r = rsqrtf(wave_sum(s) * (1.f / D) + EPS);
        const float* mb = mod + (size_t)b * 6 * D;
        unsigned long long* o8 = (unsigned long long*)(H + (size_t)row * D) + F.lane;
#pragma unroll
        for (int j = 0; j < 8; ++j) { const int c = 4 * F.lane + 256 * j;
            const f32x4 sc = *(const f32x4*)(mb + sc_off + c), sh = *(const f32x4*)(mb + sh_off + c);
            const f32x4 y = v[j] * r * (1.0f + sc) + sh;
            o8[64 * j] = (unsigned long long)pk2(y.x, y.y) | ((unsigned long long)pk2(y.z, y.w) << 32); }
    }
}

namespace fa {
#ifndef PIPE_MLA
#define PIPE_MLA 1
#endif
#ifndef PIPE_LIN
#define PIPE_LIN 0
#endif
#ifndef PIPE_GEN
#define PIPE_GEN 0
#endif
#ifndef PIPE_OLD64
#define PIPE_OLD64 0
#endif
template <typename T> __device__ __forceinline__ T ldg(const void* base, unsigned off) { return *(const T*)((const char*)base + off); }
template <typename T> __device__ __forceinline__ void stg(void* base, unsigned off, T v) { *(T*)((char*)base + off) = v; }
constexpr int crowc(int r) { return (r & 3) + 8 * (r >> 2); }
using s16x4 = __attribute__((ext_vector_type(4))) short;
using f32x8 = __attribute__((ext_vector_type(8))) float;
constexpr int QBLK = 32, KVBLK = 64, DV = 128;
constexpr int SHM_V = KVBLK * DV * 2;
constexpr float THR = 11.5f;
#define FA_SBAR() __builtin_amdgcn_sched_barrier(0)
__device__ __forceinline__ unsigned cvtpk(float lo, float hi) { unsigned r; asm volatile("v_cvt_pk_bf16_f32 %0, %1, %2" : "=v"(r) : "v"(lo), "v"(hi)); return r; }
__device__ __forceinline__ int kswz(int row, int colB) { return (colB >> 7) * 8192 + row * 128 + ((colB & 127) ^ (((row >> 1) & 7) << 4)); }
__device__ __forceinline__ int v_st(int k, int c) { const int kk = (k & ~0xC) | ((k & 4) << 1) | ((k & 8) >> 1); return ((kk >> 3) * 4 + (c >> 5)) * 512 + ((kk & 7) * 32 + (c & 31)) * 2; }
__device__ __forceinline__ int v_st_nat(int k, int c) { return ((k >> 3) * 4 + (c >> 5)) * 512 + ((k & 7) * 32 + (c & 31)) * 2; }
__device__ __forceinline__ int v_rd_base(int lane) { return ((lane & 3) << 3) | (((lane >> 2) & 3) << 6) | (((lane >> 4) & 1) << 5) | (((lane >> 5) & 1) << 8); }
constexpr int v_rd_off(int d0, int ks, int half) { return d0 * 512 + ks * 4096 + half * 2048; }
template <int OFF> __device__ __forceinline__ s16x4 tr_read(int vb) { s16x4 r; asm volatile("ds_read_b64_tr_b16 %0, %1 offset:%2" : "=&v"(r) : "v"(vb), "i"(OFF) : "memory"); return r; }
template <int D0> __device__ __forceinline__ void pv_one(f32x16& od, int vb, bf16x8 pa0, bf16x8 pa1, bf16x8 pa2, bf16x8 pa3) {
    const s16x4 l0 = tr_read<v_rd_off(D0, 0, 0)>(vb), h0 = tr_read<v_rd_off(D0, 0, 1)>(vb), l1 = tr_read<v_rd_off(D0, 1, 0)>(vb), h1 = tr_read<v_rd_off(D0, 1, 1)>(vb);
    const s16x4 l2 = tr_read<v_rd_off(D0, 2, 0)>(vb), h2 = tr_read<v_rd_off(D0, 2, 1)>(vb), l3 = tr_read<v_rd_off(D0, 3, 0)>(vb), h3 = tr_read<v_rd_off(D0, 3, 1)>(vb);
    asm volatile("s_waitcnt lgkmcnt(0)" ::: "memory"); FA_SBAR();
#define FA_PK(L, H) (bf16x8){L[0], L[1], L[2], L[3], H[0], H[1], H[2], H[3]}
    od = __builtin_amdgcn_mfma_f32_32x32x16_bf16(pa0, FA_PK(l0, h0), od, 0, 0, 0);
    od = __builtin_amdgcn_mfma_f32_32x32x16_bf16(pa1, FA_PK(l1, h1), od, 0, 0, 0);
    od = __builtin_amdgcn_mfma_f32_32x32x16_bf16(pa2, FA_PK(l2, h2), od, 0, 0, 0);
    od = __builtin_amdgcn_mfma_f32_32x32x16_bf16(pa3, FA_PK(l3, h3), od, 0, 0, 0);
#undef FA_PK
}
__device__ __forceinline__ void pv_d0(f32x16* o, int vb, bf16x8 pa0, bf16x8 pa1, bf16x8 pa2, bf16x8 pa3) {
    pv_one<0>(o[0], vb, pa0, pa1, pa2, pa3); pv_one<1>(o[1], vb, pa0, pa1, pa2, pa3); pv_one<2>(o[2], vb, pa0, pa1, pa2, pa3); pv_one<3>(o[3], vb, pa0, pa1, pa2, pa3);
}
template <int D0> __device__ __forceinline__ void pv_reads(s16x4 (&l)[4], s16x4 (&h)[4], int vb) {
    l[0] = tr_read<v_rd_off(D0, 0, 0)>(vb); h[0] = tr_read<v_rd_off(D0, 0, 1)>(vb); l[1] = tr_read<v_rd_off(D0, 1, 0)>(vb); h[1] = tr_read<v_rd_off(D0, 1, 1)>(vb);
    l[2] = tr_read<v_rd_off(D0, 2, 0)>(vb); h[2] = tr_read<v_rd_off(D0, 2, 1)>(vb); l[3] = tr_read<v_rd_off(D0, 3, 0)>(vb); h[3] = tr_read<v_rd_off(D0, 3, 1)>(vb);
}
__device__ __forceinline__ void pv_mfma(f32x16& od, const s16x4 (&l)[4], const s16x4 (&h)[4], bf16x8 pa0, bf16x8 pa1, bf16x8 pa2, bf16x8 pa3) {
#define FA_PK(L, H) (bf16x8){L[0], L[1], L[2], L[3], H[0], H[1], H[2], H[3]}
    od = __builtin_amdgcn_mfma_f32_32x32x16_bf16(pa0, FA_PK(l[0], h[0]), od, 0, 0, 0);
    od = __builtin_amdgcn_mfma_f32_32x32x16_bf16(pa1, FA_PK(l[1], h[1]), od, 0, 0, 0);
    od = __builtin_amdgcn_mfma_f32_32x32x16_bf16(pa2, FA_PK(l[2], h[2]), od, 0, 0, 0);
    od = __builtin_amdgcn_mfma_f32_32x32x16_bf16(pa3, FA_PK(l[3], h[3]), od, 0, 0, 0);
#undef FA_PK
}
__device__ __forceinline__ void pv_d0_pipe(f32x16* o, int vb, bf16x8 pa0, bf16x8 pa1, bf16x8 pa2, bf16x8 pa3) {
    s16x4 la[4], ha[4], lb[4], hb[4];
    pv_reads<0>(la, ha, vb); pv_reads<1>(lb, hb, vb);
    asm volatile("s_waitcnt lgkmcnt(8)" ::: "memory"); FA_SBAR(); pv_mfma(o[0], la, ha, pa0, pa1, pa2, pa3); FA_SBAR();
    pv_reads<2>(la, ha, vb);
    asm volatile("s_waitcnt lgkmcnt(8)" ::: "memory"); FA_SBAR(); pv_mfma(o[1], lb, hb, pa0, pa1, pa2, pa3); FA_SBAR();
    pv_reads<3>(lb, hb, vb);
    asm volatile("s_waitcnt lgkmcnt(8)" ::: "memory"); FA_SBAR(); pv_mfma(o[2], la, ha, pa0, pa1, pa2, pa3); FA_SBAR();
    asm volatile("s_waitcnt lgkmcnt(0)" ::: "memory"); FA_SBAR(); pv_mfma(o[3], lb, hb, pa0, pa1, pa2, pa3);
}
__device__ __forceinline__ void partialSM(f32x16& p0, f32x16& p1, float& m_reg, float& alpha) {
    float pmax = p0[0];
#pragma unroll
    for (int r = 1; r < 16; ++r) pmax = fmaxf(pmax, p0[r]);
#pragma unroll
    for (int r = 0; r < 16; ++r) pmax = fmaxf(pmax, p1[r]);
    { auto rr = __builtin_amdgcn_permlane32_swap(__float_as_uint(pmax), __float_as_uint(pmax), false, false); pmax = fmaxf(__uint_as_float(rr[0]), __uint_as_float(rr[1])); }
    float mn;
    if (__builtin_expect(__all(pmax - m_reg <= THR), 1)) { mn = m_reg; alpha = 1.f; }
    else { mn = fmaxf(m_reg, pmax); alpha = __builtin_amdgcn_exp2f(m_reg - mn); m_reg = mn; }
#pragma unroll
    for (int r = 0; r < 16; ++r) { p0[r] -= mn; p1[r] -= mn; }
#pragma unroll
    for (int r = 0; r < 16; ++r) p0[r] = __builtin_amdgcn_exp2f(p0[r]);
}
__device__ __forceinline__ void finishSM(f32x16& p0, f32x16& p1, float alpha, float& l_reg, bf16x8& pa0, bf16x8& pa1, bf16x8& pa2, bf16x8& pa3) {
#pragma unroll
    for (int r = 0; r < 16; ++r) p1[r] = __builtin_amdgcn_exp2f(p1[r]);
    float ps = 0;
#pragma unroll
    for (int r = 0; r < 16; ++r) ps += p0[r];
#pragma unroll
    for (int r = 0; r < 16; ++r) ps += p1[r];
    { auto rr = __builtin_amdgcn_permlane32_swap(__float_as_uint(ps), __float_as_uint(ps), false, false); ps = __uint_as_float(rr[0]) + __uint_as_float(rr[1]); }
    l_reg = l_reg * alpha + ps;
#define FA_PK4(P, BASE, OUT) do { unsigned a0 = cvtpk(P[BASE + 0], P[BASE + 1]), a1 = cvtpk(P[BASE + 2], P[BASE + 3]);   \
    unsigned b0 = cvtpk(P[BASE + 4], P[BASE + 5]), b1 = cvtpk(P[BASE + 6], P[BASE + 7]);                              \
    auto r0 = __builtin_amdgcn_permlane32_swap(a0, b0, false, false); auto r1 = __builtin_amdgcn_permlane32_swap(a1, b1, false, false); \
    u32x4_t w = {r0[0], r1[0], r0[1], r1[1]}; OUT = __builtin_bit_cast(bf16x8, w); } while (0)
    typedef unsigned u32x4_t __attribute__((ext_vector_type(4)));
    FA_PK4(p0, 0, pa0); FA_PK4(p0, 8, pa1); FA_PK4(p1, 0, pa2); FA_PK4(p1, 8, pa3);
#undef FA_PK4
}
template <bool ALIBI> __device__ __forceinline__ void fr_init(f32x16& p0, f32x16& p1, const LAS float* posl, float posq, float slope2, bool linear, int hi) {
    if (linear) {
        const float cl = -slope2 * posq;
#pragma unroll
        for (int g = 0; g < 4; ++g) { const f32x4 k0 = *(const LAS f32x4*)(posl + 8 * g + 4 * hi), k1 = *(const LAS f32x4*)(posl + 32 + 8 * g + 4 * hi);
#pragma unroll
            for (int e = 0; e < 4; ++e) { p0[4 * g + e] = fmaf(slope2, k0[e], cl); p1[4 * g + e] = fmaf(slope2, k1[e], cl); } }
    } else {
#pragma unroll
        for (int g = 0; g < 4; ++g) { const f32x4 k0 = *(const LAS f32x4*)(posl + 8 * g + 4 * hi), k1 = *(const LAS f32x4*)(posl + 32 + 8 * g + 4 * hi);
#pragma unroll
            for (int e = 0; e < 4; ++e) { p0[4 * g + e] = -slope2 * fabsf(posq - k0[e]); p1[4 * g + e] = -slope2 * fabsf(posq - k1[e]); } }
    }
}
__device__ __forceinline__ void fr_softmax(f32x16& p0, f32x16& p1, float& l_reg, bf16x8& pa0, bf16x8& pa1, bf16x8& pa2, bf16x8& pa3) {
#pragma unroll
    for (int r = 0; r < 16; ++r) { p0[r] = __builtin_amdgcn_exp2f(p0[r]); p1[r] = __builtin_amdgcn_exp2f(p1[r]); }
    float sa = 0.f, sb = 0.f;
#pragma unroll
    for (int r = 0; r < 16; ++r) { sa += p0[r]; sb += p1[r]; }
    l_reg += sa + sb;
    typedef unsigned u32x4_t __attribute__((ext_vector_type(4)));
#define FA_PKS(P, BASE, OUT) do { u32x4_t w = {cvtpk(P[BASE + 0], P[BASE + 1]), cvtpk(P[BASE + 2], P[BASE + 3]), cvtpk(P[BASE + 4], P[BASE + 5]), cvtpk(P[BASE + 6], P[BASE + 7])}; OUT = __builtin_bit_cast(bf16x8, w); } while (0)
    FA_PKS(p0, 0, pa0); FA_PKS(p0, 8, pa1); FA_PKS(p1, 0, pa2); FA_PKS(p1, 8, pa3);
#undef FA_PKS
}
template <int DQK> struct Lds {
    static constexpr int SHM_K = KVBLK * DQK * 2;
    static constexpr int V_OFF = 0, K_OFF = 2 * SHM_V, POS_OFF = K_OFF + 2 * SHM_K, WS_OFF = POS_OFF + 2 * 256, END = WS_OFF + 8 * 256;
};
template <int DQK, bool INIT = true> __device__ __forceinline__ void qkt(f32x16& p0, f32x16& p1, const LAS unsigned char* Ks, const bf16x8* qr, int r32, int hi) {
    if (INIT) { p0 = f32x16{}; p1 = f32x16{}; }
#pragma unroll
    for (int d0 = 0; d0 < DQK / 16; ++d0) { const int cb = (d0 * 16 + hi * 8) * 2;
        const bf16x8 b0 = *(const LAS bf16x8*)(Ks + kswz(r32, cb));
        const bf16x8 b1 = *(const LAS bf16x8*)(Ks + kswz(32 + r32, cb));
        p0 = __builtin_amdgcn_mfma_f32_32x32x16_bf16(b0, qr[d0], p0, 0, 0, 0);
        p1 = __builtin_amdgcn_mfma_f32_32x32x16_bf16(b1, qr[d0], p1, 0, 0, 0);
        if (DQK > 64 && (d0 & 3) == 3) FA_SBAR(); }
}
template <int OFF> __device__ __forceinline__ bf16x8 k_read(int addr) { bf16x8 r; asm volatile("ds_read_b128 %0, %1 offset:%2" : "=&v"(r) : "v"(addr), "i"(OFF) : "memory"); return r; }
__device__ __forceinline__ void k_bases(int (&ka)[4], const LAS unsigned char* K_lds, int r32, int hi) {
#pragma unroll
    for (int j = 0; j < 4; ++j) ka[j] = (int)(uintptr_t)K_lds + r32 * 128 + ((j * 32 + hi * 16) ^ (((r32 >> 1) & 7) << 4));
}
#define FA_LGK(n) asm volatile("s_waitcnt lgkmcnt(" #n ")" ::: "memory")
template <int DQK, int BOFF, int VAR = 0> __device__ __forceinline__ void qkt_pipe(f32x16& p0, f32x16& p1, const int (&ka)[4], const bf16x8* qr) {
    if constexpr (DQK == 64) {
        bf16x8 a0 = k_read<BOFF>(ka[0]), b0 = k_read<BOFF + 4096>(ka[0]), a1 = k_read<BOFF>(ka[1]), b1 = k_read<BOFF + 4096>(ka[1]);
        bf16x8 a2 = k_read<BOFF>(ka[2]), b2 = k_read<BOFF + 4096>(ka[2]), a3 = k_read<BOFF>(ka[3]), b3 = k_read<BOFF + 4096>(ka[3]);
        FA_LGK(6); FA_SBAR(); p0 = __builtin_amdgcn_mfma_f32_32x32x16_bf16(a0, qr[0], p0, 0, 0, 0); p1 = __builtin_amdgcn_mfma_f32_32x32x16_bf16(b0, qr[0], p1, 0, 0, 0); FA_SBAR();
        FA_LGK(4); FA_SBAR(); p0 = __builtin_amdgcn_mfma_f32_32x32x16_bf16(a1, qr[1], p0, 0, 0, 0); p1 = __builtin_amdgcn_mfma_f32_32x32x16_bf16(b1, qr[1], p1, 0, 0, 0); FA_SBAR();
        FA_LGK(2); FA_SBAR(); p0 = __builtin_amdgcn_mfma_f32_32x32x16_bf16(a2, qr[2], p0, 0, 0, 0); p1 = __builtin_amdgcn_mfma_f32_32x32x16_bf16(b2, qr[2], p1, 0, 0, 0); FA_SBAR();
        FA_LGK(0); FA_SBAR(); p0 = __builtin_amdgcn_mfma_f32_32x32x16_bf16(a3, qr[3], p0, 0, 0, 0); p1 = __builtin_amdgcn_mfma_f32_32x32x16_bf16(b3, qr[3], p1, 0, 0, 0); FA_SBAR();
    } else {
        static_assert(DQK == 192, "qkt_pipe: d = 64 or 192");
#define FA_KG(G, x0, y0, x1, y1) do { x0 = k_read<BOFF + ((2 * (G)) >> 2) * 8192>(ka[(2 * (G)) & 3]); y0 = k_read<BOFF + ((2 * (G)) >> 2) * 8192 + 4096>(ka[(2 * (G)) & 3]); \
        x1 = k_read<BOFF + ((2 * (G) + 1) >> 2) * 8192>(ka[(2 * (G) + 1) & 3]); y1 = k_read<BOFF + ((2 * (G) + 1) >> 2) * 8192 + 4096>(ka[(2 * (G) + 1) & 3]); } while (0)
#define FA_KM(G, x0, y0, x1, y1) do { FA_SBAR(); if (VAR == 6) { p0 = __builtin_amdgcn_mfma_f32_32x32x16_bf16(x0 ^ y0 ^ x1 ^ y1, qr[2 * (G)], p0, 0, 0, 0); } else { \
        p0 = __builtin_amdgcn_mfma_f32_32x32x16_bf16(x0, qr[2 * (G)], p0, 0, 0, 0); p1 = __builtin_amdgcn_mfma_f32_32x32x16_bf16(y0, qr[2 * (G)], p1, 0, 0, 0); \
        p0 = __builtin_amdgcn_mfma_f32_32x32x16_bf16(x1, qr[2 * (G) + 1], p0, 0, 0, 0); p1 = __builtin_amdgcn_mfma_f32_32x32x16_bf16(y1, qr[2 * (G) + 1], p1, 0, 0, 0); } FA_SBAR(); } while (0)
        bf16x8 a0, b0, a1, b1, c0, d0, c1, d1;
        if constexpr (VAR == 5) {
#pragma unroll
            for (int g = 0; g < 12; ++g) { FA_SBAR(); p0 = __builtin_amdgcn_mfma_f32_32x32x16_bf16(qr[(g + 1) % 12], qr[g], p0, 0, 0, 0); p1 = __builtin_amdgcn_mfma_f32_32x32x16_bf16(qr[(g + 5) % 12], qr[g], p1, 0, 0, 0); FA_SBAR(); }
            return; }
        FA_KG(0, a0, b0, a1, b1); FA_KG(1, c0, d0, c1, d1);
        FA_LGK(4); FA_KM(0, a0, b0, a1, b1); FA_KG(2, a0, b0, a1, b1);
        FA_LGK(4); FA_KM(1, c0, d0, c1, d1); FA_KG(3, c0, d0, c1, d1);
        FA_LGK(4); FA_KM(2, a0, b0, a1, b1); FA_KG(4, a0, b0, a1, b1);
        FA_LGK(4); FA_KM(3, c0, d0, c1, d1); FA_KG(5, c0, d0, c1, d1);
        FA_LGK(4); FA_KM(4, a0, b0, a1, b1);
        FA_LGK(0); FA_KM(5, c0, d0, c1, d1);
#undef FA_KG
#undef FA_KM
    }
}
template <bool ALIBI> __device__ __forceinline__ void fixup(f32x16& p0, f32x16& p1, const LAS float* posl, float posq, float slope2, bool masked, int hi) {
    if (ALIBI) {
#pragma unroll
        for (int g = 0; g < 4; ++g) { const f32x4 k0 = *(const LAS f32x4*)(posl + 8 * g + 4 * hi), k1 = *(const LAS f32x4*)(posl + 32 + 8 * g + 4 * hi);
#pragma unroll
            for (int e = 0; e < 4; ++e) { p0[4 * g + e] = fmaf(-slope2, fabsf(posq - k0[e]), p0[4 * g + e]); p1[4 * g + e] = fmaf(-slope2, fabsf(posq - k1[e]), p1[4 * g + e]); } }
    }
    if (masked) {
#pragma unroll
        for (int r = 0; r < 16; ++r) { p0[r] = -INFINITY; p1[r] = -INFINITY; }
    }
}
template <int DQK, bool ALIBI, int NSLOT, int MODE = 0, int VAR = 0>
__device__ __forceinline__ void attn_pass(const bf16* __restrict__ Qb, const bf16* __restrict__ Kh, const bf16* __restrict__ Vh, const int* __restrict__ posb, float slope2, float cref, int TL, int q0, int T0, int NT,
                                          LAS unsigned char* lds, int tid_, f32x16 (&o)[4], float& l_out) {
    typedef Lds<DQK> L; constexpr int KSUB = DQK / 64, SHM_K = L::SHM_K;
    const int wid = __builtin_amdgcn_readfirstlane(tid_ >> 6); int lane; asm volatile("v_mbcnt_lo_u32_b32 %0, -1, 0\n\tv_mbcnt_hi_u32_b32 %0, -1, %0" : "=v"(lane));
    const int tid = wid * 64 + lane, r32 = lane & 31, hi = lane >> 5;
    if (wid >= 4) __builtin_amdgcn_s_setprio(1);
    LAS unsigned char* V_lds = lds + L::V_OFF; LAS unsigned char* K_lds = lds + L::K_OFF; LAS float* P_lds = (LAS float*)(lds + L::POS_OFF);
    LAS float* al_l = (LAS float*)(lds + L::WS_OFF) + wid * 64;
    float m_reg = -1e30f, l_reg = 0.f;
#pragma unroll
    for (int d = 0; d < 4; ++d) o[d] = f32x16{};
    bf16x8 qr[DQK / 16];
    { const bf16* Qw = Qb + (size_t)(wid * QBLK) * DQK; unsigned qgo = (unsigned)(r32 * DQK + hi * 8) * 2u; asm volatile("" : "+v"(qgo));
#pragma unroll
      for (int d0 = 0; d0 < DQK / 16; ++d0) qr[d0] = ldg<bf16x8>(Qw + d0 * 16, qgo); }
    const float posq = ALIBI ? (float)posb[q0 + wid * QBLK + r32] : 0.f;
    const int tmax = NT - 4 + (wid >> 1);
    const int sr = tid >> 4, sc = (tid & 15) * 8, vst0 = MODE == 5 ? v_st_nat(sr, sc) : v_st(sr, sc), vst1 = MODE == 5 ? v_st_nat(32 + sr, sc) : v_st(32 + sr, sc);
    const int kr = tid >> 3, kc = (tid & 7) * 8, kst = kswz(kr, kc * 2);
    unsigned vgo = (unsigned)(sr * DV + sc) * 2u, kgo = (unsigned)(kr * DQK + kc) * 2u, pgo = (unsigned)(tid & 63) * 4u; asm volatile("" : "+v"(vgo), "+v"(kgo), "+v"(pgo));
    const int vb0 = (int)(uintptr_t)V_lds + v_rd_base(lane);
    int ka[4]; k_bases(ka, K_lds, r32, hi);
    struct Slot { bf16x8 vs0, vs1, ks[KSUB]; int ps; } sl_[NSLOT];
#define FA_SLOAD(i, k0) do { unsigned kk_ = (unsigned)__builtin_amdgcn_readfirstlane((int)(k0)); asm volatile("" : "+s"(kk_));     \
    const bf16* Vt_ = Vh + (size_t)kk_ * DV; const bf16* Kt_ = Kh + (size_t)kk_ * DQK; \
    sl_[i].vs0 = ldg<bf16x8>(Vt_, vgo); sl_[i].vs1 = ldg<bf16x8>(Vt_ + 32 * DV, vgo); \
    _Pragma("unroll") for (int s_ = 0; s_ < KSUB; ++s_) sl_[i].ks[s_] = ldg<bf16x8>(Kt_ + s_ * 64, kgo); \
    if (ALIBI) sl_[i].ps = ldg<int>(posb + kk_, pgo); } while (0)
#define FA_SWRITE(b, i) do { *(LAS bf16x8*)(V_lds + (b) * SHM_V + vst0) = sl_[i].vs0; *(LAS bf16x8*)(V_lds + (b) * SHM_V + vst1) = sl_[i].vs1; \
    _Pragma("unroll") for (int s_ = 0; s_ < KSUB; ++s_) *(LAS bf16x8*)(K_lds + (b) * SHM_K + s_ * 8192 + kst) = sl_[i].ks[s_]; \
    if (ALIBI) { if (tid < 64) P_lds[(b) * 64 + tid] = (float)sl_[i].ps; } } while (0)
#define FA_RESC(a) do { if (__any((a) < 1.f)) { if (hi == 0) al_l[r32] = (a); asm volatile("s_waitcnt lgkmcnt(0)" ::: "memory"); \
    _Pragma("unroll") for (int d = 0; d < 4; ++d) _Pragma("unroll") for (int r = 0; r < 16; ++r) o[d][r] *= al_l[crow(r, hi)]; } } while (0)
#define FA_COMPUTE(b, t, STAGE) do { bf16x8 pa0, pa1, pa2, pa3; const bool vis_ = (t) <= tmax;     \
    if (vis_) { f32x16 p0, p1; \
    if (MODE == 5) { if (VAR == 3) { p0 = f32x16{}; p1 = f32x16{}; _Pragma("unroll") for (int r_ = 0; r_ < 16; ++r_) { p0[r_] = l_reg; p1[r_] = l_reg; } } \
        else if ((DQK == 192 && PIPE_MLA) || (DQK == 64 && PIPE_OLD64)) { p0 = f32x16{}; p1 = f32x16{}; qkt_pipe<DQK, (b) * SHM_K, (VAR == 5 || VAR == 6) ? VAR : 0>(p0, p1, ka, qr); } else qkt<DQK, true>(p0, p1, K_lds + (b) * SHM_K, qr, r32, hi); fixup<ALIBI>(p0, p1, P_lds + (b) * 64, posq, slope2, false, hi); \
        if (VAR == 1) { l_reg += p0[0] + p1[5]; typedef unsigned u32x4_t __attribute__((ext_vector_type(4))); \
            u32x4_t w0_ = {cvtpk(p0[0], p0[1]), cvtpk(p0[2], p0[3]), cvtpk(p0[4], p0[5]), cvtpk(p0[6], p0[7])}, w1_ = {cvtpk(p0[8], p0[9]), cvtpk(p0[10], p0[11]), cvtpk(p0[12], p0[13]), cvtpk(p0[14], p0[15])}; \
            u32x4_t w2_ = {cvtpk(p1[0], p1[1]), cvtpk(p1[2], p1[3]), cvtpk(p1[4], p1[5]), cvtpk(p1[6], p1[7])}, w3_ = {cvtpk(p1[8], p1[9]), cvtpk(p1[10], p1[11]), cvtpk(p1[12], p1[13]), cvtpk(p1[14], p1[15])}; \
            pa0 = __builtin_bit_cast(bf16x8, w0_); pa1 = __builtin_bit_cast(bf16x8, w1_); pa2 = __builtin_bit_cast(bf16x8, w2_); pa3 = __builtin_bit_cast(bf16x8, w3_); } \
        else fr_softmax(p0, p1, l_reg, pa0, pa1, pa2, pa3); } \
    else { float alpha; qkt<DQK>(p0, p1, K_lds + (b) * SHM_K, qr, r32, hi); fixup<ALIBI>(p0, p1, P_lds + (b) * 64, posq, slope2, false, hi); \
        partialSM(p0, p1, m_reg, alpha); finishSM(p0, p1, alpha, l_reg, pa0, pa1, pa2, pa3); FA_RESC(alpha); } } \
    FA_SBAR(); STAGE; FA_SBAR();     \
    if (vis_) { \
    if (VAR == 2) { l_reg += __builtin_bit_cast(float, pa0[0] | (pa1[1] << 16)) + __builtin_bit_cast(float, pa2[0] | (pa3[1] << 16)); } else \
    if (MODE == 5 && DQK == 64) pv_d0_pipe(o, vb0 + (b) * SHM_V, pa0, pa1, pa2, pa3); else pv_d0(o, vb0 + (b) * SHM_V, pa0, pa1, pa2, pa3); } } while (0)
    constexpr int S1 = NSLOT - 1;
    FA_SLOAD(0, T0 * KVBLK); FA_SWRITE(0, 0); FA_SLOAD(S1, (T0 + 1) * KVBLK); FA_SWRITE(1, S1); FA_SLOAD(0, (T0 + 2) * KVBLK);
    if (NSLOT == 2) FA_SLOAD(1, (T0 + 3) * KVBLK);
    __syncthreads();
    static_assert(NSLOT == 1, "attn_pass: one staging slot");
    for (int j = T0; j < NT; j += 2) {
        FA_COMPUTE(0, j, { if (VAR != 4) if (j > T0) { FA_SWRITE(1, 0); if (j + 2 < NT) FA_SLOAD(0, (j + 2) * KVBLK); } });
        __syncthreads();
        FA_COMPUTE(1, j + 1, { if (VAR != 4) if (j + 2 < NT) { FA_SWRITE(0, 0); FA_SLOAD(0, (j + 3) * KVBLK); } });
        __syncthreads();
    }
    if (MODE == 5) { auto rr = __builtin_amdgcn_permlane32_swap(__float_as_uint(l_reg), __float_as_uint(l_reg), false, false); l_reg = __uint_as_float(rr[0]) + __uint_as_float(rr[1]); }
    __builtin_amdgcn_s_setprio(0);
    l_out = l_reg;
#undef FA_SLOAD
#undef FA_SWRITE
#undef FA_RESC
#undef FA_COMPUTE
}
template <int DQK> struct Lds3 {
    static constexpr int SHM_K = KVBLK * DQK * 2;
    static constexpr int V_OFF = 0, K_OFF = 3 * SHM_V, POS_OFF = K_OFF + 3 * SHM_K, WS_OFF = POS_OFF + 3 * 256, END = WS_OFF + 8 * 256;
};
template <int DQK, bool ALIBI>
__device__ __forceinline__ void attn_pass_stag(const bf16* __restrict__ Qb, const bf16* __restrict__ Kh, const bf16* __restrict__ Vh, const int* __restrict__ posb, float slope2, int q0, int T0, int NT,
                                               LAS unsigned char* lds, int tid, f32x16 (&o)[4], float& l_out) {
    typedef Lds3<DQK> L; constexpr int KSUB = DQK / 64, SHM_K = L::SHM_K;
    const int wid = __builtin_amdgcn_readfirstlane(tid >> 6), lane = tid & 63, r32 = lane & 31, hi = lane >> 5, grp = wid >> 2;
    LAS unsigned char* V_lds = lds + L::V_OFF; LAS unsigned char* K_lds = lds + L::K_OFF; LAS float* P_lds = (LAS float*)(lds + L::POS_OFF);
    float l_reg = 0.f;
#pragma unroll
    for (int d = 0; d < 4; ++d) o[d] = f32x16{};
    bf16x8 qr[DQK / 16];
    { const bf16* Qw = Qb + (size_t)(wid * QBLK) * DQK; unsigned qgo = (unsigned)(r32 * DQK + hi * 8) * 2u; asm volatile("" : "+v"(qgo));
#pragma unroll
      for (int d0 = 0; d0 < DQK / 16; ++d0) qr[d0] = ldg<bf16x8>(Qw + d0 * 16, qgo); }
    const float posq = ALIBI ? (float)posb[q0 + wid * QBLK + r32] : 0.f;
    const int tmax = NT - 4 + (wid >> 1);
    const int sr = tid >> 4, sc = (tid & 15) * 8, vst0 = v_st(sr, sc), vst1 = v_st(32 + sr, sc);
    const int kr = tid >> 3, kc = (tid & 7) * 8, kst = kswz(kr, kc * 2);
    unsigned vgo = (unsigned)(sr * DV + sc) * 2u, kgo = (unsigned)(kr * DQK + kc) * 2u, pgo = (unsigned)(tid & 63) * 4u; asm volatile("" : "+v"(vgo), "+v"(kgo), "+v"(pgo));
    const int vb0 = (int)(uintptr_t)V_lds + v_rd_base(lane);
    struct Slot { bf16x8 vs0, vs1, ks[KSUB]; int ps; } sl_;
#define FS_SLOAD(k0) do { unsigned kk_ = (unsigned)__builtin_amdgcn_readfirstlane((int)(k0)); asm volatile("" : "+s"(kk_)); \
    const bf16* Vt_ = Vh + (size_t)kk_ * DV; const bf16* Kt_ = Kh + (size_t)kk_ * DQK; \
    sl_.vs0 = ldg<bf16x8>(Vt_, vgo); sl_.vs1 = ldg<bf16x8>(Vt_ + 32 * DV, vgo); \
    _Pragma("unroll") for (int s_ = 0; s_ < KSUB; ++s_) sl_.ks[s_] = ldg<bf16x8>(Kt_ + s_ * 64, kgo); \
    if (ALIBI) sl_.ps = ldg<int>(posb + kk_, pgo); } while (0)
#define FS_SWRITE(b) do { *(LAS bf16x8*)(V_lds + (b) * SHM_V + vst0) = sl_.vs0; *(LAS bf16x8*)(V_lds + (b) * SHM_V + vst1) = sl_.vs1; \
    _Pragma("unroll") for (int s_ = 0; s_ < KSUB; ++s_) *(LAS bf16x8*)(K_lds + (b) * SHM_K + s_ * 8192 + kst) = sl_.ks[s_]; \
    if (ALIBI) { if (tid < 64) P_lds[(b) * 64 + tid] = (float)sl_.ps; } } while (0)
    const int nt = NT - T0;
    FS_SLOAD(T0 * KVBLK); FS_SWRITE(0); FS_SLOAD((T0 + 1) * KVBLK); FS_SWRITE(1); FS_SLOAD((T0 + 2) * KVBLK);
    __syncthreads();
#define FS_QKS(j_) do { int b_ = (j_) % 3; asm volatile("" : "+s"(b_)); f32x16 p0, p1; \
    qkt<DQK, true>(p0, p1, K_lds + b_ * SHM_K, qr, r32, hi); fixup<ALIBI>(p0, p1, P_lds + b_ * 64, posq, slope2, T0 + (j_) > tmax, hi); \
    fr_softmax(p0, p1, l_reg, pa0, pa1, pa2, pa3); } while (0)
#define FS_PV(j_) do { int b_ = (j_) % 3; asm volatile("" : "+s"(b_)); pv_d0(o, vb0 + b_ * SHM_V, pa0, pa1, pa2, pa3); } while (0)
#define FS_STAGE(j_) do { const int jn_ = (j_) + 2; if (jn_ < nt) { int bw_ = jn_ % 3; asm volatile("" : "+s"(bw_)); FS_SWRITE(bw_); if (jn_ + 1 < nt) FS_SLOAD((T0 + jn_ + 1) * KVBLK); } } while (0)
    bf16x8 pa0, pa1, pa2, pa3;
    if (grp == 0) {
        for (int j = 0; j < nt; ++j) { FS_QKS(j); __syncthreads(); FS_PV(j); __syncthreads(); FS_STAGE(j); }
        __syncthreads();
    } else {
        pa0 = bf16x8{}; pa1 = bf16x8{}; pa2 = bf16x8{}; pa3 = bf16x8{};
        for (int j = 0; j < nt; ++j) { if (j > 0) FS_PV(j - 1); __syncthreads(); FS_QKS(j); __syncthreads(); FS_STAGE(j); }
        FS_PV(nt - 1); __syncthreads();
    }
#undef FS_QKS
#undef FS_PV
#undef FS_STAGE
    { auto rr = __builtin_amdgcn_permlane32_swap(__float_as_uint(l_reg), __float_as_uint(l_reg), false, false); l_reg = __uint_as_float(rr[0]) + __uint_as_float(rr[1]); }
    l_out = l_reg;
#undef FS_SLOAD
#undef FS_SWRITE
}
template <int DQK, bool ALIBI>
__device__ __forceinline__ void attn_pass_p2(const bf16* __restrict__ Qb, const bf16* __restrict__ Kh, const bf16* __restrict__ Vh, const int* __restrict__ posb, float slope2, int q0, int T0, int NT,
                                             LAS unsigned char* lds, int tid, f32x16 (&o)[4], float& l_out) {
    typedef Lds<DQK> L; constexpr int KSUB = DQK / 64, SHM_K = L::SHM_K;
    const int wid = __builtin_amdgcn_readfirstlane(tid >> 6), lane = tid & 63, r32 = lane & 31, hi = lane >> 5;
    LAS unsigned char* V_lds = lds + L::V_OFF; LAS unsigned char* K_lds = lds + L::K_OFF; LAS float* P_lds = (LAS float*)(lds + L::POS_OFF);
    float l_reg = 0.f;
#pragma unroll
    for (int d = 0; d < 4; ++d) o[d] = f32x16{};
    bf16x8 qr[DQK / 16];
    { const bf16* Qw = Qb + (size_t)(wid * QBLK) * DQK; unsigned qgo = (unsigned)(r32 * DQK + hi * 8) * 2u; asm volatile("" : "+v"(qgo));
#pragma unroll
      for (int d0 = 0; d0 < DQK / 16; ++d0) qr[d0] = ldg<bf16x8>(Qw + d0 * 16, qgo); }
    const float posq = ALIBI ? (float)posb[q0 + wid * QBLK + r32] : 0.f;
    const int tmax = NT - 4 + (wid >> 1);
    const int sr = tid >> 4, sc = (tid & 15) * 8, vst0 = v_st(sr, sc), vst1 = v_st(32 + sr, sc);
    const int kr = tid >> 3, kc = (tid & 7) * 8, kst = kswz(kr, kc * 2);
    unsigned vgo = (unsigned)(sr * DV + sc) * 2u, kgo = (unsigned)(kr * DQK + kc) * 2u, pgo = (unsigned)(tid & 63) * 4u; asm volatile("" : "+v"(vgo), "+v"(kgo), "+v"(pgo));
    const int vb0 = (int)(uintptr_t)V_lds + v_rd_base(lane);
    struct Slot { bf16x8 vs0, vs1, ks[KSUB]; int ps; } sl_;
#define FP_LOADK(t) do { unsigned kk_ = (unsigned)__builtin_amdgcn_readfirstlane((int)((t) * KVBLK)); asm volatile("" : "+s"(kk_)); const bf16* Kt_ = Kh + (size_t)kk_ * DQK; \
    _Pragma("unroll") for (int s_ = 0; s_ < KSUB; ++s_) sl_.ks[s_] = ldg<bf16x8>(Kt_ + s_ * 64, kgo); if (ALIBI) sl_.ps = ldg<int>(posb + kk_, pgo); } while (0)
#define FP_LOADV(t) do { unsigned kk_ = (unsigned)__builtin_amdgcn_readfirstlane((int)((t) * KVBLK)); asm volatile("" : "+s"(kk_)); const bf16* Vt_ = Vh + (size_t)kk_ * DV; \
    sl_.vs0 = ldg<bf16x8>(Vt_, vgo); sl_.vs1 = ldg<bf16x8>(Vt_ + 32 * DV, vgo); } while (0)
#define FP_WRITEK(b) do { _Pragma("unroll") for (int s_ = 0; s_ < KSUB; ++s_) *(LAS bf16x8*)(K_lds + (b) * SHM_K + s_ * 8192 + kst) = sl_.ks[s_]; \
    if (ALIBI) { if (tid < 64) P_lds[(b) * 64 + tid] = (float)sl_.ps; } } while (0)
#define FP_WRITEV(b) do { *(LAS bf16x8*)(V_lds + (b) * SHM_V + vst0) = sl_.vs0; *(LAS bf16x8*)(V_lds + (b) * SHM_V + vst1) = sl_.vs1; } while (0)
#define FP_QK(P0, P1, b, t) do { qkt<DQK, true>(P0, P1, K_lds + (b) * SHM_K, qr, r32, hi); fixup<ALIBI>(P0, P1, P_lds + (b) * 64, posq, slope2, (t) > tmax, hi); } while (0)
    f32x16 pA0, pA1, pB0, pB1; bf16x8 pa0, pa1, pa2, pa3;
    const int nt = NT - T0;
    FP_LOADK(T0); FP_LOADV(T0); FP_WRITEK(0); FP_WRITEV(0); FP_LOADK(T0 + 1); FP_WRITEK(1); FP_LOADK(T0 + 2); FP_LOADV(T0 + 1);
    __syncthreads();
    FP_QK(pA0, pA1, 0, T0);
    __syncthreads();
    for (int r = 0; r < nt; r += 2) {
        if (r + 2 < nt) FP_WRITEK(0);
        FP_WRITEV(1);
        if (r + 3 < nt) FP_LOADK(T0 + r + 3);
        if (r + 2 < nt) FP_LOADV(T0 + r + 2);
        FA_SBAR(); FP_QK(pB0, pB1, 1, T0 + r + 1);
        fr_softmax(pA0, pA1, l_reg, pa0, pa1, pa2, pa3); FA_SBAR();
        pv_d0(o, vb0, pa0, pa1, pa2, pa3);
        __syncthreads();
        if (r + 3 < nt) FP_WRITEK(1);
        if (r + 2 < nt) FP_WRITEV(0);
        if (r + 4 < nt) FP_LOADK(T0 + r + 4);
        if (r + 3 < nt) FP_LOADV(T0 + r + 3);
        FA_SBAR(); if (r + 2 < nt) FP_QK(pA0, pA1, 0, T0 + r + 2);
        fr_softmax(pB0, pB1, l_reg, pa0, pa1, pa2, pa3); FA_SBAR();
        pv_d0(o, vb0 + SHM_V, pa0, pa1, pa2, pa3);
        __syncthreads();
    }
    { auto rr = __builtin_amdgcn_permlane32_swap(__float_as_uint(l_reg), __float_as_uint(l_reg), false, false); l_reg = __uint_as_float(rr[0]) + __uint_as_float(rr[1]); }
    l_out = l_reg;
#undef FP_LOADK
#undef FP_LOADV
#undef FP_WRITEK
#undef FP_WRITEV
#undef FP_QK
}
template <int DQK, bool ALIBI>
__device__ __forceinline__ void attn_pass_dma(const bf16* __restrict__ Qb, const bf16* __restrict__ Kh, const bf16* __restrict__ Vh, const int* __restrict__ posb, const float* __restrict__ posfb,
                                              float slope2, int q0, int T0, int NT, LAS unsigned char* lds, int tid_, f32x16 (&o)[4], float& l_out) {
    typedef Lds3<DQK> L; constexpr int KSUB = DQK / 64, SHM_K = L::SHM_K, NPT = KSUB + 2 + (ALIBI ? 1 : 0);
    const int wid = __builtin_amdgcn_readfirstlane(tid_ >> 6); int lane; asm volatile("v_mbcnt_lo_u32_b32 %0, -1, 0\n\tv_mbcnt_hi_u32_b32 %0, -1, %0" : "=v"(lane));
    const int r32 = lane & 31, hi = lane >> 5;
    LAS unsigned char* V_lds = lds + L::V_OFF; LAS unsigned char* K_lds = lds + L::K_OFF; LAS float* P_lds = (LAS float*)(lds + L::POS_OFF);
    float l_reg = 0.f;
#pragma unroll
    for (int d = 0; d < 4; ++d) o[d] = f32x16{};
    bf16x8 qr[DQK / 16];
    { const bf16* Qw = Qb + (size_t)(wid * QBLK) * DQK; unsigned qgo = (unsigned)(r32 * DQK + hi * 8) * 2u; asm volatile("" : "+v"(qgo));
#pragma unroll
      for (int d0 = 0; d0 < DQK / 16; ++d0) qr[d0] = ldg<bf16x8>(Qw + d0 * 16, qgo); }
    const float posq = ALIBI ? (float)posb[q0 + wid * QBLK + r32] : 0.f;
    const int tmax = NT - 4 + (wid >> 1);
    unsigned ksrc, vsrc, psrc;
    { const int kr = 8 * wid + (lane >> 3), kc = (lane & 7) ^ ((kr >> 1) & 7); ksrc = (unsigned)(kr * DQK + kc * 8) * 2u;
      const int vk = 8 * wid + ((lane & 31) >> 2), vc = (lane >> 5) * 32 + (lane & 3) * 8; vsrc = (unsigned)(vk * DV + vc) * 2u; psrc = (unsigned)lane * 4u;
      asm volatile("" : "+v"(ksrc), "+v"(vsrc), "+v"(psrc)); }
    const int vb0 = (int)(uintptr_t)V_lds + v_rd_base(lane);
#define FD_DMA(t, slot) do { unsigned kk_ = (unsigned)__builtin_amdgcn_readfirstlane((int)((t) * KVBLK)); asm volatile("" : "+s"(kk_)); const int sl_ = (slot); \
    const char* Kt_ = (const char*)(Kh + (size_t)kk_ * DQK); const char* Vt_ = (const char*)(Vh + (size_t)kk_ * DV); \
    _Pragma("unroll") for (int s_ = 0; s_ < KSUB; ++s_) __builtin_amdgcn_global_load_lds((const unsigned*)(Kt_ + s_ * 128 + ksrc), (LAS unsigned*)(K_lds + sl_ * SHM_K + s_ * 8192 + wid * 1024), 16, 0, 0); \
    _Pragma("unroll") for (int q_ = 0; q_ < 2; ++q_) __builtin_amdgcn_global_load_lds((const unsigned*)(Vt_ + q_ * 128 + vsrc), (LAS unsigned*)(V_lds + sl_ * SHM_V + (2 * wid + q_) * 1024), 16, 0, 0); \
    if (ALIBI) __builtin_amdgcn_global_load_lds((const unsigned*)((const char*)(posfb + kk_) + psrc), (LAS unsigned*)(P_lds + sl_ * 64), 4, 0, 0); } while (0)
    const int nt = NT - T0;
    FD_DMA(T0, 0); FD_DMA(T0 + 1, 1);
    asm volatile("s_waitcnt vmcnt(0) lgkmcnt(0)\n\ts_barrier" ::: "memory");
    int slot = 0;
    for (int j = 0; j < nt; ++j) {
        int b = slot; asm volatile("" : "+s"(b));
        if (j + 2 < nt) { int bn = b + 2; bn = bn >= 3 ? bn - 3 : bn; FD_DMA(T0 + j + 2, bn); }
        { f32x16 p0, p1; bf16x8 pa0, pa1, pa2, pa3;
          qkt<DQK, true>(p0, p1, K_lds + b * SHM_K, qr, r32, hi); fixup<ALIBI>(p0, p1, P_lds + b * 64, posq, slope2, T0 + j > tmax, hi);
          fr_softmax(p0, p1, l_reg, pa0, pa1, pa2, pa3); FA_SBAR();
          pv_d0(o, vb0 + b * SHM_V, pa0, pa1, pa2, pa3); }
        if (j + 2 < nt) asm volatile("s_waitcnt vmcnt(%0) lgkmcnt(0)\n\ts_barrier" :: "n"(NPT) : "memory");
        else asm volatile("s_waitcnt vmcnt(0) lgkmcnt(0)\n\ts_barrier" ::: "memory");
        slot = slot == 2 ? 0 : slot + 1;
    }
    { auto rr = __builtin_amdgcn_permlane32_swap(__float_as_uint(l_reg), __float_as_uint(l_reg), false, false); l_reg = __uint_as_float(rr[0]) + __uint_as_float(rr[1]); }
    l_out = l_reg;
#undef FD_DMA
}
__device__ __forceinline__ void row_bcast(float f, LAS float* al, int r32, int hi, float (&rf)[16]) {
    asm volatile("s_waitcnt lgkmcnt(0)" ::: "memory");
    if (hi == 0) al[r32] = f;
    asm volatile("s_waitcnt lgkmcnt(0)" ::: "memory");
#pragma unroll
    for (int r = 0; r < 16; ++r) rf[r] = al[crow(r, hi)];
    asm volatile("s_waitcnt lgkmcnt(0)" ::: "memory");
}

__device__ __forceinline__ void attn_pass_da5(const bf16* __restrict__ Qb, const bf16* __restrict__ Kh, const bf16* __restrict__ Vh, const int* __restrict__ posb, float slope2, int cw, int q0, int T0, int NT,
                                              LAS unsigned char* lds, int tid_, f32x16 (&o)[4], float& l_out) {
    typedef Lds<64> L; constexpr int DQK = 64, SHM_K = L::SHM_K, B_OFF = L::END;
    const int wid = __builtin_amdgcn_readfirstlane(tid_ >> 6); int lane; asm volatile("v_mbcnt_lo_u32_b32 %0, -1, 0\n\tv_mbcnt_hi_u32_b32 %0, -1, %0" : "=v"(lane));
    const int tid = wid * 64 + lane, r32 = lane & 31, hi = lane >> 5;
    LAS unsigned char* V_lds = lds + L::V_OFF; LAS unsigned char* K_lds = lds + L::K_OFF; LAS float* P_lds = (LAS float*)(lds + L::POS_OFF); LAS float* B_lds = (LAS float*)(lds + B_OFF);
    float l_reg = 0.f;
#pragma unroll
    for (int d = 0; d < 4; ++d) o[d] = f32x16{};
    bf16x8 qr[4];
    { const bf16* Qw = Qb + (size_t)(wid * QBLK) * DQK; unsigned qgo = (unsigned)(r32 * DQK + hi * 8) * 2u; asm volatile("" : "+v"(qgo));
#pragma unroll
      for (int d0 = 0; d0 < 4; ++d0) qr[d0] = ldg<bf16x8>(Qw + d0 * 16, qgo); }
    const float posq = (float)posb[q0 + wid * QBLK + r32];
    const float dl = slope2 * (posq - (float)cw);
    const int tmax = NT - 4 + (wid >> 1);
    const int sr = tid >> 4, sc = (tid & 15) * 8, vst0 = v_st_nat(sr, sc), vst1 = v_st_nat(32 + sr, sc);
    const int kr = tid >> 3, kc = (tid & 7) * 8, kst = kswz(kr, kc * 2);
    unsigned vgo = (unsigned)(sr * DV + sc) * 2u, kgo = (unsigned)(kr * DQK + kc) * 2u, pgo = (unsigned)(tid & 63) * 4u; asm volatile("" : "+v"(vgo), "+v"(kgo), "+v"(pgo));
    const int vb0 = (int)(uintptr_t)V_lds + v_rd_base(lane);
    int ka[4]; k_bases(ka, K_lds, r32, hi);
    bf16x8 vs0, vs1, ks0; int ps;
#define FD_SLOAD(k0) do { unsigned kk_ = (unsigned)__builtin_amdgcn_readfirstlane((int)(k0)); asm volatile("" : "+s"(kk_)); \
    const bf16* Vt_ = Vh + (size_t)kk_ * DV; const bf16* Kt_ = Kh + (size_t)kk_ * DQK; \
    vs0 = ldg<bf16x8>(Vt_, vgo); vs1 = ldg<bf16x8>(Vt_ + 32 * DV, vgo); ks0 = ldg<bf16x8>(Kt_, kgo); ps = ldg<int>(posb + kk_, pgo); } while (0)
#define FD_SWRITE(b) do { *(LAS bf16x8*)(V_lds + (b) * SHM_V + vst0) = vs0; *(LAS bf16x8*)(V_lds + (b) * SHM_V + vst1) = vs1; *(LAS bf16x8*)(K_lds + (b) * SHM_K + kst) = ks0; \
    B_lds[(b) * 512 + tid] = slope2 * (float)(ps - cw); if (tid < 64) P_lds[(b) * 64 + tid] = (float)ps; } while (0)
#define FD_LIN(b) do { f32x16 p0, p1; bf16x8 pa0, pa1, pa2, pa3; const LAS float* bl_ = B_lds + (b) * 512 + wid * 64 + 4 * hi; \
    _Pragma("unroll") for (int g = 0; g < 4; ++g) { const f32x4 k0 = *(const LAS f32x4*)(bl_ + 8 * g), k1 = *(const LAS f32x4*)(bl_ + 32 + 8 * g); \
        _Pragma("unroll") for (int e = 0; e < 4; ++e) { p0[4 * g + e] = k0[e]; p1[4 * g + e] = k1[e]; } } \
    if (PIPE_LIN) qkt_pipe<DQK, (b) * SHM_K>(p0, p1, ka, qr); else qkt<DQK, false>(p0, p1, K_lds + (b) * SHM_K, qr, r32, hi); fr_softmax(p0, p1, l_reg, pa0, pa1, pa2, pa3); FA_SBAR(); \
    pv_d0_pipe(o, vb0 + (b) * SHM_V, pa0, pa1, pa2, pa3); } while (0)
#define FD_GEN(b, t) do { if ((t) <= tmax) { f32x16 p0, p1; bf16x8 pa0, pa1, pa2, pa3; \
    _Pragma("unroll") for (int r = 0; r < 16; ++r) { p0[r] = dl; p1[r] = dl; } \
    if (PIPE_GEN) qkt_pipe<DQK, (b) * SHM_K>(p0, p1, ka, qr); else qkt<DQK, false>(p0, p1, K_lds + (b) * SHM_K, qr, r32, hi); fixup<true>(p0, p1, P_lds + (b) * 64, posq, slope2, false, hi); fr_softmax(p0, p1, l_reg, pa0, pa1, pa2, pa3); FA_SBAR(); \
    pv_d0_pipe(o, vb0 + (b) * SHM_V, pa0, pa1, pa2, pa3); } } while (0)
    FD_SLOAD(T0 * KVBLK); FD_SWRITE(0); FD_SLOAD((T0 + 1) * KVBLK); FD_SWRITE(1); FD_SLOAD((T0 + 2) * KVBLK);
    __syncthreads();
    int j = T0;
    for (; j < NT - 4; j += 2) {
        FD_LIN(0);
        __syncthreads();
        FD_SWRITE(0); FD_SLOAD((j + 3) * KVBLK);
        FD_LIN(1);
        __syncthreads();
        FD_SWRITE(1); FD_SLOAD((j + 4) * KVBLK);
    }
    for (; j < NT; j += 2) {
        FD_GEN(0, j);
        __syncthreads();
        if (j + 2 < NT) { FD_SWRITE(0); FD_SLOAD((j + 3) * KVBLK); }
        FD_GEN(1, j + 1);
        __syncthreads();
        if (j + 2 < NT) { FD_SWRITE(1); }
    }
    { auto rr = __builtin_amdgcn_permlane32_swap(__float_as_uint(l_reg), __float_as_uint(l_reg), false, false); l_reg = __uint_as_float(rr[0]) + __uint_as_float(rr[1]); }
    l_out = l_reg;
#undef FD_SLOAD
#undef FD_SWRITE
#undef FD_LIN
#undef FD_GEN
}

__device__ __forceinline__ void attn_pass_da5p(const bf16* __restrict__ Qb, const bf16* __restrict__ Kh, const bf16* __restrict__ Vh, const int* __restrict__ posb, float slope2, int cw, int q0, int T0, int NT,
                                               LAS unsigned char* lds, int tid_, f32x16 (&o)[4], float& l_out) {
    typedef Lds<64> L; constexpr int DQK = 64, SHM_K = L::SHM_K, B_OFF = L::END;
    const int wid = __builtin_amdgcn_readfirstlane(tid_ >> 6); int lane; asm volatile("v_mbcnt_lo_u32_b32 %0, -1, 0\n\tv_mbcnt_hi_u32_b32 %0, -1, %0" : "=v"(lane));
    const int tid = wid * 64 + lane, r32 = lane & 31, hi = lane >> 5;
    if (wid >= 4) __builtin_amdgcn_s_setprio(1);
    LAS unsigned char* V_lds = lds + L::V_OFF; LAS unsigned char* K_lds = lds + L::K_OFF; LAS float* P_lds = (LAS float*)(lds + L::POS_OFF); LAS float* B_lds = (LAS float*)(lds + B_OFF);
    float l_reg = 0.f;
#pragma unroll
    for (int d = 0; d < 4; ++d) o[d] = f32x16{};
    bf16x8 qr[4];
    { const bf16* Qw = Qb + (size_t)(wid * QBLK) * DQK; unsigned qgo = (unsigned)(r32 * DQK + hi * 8) * 2u; asm volatile("" : "+v"(qgo));
#pragma unroll
      for (int d0 = 0; d0 < 4; ++d0) qr[d0] = ldg<bf16x8>(Qw + d0 * 16, qgo); }
    const float posq = (float)posb[q0 + wid * QBLK + r32];
    const float dl = slope2 * (posq - (float)cw);
    const int tmax = NT - 4 + (wid >> 1);
    const int sr = tid >> 4, sc = (tid & 15) * 8, vst0 = v_st_nat(sr, sc), vst1 = v_st_nat(32 + sr, sc);
    const int kr = tid >> 3, kc = (tid & 7) * 8, kst = kswz(kr, kc * 2);
    unsigned vgo = (unsigned)(sr * DV + sc) * 2u, kgo = (unsigned)(kr * DQK + kc) * 2u, pgo = (unsigned)(tid & 63) * 4u; asm volatile("" : "+v"(vgo), "+v"(kgo), "+v"(pgo));
    const int vb0 = (int)(uintptr_t)V_lds + v_rd_base(lane);
    int ka[4]; k_bases(ka, K_lds, r32, hi);
    bf16x8 vs0, vs1, ks0; int ps;
#define FP_LOADV(t) do { unsigned kk_ = (unsigned)__builtin_amdgcn_readfirstlane((int)((t) * KVBLK)); asm volatile("" : "+s"(kk_)); const bf16* Vt_ = Vh + (size_t)kk_ * DV; \
    vs0 = ldg<bf16x8>(Vt_, vgo); vs1 = ldg<bf16x8>(Vt_ + 32 * DV, vgo); } while (0)
#define FP_LOADK(t) do { unsigned kk_ = (unsigned)__builtin_amdgcn_readfirstlane((int)((t) * KVBLK)); asm volatile("" : "+s"(kk_)); ks0 = ldg<bf16x8>(Kh + (size_t)kk_ * DQK, kgo); ps = ldg<int>(posb + kk_, pgo); } while (0)
#define FP_WRITEV(b) do { *(LAS bf16x8*)(V_lds + (b) * SHM_V + vst0) = vs0; *(LAS bf16x8*)(V_lds + (b) * SHM_V + vst1) = vs1; } while (0)
#define FP_WRITEK(b) do { *(LAS bf16x8*)(K_lds + (b) * SHM_K + kst) = ks0; B_lds[(b) * 512 + tid] = slope2 * (float)(ps - cw); if (tid < 64) P_lds[(b) * 64 + tid] = (float)ps; } while (0)
#define FP_BINIT(x0, x1, b) do { const LAS float* bl_ = B_lds + (b) * 512 + wid * 64 + 4 * hi; \
    _Pragma("unroll") for (int g = 0; g < 4; ++g) { const f32x4 k0 = *(const LAS f32x4*)(bl_ + 8 * g), k1 = *(const LAS f32x4*)(bl_ + 32 + 8 * g); \
        _Pragma("unroll") for (int e = 0; e < 4; ++e) { x0[4 * g + e] = k0[e]; x1[4 * g + e] = k1[e]; } } } while (0)
#define FP_QK(x0, x1, t, b) do { if ((t) < NT - 4) { FP_BINIT(x0, x1, b); qkt<DQK, false>(x0, x1, K_lds + (b) * SHM_K, qr, r32, hi); } \
    else { _Pragma("unroll") for (int r = 0; r < 16; ++r) { x0[r] = dl; x1[r] = dl; } qkt<DQK, false>(x0, x1, K_lds + (b) * SHM_K, qr, r32, hi); fixup<true>(x0, x1, P_lds + (b) * 64, posq, slope2, false, hi); } } while (0)
    f32x16 c0, c1;
    {
        FP_LOADV(T0); FP_LOADK(T0);
        bf16x8 vB0, vB1, kB; int pB;
        { unsigned kk_ = (unsigned)__builtin_amdgcn_readfirstlane((int)((T0 + 1) * KVBLK)); asm volatile("" : "+s"(kk_)); const bf16* Vt_ = Vh + (size_t)kk_ * DV;
          vB0 = ldg<bf16x8>(Vt_, vgo); vB1 = ldg<bf16x8>(Vt_ + 32 * DV, vgo); kB = ldg<bf16x8>(Kh + (size_t)kk_ * DQK, kgo); pB = ldg<int>(posb + kk_, pgo); }
        FP_WRITEV(0); FP_WRITEK(0);
        *(LAS bf16x8*)(V_lds + SHM_V + vst0) = vB0; *(LAS bf16x8*)(V_lds + SHM_V + vst1) = vB1; *(LAS bf16x8*)(K_lds + SHM_K + kst) = kB;
        B_lds[512 + tid] = slope2 * (float)(pB - cw); if (tid < 64) P_lds[64 + tid] = (float)pB;
        FP_LOADK(T0 + 2); FP_LOADV(T0 + 2);
        __syncthreads();
        FP_QK(c0, c1, T0, 0);
        __syncthreads();
        FP_WRITEK(0); FP_LOADK(T0 + 3);
    }
    int s = T0;
    for (; s <= NT - 6; ++s) {
        const int b = s & 1, nb = b ^ 1, kof = nb * SHM_K;
        f32x16 n0, n1; bf16x8 pa0, pa1, pa2, pa3;
        FP_BINIT(n0, n1, nb);
        bf16x8 a0 = k_read<0>(ka[0] + kof), b0 = k_read<4096>(ka[0] + kof), a1 = k_read<0>(ka[1] + kof), b1 = k_read<4096>(ka[1] + kof);
        float sa = 0.f, sb = 0.f;
#define FP_SM(d) do { _Pragma("unroll") for (int r = 4 * (d); r < 4 * (d) + 4; ++r) { c0[r] = __builtin_amdgcn_exp2f(c0[r]); c1[r] = __builtin_amdgcn_exp2f(c1[r]); sa += c0[r]; sb += c1[r]; } } while (0)
        FA_LGK(2); FA_SBAR(); n0 = __builtin_amdgcn_mfma_f32_32x32x16_bf16(a0, qr[0], n0, 0, 0, 0); n1 = __builtin_amdgcn_mfma_f32_32x32x16_bf16(b0, qr[0], n1, 0, 0, 0); FP_SM(0); FA_SBAR();
        a0 = k_read<0>(ka[2] + kof); b0 = k_read<4096>(ka[2] + kof);
        FA_LGK(2); FA_SBAR(); n0 = __builtin_amdgcn_mfma_f32_32x32x16_bf16(a1, qr[1], n0, 0, 0, 0); n1 = __builtin_amdgcn_mfma_f32_32x32x16_bf16(b1, qr[1], n1, 0, 0, 0); FP_SM(1); FA_SBAR();
        a1 = k_read<0>(ka[3] + kof); b1 = k_read<4096>(ka[3] + kof);
        FA_LGK(2); FA_SBAR(); n0 = __builtin_amdgcn_mfma_f32_32x32x16_bf16(a0, qr[2], n0, 0, 0, 0); n1 = __builtin_amdgcn_mfma_f32_32x32x16_bf16(b0, qr[2], n1, 0, 0, 0); FP_SM(2); FA_SBAR();
        FA_LGK(0); FA_SBAR(); n0 = __builtin_amdgcn_mfma_f32_32x32x16_bf16(a1, qr[3], n0, 0, 0, 0); n1 = __builtin_amdgcn_mfma_f32_32x32x16_bf16(b1, qr[3], n1, 0, 0, 0); FP_SM(3); FA_SBAR();
#undef FP_SM
        l_reg += sa + sb;
        typedef unsigned u32x4_t __attribute__((ext_vector_type(4)));
#define FA_PKS(P, BASE, OUT) do { u32x4_t w = {cvtpk(P[BASE + 0], P[BASE + 1]), cvtpk(P[BASE + 2], P[BASE + 3]), cvtpk(P[BASE + 4], P[BASE + 5]), cvtpk(P[BASE + 6], P[BASE + 7])}; OUT = __builtin_bit_cast(bf16x8, w); } while (0)
        FA_PKS(c0, 0, pa0); FA_PKS(c0, 8, pa1); FA_PKS(c1, 0, pa2); FA_PKS(c1, 8, pa3);
#undef FA_PKS
        FA_SBAR();
        if (s > T0) { FP_WRITEV(nb); FP_WRITEK(b); FP_LOADV(s + 2); FP_LOADK(s + 3); }
        FA_SBAR();
        pv_d0_pipe(o, vb0 + b * SHM_V, pa0, pa1, pa2, pa3);
        __syncthreads();
        c0 = n0; c1 = n1;
    }
    if (s > T0) { const int b = (s - 1) & 1; FP_WRITEV(b); FP_WRITEK(b ^ 1); FP_LOADV(s + 2); FP_LOADK(s + 3); }
    for (; s < NT; ++s) {
        const int b = s & 1, nb = b ^ 1;
        f32x16 n0 = f32x16{}, n1 = f32x16{};
        if (s + 1 < NT && s + 1 <= tmax) FP_QK(n0, n1, s + 1, nb);
        if (s <= tmax) { bf16x8 pa0, pa1, pa2, pa3; fr_softmax(c0, c1, l_reg, pa0, pa1, pa2, pa3); FA_SBAR(); pv_d0_pipe(o, vb0 + b * SHM_V, pa0, pa1, pa2, pa3); }
        __syncthreads();
        if (s + 2 < NT) FP_WRITEV(b);
        if (s + 3 < NT) { FP_WRITEK(nb); FP_LOADV(s + 3); }
        if (s + 4 < NT) FP_LOADK(s + 4);
        c0 = n0; c1 = n1;
    }
    { auto rr = __builtin_amdgcn_permlane32_swap(__float_as_uint(l_reg), __float_as_uint(l_reg), false, false); l_reg = __uint_as_float(rr[0]) + __uint_as_float(rr[1]); }
    __builtin_amdgcn_s_setprio(0);
    l_out = l_reg;
#undef FP_LOADV
#undef FP_LOADK
#undef FP_WRITEV
#undef FP_WRITEK
#undef FP_BINIT
#undef FP_QK
}
}

constexpr int CW_BAR = 4096;
constexpr int CW_Q = 8192;
__device__ __forceinline__ int next_unit(Frame& F, unsigned* ctr) {
    LAS unsigned* uq = (LAS unsigned*)(F.lds + LDSCTL_OFF + 16);
    __syncthreads();
    if (F.tid == 0) *uq = atomicAdd(ctr, 1u);
    __syncthreads();
    return __builtin_amdgcn_readfirstlane((int)*uq);
}
template <int MODE = 0> __device__ __forceinline__ void ph_attn_da(Frame& F, int l, int rep = 0) {
    const bf16 *QD = WSP(bf16, WS_QD), *KD = WSP(bf16, WS_KD), *VD = WSP(bf16, WS_VD);
    bf16* MIX = rep == 2 ? WSP(bf16, WS_U) : WSP(bf16, WS_MIX); float* O1 = WSP(float, WS_O1);
    const int lane = F.lane;
    LAS float* al = (LAS float*)(F.lds + fa::Lds<64>::WS_OFF) + F.wave * 64;
    const float s1 = wave_sum(FIN(I_LQ1)[l * 64 + lane] * FIN(I_LK1)[l * 64 + lane]);
    const float s2 = wave_sum(FIN(I_LQ2)[l * 64 + lane] * FIN(I_LK2)[l * 64 + lane]);
    const float lam_init = __int_as_float(__builtin_amdgcn_readfirstlane(__float_as_int(LAM_INIT[l])));
    const float lam = __int_as_float(__builtin_amdgcn_readfirstlane(__float_as_int(expf(s1) - expf(s2) + lam_init)));
    float gqm = fabsf(FIN(I_DAQG)[l * 64 + lane]), gkm = fabsf(FIN(I_DAKG)[l * 64 + lane]);
    gqm = wave_max(gqm); gkm = wave_max(gkm);
    const float bound = __int_as_float(__builtin_amdgcn_readfirstlane(__float_as_int(1.01f * 11.5416f * gqm * gkm)));
    const float reach = __int_as_float(__builtin_amdgcn_readfirstlane(__float_as_int(2.0f * bound + 160.0f)));
    if ((MODE == 5) != (bound < 40.0f)) return;
    const int* posmm = WSP(int, WS_POSMM);
    unsigned* ctr = (unsigned*)(F.ws + WS_CTL) + (rep == 2 ? 20000 + 64 * (l * 2) : CW_Q + 64 * 8 * (l * 4 + 0 + rep));
    for (;;) {
        const int u = next_unit(F, ctr); if (u >= 384) break;
        const int qb = 31 - u / 12, bh = u % 12, b = bh / NH, h = bh % NH, q0 = qb * 256, NT = q0 / 64 + 4;
        const int* posb = F.pos + b * SEQ;
        const float slope2 = __int_as_float(__builtin_amdgcn_readfirstlane(__float_as_int(ALIBI_SLOPE[h] * LOG2E)));
        const size_t orow = (size_t)(b * SEQ + q0 + F.wave * 32);
        int T0 = 0, TL = 0; bool lin = false;
        { const int* qm = posmm + (size_t)(b * 128 + qb * 4) * 2; int qmin = qm[0], qmax = qm[1];
#pragma unroll
          for (int c = 1; c < 4; ++c) { qmin = qm[2 * c] < qmin ? qm[2 * c] : qmin; qmax = qm[2 * c + 1] > qmax ? qm[2 * c + 1] : qmax; }
          const int* km = posmm + (size_t)(b * 128) * 2;
          for (; T0 < NT - 4; ++T0) { const int kmin = km[2 * T0], kmax = km[2 * T0 + 1]; int dmin = qmin - kmax; if (kmin - qmax > dmin) dmin = kmin - qmax; if (dmin < 0) dmin = 0;
              if (!(slope2 * (float)dmin > reach)) break; }
          T0 &= ~1;
          for (TL = T0; TL < NT; ++TL) if (km[2 * TL + 1] > qmin) break;
          if (TL < NT - 4) TL = T0;
          int span = qm[1] - qm[0];
#pragma unroll
          for (int c = 1; c < 4; ++c) { const int sp = qm[2 * c + 1] - qm[2 * c]; span = sp > span ? sp : span; }
          lin = TL >= NT - 4 && slope2 * (float)span <= 24.0f;
        }
        for (int mp = 0; mp < 2; ++mp) {
            f32x16 o[4]; float l1;
            const bf16* Qp = QD + ((size_t)(bh * 2 + mp) * SEQ + q0) * 64; const int bhk = rep == 2 ? 0 : bh; const bf16* Kp = KD + (size_t)(bhk * 2 + mp) * SEQ * 64; const bf16* Vp = VD + (size_t)bhk * SEQ * 128;
            if (MODE == 5 && lin) { const int cw = posmm[(size_t)(b * 128 + qb * 4 + (__builtin_amdgcn_readfirstlane(F.tid >> 6) >> 1)) * 2];
                fa::attn_pass_da5p(Qp, Kp, Vp, posb, slope2, cw, q0, T0, NT, F.lds, F.tid, o, l1); }
            else fa::attn_pass<64, true, 1, MODE>(Qp, Kp, Vp, posb, slope2, bound, TL, q0, T0, NT, F.lds, F.tid, o, l1);
            int le_; asm volatile("v_mbcnt_lo_u32_b32 %0, -1, 0\n\tv_mbcnt_hi_u32_b32 %0, -1, %0" : "=v"(le_)); const int r32 = le_ & 31, hi = le_ >> 5;
            float f[16];
            if (mp == 0) {
                fa::row_bcast(1.0f / l1, al, r32, hi, f);
                float* ob = O1 + orow * 768 + h * 128; unsigned lo = (unsigned)(4 * hi * 768 + r32) * 4u; asm volatile("" : "+v"(lo));
#pragma unroll
                for (int r2 = 0; r2 < 16; ++r2)
#pragma unroll
                    for (int d = 0; d < 4; ++d) fa::stg<float>(ob, lo + (fa::crowc(r2) * 768 + d * 32) * 4, o[d][r2] * f[r2]);
            } else {
                fa::row_bcast(lam / l1, al, r32, hi, f);
                const float* hg = FIN(I_DAHG) + (size_t)l * 768 + h * 128;
                float hgv[4];
#pragma unroll
                for (int d = 0; d < 4; ++d) hgv[d] = fa::ldg<float>(hg + d * 32, (unsigned)r32 * 4u) * (1.0f - lam_init);
                const float* ob = O1 + orow * 768 + h * 128; unsigned lo = (unsigned)(4 * hi * 768 + r32) * 4u; asm volatile("" : "+v"(lo));
                bf16* mb = MIX + orow * D + h * 128; unsigned mo = (unsigned)(4 * hi * D + r32) * 2u; asm volatile("" : "+v"(mo));
#pragma unroll
                for (int r2 = 0; r2 < 16; ++r2)
#pragma unroll
                    for (int d = 0; d < 4; ++d) o[d][r2] = fa::ldg<float>(ob, lo + (fa::crowc(r2) * 768 + d * 32) * 4) - o[d][r2] * f[r2];
#pragma unroll
                for (int r2 = 0; r2 < 16; ++r2) {
                    float ss = 0.f;
#pragma unroll
                    for (int d = 0; d < 4; ++d) ss += o[d][r2] * o[d][r2];
                    ss = sum32(ss);
                    const float rn = rsqrtf(ss * (1.f / 128) + EPS);
#pragma unroll
                    for (int d = 0; d < 4; ++d) fa::stg<bf16>(mb, mo + (fa::crowc(r2) * D + d * 32) * 2, (bf16)f2bf(o[d][r2] * rn * hgv[d]));
                }
            }
        }
    }
}
template <int MODE> __device__ __forceinline__ void ph_attn_mla(Frame& F, int l, int rep = 0) {
    const bf16 *QM = WSP(bf16, WS_QM), *KM = WSP(bf16, WS_KM), *VM = WSP(bf16, WS_VM);
    bf16* MIX = rep >= 2 ? WSP(bf16, WS_U) : WSP(bf16, WS_MIX);
    const int lane = F.lane;
    LAS float* al = (LAS float*)(F.lds + fa::Lds<192>::WS_OFF) + F.wave * 64;
    float gqm = fmaxf(fmaxf(fabsf(FIN(I_MQG)[l * 192 + lane]), fabsf(FIN(I_MQG)[l * 192 + 64 + lane])), fabsf(FIN(I_MQG)[l * 192 + 128 + lane]));
    float gkm = fmaxf(fmaxf(fabsf(FIN(I_MKG)[l * 192 + lane]), fabsf(FIN(I_MKG)[l * 192 + 64 + lane])), fabsf(FIN(I_MKG)[l * 192 + 128 + lane]));
    gqm = wave_max(gqm); gkm = wave_max(gkm);
    const float bound = __int_as_float(__builtin_amdgcn_readfirstlane(__float_as_int(1.01f * 19.9907f * gqm * gkm)));
    if ((MODE == 5) != (bound < 60.0f)) return;
    unsigned* ctr = (unsigned*)(F.ws + WS_CTL) + (rep >= 2 ? 20000 + 64 * (l * 2 + 1) : CW_Q + 64 * 8 * (l * 4 + 2 + rep));
    for (;;) {
        const int u = next_unit(F, ctr); if (u >= 384) break;
        const int qb = 31 - u / 12, bh = u % 12, b = bh / NH, h = bh % NH, q0 = qb * 256, NT = q0 / 64 + 4;
        const size_t orow = (size_t)(b * SEQ + q0 + F.wave * 32);
        f32x16 o[4]; float l1;
        const int bhk = rep == 2 ? 0 : bh;
#if defined(PROBE_VAR)
        if (rep == 3) fa::attn_pass<192, false, 1, MODE, PROBE_VAR>(QM + ((size_t)bh * SEQ + q0) * 192, KM + (size_t)bhk * SEQ * 192, VM + (size_t)bhk * SEQ * 128, nullptr, 0.f, bound, 0, q0, 0, NT, F.lds, F.tid, o, l1); else
#endif
        fa::attn_pass<192, false, 1, MODE>(QM + ((size_t)bh * SEQ + q0) * 192, KM + (size_t)bhk * SEQ * 192, VM + (size_t)bhk * SEQ * 128, nullptr, 0.f, bound, 0, q0, 0, NT, F.lds, F.tid, o, l1);
        int le_; asm volatile("v_mbcnt_lo_u32_b32 %0, -1, 0\n\tv_mbcnt_hi_u32_b32 %0, -1, %0" : "=v"(le_)); const int r32 = le_ & 31, hi = le_ >> 5;
        float f[16]; fa::row_bcast(1.0f / l1, al, r32, hi, f);
        bf16* mb = MIX + orow * D + 768 + h * 128; unsigned mo = (unsigned)(4 * hi * D + r32) * 2u; asm volatile("" : "+v"(mo));
#pragma unroll
        for (int r2 = 0; r2 < 16; ++r2)
#pragma unroll
            for (int d = 0; d < 4; ++d) fa::stg<bf16>(mb, mo + (fa::crowc(r2) * D + d * 32) * 2, (bf16)f2bf(o[d][r2] * f[r2]));
    }
}
__device__ __forceinline__ void ph_sgu(Frame& F, int l, int rep = 0) {
    const float* UU = WSP(float, WS_UU); const bf16* GV = WSP(bf16, WS_GV); const float* SSQ = WSP(float, WS_SSQ_SGV); bf16* MIX = WSP(bf16, WS_MIX);
    LAS unsigned short* vs = (LAS unsigned short*)F.lds;
    LAS float* rs = (LAS float*)(F.lds + 128 * 128 * 2);
    const int lane = F.lane, r32 = lane & 31, hi = lane >> 5, tm = F.wave >> 1, tn0 = (F.wave & 1) * 2;
    __syncthreads();
    unsigned* sctr = (unsigned*)(F.ws + WS_CTL) + CW_Q + 64 * 8 * 16 + 64 * (l + 4 * rep);
    LAS float* wl = rs + 128;
    for (;;) { const int u = next_unit(F, sctr); if (u >= 512) break;
        const int g = u & 3, row0 = (u >> 2) * 128;
        const int t = 32 * tm + r32;
        const float* bias = FIN(I_SGB) + (l * 4 + g) * 128 + 32 * tm;
        const int c0 = g * 128 + 32 * tn0 + r32;
        float uu0[16], uu1[16], bvv[16];
#pragma unroll
        for (int r = 0; r < 16; ++r) { const int tt = crow(r, hi); const size_t row = (size_t)(row0 + 32 * tm + tt); uu0[r] = UU[row * 512 + c0]; uu1[r] = UU[row * 512 + c0 + 32]; bvv[r] = bias[tt]; }
        { const float* wb = FIN(I_SGW) + (size_t)(l * 4 + g) * 128 * 128;
          f32x4 wv_[8];
#pragma unroll
          for (int k = 0; k < 8; ++k) wv_[k] = *(const f32x4*)(wb + (size_t)(F.tid + k * NTHREADS) * 4);
#pragma unroll
          for (int k = 0; k < 8; ++k) { const int e = (F.tid + k * NTHREADS) * 4, tr = e >> 7, sc_ = e & 127; *(LAS f32x4*)(wl + tr * 132 + sc_) = wv_[k]; } }
        for (int i = F.tid; i < 128 * 16; i += NTHREADS) { const int s = i >> 4, c8 = i & 15; *(LAS bf16x8*)(vs + s * 128 + c8 * 8) = *(const bf16x8*)(GV + (size_t)(row0 + s) * 512 + g * 128 + c8 * 8); }
        if (F.tid < 128) { const f32x4 p = *(const f32x4*)(SSQ + (size_t)(row0 + F.tid) * 16 + g * 4); rs[F.tid] = rsqrtf(((p.x + p.y) + (p.z + p.w)) * (1.f / 128) + EPS); }
        __syncthreads();
        f32x16 acc0 = f32x16{}, acc1 = f32x16{};
        const LAS float* wrow = wl + t * 132;
        for (int ks = 0; ks < 2 * (tm + 1); ++ks) {
            const int s0 = 16 * ks + 8 * hi;
            const f32x4 w0 = *(const LAS f32x4*)(wrow + s0), w1 = *(const LAS f32x4*)(wrow + s0 + 4);
            float wv[8] = {w0.x, w0.y, w0.z, w0.w, w1.x, w1.y, w1.z, w1.w};
            bf16x8 af, b0, b1;
#pragma unroll
            for (int j = 0; j < 8; ++j) { af[j] = (short)f2bf(s0 + j <= t ? wv[j] * rs[s0 + j] : 0.f);
                b0[j] = (short)vs[(s0 + j) * 128 + 32 * tn0 + r32]; b1[j] = (short)vs[(s0 + j) * 128 + 32 * (tn0 + 1) + r32]; }
            acc0 = __builtin_amdgcn_mfma_f32_32x32x16_bf16(af, b0, acc0, 0, 0, 0);
            acc1 = __builtin_amdgcn_mfma_f32_32x32x16_bf16(af, b1, acc1, 0, 0, 0);
        }
#pragma unroll
        for (int r = 0; r < 16; ++r) { const int tt = crow(r, hi); const size_t row = (size_t)(row0 + 32 * tm + tt);
            MIX[row * D + 1536 + c0] = (bf16)f2bf(uu0[r] * (acc0[r] + bvv[r]));
            MIX[row * D + 1536 + c0 + 32] = (bf16)f2bf(uu1[r] * (acc1[r] + bvv[r])); }
        __syncthreads();
    }
}
__device__ __forceinline__ void ph_convfix(Frame& F, int l) {
    const float* EDGE = WSP(float, WS_EDGE); bf16* U = WSP(bf16, WS_U);
    const float* cw = FIN(I_CONVW) + (size_t)l * 3 * NUP; const float* cb = FIN(I_CONVB) + (size_t)l * NUP;
    const int gt = F.bid * NTHREADS + F.tid, nt = F.G * NTHREADS;
    constexpr int NIT = (M / 64) * 2 * (DFF / 4);
    auto item = [&](int i, unsigned long long& pk, size_t& dst) {
        const int ch = (i % (DFF / 4)) * 4, r = (i / (DFF / 4)) & 1, blk = i / (2 * (DFF / 4)); const bool first = (blk % (SEQ / 64)) == 0;
        f32x4 y[2];
#pragma unroll
        for (int bj = 0; bj < 2; ++bj) {
            const float* e0 = EDGE + ((size_t)(blk * 4) * 2 + bj) * DFF + ch;
            const f32x4 z = {0.f, 0.f, 0.f, 0.f};
            const f32x4 a0 = *(const f32x4*)(e0 + (size_t)r * 2 * DFF);
            const f32x4 a1 = r == 1 ? *(const f32x4*)e0 : (first ? z : *(const f32x4*)(e0 - (size_t)1 * 2 * DFF));
            const f32x4 a2 = first ? z : (r == 1 ? *(const f32x4*)(e0 - (size_t)1 * 2 * DFF) : *(const f32x4*)(e0 - (size_t)2 * 2 * DFF));
            y[bj] = *(const f32x4*)(cb + bj * DFF + ch) + *(const f32x4*)(cw + (size_t)2 * NUP + bj * DFF + ch) * a0 + *(const f32x4*)(cw + (size_t)NUP + bj * DFF + ch) * a1 + *(const f32x4*)(cw + bj * DFF + ch) * a2; }
        float o[4];
#pragma unroll
        for (int e = 0; e < 4; ++e) { const float g = y[0][e]; o[e] = g * __builtin_amdgcn_rcpf(1.0f + __expf(-g)) * y[1][e]; }
        pk = (unsigned long long)pk2(o[0], o[1]) | ((unsigned long long)pk2(o[2], o[3]) << 32); dst = (size_t)(blk * 64 + r) * DFF + ch; };
    for (int i = gt; i < NIT; i += 3 * nt) {
        unsigned long long p0 = 0, p1 = 0, p2 = 0; size_t d0 = 0, d1 = 0, d2 = 0;
        const bool h1 = i + nt < NIT, h2 = i + 2 * nt < NIT;
        item(i, p0, d0); if (h1) item(i + nt, p1, d1); if (h2) item(i + 2 * nt, p2, d2);
        *(unsigned long long*)(U + d0) = p0; if (h1) *(unsigned long long*)(U + d1) = p1; if (h2) *(unsigned long long*)(U + d2) = p2; }
}

__device__ __forceinline__ void ph_krope(Frame& F, int l) {
    const bf16* H = WSP(bf16, WS_H); const bf16* Wk = wptr(F, l, WL_IN) + (size_t)4096 * D; float* KR = WSP(float, WS_KR); float* SSQ = WSP(float, WS_SSQ_KR);
    constexpr int PITCH = 1024;
    LAS unsigned char* As = F.lds; LAS unsigned char* Bs = F.lds + 64 * PITCH;
    LAS float* red = (LAS float*)F.lds;
    const int lane = F.lane, r32 = lane & 31, hi = lane >> 5, w = F.wave;
    __syncthreads();
    for (int tb = F.bid; tb < M / 64; tb += F.G) {
        f32x16 acc[2][2];
#pragma unroll
        for (int i = 0; i < 2; ++i)
#pragma unroll
            for (int j = 0; j < 2; ++j) acc[i][j] = f32x16{};
        for (int kc = 0; kc < 4; ++kc) {
#pragma unroll
            for (int p = 0; p < 8; ++p) { const int q = p * NTHREADS + F.tid, row = q >> 6, c16 = q & 63;
                *(LAS v4u*)(As + row * PITCH + (c16 ^ (row & 7)) * 16) = *(const v4u*)(H + (size_t)(tb * 64 + row) * D + kc * 512 + c16 * 8);
                *(LAS v4u*)(Bs + row * PITCH + (c16 ^ (row & 7)) * 16) = *(const v4u*)(Wk + (size_t)row * D + kc * 512 + c16 * 8); }
            __syncthreads();
#pragma unroll
            for (int ks = 0; ks < 4; ++ks) { const int ko = (((w * 64 + ks * 16 + hi * 8) >> 3) ^ (r32 & 7)) * 16;
                const bf16x8 A0 = *(const LAS bf16x8*)(As + r32 * PITCH + ko), A1 = *(const LAS bf16x8*)(As + (32 + r32) * PITCH + ko);
                const bf16x8 B0 = *(const LAS bf16x8*)(Bs + r32 * PITCH + ko), B1 = *(const LAS bf16x8*)(Bs + (32 + r32) * PITCH + ko);
                acc[0][0] = __builtin_amdgcn_mfma_f32_32x32x16_bf16(A0, B0, acc[0][0], 0, 0, 0); acc[0][1] = __builtin_amdgcn_mfma_f32_32x32x16_bf16(A0, B1, acc[0][1], 0, 0, 0);
                acc[1][0] = __builtin_amdgcn_mfma_f32_32x32x16_bf16(A1, B0, acc[1][0], 0, 0, 0); acc[1][1] = __builtin_amdgcn_mfma_f32_32x32x16_bf16(A1, B1, acc[1][1], 0, 0, 0); }
            __syncthreads();
        }
#pragma unroll
        for (int i = 0; i < 2; ++i)
#pragma unroll
            for (int j = 0; j < 2; ++j)
#pragma unroll
                for (int r = 0; r < 16; ++r) red[(w * 64 + (i * 2 + j) * 16 + r) * 64 + lane] = acc[i][j][r];
        __syncthreads();
#pragma unroll
        for (int c = 0; c < 8; ++c) { const int cb = w * 8 + c, i = cb >> 5, j = (cb >> 4) & 1, r = cb & 15;
            float v = 0.f;
#pragma unroll
            for (int ww = 0; ww < 8; ++ww) v += red[(ww * 64 + cb) * 64 + lane];
            const int row = tb * 64 + 32 * i + crow(r, hi);
            KR[(size_t)row * 64 + 32 * j + r32] = v;
            const float ss = sum32(v * v);
            if (r32 == 0) SSQ[(size_t)row * 2 + j] = ss; }
        __syncthreads();
    }
}
__device__ __forceinline__ void frame_init(Frame& F, const Args& a, unsigned char* lds) {
    F.lds = (LAS unsigned char*)lds; F.tid = threadIdx.x; F.lane = F.tid & 63; F.wave = __builtin_amdgcn_readfirstlane(F.tid >> 6); F.wave0 = F.wave;
    F.bid = blockIdx.x; F.G = gridDim.x; F.gw = F.bid * NWAVES + F.wave; F.ngw = F.G * NWAVES;
    F.ka = (const __attribute__((address_space(4))) Args*)__builtin_amdgcn_kernarg_segment_ptr();
    F.pos = (const int*)a.in[I_POS]; F.out = a.out; F.ws = a.ws;
}
__device__ __forceinline__ void frame_retid(Frame& F) {
    int lane; asm volatile("v_mbcnt_lo_u32_b32 %0, -1, 0\n\tv_mbcnt_hi_u32_b32 %0, -1, %0" : "=v"(lane));
    int w = F.wave0; asm volatile("" : "+s"(w));
    F.lane = lane; F.wave = w; F.tid = w * 64 + lane;
    int bid = blockIdx.x, G = gridDim.x; asm volatile("" : "+s"(bid)); asm volatile("" : "+s"(G)); F.bid = bid; F.G = G;
    F.gw = bid * NWAVES + F.wave; F.ngw = G * NWAVES;
}
__device__ __forceinline__ void grid_bar(const XcdBarrier& bar, int wave0) {
    int lane_; asm volatile("v_mbcnt_lo_u32_b32 %0, -1, 0\n\tv_mbcnt_hi_u32_b32 %0, -1, %0" : "=v"(lane_)); const bool leader = (wave0 == 0) && (lane_ == 0);
    XcdBarrier b2 = bar; unsigned z_ = 0u; asm volatile("" : "+s"(b2.x), "+s"(z_)); b2.bar = bar.bar + z_; xcd_barrier(b2, leader); }
template <int PH> __device__ __forceinline__ void run_phase(Frame& F, int l) {
    frame_retid(F); asm volatile("; PHASE_BEGIN %0" :: "n"(PH));
    const float* mod = WSP(float, WS_MOD) + (size_t)l * 12 * D;
    if constexpr (PH == 0) ph_prologue(F);
    if constexpr (PH == 1) ph_modreduce(F);
    if constexpr (PH == 2) ph_norm(F, l, l == 0 ? FIN(I_X) : F.out, 0, D);
    if constexpr (PH == 3) { pg8::Gemm g{WSP(bf16, WS_H), wptr(F, l, WL_IN), M, 4096, D}; pg8::StaticOrder S; S.init(M, 4096, F.G, F.bid);
        pg8::EpiInProj E{WSP(bf16, WS_QD), WSP(bf16, WS_KD), WSP(bf16, WS_VD), WSP(bf16, WS_QA), WSP(bf16, WS_KVA), WSP(bf16, WS_GV), WSP(float, WS_UU), WSP(float, WS_KR),
                         WSP(float, WS_SSQ_QA), WSP(float, WS_SSQ_KVA), WSP(float, WS_SSQ_SGV), WSP(float, WS_SSQ_KR), FIN(I_DAQG) + l * 64, FIN(I_DAKG) + l * 64, FIN(I_QAG) + l * 512, FIN(I_KVAG) + l * 256, FIN(I_SGVG) + l * 512};
        pg8::gemm_phase<pg8::EpiInProj, pg8::StaticOrder, true, true>(F.lds, g, S, E, F.tid); frame_retid(F); ph_krope(F, l); }
    if constexpr (PH == 5) {
        PG8_LAS float* X = (PG8_LAS float*)(F.lds + LDSCTL_OFF + 1024);
        { pg8::Gemm g{WSP(bf16, WS_QA), wptr(F, l, WL_UQ), M, UQ_PAD, QRANK}; pg8::StaticOrder S; S.init(M, UQ_PAD, F.G, F.bid);
          pg8::EpiMlaQ E{WSP(bf16, WS_QM), WSP(float, WS_SSQ_QA), WSP(float, WS_COS), WSP(float, WS_SIN), FIN(I_MQG) + l * 192, X};
          pg8::gemm_phase<pg8::EpiMlaQ, pg8::StaticOrder, true, true>(F.lds, g, S, E, F.tid); }
        __syncthreads(); frame_retid(F);
        { pg8::Gemm g{WSP(bf16, WS_KVA), wptr(F, l, WL_UKV), M, UKV_N, KVRANK}; pg8::StaticOrder S; S.init(M, UKV_N, F.G, F.G - 1 - F.bid);
          pg8::EpiMlaKV E{WSP(bf16, WS_KM), WSP(bf16, WS_VM), WSP(float, WS_SSQ_KVA), WSP(float, WS_SSQ_KR), WSP(float, WS_KR), WSP(float, WS_COS), WSP(float, WS_SIN), FIN(I_MKG) + l * 192, X};
          pg8::gemm_phase<pg8::EpiMlaKV, pg8::StaticOrder, true, true>(F.lds, g, S, E, F.tid); }
    }
    if constexpr (PH == 7) { ph_attn_da<5>(F, l); frame_retid(F); ph_attn_da<0>(F, l); frame_retid(F); asm volatile("; PHASE_BEGIN 71"); ph_attn_mla<5>(F, l); frame_retid(F); ph_attn_mla<0>(F, l); frame_retid(F); asm volatile("; PHASE_BEGIN 72"); ph_sgu(F, l); }
    if constexpr (PH == 8) { pg8::Gemm g{WSP(bf16, WS_MIX), wptr(F, l, WL_OUT), M, D, D}; pg8::StaticOrder S; S.init(M, D, F.G, F.bid);
        pg8::EpiResid E{l == 0 ? FIN(I_X) : F.out, F.out, D, mod + 2 * D, 6 * D}; pg8::gemm_phase<pg8::EpiResid, pg8::StaticOrder, true, true>(F.lds, g, S, E, F.tid); }
    if constexpr (PH == 9) ph_norm(F, l, F.out, 3 * D, 4 * D);
    if constexpr (PH == 10) { pg8::Gemm g{WSP(bf16, WS_H), wptr(F, l, WL_UP), M, NUP, D}; pg8::StaticOrder S; S.init(M, NUP, F.G, F.bid);
        pg8::EpiConvGate E{WSP(bf16, WS_U), WSP(float, WS_EDGE), FIN(I_CONVW) + (size_t)l * 3 * NUP, FIN(I_CONVB) + (size_t)l * NUP}; pg8::gemm_phase<pg8::EpiConvGate, pg8::StaticOrder, true, true>(F.lds, g, S, E, F.tid); }
    if constexpr (PH == 11) ph_convfix(F, l);
    if constexpr (PH == 12) { pg8::Gemm g{WSP(bf16, WS_U), wptr(F, l, WL_DOWN), M, D, DFF}; pg8::StaticOrder S; S.init(M, D, F.G, F.bid);
        pg8::EpiResid E{F.out, F.out, D, mod + 5 * D, 6 * D}; pg8::gemm_phase<pg8::EpiResid, pg8::StaticOrder, true, true>(F.lds, g, S, E, F.tid); }
}
__global__ void __launch_bounds__(NTHREADS, 2) mega_fwd(Args a) {
    extern __shared__ __attribute__((aligned(16))) unsigned char lds[];
    Frame F; frame_init(F, a, lds);
    if (F.tid < 16) ((LAS unsigned*)(F.lds + LDSCTL_OFF))[F.tid] = 0u;
    __syncthreads();
    XcdBarrier bar = xcd_barrier_post((unsigned*)(F.ws + WS_CTL) + CW_BAR, (volatile LAS unsigned*)(F.lds + LDSCTL_OFF + 32));
    run_phase<0>(F, 0); grid_bar(bar, F.wave0);
#if defined(PROBE_P0)
    run_phase<0>(F, 0); grid_bar(bar, F.wave0);
#endif
    run_phase<1>(F, 0); grid_bar(bar, F.wave0);
    for (int l = 0; l < DEPTH; ++l) {
        run_phase<2>(F, l); grid_bar(bar, F.wave0);
#if defined(PROBE_EW)
        run_phase<2>(F, l); grid_bar(bar, F.wave0);
#endif
        run_phase<3>(F, l); grid_bar(bar, F.wave0);
#if defined(PROBE_GEMM)
        run_phase<3>(F, l); grid_bar(bar, F.wave0);
#endif
        run_phase<5>(F, l); grid_bar(bar, F.wave0);
        run_phase<7>(F, l); grid_bar(bar, F.wave0);
#if defined(PROBE_P7)
        frame_retid(F); ph_attn_da<5>(F, l, 1); frame_retid(F); ph_attn_mla<5>(F, l, 1); grid_bar(bar, F.wave0);
#endif
#if defined(PROBE_LOC)
        frame_retid(F); ph_attn_da<5>(F, l, 2); frame_retid(F); ph_attn_mla<5>(F, l, 2); grid_bar(bar, F.wave0);
#endif
#if defined(PROBE_DA)
        frame_retid(F); ph_attn_da<5>(F, l, 1); grid_bar(bar, F.wave0);
#endif
#if defined(PROBE_VAR)
        frame_retid(F); ph_attn_mla<5>(F, l, 3); grid_bar(bar, F.wave0);
#endif
#if defined(PROBE_MLA)
        frame_retid(F); ph_attn_mla<5>(F, l, 1); grid_bar(bar, F.wave0);
#endif
#if defined(PROBE_SGU)
        frame_retid(F); ph_sgu(F, l, 1); grid_bar(bar, F.wave0);
#endif
        run_phase<8>(F, l); grid_bar(bar, F.wave0);
        run_phase<9>(F, l); grid_bar(bar, F.wave0);
        run_phase<10>(F, l); grid_bar(bar, F.wave0);
#if defined(PROBE_G10)
        frame_retid(F); run_phase<10>(F, l); grid_bar(bar, F.wave0);
#endif
#if defined(PROBE_G10N)
        frame_retid(F); { pg8::Gemm g{WSP(bf16, WS_H), wptr(F, l, WL_UP), M, NUP, D}; pg8::StaticOrder S; S.init(M, NUP, F.G, F.bid);
          pg8::EpiNull E{WSP(float, WS_MIX)}; pg8::gemm_phase<pg8::EpiNull, pg8::StaticOrder, true, true>(F.lds, g, S, E, F.tid); } grid_bar(bar, F.wave0);
#endif
#if defined(PROBE_GEMM)
        run_phase<10>(F, l); grid_bar(bar, F.wave0);
#endif
        run_phase<11>(F, l); grid_bar(bar, F.wave0);
#if defined(PROBE_EW)
        run_phase<11>(F, l); grid_bar(bar, F.wave0);
#endif
        run_phase<12>(F, l); if (l + 1 < DEPTH) grid_bar(bar, F.wave0);
    }
}

extern "C" void kernel_launch(void* const* d_in, const int* in_sizes, int n_in, void* d_out, int out_size, void* d_ws, size_t ws_size, hipStream_t stream) {
    static int grid = 0;
    if (grid == 0) {
        if (n_in != N_IN || in_sizes[0] != M * D || out_size != M * D || ws_size < WS_END) { fprintf(stderr, "kernel_launch: shape mismatch (n_in %d, ws %zu, need %zu)\n", n_in, ws_size, (size_t)WS_END); grid = -1; return; }
        int dev = 0, cus = 0, per_cu = 0;
        if (hipGetDevice(&dev) != hipSuccess || hipDeviceGetAttribute(&cus, hipDeviceAttributeMultiprocessorCount, dev) != hipSuccess) { grid = -1; return; }
        if (hipFuncSetAttribute((const void*)mega_fwd, hipFuncAttributeMaxDynamicSharedMemorySize, LDS_BYTES) != hipSuccess) { fprintf(stderr, "hipFuncSetAttribute failed\n"); grid = -1; return; }
        if (hipOccupancyMaxActiveBlocksPerMultiprocessor(&per_cu, (const void*)mega_fwd, NTHREADS, LDS_BYTES) != hipSuccess || per_cu < 1) fprintf(stderr, "kernel_launch: occupancy query reports %d\n", per_cu);
        (void)hipGetLastError();
        grid = cus > 0 ? cus : 256;
    }
    if (grid < 0) return;
    if (hipMemsetAsync((char*)d_ws + WS_CTL, 0, CTL_ZERO_BYTES, stream) != hipSuccess) { fprintf(stderr, "kernel_launch: memset failed\n"); return; }
    Args a{};
    for (int i = 0; i < N_IN; ++i) a.in[i] = d_in[i];
    a.out = (float*)d_out; a.ws = (unsigned char*)d_ws; a.ph = 0; a.l = 0;
    hipLaunchKernelGGL(mega_fwd, dim3(grid), dim3(NTHREADS), LDS_BYTES, stream, a);
    const hipError_t le = hipPeekAtLastError();
    if (le != hipSuccess) fprintf(stderr, "kernel_launch: launch failed: %s\n", hipGetErrorName(le));
}
```

```cpp
#include <hip/hip_runtime.h>
#include <cstdio>
#include <cstdint>
#include <cmath>
#define GAS __attribute__((address_space(1)))
#define LAS __attribute__((address_space(3)))
namespace pg8 {
#define PG8_LAS __attribute__((address_space(3)))
typedef unsigned short bf16_t;
typedef short bf16x8 __attribute__((ext_vector_type(8)));
typedef float f32x4 __attribute__((ext_vector_type(4)));
typedef unsigned u32x4 __attribute__((ext_vector_type(4)));
constexpr int BM = 256, BK = 64, HALF = 128, HTB = HALF * BK * 2  , STAGE_BYTES = 8 * HTB, NXCD = 8, WGM = 8;

__host__ __device__ __forceinline__ int lds_byte(int r, int c) { const int st = (r >> 4) * 2 + (c >> 5), rr = r & 15, cc = c & 31, ob = rr * 64 + cc * 2; return st * 1024 + (ob ^ (((ob >> 9) & 1) << 5)); }
__host__ __device__ __forceinline__ void stage_rc(int b, int& R, int& C) { const int st = b / 1024, sb = b % 1024, swz = sb ^ (((sb >> 9) & 1) << 5); R = (st >> 1) * 16 + swz / 64; C = (st & 1) * 32 + (swz % 64) / 2; }
__host__ __device__ __forceinline__ int perm32(int rho) { const int n = rho >> 4, i = rho & 15; return 8 * (i >> 2) + 4 * n + (i & 3); }

struct Unit { int pm, pn; };
struct Gemm { const bf16_t* A; const bf16_t* Bt; int M, N, K; };

struct StaticOrder {
    int nM, nN, nwg, G, c;
    __host__ __device__ void init(int M, int N, int G_, int c_) { nM = M / BM; nN = N / BM; nwg = nM * nN; G = G_; c = c_; }
    __host__ __device__ bool next(int i, Unit& u) const {
        const long L = (long)i * G + c; if (L >= nwg) return false;
        int wgid = (int)L; { const int q = nwg / NXCD, r = nwg % NXCD, xcd = wgid % NXCD, off = wgid / NXCD; wgid = (xcd < r ? xcd * (q + 1) : r * (q + 1) + (xcd - r) * q) + off; }
        const int nig = WGM * nN, gid = wgid / nig, fm = gid * WGM, gsz = (nM - fm) < WGM ? (nM - fm) : WGM;
        u.pm = fm + ((wgid % nig) % gsz); u.pn = (wgid % nig) / gsz; return true;
    }
    __device__ __forceinline__ void a_ready(const Unit&) const {}
    __device__ __forceinline__ void done(const Unit&) const {}
};

__device__ __forceinline__ unsigned cvt_pk_bf16(float lo, float hi) { unsigned r; asm volatile("v_cvt_pk_bf16_f32 %0, %1, %2" : "=v"(r) : "v"(lo), "v"(hi)); return r; }
typedef float f32x2 __attribute__((ext_vector_type(2)));

template <class Epi, class Sched, bool ALIGN_EPI = false, bool SP2 = false>
__device__ __forceinline__ void gemm_phase(PG8_LAS unsigned char* lds, const Gemm g, const Sched& S, const Epi& E, int tid_in) {
    int tid_ = tid_in; asm volatile("" : "+v"(tid_));
    const int tid = tid_, wid = __builtin_amdgcn_readfirstlane(tid >> 6), lane = tid & 63, wr = wid >> 2, wc = wid & 3, fr = lane & 15, fq = lane >> 4;
    const int K = g.K, nt = K / BK;
    unsigned voffA[2], voffB[2];
#pragma unroll
    for (int i = 0; i < 2; ++i) { int R, C; stage_rc(tid * 16 + i * 8192, R, C); const int Rb = Epi::PERM ? ((R & ~31) + perm32(R & 31)) : R;
        voffA[i] = (unsigned)(R * K + C) * 2u; voffB[i] = (unsigned)(Rb * K + C) * 2u; }
    const size_t kstep = (size_t)(BK * 2);
    const size_t hstep = (size_t)HALF * K * 2;
    const size_t tstep = 2 * hstep;
    const unsigned ldsw = (unsigned)wid * 1024u;
    const int aoff = lds_byte(wr * 64 + fr, fq * 8), boff = lds_byte(wc * 32 + fr, fq * 8);
#define PG8_SA(b, h) (((b) * 2 + (h)) * HTB)
#define PG8_SB(b, h) ((4 + (b) * 2 + (h)) * HTB)
#define PG8_STAGE(bufoff, gbase, voff) do { _Pragma("unroll") for (int _i = 0; _i < 2; ++_i) \
        __builtin_amdgcn_global_load_lds((const unsigned*)((const char*)(gbase) + (voff)[_i]), (PG8_LAS unsigned*)(lds + (bufoff) + ldsw + _i * 8192), 16, 0, 0); } while (0)
#define PG8_LDA(dst, b, h) do { _Pragma("unroll") for (int m = 0; m < 4; ++m) _Pragma("unroll") for (int k = 0; k < 2; ++k) dst[m][k] = *(const PG8_LAS bf16x8*)(lds + PG8_SA(b, h) + aoff + m * 2048 + k * 1024); } while (0)
#define PG8_LDB(dst, b, h) do { _Pragma("unroll") for (int n = 0; n < 2; ++n) _Pragma("unroll") for (int k = 0; k < 2; ++k) dst[n][k] = *(const PG8_LAS bf16x8*)(lds + PG8_SB(b, h) + boff + n * 2048 + k * 1024); } while (0)
#define PG8_MMA(ai, bj, At, Bt) do { __builtin_amdgcn_s_setprio(1); _Pragma("unroll") for (int m = 0; m < 4; ++m) _Pragma("unroll") for (int n = 0; n < 2; ++n) _Pragma("unroll") for (int k = 0; k < 2; ++k) \
        acc[ai][bj][m][n] = __builtin_amdgcn_mfma_f32_16x16x32_bf16(Bt[n][k], At[m][k], acc[ai][bj][m][n], 0, 0, 0); __builtin_amdgcn_s_setprio(0); } while (0)
#define PG8_WAIT_V(n) asm volatile("s_waitcnt vmcnt(" #n ")" ::: "memory")
#define PG8_WAIT_L(n) asm volatile("s_waitcnt lgkmcnt(" #n ")" ::: "memory")
#define PG8_BAR __builtin_amdgcn_s_barrier()
#define PG8_SCHED __builtin_amdgcn_sched_barrier(0)
    Unit cur, nxt; int ui = 0;
    if (!S.next(0, cur)) return;
    f32x4 acc[2][2][4][2];
#pragma unroll
    for (int a = 0; a < 2; ++a)
#pragma unroll
        for (int b = 0; b < 2; ++b)
#pragma unroll
            for (int m = 0; m < 4; ++m)
#pragma unroll
                for (int n = 0; n < 2; ++n) acc[a][b][m][n] = (f32x4){0.f, 0.f, 0.f, 0.f};
    bf16x8 At[4][2], B0[2][2], B1[2][2];
    const char* cA = (const char*)g.A + (size_t)cur.pm * tstep; const char* cB = (const char*)g.Bt + (size_t)cur.pn * tstep;
    S.a_ready(cur);
    if constexpr (SP2) {
        PG8_STAGE(PG8_SB(0, 0), cB, voffB); PG8_STAGE(PG8_SB(0, 1), cB + hstep, voffB); PG8_STAGE(PG8_SA(0, 0), cA, voffA); PG8_STAGE(PG8_SA(0, 1), cA + hstep, voffA);
        if (wr == 1) PG8_BAR;
        PG8_WAIT_V(2); PG8_BAR;
        PG8_STAGE(PG8_SB(1, 0), cB + kstep, voffB); PG8_STAGE(PG8_SA(1, 0), cA + kstep, voffA); PG8_STAGE(PG8_SB(1, 1), cB + hstep + kstep, voffB);
        PG8_WAIT_V(6); PG8_BAR;
    } else {
        PG8_STAGE(PG8_SB(0, 0), cB, voffB); PG8_STAGE(PG8_SA(0, 0), cA, voffA); PG8_STAGE(PG8_SB(0, 1), cB + hstep, voffB); PG8_STAGE(PG8_SA(0, 1), cA + hstep, voffA);
        if (wr == 1) PG8_BAR;
        PG8_WAIT_V(4); PG8_BAR;
        PG8_STAGE(PG8_SB(1, 0), cB + kstep, voffB); PG8_STAGE(PG8_SA(1, 0), cA + kstep, voffA); PG8_STAGE(PG8_SB(1, 1), cB + hstep + kstep, voffB);
        PG8_WAIT_V(6); PG8_BAR;
    }
    for (;;) {
        const bool has_next = S.next(ui + 1, nxt);
        const char* nA = has_next ? (const char*)g.A + (size_t)nxt.pm * tstep : cA; const char* nB = has_next ? (const char*)g.Bt + (size_t)nxt.pn * tstep : cB;
        for (int t = 0; t < nt; t += 2) {
            const bool last = (t == nt - 2);
            const char* a1 = cA + (size_t)(t + 1) * kstep;
            const char* a2 = last ? nA : cA + (size_t)(t + 2) * kstep; const char* b2 = last ? nB : cB + (size_t)(t + 2) * kstep;
            const char* a3 = a2 + kstep; const char* b3 = b2 + kstep;
            if (last && has_next) S.a_ready(nxt);
            if constexpr (SP2) {
            PG8_LDB(B0, 0, 0); PG8_LDB(B1, 0, 1); PG8_SCHED; PG8_LDA(At, 0, 0); PG8_STAGE(PG8_SA(1, 1), a1 + hstep, voffA);
            PG8_WAIT_V(8); PG8_WAIT_L(0); PG8_BAR; PG8_MMA(0, 0, At, B0); PG8_MMA(0, 1, At, B1); PG8_BAR; PG8_SCHED;
            PG8_LDA(At, 0, 1); PG8_STAGE(PG8_SB(0, 0), b2, voffB); PG8_STAGE(PG8_SB(0, 1), b2 + hstep, voffB); PG8_STAGE(PG8_SA(0, 0), a2, voffA);
            PG8_WAIT_V(8); PG8_WAIT_L(0); PG8_BAR; PG8_MMA(1, 0, At, B0); PG8_MMA(1, 1, At, B1); PG8_BAR; PG8_SCHED;
            PG8_LDB(B0, 1, 0); PG8_LDB(B1, 1, 1); PG8_SCHED; PG8_LDA(At, 1, 0); PG8_STAGE(PG8_SA(0, 1), a2 + hstep, voffA);
            PG8_WAIT_V(8); PG8_WAIT_L(0); PG8_BAR; PG8_MMA(0, 0, At, B0); PG8_MMA(0, 1, At, B1); PG8_BAR; PG8_SCHED;
            PG8_LDA(At, 1, 1); PG8_STAGE(PG8_SB(1, 0), b3, voffB); PG8_STAGE(PG8_SB(1, 1), b3 + hstep, voffB); PG8_STAGE(PG8_SA(1, 0), a3, voffA);
            PG8_WAIT_V(8); PG8_WAIT_L(0); PG8_BAR; PG8_MMA(1, 0, At, B0); PG8_MMA(1, 1, At, B1); PG8_BAR; PG8_SCHED;
            } else {
            PG8_LDB(B0, 0, 0); PG8_SCHED; PG8_LDA(At, 0, 0); PG8_STAGE(PG8_SA(1, 1), a1 + hstep, voffA);
            PG8_WAIT_L(8); PG8_BAR; PG8_WAIT_L(0); PG8_MMA(0, 0, At, B0); PG8_BAR; PG8_SCHED;
            PG8_LDB(B1, 0, 1); PG8_STAGE(PG8_SB(0, 0), b2, voffB);
            PG8_BAR; PG8_WAIT_L(0); PG8_MMA(0, 1, At, B1); PG8_BAR;
            PG8_LDA(At, 0, 1); PG8_STAGE(PG8_SA(0, 0), a2, voffA);
            PG8_BAR; PG8_WAIT_L(0); PG8_MMA(1, 0, At, B0); PG8_BAR; PG8_SCHED;
            PG8_STAGE(PG8_SB(0, 1), b2 + hstep, voffB);
            PG8_WAIT_V(6); PG8_BAR; PG8_MMA(1, 1, At, B1); PG8_BAR;
            PG8_LDB(B0, 1, 0); PG8_SCHED; PG8_LDA(At, 1, 0); PG8_STAGE(PG8_SA(0, 1), a2 + hstep, voffA);
            PG8_WAIT_L(8); PG8_BAR; PG8_WAIT_L(0); PG8_MMA(0, 0, At, B0); PG8_BAR; PG8_SCHED;
            PG8_LDB(B1, 1, 1); PG8_STAGE(PG8_SB(1, 0), b3, voffB);
            PG8_BAR; PG8_WAIT_L(0); PG8_MMA(0, 1, At, B1); PG8_BAR;
            PG8_LDA(At, 1, 1); PG8_STAGE(PG8_SA(1, 0), a3, voffA);
            PG8_BAR; PG8_WAIT_L(0); PG8_MMA(1, 0, At, B0); PG8_BAR; PG8_SCHED;
            PG8_STAGE(PG8_SB(1, 1), b3 + hstep, voffB);
            PG8_WAIT_V(6); PG8_BAR; PG8_MMA(1, 1, At, B1); PG8_BAR;
            }
        }
        if constexpr (ALIGN_EPI) { if (wr == 0) PG8_BAR; }
        if constexpr (!Epi::AFTER_DRAIN) { E(acc, cur, wr, wc, fr, fq); S.done(cur); }
        if (!has_next) break;
#pragma unroll
        for (int a = 0; a < 2; ++a)
#pragma unroll
            for (int b = 0; b < 2; ++b)
#pragma unroll
                for (int m = 0; m < 4; ++m)
#pragma unroll
                    for (int n = 0; n < 2; ++n) acc[a][b][m][n] = (f32x4){0.f, 0.f, 0.f, 0.f};
        cur = nxt; cA = nA; cB = nB; ++ui;
        if constexpr (ALIGN_EPI) { if (wr == 1) PG8_BAR; }
    }
    PG8_WAIT_V(0);
    if constexpr (!ALIGN_EPI) { if (wr == 0) PG8_BAR; }
    PG8_BAR;
    if constexpr (Epi::AFTER_DRAIN) { E.fused(acc, cur, wr, wc, fr, fq, lds, wid, lane); S.done(cur); }
#undef PG8_SA
#undef PG8_SB
#undef PG8_STAGE
#undef PG8_LDA
#undef PG8_LDB
#undef PG8_MMA
#undef PG8_WAIT_V
#undef PG8_WAIT_L
#undef PG8_BAR
#undef PG8_SCHED
}
}
#define XB_TMO      128
#define XB_XCNT(j)  (256  + 64 * (j))
#define XB_XSUB(j)  (1280 + 64 * (j))
#define XB_XGEN(j)  (2304 + 64 * (j))
#define XB_TOP      3328
#define XB_TOPGEN   3392
#define XCD_BAR_WORDS 3456
#define XB_SPIN_CAP (1u << 18)

__device__ __forceinline__ unsigned xb_ld(unsigned* p)              { return __hip_atomic_load(p, __ATOMIC_RELAXED, __HIP_MEMORY_SCOPE_AGENT); }
__device__ __forceinline__ unsigned xb_add(unsigned* p, unsigned v) { return __hip_atomic_fetch_add(p, v, __ATOMIC_RELAXED, __HIP_MEMORY_SCOPE_AGENT); }
__device__ __forceinline__ unsigned xb_xcc_id() { return (unsigned)__builtin_amdgcn_s_getreg((3 << 11) | 20) & 0xFu; }
#define XB_SPIN(cond, bar) do { unsigned _sp = 0; while (cond) { __builtin_amdgcn_s_sleep(1); \
    if ((++_sp & 255u) == 0u) { if (xb_ld(&(bar)[XB_TMO])) break; if (_sp > XB_SPIN_CAP) { atomicAdd(&(bar)[XB_TMO], 1u); break; } } } } while (0)

struct XcdBarrier {
    unsigned* bar; unsigned x;
    volatile LAS unsigned* st;
};

__device__ __forceinline__ XcdBarrier xcd_barrier_post(unsigned* bar, volatile LAS unsigned* st) {
    XcdBarrier b; b.bar = bar; b.x = xb_xcc_id(); b.st = st;
    if (threadIdx.x == 0) (void)xb_add(&bar[XB_XCNT(b.x)], 1u);
    return b;
}
__device__ __forceinline__ void xcd_barrier_complete(unsigned* bar, unsigned x, unsigned& nloc, unsigned& nx) {
    const unsigned G = gridDim.x * gridDim.y * gridDim.z;
    unsigned sum, cnt, mine, sp = 0u;
    for (;;) {
        sum = 0u; cnt = 0u; mine = 0u;
#pragma unroll
        for (unsigned j = 0; j < 16; ++j) { const unsigned c = xb_ld(&bar[XB_XCNT(j)]); sum += c; cnt += (c > 0u) ? 1u : 0u; mine = (j == x) ? c : mine; }
        if (sum == G) break;
        __builtin_amdgcn_s_sleep(1);
        if ((++sp & 255u) == 0u) { if (xb_ld(&bar[XB_TMO])) break; if (sp > XB_SPIN_CAP) { atomicAdd(&bar[XB_TMO], 1u); break; } }
    }
    nloc = mine > 0u ? mine : 1u; nx = cnt > 0u ? cnt : 1u;
}

__device__ __forceinline__ void xcd_barrier(const XcdBarrier& b, bool leader) {
    asm volatile("s_waitcnt vmcnt(0)" ::: "memory");
    __syncthreads();
    if (leader) {
        unsigned* bar = b.bar;
        __builtin_amdgcn_s_waitcnt(0);
        unsigned nloc = b.st[0], nx = b.st[1];
        if (nloc == 0u) { xcd_barrier_complete(bar, b.x, nloc, nx); b.st[0] = nloc; b.st[1] = nx; }
        const unsigned old = xb_add(&bar[XB_XSUB(b.x)], 1u);
        const unsigned gen = old / nloc;
        if (old + 1u == (gen + 1u) * nloc) {
            __builtin_amdgcn_fence(__ATOMIC_RELEASE, "agent");
            asm volatile("s_waitcnt vmcnt(0)" ::: "memory");
            const unsigned og = xb_add(&bar[XB_TOP], 1u);
            const unsigned tg = og / nx;
            if (og + 1u == (tg + 1u) * nx) xb_add(&bar[XB_TOPGEN], 1u);
            else XB_SPIN(xb_ld(&bar[XB_TOPGEN]) == tg, bar);
            __builtin_amdgcn_fence(__ATOMIC_ACQUIRE, "agent");
            xb_add(&bar[XB_XGEN(b.x)], 1u);
            asm volatile("s_waitcnt vmcnt(0)" ::: "memory");
        } else {
            XB_SPIN(xb_ld(&bar[XB_XGEN(b.x)]) == gen, bar);
            __builtin_amdgcn_fence(__ATOMIC_ACQUIRE, "agent");
            asm volatile("s_waitcnt vmcnt(0)" ::: "memory");
        }
    }
    __syncthreads();
}

typedef unsigned short bf16;
typedef unsigned v4u __attribute__((ext_vector_type(4)));
typedef unsigned v2u __attribute__((ext_vector_type(2)));
typedef float f32x4 __attribute__((ext_vector_type(4)));
typedef float f32x16 __attribute__((ext_vector_type(16)));
typedef short bf16x8 __attribute__((ext_vector_type(8)));
#define LDS_WAIT() asm volatile("s_waitcnt lgkmcnt(0)" ::: "memory")
#define VM_WAIT() asm volatile("s_waitcnt vmcnt(0)" ::: "memory")

constexpr int NWAVES = 8, NTHREADS = 512;
constexpr int BATCH = 2, SEQ = 8192, M = BATCH * SEQ, D = 2048, DEPTH = 4;
constexpr int IN_COLS = 4160, IN_PAD = 4352;
constexpr int C_DAQ = 0, C_DAK = 768, C_DAV = 1536, C_QA = 2304, C_KVA = 2816, C_KR = 3072, C_SGU = 3136, C_SGV = 3648;
constexpr int DFF = 5632, NUP = 2 * DFF;
constexpr int UQ_N = 1152, UQ_PAD = 1536, UKV_N = 1536, QRANK = 512, KVRANK = 256;
constexpr int NH = 6;
constexpr float EPS = 1e-6f;
constexpr float LOG2E = 1.4426950408889634f;
constexpr float QS_DA = 0.125f * LOG2E;
constexpr float QS_MLA = 0.07216878364870322f * LOG2E;

enum { I_X = 0, I_C, I_POS, I_WADA, I_BADA, I_WIN, I_DAQG, I_DAKG, I_LQ1, I_LK1, I_LQ2, I_LK2, I_DAHG, I_QAG, I_WUQ, I_KVAG, I_WUKV, I_MQG, I_MKG, I_SGVG, I_SGW, I_SGB, I_WOUT, I_WUP, I_CONVW, I_CONVB, I_WDOWN, N_IN };

constexpr size_t MiB = 1u << 20;
constexpr size_t WS_CTL = 0, CTL_ZERO_BYTES = 1 * MiB;
constexpr size_t WS_MOD = 1 * MiB;
constexpr size_t WS_POSMM = 1 * MiB + 512 * 1024;
constexpr size_t WS_MODP = 2 * MiB;
constexpr size_t WS_W = 8 * MiB;
constexpr size_t WL_IN = 0, WL_UQ = 17 * MiB, WL_UKV = WL_UQ + 1572864, WL_OUT = 20 * MiB, WL_UP = 28 * MiB, WL_DOWN = 72 * MiB, WL_STRIDE = 94 * MiB;
constexpr size_t WS_H = 384 * MiB;
constexpr size_t WS_MIX = 448 * MiB;
constexpr size_t WS_U = 512 * MiB;
constexpr size_t WS_R = 688 * MiB;
constexpr size_t WS_KR = WS_R;
constexpr size_t WS_SSQ_QA = WS_R + 4 * MiB, WS_SSQ_KVA = WS_R + 5 * MiB, WS_SSQ_SGV = WS_R + 6 * MiB, WS_SSQ_KR = WS_R + 7 * MiB;
constexpr size_t WS_QD = WS_R + 272 * MiB, WS_KD = WS_R + 296 * MiB, WS_VD = WS_R + 320 * MiB;
constexpr size_t WS_QM = WS_R + 344 * MiB, WS_KM = WS_R + 380 * MiB, WS_VM = WS_R + 416 * MiB;
constexpr size_t WS_QA = WS_R + 440 * MiB, WS_KVA = WS_R + 456 * MiB;
constexpr size_t WS_MLQ = WS_R + 464 * MiB, WS_MLKV = WS_R + 544 * MiB;
constexpr size_t WS_UU = WS_R + 640 * MiB, WS_GV = WS_R + 672 * MiB;
constexpr size_t WS_EDGE = WS_R;
constexpr size_t WS_A = WS_R;
constexpr size_t WS_O1 = WS_R + 704 * MiB;
constexpr size_t WS_COS = WS_R + 752 * MiB, WS_SIN = WS_R + 754 * MiB;
constexpr size_t WS_END = WS_R + 756 * MiB;

constexpr int RING_BYTES = 131072;
constexpr int LDSCTL_OFF = RING_BYTES;
constexpr int LDS_BYTES = 147456;

__device__ const float ROPE_INV[32] = {1.000000000e+00f, 7.498942614e-01f, 5.623413324e-01f, 4.216965139e-01f, 3.162277639e-01f, 2.371373773e-01f, 1.778279394e-01f, 1.333521307e-01f, 1.000000015e-01f, 7.498941571e-02f, 5.623413250e-02f, 4.216965288e-02f, 3.162277490e-02f, 2.371373773e-02f, 1.778279431e-02f, 1.333521493e-02f, 9.999999776e-03f, 7.498941850e-03f, 5.623413250e-03f, 4.216964822e-03f, 3.162277630e-03f, 2.371373586e-03f, 1.778279431e-03f, 1.333521446e-03f, 1.000000047e-03f, 7.498942432e-04f, 5.623413017e-04f, 4.216965172e-04f, 3.162277571e-04f, 2.371373703e-04f, 1.778279402e-04f, 1.333521504e-04f};
__device__ const float ALIBI_SLOPE[6] = {0.3968502629920499f, 0.15749013123685915f, 0.0625f, 0.024803141437003122f, 0.0098431332023036951f, 0.00390625f};
__device__ const float LAM_INIT[4] = {0.20000000000000007f, 0.35550906759096934f, 0.4707130183435842f, 0.5560582041556406f};

struct Args { const void* in[N_IN]; float* out; unsigned char* ws; int ph; int l; };

__device__ __forceinline__ unsigned f2bf(float f) { unsigned u = __builtin_bit_cast(unsigned, f); return (u + 0x7fffu + ((u >> 16) & 1u)) >> 16; }
__device__ __forceinline__ unsigned pk2(float lo, float hi) { return f2bf(lo) | (f2bf(hi) << 16); }
__device__ __forceinline__ float bf2f(unsigned short h) { return __builtin_bit_cast(float, (unsigned)h << 16); }
template <int CTRL> __device__ __forceinline__ float dpp_mov(float v) { return __builtin_bit_cast(float, __builtin_amdgcn_update_dpp(0, __builtin_bit_cast(int, v), CTRL, 0xF, 0xF, true)); }
__device__ __forceinline__ float sum16(float v) { v += dpp_mov<0xB1>(v); v += dpp_mov<0x4E>(v); v += dpp_mov<0x141>(v); v += dpp_mov<0x140>(v); return v; }
__device__ __forceinline__ float sum32(float v) { v = sum16(v); auto r = __builtin_amdgcn_permlane16_swap(__float_as_uint(v), __float_as_uint(v), false, false); return __uint_as_float(r[0]) + __uint_as_float(r[1]); }
__device__ __forceinline__ float wave_sum(float v) { v = sum32(v); auto r = __builtin_amdgcn_permlane32_swap(__float_as_uint(v), __float_as_uint(v), false, false); return __uint_as_float(r[0]) + __uint_as_float(r[1]); }
__device__ __forceinline__ float wave_max(float v) { v = fmaxf(v, dpp_mov<0xB1>(v)); v = fmaxf(v, dpp_mov<0x4E>(v)); v = fmaxf(v, dpp_mov<0x141>(v)); v = fmaxf(v, dpp_mov<0x140>(v));
    { auto r = __builtin_amdgcn_permlane16_swap(__float_as_uint(v), __float_as_uint(v), false, false); v = fmaxf(__uint_as_float(r[0]), __uint_as_float(r[1])); }
    { auto r = __builtin_amdgcn_permlane32_swap(__float_as_uint(v), __float_as_uint(v), false, false); v = fmaxf(__uint_as_float(r[0]), __uint_as_float(r[1])); } return v; }
__device__ __forceinline__ float xor32(float v, int lane) { auto r = __builtin_amdgcn_permlane32_swap(__float_as_uint(v), __float_as_uint(v), false, false); return lane < 32 ? __uint_as_float(r[1]) : __uint_as_float(r[0]); }
__device__ __forceinline__ float gelu_tanh(float x) {
    const float u = 0.7978845608028654f * (x + 0.044715f * x * x * x);
    const float e = __expf(2.0f * u);
    const float th = 1.0f - 2.0f / (e + 1.0f);
    return 0.5f * x * (1.0f + th);
}
__device__ __forceinline__ float silu_f(float x) { return x / (1.0f + __expf(-x)); }
__device__ __forceinline__ int crow(int r, int hi) { return (r & 3) + 8 * (r >> 2) + 4 * hi; }

namespace pg8 {
struct EpiF32 {
    static constexpr bool PERM = false, AFTER_DRAIN = false;
    float* C; int ldc;
    __device__ __forceinline__ void operator()(const f32x4 (&acc)[2][2][4][2], const Unit& u, int wr, int wc, int fr, int fq) const {
        const int row0 = u.pm * BM + wr * 64 + fr, col0 = u.pn * BM + wc * 32 + 4 * fq;
#pragma unroll
        for (int ai = 0; ai < 2; ++ai)
#pragma unroll
            for (int m = 0; m < 4; ++m) { float* rowp = C + (size_t)(row0 + ai * HALF + m * 16) * ldc + col0;
#pragma unroll
                for (int bj = 0; bj < 2; ++bj)
#pragma unroll
                    for (int n = 0; n < 2; ++n) *(f32x4*)(rowp + bj * HALF + n * 16) = acc[ai][bj][m][n]; }
    }
};
struct EpiNull {
    static constexpr bool PERM = true, AFTER_DRAIN = false;
    float* C;
    __device__ __forceinline__ void operator()(const f32x4 (&acc)[2][2][4][2], const Unit& u, int wr, int wc, int fr, int fq) const {
        f32x4 s = {0.f, 0.f, 0.f, 0.f};
#pragma unroll
        for (int ai = 0; ai < 2; ++ai)
#pragma unroll
            for (int bj = 0; bj < 2; ++bj)
#pragma unroll
                for (int m = 0; m < 4; ++m)
#pragma unroll
                    for (int n = 0; n < 2; ++n) s += acc[ai][bj][m][n];
        C[(size_t)(u.pm * 44 + u.pn) * 512 + (wr * 4 + wc) * 64 + fq * 16 + fr] = (s[0] + s[1]) + (s[2] + s[3]);
    }
};
struct EpiResid {
    static constexpr bool PERM = false, AFTER_DRAIN = false;
    const float* xin; float* out; int ldc; const float* gate; int gate_stride;
    __device__ __forceinline__ void operator()(const f32x4 (&acc)[2][2][4][2], const Unit& u, int wr, int wc, int fr, int fq) const {
        const int row0 = u.pm * BM + wr * 64 + fr, col0 = u.pn * BM + wc * 32 + 4 * fq;
        const float* gp = gate + (size_t)((u.pm * BM) / SEQ) * gate_stride + col0;
        f32x4 gv[2][2];
#pragma unroll
        for (int bj = 0; bj < 2; ++bj)
#pragma unroll
            for (int n = 0; n < 2; ++n) gv[bj][n] = *(const f32x4*)(gp + bj * HALF + n * 16);
#pragma unroll
        for (int ai = 0; ai < 2; ++ai) {
            f32x4 xv[4][2][2];
#pragma unroll
            for (int m = 0; m < 4; ++m) { const size_t off = (size_t)(row0 + ai * HALF + m * 16) * ldc + col0;
#pragma unroll
                for (int bj = 0; bj < 2; ++bj)
#pragma unroll
                    for (int n = 0; n < 2; ++n) xv[m][bj][n] = *(const f32x4*)(xin + off + bj * HALF + n * 16); }
#pragma unroll
            for (int m = 0; m < 4; ++m) { const size_t off = (size_t)(row0 + ai * HALF + m * 16) * ldc + col0;
#pragma unroll
                for (int bj = 0; bj < 2; ++bj)
#pragma unroll
                    for (int n = 0; n < 2; ++n) *(f32x4*)(out + off + bj * HALF + n * 16) = xv[m][bj][n] + gv[bj][n] * acc[ai][bj][m][n]; }
        }
    }
};
struct EpiBf16S {
    static constexpr bool PERM = true, AFTER_DRAIN = false;
    bf16_t* O; int ldc;
    __device__ __forceinline__ void operator()(const f32x4 (&acc)[2][2][4][2], const Unit& u, int wr, int wc, int fr, int fq) const {
        const int row0 = u.pm * BM + wr * 64 + fr, col0 = u.pn * BM + wc * 32 + 8 * fq;
#pragma unroll
        for (int ai = 0; ai < 2; ++ai)
#pragma unroll
            for (int m = 0; m < 4; ++m) { bf16_t* rowp = O + (size_t)(row0 + ai * HALF + m * 16) * ldc + col0;
#pragma unroll
                for (int bj = 0; bj < 2; ++bj) { const f32x4 v0 = acc[ai][bj][m][0], v1 = acc[ai][bj][m][1]; u32x4 w;
                    w.x = cvt_pk_bf16(v0[0], v0[1]); w.y = cvt_pk_bf16(v0[2], v0[3]); w.z = cvt_pk_bf16(v1[0], v1[1]); w.w = cvt_pk_bf16(v1[2], v1[3]);
                    *(u32x4*)(rowp + bj * HALF) = w; } }
    }
};
template <int CTRL> __device__ __forceinline__ float dppf(float old, float src) { return __builtin_bit_cast(float, __builtin_amdgcn_update_dpp(__builtin_bit_cast(int, old), __builtin_bit_cast(int, src), CTRL, 0xF, 0xF, false)); }
struct EpiConvGate {
    static constexpr bool PERM = true, AFTER_DRAIN = false;
    bf16_t* U; float* EDGE; const float* cw; const float* cb;
    __device__ __forceinline__ void operator()(const f32x4 (&acc)[2][2][4][2], const Unit& u, int wr, int wc, int fr, int fq) const {
        const int ch0 = u.pn * 128 + wc * 32 + 8 * fq, rowb = u.pm * BM + wr * 64;
#pragma unroll
        for (int ai = 0; ai < 2; ++ai) { const int blk = (rowb + ai * HALF) >> 6;
            if (fr < 2) { float* e = EDGE + ((size_t)(blk * 4 + fr) * 2) * DFF + ch0;
#pragma unroll
                for (int bj = 0; bj < 2; ++bj) { *(f32x4*)(e + bj * DFF) = acc[ai][bj][0][0]; *(f32x4*)(e + bj * DFF + 4) = acc[ai][bj][0][1]; } }
            if (fr >= 14) { float* e = EDGE + ((size_t)(blk * 4 + fr - 12) * 2) * DFF + ch0;
#pragma unroll
                for (int bj = 0; bj < 2; ++bj) { *(f32x4*)(e + bj * DFF) = acc[ai][bj][3][0]; *(f32x4*)(e + bj * DFF + 4) = acc[ai][bj][3][1]; } }
        }
        f32x4 w[2][2][3], bb[2][2];
#pragma unroll
        for (int n = 0; n < 2; ++n)
#pragma unroll
            for (int bj = 0; bj < 2; ++bj) { bb[n][bj] = *(const f32x4*)(cb + bj * DFF + ch0 + 4 * n);
#pragma unroll
                for (int j = 0; j < 3; ++j) w[n][bj][j] = *(const f32x4*)(cw + (size_t)j * (2 * DFF) + bj * DFF + ch0 + 4 * n); }
#pragma unroll
        for (int ai = 0; ai < 2; ++ai)
#pragma unroll
            for (int m = 0; m < 4; ++m) {
                unsigned pkw[4];
#pragma unroll
                for (int n = 0; n < 2; ++n) {
                    f32x4 y[2];
#pragma unroll
                    for (int bj = 0; bj < 2; ++bj) { const f32x4 cur = acc[ai][bj][m][n]; const f32x4 prv = m > 0 ? acc[ai][bj][m - 1][n] : (f32x4){0.f, 0.f, 0.f, 0.f};
                        f32x4 s1, s2;
#pragma unroll
                        for (int e = 0; e < 4; ++e) {
                            if (m > 0) { s1[e] = dppf<0x111>(dpp_mov<0x121>(prv[e]), cur[e]); s2[e] = dppf<0x112>(dpp_mov<0x122>(prv[e]), cur[e]); }
                            else { s1[e] = dpp_mov<0x111>(cur[e]); s2[e] = dpp_mov<0x112>(cur[e]); } }
                        y[bj] = bb[n][bj] + w[n][bj][2] * cur + w[n][bj][1] * s1 + w[n][bj][0] * s2; }
                    const f32x4 tg = y[0] * -1.4426950408889634f;
                    f32x4 ev; ev[0] = __builtin_amdgcn_exp2f(tg[0]); ev[1] = __builtin_amdgcn_exp2f(tg[1]); ev[2] = __builtin_amdgcn_exp2f(tg[2]); ev[3] = __builtin_amdgcn_exp2f(tg[3]);
                    const f32x4 dn = ev + 1.0f;
                    f32x4 rc; rc[0] = __builtin_amdgcn_rcpf(dn[0]); rc[1] = __builtin_amdgcn_rcpf(dn[1]); rc[2] = __builtin_amdgcn_rcpf(dn[2]); rc[3] = __builtin_amdgcn_rcpf(dn[3]);
                    const f32x4 o = (y[0] * rc) * y[1];
                    pkw[2 * n] = cvt_pk_bf16(o[0], o[1]); pkw[2 * n + 1] = cvt_pk_bf16(o[2], o[3]);
                }
                u32x4 pk; pk.x = pkw[0]; pk.y = pkw[1]; pk.z = pkw[2]; pk.w = pkw[3];
                *(u32x4*)(U + (size_t)(rowb + ai * HALF + m * 16 + fr) * DFF + ch0) = pk;
            }
    }
};
__device__ __forceinline__ float lane_xor16_sum(float v) { auto r = __builtin_amdgcn_permlane16_swap(__float_as_uint(v), __float_as_uint(v), false, false); return __uint_as_float(r[0]) + __uint_as_float(r[1]); }
__device__ __forceinline__ float lane_xor32_sum(float v) { auto r = __builtin_amdgcn_permlane32_swap(__float_as_uint(v), __float_as_uint(v), false, false); return __uint_as_float(r[0]) + __uint_as_float(r[1]); }
__device__ __forceinline__ float sq4(f32x4 v) { return (v[0] * v[0] + v[1] * v[1]) + (v[2] * v[2] + v[3] * v[3]); }
__device__ __forceinline__ u32x4 pk8(f32x4 a, f32x4 b) { u32x4 w; w.x = cvt_pk_bf16(a[0], a[1]); w.y = cvt_pk_bf16(a[2], a[3]); w.z = cvt_pk_bf16(b[0], b[1]); w.w = cvt_pk_bf16(b[2], b[3]); return w; }
__device__ __forceinline__ float gelu_t(float x) { const float u = 0.7978845608028654f * (x + 0.044715f * x * x * x); const float e = __expf(2.0f * u); return 0.5f * x * (2.0f - 2.0f * __builtin_amdgcn_rcpf(e + 1.0f)); }
__device__ __forceinline__ f32x4 gelu4(f32x4 v) { return (f32x4){gelu_t(v[0]), gelu_t(v[1]), gelu_t(v[2]), gelu_t(v[3])}; }
struct EpiInProj {
    static constexpr bool PERM = true, AFTER_DRAIN = false;
    bf16_t *QD, *KD, *VD, *QA, *KVA, *GV; float *UU, *KR, *SSQ_QA, *SSQ_KVA, *SSQ_SGV, *SSQ_KR;
    const float *qg, *kg, *qag, *kvag, *sgvg;
    __device__ __forceinline__ void operator()(const f32x4 (&acc)[2][2][4][2], const Unit& u, int wr, int wc, int fr, int fq) const {
        const int pn = u.pn, rowb = u.pm * BM + wr * 64 + fr, b = (u.pm * BM) / SEQ, c8 = wc * 32 + 8 * fq;
        if (pn < 6) {
            const bool isk = pn >= 3; const int G = 4 * (isk ? pn - 3 : pn) + wc;
            const float* gp = isk ? kg : qg;
            const f32x4 g00 = *(const f32x4*)(gp + 8 * fq), g01 = *(const f32x4*)(gp + 8 * fq + 4), g10 = *(const f32x4*)(gp + 32 + 8 * fq), g11 = *(const f32x4*)(gp + 32 + 8 * fq + 4);
            bf16_t* dst = (isk ? KD : QD) + ((size_t)(b * 12 + G) * SEQ) * 64 + 8 * fq;
            const float post = isk ? 1.0f : QS_DA;
#pragma unroll
            for (int ai = 0; ai < 2; ++ai)
#pragma unroll
                for (int m = 0; m < 4; ++m) { const f32x4 v00 = acc[ai][0][m][0], v01 = acc[ai][0][m][1], v10 = acc[ai][1][m][0], v11 = acc[ai][1][m][1];
                    float ss = (sq4(v00) + sq4(v01)) + (sq4(v10) + sq4(v11)); ss = lane_xor16_sum(ss); ss = lane_xor32_sum(ss);
                    const float r = rsqrtf(ss * (1.f / 64) + EPS) * post;
                    bf16_t* d = dst + (size_t)((rowb + ai * HALF + m * 16) & (SEQ - 1)) * 64;
                    *(u32x4*)d = pk8(v00 * g00 * r, v01 * g01 * r); *(u32x4*)(d + 32) = pk8(v10 * g10 * r, v11 * g11 * r); }
        } else if (pn < 9) {
#pragma unroll
            for (int bj = 0; bj < 2; ++bj) { bf16_t* dst = VD + ((size_t)(b * NH + 2 * (pn - 6) + bj) * SEQ) * 128 + c8;
#pragma unroll
                for (int ai = 0; ai < 2; ++ai)
#pragma unroll
                    for (int m = 0; m < 4; ++m) *(u32x4*)(dst + (size_t)((rowb + ai * HALF + m * 16) & (SEQ - 1)) * 128) = pk8(acc[ai][bj][m][0], acc[ai][bj][m][1]); }
        } else if (pn < 12) {
            const bool iskv = pn == 11; const int ct = iskv ? 0 : 256 * (pn - 9);
            const float* gp = (iskv ? kvag : qag) + ct + c8;
            const f32x4 g00 = *(const f32x4*)gp, g01 = *(const f32x4*)(gp + 4), g10 = *(const f32x4*)(gp + HALF), g11 = *(const f32x4*)(gp + HALF + 4);
            bf16_t* dst = (iskv ? KVA : QA) + ct + c8; const int ld = iskv ? KVRANK : QRANK;
            float* sq = iskv ? SSQ_KVA + wc : SSQ_QA + (pn - 9) * 4 + wc; const int sld = iskv ? 4 : 8;
#pragma unroll
            for (int ai = 0; ai < 2; ++ai)
#pragma unroll
                for (int m = 0; m < 4; ++m) { const int row = rowb + ai * HALF + m * 16;
                    const f32x4 v00 = acc[ai][0][m][0], v01 = acc[ai][0][m][1], v10 = acc[ai][1][m][0], v11 = acc[ai][1][m][1];
                    float ss = (sq4(v00) + sq4(v01)) + (sq4(v10) + sq4(v11)); ss = lane_xor16_sum(ss); ss = lane_xor32_sum(ss);
                    if (fq == 0) sq[(size_t)row * sld] = ss;
                    *(u32x4*)(dst + (size_t)row * ld) = pk8(v00 * g00, v01 * g01); *(u32x4*)(dst + (size_t)row * ld + HALF) = pk8(v10 * g10, v11 * g11); }
        } else if (pn < 14) {
            float* dst = UU + 256 * (pn - 12) + c8;
#pragma unroll
            for (int ai = 0; ai < 2; ++ai)
#pragma unroll
                for (int m = 0; m < 4; ++m) { float* d = dst + (size_t)(rowb + ai * HALF + m * 16) * 512;
#pragma unroll
                    for (int bj = 0; bj < 2; ++bj) { *(f32x4*)(d + bj * HALF) = gelu4(acc[ai][bj][m][0]); *(f32x4*)(d + bj * HALF + 4) = gelu4(acc[ai][bj][m][1]); } }
        } else if (pn < 16) {
            const int g0 = 2 * (pn - 14);
#pragma unroll
            for (int bj = 0; bj < 2; ++bj) { const float* gp = sgvg + (g0 + bj) * 128 + c8; const f32x4 ga = *(const f32x4*)gp, gb = *(const f32x4*)(gp + 4);
                bf16_t* dst = GV + (g0 + bj) * 128 + c8; float* sq = SSQ_SGV + (g0 + bj) * 4 + wc;
#pragma unroll
                for (int ai = 0; ai < 2; ++ai)
#pragma unroll
                    for (int m = 0; m < 4; ++m) { const int row = rowb + ai * HALF + m * 16; const f32x4 a = gelu4(acc[ai][bj][m][0]), c = gelu4(acc[ai][bj][m][1]);
                        float ss = sq4(a) + sq4(c); ss = lane_xor16_sum(ss); ss = lane_xor32_sum(ss);
                        if (fq == 0) sq[(size_t)row * 16] = ss;
                        *(u32x4*)(dst + (size_t)row * 512) = pk8(a * ga, c * gb); } }
        } else {
            if (wc < 2) {
#pragma unroll
                for (int ai = 0; ai < 2; ++ai)
#pragma unroll
                    for (int m = 0; m < 4; ++m) { const int row = rowb + ai * HALF + m * 16; float* d = KR + (size_t)row * 64 + c8; *(f32x4*)d = acc[ai][0][m][0]; *(f32x4*)(d + 4) = acc[ai][0][m][1];
                        float ss = sq4(acc[ai][0][m][0]) + sq4(acc[ai][0][m][1]); ss = lane_xor16_sum(ss); ss = lane_xor32_sum(ss); if (fq == 0) SSQ_KR[(size_t)row * 2 + wc] = ss; } }
        }
    }
};
struct EpiMlaQ {
    static constexpr bool PERM = true, AFTER_DRAIN = false;
    bf16_t* QM; const float *SSQ_QA, *COS, *SIN, *qg; PG8_LAS float* X;
    __device__ __forceinline__ void operator()(const f32x4 (&acc)[2][2][4][2], const Unit& u, int wr, int wc, int fr_, int fq_) const {
        float eps_ = EPS, k192 = 1.f / 192; asm volatile("" : "+s"(eps_), "+s"(k192));
        int fr = fr_, fq = fq_; asm volatile("" : "+v"(fr), "+v"(fq));
        const int h = u.pn, rowb = u.pm * BM + wr * 64 + fr, b = (u.pm * BM) / SEQ, c8 = wc * 32 + 8 * fq, rt = wr * 64 + fr;
#pragma unroll
        for (int ai = 0; ai < 2; ++ai)
#pragma unroll
            for (int m = 0; m < 4; ++m) { float ss = (sq4(acc[ai][0][m][0]) + sq4(acc[ai][0][m][1])) + (sq4(acc[ai][1][m][0]) + sq4(acc[ai][1][m][1])); ss = lane_xor16_sum(ss); ss = lane_xor32_sum(ss);
                if (fq == 0) X[(ai * HALF + m * 16 + rt) * 4 + wc] = ss; }
        asm volatile("s_waitcnt lgkmcnt(0)" ::: "memory"); __builtin_amdgcn_s_barrier(); asm volatile("" ::: "memory");
        const f32x4 g0a = *(const f32x4*)(qg + c8), g0b = *(const f32x4*)(qg + c8 + 4);
        const int i0 = 16 * wc + 4 * fq;
        f32x4 g1 = {0.f, 0.f, 0.f, 0.f}, g2 = g1; if (wc < 2) { g1 = *(const f32x4*)(qg + 128 + i0); g2 = *(const f32x4*)(qg + 160 + i0); }
        bf16_t* dst = QM + ((size_t)(b * NH + h) * SEQ) * 192;
#pragma unroll
        for (int ai = 0; ai < 2; ++ai)
#pragma unroll
        for (int mh = 0; mh < 4; mh += 2) {
        float rr[2][4]; f32x4 csv[2][4], snv[2][4];
#pragma unroll
            for (int m = mh; m < mh + 2; ++m) { const int row = rowb + ai * HALF + m * 16; const f32x4 xs = *(const PG8_LAS f32x4*)(X + (ai * HALF + m * 16 + rt) * 4);
                const f32x4 pa = *(const f32x4*)(SSQ_QA + (size_t)row * 8), pb = *(const f32x4*)(SSQ_QA + (size_t)row * 8 + 4);
                const float msq = (((pa[0] + pa[1]) + (pa[2] + pa[3])) + ((pb[0] + pb[1]) + (pb[2] + pb[3]))) * (1.f / 512) + eps_;
                rr[ai][m] = rsqrtf(((xs[0] + xs[1]) + (xs[2] + xs[3])) * k192 + eps_ * msq) * QS_MLA;
                if (wc < 2) { csv[ai][m] = *(const f32x4*)(COS + (size_t)row * 32 + i0); snv[ai][m] = *(const f32x4*)(SIN + (size_t)row * 32 + i0); } }
#pragma unroll
            for (int m = mh; m < mh + 2; ++m) { const int row = rowb + ai * HALF + m * 16; const float r = rr[ai][m];
                bf16_t* d = dst + (size_t)(row & (SEQ - 1)) * 192;
                *(u32x4*)(d + c8) = pk8(acc[ai][0][m][0] * g0a * r, acc[ai][0][m][1] * g0b * r);
                if (wc < 2) { const f32x4 cs = csv[ai][m], sn = snv[ai][m];
                    const f32x4 va = acc[ai][1][m][0], vb = acc[ai][1][m][1];
                    const f32x4 y1 = (f32x4){va[0], va[2], vb[0], vb[2]} * g1 * r, y2 = (f32x4){va[1], va[3], vb[1], vb[3]} * g2 * r;
                    const f32x4 o1 = y1 * cs - y2 * sn, o2 = y2 * cs + y1 * sn;
                    *(u32x4*)(d + 128 + c8) = pk8((f32x4){o1[0], o2[0], o1[1], o2[1]}, (f32x4){o1[2], o2[2], o1[3], o2[3]}); } }
        }
        asm volatile("s_waitcnt lgkmcnt(0)" ::: "memory"); __builtin_amdgcn_s_barrier(); asm volatile("" ::: "memory");
    }
};
struct EpiMlaKV {
    static constexpr bool PERM = true, AFTER_DRAIN = false;
    bf16_t *KM, *VM; const float *SSQ_KVA, *SSQ_KR, *KR, *COS, *SIN, *kg; PG8_LAS float* X;
    __device__ __forceinline__ void operator()(const f32x4 (&acc)[2][2][4][2], const Unit& u, int wr, int wc, int fr_, int fq_) const {
        float eps_ = EPS, k192 = 1.f / 192; asm volatile("" : "+s"(eps_), "+s"(k192));
        int fr = fr_, fq = fq_; asm volatile("" : "+v"(fr), "+v"(fq));
        const int h = u.pn, rowb = u.pm * BM + wr * 64 + fr, b = (u.pm * BM) / SEQ, c8 = wc * 32 + 8 * fq, rt = wr * 64 + fr;
#pragma unroll
        for (int ai = 0; ai < 2; ++ai)
#pragma unroll
            for (int m = 0; m < 4; ++m) { float ss = sq4(acc[ai][0][m][0]) + sq4(acc[ai][0][m][1]); ss = lane_xor16_sum(ss); ss = lane_xor32_sum(ss);
                if (fq == 0) X[(ai * HALF + m * 16 + rt) * 4 + wc] = ss; }
        asm volatile("s_waitcnt lgkmcnt(0)" ::: "memory"); __builtin_amdgcn_s_barrier(); asm volatile("" ::: "memory");
        const f32x4 g0a = *(const f32x4*)(kg + c8), g0b = *(const f32x4*)(kg + c8 + 4);
        const int i0 = 8 * wc + 2 * fq;
        const float g1a = kg[128 + i0], g1b = kg[128 + i0 + 1], g2a = kg[160 + i0], g2b = kg[160 + i0 + 1];
        bf16_t* kd = KM + ((size_t)(b * NH + h) * SEQ) * 192; bf16_t* vd = VM + ((size_t)(b * NH + h) * SEQ) * 128;
#pragma unroll
        for (int ai = 0; ai < 2; ++ai) {
        float rr[2][4], cv[2][4]; float2 k1v[2][4], k2v[2][4], cpv[2][4], spv[2][4];
#pragma unroll
            for (int m = 0; m < 4; ++m) { const int row = rowb + ai * HALF + m * 16; const f32x4 xs = *(const PG8_LAS f32x4*)(X + (ai * HALF + m * 16 + rt) * 4);
                const f32x4 pc = *(const f32x4*)(SSQ_KVA + (size_t)row * 4);
                const float c2 = 1.0f / (((pc[0] + pc[1]) + (pc[2] + pc[3])) * (1.f / 256) + eps_);
                const float2 sk = *(const float2*)(SSQ_KR + (size_t)row * 2);
                cv[ai][m] = sqrtf(c2); rr[ai][m] = rsqrtf((c2 * ((xs[0] + xs[1]) + (xs[2] + xs[3])) + (sk.x + sk.y)) * k192 + eps_);
                const float* kr = KR + (size_t)row * 64 + i0;
                k1v[ai][m] = *(const float2*)kr; k2v[ai][m] = *(const float2*)(kr + 32); cpv[ai][m] = *(const float2*)(COS + (size_t)row * 32 + i0); spv[ai][m] = *(const float2*)(SIN + (size_t)row * 32 + i0); }
#pragma unroll
            for (int m = 0; m < 4; ++m) { const int row = rowb + ai * HALF + m * 16; const float r = rr[ai][m], ckv = cv[ai][m];
                const int srow = row & (SEQ - 1);
                *(u32x4*)(kd + (size_t)srow * 192 + c8) = pk8(acc[ai][0][m][0] * g0a * (ckv * r), acc[ai][0][m][1] * g0b * (ckv * r));
                *(u32x4*)(vd + (size_t)srow * 128 + c8) = pk8(acc[ai][1][m][0] * ckv, acc[ai][1][m][1] * ckv);
                const float2 cp = cpv[ai][m], sp = spv[ai][m];
                const float y1a = k1v[ai][m].x * r * g1a, y1b = k1v[ai][m].y * r * g1b, y2a = k2v[ai][m].x * r * g2a, y2b = k2v[ai][m].y * r * g2b;
                const float oa1 = y1a * cp.x - y2a * sp.x, oa2 = y2a * cp.x + y1a * sp.x, ob1 = y1b * cp.y - y2b * sp.y, ob2 = y2b * cp.y + y1b * sp.y;
                *(unsigned long long*)(kd + (size_t)srow * 192 + 128 + 2 * i0) = (unsigned long long)cvt_pk_bf16(oa1, oa2) | ((unsigned long long)cvt_pk_bf16(ob1, ob2) << 32); }
        }
        asm volatile("s_waitcnt lgkmcnt(0)" ::: "memory"); __builtin_amdgcn_s_barrier(); asm volatile("" ::: "memory");
    }
};
}

struct Frame {
    LAS unsigned char* lds;
    int tid, lane, wave, wave0, gw, ngw, bid, G;
    const __attribute__((address_space(4))) Args* ka; const int* pos;
    float* out; unsigned char* ws;
};
__device__ __forceinline__ size_t opq(size_t v) { asm volatile("" : "+s"(v)); return v; }
#define WSP(T, off) ((T*)(F.ws + opq(off)))
#define FIN(i) ((const float*)F.ka->in[i])
__device__ __forceinline__ const bf16* wptr(const Frame& F, int l, size_t off) { return (const bf16*)(F.ws + WS_W + (size_t)l * WL_STRIDE + off); }

__device__ __forceinline__ void p0_transpose_item(const float* W, int K, int N, bf16* WT, int row_off, LAS float* scr, int item, int lane, int rstride = 1) {
    const int nblk = N / 32, kb = item / nblk, nb = item % nblk, k0 = 64 * kb, n0 = 32 * nb;
    float wv_[32];
#pragma unroll
    for (int i = 0; i < 32; ++i) { const int kk = 2 * i + (lane >> 5); wv_[i] = W[(size_t)(k0 + kk) * N + n0 + (lane & 31)]; }
#pragma unroll
    for (int i = 0; i < 32; ++i) { const int kk = 2 * i + (lane >> 5); scr[kk * 33 + (lane & 31)] = wv_[i]; }
    LDS_WAIT(); asm volatile("" ::: "memory");
    const int c = lane & 7;
#pragma unroll
    for (int j = 0; j < 4; ++j) { const int n = (lane >> 3) + 8 * j; const LAS float* s = scr + (8 * c) * 33 + n;
        v4u o; o.x = pk2(s[0 * 33], s[1 * 33]); o.y = pk2(s[2 * 33], s[3 * 33]); o.z = pk2(s[4 * 33], s[5 * 33]); o.w = pk2(s[6 * 33], s[7 * 33]);
        *(v4u*)(WT + (size_t)(row_off + n0 + rstride * n) * K + k0 + 8 * c) = o; }
    LDS_WAIT(); asm volatile("" ::: "memory");
}
__device__ __forceinline__ void ph_prologue(Frame& F) {
    LAS float* scr = (LAS float*)(F.lds + F.wave * 16384);
    constexpr int I_IN = (D / 64) * (IN_COLS / 32), I_UQ = (QRANK / 64) * (UQ_N / 32), I_UKV = (KVRANK / 64) * (UKV_N / 32), I_OUT = (D / 64) * (D / 32), I_UP = (D / 64) * (NUP / 32), I_DN = (DFF / 64) * (D / 32);
    constexpr int I_L = I_IN + I_UQ + I_UKV + I_OUT + I_UP + I_DN;
    for (int it = F.gw; it < DEPTH * I_L; it += F.ngw) {
        const int l = it / I_L; int r = it % I_L;
        bf16* wl = (bf16*)(F.ws + WS_W + (size_t)l * WL_STRIDE);
        if (r < I_IN) { const int n0 = 32 * (r % (IN_COLS / 32)); int dst;
            if (n0 < C_DAV) { const int q = n0 % 768, G = q / 64, e = q % 64; dst = (n0 - q) + 256 * (G / 4) + 128 * (e / 32) + 32 * (G % 4) + (e % 32); }
            else if (n0 < C_KR) dst = n0;
            else if (n0 < C_SGU) dst = 4096 + (n0 - C_KR);
            else dst = n0 - 64;
            p0_transpose_item(FIN(I_WIN) + (size_t)l * D * IN_COLS, D, IN_COLS, (bf16*)((unsigned char*)wl + WL_IN), dst - n0, scr, r, F.lane); continue; } r -= I_IN;
        if (r < I_UQ) { const int n0 = 32 * (r % (UQ_N / 32)), hh = n0 / 192, e = n0 % 192;
            const int dst = 256 * hh + (e < 128 ? e : 128 + (e - 128) / 32);
            p0_transpose_item(FIN(I_WUQ) + (size_t)l * QRANK * UQ_N, QRANK, UQ_N, (bf16*)((unsigned char*)wl + WL_UQ), dst - n0, scr, r, F.lane, e < 128 ? 1 : 2); continue; } r -= I_UQ;
        if (r < I_UKV) { p0_transpose_item(FIN(I_WUKV) + (size_t)l * KVRANK * UKV_N, KVRANK, UKV_N, (bf16*)((unsigned char*)wl + WL_UKV), 0, scr, r, F.lane); continue; } r -= I_UKV;
        if (r < I_OUT) { p0_transpose_item(FIN(I_WOUT) + (size_t)l * D * D, D, D, (bf16*)((unsigned char*)wl + WL_OUT), 0, scr, r, F.lane); continue; } r -= I_OUT;
        if (r < I_UP) { const int n0 = 32 * (r % (NUP / 32)), chn = n0 % DFF, dst = 256 * (chn / 128) + 128 * (n0 / DFF) + (chn % 128);
            p0_transpose_item(FIN(I_WUP) + (size_t)l * D * NUP, D, NUP, (bf16*)((unsigned char*)wl + WL_UP), dst - n0, scr, r, F.lane); continue; } r -= I_UP;
        p0_transpose_item(FIN(I_WDOWN) + (size_t)l * DFF * D, DFF, D, (bf16*)((unsigned char*)wl + WL_DOWN), 0, scr, r, F.lane);
    }
    {
        const int gt = F.bid * NTHREADS + F.tid, nt = F.G * NTHREADS;
        constexpr int Z_IN = (IN_PAD - IN_COLS) * D / 8, Z_UQ = NH * 64 * QRANK / 8;
        for (int i = gt; i < DEPTH * (Z_IN + Z_UQ); i += nt) { const int l = i / (Z_IN + Z_UQ); int r = i % (Z_IN + Z_UQ);
            unsigned char* wl = F.ws + WS_W + (size_t)l * WL_STRIDE;
            v4u z = {0u, 0u, 0u, 0u};
            if (r < Z_IN) *(v4u*)(wl + WL_IN + (size_t)IN_COLS * D * 2 + (size_t)r * 16) = z;
            else { r -= Z_IN; const int hh = r / (64 * QRANK / 8), q = r % (64 * QRANK / 8); *(v4u*)(wl + WL_UQ + ((size_t)(256 * hh + 192) * QRANK) * 2 + (size_t)q * 16) = z; } }
    }
    __syncthreads();
    LAS float* cond = (LAS float*)F.lds;
    for (int i = F.tid; i < 2 * D; i += NTHREADS) cond[i] = silu_f(FIN(I_C)[i]);
    __syncthreads();
    {
        const int gt = F.bid * NTHREADS + F.tid, nt = F.G * NTHREADS;
        float* part = WSP(float, WS_MODP);
        for (int it = gt; it < DEPTH * 16 * 3072; it += nt) {
            const int n4 = it % 3072, ks = (it / 3072) % 16, l = it / (3072 * 16);
            const float* w = FIN(I_WADA) + ((size_t)l * D + ks * 128) * (6 * D) + n4 * 4;
            f32x4 a0 = {0.f, 0.f, 0.f, 0.f}, a1 = {0.f, 0.f, 0.f, 0.f};
#pragma unroll 8
            for (int k = 0; k < 128; ++k) { const f32x4 wv = *(const f32x4*)(w + (size_t)k * (6 * D)); a0 += cond[ks * 128 + k] * wv; a1 += cond[D + ks * 128 + k] * wv; }
            *(f32x4*)(part + ((size_t)(l * 16 + ks) * 2 + 0) * (6 * D) + n4 * 4) = a0;
            *(f32x4*)(part + ((size_t)(l * 16 + ks) * 2 + 1) * (6 * D) + n4 * 4) = a1;
        }
    }
    __syncthreads();
}
__device__ __forceinline__ void ph_modreduce(Frame& F) {
    const int gt = F.bid * NTHREADS + F.tid, nt = F.G * NTHREADS;
    const float* part = WSP(float, WS_MODP); float* mod = WSP(float, WS_MOD);
    for (int i = gt; i < DEPTH * 2 * 6 * D; i += nt) { const int n = i % (6 * D), b = (i / (6 * D)) & 1, l = i / (12 * D);
        float s = FIN(I_BADA)[l * 6 * D + n];
#pragma unroll
        for (int ks = 0; ks < 16; ++ks) s += part[((size_t)(l * 16 + ks) * 2 + b) * (6 * D) + n];
        mod[i] = s; }
    { float* ct = WSP(float, WS_COS); float* st = WSP(float, WS_SIN);
      for (int i = gt; i < M * 32; i += nt) { const float ang = (float)F.pos[i >> 5] * ROPE_INV[i & 31];
          const double rev = (double)ang * 0.15915494309189535; const float fr = (float)(rev - floor(rev));
          ct[i] = __builtin_amdgcn_cosf(fr); st[i] = __builtin_amdgcn_sinf(fr); } }
    if (gt < M / 64) { int mn = 0x7fffffff, mx = -0x7fffffff - 1;
        for (int i = 0; i < 64; ++i) { const int p = F.pos[gt * 64 + i]; mn = p < mn ? p : mn; mx = p > mx ? p : mx; }
        int* mm = WSP(int, WS_POSMM); mm[gt * 2] = mn; mm[gt * 2 + 1] = mx; }
}
__device__ __forceinline__ void ph_norm(Frame& F, int l, const float* xsrc, int sh_off, int sc_off) {
    const float* mod = WSP(float, WS_MOD) + (size_t)l * 12 * D; bf16* H = WSP(bf16, WS_H);
    for (int row = F.gw; row < M; row += F.ngw) {
        const int b = row >> 13;
        const f32x4* xr = (const f32x4*)(xsrc + (size_t)row * D) + F.lane;
        f32x4 v[8]; float s = 0.f;
#pragma unroll
        for (int j = 0; j < 8; ++j) { v[j] = xr[64 * j]; s += (v[j].x * v[j].x + v[j].y * v[j].y) + (v[j].z * v[j].z + v[j].w * v[j].w); }
        const float r = rsqrtf(wave_sum(s) * (1.f / D) + EPS);
        const float* mb = mod + (size_t)b * 6 * D;
        unsigned long long* o8 = (unsigned long long*)(H + (size_t)row * D) + F.lane;
#pragma unroll
        for (int j = 0; j < 8; ++j) { const int c = 4 * F.lane + 256 * j;
            const f32x4 sc = *(const f32x4*)(mb + sc_off + c), sh = *(const f32x4*)(mb + sh_off + c);
            const f32x4 y = v[j] * r * (1.0f + sc) + sh;
            o8[64 * j] = (unsigned long long)pk2(y.x, y.y) | ((unsigned long long)pk2(y.z, y.w) << 32); }
    }
}

namespace fa {
#ifndef PIPE_MLA
#define PIPE_MLA 1
#endif
#ifndef PIPE_LIN
#define PIPE_LIN 0
#endif
#ifndef PIPE_GEN
#define PIPE_GEN 0
#endif
#ifndef PIPE_OLD64
#define PIPE_OLD64 0
#endif
template <typename T> __device__ __forceinline__ T ldg(const void* base, unsigned off) { return *(const T*)((const char*)base + off); }
template <typename T> __device__ __forceinline__ void stg(void* base, unsigned off, T v) { *(T*)((char*)base + off) = v; }
constexpr int crowc(int r) { return (r & 3) + 8 * (r >> 2); }
using s16x4 = __attribute__((ext_vector_type(4))) short;
using f32x8 = __attribute__((ext_vector_type(8))) float;
constexpr int QBLK = 32, KVBLK = 64, DV = 128;
constexpr int SHM_V = KVBLK * DV * 2;
constexpr float THR = 11.5f;
#define FA_SBAR() __builtin_amdgcn_sched_barrier(0)
__device__ __forceinline__ unsigned cvtpk(float lo, float hi) { unsigned r; asm volatile("v_cvt_pk_bf16_f32 %0, %1, %2" : "=v"(r) : "v"(lo), "v"(hi)); return r; }
__device__ __forceinline__ int kswz(int row, int colB) { return (colB >> 7) * 8192 + row * 128 + ((colB & 127) ^ (((row >> 1) & 7) << 4)); }
__device__ __forceinline__ int v_st(int k, int c) { const int kk = (k & ~0xC) | ((k & 4) << 1) | ((k & 8) >> 1); return ((kk >> 3) * 4 + (c >> 5)) * 512 + ((kk & 7) * 32 + (c & 31)) * 2; }
__device__ __forceinline__ int v_st_nat(int k, int c) { return ((k >> 3) * 4 + (c >> 5)) * 512 + ((k & 7) * 32 + (c & 31)) * 2; }
__device__ __forceinline__ int v_rd_base(int lane) { return ((lane & 3) << 3) | (((lane >> 2) & 3) << 6) | (((lane >> 4) & 1) << 5) | (((lane >> 5) & 1) << 8); }
constexpr int v_rd_off(int d0, int ks, int half) { return d0 * 512 + ks * 4096 + half * 2048; }
template <int OFF> __device__ __forceinline__ s16x4 tr_read(int vb) { s16x4 r; asm volatile("ds_read_b64_tr_b16 %0, %1 offset:%2" : "=&v"(r) : "v"(vb), "i"(OFF) : "memory"); return r; }
template <int D0> __device__ __forceinline__ void pv_one(f32x16& od, int vb, bf16x8 pa0, bf16x8 pa1, bf16x8 pa2, bf16x8 pa3) {
    const s16x4 l0 = tr_read<v_rd_off(D0, 0, 0)>(vb), h0 = tr_read<v_rd_off(D0, 0, 1)>(vb), l1 = tr_read<v_rd_off(D0, 1, 0)>(vb), h1 = tr_read<v_rd_off(D0, 1, 1)>(vb);
    const s16x4 l2 = tr_read<v_rd_off(D0, 2, 0)>(vb), h2 = tr_read<v_rd_off(D0, 2, 1)>(vb), l3 = tr_read<v_rd_off(D0, 3, 0)>(vb), h3 = tr_read<v_rd_off(D0, 3, 1)>(vb);
    asm volatile("s_waitcnt lgkmcnt(0)" ::: "memory"); FA_SBAR();
#define FA_PK(L, H) (bf16x8){L[0], L[1], L[2], L[3], H[0], H[1], H[2], H[3]}
    od = __builtin_amdgcn_mfma_f32_32x32x16_bf16(pa0, FA_PK(l0, h0), od, 0, 0, 0);
    od = __builtin_amdgcn_mfma_f32_32x32x16_bf16(pa1, FA_PK(l1, h1), od, 0, 0, 0);
    od = __builtin_amdgcn_mfma_f32_32x32x16_bf16(pa2, FA_PK(l2, h2), od, 0, 0, 0);
    od = __builtin_amdgcn_mfma_f32_32x32x16_bf16(pa3, FA_PK(l3, h3), od, 0, 0, 0);
#undef FA_PK
}
__device__ __forceinline__ void pv_d0(f32x16* o, int vb, bf16x8 pa0, bf16x8 pa1, bf16x8 pa2, bf16x8 pa3) {
    pv_one<0>(o[0], vb, pa0, pa1, pa2, pa3); pv_one<1>(o[1], vb, pa0, pa1, pa2, pa3); pv_one<2>(o[2], vb, pa0, pa1, pa2, pa3); pv_one<3>(o[3], vb, pa0, pa1, pa2, pa3);
}
template <int D0> __device__ __forceinline__ void pv_reads(s16x4 (&l)[4], s16x4 (&h)[4], int vb) {
    l[0] = tr_read<v_rd_off(D0, 0, 0)>(vb); h[0] = tr_read<v_rd_off(D0, 0, 1)>(vb); l[1] = tr_read<v_rd_off(D0, 1, 0)>(vb); h[1] = tr_read<v_rd_off(D0, 1, 1)>(vb);
    l[2] = tr_read<v_rd_off(D0, 2, 0)>(vb); h[2] = tr_read<v_rd_off(D0, 2, 1)>(vb); l[3] = tr_read<v_rd_off(D0, 3, 0)>(vb); h[3] = tr_read<v_rd_off(D0, 3, 1)>(vb);
}
__device__ __forceinline__ void pv_mfma(f32x16& od, const s16x4 (&l)[4], const s16x4 (&h)[4], bf16x8 pa0, bf16x8 pa1, bf16x8 pa2, bf16x8 pa3) {
#define FA_PK(L, H) (bf16x8){L[0], L[1], L[2], L[3], H[0], H[1], H[2], H[3]}
    od = __builtin_amdgcn_mfma_f32_32x32x16_bf16(pa0, FA_PK(l[0], h[0]), od, 0, 0, 0);
    od = __builtin_amdgcn_mfma_f32_32x32x16_bf16(pa1, FA_PK(l[1], h[1]), od, 0, 0, 0);
    od = __builtin_amdgcn_mfma_f32_32x32x16_bf16(pa2, FA_PK(l[2], h[2]), od, 0, 0, 0);
    od = __builtin_amdgcn_mfma_f32_32x32x16_bf16(pa3, FA_PK(l[3], h[3]), od, 0, 0, 0);
#undef FA_PK
}
__device__ __forceinline__ void pv_d0_pipe(f32x16* o, int vb, bf16x8 pa0, bf16x8 pa1, bf16x8 pa2, bf16x8 pa3) {
    s16x4 la[4], ha[4], lb[4], hb[4];
    pv_reads<0>(la, ha, vb); pv_reads<1>(lb, hb, vb);
    asm volatile("s_waitcnt lgkmcnt(8)" ::: "memory"); FA_SBAR(); pv_mfma(o[0], la, ha, pa0, pa1, pa2, pa3); FA_SBAR();
    pv_reads<2>(la, ha, vb);
    asm volatile("s_waitcnt lgkmcnt(8)" ::: "memory"); FA_SBAR(); pv_mfma(o[1], lb, hb, pa0, pa1, pa2, pa3); FA_SBAR();
    pv_reads<3>(lb, hb, vb);
    asm volatile("s_waitcnt lgkmcnt(8)" ::: "memory"); FA_SBAR(); pv_mfma(o[2], la, ha, pa0, pa1, pa2, pa3); FA_SBAR();
    asm volatile("s_waitcnt lgkmcnt(0)" ::: "memory"); FA_SBAR(); pv_mfma(o[3], lb, hb, pa0, pa1, pa2, pa3);
}
__device__ __forceinline__ void partialSM(f32x16& p0, f32x16& p1, float& m_reg, float& alpha) {
    float pmax = p0[0];
#pragma unroll
    for (int r = 1; r < 16; ++r) pmax = fmaxf(pmax, p0[r]);
#pragma unroll
    for (int r = 0; r < 16; ++r) pmax = fmaxf(pmax, p1[r]);
    { auto rr = __builtin_amdgcn_permlane32_swap(__float_as_uint(pmax), __float_as_uint(pmax), false, false); pmax = fmaxf(__uint_as_float(rr[0]), __uint_as_float(rr[1])); }
    float mn;
    if (__builtin_expect(__all(pmax - m_reg <= THR), 1)) { mn = m_reg; alpha = 1.f; }
    else { mn = fmaxf(m_reg, pmax); alpha = __builtin_amdgcn_exp2f(m_reg - mn); m_reg = mn; }
#pragma unroll
    for (int r = 0; r < 16; ++r) { p0[r] -= mn; p1[r] -= mn; }
#pragma unroll
    for (int r = 0; r < 16; ++r) p0[r] = __builtin_amdgcn_exp2f(p0[r]);
}
__device__ __forceinline__ void finishSM(f32x16& p0, f32x16& p1, float alpha, float& l_reg, bf16x8& pa0, bf16x8& pa1, bf16x8& pa2, bf16x8& pa3) {
#pragma unroll
    for (int r = 0; r < 16; ++r) p1[r] = __builtin_amdgcn_exp2f(p1[r]);
    float ps = 0;
#pragma unroll
    for (int r = 0; r < 16; ++r) ps += p0[r];
#pragma unroll
    for (int r = 0; r < 16; ++r) ps += p1[r];
    { auto rr = __builtin_amdgcn_permlane32_swap(__float_as_uint(ps), __float_as_uint(ps), false, false); ps = __uint_as_float(rr[0]) + __uint_as_float(rr[1]); }
    l_reg = l_reg * alpha + ps;
#define FA_PK4(P, BASE, OUT) do { unsigned a0 = cvtpk(P[BASE + 0], P[BASE + 1]), a1 = cvtpk(P[BASE + 2], P[BASE + 3]);   \
    unsigned b0 = cvtpk(P[BASE + 4], P[BASE + 5]), b1 = cvtpk(P[BASE + 6], P[BASE + 7]);                              \
    auto r0 = __builtin_amdgcn_permlane32_swap(a0, b0, false, false); auto r1 = __builtin_amdgcn_permlane32_swap(a1, b1, false, false); \
    u32x4_t w = {r0[0], r1[0], r0[1], r1[1]}; OUT = __builtin_bit_cast(bf16x8, w); } while (0)
    typedef unsigned u32x4_t __attribute__((ext_vector_type(4)));
    FA_PK4(p0, 0, pa0); FA_PK4(p0, 8, pa1); FA_PK4(p1, 0, pa2); FA_PK4(p1, 8, pa3);
#undef FA_PK4
}
template <bool ALIBI> __device__ __forceinline__ void fr_init(f32x16& p0, f32x16& p1, const LAS float* posl, float posq, float slope2, bool linear, int hi) {
    if (linear) {
        const float cl = -slope2 * posq;
#pragma unroll
        for (int g = 0; g < 4; ++g) { const f32x4 k0 = *(const LAS f32x4*)(posl + 8 * g + 4 * hi), k1 = *(const LAS f32x4*)(posl + 32 + 8 * g + 4 * hi);
#pragma unroll
            for (int e = 0; e < 4; ++e) { p0[4 * g + e] = fmaf(slope2, k0[e], cl); p1[4 * g + e] = fmaf(slope2, k1[e], cl); } }
    } else {
#pragma unroll
        for (int g = 0; g < 4; ++g) { const f32x4 k0 = *(const LAS f32x4*)(posl + 8 * g + 4 * hi), k1 = *(const LAS f32x4*)(posl + 32 + 8 * g + 4 * hi);
#pragma unroll
            for (int e = 0; e < 4; ++e) { p0[4 * g + e] = -slope2 * fabsf(posq - k0[e]); p1[4 * g + e] = -slope2 * fabsf(posq - k1[e]); } }
    }
}
__device__ __forceinline__ void fr_softmax(f32x16& p0, f32x16& p1, float& l_reg, bf16x8& pa0, bf16x8& pa1, bf16x8& pa2, bf16x8& pa3) {
#pragma unroll
    for (int r = 0; r < 16; ++r) { p0[r] = __builtin_amdgcn_exp2f(p0[r]); p1[r] = __builtin_amdgcn_exp2f(p1[r]); }
    float sa = 0.f, sb = 0.f;
#pragma unroll
    for (int r = 0; r < 16; ++r) { sa += p0[r]; sb += p1[r]; }
    l_reg += sa + sb;
    typedef unsigned u32x4_t __attribute__((ext_vector_type(4)));
#define FA_PKS(P, BASE, OUT) do { u32x4_t w = {cvtpk(P[BASE + 0], P[BASE + 1]), cvtpk(P[BASE + 2], P[BASE + 3]), cvtpk(P[BASE + 4], P[BASE + 5]), cvtpk(P[BASE + 6], P[BASE + 7])}; OUT = __builtin_bit_cast(bf16x8, w); } while (0)
    FA_PKS(p0, 0, pa0); FA_PKS(p0, 8, pa1); FA_PKS(p1, 0, pa2); FA_PKS(p1, 8, pa3);
#undef FA_PKS
}
template <int DQK> struct Lds {
    static constexpr int SHM_K = KVBLK * DQK * 2;
    static constexpr int V_OFF = 0, K_OFF = 2 * SHM_V, POS_OFF = K_OFF + 2 * SHM_K, WS_OFF = POS_OFF + 2 * 256, END = WS_OFF + 8 * 256;
};
template <int DQK, bool INIT = true> __device__ __forceinline__ void qkt(f32x16& p0, f32x16& p1, const LAS unsigned char* Ks, const bf16x8* qr, int r32, int hi) {
    if (INIT) { p0 = f32x16{}; p1 = f32x16{}; }
#pragma unroll
    for (int d0 = 0; d0 < DQK / 16; ++d0) { const int cb = (d0 * 16 + hi * 8) * 2;
        const bf16x8 b0 = *(const LAS bf16x8*)(Ks + kswz(r32, cb));
        const bf16x8 b1 = *(const LAS bf16x8*)(Ks + kswz(32 + r32, cb));
        p0 = __builtin_amdgcn_mfma_f32_32x32x16_bf16(b0, qr[d0], p0, 0, 0, 0);
        p1 = __builtin_amdgcn_mfma_f32_32x32x16_bf16(b1, qr[d0], p1, 0, 0, 0);
        if (DQK > 64 && (d0 & 3) == 3) FA_SBAR(); }
}
template <int OFF> __device__ __forceinline__ bf16x8 k_read(int addr) { bf16x8 r; asm volatile("ds_read_b128 %0, %1 offset:%2" : "=&v"(r) : "v"(addr), "i"(OFF) : "memory"); return r; }
__device__ __forceinline__ void k_bases(int (&ka)[4], const LAS unsigned char* K_lds, int r32, int hi) {
#pragma unroll
    for (int j = 0; j < 4; ++j) ka[j] = (int)(uintptr_t)K_lds + r32 * 128 + ((j * 32 + hi * 16) ^ (((r32 >> 1) & 7) << 4));
}
#define FA_LGK(n) asm volatile("s_waitcnt lgkmcnt(" #n ")" ::: "memory")
template <int DQK, int BOFF, int VAR = 0> __device__ __forceinline__ void qkt_pipe(f32x16& p0, f32x16& p1, const int (&ka)[4], const bf16x8* qr) {
    if constexpr (DQK == 64) {
        bf16x8 a0 = k_read<BOFF>(ka[0]), b0 = k_read<BOFF + 4096>(ka[0]), a1 = k_read<BOFF>(ka[1]), b1 = k_read<BOFF + 4096>(ka[1]);
        bf16x8 a2 = k_read<BOFF>(ka[2]), b2 = k_read<BOFF + 4096>(ka[2]), a3 = k_read<BOFF>(ka[3]), b3 = k_read<BOFF + 4096>(ka[3]);
        FA_LGK(6); FA_SBAR(); p0 = __builtin_amdgcn_mfma_f32_32x32x16_bf16(a0, qr[0], p0, 0, 0, 0); p1 = __builtin_amdgcn_mfma_f32_32x32x16_bf16(b0, qr[0], p1, 0, 0, 0); FA_SBAR();
        FA_LGK(4); FA_SBAR(); p0 = __builtin_amdgcn_mfma_f32_32x32x16_bf16(a1, qr[1], p0, 0, 0, 0); p1 = __builtin_amdgcn_mfma_f32_32x32x16_bf16(b1, qr[1], p1, 0, 0, 0); FA_SBAR();
        FA_LGK(2); FA_SBAR(); p0 = __builtin_amdgcn_mfma_f32_32x32x16_bf16(a2, qr[2], p0, 0, 0, 0); p1 = __builtin_amdgcn_mfma_f32_32x32x16_bf16(b2, qr[2], p1, 0, 0, 0); FA_SBAR();
        FA_LGK(0); FA_SBAR(); p0 = __builtin_amdgcn_mfma_f32_32x32x16_bf16(a3, qr[3], p0, 0, 0, 0); p1 = __builtin_amdgcn_mfma_f32_32x32x16_bf16(b3, qr[3], p1, 0, 0, 0); FA_SBAR();
    } else {
        static_assert(DQK == 192, "qkt_pipe: d = 64 or 192");
#define FA_KG(G, x0, y0, x1, y1) do { x0 = k_read<BOFF + ((2 * (G)) >> 2) * 8192>(ka[(2 * (G)) & 3]); y0 = k_read<BOFF + ((2 * (G)) >> 2) * 8192 + 4096>(ka[(2 * (G)) & 3]); \
        x1 = k_read<BOFF + ((2 * (G) + 1) >> 2) * 8192>(ka[(2 * (G) + 1) & 3]); y1 = k_read<BOFF + ((2 * (G) + 1) >> 2) * 8192 + 4096>(ka[(2 * (G) + 1) & 3]); } while (0)
#define FA_KM(G, x0, y0, x1, y1) do { FA_SBAR(); if (VAR == 6) { p0 = __builtin_amdgcn_mfma_f32_32x32x16_bf16(x0 ^ y0 ^ x1 ^ y1, qr[2 * (G)], p0, 0, 0, 0); } else { \
        p0 = __builtin_amdgcn_mfma_f32_32x32x16_bf16(x0, qr[2 * (G)], p0, 0, 0, 0); p1 = __builtin_amdgcn_mfma_f32_32x32x16_bf16(y0, qr[2 * (G)], p1, 0, 0, 0); \
        p0 = __builtin_amdgcn_mfma_f32_32x32x16_bf16(x1, qr[2 * (G) + 1], p0, 0, 0, 0); p1 = __builtin_amdgcn_mfma_f32_32x32x16_bf16(y1, qr[2 * (G) + 1], p1, 0, 0, 0); } FA_SBAR(); } while (0)
        bf16x8 a0, b0, a1, b1, c0, d0, c1, d1;
        if constexpr (VAR == 5) {
#pragma unroll
            for (int g = 0; g < 12; ++g) { FA_SBAR(); p0 = __builtin_amdgcn_mfma_f32_32x32x16_bf16(qr[(g + 1) % 12], qr[g], p0, 0, 0, 0); p1 = __builtin_amdgcn_mfma_f32_32x32x16_bf16(qr[(g + 5) % 12], qr[g], p1, 0, 0, 0); FA_SBAR(); }
            return; }
        FA_KG(0, a0, b0, a1, b1); FA_KG(1, c0, d0, c1, d1);
        FA_LGK(4); FA_KM(0, a0, b0, a1, b1); FA_KG(2, a0, b0, a1, b1);
        FA_LGK(4); FA_KM(1, c0, d0, c1, d1); FA_KG(3, c0, d0, c1, d1);
        FA_LGK(4); FA_KM(2, a0, b0, a1, b1); FA_KG(4, a0, b0, a1, b1);
        FA_LGK(4); FA_KM(3, c0, d0, c1, d1); FA_KG(5, c0, d0, c1, d1);
        FA_LGK(4); FA_KM(4, a0, b0, a1, b1);
        FA_LGK(0); FA_KM(5, c0, d0, c1, d1);
#undef FA_KG
#undef FA_KM
    }
}
template <bool ALIBI> __device__ __forceinline__ void fixup(f32x16& p0, f32x16& p1, const LAS float* posl, float posq, float slope2, bool masked, int hi) {
    if (ALIBI) {
#pragma unroll
        for (int g = 0; g < 4; ++g) { const f32x4 k0 = *(const LAS f32x4*)(posl + 8 * g + 4 * hi), k1 = *(const LAS f32x4*)(posl + 32 + 8 * g + 4 * hi);
#pragma unroll
            for (int e = 0; e < 4; ++e) { p0[4 * g + e] = fmaf(-slope2, fabsf(posq - k0[e]), p0[4 * g + e]); p1[4 * g + e] = fmaf(-slope2, fabsf(posq - k1[e]), p1[4 * g + e]); } }
    }
    if (masked) {
#pragma unroll
        for (int r = 0; r < 16; ++r) { p0[r] = -INFINITY; p1[r] = -INFINITY; }
    }
}
template <int DQK, bool ALIBI, int NSLOT, int MODE = 0, int VAR = 0>
__device__ __forceinline__ void attn_pass(const bf16* __restrict__ Qb, const bf16* __restrict__ Kh, const bf16* __restrict__ Vh, const int* __restrict__ posb, float slope2, float cref, int TL, int q0, int T0, int NT,
                                          LAS unsigned char* lds, int tid_, f32x16 (&o)[4], float& l_out) {
    typedef Lds<DQK> L; constexpr int KSUB = DQK / 64, SHM_K = L::SHM_K;
    const int wid = __builtin_amdgcn_readfirstlane(tid_ >> 6); int lane; asm volatile("v_mbcnt_lo_u32_b32 %0, -1, 0\n\tv_mbcnt_hi_u32_b32 %0, -1, %0" : "=v"(lane));
    const int tid = wid * 64 + lane, r32 = lane & 31, hi = lane >> 5;
    if (wid >= 4) __builtin_amdgcn_s_setprio(1);
    LAS unsigned char* V_lds = lds + L::V_OFF; LAS unsigned char* K_lds = lds + L::K_OFF; LAS float* P_lds = (LAS float*)(lds + L::POS_OFF);
    LAS float* al_l = (LAS float*)(lds + L::WS_OFF) + wid * 64;
    float m_reg = -1e30f, l_reg = 0.f;
#pragma unroll
    for (int d = 0; d < 4; ++d) o[d] = f32x16{};
    bf16x8 qr[DQK / 16];
    { const bf16* Qw = Qb + (size_t)(wid * QBLK) * DQK; unsigned qgo = (unsigned)(r32 * DQK + hi * 8) * 2u; asm volatile("" : "+v"(qgo));
#pragma unroll
      for (int d0 = 0; d0 < DQK / 16; ++d0) qr[d0] = ldg<bf16x8>(Qw + d0 * 16, qgo); }
    const float posq = ALIBI ? (float)posb[q0 + wid * QBLK + r32] : 0.f;
    const int tmax = NT - 4 + (wid >> 1);
    const int sr = tid >> 4, sc = (tid & 15) * 8, vst0 = MODE == 5 ? v_st_nat(sr, sc) : v_st(sr, sc), vst1 = MODE == 5 ? v_st_nat(32 + sr, sc) : v_st(32 + sr, sc);
    const int kr = tid >> 3, kc = (tid & 7) * 8, kst = kswz(kr, kc * 2);
    unsigned vgo = (unsigned)(sr * DV + sc) * 2u, kgo = (unsigned)(kr * DQK + kc) * 2u, pgo = (unsigned)(tid & 63) * 4u; asm volatile("" : "+v"(vgo), "+v"(kgo), "+v"(pgo));
    const int vb0 = (int)(uintptr_t)V_lds + v_rd_base(lane);
    int ka[4]; k_bases(ka, K_lds, r32, hi);
    struct Slot { bf16x8 vs0, vs1, ks[KSUB]; int ps; } sl_[NSLOT];
#define FA_SLOAD(i, k0) do { unsigned kk_ = (unsigned)__builtin_amdgcn_readfirstlane((int)(k0)); asm volatile("" : "+s"(kk_));     \
    const bf16* Vt_ = Vh + (size_t)kk_ * DV; const bf16* Kt_ = Kh + (size_t)kk_ * DQK; \
    sl_[i].vs0 = ldg<bf16x8>(Vt_, vgo); sl_[i].vs1 = ldg<bf16x8>(Vt_ + 32 * DV, vgo); \
    _Pragma("unroll") for (int s_ = 0; s_ < KSUB; ++s_) sl_[i].ks[s_] = ldg<bf16x8>(Kt_ + s_ * 64, kgo); \
    if (ALIBI) sl_[i].ps = ldg<int>(posb + kk_, pgo); } while (0)
#define FA_SWRITE(b, i) do { *(LAS bf16x8*)(V_lds + (b) * SHM_V + vst0) = sl_[i].vs0; *(LAS bf16x8*)(V_lds + (b) * SHM_V + vst1) = sl_[i].vs1; \
    _Pragma("unroll") for (int s_ = 0; s_ < KSUB; ++s_) *(LAS bf16x8*)(K_lds + (b) * SHM_K + s_ * 8192 + kst) = sl_[i].ks[s_]; \
    if (ALIBI) { if (tid < 64) P_lds[(b) * 64 + tid] = (float)sl_[i].ps; } } while (0)
#define FA_RESC(a) do { if (__any((a) < 1.f)) { if (hi == 0) al_l[r32] = (a); asm volatile("s_waitcnt lgkmcnt(0)" ::: "memory"); \
    _Pragma("unroll") for (int d = 0; d < 4; ++d) _Pragma("unroll") for (int r = 0; r < 16; ++r) o[d][r] *= al_l[crow(r, hi)]; } } while (0)
#define FA_COMPUTE(b, t, STAGE) do { bf16x8 pa0, pa1, pa2, pa3; const bool vis_ = (t) <= tmax;     \
    if (vis_) { f32x16 p0, p1; \
    if (MODE == 5) { if (VAR == 3) { p0 = f32x16{}; p1 = f32x16{}; _Pragma("unroll") for (int r_ = 0; r_ < 16; ++r_) { p0[r_] = l_reg; p1[r_] = l_reg; } } \
        else if ((DQK == 192 && PIPE_MLA) || (DQK == 64 && PIPE_OLD64)) { p0 = f32x16{}; p1 = f32x16{}; qkt_pipe<DQK, (b) * SHM_K, (VAR == 5 || VAR == 6) ? VAR : 0>(p0, p1, ka, qr); } else qkt<DQK, true>(p0, p1, K_lds + (b) * SHM_K, qr, r32, hi); fixup<ALIBI>(p0, p1, P_lds + (b) * 64, posq, slope2, false, hi); \
        if (VAR == 1) { l_reg += p0[0] + p1[5]; typedef unsigned u32x4_t __attribute__((ext_vector_type(4))); \
            u32x4_t w0_ = {cvtpk(p0[0], p0[1]), cvtpk(p0[2], p0[3]), cvtpk(p0[4], p0[5]), cvtpk(p0[6], p0[7])}, w1_ = {cvtpk(p0[8], p0[9]), cvtpk(p0[10], p0[11]), cvtpk(p0[12], p0[13]), cvtpk(p0[14], p0[15])}; \
            u32x4_t w2_ = {cvtpk(p1[0], p1[1]), cvtpk(p1[2], p1[3]), cvtpk(p1[4], p1[5]), cvtpk(p1[6], p1[7])}, w3_ = {cvtpk(p1[8], p1[9]), cvtpk(p1[10], p1[11]), cvtpk(p1[12], p1[13]), cvtpk(p1[14], p1[15])}; \
            pa0 = __builtin_bit_cast(bf16x8, w0_); pa1 = __builtin_bit_cast(bf16x8, w1_); pa2 = __builtin_bit_cast(bf16x8, w2_); pa3 = __builtin_bit_cast(bf16x8, w3_); } \
        else fr_softmax(p0, p1, l_reg, pa0, pa1, pa2, pa3); } \
    else { float alpha; qkt<DQK>(p0, p1, K_lds + (b) * SHM_K, qr, r32, hi); fixup<ALIBI>(p0, p1, P_lds + (b) * 64, posq, slope2, false, hi); \
        partialSM(p0, p1, m_reg, alpha); finishSM(p0, p1, alpha, l_reg, pa0, pa1, pa2, pa3); FA_RESC(alpha); } } \
    FA_SBAR(); STAGE; FA_SBAR();     \
    if (vis_) { \
    if (VAR == 2) { l_reg += __builtin_bit_cast(float, pa0[0] | (pa1[1] << 16)) + __builtin_bit_cast(float, pa2[0] | (pa3[1] << 16)); } else \
    if (MODE == 5 && DQK == 64) pv_d0_pipe(o, vb0 + (b) * SHM_V, pa0, pa1, pa2, pa3); else pv_d0(o, vb0 + (b) * SHM_V, pa0, pa1, pa2, pa3); } } while (0)
    constexpr int S1 = NSLOT - 1;
    FA_SLOAD(0, T0 * KVBLK); FA_SWRITE(0, 0); FA_SLOAD(S1, (T0 + 1) * KVBLK); FA_SWRITE(1, S1); FA_SLOAD(0, (T0 + 2) * KVBLK);
    if (NSLOT == 2) FA_SLOAD(1, (T0 + 3) * KVBLK);
    __syncthreads();
    static_assert(NSLOT == 1, "attn_pass: one staging slot");
    for (int j = T0; j < NT; j += 2) {
        FA_COMPUTE(0, j, { if (VAR != 4) if (j > T0) { FA_SWRITE(1, 0); if (j + 2 < NT) FA_SLOAD(0, (j + 2) * KVBLK); } });
        __syncthreads();
        FA_COMPUTE(1, j + 1, { if (VAR != 4) if (j + 2 < NT) { FA_SWRITE(0, 0); FA_SLOAD(0, (j + 3) * KVBLK); } });
        __syncthreads();
    }
    if (MODE == 5) { auto rr = __builtin_amdgcn_permlane32_swap(__float_as_uint(l_reg), __float_as_uint(l_reg), false, false); l_reg = __uint_as_float(rr[0]) + __uint_as_float(rr[1]); }
    __builtin_amdgcn_s_setprio(0);
    l_out = l_reg;
#undef FA_SLOAD
#undef FA_SWRITE
#undef FA_RESC
#undef FA_COMPUTE
}
template <int DQK> struct Lds3 {
    static constexpr int SHM_K = KVBLK * DQK * 2;
    static constexpr int V_OFF = 0, K_OFF = 3 * SHM_V, POS_OFF = K_OFF + 3 * SHM_K, WS_OFF = POS_OFF + 3 * 256, END = WS_OFF + 8 * 256;
};
template <int DQK, bool ALIBI>
__device__ __forceinline__ void attn_pass_stag(const bf16* __restrict__ Qb, const bf16* __restrict__ Kh, const bf16* __restrict__ Vh, const int* __restrict__ posb, float slope2, int q0, int T0, int NT,
                                               LAS unsigned char* lds, int tid, f32x16 (&o)[4], float& l_out) {
    typedef Lds3<DQK> L; constexpr int KSUB = DQK / 64, SHM_K = L::SHM_K;
    const int wid = __builtin_amdgcn_readfirstlane(tid >> 6), lane = tid & 63, r32 = lane & 31, hi = lane >> 5, grp = wid >> 2;
    LAS unsigned char* V_lds = lds + L::V_OFF; LAS unsigned char* K_lds = lds + L::K_OFF; LAS float* P_lds = (LAS float*)(lds + L::POS_OFF);
    float l_reg = 0.f;
#pragma unroll
    for (int d = 0; d < 4; ++d) o[d] = f32x16{};
    bf16x8 qr[DQK / 16];
    { const bf16* Qw = Qb + (size_t)(wid * QBLK) * DQK; unsigned qgo = (unsigned)(r32 * DQK + hi * 8) * 2u; asm volatile("" : "+v"(qgo));
#pragma unroll
      for (int d0 = 0; d0 < DQK / 16; ++d0) qr[d0] = ldg<bf16x8>(Qw + d0 * 16, qgo); }
    const float posq = ALIBI ? (float)posb[q0 + wid * QBLK + r32] : 0.f;
    const int tmax = NT - 4 + (wid >> 1);
    const int sr = tid >> 4, sc = (tid & 15) * 8, vst0 = v_st(sr, sc), vst1 = v_st(32 + sr, sc);
    const int kr = tid >> 3, kc = (tid & 7) * 8, kst = kswz(kr, kc * 2);
    unsigned vgo = (unsigned)(sr * DV + sc) * 2u, kgo = (unsigned)(kr * DQK + kc) * 2u, pgo = (unsigned)(tid & 63) * 4u; asm volatile("" : "+v"(vgo), "+v"(kgo), "+v"(pgo));
    const int vb0 = (int)(uintptr_t)V_lds + v_rd_base(lane);
    struct Slot { bf16x8 vs0, vs1, ks[KSUB]; int ps; } sl_;
#define FS_SLOAD(k0) do { unsigned kk_ = (unsigned)__builtin_amdgcn_readfirstlane((int)(k0)); asm volatile("" : "+s"(kk_)); \
    const bf16* Vt_ = Vh + (size_t)kk_ * DV; const bf16* Kt_ = Kh + (size_t)kk_ * DQK; \
    sl_.vs0 = ldg<bf16x8>(Vt_, vgo); sl_.vs1 = ldg<bf16x8>(Vt_ + 32 * DV, vgo); \
    _Pragma("unroll") for (int s_ = 0; s_ < KSUB; ++s_) sl_.ks[s_] = ldg<bf16x8>(Kt_ + s_ * 64, kgo); \
    if (ALIBI) sl_.ps = ldg<int>(posb + kk_, pgo); } while (0)
#define FS_SWRITE(b) do { *(LAS bf16x8*)(V_lds + (b) * SHM_V + vst0) = sl_.vs0; *(LAS bf16x8*)(V_lds + (b) * SHM_V + vst1) = sl_.vs1; \
    _Pragma("unroll") for (int s_ = 0; s_ < KSUB; ++s_) *(LAS bf16x8*)(K_lds + (b) * SHM_K + s_ * 8192 + kst) = sl_.ks[s_]; \
    if (ALIBI) { if (tid < 64) P_lds[(b) * 64 + tid] = (float)sl_.ps; } } while (0)
    const int nt = NT - T0;
    FS_SLOAD(T0 * KVBLK); FS_SWRITE(0); FS_SLOAD((T0 + 1) * KVBLK); FS_SWRITE(1); FS_SLOAD((T0 + 2) * KVBLK);
    __syncthreads();
#define FS_QKS(j_) do { int b_ = (j_) % 3; asm volatile("" : "+s"(b_)); f32x16 p0, p1; \
    qkt<DQK, true>(p0, p1, K_lds + b_ * SHM_K, qr, r32, hi); fixup<ALIBI>(p0, p1, P_lds + b_ * 64, posq, slope2, T0 + (j_) > tmax, hi); \
    fr_softmax(p0, p1, l_reg, pa0, pa1, pa2, pa3); } while (0)
#define FS_PV(j_) do { int b_ = (j_) % 3; asm volatile("" : "+s"(b_)); pv_d0(o, vb0 + b_ * SHM_V, pa0, pa1, pa2, pa3); } while (0)
#define FS_STAGE(j_) do { const int jn_ = (j_) + 2; if (jn_ < nt) { int bw_ = jn_ % 3; asm volatile("" : "+s"(bw_)); FS_SWRITE(bw_); if (jn_ + 1 < nt) FS_SLOAD((T0 + jn_ + 1) * KVBLK); } } while (0)
    bf16x8 pa0, pa1, pa2, pa3;
    if (grp == 0) {
        for (int j = 0; j < nt; ++j) { FS_QKS(j); __syncthreads(); FS_PV(j); __syncthreads(); FS_STAGE(j); }
        __syncthreads();
    } else {
        pa0 = bf16x8{}; pa1 = bf16x8{}; pa2 = bf16x8{}; pa3 = bf16x8{};
        for (int j = 0; j < nt; ++j) { if (j > 0) FS_PV(j - 1); __syncthreads(); FS_QKS(j); __syncthreads(); FS_STAGE(j); }
        FS_PV(nt - 1); __syncthreads();
    }
#undef FS_QKS
#undef FS_PV
#undef FS_STAGE
    { auto rr = __builtin_amdgcn_permlane32_swap(__float_as_uint(l_reg), __float_as_uint(l_reg), false, false); l_reg = __uint_as_float(rr[0]) + __uint_as_float(rr[1]); }
    l_out = l_reg;
#undef FS_SLOAD
#undef FS_SWRITE
}
template <int DQK, bool ALIBI>
__device__ __forceinline__ void attn_pass_p2(const bf16* __restrict__ Qb, const bf16* __restrict__ Kh, const bf16* __restrict__ Vh, const int* __restrict__ posb, float slope2, int q0, int T0, int NT,
                                             LAS unsigned char* lds, int tid, f32x16 (&o)[4], float& l_out) {
    typedef Lds<DQK> L; constexpr int KSUB = DQK / 64, SHM_K = L::SHM_K;
    const int wid = __builtin_amdgcn_readfirstlane(tid >> 6), lane = tid & 63, r32 = lane & 31, hi = lane >> 5;
    LAS unsigned char* V_lds = lds + L::V_OFF; LAS unsigned char* K_lds = lds + L::K_OFF; LAS float* P_lds = (LAS float*)(lds + L::POS_OFF);
    float l_reg = 0.f;
#pragma unroll
    for (int d = 0; d < 4; ++d) o[d] = f32x16{};
    bf16x8 qr[DQK / 16];
    { const bf16* Qw = Qb + (size_t)(wid * QBLK) * DQK; unsigned qgo = (unsigned)(r32 * DQK + hi * 8) * 2u; asm volatile("" : "+v"(qgo));
#pragma unroll
      for (int d0 = 0; d0 < DQK / 16; ++d0) qr[d0] = ldg<bf16x8>(Qw + d0 * 16, qgo); }
    const float posq = ALIBI ? (float)posb[q0 + wid * QBLK + r32] : 0.f;
    const int tmax = NT - 4 + (wid >> 1);
    const int sr = tid >> 4, sc = (tid & 15) * 8, vst0 = v_st(sr, sc), vst1 = v_st(32 + sr, sc);
    const int kr = tid >> 3, kc = (tid & 7) * 8, kst = kswz(kr, kc * 2);
    unsigned vgo = (unsigned)(sr * DV + sc) * 2u, kgo = (unsigned)(kr * DQK + kc) * 2u, pgo = (unsigned)(tid & 63) * 4u; asm volatile("" : "+v"(vgo), "+v"(kgo), "+v"(pgo));
    const int vb0 = (int)(uintptr_t)V_lds + v_rd_base(lane);
    struct Slot { bf16x8 vs0, vs1, ks[KSUB]; int ps; } sl_;
#define FP_LOADK(t) do { unsigned kk_ = (unsigned)__builtin_amdgcn_readfirstlane((int)((t) * KVBLK)); asm volatile("" : "+s"(kk_)); const bf16* Kt_ = Kh + (size_t)kk_ * DQK; \
    _Pragma("unroll") for (int s_ = 0; s_ < KSUB; ++s_) sl_.ks[s_] = ldg<bf16x8>(Kt_ + s_ * 64, kgo); if (ALIBI) sl_.ps = ldg<int>(posb + kk_, pgo); } while (0)
#define FP_LOADV(t) do { unsigned kk_ = (unsigned)__builtin_amdgcn_readfirstlane((int)((t) * KVBLK)); asm volatile("" : "+s"(kk_)); const bf16* Vt_ = Vh + (size_t)kk_ * DV; \
    sl_.vs0 = ldg<bf16x8>(Vt_, vgo); sl_.vs1 = ldg<bf16x8>(Vt_ + 32 * DV, vgo); } while (0)
#define FP_WRITEK(b) do { _Pragma("unroll") for (int s_ = 0; s_ < KSUB; ++s_) *(LAS bf16x8*)(K_lds + (b) * SHM_K + s_ * 8192 + kst) = sl_.ks[s_]; \
    if (ALIBI) { if (tid < 64) P_lds[(b) * 64 + tid] = (float)sl_.ps; } } while (0)
#define FP_WRITEV(b) do { *(LAS bf16x8*)(V_lds + (b) * SHM_V + vst0) = sl_.vs0; *(LAS bf16x8*)(V_lds + (b) * SHM_V + vst1) = sl_.vs1; } while (0)
#define FP_QK(P0, P1, b, t) do { qkt<DQK, true>(P0, P1, K_lds + (b) * SHM_K, qr, r32, hi); fixup<ALIBI>(P0, P1, P_lds + (b) * 64, posq, slope2, (t) > tmax, hi); } while (0)
    f32x16 pA0, pA1, pB0, pB1; bf16x8 pa0, pa1, pa2, pa3;
    const int nt = NT - T0;
    FP_LOADK(T0); FP_LOADV(T0); FP_WRITEK(0); FP_WRITEV(0); FP_LOADK(T0 + 1); FP_WRITEK(1); FP_LOADK(T0 + 2); FP_LOADV(T0 + 1);
    __syncthreads();
    FP_QK(pA0, pA1, 0, T0);
    __syncthreads();
    for (int r = 0; r < nt; r += 2) {
        if (r + 2 < nt) FP_WRITEK(0);
        FP_WRITEV(1);
        if (r + 3 < nt) FP_LOADK(T0 + r + 3);
        if (r + 2 < nt) FP_LOADV(T0 + r + 2);
        FA_SBAR(); FP_QK(pB0, pB1, 1, T0 + r + 1);
        fr_softmax(pA0, pA1, l_reg, pa0, pa1, pa2, pa3); FA_SBAR();
        pv_d0(o, vb0, pa0, pa1, pa2, pa3);
        __syncthreads();
        if (r + 3 < nt) FP_WRITEK(1);
        if (r + 2 < nt) FP_WRITEV(0);
        if (r + 4 < nt) FP_LOADK(T0 + r + 4);
        if (r + 3 < nt) FP_LOADV(T0 + r + 3);
        FA_SBAR(); if (r + 2 < nt) FP_QK(pA0, pA1, 0, T0 + r + 2);
        fr_softmax(pB0, pB1, l_reg, pa0, pa1, pa2, pa3); FA_SBAR();
        pv_d0(o, vb0 + SHM_V, pa0, pa1, pa2, pa3);
        __syncthreads();
    }
    { auto rr = __builtin_amdgcn_permlane32_swap(__float_as_uint(l_reg), __float_as_uint(l_reg), false, false); l_reg = __uint_as_float(rr[0]) + __uint_as_float(rr[1]); }
    l_out = l_reg;
#undef FP_LOADK
#undef FP_LOADV
#undef FP_WRITEK
#undef FP_WRITEV
#undef FP_QK
}
template <int DQK, bool ALIBI>
__device__ __forceinline__ void attn_pass_dma(const bf16* __restrict__ Qb, const bf16* __restrict__ Kh, const bf16* __restrict__ Vh, const int* __restrict__ posb, const float* __restrict__ posfb,
                                              float slope2, int q0, int T0, int NT, LAS unsigned char* lds, int tid_, f32x16 (&o)[4], float& l_out) {
    typedef Lds3<DQK> L; constexpr int KSUB = DQK / 64, SHM_K = L::SHM_K, NPT = KSUB + 2 + (ALIBI ? 1 : 0);
    const int wid = __builtin_amdgcn_readfirstlane(tid_ >> 6); int lane; asm volatile("v_mbcnt_lo_u32_b32 %0, -1, 0\n\tv_mbcnt_hi_u32_b32 %0, -1, %0" : "=v"(lane));
    const int r32 = lane & 31, hi = lane >> 5;
    LAS unsigned char* V_lds = lds + L::V_OFF; LAS unsigned char* K_lds = lds + L::K_OFF; LAS float* P_lds = (LAS float*)(lds + L::POS_OFF);
    float l_reg = 0.f;
#pragma unroll
    for (int d = 0; d < 4; ++d) o[d] = f32x16{};
    bf16x8 qr[DQK / 16];
    { const bf16* Qw = Qb + (size_t)(wid * QBLK) * DQK; unsigned qgo = (unsigned)(r32 * DQK + hi * 8) * 2u; asm volatile("" : "+v"(qgo));
#pragma unroll
      for (int d0 = 0; d0 < DQK / 16; ++d0) qr[d0] = ldg<bf16x8>(Qw + d0 * 16, qgo); }
    const float posq = ALIBI ? (float)posb[q0 + wid * QBLK + r32] : 0.f;
    const int tmax = NT - 4 + (wid >> 1);
    unsigned ksrc, vsrc, psrc;
    { const int kr = 8 * wid + (lane >> 3), kc = (lane & 7) ^ ((kr >> 1) & 7); ksrc = (unsigned)(kr * DQK + kc * 8) * 2u;
      const int vk = 8 * wid + ((lane & 31) >> 2), vc = (lane >> 5) * 32 + (lane & 3) * 8; vsrc = (unsigned)(vk * DV + vc) * 2u; psrc = (unsigned)lane * 4u;
      asm volatile("" : "+v"(ksrc), "+v"(vsrc), "+v"(psrc)); }
    const int vb0 = (int)(uintptr_t)V_lds + v_rd_base(lane);
#define FD_DMA(t, slot) do { unsigned kk_ = (unsigned)__builtin_amdgcn_readfirstlane((int)((t) * KVBLK)); asm volatile("" : "+s"(kk_)); const int sl_ = (slot); \
    const char* Kt_ = (const char*)(Kh + (size_t)kk_ * DQK); const char* Vt_ = (const char*)(Vh + (size_t)kk_ * DV); \
    _Pragma("unroll") for (int s_ = 0; s_ < KSUB; ++s_) __builtin_amdgcn_global_load_lds((const unsigned*)(Kt_ + s_ * 128 + ksrc), (LAS unsigned*)(K_lds + sl_ * SHM_K + s_ * 8192 + wid * 1024), 16, 0, 0); \
    _Pragma("unroll") for (int q_ = 0; q_ < 2; ++q_) __builtin_amdgcn_global_load_lds((const unsigned*)(Vt_ + q_ * 128 + vsrc), (LAS unsigned*)(V_lds + sl_ * SHM_V + (2 * wid + q_) * 1024), 16, 0, 0); \
    if (ALIBI) __builtin_amdgcn_global_load_lds((const unsigned*)((const char*)(posfb + kk_) + psrc), (LAS unsigned*)(P_lds + sl_ * 64), 4, 0, 0); } while (0)
    const int nt = NT - T0;
    FD_DMA(T0, 0); FD_DMA(T0 + 1, 1);
    asm volatile("s_waitcnt vmcnt(0) lgkmcnt(0)\n\ts_barrier" ::: "memory");
    int slot = 0;
    for (int j = 0; j < nt; ++j) {
        int b = slot; asm volatile("" : "+s"(b));
        if (j + 2 < nt) { int bn = b + 2; bn = bn >= 3 ? bn - 3 : bn; FD_DMA(T0 + j + 2, bn); }
        { f32x16 p0, p1; bf16x8 pa0, pa1, pa2, pa3;
          qkt<DQK, true>(p0, p1, K_lds + b * SHM_K, qr, r32, hi); fixup<ALIBI>(p0, p1, P_lds + b * 64, posq, slope2, T0 + j > tmax, hi);
          fr_softmax(p0, p1, l_reg, pa0, pa1, pa2, pa3); FA_SBAR();
          pv_d0(o, vb0 + b * SHM_V, pa0, pa1, pa2, pa3); }
        if (j + 2 < nt) asm volatile("s_waitcnt vmcnt(%0) lgkmcnt(0)\n\ts_barrier" :: "n"(NPT) : "memory");
        else asm volatile("s_waitcnt vmcnt(0) lgkmcnt(0)\n\ts_barrier" ::: "memory");
        slot = slot == 2 ? 0 : slot + 1;
    }
    { auto rr = __builtin_amdgcn_permlane32_swap(__float_as_uint(l_reg), __float_as_uint(l_reg), false, false); l_reg = __uint_as_float(rr[0]) + __uint_as_float(rr[1]); }
    l_out = l_reg;
#undef FD_DMA
}
__device__ __forceinline__ void row_bcast(float f, LAS float* al, int r32, int hi, float (&rf)[16]) {
    asm volatile("s_waitcnt lgkmcnt(0)" ::: "memory");
    if (hi == 0) al[r32] = f;
    asm volatile("s_waitcnt lgkmcnt(0)" ::: "memory");
#pragma unroll
    for (int r = 0; r < 16; ++r) rf[r] = al[crow(r, hi)];
    asm volatile("s_waitcnt lgkmcnt(0)" ::: "memory");
}

__device__ __forceinline__ void attn_pass_da5(const bf16* __restrict__ Qb, const bf16* __restrict__ Kh, const bf16* __restrict__ Vh, const int* __restrict__ posb, float slope2, int cw, int q0, int T0, int NT,
                                              LAS unsigned char* lds, int tid_, f32x16 (&o)[4], float& l_out) {
    typedef Lds<64> L; constexpr int DQK = 64, SHM_K = L::SHM_K, B_OFF = L::END;
    const int wid = __builtin_amdgcn_readfirstlane(tid_ >> 6); int lane; asm volatile("v_mbcnt_lo_u32_b32 %0, -1, 0\n\tv_mbcnt_hi_u32_b32 %0, -1, %0" : "=v"(lane));
    const int tid = wid * 64 + lane, r32 = lane & 31, hi = lane >> 5;
    LAS unsigned char* V_lds = lds + L::V_OFF; LAS unsigned char* K_lds = lds + L::K_OFF; LAS float* P_lds = (LAS float*)(lds + L::POS_OFF); LAS float* B_lds = (LAS float*)(lds + B_OFF);
    float l_reg = 0.f;
#pragma unroll
    for (int d = 0; d < 4; ++d) o[d] = f32x16{};
    bf16x8 qr[4];
    { const bf16* Qw = Qb + (size_t)(wid * QBLK) * DQK; unsigned qgo = (unsigned)(r32 * DQK + hi * 8) * 2u; asm volatile("" : "+v"(qgo));
#pragma unroll
      for (int d0 = 0; d0 < 4; ++d0) qr[d0] = ldg<bf16x8>(Qw + d0 * 16, qgo); }
    const float posq = (float)posb[q0 + wid * QBLK + r32];
    const float dl = slope2 * (posq - (float)cw);
    const int tmax = NT - 4 + (wid >> 1);
    const int sr = tid >> 4, sc = (tid & 15) * 8, vst0 = v_st_nat(sr, sc), vst1 = v_st_nat(32 + sr, sc);
    const int kr = tid >> 3, kc = (tid & 7) * 8, kst = kswz(kr, kc * 2);
    unsigned vgo = (unsigned)(sr * DV + sc) * 2u, kgo = (unsigned)(kr * DQK + kc) * 2u, pgo = (unsigned)(tid & 63) * 4u; asm volatile("" : "+v"(vgo), "+v"(kgo), "+v"(pgo));
    const int vb0 = (int)(uintptr_t)V_lds + v_rd_base(lane);
    int ka[4]; k_bases(ka, K_lds, r32, hi);
    bf16x8 vs0, vs1, ks0; int ps;
#define FD_SLOAD(k0) do { unsigned kk_ = (unsigned)__builtin_amdgcn_readfirstlane((int)(k0)); asm volatile("" : "+s"(kk_)); \
    const bf16* Vt_ = Vh + (size_t)kk_ * DV; const bf16* Kt_ = Kh + (size_t)kk_ * DQK; \
    vs0 = ldg<bf16x8>(Vt_, vgo); vs1 = ldg<bf16x8>(Vt_ + 32 * DV, vgo); ks0 = ldg<bf16x8>(Kt_, kgo); ps = ldg<int>(posb + kk_, pgo); } while (0)
#define FD_SWRITE(b) do { *(LAS bf16x8*)(V_lds + (b) * SHM_V + vst0) = vs0; *(LAS bf16x8*)(V_lds + (b) * SHM_V + vst1) = vs1; *(LAS bf16x8*)(K_lds + (b) * SHM_K + kst) = ks0; \
    B_lds[(b) * 512 + tid] = slope2 * (float)(ps - cw); if (tid < 64) P_lds[(b) * 64 + tid] = (float)ps; } while (0)
#define FD_LIN(b) do { f32x16 p0, p1; bf16x8 pa0, pa1, pa2, pa3; const LAS float* bl_ = B_lds + (b) * 512 + wid * 64 + 4 * hi; \
    _Pragma("unroll") for (int g = 0; g < 4; ++g) { const f32x4 k0 = *(const LAS f32x4*)(bl_ + 8 * g), k1 = *(const LAS f32x4*)(bl_ + 32 + 8 * g); \
        _Pragma("unroll") for (int e = 0; e < 4; ++e) { p0[4 * g + e] = k0[e]; p1[4 * g + e] = k1[e]; } } \
    if (PIPE_LIN) qkt_pipe<DQK, (b) * SHM_K>(p0, p1, ka, qr); else qkt<DQK, false>(p0, p1, K_lds + (b) * SHM_K, qr, r32, hi); fr_softmax(p0, p1, l_reg, pa0, pa1, pa2, pa3); FA_SBAR(); \
    pv_d0_pipe(o, vb0 + (b) * SHM_V, pa0, pa1, pa2, pa3); } while (0)
#define FD_GEN(b, t) do { if ((t) <= tmax) { f32x16 p0, p1; bf16x8 pa0, pa1, pa2, pa3; \
    _Pragma("unroll") for (int r = 0; r < 16; ++r) { p0[r] = dl; p1[r] = dl; } \
    if (PIPE_GEN) qkt_pipe<DQK, (b) * SHM_K>(p0, p1, ka, qr); else qkt<DQK, false>(p0, p1, K_lds + (b) * SHM_K, qr, r32, hi); fixup<true>(p0, p1, P_lds + (b) * 64, posq, slope2, false, hi); fr_softmax(p0, p1, l_reg, pa0, pa1, pa2, pa3); FA_SBAR(); \
    pv_d0_pipe(o, vb0 + (b) * SHM_V, pa0, pa1, pa2, pa3); } } while (0)
    FD_SLOAD(T0 * KVBLK); FD_SWRITE(0); FD_SLOAD((T0 + 1) * KVBLK); FD_SWRITE(1); FD_SLOAD((T0 + 2) * KVBLK);
    __syncthreads();
    int j = T0;
    for (; j < NT - 4; j += 2) {
        FD_LIN(0);
        __syncthreads();
        FD_SWRITE(0); FD_SLOAD((j + 3) * KVBLK);
        FD_LIN(1);
        __syncthreads();
        FD_SWRITE(1); FD_SLOAD((j + 4) * KVBLK);
    }
    for (; j < NT; j += 2) {
        FD_GEN(0, j);
        __syncthreads();
        if (j + 2 < NT) { FD_SWRITE(0); FD_SLOAD((j + 3) * KVBLK); }
        FD_GEN(1, j + 1);
        __syncthreads();
        if (j + 2 < NT) { FD_SWRITE(1); }
    }
    { auto rr = __builtin_amdgcn_permlane32_swap(__float_as_uint(l_reg), __float_as_uint(l_reg), false, false); l_reg = __uint_as_float(rr[0]) + __uint_as_float(rr[1]); }
    l_out = l_reg;
#undef FD_SLOAD
#undef FD_SWRITE
#undef FD_LIN
#undef FD_GEN
}

__device__ __forceinline__ void attn_pass_da5p(const bf16* __restrict__ Qb, const bf16* __restrict__ Kh, const bf16* __restrict__ Vh, const int* __restrict__ posb, float slope2, int cw, int q0, int T0, int NT,
                                               LAS unsigned char* lds, int tid_, f32x16 (&o)[4], float& l_out) {
    typedef Lds<64> L; constexpr int DQK = 64, SHM_K = L::SHM_K, B_OFF = L::END;
    const int wid = __builtin_amdgcn_readfirstlane(tid_ >> 6); int lane; asm volatile("v_mbcnt_lo_u32_b32 %0, -1, 0\n\tv_mbcnt_hi_u32_b32 %0, -1, %0" : "=v"(lane));
    const int tid = wid * 64 + lane, r32 = lane & 31, hi = lane >> 5;
    if (wid >= 4) __builtin_amdgcn_s_setprio(1);
    LAS unsigned char* V_lds = lds + L::V_OFF; LAS unsigned char* K_lds = lds + L::K_OFF; LAS float* P_lds = (LAS float*)(lds + L::POS_OFF); LAS float* B_lds = (LAS float*)(lds + B_OFF);
    float l_reg = 0.f;
#pragma unroll
    for (int d = 0; d < 4; ++d) o[d] = f32x16{};
    bf16x8 qr[4];
    { const bf16* Qw = Qb + (size_t)(wid * QBLK) * DQK; unsigned qgo = (unsigned)(r32 * DQK + hi * 8) * 2u; asm volatile("" : "+v"(qgo));
#pragma unroll
      for (int d0 = 0; d0 < 4; ++d0) qr[d0] = ldg<bf16x8>(Qw + d0 * 16, qgo); }
    const float posq = (float)posb[q0 + wid * QBLK + r32];
    const float dl = slope2 * (posq - (float)cw);
    const int tmax = NT - 4 + (wid >> 1);
    const int sr = tid >> 4, sc = (tid & 15) * 8, vst0 = v_st_nat(sr, sc), vst1 = v_st_nat(32 + sr, sc);
    const int kr = tid >> 3, kc = (tid & 7) * 8, kst = kswz(kr, kc * 2);
    unsigned vgo = (unsigned)(sr * DV + sc) * 2u, kgo = (unsigned)(kr * DQK + kc) * 2u, pgo = (unsigned)(tid & 63) * 4u; asm volatile("" : "+v"(vgo), "+v"(kgo), "+v"(pgo));
    const int vb0 = (int)(uintptr_t)V_lds + v_rd_base(lane);
    int ka[4]; k_bases(ka, K_lds, r32, hi);
    bf16x8 vs0, vs1, ks0; int ps;
#define FP_LOADV(t) do { unsigned kk_ = (unsigned)__builtin_amdgcn_readfirstlane((int)((t) * KVBLK)); asm volatile("" : "+s"(kk_)); const bf16* Vt_ = Vh + (size_t)kk_ * DV; \
    vs0 = ldg<bf16x8>(Vt_, vgo); vs1 = ldg<bf16x8>(Vt_ + 32 * DV, vgo); } while (0)
#define FP_LOADK(t) do { unsigned kk_ = (unsigned)__builtin_amdgcn_readfirstlane((int)((t) * KVBLK)); asm volatile("" : "+s"(kk_)); ks0 = ldg<bf16x8>(Kh + (size_t)kk_ * DQK, kgo); ps = ldg<int>(posb + kk_, pgo); } while (0)
#define FP_WRITEV(b) do { *(LAS bf16x8*)(V_lds + (b) * SHM_V + vst0) = vs0; *(LAS bf16x8*)(V_lds + (b) * SHM_V + vst1) = vs1; } while (0)
#define FP_WRITEK(b) do { *(LAS bf16x8*)(K_lds + (b) * SHM_K + kst) = ks0; B_lds[(b) * 512 + tid] = slope2 * (float)(ps - cw); if (tid < 64) P_lds[(b) * 64 + tid] = (float)ps; } while (0)
#define FP_BINIT(x0, x1, b) do { const LAS float* bl_ = B_lds + (b) * 512 + wid * 64 + 4 * hi; \
    _Pragma("unroll") for (int g = 0; g < 4; ++g) { const f32x4 k0 = *(const LAS f32x4*)(bl_ + 8 * g), k1 = *(const LAS f32x4*)(bl_ + 32 + 8 * g); \
        _Pragma("unroll") for (int e = 0; e < 4; ++e) { x0[4 * g + e] = k0[e]; x1[4 * g + e] = k1[e]; } } } while (0)
#define FP_QK(x0, x1, t, b) do { if ((t) < NT - 4) { FP_BINIT(x0, x1, b); qkt<DQK, false>(x0, x1, K_lds + (b) * SHM_K, qr, r32, hi); } \
    else { _Pragma("unroll") for (int r = 0; r < 16; ++r) { x0[r] = dl; x1[r] = dl; } qkt<DQK, false>(x0, x1, K_lds + (b) * SHM_K, qr, r32, hi); fixup<true>(x0, x1, P_lds + (b) * 64, posq, slope2, false, hi); } } while (0)
    f32x16 c0, c1;
    {
        FP_LOADV(T0); FP_LOADK(T0);
        bf16x8 vB0, vB1, kB; int pB;
        { unsigned kk_ = (unsigned)__builtin_amdgcn_readfirstlane((int)((T0 + 1) * KVBLK)); asm volatile("" : "+s"(kk_)); const bf16* Vt_ = Vh + (size_t)kk_ * DV;
          vB0 = ldg<bf16x8>(Vt_, vgo); vB1 = ldg<bf16x8>(Vt_ + 32 * DV, vgo); kB = ldg<bf16x8>(Kh + (size_t)kk_ * DQK, kgo); pB = ldg<int>(posb + kk_, pgo); }
        FP_WRITEV(0); FP_WRITEK(0);
        *(LAS bf16x8*)(V_lds + SHM_V + vst0) = vB0; *(LAS bf16x8*)(V_lds + SHM_V + vst1) = vB1; *(LAS bf16x8*)(K_lds + SHM_K + kst) = kB;
        B_lds[512 + tid] = slope2 * (float)(pB - cw); if (tid < 64) P_lds[64 + tid] = (float)pB;
        FP_LOADK(T0 + 2); FP_LOADV(T0 + 2);
        __syncthreads();
        FP_QK(c0, c1, T0, 0);
        __syncthreads();
        FP_WRITEK(0); FP_LOADK(T0 + 3);
    }
    int s = T0;
    for (; s <= NT - 6; ++s) {
        const int b = s & 1, nb = b ^ 1, kof = nb * SHM_K;
        f32x16 n0, n1; bf16x8 pa0, pa1, pa2, pa3;
        FP_BINIT(n0, n1, nb);
        const bf16x8 a0 = k_read<0>(ka[0] + kof), b0 = k_read<4096>(ka[0] + kof), a1 = k_read<0>(ka[1] + kof), b1 = k_read<4096>(ka[1] + kof);
        const bf16x8 a2 = k_read<0>(ka[2] + kof), b2 = k_read<4096>(ka[2] + kof), a3 = k_read<0>(ka[3] + kof), b3 = k_read<4096>(ka[3] + kof);
        float sa = 0.f, sb = 0.f;
#define FP_SM(d) do { _Pragma("unroll") for (int r = 4 * (d); r < 4 * (d) + 4; ++r) { c0[r] = __builtin_amdgcn_exp2f(c0[r]); c1[r] = __builtin_amdgcn_exp2f(c1[r]); sa += c0[r]; sb += c1[r]; } } while (0)
        FA_LGK(6); FA_SBAR(); n0 = __builtin_amdgcn_mfma_f32_32x32x16_bf16(a0, qr[0], n0, 0, 0, 0); n1 = __builtin_amdgcn_mfma_f32_32x32x16_bf16(b0, qr[0], n1, 0, 0, 0); FP_SM(0); FA_SBAR();
        FA_LGK(4); FA_SBAR(); n0 = __builtin_amdgcn_mfma_f32_32x32x16_bf16(a1, qr[1], n0, 0, 0, 0); n1 = __builtin_amdgcn_mfma_f32_32x32x16_bf16(b1, qr[1], n1, 0, 0, 0); FP_SM(1); FA_SBAR();
        FA_LGK(2); FA_SBAR(); n0 = __builtin_amdgcn_mfma_f32_32x32x16_bf16(a2, qr[2], n0, 0, 0, 0); n1 = __builtin_amdgcn_mfma_f32_32x32x16_bf16(b2, qr[2], n1, 0, 0, 0); FP_SM(2); FA_SBAR();
        FA_LGK(0); FA_SBAR(); n0 = __builtin_amdgcn_mfma_f32_32x32x16_bf16(a3, qr[3], n0, 0, 0, 0); n1 = __builtin_amdgcn_mfma_f32_32x32x16_bf16(b3, qr[3], n1, 0, 0, 0); FP_SM(3); FA_SBAR();
#undef FP_SM
        l_reg += sa + sb;
        typedef unsigned u32x4_t __attribute__((ext_vector_type(4)));
#define FA_PKS(P, BASE, OUT) do { u32x4_t w = {cvtpk(P[BASE + 0], P[BASE + 1]), cvtpk(P[BASE + 2], P[BASE + 3]), cvtpk(P[BASE + 4], P[BASE + 5]), cvtpk(P[BASE + 6], P[BASE + 7])}; OUT = __builtin_bit_cast(bf16x8, w); } while (0)
        FA_PKS(c0, 0, pa0); FA_PKS(c0, 8, pa1); FA_PKS(c1, 0, pa2); FA_PKS(c1, 8, pa3);
#undef FA_PKS
        FA_SBAR();
        pv_d0_pipe(o, vb0 + b * SHM_V, pa0, pa1, pa2, pa3);
        __syncthreads();
        FP_WRITEV(b); FP_WRITEK(nb); FP_LOADV(s + 3); FP_LOADK(s + 4);
        c0 = n0; c1 = n1;
    }
    for (; s < NT; ++s) {
        const int b = s & 1, nb = b ^ 1;
        f32x16 n0 = f32x16{}, n1 = f32x16{};
        if (s + 1 < NT && s + 1 <= tmax) FP_QK(n0, n1, s + 1, nb);
        if (s <= tmax) { bf16x8 pa0, pa1, pa2, pa3; fr_softmax(c0, c1, l_reg, pa0, pa1, pa2, pa3); FA_SBAR(); pv_d0_pipe(o, vb0 + b * SHM_V, pa0, pa1, pa2, pa3); }
        __syncthreads();
        if (s + 2 < NT) FP_WRITEV(b);
        if (s + 3 < NT) { FP_WRITEK(nb); FP_LOADV(s + 3); }
        if (s + 4 < NT) FP_LOADK(s + 4);
        c0 = n0; c1 = n1;
    }
    { auto rr = __builtin_amdgcn_permlane32_swap(__float_as_uint(l_reg), __float_as_uint(l_reg), false, false); l_reg = __uint_as_float(rr[0]) + __uint_as_float(rr[1]); }
    __builtin_amdgcn_s_setprio(0);
    l_out = l_reg;
#undef FP_LOADV
#undef FP_LOADK
#undef FP_WRITEV
#undef FP_WRITEK
#undef FP_BINIT
#undef FP_QK
}
}

constexpr int CW_BAR = 4096;
constexpr int CW_Q = 8192;
__device__ __forceinline__ int next_unit(Frame& F, unsigned* ctr) {
    LAS unsigned* uq = (LAS unsigned*)(F.lds + LDSCTL_OFF + 16);
    __syncthreads();
    if (F.tid == 0) *uq = atomicAdd(ctr, 1u);
    __syncthreads();
    return __builtin_amdgcn_readfirstlane((int)*uq);
}
template <int MODE = 0> __device__ __forceinline__ void ph_attn_da(Frame& F, int l, int rep = 0) {
    const bf16 *QD = WSP(bf16, WS_QD), *KD = WSP(bf16, WS_KD), *VD = WSP(bf16, WS_VD);
    bf16* MIX = rep == 2 ? WSP(bf16, WS_U) : WSP(bf16, WS_MIX); float* O1 = WSP(float, WS_O1);
    const int lane = F.lane;
    LAS float* al = (LAS float*)(F.lds + fa::Lds<64>::WS_OFF) + F.wave * 64;
    const float s1 = wave_sum(FIN(I_LQ1)[l * 64 + lane] * FIN(I_LK1)[l * 64 + lane]);
    const float s2 = wave_sum(FIN(I_LQ2)[l * 64 + lane] * FIN(I_LK2)[l * 64 + lane]);
    const float lam_init = __int_as_float(__builtin_amdgcn_readfirstlane(__float_as_int(LAM_INIT[l])));
    const float lam = __int_as_float(__builtin_amdgcn_readfirstlane(__float_as_int(expf(s1) - expf(s2) + lam_init)));
    float gqm = fabsf(FIN(I_DAQG)[l * 64 + lane]), gkm = fabsf(FIN(I_DAKG)[l * 64 + lane]);
    gqm = wave_max(gqm); gkm = wave_max(gkm);
    const float bound = __int_as_float(__builtin_amdgcn_readfirstlane(__float_as_int(1.01f * 11.5416f * gqm * gkm)));
    const float reach = __int_as_float(__builtin_amdgcn_readfirstlane(__float_as_int(2.0f * bound + 160.0f)));
    if ((MODE == 5) != (bound < 40.0f)) return;
    const int* posmm = WSP(int, WS_POSMM);
    unsigned* ctr = (unsigned*)(F.ws + WS_CTL) + (rep == 2 ? 20000 + 64 * (l * 2) : CW_Q + 64 * 8 * (l * 4 + 0 + rep));
    for (;;) {
        const int u = next_unit(F, ctr); if (u >= 384) break;
        const int qb = 31 - u / 12, bh = u % 12, b = bh / NH, h = bh % NH, q0 = qb * 256, NT = q0 / 64 + 4;
        const int* posb = F.pos + b * SEQ;
        const float slope2 = __int_as_float(__builtin_amdgcn_readfirstlane(__float_as_int(ALIBI_SLOPE[h] * LOG2E)));
        const size_t orow = (size_t)(b * SEQ + q0 + F.wave * 32);
        int T0 = 0, TL = 0; bool lin = false;
        { const int* qm = posmm + (size_t)(b * 128 + qb * 4) * 2; int qmin = qm[0], qmax = qm[1];
#pragma unroll
          for (int c = 1; c < 4; ++c) { qmin = qm[2 * c] < qmin ? qm[2 * c] : qmin; qmax = qm[2 * c + 1] > qmax ? qm[2 * c + 1] : qmax; }
          const int* km = posmm + (size_t)(b * 128) * 2;
          for (; T0 < NT - 4; ++T0) { const int kmin = km[2 * T0], kmax = km[2 * T0 + 1]; int dmin = qmin - kmax; if (kmin - qmax > dmin) dmin = kmin - qmax; if (dmin < 0) dmin = 0;
              if (!(slope2 * (float)dmin > reach)) break; }
          T0 &= ~1;
          for (TL = T0; TL < NT; ++TL) if (km[2 * TL + 1] > qmin) break;
          if (TL < NT - 4) TL = T0;
          int span = qm[1] - qm[0];
#pragma unroll
          for (int c = 1; c < 4; ++c) { const int sp = qm[2 * c + 1] - qm[2 * c]; span = sp > span ? sp : span; }
          lin = TL >= NT - 4 && slope2 * (float)span <= 24.0f;
        }
        for (int mp = 0; mp < 2; ++mp) {
            f32x16 o[4]; float l1;
            const bf16* Qp = QD + ((size_t)(bh * 2 + mp) * SEQ + q0) * 64; const int bhk = rep == 2 ? 0 : bh; const bf16* Kp = KD + (size_t)(bhk * 2 + mp) * SEQ * 64; const bf16* Vp = VD + (size_t)bhk * SEQ * 128;
            if (MODE == 5 && lin) { const int cw = posmm[(size_t)(b * 128 + qb * 4 + (__builtin_amdgcn_readfirstlane(F.tid >> 6) >> 1)) * 2];
                fa::attn_pass_da5p(Qp, Kp, Vp, posb, slope2, cw, q0, T0, NT, F.lds, F.tid, o, l1); }
            else fa::attn_pass<64, true, 1, MODE>(Qp, Kp, Vp, posb, slope2, bound, TL, q0, T0, NT, F.lds, F.tid, o, l1);
            int le_; asm volatile("v_mbcnt_lo_u32_b32 %0, -1, 0\n\tv_mbcnt_hi_u32_b32 %0, -1, %0" : "=v"(le_)); const int r32 = le_ & 31, hi = le_ >> 5;
            float f[16];
            if (mp == 0) {
                fa::row_bcast(1.0f / l1, al, r32, hi, f);
                float* ob = O1 + orow * 768 + h * 128; unsigned lo = (unsigned)(4 * hi * 768 + r32) * 4u; asm volatile("" : "+v"(lo));
#pragma unroll
                for (int r2 = 0; r2 < 16; ++r2)
#pragma unroll
                    for (int d = 0; d < 4; ++d) fa::stg<float>(ob, lo + (fa::crowc(r2) * 768 + d * 32) * 4, o[d][r2] * f[r2]);
            } else {
                fa::row_bcast(lam / l1, al, r32, hi, f);
                const float* hg = FIN(I_DAHG) + (size_t)l * 768 + h * 128;
                float hgv[4];
#pragma unroll
                for (int d = 0; d < 4; ++d) hgv[d] = fa::ldg<float>(hg + d * 32, (unsigned)r32 * 4u) * (1.0f - lam_init);
                const float* ob = O1 + orow * 768 + h * 128; unsigned lo = (unsigned)(4 * hi * 768 + r32) * 4u; asm volatile("" : "+v"(lo));
                bf16* mb = MIX + orow * D + h * 128; unsigned mo = (unsigned)(4 * hi * D + r32) * 2u; asm volatile("" : "+v"(mo));
#pragma unroll
                for (int r2 = 0; r2 < 16; ++r2)
#pragma unroll
                    for (int d = 0; d < 4; ++d) o[d][r2] = fa::ldg<float>(ob, lo + (fa::crowc(r2) * 768 + d * 32) * 4) - o[d][r2] * f[r2];
#pragma unroll
                for (int r2 = 0; r2 < 16; ++r2) {
                    float ss = 0.f;
#pragma unroll
                    for (int d = 0; d < 4; ++d) ss += o[d][r2] * o[d][r2];
                    ss = sum32(ss);
                    const float rn = rsqrtf(ss * (1.f / 128) + EPS);
#pragma unroll
                    for (int d = 0; d < 4; ++d) fa::stg<bf16>(mb, mo + (fa::crowc(r2) * D + d * 32) * 2, (bf16)f2bf(o[d][r2] * rn * hgv[d]));
                }
            }
        }
    }
}
template <int MODE> __device__ __forceinline__ void ph_attn_mla(Frame& F, int l, int rep = 0) {
    const bf16 *QM = WSP(bf16, WS_QM), *KM = WSP(bf16, WS_KM), *VM = WSP(bf16, WS_VM);
    bf16* MIX = rep >= 2 ? WSP(bf16, WS_U) : WSP(bf16, WS_MIX);
    const int lane = F.lane;
    LAS float* al = (LAS float*)(F.lds + fa::Lds<192>::WS_OFF) + F.wave * 64;
    float gqm = fmaxf(fmaxf(fabsf(FIN(I_MQG)[l * 192 + lane]), fabsf(FIN(I_MQG)[l * 192 + 64 + lane])), fabsf(FIN(I_MQG)[l * 192 + 128 + lane]));
    float gkm = fmaxf(fmaxf(fabsf(FIN(I_MKG)[l * 192 + lane]), fabsf(FIN(I_MKG)[l * 192 + 64 + lane])), fabsf(FIN(I_MKG)[l * 192 + 128 + lane]));
    gqm = wave_max(gqm); gkm = wave_max(gkm);
    const float bound = __int_as_float(__builtin_amdgcn_readfirstlane(__float_as_int(1.01f * 19.9907f * gqm * gkm)));
    if ((MODE == 5) != (bound < 60.0f)) return;
    unsigned* ctr = (unsigned*)(F.ws + WS_CTL) + (rep >= 2 ? 20000 + 64 * (l * 2 + 1) : CW_Q + 64 * 8 * (l * 4 + 2 + rep));
    for (;;) {
        const int u = next_unit(F, ctr); if (u >= 384) break;
        const int qb = 31 - u / 12, bh = u % 12, b = bh / NH, h = bh % NH, q0 = qb * 256, NT = q0 / 64 + 4;
        const size_t orow = (size_t)(b * SEQ + q0 + F.wave * 32);
        f32x16 o[4]; float l1;
        const int bhk = rep == 2 ? 0 : bh;
#if defined(PROBE_VAR)
        if (rep == 3) fa::attn_pass<192, false, 1, MODE, PROBE_VAR>(QM + ((size_t)bh * SEQ + q0) * 192, KM + (size_t)bhk * SEQ * 192, VM + (size_t)bhk * SEQ * 128, nullptr, 0.f, bound, 0, q0, 0, NT, F.lds, F.tid, o, l1); else
#endif
        fa::attn_pass<192, false, 1, MODE>(QM + ((size_t)bh * SEQ + q0) * 192, KM + (size_t)bhk * SEQ * 192, VM + (size_t)bhk * SEQ * 128, nullptr, 0.f, bound, 0, q0, 0, NT, F.lds, F.tid, o, l1);
        int le_; asm volatile("v_mbcnt_lo_u32_b32 %0, -1, 0\n\tv_mbcnt_hi_u32_b32 %0, -1, %0" : "=v"(le_)); const int r32 = le_ & 31, hi = le_ >> 5;
        float f[16]; fa::row_bcast(1.0f / l1, al, r32, hi, f);
        bf16* mb = MIX + orow * D + 768 + h * 128; unsigned mo = (unsigned)(4 * hi * D + r32) * 2u; asm volatile("" : "+v"(mo));
#pragma unroll
        for (int r2 = 0; r2 < 16; ++r2)
#pragma unroll
            for (int d = 0; d < 4; ++d) fa::stg<bf16>(mb, mo + (fa::crowc(r2) * D + d * 32) * 2, (bf16)f2bf(o[d][r2] * f[r2]));
    }
}
__device__ __forceinline__ void ph_sgu(Frame& F, int l, int rep = 0) {
    const float* UU = WSP(float, WS_UU); const bf16* GV = WSP(bf16, WS_GV); const float* SSQ = WSP(float, WS_SSQ_SGV); bf16* MIX = WSP(bf16, WS_MIX);
    LAS unsigned short* vs = (LAS unsigned short*)F.lds;
    LAS float* rs = (LAS float*)(F.lds + 128 * 128 * 2);
    const int lane = F.lane, r32 = lane & 31, hi = lane >> 5, tm = F.wave >> 1, tn0 = (F.wave & 1) * 2;
    __syncthreads();
    unsigned* sctr = (unsigned*)(F.ws + WS_CTL) + CW_Q + 64 * 8 * 16 + 64 * (l + 4 * rep);
    LAS float* wl = rs + 128;
    for (;;) { const int u = next_unit(F, sctr); if (u >= 512) break;
        const int g = u & 3, row0 = (u >> 2) * 128;
        const int t = 32 * tm + r32;
        const float* bias = FIN(I_SGB) + (l * 4 + g) * 128 + 32 * tm;
        const int c0 = g * 128 + 32 * tn0 + r32;
        float uu0[16], uu1[16], bvv[16];
#pragma unroll
        for (int r = 0; r < 16; ++r) { const int tt = crow(r, hi); const size_t row = (size_t)(row0 + 32 * tm + tt); uu0[r] = UU[row * 512 + c0]; uu1[r] = UU[row * 512 + c0 + 32]; bvv[r] = bias[tt]; }
        { const float* wb = FIN(I_SGW) + (size_t)(l * 4 + g) * 128 * 128;
          f32x4 wv_[8];
#pragma unroll
          for (int k = 0; k < 8; ++k) wv_[k] = *(const f32x4*)(wb + (size_t)(F.tid + k * NTHREADS) * 4);
#pragma unroll
          for (int k = 0; k < 8; ++k) { const int e = (F.tid + k * NTHREADS) * 4, tr = e >> 7, sc_ = e & 127; *(LAS f32x4*)(wl + tr * 132 + sc_) = wv_[k]; } }
        for (int i = F.tid; i < 128 * 16; i += NTHREADS) { const int s = i >> 4, c8 = i & 15; *(LAS bf16x8*)(vs + s * 128 + c8 * 8) = *(const bf16x8*)(GV + (size_t)(row0 + s) * 512 + g * 128 + c8 * 8); }
        if (F.tid < 128) { const f32x4 p = *(const f32x4*)(SSQ + (size_t)(row0 + F.tid) * 16 + g * 4); rs[F.tid] = rsqrtf(((p.x + p.y) + (p.z + p.w)) * (1.f / 128) + EPS); }
        __syncthreads();
        f32x16 acc0 = f32x16{}, acc1 = f32x16{};
        const LAS float* wrow = wl + t * 132;
        for (int ks = 0; ks < 2 * (tm + 1); ++ks) {
            const int s0 = 16 * ks + 8 * hi;
            const f32x4 w0 = *(const LAS f32x4*)(wrow + s0), w1 = *(const LAS f32x4*)(wrow + s0 + 4);
            float wv[8] = {w0.x, w0.y, w0.z, w0.w, w1.x, w1.y, w1.z, w1.w};
            bf16x8 af, b0, b1;
#pragma unroll
            for (int j = 0; j < 8; ++j) { af[j] = (short)f2bf(s0 + j <= t ? wv[j] * rs[s0 + j] : 0.f);
                b0[j] = (short)vs[(s0 + j) * 128 + 32 * tn0 + r32]; b1[j] = (short)vs[(s0 + j) * 128 + 32 * (tn0 + 1) + r32]; }
            acc0 = __builtin_amdgcn_mfma_f32_32x32x16_bf16(af, b0, acc0, 0, 0, 0);
            acc1 = __builtin_amdgcn_mfma_f32_32x32x16_bf16(af, b1, acc1, 0, 0, 0);
        }
#pragma unroll
        for (int r = 0; r < 16; ++r) { const int tt = crow(r, hi); const size_t row = (size_t)(row0 + 32 * tm + tt);
            MIX[row * D + 1536 + c0] = (bf16)f2bf(uu0[r] * (acc0[r] + bvv[r]));
            MIX[row * D + 1536 + c0 + 32] = (bf16)f2bf(uu1[r] * (acc1[r] + bvv[r])); }
        __syncthreads();
    }
}
__device__ __forceinline__ void ph_convfix(Frame& F, int l) {
    const float* EDGE = WSP(float, WS_EDGE); bf16* U = WSP(bf16, WS_U);
    const float* cw = FIN(I_CONVW) + (size_t)l * 3 * NUP; const float* cb = FIN(I_CONVB) + (size_t)l * NUP;
    const int gt = F.bid * NTHREADS + F.tid, nt = F.G * NTHREADS;
    constexpr int NIT = (M / 64) * 2 * (DFF / 4);
    auto item = [&](int i, unsigned long long& pk, size_t& dst) {
        const int ch = (i % (DFF / 4)) * 4, r = (i / (DFF / 4)) & 1, blk = i / (2 * (DFF / 4)); const bool first = (blk % (SEQ / 64)) == 0;
        f32x4 y[2];
#pragma unroll
        for (int bj = 0; bj < 2; ++bj) {
            const float* e0 = EDGE + ((size_t)(blk * 4) * 2 + bj) * DFF + ch;
            const f32x4 z = {0.f, 0.f, 0.f, 0.f};
            const f32x4 a0 = *(const f32x4*)(e0 + (size_t)r * 2 * DFF);
            const f32x4 a1 = r == 1 ? *(const f32x4*)e0 : (first ? z : *(const f32x4*)(e0 - (size_t)1 * 2 * DFF));
            const f32x4 a2 = first ? z : (r == 1 ? *(const f32x4*)(e0 - (size_t)1 * 2 * DFF) : *(const f32x4*)(e0 - (size_t)2 * 2 * DFF));
            y[bj] = *(const f32x4*)(cb + bj * DFF + ch) + *(const f32x4*)(cw + (size_t)2 * NUP + bj * DFF + ch) * a0 + *(const f32x4*)(cw + (size_t)NUP + bj * DFF + ch) * a1 + *(const f32x4*)(cw + bj * DFF + ch) * a2; }
        float o[4];
#pragma unroll
        for (int e = 0; e < 4; ++e) { const float g = y[0][e]; o[e] = g * __builtin_amdgcn_rcpf(1.0f + __expf(-g)) * y[1][e]; }
        pk = (unsigned long long)pk2(o[0], o[1]) | ((unsigned long long)pk2(o[2], o[3]) << 32); dst = (size_t)(blk * 64 + r) * DFF + ch; };
    for (int i = gt; i < NIT; i += 3 * nt) {
        unsigned long long p0 = 0, p1 = 0, p2 = 0; size_t d0 = 0, d1 = 0, d2 = 0;
        const bool h1 = i + nt < NIT, h2 = i + 2 * nt < NIT;
        item(i, p0, d0); if (h1) item(i + nt, p1, d1); if (h2) item(i + 2 * nt, p2, d2);
        *(unsigned long long*)(U + d0) = p0; if (h1) *(unsigned long long*)(U + d1) = p1; if (h2) *(unsigned long long*)(U + d2) = p2; }
}

__device__ __forceinline__ void ph_krope(Frame& F, int l) {
    const bf16* H = WSP(bf16, WS_H); const bf16* Wk = wptr(F, l, WL_IN) + (size_t)4096 * D; float* KR = WSP(float, WS_KR); float* SSQ = WSP(float, WS_SSQ_KR);
    constexpr int PITCH = 1024;
    LAS unsigned char* As = F.lds; LAS unsigned char* Bs = F.lds + 64 * PITCH;
    LAS float* red = (LAS float*)F.lds;
    const int lane = F.lane, r32 = lane & 31, hi = lane >> 5, w = F.wave;
    __syncthreads();
    for (int tb = F.bid; tb < M / 64; tb += F.G) {
        f32x16 acc[2][2];
#pragma unroll
        for (int i = 0; i < 2; ++i)
#pragma unroll
            for (int j = 0; j < 2; ++j) acc[i][j] = f32x16{};
        for (int kc = 0; kc < 4; ++kc) {
#pragma unroll
            for (int p = 0; p < 8; ++p) { const int q = p * NTHREADS + F.tid, row = q >> 6, c16 = q & 63;
                *(LAS v4u*)(As + row * PITCH + (c16 ^ (row & 7)) * 16) = *(const v4u*)(H + (size_t)(tb * 64 + row) * D + kc * 512 + c16 * 8);
                *(LAS v4u*)(Bs + row * PITCH + (c16 ^ (row & 7)) * 16) = *(const v4u*)(Wk + (size_t)row * D + kc * 512 + c16 * 8); }
            __syncthreads();
#pragma unroll
            for (int ks = 0; ks < 4; ++ks) { const int ko = (((w * 64 + ks * 16 + hi * 8) >> 3) ^ (r32 & 7)) * 16;
                const bf16x8 A0 = *(const LAS bf16x8*)(As + r32 * PITCH + ko), A1 = *(const LAS bf16x8*)(As + (32 + r32) * PITCH + ko);
                const bf16x8 B0 = *(const LAS bf16x8*)(Bs + r32 * PITCH + ko), B1 = *(const LAS bf16x8*)(Bs + (32 + r32) * PITCH + ko);
                acc[0][0] = __builtin_amdgcn_mfma_f32_32x32x16_bf16(A0, B0, acc[0][0], 0, 0, 0); acc[0][1] = __builtin_amdgcn_mfma_f32_32x32x16_bf16(A0, B1, acc[0][1], 0, 0, 0);
                acc[1][0] = __builtin_amdgcn_mfma_f32_32x32x16_bf16(A1, B0, acc[1][0], 0, 0, 0); acc[1][1] = __builtin_amdgcn_mfma_f32_32x32x16_bf16(A1, B1, acc[1][1], 0, 0, 0); }
            __syncthreads();
        }
#pragma unroll
        for (int i = 0; i < 2; ++i)
#pragma unroll
            for (int j = 0; j < 2; ++j)
#pragma unroll
                for (int r = 0; r < 16; ++r) red[(w * 64 + (i * 2 + j) * 16 + r) * 64 + lane] = acc[i][j][r];
        __syncthreads();
#pragma unroll
        for (int c = 0; c < 8; ++c) { const int cb = w * 8 + c, i = cb >> 5, j = (cb >> 4) & 1, r = cb & 15;
            float v = 0.f;
#pragma unroll
            for (int ww = 0; ww < 8; ++ww) v += red[(ww * 64 + cb) * 64 + lane];
            const int row = tb * 64 + 32 * i + crow(r, hi);
            KR[(size_t)row * 64 + 32 * j + r32] = v;
            const float ss = sum32(v * v);
            if (r32 == 0) SSQ[(size_t)row * 2 + j] = ss; }
        __syncthreads();
    }
}
__device__ __forceinline__ void frame_init(Frame& F, const Args& a, unsigned char* lds) {
    F.lds = (LAS unsigned char*)lds; F.tid = threadIdx.x; F.lane = F.tid & 63; F.wave = __builtin_amdgcn_readfirstlane(F.tid >> 6); F.wave0 = F.wave;
    F.bid = blockIdx.x; F.G = gridDim.x; F.gw = F.bid * NWAVES + F.wave; F.ngw = F.G * NWAVES;
    F.ka = (const __attribute__((address_space(4))) Args*)__builtin_amdgcn_kernarg_segment_ptr();
    F.pos = (const int*)a.in[I_POS]; F.out = a.out; F.ws = a.ws;
}
__device__ __forceinline__ void frame_retid(Frame& F) {
    int lane; asm volatile("v_mbcnt_lo_u32_b32 %0, -1, 0\n\tv_mbcnt_hi_u32_b32 %0, -1, %0" : "=v"(lane));
    int w = F.wave0; asm volatile("" : "+s"(w));
    F.lane = lane; F.wave = w; F.tid = w * 64 + lane;
    int bid = blockIdx.x, G = gridDim.x; asm volatile("" : "+s"(bid)); asm volatile("" : "+s"(G)); F.bid = bid; F.G = G;
    F.gw = bid * NWAVES + F.wave; F.ngw = G * NWAVES;
}
__device__ __forceinline__ void grid_bar(const XcdBarrier& bar, int wave0) {
    int lane_; asm volatile("v_mbcnt_lo_u32_b32 %0, -1, 0\n\tv_mbcnt_hi_u32_b32 %0, -1, %0" : "=v"(lane_)); const bool leader = (wave0 == 0) && (lane_ == 0);
    XcdBarrier b2 = bar; unsigned z_ = 0u; asm volatile("" : "+s"(b2.x), "+s"(z_)); b2.bar = bar.bar + z_; xcd_barrier(b2, leader); }
template <int PH> __device__ __forceinline__ void run_phase(Frame& F, int l) {
    frame_retid(F); asm volatile("; PHASE_BEGIN %0" :: "n"(PH));
    const float* mod = WSP(float, WS_MOD) + (size_t)l * 12 * D;
    if constexpr (PH == 0) ph_prologue(F);
    if constexpr (PH == 1) ph_modreduce(F);
    if constexpr (PH == 2) ph_norm(F, l, l == 0 ? FIN(I_X) : F.out, 0, D);
    if constexpr (PH == 3) { pg8::Gemm g{WSP(bf16, WS_H), wptr(F, l, WL_IN), M, 4096, D}; pg8::StaticOrder S; S.init(M, 4096, F.G, F.bid);
        pg8::EpiInProj E{WSP(bf16, WS_QD), WSP(bf16, WS_KD), WSP(bf16, WS_VD), WSP(bf16, WS_QA), WSP(bf16, WS_KVA), WSP(bf16, WS_GV), WSP(float, WS_UU), WSP(float, WS_KR),
                         WSP(float, WS_SSQ_QA), WSP(float, WS_SSQ_KVA), WSP(float, WS_SSQ_SGV), WSP(float, WS_SSQ_KR), FIN(I_DAQG) + l * 64, FIN(I_DAKG) + l * 64, FIN(I_QAG) + l * 512, FIN(I_KVAG) + l * 256, FIN(I_SGVG) + l * 512};
        pg8::gemm_phase<pg8::EpiInProj, pg8::StaticOrder, true, true>(F.lds, g, S, E, F.tid); frame_retid(F); ph_krope(F, l); }
    if constexpr (PH == 5) {
        PG8_LAS float* X = (PG8_LAS float*)(F.lds + LDSCTL_OFF + 1024);
        { pg8::Gemm g{WSP(bf16, WS_QA), wptr(F, l, WL_UQ), M, UQ_PAD, QRANK}; pg8::StaticOrder S; S.init(M, UQ_PAD, F.G, F.bid);
          pg8::EpiMlaQ E{WSP(bf16, WS_QM), WSP(float, WS_SSQ_QA), WSP(float, WS_COS), WSP(float, WS_SIN), FIN(I_MQG) + l * 192, X};
          pg8::gemm_phase<pg8::EpiMlaQ, pg8::StaticOrder, true, true>(F.lds, g, S, E, F.tid); }
        __syncthreads(); frame_retid(F);
        { pg8::Gemm g{WSP(bf16, WS_KVA), wptr(F, l, WL_UKV), M, UKV_N, KVRANK}; pg8::StaticOrder S; S.init(M, UKV_N, F.G, F.G - 1 - F.bid);
          pg8::EpiMlaKV E{WSP(bf16, WS_KM), WSP(bf16, WS_VM), WSP(float, WS_SSQ_KVA), WSP(float, WS_SSQ_KR), WSP(float, WS_KR), WSP(float, WS_COS), WSP(float, WS_SIN), FIN(I_MKG) + l * 192, X};
          pg8::gemm_phase<pg8::EpiMlaKV, pg8::StaticOrder, true, true>(F.lds, g, S, E, F.tid); }
    }
    if constexpr (PH == 7) { ph_attn_da<5>(F, l); frame_retid(F); ph_attn_da<0>(F, l); frame_retid(F); asm volatile("; PHASE_BEGIN 71"); ph_attn_mla<5>(F, l); frame_retid(F); ph_attn_mla<0>(F, l); frame_retid(F); asm volatile("; PHASE_BEGIN 72"); ph_sgu(F, l); }
    if constexpr (PH == 8) { pg8::Gemm g{WSP(bf16, WS_MIX), wptr(F, l, WL_OUT), M, D, D}; pg8::StaticOrder S; S.init(M, D, F.G, F.bid);
        pg8::EpiResid E{l == 0 ? FIN(I_X) : F.out, F.out, D, mod + 2 * D, 6 * D}; pg8::gemm_phase<pg8::EpiResid, pg8::StaticOrder, true, true>(F.lds, g, S, E, F.tid); }
    if constexpr (PH == 9) ph_norm(F, l, F.out, 3 * D, 4 * D);
    if constexpr (PH == 10) { pg8::Gemm g{WSP(bf16, WS_H), wptr(F, l, WL_UP), M, NUP, D}; pg8::StaticOrder S; S.init(M, NUP, F.G, F.bid);
        pg8::EpiConvGate E{WSP(bf16, WS_U), WSP(float, WS_EDGE), FIN(I_CONVW) + (size_t)l * 3 * NUP, FIN(I_CONVB) + (size_t)l * NUP}; pg8::gemm_phase<pg8::EpiConvGate, pg8::StaticOrder, true, true>(F.lds, g, S, E, F.tid); }
    if constexpr (PH == 11) ph_convfix(F, l);
    if constexpr (PH == 12) { pg8::Gemm g{WSP(bf16, WS_U), wptr(F, l, WL_DOWN), M, D, DFF}; pg8::StaticOrder S; S.init(M, D, F.G, F.bid);
        pg8::EpiResid E{F.out, F.out, D, mod + 5 * D, 6 * D}; pg8::gemm_phase<pg8::EpiResid, pg8::StaticOrder, true, true>(F.lds, g, S, E, F.tid); }
}
__global__ void __launch_bounds__(NTHREADS, 2) mega_fwd(Args a) {
    extern __shared__ __attribute__((aligned(16))) unsigned char lds[];
    Frame F; frame_init(F, a, lds);
    if (F.tid < 16) ((LAS unsigned*)(F.lds + LDSCTL_OFF))[F.tid] = 0u;
    __syncthreads();
    XcdBarrier bar = xcd_barrier_post((unsigned*)(F.ws + WS_CTL) + CW_BAR, (volatile LAS unsigned*)(F.lds + LDSCTL_OFF + 32));
    run_phase<0>(F, 0); grid_bar(bar, F.wave0);
#if defined(PROBE_P0)
    run_phase<0>(F, 0); grid_bar(bar, F.wave0);
#endif
    run_phase<1>(F, 0); grid_bar(bar, F.wave0);
    for (int l = 0; l < DEPTH; ++l) {
        run_phase<2>(F, l); grid_bar(bar, F.wave0);
#if defined(PROBE_EW)
        run_phase<2>(F, l); grid_bar(bar, F.wave0);
#endif
        run_phase<3>(F, l); grid_bar(bar, F.wave0);
#if defined(PROBE_GEMM)
        run_phase<3>(F, l); grid_bar(bar, F.wave0);
#endif
        run_phase<5>(F, l); grid_bar(bar, F.wave0);
        run_phase<7>(F, l); grid_bar(bar, F.wave0);
#if defined(PROBE_P7)
        frame_retid(F); ph_attn_da<5>(F, l, 1); frame_retid(F); ph_attn_mla<5>(F, l, 1); grid_bar(bar, F.wave0);
#endif
#if defined(PROBE_LOC)
        frame_retid(F); ph_attn_da<5>(F, l, 2); frame_retid(F); ph_attn_mla<5>(F, l, 2); grid_bar(bar, F.wave0);
#endif
#if defined(PROBE_DA)
        frame_retid(F); ph_attn_da<5>(F, l, 1); grid_bar(bar, F.wave0);
#endif
#if defined(PROBE_VAR)
        frame_retid(F); ph_attn_mla<5>(F, l, 3); grid_bar(bar, F.wave0);
#endif
#if defined(PROBE_MLA)
        frame_retid(F); ph_attn_mla<5>(F, l, 1); grid_bar(bar, F.wave0);
#endif
#if defined(PROBE_SGU)
        frame_retid(F); ph_sgu(F, l, 1); grid_bar(bar, F.wave0);
#endif
        run_phase<8>(F, l); grid_bar(bar, F.wave0);
        run_phase<9>(F, l); grid_bar(bar, F.wave0);
        run_phase<10>(F, l); grid_bar(bar, F.wave0);
#if defined(PROBE_G10)
        frame_retid(F); run_phase<10>(F, l); grid_bar(bar, F.wave0);
#endif
#if defined(PROBE_G10N)
        frame_retid(F); { pg8::Gemm g{WSP(bf16, WS_H), wptr(F, l, WL_UP), M, NUP, D}; pg8::StaticOrder S; S.init(M, NUP, F.G, F.bid);
          pg8::EpiNull E{WSP(float, WS_MIX)}; pg8::gemm_phase<pg8::EpiNull, pg8::StaticOrder, true, true>(F.lds, g, S, E, F.tid); } grid_bar(bar, F.wave0);
#endif
#if defined(PROBE_GEMM)
        run_phase<10>(F, l); grid_bar(bar, F.wave0);
#endif
        run_phase<11>(F, l); grid_bar(bar, F.wave0);
#if defined(PROBE_EW)
        run_phase<11>(F, l); grid_bar(bar, F.wave0);
#endif
        run_phase<12>(F, l); if (l + 1 < DEPTH) grid_bar(bar, F.wave0);
    }
}

extern "C" void kernel_launch(void* const* d_in, const int* in_sizes, int n_in, void* d_out, int out_size, void* d_ws, size_t ws_size, hipStream_t stream) {
    static int grid = 0;
    if (grid == 0) {
        if (n_in != N_IN || in_sizes[0] != M * D || out_size != M * D || ws_size < WS_END) { fprintf(stderr, "kernel_launch: shape mismatch (n_in %d, ws %zu, need %zu)\n", n_in, ws_size, (size_t)WS_END); grid = -1; return; }
        int dev = 0, cus = 0, per_cu = 0;
        if (hipGetDevice(&dev) != hipSuccess || hipDeviceGetAttribute(&cus, hipDeviceAttributeMultiprocessorCount, dev) != hipSuccess) { grid = -1; return; }
        if (hipFuncSetAttribute((const void*)mega_fwd, hipFuncAttributeMaxDynamicSharedMemorySize, LDS_BYTES) != hipSuccess) { fprintf(stderr, "hipFuncSetAttribute failed\n"); grid = -1; return; }
        if (hipOccupancyMaxActiveBlocksPerMultiprocessor(&per_cu, (const void*)mega_fwd, NTHREADS, LDS_BYTES) != hipSuccess || per_cu < 1) fprintf(stderr, "kernel_launch: occupancy query reports %d\n", per_cu);
        (void)hipGetLastError();
        grid = cus > 0 ? cus : 256;
    }
    if (grid < 0) return;
    if (hipMemsetAsync((char*)d_ws + WS_CTL, 0, CTL_ZERO_BYTES, stream) != hipSuccess) { fprintf(stderr, "kernel_launch: memset failed\n"); return; }
    Args a{};
    for (int i = 0; i < N_IN; ++i) a.in[i] = d_in[i];
    a.out = (float*)d_out; a.ws = (unsigned char*)d_ws; a.ph = 0; a.l = 0;
    hipLaunchKernelGGL(mega_fwd, dim3(grid), dim3(NTHREADS), LDS_BYTES, stream, a);
    const hipError_t le = hipPeekAtLastError();
    if (le != hipSuccess) fprintf(stderr, "kernel_launch: launch failed: %s\n", hipGetErrorName(le));
}
```

```cpp
#include <hip/hip_runtime.h>
#include <cstdio>
#include <cstdint>
#include <cmath>
#define GAS __attribute__((address_space(1)))
#define LAS __attribute__((address_space(3)))
namespace pg8 {
#define PG8_LAS __attribute__((address_space(3)))
typedef unsigned short bf16_t;
typedef short bf16x8 __attribute__((ext_vector_type(8)));
typedef float f32x4 __attribute__((ext_vector_type(4)));
typedef unsigned u32x4 __attribute__((ext_vector_type(4)));
constexpr int BM = 256, BK = 64, HALF = 128, HTB = HALF * BK * 2  , STAGE_BYTES = 8 * HTB, NXCD = 8, WGM = 8;

__host__ __device__ __forceinline__ int lds_byte(int r, int c) { const int st = (r >> 4) * 2 + (c >> 5), rr = r & 15, cc = c & 31, ob = rr * 64 + cc * 2; return st * 1024 + (ob ^ (((ob >> 9) & 1) << 5)); }
__host__ __device__ __forceinline__ void stage_rc(int b, int& R, int& C) { const int st = b / 1024, sb = b % 1024, swz = sb ^ (((sb >> 9) & 1) << 5); R = (st >> 1) * 16 + swz / 64; C = (st & 1) * 32 + (swz % 64) / 2; }
__host__ __device__ __forceinline__ int perm32(int rho) { const int n = rho >> 4, i = rho & 15; return 8 * (i >> 2) + 4 * n + (i & 3); }

struct Unit { int pm, pn; };
struct Gemm { const bf16_t* A; const bf16_t* Bt; int M, N, K; };

struct StaticOrder {
    int nM, nN, nwg, G, c;
    __host__ __device__ void init(int M, int N, int G_, int c_) { nM = M / BM; nN = N / BM; nwg = nM * nN; G = G_; c = c_; }
    __host__ __device__ bool next(int i, Unit& u) const {
        const long L = (long)i * G + c; if (L >= nwg) return false;
        int wgid = (int)L; { const int q = nwg / NXCD, r = nwg % NXCD, xcd = wgid % NXCD, off = wgid / NXCD; wgid = (xcd < r ? xcd * (q + 1) : r * (q + 1) + (xcd - r) * q) + off; }
        const int nig = WGM * nN, gid = wgid / nig, fm = gid * WGM, gsz = (nM - fm) < WGM ? (nM - fm) : WGM;
        u.pm = fm + ((wgid % nig) % gsz); u.pn = (wgid % nig) / gsz; return true;
    }
    __device__ __forceinline__ void a_ready(const Unit&) const {}
    __device__ __forceinline__ void done(const Unit&) const {}
};

__device__ __forceinline__ unsigned cvt_pk_bf16(float lo, float hi) { unsigned r; asm volatile("v_cvt_pk_bf16_f32 %0, %1, %2" : "=v"(r) : "v"(lo), "v"(hi)); return r; }
typedef float f32x2 __attribute__((ext_vector_type(2)));
typedef _Float16 f16x2 __attribute__((ext_vector_type(2)));
__device__ __forceinline__ unsigned pkh2(float a, float b) { const f16x2 h = {(_Float16)a, (_Float16)b}; return __builtin_bit_cast(unsigned, h); }
__device__ __forceinline__ float uph_lo(unsigned w) { return (float)__builtin_bit_cast(f16x2, w).x; }
__device__ __forceinline__ float uph_hi(unsigned w) { return (float)__builtin_bit_cast(f16x2, w).y; }

template <class Epi, class Sched, bool ALIGN_EPI = false, bool SP2 = false>
__device__ __forceinline__ void gemm_phase(PG8_LAS unsigned char* lds, const Gemm g, const Sched& S, const Epi& E, int tid_in) {
    int tid_ = tid_in; asm volatile("" : "+v"(tid_));
    const int tid = tid_, wid = __builtin_amdgcn_readfirstlane(tid >> 6), lane = tid & 63, wr = wid >> 2, wc = wid & 3, fr = lane & 15, fq = lane >> 4;
    const int K = g.K, nt = K / BK;
    unsigned voffA[2], voffB[2];
#pragma unroll
    for (int i = 0; i < 2; ++i) { int R, C; stage_rc(tid * 16 + i * 8192, R, C); const int Rb = Epi::PERM ? ((R & ~31) + perm32(R & 31)) : R;
        voffA[i] = (unsigned)(R * K + C) * 2u; voffB[i] = (unsigned)(Rb * K + C) * 2u; }
    const size_t kstep = (size_t)(BK * 2);
    const size_t hstep = (size_t)HALF * K * 2;
    const size_t tstep = 2 * hstep;
    const unsigned ldsw = (unsigned)wid * 1024u;
    const int aoff = lds_byte(wr * 64 + fr, fq * 8), boff = lds_byte(wc * 32 + fr, fq * 8);
#define PG8_SA(b, h) (((b) * 2 + (h)) * HTB)
#define PG8_SB(b, h) ((4 + (b) * 2 + (h)) * HTB)
#define PG8_STAGE(bufoff, gbase, voff) do { _Pragma("unroll") for (int _i = 0; _i < 2; ++_i) \
        __builtin_amdgcn_global_load_lds((const unsigned*)((const char*)(gbase) + (voff)[_i]), (PG8_LAS unsigned*)(lds + (bufoff) + ldsw + _i * 8192), 16, 0, 0); } while (0)
#define PG8_LDA(dst, b, h) do { _Pragma("unroll") for (int m = 0; m < 4; ++m) _Pragma("unroll") for (int k = 0; k < 2; ++k) dst[m][k] = *(const PG8_LAS bf16x8*)(lds + PG8_SA(b, h) + aoff + m * 2048 + k * 1024); } while (0)
#define PG8_LDB(dst, b, h) do { _Pragma("unroll") for (int n = 0; n < 2; ++n) _Pragma("unroll") for (int k = 0; k < 2; ++k) dst[n][k] = *(const PG8_LAS bf16x8*)(lds + PG8_SB(b, h) + boff + n * 2048 + k * 1024); } while (0)
#define PG8_MMA(ai, bj, At, Bt) do { __builtin_amdgcn_s_setprio(1); _Pragma("unroll") for (int m = 0; m < 4; ++m) _Pragma("unroll") for (int n = 0; n < 2; ++n) _Pragma("unroll") for (int k = 0; k < 2; ++k) \
        acc[ai][bj][m][n] = __builtin_amdgcn_mfma_f32_16x16x32_bf16(Bt[n][k], At[m][k], acc[ai][bj][m][n], 0, 0, 0); __builtin_amdgcn_s_setprio(0); } while (0)
#define PG8_WAIT_V(n) asm volatile("s_waitcnt vmcnt(" #n ")" ::: "memory")
#define PG8_WAIT_L(n) asm volatile("s_waitcnt lgkmcnt(" #n ")" ::: "memory")
#define PG8_BAR __builtin_amdgcn_s_barrier()
#define PG8_SCHED __builtin_amdgcn_sched_barrier(0)
    Unit cur, nxt; int ui = 0;
    if (!S.next(0, cur)) return;
    f32x4 acc[2][2][4][2];
#pragma unroll
    for (int a = 0; a < 2; ++a)
#pragma unroll
        for (int b = 0; b < 2; ++b)
#pragma unroll
            for (int m = 0; m < 4; ++m)
#pragma unroll
                for (int n = 0; n < 2; ++n) acc[a][b][m][n] = (f32x4){0.f, 0.f, 0.f, 0.f};
    bf16x8 At[4][2], B0[2][2], B1[2][2];
    const char* cA = (const char*)g.A + (size_t)cur.pm * tstep; const char* cB = (const char*)g.Bt + (size_t)cur.pn * tstep;
    S.a_ready(cur);
    if constexpr (SP2) {
        PG8_STAGE(PG8_SB(0, 0), cB, voffB); PG8_STAGE(PG8_SB(0, 1), cB + hstep, voffB); PG8_STAGE(PG8_SA(0, 0), cA, voffA); PG8_STAGE(PG8_SA(0, 1), cA + hstep, voffA);
        if (wr == 1) PG8_BAR;
        PG8_WAIT_V(2); PG8_BAR;
        PG8_STAGE(PG8_SB(1, 0), cB + kstep, voffB); PG8_STAGE(PG8_SA(1, 0), cA + kstep, voffA); PG8_STAGE(PG8_SB(1, 1), cB + hstep + kstep, voffB);
        PG8_WAIT_V(6); PG8_BAR;
    } else {
        PG8_STAGE(PG8_SB(0, 0), cB, voffB); PG8_STAGE(PG8_SA(0, 0), cA, voffA); PG8_STAGE(PG8_SB(0, 1), cB + hstep, voffB); PG8_STAGE(PG8_SA(0, 1), cA + hstep, voffA);
        if (wr == 1) PG8_BAR;
        PG8_WAIT_V(4); PG8_BAR;
        PG8_STAGE(PG8_SB(1, 0), cB + kstep, voffB); PG8_STAGE(PG8_SA(1, 0), cA + kstep, voffA); PG8_STAGE(PG8_SB(1, 1), cB + hstep + kstep, voffB);
        PG8_WAIT_V(6); PG8_BAR;
    }
    for (;;) {
        const bool has_next = S.next(ui + 1, nxt);
        const char* nA = has_next ? (const char*)g.A + (size_t)nxt.pm * tstep : cA; const char* nB = has_next ? (const char*)g.Bt + (size_t)nxt.pn * tstep : cB;
        for (int t = 0; t < nt; t += 2) {
            const bool last = (t == nt - 2);
            const char* a1 = cA + (size_t)(t + 1) * kstep;
            const char* a2 = last ? nA : cA + (size_t)(t + 2) * kstep; const char* b2 = last ? nB : cB + (size_t)(t + 2) * kstep;
            const char* a3 = a2 + kstep; const char* b3 = b2 + kstep;
            if (last && has_next) S.a_ready(nxt);
            if constexpr (SP2) {
            PG8_LDB(B0, 0, 0); PG8_LDB(B1, 0, 1); PG8_SCHED; PG8_LDA(At, 0, 0); PG8_STAGE(PG8_SA(1, 1), a1 + hstep, voffA);
            PG8_WAIT_V(8); PG8_WAIT_L(0); PG8_BAR; PG8_MMA(0, 0, At, B0); PG8_MMA(0, 1, At, B1); PG8_BAR; PG8_SCHED;
            PG8_LDA(At, 0, 1); PG8_STAGE(PG8_SB(0, 0), b2, voffB); PG8_STAGE(PG8_SB(0, 1), b2 + hstep, voffB); PG8_STAGE(PG8_SA(0, 0), a2, voffA);
            PG8_WAIT_V(8); PG8_WAIT_L(0); PG8_BAR; PG8_MMA(1, 0, At, B0); PG8_MMA(1, 1, At, B1); PG8_BAR; PG8_SCHED;
            PG8_LDB(B0, 1, 0); PG8_LDB(B1, 1, 1); PG8_SCHED; PG8_LDA(At, 1, 0); PG8_STAGE(PG8_SA(0, 1), a2 + hstep, voffA);
            PG8_WAIT_V(8); PG8_WAIT_L(0); PG8_BAR; PG8_MMA(0, 0, At, B0); PG8_MMA(0, 1, At, B1); PG8_BAR; PG8_SCHED;
            PG8_LDA(At, 1, 1); PG8_STAGE(PG8_SB(1, 0), b3, voffB); PG8_STAGE(PG8_SB(1, 1), b3 + hstep, voffB); PG8_STAGE(PG8_SA(1, 0), a3, voffA);
            PG8_WAIT_V(8); PG8_WAIT_L(0); PG8_BAR; PG8_MMA(1, 0, At, B0); PG8_MMA(1, 1, At, B1); PG8_BAR; PG8_SCHED;
            } else {
            PG8_LDB(B0, 0, 0); PG8_SCHED; PG8_LDA(At, 0, 0); PG8_STAGE(PG8_SA(1, 1), a1 + hstep, voffA);
            PG8_WAIT_L(8); PG8_BAR; PG8_WAIT_L(0); PG8_MMA(0, 0, At, B0); PG8_BAR; PG8_SCHED;
            PG8_LDB(B1, 0, 1); PG8_STAGE(PG8_SB(0, 0), b2, voffB);
            PG8_BAR; PG8_WAIT_L(0); PG8_MMA(0, 1, At, B1); PG8_BAR;
            PG8_LDA(At, 0, 1); PG8_STAGE(PG8_SA(0, 0), a2, voffA);
            PG8_BAR; PG8_WAIT_L(0); PG8_MMA(1, 0, At, B0); PG8_BAR; PG8_SCHED;
            PG8_STAGE(PG8_SB(0, 1), b2 + hstep, voffB);
            PG8_WAIT_V(6); PG8_BAR; PG8_MMA(1, 1, At, B1); PG8_BAR;
            PG8_LDB(B0, 1, 0); PG8_SCHED; PG8_LDA(At, 1, 0); PG8_STAGE(PG8_SA(0, 1), a2 + hstep, voffA);
            PG8_WAIT_L(8); PG8_BAR; PG8_WAIT_L(0); PG8_MMA(0, 0, At, B0); PG8_BAR; PG8_SCHED;
            PG8_LDB(B1, 1, 1); PG8_STAGE(PG8_SB(1, 0), b3, voffB);
            PG8_BAR; PG8_WAIT_L(0); PG8_MMA(0, 1, At, B1); PG8_BAR;
            PG8_LDA(At, 1, 1); PG8_STAGE(PG8_SA(1, 0), a3, voffA);
            PG8_BAR; PG8_WAIT_L(0); PG8_MMA(1, 0, At, B0); PG8_BAR; PG8_SCHED;
            PG8_STAGE(PG8_SB(1, 1), b3 + hstep, voffB);
            PG8_WAIT_V(6); PG8_BAR; PG8_MMA(1, 1, At, B1); PG8_BAR;
            }
        }
        if constexpr (ALIGN_EPI) { if (wr == 0) PG8_BAR; }
        if constexpr (!Epi::AFTER_DRAIN) { E(acc, cur, wr, wc, fr, fq); S.done(cur); }
        if (!has_next) break;
#pragma unroll
        for (int a = 0; a < 2; ++a)
#pragma unroll
            for (int b = 0; b < 2; ++b)
#pragma unroll
                for (int m = 0; m < 4; ++m)
#pragma unroll
                    for (int n = 0; n < 2; ++n) acc[a][b][m][n] = (f32x4){0.f, 0.f, 0.f, 0.f};
        cur = nxt; cA = nA; cB = nB; ++ui;
        if constexpr (ALIGN_EPI) { if (wr == 1) PG8_BAR; }
    }
    PG8_WAIT_V(0);
    if constexpr (!ALIGN_EPI) { if (wr == 0) PG8_BAR; }
    PG8_BAR;
    if constexpr (Epi::AFTER_DRAIN) { E.fused(acc, cur, wr, wc, fr, fq, lds, wid, lane); S.done(cur); }
#undef PG8_SA
#undef PG8_SB
#undef PG8_STAGE
#undef PG8_LDA
#undef PG8_LDB
#undef PG8_MMA
#undef PG8_WAIT_V
#undef PG8_WAIT_L
#undef PG8_BAR
#undef PG8_SCHED
}
}
#define XB_TMO      128
#define XB_XCNT(j)  (256  + 64 * (j))
#define XB_XSUB(j)  (1280 + 64 * (j))
#define XB_XGEN(j)  (2304 + 64 * (j))
#define XB_TOP      3328
#define XB_TOPGEN   3392
#define XCD_BAR_WORDS 3456
#define XB_SPIN_CAP (1u << 18)

__device__ __forceinline__ unsigned xb_ld(unsigned* p)              { return __hip_atomic_load(p, __ATOMIC_RELAXED, __HIP_MEMORY_SCOPE_AGENT); }
__device__ __forceinline__ unsigned xb_add(unsigned* p, unsigned v) { return __hip_atomic_fetch_add(p, v, __ATOMIC_RELAXED, __HIP_MEMORY_SCOPE_AGENT); }
__device__ __forceinline__ unsigned xb_xcc_id() { return (unsigned)__builtin_amdgcn_s_getreg((3 << 11) | 20) & 0xFu; }
#define XB_SPIN(cond, bar) do { unsigned _sp = 0; while (cond) { __builtin_amdgcn_s_sleep(1); \
    if ((++_sp & 255u) == 0u) { if (xb_ld(&(bar)[XB_TMO])) break; if (_sp > XB_SPIN_CAP) { atomicAdd(&(bar)[XB_TMO], 1u); break; } } } } while (0)

struct XcdBarrier {
    unsigned* bar; unsigned x;
    volatile LAS unsigned* st;
};

__device__ __forceinline__ XcdBarrier xcd_barrier_post(unsigned* bar, volatile LAS unsigned* st) {
    XcdBarrier b; b.bar = bar; b.x = xb_xcc_id(); b.st = st;
    if (threadIdx.x == 0) (void)xb_add(&bar[XB_XCNT(b.x)], 1u);
    return b;
}
__device__ __forceinline__ void xcd_barrier_complete(unsigned* bar, unsigned x, unsigned& nloc, unsigned& nx) {
    const unsigned G = gridDim.x * gridDim.y * gridDim.z;
    unsigned sum, cnt, mine, sp = 0u;
    for (;;) {
        sum = 0u; cnt = 0u; mine = 0u;
#pragma unroll
        for (unsigned j = 0; j < 16; ++j) { const unsigned c = xb_ld(&bar[XB_XCNT(j)]); sum += c; cnt += (c > 0u) ? 1u : 0u; mine = (j == x) ? c : mine; }
        if (sum == G) break;
        __builtin_amdgcn_s_sleep(1);
        if ((++sp & 255u) == 0u) { if (xb_ld(&bar[XB_TMO])) break; if (sp > XB_SPIN_CAP) { atomicAdd(&bar[XB_TMO], 1u); break; } }
    }
    nloc = mine > 0u ? mine : 1u; nx = cnt > 0u ? cnt : 1u;
}

__device__ __forceinline__ void xcd_barrier(const XcdBarrier& b, bool leader) {
    asm volatile("s_waitcnt vmcnt(0)" ::: "memory");
    __syncthreads();
    if (leader) {
        unsigned* bar = b.bar;
        __builtin_amdgcn_s_waitcnt(0);
        unsigned nloc = b.st[0], nx = b.st[1];
        if (nloc == 0u) { xcd_barrier_complete(bar, b.x, nloc, nx); b.st[0] = nloc; b.st[1] = nx; }
        const unsigned old = xb_add(&bar[XB_XSUB(b.x)], 1u);
        const unsigned gen = old / nloc;
        if (old + 1u == (gen + 1u) * nloc) {
            __builtin_amdgcn_fence(__ATOMIC_RELEASE, "agent");
            asm volatile("s_waitcnt vmcnt(0)" ::: "memory");
            const unsigned og = xb_add(&bar[XB_TOP], 1u);
            const unsigned tg = og / nx;
            if (og + 1u == (tg + 1u) * nx) xb_add(&bar[XB_TOPGEN], 1u);
            else XB_SPIN(xb_ld(&bar[XB_TOPGEN]) == tg, bar);
            __builtin_amdgcn_fence(__ATOMIC_ACQUIRE, "agent");
            xb_add(&bar[XB_XGEN(b.x)], 1u);
            asm volatile("s_waitcnt vmcnt(0)" ::: "memory");
        } else {
            XB_SPIN(xb_ld(&bar[XB_XGEN(b.x)]) == gen, bar);
            __builtin_amdgcn_fence(__ATOMIC_ACQUIRE, "agent");
            asm volatile("s_waitcnt vmcnt(0)" ::: "memory");
        }
    }
    __syncthreads();
}

typedef unsigned short bf16;
typedef unsigned v4u __attribute__((ext_vector_type(4)));
typedef unsigned v2u __attribute__((ext_vector_type(2)));
typedef float f32x4 __attribute__((ext_vector_type(4)));
typedef float f32x16 __attribute__((ext_vector_type(16)));
typedef short bf16x8 __attribute__((ext_vector_type(8)));
#define LDS_WAIT() asm volatile("s_waitcnt lgkmcnt(0)" ::: "memory")
#define VM_WAIT() asm volatile("s_waitcnt vmcnt(0)" ::: "memory")

constexpr int NWAVES = 8, NTHREADS = 512;
constexpr int BATCH = 2, SEQ = 8192, M = BATCH * SEQ, D = 2048, DEPTH = 4;
constexpr int IN_COLS = 4160, IN_PAD = 4352;
constexpr int C_DAQ = 0, C_DAK = 768, C_DAV = 1536, C_QA = 2304, C_KVA = 2816, C_KR = 3072, C_SGU = 3136, C_SGV = 3648;
constexpr int DFF = 5632, NUP = 2 * DFF;
constexpr int UQ_N = 1152, UQ_PAD = 1536, UKV_N = 1536, QRANK = 512, KVRANK = 256;
constexpr int NH = 6;
constexpr float EPS = 1e-6f;
constexpr float LOG2E = 1.4426950408889634f;
constexpr float QS_DA = 0.125f * LOG2E;
constexpr float QS_MLA = 0.07216878364870322f * LOG2E;

enum { I_X = 0, I_C, I_POS, I_WADA, I_BADA, I_WIN, I_DAQG, I_DAKG, I_LQ1, I_LK1, I_LQ2, I_LK2, I_DAHG, I_QAG, I_WUQ, I_KVAG, I_WUKV, I_MQG, I_MKG, I_SGVG, I_SGW, I_SGB, I_WOUT, I_WUP, I_CONVW, I_CONVB, I_WDOWN, N_IN };

constexpr size_t MiB = 1u << 20;
constexpr size_t WS_CTL = 0, CTL_ZERO_BYTES = 1 * MiB;
constexpr size_t WS_MOD = 1 * MiB;
constexpr size_t WS_POSMM = 1 * MiB + 512 * 1024;
constexpr size_t WS_MODP = 2 * MiB;
constexpr size_t WS_W = 8 * MiB;
constexpr size_t WL_IN = 0, WL_UQ = 17 * MiB, WL_UKV = WL_UQ + 1572864, WL_OUT = 20 * MiB, WL_UP = 28 * MiB, WL_DOWN = 72 * MiB, WL_STRIDE = 94 * MiB;
constexpr size_t WS_H = 384 * MiB;
constexpr size_t WS_MIX = 448 * MiB;
constexpr size_t WS_U = 512 * MiB;
constexpr size_t WS_R = 688 * MiB;
constexpr size_t WS_KR = WS_R;
constexpr size_t WS_SSQ_QA = WS_R + 4 * MiB, WS_SSQ_KVA = WS_R + 5 * MiB, WS_SSQ_SGV = WS_R + 6 * MiB, WS_SSQ_KR = WS_R + 7 * MiB;
constexpr size_t WS_QD = WS_R + 272 * MiB, WS_KD = WS_R + 296 * MiB, WS_VD = WS_R + 320 * MiB;
constexpr size_t WS_QM = WS_R + 344 * MiB, WS_KM = WS_R + 380 * MiB, WS_VM = WS_R + 416 * MiB;
constexpr size_t WS_QA = WS_R + 440 * MiB, WS_KVA = WS_R + 456 * MiB;
constexpr size_t WS_MLQ = WS_R + 464 * MiB, WS_MLKV = WS_R + 544 * MiB;
constexpr size_t WS_XB = WS_R + 464 * MiB;
constexpr size_t WS_UU = WS_R + 640 * MiB, WS_GV = WS_R + 672 * MiB;
constexpr size_t WS_EDGE = WS_R;
constexpr size_t WS_A = WS_R;
constexpr size_t WS_O1 = WS_R + 704 * MiB;
constexpr size_t WS_COS = WS_R + 752 * MiB, WS_SIN = WS_R + 754 * MiB;
constexpr size_t WS_END = WS_R + 756 * MiB;

constexpr int RING_BYTES = 131072;
constexpr int LDSCTL_OFF = RING_BYTES;
constexpr int LDS_BYTES = 147456;

__device__ const float ROPE_INV[32] = {1.000000000e+00f, 7.498942614e-01f, 5.623413324e-01f, 4.216965139e-01f, 3.162277639e-01f, 2.371373773e-01f, 1.778279394e-01f, 1.333521307e-01f, 1.000000015e-01f, 7.498941571e-02f, 5.623413250e-02f, 4.216965288e-02f, 3.162277490e-02f, 2.371373773e-02f, 1.778279431e-02f, 1.333521493e-02f, 9.999999776e-03f, 7.498941850e-03f, 5.623413250e-03f, 4.216964822e-03f, 3.162277630e-03f, 2.371373586e-03f, 1.778279431e-03f, 1.333521446e-03f, 1.000000047e-03f, 7.498942432e-04f, 5.623413017e-04f, 4.216965172e-04f, 3.162277571e-04f, 2.371373703e-04f, 1.778279402e-04f, 1.333521504e-04f};
__device__ const float ALIBI_SLOPE[6] = {0.3968502629920499f, 0.15749013123685915f, 0.0625f, 0.024803141437003122f, 0.0098431332023036951f, 0.00390625f};
__device__ const float LAM_INIT[4] = {0.20000000000000007f, 0.35550906759096934f, 0.4707130183435842f, 0.5560582041556406f};

struct Args { const void* in[N_IN]; float* out; unsigned char* ws; int ph; int l; };

__device__ __forceinline__ unsigned f2bf(float f) { unsigned u = __builtin_bit_cast(unsigned, f); return (u + 0x7fffu + ((u >> 16) & 1u)) >> 16; }
__device__ __forceinline__ unsigned pk2(float lo, float hi) { return f2bf(lo) | (f2bf(hi) << 16); }
__device__ __forceinline__ float bf2f(unsigned short h) { return __builtin_bit_cast(float, (unsigned)h << 16); }
template <int CTRL> __device__ __forceinline__ float dpp_mov(float v) { return __builtin_bit_cast(float, __builtin_amdgcn_update_dpp(0, __builtin_bit_cast(int, v), CTRL, 0xF, 0xF, true)); }
__device__ __forceinline__ float sum16(float v) { v += dpp_mov<0xB1>(v); v += dpp_mov<0x4E>(v); v += dpp_mov<0x141>(v); v += dpp_mov<0x140>(v); return v; }
__device__ __forceinline__ float sum32(float v) { v = sum16(v); auto r = __builtin_amdgcn_permlane16_swap(__float_as_uint(v), __float_as_uint(v), false, false); return __uint_as_float(r[0]) + __uint_as_float(r[1]); }
__device__ __forceinline__ float wave_sum(float v) { v = sum32(v); auto r = __builtin_amdgcn_permlane32_swap(__float_as_uint(v), __float_as_uint(v), false, false); return __uint_as_float(r[0]) + __uint_as_float(r[1]); }
__device__ __forceinline__ float wave_max(float v) { v = fmaxf(v, dpp_mov<0xB1>(v)); v = fmaxf(v, dpp_mov<0x4E>(v)); v = fmaxf(v, dpp_mov<0x141>(v)); v = fmaxf(v, dpp_mov<0x140>(v));
    { auto r = __builtin_amdgcn_permlane16_swap(__float_as_uint(v), __float_as_uint(v), false, false); v = fmaxf(__uint_as_float(r[0]), __uint_as_float(r[1])); }
    { auto r = __builtin_amdgcn_permlane32_swap(__float_as_uint(v), __float_as_uint(v), false, false); v = fmaxf(__uint_as_float(r[0]), __uint_as_float(r[1])); } return v; }
__device__ __forceinline__ float xor32(float v, int lane) { auto r = __builtin_amdgcn_permlane32_swap(__float_as_uint(v), __float_as_uint(v), false, false); return lane < 32 ? __uint_as_float(r[1]) : __uint_as_float(r[0]); }
__device__ __forceinline__ float gelu_tanh(float x) {
    const float u = 0.7978845608028654f * (x + 0.044715f * x * x * x);
    const float e = __expf(2.0f * u);
    const float th = 1.0f - 2.0f / (e + 1.0f);
    return 0.5f * x * (1.0f + th);
}
__device__ __forceinline__ float silu_f(float x) { return x / (1.0f + __expf(-x)); }
__device__ __forceinline__ int crow(int r, int hi) { return (r & 3) + 8 * (r >> 2) + 4 * hi; }

namespace pg8 {
struct EpiF32 {
    static constexpr bool PERM = false, AFTER_DRAIN = false;
    float* C; int ldc;
    __device__ __forceinline__ void operator()(const f32x4 (&acc)[2][2][4][2], const Unit& u, int wr, int wc, int fr, int fq) const {
        const int row0 = u.pm * BM + wr * 64 + fr, col0 = u.pn * BM + wc * 32 + 4 * fq;
#pragma unroll
        for (int ai = 0; ai < 2; ++ai)
#pragma unroll
            for (int m = 0; m < 4; ++m) { float* rowp = C + (size_t)(row0 + ai * HALF + m * 16) * ldc + col0;
#pragma unroll
                for (int bj = 0; bj < 2; ++bj)
#pragma unroll
                    for (int n = 0; n < 2; ++n) *(f32x4*)(rowp + bj * HALF + n * 16) = acc[ai][bj][m][n]; }
    }
};
struct EpiNull {
    static constexpr bool PERM = true, AFTER_DRAIN = false;
    float* C;
    __device__ __forceinline__ void operator()(const f32x4 (&acc)[2][2][4][2], const Unit& u, int wr, int wc, int fr, int fq) const {
        f32x4 s = {0.f, 0.f, 0.f, 0.f};
#pragma unroll
        for (int ai = 0; ai < 2; ++ai)
#pragma unroll
            for (int bj = 0; bj < 2; ++bj)
#pragma unroll
                for (int m = 0; m < 4; ++m)
#pragma unroll
                    for (int n = 0; n < 2; ++n) s += acc[ai][bj][m][n];
        C[(size_t)(u.pm * 44 + u.pn) * 512 + (wr * 4 + wc) * 64 + fq * 16 + fr] = (s[0] + s[1]) + (s[2] + s[3]);
    }
};
struct EpiResid {
    static constexpr bool PERM = false, AFTER_DRAIN = false;
    const float* xin; float* out; int ldc; const float* gate; int gate_stride;
    __device__ __forceinline__ void operator()(const f32x4 (&acc)[2][2][4][2], const Unit& u, int wr, int wc, int fr, int fq) const {
        const int row0 = u.pm * BM + wr * 64 + fr, col0 = u.pn * BM + wc * 32 + 4 * fq;
        const float* gp = gate + (size_t)((u.pm * BM) / SEQ) * gate_stride + col0;
        f32x4 gv[2][2];
#pragma unroll
        for (int bj = 0; bj < 2; ++bj)
#pragma unroll
            for (int n = 0; n < 2; ++n) gv[bj][n] = *(const f32x4*)(gp + bj * HALF + n * 16);
#pragma unroll
        for (int ai = 0; ai < 2; ++ai) {
            f32x4 xv[4][2][2];
#pragma unroll
            for (int m = 0; m < 4; ++m) { const size_t off = (size_t)(row0 + ai * HALF + m * 16) * ldc + col0;
#pragma unroll
                for (int bj = 0; bj < 2; ++bj)
#pragma unroll
                    for (int n = 0; n < 2; ++n) xv[m][bj][n] = *(const f32x4*)(xin + off + bj * HALF + n * 16); }
#pragma unroll
            for (int m = 0; m < 4; ++m) { const size_t off = (size_t)(row0 + ai * HALF + m * 16) * ldc + col0;
#pragma unroll
                for (int bj = 0; bj < 2; ++bj)
#pragma unroll
                    for (int n = 0; n < 2; ++n) *(f32x4*)(out + off + bj * HALF + n * 16) = xv[m][bj][n] + gv[bj][n] * acc[ai][bj][m][n]; }
        }
    }
};
struct EpiResidP {
    static constexpr bool PERM = true, AFTER_DRAIN = false;
    const void* xin; void* out; int inb, outb; const float* gate; int gate_stride;
    __device__ __forceinline__ void put(unsigned eo, const f32x4 r0, const f32x4 r1) const {
        if (outb) *(u32x4*)((char*)out + eo * 2u) = (u32x4){pkh2(r0[0], r0[1]), pkh2(r0[2], r0[3]), pkh2(r1[0], r1[1]), pkh2(r1[2], r1[3])};
        else { *(f32x4*)((char*)out + eo * 4u) = r0; *(f32x4*)((char*)out + eo * 4u + 16u) = r1; } }
    __device__ __forceinline__ void operator()(const f32x4 (&acc)[2][2][4][2], const Unit& u, int wr, int wc, int fr_, int fq_) const {
        int fr = fr_, fq = fq_; asm volatile("" : "+v"(fr), "+v"(fq));
        const int row0 = u.pm * BM + wr * 64 + fr, col0 = u.pn * BM + wc * 32 + 8 * fq;
        const unsigned lo = (unsigned)(row0 * 2048 + col0);
        const float* gp = gate + (size_t)((u.pm * BM) / SEQ) * gate_stride + col0;
        f32x4 gv[2][2];
#pragma unroll
        for (int bj = 0; bj < 2; ++bj)
#pragma unroll
            for (int n = 0; n < 2; ++n) gv[bj][n] = *(const f32x4*)(gp + bj * HALF + 4 * n);
        if (inb) {
            u32x4 xb[2][4][2];
#pragma unroll
            for (int ai = 0; ai < 2; ++ai)
#pragma unroll
                for (int m = 0; m < 4; ++m)
#pragma unroll
                    for (int bj = 0; bj < 2; ++bj) xb[ai][m][bj] = *(const u32x4*)((const char*)xin + (lo + (unsigned)((ai * HALF + m * 16) * 2048 + bj * HALF)) * 2u);
#pragma unroll
            for (int ai = 0; ai < 2; ++ai)
#pragma unroll
                for (int m = 0; m < 4; ++m)
#pragma unroll
                    for (int bj = 0; bj < 2; ++bj) { const u32x4 w = xb[ai][m][bj];
                        const f32x4 x0 = {uph_lo(w.x), uph_hi(w.x), uph_lo(w.y), uph_hi(w.y)};
                        const f32x4 x1 = {uph_lo(w.z), uph_hi(w.z), uph_lo(w.w), uph_hi(w.w)};
                        put(lo + (unsigned)((ai * HALF + m * 16) * 2048 + bj * HALF), x0 + gv[bj][0] * acc[ai][bj][m][0], x1 + gv[bj][1] * acc[ai][bj][m][1]); }
        } else {
#pragma unroll
            for (int ai = 0; ai < 2; ++ai) {
                f32x4 xv[4][2][2];
#pragma unroll
                for (int m = 0; m < 4; ++m)
#pragma unroll
                    for (int bj = 0; bj < 2; ++bj)
#pragma unroll
                        for (int n = 0; n < 2; ++n) xv[m][bj][n] = *(const f32x4*)((const char*)xin + (lo + (unsigned)((ai * HALF + m * 16) * 2048 + bj * HALF + 4 * n)) * 4u);
#pragma unroll
                for (int m = 0; m < 4; ++m)
#pragma unroll
                    for (int bj = 0; bj < 2; ++bj) put(lo + (unsigned)((ai * HALF + m * 16) * 2048 + bj * HALF), xv[m][bj][0] + gv[bj][0] * acc[ai][bj][m][0], xv[m][bj][1] + gv[bj][1] * acc[ai][bj][m][1]);
            }
        }
    }
};
struct EpiBf16S {
    static constexpr bool PERM = true, AFTER_DRAIN = false;
    bf16_t* O; int ldc;
    __device__ __forceinline__ void operator()(const f32x4 (&acc)[2][2][4][2], const Unit& u, int wr, int wc, int fr, int fq) const {
        const int row0 = u.pm * BM + wr * 64 + fr, col0 = u.pn * BM + wc * 32 + 8 * fq;
#pragma unroll
        for (int ai = 0; ai < 2; ++ai)
#pragma unroll
            for (int m = 0; m < 4; ++m) { bf16_t* rowp = O + (size_t)(row0 + ai * HALF + m * 16) * ldc + col0;
#pragma unroll
                for (int bj = 0; bj < 2; ++bj) { const f32x4 v0 = acc[ai][bj][m][0], v1 = acc[ai][bj][m][1]; u32x4 w;
                    w.x = cvt_pk_bf16(v0[0], v0[1]); w.y = cvt_pk_bf16(v0[2], v0[3]); w.z = cvt_pk_bf16(v1[0], v1[1]); w.w = cvt_pk_bf16(v1[2], v1[3]);
                    *(u32x4*)(rowp + bj * HALF) = w; } }
    }
};
template <int CTRL> __device__ __forceinline__ float dppf(float old, float src) { return __builtin_bit_cast(float, __builtin_amdgcn_update_dpp(__builtin_bit_cast(int, old), __builtin_bit_cast(int, src), CTRL, 0xF, 0xF, false)); }
struct EpiConvGate {
    static constexpr bool PERM = true, AFTER_DRAIN = false;
    bf16_t* U; float* EDGE; const float* cw; const float* cb;
    __device__ __forceinline__ void operator()(const f32x4 (&acc)[2][2][4][2], const Unit& u, int wr, int wc, int fr, int fq) const {
        const int ch0 = u.pn * 128 + wc * 32 + 8 * fq, rowb = u.pm * BM + wr * 64;
#pragma unroll
        for (int ai = 0; ai < 2; ++ai) { const int blk = (rowb + ai * HALF) >> 6;
            if (fr < 2) { float* e = EDGE + ((size_t)(blk * 4 + fr) * 2) * DFF + ch0;
#pragma unroll
                for (int bj = 0; bj < 2; ++bj) { *(f32x4*)(e + bj * DFF) = acc[ai][bj][0][0]; *(f32x4*)(e + bj * DFF + 4) = acc[ai][bj][0][1]; } }
            if (fr >= 14) { float* e = EDGE + ((size_t)(blk * 4 + fr - 12) * 2) * DFF + ch0;
#pragma unroll
                for (int bj = 0; bj < 2; ++bj) { *(f32x4*)(e + bj * DFF) = acc[ai][bj][3][0]; *(f32x4*)(e + bj * DFF + 4) = acc[ai][bj][3][1]; } }
        }
        f32x4 w[2][2][3], bb[2][2];
#pragma unroll
        for (int n = 0; n < 2; ++n)
#pragma unroll
            for (int bj = 0; bj < 2; ++bj) { bb[n][bj] = *(const f32x4*)(cb + bj * DFF + ch0 + 4 * n);
#pragma unroll
                for (int j = 0; j < 3; ++j) w[n][bj][j] = *(const f32x4*)(cw + (size_t)j * (2 * DFF) + bj * DFF + ch0 + 4 * n); }
#pragma unroll
        for (int ai = 0; ai < 2; ++ai)
#pragma unroll
            for (int m = 0; m < 4; ++m) {
                unsigned pkw[4];
#pragma unroll
                for (int n = 0; n < 2; ++n) {
                    f32x4 y[2];
#pragma unroll
                    for (int bj = 0; bj < 2; ++bj) { const f32x4 cur = acc[ai][bj][m][n]; const f32x4 prv = m > 0 ? acc[ai][bj][m - 1][n] : (f32x4){0.f, 0.f, 0.f, 0.f};
                        f32x4 s1, s2;
#pragma unroll
                        for (int e = 0; e < 4; ++e) {
                            if (m > 0) { s1[e] = dppf<0x111>(dpp_mov<0x121>(prv[e]), cur[e]); s2[e] = dppf<0x112>(dpp_mov<0x122>(prv[e]), cur[e]); }
                            else { s1[e] = dpp_mov<0x111>(cur[e]); s2[e] = dpp_mov<0x112>(cur[e]); } }
                        y[bj] = bb[n][bj] + w[n][bj][2] * cur + w[n][bj][1] * s1 + w[n][bj][0] * s2; }
                    const f32x4 tg = y[0] * -1.4426950408889634f;
                    f32x4 ev; ev[0] = __builtin_amdgcn_exp2f(tg[0]); ev[1] = __builtin_amdgcn_exp2f(tg[1]); ev[2] = __builtin_amdgcn_exp2f(tg[2]); ev[3] = __builtin_amdgcn_exp2f(tg[3]);
                    const f32x4 dn = ev + 1.0f;
                    f32x4 rc; rc[0] = __builtin_amdgcn_rcpf(dn[0]); rc[1] = __builtin_amdgcn_rcpf(dn[1]); rc[2] = __builtin_amdgcn_rcpf(dn[2]); rc[3] = __builtin_amdgcn_rcpf(dn[3]);
                    const f32x4 o = (y[0] * rc) * y[1];
                    pkw[2 * n] = cvt_pk_bf16(o[0], o[1]); pkw[2 * n + 1] = cvt_pk_bf16(o[2], o[3]);
                }
                u32x4 pk; pk.x = pkw[0]; pk.y = pkw[1]; pk.z = pkw[2]; pk.w = pkw[3];
                *(u32x4*)(U + (size_t)(rowb + ai * HALF + m * 16 + fr) * DFF + ch0) = pk;
            }
    }
};
__device__ __forceinline__ float lane_xor16_sum(float v) { auto r = __builtin_amdgcn_permlane16_swap(__float_as_uint(v), __float_as_uint(v), false, false); return __uint_as_float(r[0]) + __uint_as_float(r[1]); }
__device__ __forceinline__ float lane_xor32_sum(float v) { auto r = __builtin_amdgcn_permlane32_swap(__float_as_uint(v), __float_as_uint(v), false, false); return __uint_as_float(r[0]) + __uint_as_float(r[1]); }
__device__ __forceinline__ float sq4(f32x4 v) { return (v[0] * v[0] + v[1] * v[1]) + (v[2] * v[2] + v[3] * v[3]); }
__device__ __forceinline__ u32x4 pk8(f32x4 a, f32x4 b) { u32x4 w; w.x = cvt_pk_bf16(a[0], a[1]); w.y = cvt_pk_bf16(a[2], a[3]); w.z = cvt_pk_bf16(b[0], b[1]); w.w = cvt_pk_bf16(b[2], b[3]); return w; }
__device__ __forceinline__ float gelu_t(float x) { const float u = 0.7978845608028654f * (x + 0.044715f * x * x * x); const float e = __expf(2.0f * u); return 0.5f * x * (2.0f - 2.0f * __builtin_amdgcn_rcpf(e + 1.0f)); }
__device__ __forceinline__ f32x4 gelu4(f32x4 v) { return (f32x4){gelu_t(v[0]), gelu_t(v[1]), gelu_t(v[2]), gelu_t(v[3])}; }
struct EpiInProj {
    static constexpr bool PERM = true, AFTER_DRAIN = false;
    bf16_t *QD, *KD, *VD, *QA, *KVA, *GV; float *UU, *KR, *SSQ_QA, *SSQ_KVA, *SSQ_SGV, *SSQ_KR;
    const float *qg, *kg, *qag, *kvag, *sgvg;
    __device__ __forceinline__ void operator()(const f32x4 (&acc)[2][2][4][2], const Unit& u, int wr, int wc, int fr, int fq) const {
        const int pn = u.pn, rowb = u.pm * BM + wr * 64 + fr, b = (u.pm * BM) / SEQ, c8 = wc * 32 + 8 * fq;
        if (pn < 6) {
            const bool isk = pn >= 3; const int G = 4 * (isk ? pn - 3 : pn) + wc;
            const float* gp = isk ? kg : qg;
            const f32x4 g00 = *(const f32x4*)(gp + 8 * fq), g01 = *(const f32x4*)(gp + 8 * fq + 4), g10 = *(const f32x4*)(gp + 32 + 8 * fq), g11 = *(const f32x4*)(gp + 32 + 8 * fq + 4);
            bf16_t* dst = (isk ? KD : QD) + ((size_t)(b * 12 + G) * SEQ) * 64 + 8 * fq;
            const float post = isk ? 1.0f : QS_DA;
#pragma unroll
            for (int ai = 0; ai < 2; ++ai)
#pragma unroll
                for (int m = 0; m < 4; ++m) { const f32x4 v00 = acc[ai][0][m][0], v01 = acc[ai][0][m][1], v10 = acc[ai][1][m][0], v11 = acc[ai][1][m][1];
                    float ss = (sq4(v00) + sq4(v01)) + (sq4(v10) + sq4(v11)); ss = lane_xor16_sum(ss); ss = lane_xor32_sum(ss);
                    const float r = rsqrtf(ss * (1.f / 64) + EPS) * post;
                    bf16_t* d = dst + (size_t)((rowb + ai * HALF + m * 16) & (SEQ - 1)) * 64;
                    *(u32x4*)d = pk8(v00 * g00 * r, v01 * g01 * r); *(u32x4*)(d + 32) = pk8(v10 * g10 * r, v11 * g11 * r); }
        } else if (pn < 9) {
#pragma unroll
            for (int bj = 0; bj < 2; ++bj) { bf16_t* dst = VD + ((size_t)(b * NH + 2 * (pn - 6) + bj) * SEQ) * 128 + c8;
#pragma unroll
                for (int ai = 0; ai < 2; ++ai)
#pragma unroll
                    for (int m = 0; m < 4; ++m) *(u32x4*)(dst + (size_t)((rowb + ai * HALF + m * 16) & (SEQ - 1)) * 128) = pk8(acc[ai][bj][m][0], acc[ai][bj][m][1]); }
        } else if (pn < 12) {
            const bool iskv = pn == 11; const int ct = iskv ? 0 : 256 * (pn - 9);
            const float* gp = (iskv ? kvag : qag) + ct + c8;
            const f32x4 g00 = *(const f32x4*)gp, g01 = *(const f32x4*)(gp + 4), g10 = *(const f32x4*)(gp + HALF), g11 = *(const f32x4*)(gp + HALF + 4);
            bf16_t* dst = (iskv ? KVA : QA) + ct + c8; const int ld = iskv ? KVRANK : QRANK;
            float* sq = iskv ? SSQ_KVA + wc : SSQ_QA + (pn - 9) * 4 + wc; const int sld = iskv ? 4 : 8;
#pragma unroll
            for (int ai = 0; ai < 2; ++ai)
#pragma unroll
                for (int m = 0; m < 4; ++m) { const int row = rowb + ai * HALF + m * 16;
                    const f32x4 v00 = acc[ai][0][m][0], v01 = acc[ai][0][m][1], v10 = acc[ai][1][m][0], v11 = acc[ai][1][m][1];
                    float ss = (sq4(v00) + sq4(v01)) + (sq4(v10) + sq4(v11)); ss = lane_xor16_sum(ss); ss = lane_xor32_sum(ss);
                    if (fq == 0) sq[(size_t)row * sld] = ss;
                    *(u32x4*)(dst + (size_t)row * ld) = pk8(v00 * g00, v01 * g01); *(u32x4*)(dst + (size_t)row * ld + HALF) = pk8(v10 * g10, v11 * g11); }
        } else if (pn < 14) {
            float* dst = UU + 256 * (pn - 12) + c8;
#pragma unroll
            for (int ai = 0; ai < 2; ++ai)
#pragma unroll
                for (int m = 0; m < 4; ++m) { float* d = dst + (size_t)(rowb + ai * HALF + m * 16) * 512;
#pragma unroll
                    for (int bj = 0; bj < 2; ++bj) { *(f32x4*)(d + bj * HALF) = gelu4(acc[ai][bj][m][0]); *(f32x4*)(d + bj * HALF + 4) = gelu4(acc[ai][bj][m][1]); } }
        } else if (pn < 16) {
            const int g0 = 2 * (pn - 14);
#pragma unroll
            for (int bj = 0; bj < 2; ++bj) { const float* gp = sgvg + (g0 + bj) * 128 + c8; const f32x4 ga = *(const f32x4*)gp, gb = *(const f32x4*)(gp + 4);
                bf16_t* dst = GV + (g0 + bj) * 128 + c8; float* sq = SSQ_SGV + (g0 + bj) * 4 + wc;
#pragma unroll
                for (int ai = 0; ai < 2; ++ai)
#pragma unroll
                    for (int m = 0; m < 4; ++m) { const int row = rowb + ai * HALF + m * 16; const f32x4 a = gelu4(acc[ai][bj][m][0]), c = gelu4(acc[ai][bj][m][1]);
                        float ss = sq4(a) + sq4(c); ss = lane_xor16_sum(ss); ss = lane_xor32_sum(ss);
                        if (fq == 0) sq[(size_t)row * 16] = ss;
                        *(u32x4*)(dst + (size_t)row * 512) = pk8(a * ga, c * gb); } }
        } else {
            if (wc < 2) {
#pragma unroll
                for (int ai = 0; ai < 2; ++ai)
#pragma unroll
                    for (int m = 0; m < 4; ++m) { const int row = rowb + ai * HALF + m * 16; float* d = KR + (size_t)row * 64 + c8; *(f32x4*)d = acc[ai][0][m][0]; *(f32x4*)(d + 4) = acc[ai][0][m][1];
                        float ss = sq4(acc[ai][0][m][0]) + sq4(acc[ai][0][m][1]); ss = lane_xor16_sum(ss); ss = lane_xor32_sum(ss); if (fq == 0) SSQ_KR[(size_t)row * 2 + wc] = ss; } }
        }
    }
};
struct EpiMlaQ {
    static constexpr bool PERM = true, AFTER_DRAIN = false;
    bf16_t* QM; const float *SSQ_QA, *COS, *SIN, *qg; PG8_LAS float* X;
    __device__ __forceinline__ void operator()(const f32x4 (&acc)[2][2][4][2], const Unit& u, int wr, int wc, int fr_, int fq_) const {
        float eps_ = EPS, k192 = 1.f / 192; asm volatile("" : "+s"(eps_), "+s"(k192));
        int fr = fr_, fq = fq_; asm volatile("" : "+v"(fr), "+v"(fq));
        const int h = u.pn, rowb = u.pm * BM + wr * 64 + fr, b = (u.pm * BM) / SEQ, c8 = wc * 32 + 8 * fq, rt = wr * 64 + fr;
#pragma unroll
        for (int ai = 0; ai < 2; ++ai)
#pragma unroll
            for (int m = 0; m < 4; ++m) { float ss = (sq4(acc[ai][0][m][0]) + sq4(acc[ai][0][m][1])) + (sq4(acc[ai][1][m][0]) + sq4(acc[ai][1][m][1])); ss = lane_xor16_sum(ss); ss = lane_xor32_sum(ss);
                if (fq == 0) X[(ai * HALF + m * 16 + rt) * 4 + wc] = ss; }
        asm volatile("s_waitcnt lgkmcnt(0)" ::: "memory"); __builtin_amdgcn_s_barrier(); asm volatile("" ::: "memory");
        const f32x4 g0a = *(const f32x4*)(qg + c8), g0b = *(const f32x4*)(qg + c8 + 4);
        const int i0 = 16 * wc + 4 * fq;
        f32x4 g1 = {0.f, 0.f, 0.f, 0.f}, g2 = g1; if (wc < 2) { g1 = *(const f32x4*)(qg + 128 + i0); g2 = *(const f32x4*)(qg + 160 + i0); }
        bf16_t* dst = QM + ((size_t)(b * NH + h) * SEQ) * 192;
#pragma unroll
        for (int ai = 0; ai < 2; ++ai)
#pragma unroll
        for (int mh = 0; mh < 4; mh += 2) {
        float rr[2][4]; f32x4 csv[2][4], snv[2][4];
#pragma unroll
            for (int m = mh; m < mh + 2; ++m) { const int row = rowb + ai * HALF + m * 16; const f32x4 xs = *(const PG8_LAS f32x4*)(X + (ai * HALF + m * 16 + rt) * 4);
                const f32x4 pa = *(const f32x4*)(SSQ_QA + (size_t)row * 8), pb = *(const f32x4*)(SSQ_QA + (size_t)row * 8 + 4);
                const float msq = (((pa[0] + pa[1]) + (pa[2] + pa[3])) + ((pb[0] + pb[1]) + (pb[2] + pb[3]))) * (1.f / 512) + eps_;
                rr[ai][m] = rsqrtf(((xs[0] + xs[1]) + (xs[2] + xs[3])) * k192 + eps_ * msq) * QS_MLA;
                if (wc < 2) { csv[ai][m] = *(const f32x4*)(COS + (size_t)row * 32 + i0); snv[ai][m] = *(const f32x4*)(SIN + (size_t)row * 32 + i0); } }
#pragma unroll
            for (int m = mh; m < mh + 2; ++m) { const int row = rowb + ai * HALF + m * 16; const float r = rr[ai][m];
                bf16_t* d = dst + (size_t)(row & (SEQ - 1)) * 192;
                *(u32x4*)(d + c8) = pk8(acc[ai][0][m][0] * g0a * r, acc[ai][0][m][1] * g0b * r);
                if (wc < 2) { const f32x4 cs = csv[ai][m], sn = snv[ai][m];
                    const f32x4 va = acc[ai][1][m][0], vb = acc[ai][1][m][1];
                    const f32x4 y1 = (f32x4){va[0], va[2], vb[0], vb[2]} * g1 * r, y2 = (f32x4){va[1], va[3], vb[1], vb[3]} * g2 * r;
                    const f32x4 o1 = y1 * cs - y2 * sn, o2 = y2 * cs + y1 * sn;
                    *(u32x4*)(d + 128 + c8) = pk8((f32x4){o1[0], o2[0], o1[1], o2[1]}, (f32x4){o1[2], o2[2], o1[3], o2[3]}); } }
        }
        asm volatile("s_waitcnt lgkmcnt(0)" ::: "memory"); __builtin_amdgcn_s_barrier(); asm volatile("" ::: "memory");
    }
};
struct EpiMlaKV {
    static constexpr bool PERM = true, AFTER_DRAIN = false;
    bf16_t *KM, *VM; const float *SSQ_KVA, *SSQ_KR, *KR, *COS, *SIN, *kg; PG8_LAS float* X;
    __device__ __forceinline__ void operator()(const f32x4 (&acc)[2][2][4][2], const Unit& u, int wr, int wc, int fr_, int fq_) const {
        float eps_ = EPS, k192 = 1.f / 192; asm volatile("" : "+s"(eps_), "+s"(k192));
        int fr = fr_, fq = fq_; asm volatile("" : "+v"(fr), "+v"(fq));
        const int h = u.pn, rowb = u.pm * BM + wr * 64 + fr, b = (u.pm * BM) / SEQ, c8 = wc * 32 + 8 * fq, rt = wr * 64 + fr;
#pragma unroll
        for (int ai = 0; ai < 2; ++ai)
#pragma unroll
            for (int m = 0; m < 4; ++m) { float ss = sq4(acc[ai][0][m][0]) + sq4(acc[ai][0][m][1]); ss = lane_xor16_sum(ss); ss = lane_xor32_sum(ss);
                if (fq == 0) X[(ai * HALF + m * 16 + rt) * 4 + wc] = ss; }
        asm volatile("s_waitcnt lgkmcnt(0)" ::: "memory"); __builtin_amdgcn_s_barrier(); asm volatile("" ::: "memory");
        const f32x4 g0a = *(const f32x4*)(kg + c8), g0b = *(const f32x4*)(kg + c8 + 4);
        const int i0 = 8 * wc + 2 * fq;
        const float g1a = kg[128 + i0], g1b = kg[128 + i0 + 1], g2a = kg[160 + i0], g2b = kg[160 + i0 + 1];
        bf16_t* kd = KM + ((size_t)(b * NH + h) * SEQ) * 192; bf16_t* vd = VM + ((size_t)(b * NH + h) * SEQ) * 128;
#pragma unroll
        for (int ai = 0; ai < 2; ++ai) {
        float rr[2][4], cv[2][4]; float2 k1v[2][4], k2v[2][4], cpv[2][4], spv[2][4];
#pragma unroll
            for (int m = 0; m < 4; ++m) { const int row = rowb + ai * HALF + m * 16; const f32x4 xs = *(const PG8_LAS f32x4*)(X + (ai * HALF + m * 16 + rt) * 4);
                const f32x4 pc = *(const f32x4*)(SSQ_KVA + (size_t)row * 4);
                const float c2 = 1.0f / (((pc[0] + pc[1]) + (pc[2] + pc[3])) * (1.f / 256) + eps_);
                const float2 sk = *(const float2*)(SSQ_KR + (size_t)row * 2);
                cv[ai][m] = sqrtf(c2); rr[ai][m] = rsqrtf((c2 * ((xs[0] + xs[1]) + (xs[2] + xs[3])) + (sk.x + sk.y)) * k192 + eps_);
                const float* kr = KR + (size_t)row * 64 + i0;
                k1v[ai][m] = *(const float2*)kr; k2v[ai][m] = *(const float2*)(kr + 32); cpv[ai][m] = *(const float2*)(COS + (size_t)row * 32 + i0); spv[ai][m] = *(const float2*)(SIN + (size_t)row * 32 + i0); }
#pragma unroll
            for (int m = 0; m < 4; ++m) { const int row = rowb + ai * HALF + m * 16; const float r = rr[ai][m], ckv = cv[ai][m];
                const int srow = row & (SEQ - 1);
                *(u32x4*)(kd + (size_t)srow * 192 + c8) = pk8(acc[ai][0][m][0] * g0a * (ckv * r), acc[ai][0][m][1] * g0b * (ckv * r));
                *(u32x4*)(vd + (size_t)srow * 128 + c8) = pk8(acc[ai][1][m][0] * ckv, acc[ai][1][m][1] * ckv);
                const float2 cp = cpv[ai][m], sp = spv[ai][m];
                const float y1a = k1v[ai][m].x * r * g1a, y1b = k1v[ai][m].y * r * g1b, y2a = k2v[ai][m].x * r * g2a, y2b = k2v[ai][m].y * r * g2b;
                const float oa1 = y1a * cp.x - y2a * sp.x, oa2 = y2a * cp.x + y1a * sp.x, ob1 = y1b * cp.y - y2b * sp.y, ob2 = y2b * cp.y + y1b * sp.y;
                *(unsigned long long*)(kd + (size_t)srow * 192 + 128 + 2 * i0) = (unsigned long long)cvt_pk_bf16(oa1, oa2) | ((unsigned long long)cvt_pk_bf16(ob1, ob2) << 32); }
        }
        asm volatile("s_waitcnt lgkmcnt(0)" ::: "memory"); __builtin_amdgcn_s_barrier(); asm volatile("" ::: "memory");
    }
};
}

struct Frame {
    LAS unsigned char* lds;
    int tid, lane, wave, wave0, gw, ngw, bid, G;
    const __attribute__((address_space(4))) Args* ka; const int* pos;
    float* out; unsigned char* ws;
};
__device__ __forceinline__ size_t opq(size_t v) { asm volatile("" : "+s"(v)); return v; }
#define WSP(T, off) ((T*)(F.ws + opq(off)))
#define FIN(i) ((const float*)F.ka->in[i])
__device__ __forceinline__ const bf16* wptr(const Frame& F, int l, size_t off) { return (const bf16*)(F.ws + WS_W + (size_t)l * WL_STRIDE + off); }

__device__ __forceinline__ void p0_transpose_item(const float* W, int K, int N, bf16* WT, int row_off, LAS float* scr, int item, int lane, int rstride = 1) {
    const int nblk = N / 32, kb = item / nblk, nb = item % nblk, k0 = 64 * kb, n0 = 32 * nb;
    float wv_[32];
#pragma unroll
    for (int i = 0; i < 32; ++i) { const int kk = 2 * i + (lane >> 5); wv_[i] = W[(size_t)(k0 + kk) * N + n0 + (lane & 31)]; }
#pragma unroll
    for (int i = 0; i < 32; ++i) { const int kk = 2 * i + (lane >> 5); scr[kk * 33 + (lane & 31)] = wv_[i]; }
    LDS_WAIT(); asm volatile("" ::: "memory");
    const int c = lane & 7;
#pragma unroll
    for (int j = 0; j < 4; ++j) { const int n = (lane >> 3) + 8 * j; const LAS float* s = scr + (8 * c) * 33 + n;
        v4u o; o.x = pk2(s[0 * 33], s[1 * 33]); o.y = pk2(s[2 * 33], s[3 * 33]); o.z = pk2(s[4 * 33], s[5 * 33]); o.w = pk2(s[6 * 33], s[7 * 33]);
        *(v4u*)(WT + (size_t)(row_off + n0 + rstride * n) * K + k0 + 8 * c) = o; }
    LDS_WAIT(); asm volatile("" ::: "memory");
}
__device__ __forceinline__ void ph_prologue(Frame& F) {
    LAS float* scr = (LAS float*)(F.lds + F.wave * 16384);
    constexpr int I_IN = (D / 64) * (IN_COLS / 32), I_UQ = (QRANK / 64) * (UQ_N / 32), I_UKV = (KVRANK / 64) * (UKV_N / 32), I_OUT = (D / 64) * (D / 32), I_UP = (D / 64) * (NUP / 32), I_DN = (DFF / 64) * (D / 32);
    constexpr int I_L = I_IN + I_UQ + I_UKV + I_OUT + I_UP + I_DN;
    for (int it = F.gw; it < DEPTH * I_L; it += F.ngw) {
        const int l = it / I_L; int r = it % I_L;
        bf16* wl = (bf16*)(F.ws + WS_W + (size_t)l * WL_STRIDE);
        if (r < I_IN) { const int n0 = 32 * (r % (IN_COLS / 32)); int dst;
            if (n0 < C_DAV) { const int q = n0 % 768, G = q / 64, e = q % 64; dst = (n0 - q) + 256 * (G / 4) + 128 * (e / 32) + 32 * (G % 4) + (e % 32); }
            else if (n0 < C_KR) dst = n0;
            else if (n0 < C_SGU) dst = 4096 + (n0 - C_KR);
            else dst = n0 - 64;
            p0_transpose_item(FIN(I_WIN) + (size_t)l * D * IN_COLS, D, IN_COLS, (bf16*)((unsigned char*)wl + WL_IN), dst - n0, scr, r, F.lane); continue; } r -= I_IN;
        if (r < I_UQ) { const int n0 = 32 * (r % (UQ_N / 32)), hh = n0 / 192, e = n0 % 192;
            const int dst = 256 * hh + (e < 128 ? e : 128 + (e - 128) / 32);
            p0_transpose_item(FIN(I_WUQ) + (size_t)l * QRANK * UQ_N, QRANK, UQ_N, (bf16*)((unsigned char*)wl + WL_UQ), dst - n0, scr, r, F.lane, e < 128 ? 1 : 2); continue; } r -= I_UQ;
        if (r < I_UKV) { p0_transpose_item(FIN(I_WUKV) + (size_t)l * KVRANK * UKV_N, KVRANK, UKV_N, (bf16*)((unsigned char*)wl + WL_UKV), 0, scr, r, F.lane); continue; } r -= I_UKV;
        if (r < I_OUT) { p0_transpose_item(FIN(I_WOUT) + (size_t)l * D * D, D, D, (bf16*)((unsigned char*)wl + WL_OUT), 0, scr, r, F.lane); continue; } r -= I_OUT;
        if (r < I_UP) { const int n0 = 32 * (r % (NUP / 32)), chn = n0 % DFF, dst = 256 * (chn / 128) + 128 * (n0 / DFF) + (chn % 128);
            p0_transpose_item(FIN(I_WUP) + (size_t)l * D * NUP, D, NUP, (bf16*)((unsigned char*)wl + WL_UP), dst - n0, scr, r, F.lane); continue; } r -= I_UP;
        p0_transpose_item(FIN(I_WDOWN) + (size_t)l * DFF * D, DFF, D, (bf16*)((unsigned char*)wl + WL_DOWN), 0, scr, r, F.lane);
    }
    {
        const int gt = F.bid * NTHREADS + F.tid, nt = F.G * NTHREADS;
        constexpr int Z_IN = (IN_PAD - IN_COLS) * D / 8, Z_UQ = NH * 64 * QRANK / 8;
        for (int i = gt; i < DEPTH * (Z_IN + Z_UQ); i += nt) { const int l = i / (Z_IN + Z_UQ); int r = i % (Z_IN + Z_UQ);
            unsigned char* wl = F.ws + WS_W + (size_t)l * WL_STRIDE;
            v4u z = {0u, 0u, 0u, 0u};
            if (r < Z_IN) *(v4u*)(wl + WL_IN + (size_t)IN_COLS * D * 2 + (size_t)r * 16) = z;
            else { r -= Z_IN; const int hh = r / (64 * QRANK / 8), q = r % (64 * QRANK / 8); *(v4u*)(wl + WL_UQ + ((size_t)(256 * hh + 192) * QRANK) * 2 + (size_t)q * 16) = z; } }
    }
    __syncthreads();
    LAS float* cond = (LAS float*)F.lds;
    for (int i = F.tid; i < 2 * D; i += NTHREADS) cond[i] = silu_f(FIN(I_C)[i]);
    __syncthreads();
    {
        const int gt = F.bid * NTHREADS + F.tid, nt = F.G * NTHREADS;
        float* part = WSP(float, WS_MODP);
        for (int it = gt; it < DEPTH * 16 * 3072; it += nt) {
            const int n4 = it % 3072, ks = (it / 3072) % 16, l = it / (3072 * 16);
            const float* w = FIN(I_WADA) + ((size_t)l * D + ks * 128) * (6 * D) + n4 * 4;
            f32x4 a0 = {0.f, 0.f, 0.f, 0.f}, a1 = {0.f, 0.f, 0.f, 0.f};
#pragma unroll 8
            for (int k = 0; k < 128; ++k) { const f32x4 wv = *(const f32x4*)(w + (size_t)k * (6 * D)); a0 += cond[ks * 128 + k] * wv; a1 += cond[D + ks * 128 + k] * wv; }
            *(f32x4*)(part + ((size_t)(l * 16 + ks) * 2 + 0) * (6 * D) + n4 * 4) = a0;
            *(f32x4*)(part + ((size_t)(l * 16 + ks) * 2 + 1) * (6 * D) + n4 * 4) = a1;
        }
    }
    __syncthreads();
}
__device__ __forceinline__ void ph_modreduce(Frame& F) {
    const int gt = F.bid * NTHREADS + F.tid, nt = F.G * NTHREADS;
    const float* part = WSP(float, WS_MODP); float* mod = WSP(float, WS_MOD);
    for (int i = gt; i < DEPTH * 2 * 6 * D; i += nt) { const int n = i % (6 * D), b = (i / (6 * D)) & 1, l = i / (12 * D);
        float s = FIN(I_BADA)[l * 6 * D + n];
#pragma unroll
        for (int ks = 0; ks < 16; ++ks) s += part[((size_t)(l * 16 + ks) * 2 + b) * (6 * D) + n];
        mod[i] = s; }
    { float* ct = WSP(float, WS_COS); float* st = WSP(float, WS_SIN);
      for (int i = gt; i < M * 32; i += nt) { const float ang = (float)F.pos[i >> 5] * ROPE_INV[i & 31];
          const double rev = (double)ang * 0.15915494309189535; const float fr = (float)(rev - floor(rev));
          ct[i] = __builtin_amdgcn_cosf(fr); st[i] = __builtin_amdgcn_sinf(fr); } }
    if (gt < M / 64) { int mn = 0x7fffffff, mx = -0x7fffffff - 1;
        for (int i = 0; i < 64; ++i) { const int p = F.pos[gt * 64 + i]; mn = p < mn ? p : mn; mx = p > mx ? p : mx; }
        int* mm = WSP(int, WS_POSMM); mm[gt * 2] = mn; mm[gt * 2 + 1] = mx; }
}
template <bool XBF> __device__ __forceinline__ void ph_norm(Frame& F, int l, const void* xsrc, int sh_off, int sc_off) {
    const float* mod = WSP(float, WS_MOD) + (size_t)l * 12 * D; bf16* H = WSP(bf16, WS_H);
    for (int row = F.gw; row < M; row += F.ngw) {
        const int b = row >> 13;
        const float* mb = mod + (size_t)b * 6 * D;
        if constexpr (XBF) {
            const v4u* xr = (const v4u*)((const bf16*)xsrc + (size_t)row * D) + F.lane;
            v4u w[4]; float v[4][8]; float s = 0.f;
#pragma unroll
            for (int j = 0; j < 4; ++j) w[j] = xr[64 * j];
#pragma unroll
            for (int j = 0; j < 4; ++j) { const unsigned ww[4] = {w[j].x, w[j].y, w[j].z, w[j].w};
#pragma unroll
                for (int q = 0; q < 4; ++q) { v[j][2 * q] = pg8::uph_lo(ww[q]); v[j][2 * q + 1] = pg8::uph_hi(ww[q]); s += v[j][2 * q] * v[j][2 * q] + v[j][2 * q + 1] * v[j][2 * q + 1]; } }
            const float r = rsqrtf(wave_sum(s) * (1.f / D) + EPS);
            v4u* o16 = (v4u*)(H + (size_t)row * D) + F.lane;
#pragma unroll
            for (int j = 0; j < 4; ++j) { const int c = 8 * F.lane + 512 * j;
                const f32x4 sc0 = *(const f32x4*)(mb + sc_off + c), sc1 = *(const f32x4*)(mb + sc_off + c + 4), sh0 = *(const f32x4*)(mb + sh_off + c), sh1 = *(const f32x4*)(mb + sh_off + c + 4);
                v4u o; o.x = pk2(v[j][0] * r * (1.0f + sc0.x) + sh0.x, v[j][1] * r * (1.0f + sc0.y) + sh0.y); o.y = pk2(v[j][2] * r * (1.0f + sc0.z) + sh0.z, v[j][3] * r * (1.0f + sc0.w) + sh0.w);
                o.z = pk2(v[j][4] * r * (1.0f + sc1.x) + sh1.x, v[j][5] * r * (1.0f + sc1.y) + sh1.y); o.w = pk2(v[j][6] * r * (1.0f + sc1.z) + sh1.z, v[j][7] * r * (1.0f + sc1.w) + sh1.w);
                o16[64 * j] = o; }
        } else {
        const f32x4* xr = (const f32x4*)((const float*)xsrc + (size_t)row * D) + F.lane;
        f32x4 v[8]; float s = 0.f;
#pragma unroll
        for (int j = 0; j < 8; ++j) { v[j] = xr[64 * j]; s += (v[j].x * v[j].x + v[j].y * v[j].y) + (v[j].z * v[j].z + v[j].w * v[j].w); }
        const float r = rsqrtf(wave_sum(s) * (1.f / D) + EPS);
        unsigned long long* o8 = (unsigned long long*)(H + (size_t)row * D) + F.lane;
#pragma unroll
        for (int j = 0; j < 8; ++j) { const int c = 4 * F.lane + 256 * j;
            const f32x4 sc = *(const f32x4*)(mb + sc_off + c), sh = *(const f32x4*)(mb + sh_off + c);
            const f32x4 y = v[j] * r * (1.0f + sc) + sh;
            o8[64 * j] = (unsigned long long)pk2(y.x, y.y) | ((unsigned long long)pk2(y.z, y.w) << 32); }
        }
    }
}

namespace fa {
#ifndef PIPE_MLA
#define PIPE_MLA 1
#endif
#ifndef PIPE_LIN
#define PIPE_LIN 0
#endif
#ifndef PIPE_GEN
#define PIPE_GEN 0
#endif
#ifndef PIPE_OLD64
#define PIPE_OLD64 0
#endif
template <typename T> __device__ __forceinline__ T ldg(const void* base, unsigned off) { return *(const T*)((const char*)base + off); }
template <typename T> __device__ __forceinline__ void stg(void* base, unsigned off, T v) { *(T*)((char*)base + off) = v; }
constexpr int crowc(int r) { return (r & 3) + 8 * (r >> 2); }
using s16x4 = __attribute__((ext_vector_type(4))) short;
using f32x8 = __attribute__((ext_vector_type(8))) float;
constexpr int QBLK = 32, KVBLK = 64, DV = 128;
constexpr int SHM_V = KVBLK * DV * 2;
constexpr float THR = 11.5f;
#define FA_SBAR() __builtin_amdgcn_sched_barrier(0)
__device__ __forceinline__ unsigned cvtpk(float lo, float hi) { unsigned r; asm volatile("v_cvt_pk_bf16_f32 %0, %1, %2" : "=v"(r) : "v"(lo), "v"(hi)); return r; }
__device__ __forceinline__ int kswz(int row, int colB) { return (colB >> 7) * 8192 + row * 128 + ((colB & 127) ^ (((row >> 1) & 7) << 4)); }
__device__ __forceinline__ int v_st(int k, int c) { const int kk = (k & ~0xC) | ((k & 4) << 1) | ((k & 8) >> 1); return ((kk >> 3) * 4 + (c >> 5)) * 512 + ((kk & 7) * 32 + (c & 31)) * 2; }
__device__ __forceinline__ int v_st_nat(int k, int c) { return ((k >> 3) * 4 + (c >> 5)) * 512 + ((k & 7) * 32 + (c & 31)) * 2; }
__device__ __forceinline__ int v_rd_base(int lane) { return ((lane & 3) << 3) | (((lane >> 2) & 3) << 6) | (((lane >> 4) & 1) << 5) | (((lane >> 5) & 1) << 8); }
constexpr int v_rd_off(int d0, int ks, int half) { return d0 * 512 + ks * 4096 + half * 2048; }
template <int OFF> __device__ __forceinline__ s16x4 tr_read(int vb) { s16x4 r; asm volatile("ds_read_b64_tr_b16 %0, %1 offset:%2" : "=&v"(r) : "v"(vb), "i"(OFF) : "memory"); return r; }
template <int D0> __device__ __forceinline__ void pv_one(f32x16& od, int vb, bf16x8 pa0, bf16x8 pa1, bf16x8 pa2, bf16x8 pa3) {
    const s16x4 l0 = tr_read<v_rd_off(D0, 0, 0)>(vb), h0 = tr_read<v_rd_off(D0, 0, 1)>(vb), l1 = tr_read<v_rd_off(D0, 1, 0)>(vb), h1 = tr_read<v_rd_off(D0, 1, 1)>(vb);
    const s16x4 l2 = tr_read<v_rd_off(D0, 2, 0)>(vb), h2 = tr_read<v_rd_off(D0, 2, 1)>(vb), l3 = tr_read<v_rd_off(D0, 3, 0)>(vb), h3 = tr_read<v_rd_off(D0, 3, 1)>(vb);
    asm volatile("s_waitcnt lgkmcnt(0)" ::: "memory"); FA_SBAR();
#define FA_PK(L, H) (bf16x8){L[0], L[1], L[2], L[3], H[0], H[1], H[2], H[3]}
    od = __builtin_amdgcn_mfma_f32_32x32x16_bf16(pa0, FA_PK(l0, h0), od, 0, 0, 0);
    od = __builtin_amdgcn_mfma_f32_32x32x16_bf16(pa1, FA_PK(l1, h1), od, 0, 0, 0);
    od = __builtin_amdgcn_mfma_f32_32x32x16_bf16(pa2, FA_PK(l2, h2), od, 0, 0, 0);
    od = __builtin_amdgcn_mfma_f32_32x32x16_bf16(pa3, FA_PK(l3, h3), od, 0, 0, 0);
#undef FA_PK
}
__device__ __forceinline__ void pv_d0(f32x16* o, int vb, bf16x8 pa0, bf16x8 pa1, bf16x8 pa2, bf16x8 pa3) {
    pv_one<0>(o[0], vb, pa0, pa1, pa2, pa3); pv_one<1>(o[1], vb, pa0, pa1, pa2, pa3); pv_one<2>(o[2], vb, pa0, pa1, pa2, pa3); pv_one<3>(o[3], vb, pa0, pa1, pa2, pa3);
}
template <int D0> __device__ __forceinline__ void pv_reads(s16x4 (&l)[4], s16x4 (&h)[4], int vb) {
    l[0] = tr_read<v_rd_off(D0, 0, 0)>(vb); h[0] = tr_read<v_rd_off(D0, 0, 1)>(vb); l[1] = tr_read<v_rd_off(D0, 1, 0)>(vb); h[1] = tr_read<v_rd_off(D0, 1, 1)>(vb);
    l[2] = tr_read<v_rd_off(D0, 2, 0)>(vb); h[2] = tr_read<v_rd_off(D0, 2, 1)>(vb); l[3] = tr_read<v_rd_off(D0, 3, 0)>(vb); h[3] = tr_read<v_rd_off(D0, 3, 1)>(vb);
}
__device__ __forceinline__ void pv_mfma(f32x16& od, const s16x4 (&l)[4], const s16x4 (&h)[4], bf16x8 pa0, bf16x8 pa1, bf16x8 pa2, bf16x8 pa3) {
#define FA_PK(L, H) (bf16x8){L[0], L[1], L[2], L[3], H[0], H[1], H[2], H[3]}
    od = __builtin_amdgcn_mfma_f32_32x32x16_bf16(pa0, FA_PK(l[0], h[0]), od, 0, 0, 0);
    od = __builtin_amdgcn_mfma_f32_32x32x16_bf16(pa1, FA_PK(l[1], h[1]), od, 0, 0, 0);
    od = __builtin_amdgcn_mfma_f32_32x32x16_bf16(pa2, FA_PK(l[2], h[2]), od, 0, 0, 0);
    od = __builtin_amdgcn_mfma_f32_32x32x16_bf16(pa3, FA_PK(l[3], h[3]), od, 0, 0, 0);
#undef FA_PK
}
__device__ __forceinline__ void pv_d0_pipe(f32x16* o, int vb, bf16x8 pa0, bf16x8 pa1, bf16x8 pa2, bf16x8 pa3) {
    s16x4 la[4], ha[4], lb[4], hb[4];
    pv_reads<0>(la, ha, vb); pv_reads<1>(lb, hb, vb);
    asm volatile("s_waitcnt lgkmcnt(8)" ::: "memory"); FA_SBAR(); pv_mfma(o[0], la, ha, pa0, pa1, pa2, pa3); FA_SBAR();
    pv_reads<2>(la, ha, vb);
    asm volatile("s_waitcnt lgkmcnt(8)" ::: "memory"); FA_SBAR(); pv_mfma(o[1], lb, hb, pa0, pa1, pa2, pa3); FA_SBAR();
    pv_reads<3>(lb, hb, vb);
    asm volatile("s_waitcnt lgkmcnt(8)" ::: "memory"); FA_SBAR(); pv_mfma(o[2], la, ha, pa0, pa1, pa2, pa3); FA_SBAR();
    asm volatile("s_waitcnt lgkmcnt(0)" ::: "memory"); FA_SBAR(); pv_mfma(o[3], lb, hb, pa0, pa1, pa2, pa3);
}
__device__ __forceinline__ void partialSM(f32x16& p0, f32x16& p1, float& m_reg, float& alpha) {
    float pmax = p0[0];
#pragma unroll
    for (int r = 1; r < 16; ++r) pmax = fmaxf(pmax, p0[r]);
#pragma unroll
    for (int r = 0; r < 16; ++r) pmax = fmaxf(pmax, p1[r]);
    { auto rr = __builtin_amdgcn_permlane32_swap(__float_as_uint(pmax), __float_as_uint(pmax), false, false); pmax = fmaxf(__uint_as_float(rr[0]), __uint_as_float(rr[1])); }
    float mn;
    if (__builtin_expect(__all(pmax - m_reg <= THR), 1)) { mn = m_reg; alpha = 1.f; }
    else { mn = fmaxf(m_reg, pmax); alpha = __builtin_amdgcn_exp2f(m_reg - mn); m_reg = mn; }
#pragma unroll
    for (int r = 0; r < 16; ++r) { p0[r] -= mn; p1[r] -= mn; }
#pragma unroll
    for (int r = 0; r < 16; ++r) p0[r] = __builtin_amdgcn_exp2f(p0[r]);
}
__device__ __forceinline__ void finishSM(f32x16& p0, f32x16& p1, float alpha, float& l_reg, bf16x8& pa0, bf16x8& pa1, bf16x8& pa2, bf16x8& pa3) {
#pragma unroll
    for (int r = 0; r < 16; ++r) p1[r] = __builtin_amdgcn_exp2f(p1[r]);
    float ps = 0;
#pragma unroll
    for (int r = 0; r < 16; ++r) ps += p0[r];
#pragma unroll
    for (int r = 0; r < 16; ++r) ps += p1[r];
    { auto rr = __builtin_amdgcn_permlane32_swap(__float_as_uint(ps), __float_as_uint(ps), false, false); ps = __uint_as_float(rr[0]) + __uint_as_float(rr[1]); }
    l_reg = l_reg * alpha + ps;
#define FA_PK4(P, BASE, OUT) do { unsigned a0 = cvtpk(P[BASE + 0], P[BASE + 1]), a1 = cvtpk(P[BASE + 2], P[BASE + 3]);   \
    unsigned b0 = cvtpk(P[BASE + 4], P[BASE + 5]), b1 = cvtpk(P[BASE + 6], P[BASE + 7]);                              \
    auto r0 = __builtin_amdgcn_permlane32_swap(a0, b0, false, false); auto r1 = __builtin_amdgcn_permlane32_swap(a1, b1, false, false); \
    u32x4_t w = {r0[0], r1[0], r0[1], r1[1]}; OUT = __builtin_bit_cast(bf16x8, w); } while (0)
    typedef unsigned u32x4_t __attribute__((ext_vector_type(4)));
    FA_PK4(p0, 0, pa0); FA_PK4(p0, 8, pa1); FA_PK4(p1, 0, pa2); FA_PK4(p1, 8, pa3);
#undef FA_PK4
}
template <bool ALIBI> __device__ __forceinline__ void fr_init(f32x16& p0, f32x16& p1, const LAS float* posl, float posq, float slope2, bool linear, int hi) {
    if (linear) {
        const float cl = -slope2 * posq;
#pragma unroll
        for (int g = 0; g < 4; ++g) { const f32x4 k0 = *(const LAS f32x4*)(posl + 8 * g + 4 * hi), k1 = *(const LAS f32x4*)(posl + 32 + 8 * g + 4 * hi);
#pragma unroll
            for (int e = 0; e < 4; ++e) { p0[4 * g + e] = fmaf(slope2, k0[e], cl); p1[4 * g + e] = fmaf(slope2, k1[e], cl); } }
    } else {
#pragma unroll
        for (int g = 0; g < 4; ++g) { const f32x4 k0 = *(const LAS f32x4*)(posl + 8 * g + 4 * hi), k1 = *(const LAS f32x4*)(posl + 32 + 8 * g + 4 * hi);
#pragma unroll
            for (int e = 0; e < 4; ++e) { p0[4 * g + e] = -slope2 * fabsf(posq - k0[e]); p1[4 * g + e] = -slope2 * fabsf(posq - k1[e]); } }
    }
}
__device__ __forceinline__ void fr_softmax(f32x16& p0, f32x16& p1, float& l_reg, bf16x8& pa0, bf16x8& pa1, bf16x8& pa2, bf16x8& pa3) {
#pragma unroll
    for (int r = 0; r < 16; ++r) { p0[r] = __builtin_amdgcn_exp2f(p0[r]); p1[r] = __builtin_amdgcn_exp2f(p1[r]); }
    float sa = 0.f, sb = 0.f;
#pragma unroll
    for (int r = 0; r < 16; ++r) { sa += p0[r]; sb += p1[r]; }
    l_reg += sa + sb;
    typedef unsigned u32x4_t __attribute__((ext_vector_type(4)));
#define FA_PKS(P, BASE, OUT) do { u32x4_t w = {cvtpk(P[BASE + 0], P[BASE + 1]), cvtpk(P[BASE + 2], P[BASE + 3]), cvtpk(P[BASE + 4], P[BASE + 5]), cvtpk(P[BASE + 6], P[BASE + 7])}; OUT = __builtin_bit_cast(bf16x8, w); } while (0)
    FA_PKS(p0, 0, pa0); FA_PKS(p0, 8, pa1); FA_PKS(p1, 0, pa2); FA_PKS(p1, 8, pa3);
#undef FA_PKS
}
template <int DQK> struct Lds {
    static constexpr int SHM_K = KVBLK * DQK * 2;
    static constexpr int V_OFF = 0, K_OFF = 2 * SHM_V, POS_OFF = K_OFF + 2 * SHM_K, WS_OFF = POS_OFF + 2 * 256, END = WS_OFF + 8 * 256;
};
template <int DQK, bool INIT = true> __device__ __forceinline__ void qkt(f32x16& p0, f32x16& p1, const LAS unsigned char* Ks, const bf16x8* qr, int r32, int hi) {
    if (INIT) { p0 = f32x16{}; p1 = f32x16{}; }
#pragma unroll
    for (int d0 = 0; d0 < DQK / 16; ++d0) { const int cb = (d0 * 16 + hi * 8) * 2;
        const bf16x8 b0 = *(const LAS bf16x8*)(Ks + kswz(r32, cb));
        const bf16x8 b1 = *(const LAS bf16x8*)(Ks + kswz(32 + r32, cb));
        p0 = __builtin_amdgcn_mfma_f32_32x32x16_bf16(b0, qr[d0], p0, 0, 0, 0);
        p1 = __builtin_amdgcn_mfma_f32_32x32x16_bf16(b1, qr[d0], p1, 0, 0, 0);
        if (DQK > 64 && (d0 & 3) == 3) FA_SBAR(); }
}
template <int OFF> __device__ __forceinline__ bf16x8 k_read(int addr) { bf16x8 r; asm volatile("ds_read_b128 %0, %1 offset:%2" : "=&v"(r) : "v"(addr), "i"(OFF) : "memory"); return r; }
__device__ __forceinline__ void k_bases(int (&ka)[4], const LAS unsigned char* K_lds, int r32, int hi) {
#pragma unroll
    for (int j = 0; j < 4; ++j) ka[j] = (int)(uintptr_t)K_lds + r32 * 128 + ((j * 32 + hi * 16) ^ (((r32 >> 1) & 7) << 4));
}
#define FA_LGK(n) asm volatile("s_waitcnt lgkmcnt(" #n ")" ::: "memory")
template <int DQK, int BOFF, int VAR = 0> __device__ __forceinline__ void qkt_pipe(f32x16& p0, f32x16& p1, const int (&ka)[4], const bf16x8* qr) {
    if constexpr (DQK == 64) {
        bf16x8 a0 = k_read<BOFF>(ka[0]), b0 = k_read<BOFF + 4096>(ka[0]), a1 = k_read<BOFF>(ka[1]), b1 = k_read<BOFF + 4096>(ka[1]);
        bf16x8 a2 = k_read<BOFF>(ka[2]), b2 = k_read<BOFF + 4096>(ka[2]), a3 = k_read<BOFF>(ka[3]), b3 = k_read<BOFF + 4096>(ka[3]);
        FA_LGK(6); FA_SBAR(); p0 = __builtin_amdgcn_mfma_f32_32x32x16_bf16(a0, qr[0], p0, 0, 0, 0); p1 = __builtin_amdgcn_mfma_f32_32x32x16_bf16(b0, qr[0], p1, 0, 0, 0); FA_SBAR();
        FA_LGK(4); FA_SBAR(); p0 = __builtin_amdgcn_mfma_f32_32x32x16_bf16(a1, qr[1], p0, 0, 0, 0); p1 = __builtin_amdgcn_mfma_f32_32x32x16_bf16(b1, qr[1], p1, 0, 0, 0); FA_SBAR();
        FA_LGK(2); FA_SBAR(); p0 = __builtin_amdgcn_mfma_f32_32x32x16_bf16(a2, qr[2], p0, 0, 0, 0); p1 = __builtin_amdgcn_mfma_f32_32x32x16_bf16(b2, qr[2], p1, 0, 0, 0); FA_SBAR();
        FA_LGK(0); FA_SBAR(); p0 = __builtin_amdgcn_mfma_f32_32x32x16_bf16(a3, qr[3], p0, 0, 0, 0); p1 = __builtin_amdgcn_mfma_f32_32x32x16_bf16(b3, qr[3], p1, 0, 0, 0); FA_SBAR();
    } else {
        static_assert(DQK == 192, "qkt_pipe: d = 64 or 192");
#define FA_KG(G, x0, y0, x1, y1) do { x0 = k_read<BOFF + ((2 * (G)) >> 2) * 8192>(ka[(2 * (G)) & 3]); y0 = k_read<BOFF + ((2 * (G)) >> 2) * 8192 + 4096>(ka[(2 * (G)) & 3]); \
        x1 = k_read<BOFF + ((2 * (G) + 1) >> 2) * 8192>(ka[(2 * (G) + 1) & 3]); y1 = k_read<BOFF + ((2 * (G) + 1) >> 2) * 8192 + 4096>(ka[(2 * (G) + 1) & 3]); } while (0)
#define FA_KM(G, x0, y0, x1, y1) do { FA_SBAR(); if (VAR == 6) { p0 = __builtin_amdgcn_mfma_f32_32x32x16_bf16(x0 ^ y0 ^ x1 ^ y1, qr[2 * (G)], p0, 0, 0, 0); } else { \
        p0 = __builtin_amdgcn_mfma_f32_32x32x16_bf16(x0, qr[2 * (G)], p0, 0, 0, 0); p1 = __builtin_amdgcn_mfma_f32_32x32x16_bf16(y0, qr[2 * (G)], p1, 0, 0, 0); \
        p0 = __builtin_amdgcn_mfma_f32_32x32x16_bf16(x1, qr[2 * (G) + 1], p0, 0, 0, 0); p1 = __builtin_amdgcn_mfma_f32_32x32x16_bf16(y1, qr[2 * (G) + 1], p1, 0, 0, 0); } FA_SBAR(); } while (0)
        bf16x8 a0, b0, a1, b1, c0, d0, c1, d1;
        if constexpr (VAR == 5) {
#pragma unroll
            for (int g = 0; g < 12; ++g) { FA_SBAR(); p0 = __builtin_amdgcn_mfma_f32_32x32x16_bf16(qr[(g + 1) % 12], qr[g], p0, 0, 0, 0); p1 = __builtin_amdgcn_mfma_f32_32x32x16_bf16(qr[(g + 5) % 12], qr[g], p1, 0, 0, 0); FA_SBAR(); }
            return; }
        FA_KG(0, a0, b0, a1, b1); FA_KG(1, c0, d0, c1, d1);
        FA_LGK(4); FA_KM(0, a0, b0, a1, b1); FA_KG(2, a0, b0, a1, b1);
        FA_LGK(4); FA_KM(1, c0, d0, c1, d1); FA_KG(3, c0, d0, c1, d1);
        FA_LGK(4); FA_KM(2, a0, b0, a1, b1); FA_KG(4, a0, b0, a1, b1);
        FA_LGK(4); FA_KM(3, c0, d0, c1, d1); FA_KG(5, c0, d0, c1, d1);
        FA_LGK(4); FA_KM(4, a0, b0, a1, b1);
        FA_LGK(0); FA_KM(5, c0, d0, c1, d1);
#undef FA_KG
#undef FA_KM
    }
}
template <bool ALIBI> __device__ __forceinline__ void fixup(f32x16& p0, f32x16& p1, const LAS float* posl, float posq, float slope2, bool masked, int hi) {
    if (ALIBI) {
#pragma unroll
        for (int g = 0; g < 4; ++g) { const f32x4 k0 = *(const LAS f32x4*)(posl + 8 * g + 4 * hi), k1 = *(const LAS f32x4*)(posl + 32 + 8 * g + 4 * hi);
#pragma unroll
            for (int e = 0; e < 4; ++e) { p0[4 * g + e] = fmaf(-slope2, fabsf(posq - k0[e]), p0[4 * g + e]); p1[4 * g + e] = fmaf(-slope2, fabsf(posq - k1[e]), p1[4 * g + e]); } }
    }
    if (masked) {
#pragma unroll
        for (int r = 0; r < 16; ++r) { p0[r] = -INFINITY; p1[r] = -INFINITY; }
    }
}
template <int DQK, bool ALIBI, int NSLOT, int MODE = 0, int VAR = 0>
__device__ __forceinline__ void attn_pass(const bf16* __restrict__ Qb, const bf16* __restrict__ Kh, const bf16* __restrict__ Vh, const int* __restrict__ posb, float slope2, float cref, int TL, int q0, int T0, int NT,
                                          LAS unsigned char* lds, int tid_, f32x16 (&o)[4], float& l_out) {
    typedef Lds<DQK> L; constexpr int KSUB = DQK / 64, SHM_K = L::SHM_K;
    const int wid = __builtin_amdgcn_readfirstlane(tid_ >> 6); int lane; asm volatile("v_mbcnt_lo_u32_b32 %0, -1, 0\n\tv_mbcnt_hi_u32_b32 %0, -1, %0" : "=v"(lane));
    const int tid = wid * 64 + lane, r32 = lane & 31, hi = lane >> 5;
    if (wid >= 4) __builtin_amdgcn_s_setprio(1);
    LAS unsigned char* V_lds = lds + L::V_OFF; LAS unsigned char* K_lds = lds + L::K_OFF; LAS float* P_lds = (LAS float*)(lds + L::POS_OFF);
    LAS float* al_l = (LAS float*)(lds + L::WS_OFF) + wid * 64;
    float m_reg = -1e30f, l_reg = 0.f;
#pragma unroll
    for (int d = 0; d < 4; ++d) o[d] = f32x16{};
    bf16x8 qr[DQK / 16];
    { const bf16* Qw = Qb + (size_t)(wid * QBLK) * DQK; unsigned qgo = (unsigned)(r32 * DQK + hi * 8) * 2u; asm volatile("" : "+v"(qgo));
#pragma unroll
      for (int d0 = 0; d0 < DQK / 16; ++d0) qr[d0] = ldg<bf16x8>(Qw + d0 * 16, qgo); }
    const float posq = ALIBI ? (float)posb[q0 + wid * QBLK + r32] : 0.f;
    const int tmax = NT - 4 + (wid >> 1);
    const int sr = tid >> 4, sc = (tid & 15) * 8, vst0 = MODE == 5 ? v_st_nat(sr, sc) : v_st(sr, sc), vst1 = MODE == 5 ? v_st_nat(32 + sr, sc) : v_st(32 + sr, sc);
    const int kr = tid >> 3, kc = (tid & 7) * 8, kst = kswz(kr, kc * 2);
    unsigned vgo = (unsigned)(sr * DV + sc) * 2u, kgo = (unsigned)(kr * DQK + kc) * 2u, pgo = (unsigned)(tid & 63) * 4u; asm volatile("" : "+v"(vgo), "+v"(kgo), "+v"(pgo));
    const int vb0 = (int)(uintptr_t)V_lds + v_rd_base(lane);
    int ka[4]; k_bases(ka, K_lds, r32, hi);
    struct Slot { bf16x8 vs0, vs1, ks[KSUB]; int ps; } sl_[NSLOT];
#define FA_SLOAD(i, k0) do { unsigned kk_ = (unsigned)__builtin_amdgcn_readfirstlane((int)(k0)); asm volatile("" : "+s"(kk_));     \
    const bf16* Vt_ = Vh + (size_t)kk_ * DV; const bf16* Kt_ = Kh + (size_t)kk_ * DQK; \
    sl_[i].vs0 = ldg<bf16x8>(Vt_, vgo); sl_[i].vs1 = ldg<bf16x8>(Vt_ + 32 * DV, vgo); \
    _Pragma("unroll") for (int s_ = 0; s_ < KSUB; ++s_) sl_[i].ks[s_] = ldg<bf16x8>(Kt_ + s_ * 64, kgo); \
    if (ALIBI) sl_[i].ps = ldg<int>(posb + kk_, pgo); } while (0)
#define FA_SWRITE(b, i) do { *(LAS bf16x8*)(V_lds + (b) * SHM_V + vst0) = sl_[i].vs0; *(LAS bf16x8*)(V_lds + (b) * SHM_V + vst1) = sl_[i].vs1; \
    _Pragma("unroll") for (int s_ = 0; s_ < KSUB; ++s_) *(LAS bf16x8*)(K_lds + (b) * SHM_K + s_ * 8192 + kst) = sl_[i].ks[s_]; \
    if (ALIBI) { if (tid < 64) P_lds[(b) * 64 + tid] = (float)sl_[i].ps; } } while (0)
#define FA_RESC(a) do { if (__any((a) < 1.f)) { if (hi == 0) al_l[r32] = (a); asm volatile("s_waitcnt lgkmcnt(0)" ::: "memory"); \
    _Pragma("unroll") for (int d = 0; d < 4; ++d) _Pragma("unroll") for (int r = 0; r < 16; ++r) o[d][r] *= al_l[crow(r, hi)]; } } while (0)
#define FA_COMPUTE(b, t, STAGE) do { bf16x8 pa0, pa1, pa2, pa3; const bool vis_ = (t) <= tmax;     \
    if (vis_) { f32x16 p0, p1; \
    if (MODE == 5) { if (VAR == 3) { p0 = f32x16{}; p1 = f32x16{}; _Pragma("unroll") for (int r_ = 0; r_ < 16; ++r_) { p0[r_] = l_reg; p1[r_] = l_reg; } } \
        else if ((DQK == 192 && PIPE_MLA) || (DQK == 64 && PIPE_OLD64)) { p0 = f32x16{}; p1 = f32x16{}; qkt_pipe<DQK, (b) * SHM_K, (VAR == 5 || VAR == 6) ? VAR : 0>(p0, p1, ka, qr); } else qkt<DQK, true>(p0, p1, K_lds + (b) * SHM_K, qr, r32, hi); fixup<ALIBI>(p0, p1, P_lds + (b) * 64, posq, slope2, false, hi); \
        if (VAR == 1) { l_reg += p0[0] + p1[5]; typedef unsigned u32x4_t __attribute__((ext_vector_type(4))); \
            u32x4_t w0_ = {cvtpk(p0[0], p0[1]), cvtpk(p0[2], p0[3]), cvtpk(p0[4], p0[5]), cvtpk(p0[6], p0[7])}, w1_ = {cvtpk(p0[8], p0[9]), cvtpk(p0[10], p0[11]), cvtpk(p0[12], p0[13]), cvtpk(p0[14], p0[15])}; \
            u32x4_t w2_ = {cvtpk(p1[0], p1[1]), cvtpk(p1[2], p1[3]), cvtpk(p1[4], p1[5]), cvtpk(p1[6], p1[7])}, w3_ = {cvtpk(p1[8], p1[9]), cvtpk(p1[10], p1[11]), cvtpk(p1[12], p1[13]), cvtpk(p1[14], p1[15])}; \
            pa0 = __builtin_bit_cast(bf16x8, w0_); pa1 = __builtin_bit_cast(bf16x8, w1_); pa2 = __builtin_bit_cast(bf16x8, w2_); pa3 = __builtin_bit_cast(bf16x8, w3_); } \
        else fr_softmax(p0, p1, l_reg, pa0, pa1, pa2, pa3); } \
    else { float alpha; qkt<DQK>(p0, p1, K_lds + (b) * SHM_K, qr, r32, hi); fixup<ALIBI>(p0, p1, P_lds + (b) * 64, posq, slope2, false, hi); \
        partialSM(p0, p1, m_reg, alpha); finishSM(p0, p1, alpha, l_reg, pa0, pa1, pa2, pa3); FA_RESC(alpha); } } \
    FA_SBAR(); STAGE; FA_SBAR();     \
    if (vis_) { \
    if (VAR == 2) { l_reg += __builtin_bit_cast(float, pa0[0] | (pa1[1] << 16)) + __builtin_bit_cast(float, pa2[0] | (pa3[1] << 16)); } else \
    if (MODE == 5 && DQK == 64) pv_d0_pipe(o, vb0 + (b) * SHM_V, pa0, pa1, pa2, pa3); else pv_d0(o, vb0 + (b) * SHM_V, pa0, pa1, pa2, pa3); } } while (0)
    constexpr int S1 = NSLOT - 1;
    FA_SLOAD(0, T0 * KVBLK); FA_SWRITE(0, 0); FA_SLOAD(S1, (T0 + 1) * KVBLK); FA_SWRITE(1, S1); FA_SLOAD(0, (T0 + 2) * KVBLK);
    if (NSLOT == 2) FA_SLOAD(1, (T0 + 3) * KVBLK);
    __syncthreads();
    static_assert(NSLOT == 1, "attn_pass: one staging slot");
    for (int j = T0; j < NT; j += 2) {
        FA_COMPUTE(0, j, { if (VAR != 4) if (j > T0) { FA_SWRITE(1, 0); if (j + 2 < NT) FA_SLOAD(0, (j + 2) * KVBLK); } });
        __syncthreads();
        FA_COMPUTE(1, j + 1, { if (VAR != 4) if (j + 2 < NT) { FA_SWRITE(0, 0); FA_SLOAD(0, (j + 3) * KVBLK); } });
        __syncthreads();
    }
    if (MODE == 5) { auto rr = __builtin_amdgcn_permlane32_swap(__float_as_uint(l_reg), __float_as_uint(l_reg), false, false); l_reg = __uint_as_float(rr[0]) + __uint_as_float(rr[1]); }
    __builtin_amdgcn_s_setprio(0);
    l_out = l_reg;
#undef FA_SLOAD
#undef FA_SWRITE
#undef FA_RESC
#undef FA_COMPUTE
}
template <int DQK> struct Lds3 {
    static constexpr int SHM_K = KVBLK * DQK * 2;
    static constexpr int V_OFF = 0, K_OFF = 3 * SHM_V, POS_OFF = K_OFF + 3 * SHM_K, WS_OFF = POS_OFF + 3 * 256, END = WS_OFF + 8 * 256;
};
template <int DQK, bool ALIBI>
__device__ __forceinline__ void attn_pass_stag(const bf16* __restrict__ Qb, const bf16* __restrict__ Kh, const bf16* __restrict__ Vh, const int* __restrict__ posb, float slope2, int q0, int T0, int NT,
                                               LAS unsigned char* lds, int tid, f32x16 (&o)[4], float& l_out) {
    typedef Lds3<DQK> L; constexpr int KSUB = DQK / 64, SHM_K = L::SHM_K;
    const int wid = __builtin_amdgcn_readfirstlane(tid >> 6), lane = tid & 63, r32 = lane & 31, hi = lane >> 5, grp = wid >> 2;
    LAS unsigned char* V_lds = lds + L::V_OFF; LAS unsigned char* K_lds = lds + L::K_OFF; LAS float* P_lds = (LAS float*)(lds + L::POS_OFF);
    float l_reg = 0.f;
#pragma unroll
    for (int d = 0; d < 4; ++d) o[d] = f32x16{};
    bf16x8 qr[DQK / 16];
    { const bf16* Qw = Qb + (size_t)(wid * QBLK) * DQK; unsigned qgo = (unsigned)(r32 * DQK + hi * 8) * 2u; asm volatile("" : "+v"(qgo));
#pragma unroll
      for (int d0 = 0; d0 < DQK / 16; ++d0) qr[d0] = ldg<bf16x8>(Qw + d0 * 16, qgo); }
    const float posq = ALIBI ? (float)posb[q0 + wid * QBLK + r32] : 0.f;
    const int tmax = NT - 4 + (wid >> 1);
    const int sr = tid >> 4, sc = (tid & 15) * 8, vst0 = v_st(sr, sc), vst1 = v_st(32 + sr, sc);
    const int kr = tid >> 3, kc = (tid & 7) * 8, kst = kswz(kr, kc * 2);
    unsigned vgo = (unsigned)(sr * DV + sc) * 2u, kgo = (unsigned)(kr * DQK + kc) * 2u, pgo = (unsigned)(tid & 63) * 4u; asm volatile("" : "+v"(vgo), "+v"(kgo), "+v"(pgo));
    const int vb0 = (int)(uintptr_t)V_lds + v_rd_base(lane);
    struct Slot { bf16x8 vs0, vs1, ks[KSUB]; int ps; } sl_;
#define FS_SLOAD(k0) do { unsigned kk_ = (unsigned)__builtin_amdgcn_readfirstlane((int)(k0)); asm volatile("" : "+s"(kk_)); \
    const bf16* Vt_ = Vh + (size_t)kk_ * DV; const bf16* Kt_ = Kh + (size_t)kk_ * DQK; \
    sl_.vs0 = ldg<bf16x8>(Vt_, vgo); sl_.vs1 = ldg<bf16x8>(Vt_ + 32 * DV, vgo); \
    _Pragma("unroll") for (int s_ = 0; s_ < KSUB; ++s_) sl_.ks[s_] = ldg<bf16x8>(Kt_ + s_ * 64, kgo); \
    if (ALIBI) sl_.ps = ldg<int>(posb + kk_, pgo); } while (0)
#define FS_SWRITE(b) do { *(LAS bf16x8*)(V_lds + (b) * SHM_V + vst0) = sl_.vs0; *(LAS bf16x8*)(V_lds + (b) * SHM_V + vst1) = sl_.vs1; \
    _Pragma("unroll") for (int s_ = 0; s_ < KSUB; ++s_) *(LAS bf16x8*)(K_lds + (b) * SHM_K + s_ * 8192 + kst) = sl_.ks[s_]; \
    if (ALIBI) { if (tid < 64) P_lds[(b) * 64 + tid] = (float)sl_.ps; } } while (0)
    const int nt = NT - T0;
    FS_SLOAD(T0 * KVBLK); FS_SWRITE(0); FS_SLOAD((T0 + 1) * KVBLK); FS_SWRITE(1); FS_SLOAD((T0 + 2) * KVBLK);
    __syncthreads();
#define FS_QKS(j_) do { int b_ = (j_) % 3; asm volatile("" : "+s"(b_)); f32x16 p0, p1; \
    qkt<DQK, true>(p0, p1, K_lds + b_ * SHM_K, qr, r32, hi); fixup<ALIBI>(p0, p1, P_lds + b_ * 64, posq, slope2, T0 + (j_) > tmax, hi); \
    fr_softmax(p0, p1, l_reg, pa0, pa1, pa2, pa3); } while (0)
#define FS_PV(j_) do { int b_ = (j_) % 3; asm volatile("" : "+s"(b_)); pv_d0(o, vb0 + b_ * SHM_V, pa0, pa1, pa2, pa3); } while (0)
#define FS_STAGE(j_) do { const int jn_ = (j_) + 2; if (jn_ < nt) { int bw_ = jn_ % 3; asm volatile("" : "+s"(bw_)); FS_SWRITE(bw_); if (jn_ + 1 < nt) FS_SLOAD((T0 + jn_ + 1) * KVBLK); } } while (0)
    bf16x8 pa0, pa1, pa2, pa3;
    if (grp == 0) {
        for (int j = 0; j < nt; ++j) { FS_QKS(j); __syncthreads(); FS_PV(j); __syncthreads(); FS_STAGE(j); }
        __syncthreads();
    } else {
        pa0 = bf16x8{}; pa1 = bf16x8{}; pa2 = bf16x8{}; pa3 = bf16x8{};
        for (int j = 0; j < nt; ++j) { if (j > 0) FS_PV(j - 1); __syncthreads(); FS_QKS(j); __syncthreads(); FS_STAGE(j); }
        FS_PV(nt - 1); __syncthreads();
    }
#undef FS_QKS
#undef FS_PV
#undef FS_STAGE
    { auto rr = __builtin_amdgcn_permlane32_swap(__float_as_uint(l_reg), __float_as_uint(l_reg), false, false); l_reg = __uint_as_float(rr[0]) + __uint_as_float(rr[1]); }
    l_out = l_reg;
#undef FS_SLOAD
#undef FS_SWRITE
}
template <int DQK, bool ALIBI>
__device__ __forceinline__ void attn_pass_p2(const bf16* __restrict__ Qb, const bf16* __restrict__ Kh, const bf16* __restrict__ Vh, const int* __restrict__ posb, float slope2, int q0, int T0, int NT,
                                             LAS unsigned char* lds, int tid, f32x16 (&o)[4], float& l_out) {
    typedef Lds<DQK> L; constexpr int KSUB = DQK / 64, SHM_K = L::SHM_K;
    const int wid = __builtin_amdgcn_readfirstlane(tid >> 6), lane = tid & 63, r32 = lane & 31, hi = lane >> 5;
    LAS unsigned char* V_lds = lds + L::V_OFF; LAS unsigned char* K_lds = lds + L::K_OFF; LAS float* P_lds = (LAS float*)(lds + L::POS_OFF);
    float l_reg = 0.f;
#pragma unroll
    for (int d = 0; d < 4; ++d) o[d] = f32x16{};
    bf16x8 qr[DQK / 16];
    { const bf16* Qw = Qb + (size_t)(wid * QBLK) * DQK; unsigned qgo = (unsigned)(r32 * DQK + hi * 8) * 2u; asm volatile("" : "+v"(qgo));
#pragma unroll
      for (int d0 = 0; d0 < DQK / 16; ++d0) qr[d0] = ldg<bf16x8>(Qw + d0 * 16, qgo); }
    const float posq = ALIBI ? (float)posb[q0 + wid * QBLK + r32] : 0.f;
    const int tmax = NT - 4 + (wid >> 1);
    const int sr = tid >> 4, sc = (tid & 15) * 8, vst0 = v_st(sr, sc), vst1 = v_st(32 + sr, sc);
    const int kr = tid >> 3, kc = (tid & 7) * 8, kst = kswz(kr, kc * 2);
    unsigned vgo = (unsigned)(sr * DV + sc) * 2u, kgo = (unsigned)(kr * DQK + kc) * 2u, pgo = (unsigned)(tid & 63) * 4u; asm volatile("" : "+v"(vgo), "+v"(kgo), "+v"(pgo));
    const int vb0 = (int)(uintptr_t)V_lds + v_rd_base(lane);
    struct Slot { bf16x8 vs0, vs1, ks[KSUB]; int ps; } sl_;
#define FP_LOADK(t) do { unsigned kk_ = (unsigned)__builtin_amdgcn_readfirstlane((int)((t) * KVBLK)); asm volatile("" : "+s"(kk_)); const bf16* Kt_ = Kh + (size_t)kk_ * DQK; \
    _Pragma("unroll") for (int s_ = 0; s_ < KSUB; ++s_) sl_.ks[s_] = ldg<bf16x8>(Kt_ + s_ * 64, kgo); if (ALIBI) sl_.ps = ldg<int>(posb + kk_, pgo); } while (0)
#define FP_LOADV(t) do { unsigned kk_ = (unsigned)__builtin_amdgcn_readfirstlane((int)((t) * KVBLK)); asm volatile("" : "+s"(kk_)); const bf16* Vt_ = Vh + (size_t)kk_ * DV; \
    sl_.vs0 = ldg<bf16x8>(Vt_, vgo); sl_.vs1 = ldg<bf16x8>(Vt_ + 32 * DV, vgo); } while (0)
#define FP_WRITEK(b) do { _Pragma("unroll") for (int s_ = 0; s_ < KSUB; ++s_) *(LAS bf16x8*)(K_lds + (b) * SHM_K + s_ * 8192 + kst) = sl_.ks[s_]; \
    if (ALIBI) { if (tid < 64) P_lds[(b) * 64 + tid] = (float)sl_.ps; } } while (0)
#define FP_WRITEV(b) do { *(LAS bf16x8*)(V_lds + (b) * SHM_V + vst0) = sl_.vs0; *(LAS bf16x8*)(V_lds + (b) * SHM_V + vst1) = sl_.vs1; } while (0)
#define FP_QK(P0, P1, b, t) do { qkt<DQK, true>(P0, P1, K_lds + (b) * SHM_K, qr, r32, hi); fixup<ALIBI>(P0, P1, P_lds + (b) * 64, posq, slope2, (t) > tmax, hi); } while (0)
    f32x16 pA0, pA1, pB0, pB1; bf16x8 pa0, pa1, pa2, pa3;
    const int nt = NT - T0;
    FP_LOADK(T0); FP_LOADV(T0); FP_WRITEK(0); FP_WRITEV(0); FP_LOADK(T0 + 1); FP_WRITEK(1); FP_LOADK(T0 + 2); FP_LOADV(T0 + 1);
    __syncthreads();
    FP_QK(pA0, pA1, 0, T0);
    __syncthreads();
    for (int r = 0; r < nt; r += 2) {
        if (r + 2 < nt) FP_WRITEK(0);
        FP_WRITEV(1);
        if (r + 3 < nt) FP_LOADK(T0 + r + 3);
        if (r + 2 < nt) FP_LOADV(T0 + r + 2);
        FA_SBAR(); FP_QK(pB0, pB1, 1, T0 + r + 1);
        fr_softmax(pA0, pA1, l_reg, pa0, pa1, pa2, pa3); FA_SBAR();
        pv_d0(o, vb0, pa0, pa1, pa2, pa3);
        __syncthreads();
        if (r + 3 < nt) FP_WRITEK(1);
        if (r + 2 < nt) FP_WRITEV(0);
        if (r + 4 < nt) FP_LOADK(T0 + r + 4);
        if (r + 3 < nt) FP_LOADV(T0 + r + 3);
        FA_SBAR(); if (r + 2 < nt) FP_QK(pA0, pA1, 0, T0 + r + 2);
        fr_softmax(pB0, pB1, l_reg, pa0, pa1, pa2, pa3); FA_SBAR();
        pv_d0(o, vb0 + SHM_V, pa0, pa1, pa2, pa3);
        __syncthreads();
    }
    { auto rr = __builtin_amdgcn_permlane32_swap(__float_as_uint(l_reg), __float_as_uint(l_reg), false, false); l_reg = __uint_as_float(rr[0]) + __uint_as_float(rr[1]); }
    l_out = l_reg;
#undef FP_LOADK
#undef FP_LOADV
#undef FP_WRITEK
#undef FP_WRITEV
#undef FP_QK
}
template <int DQK, bool ALIBI>
__device__ __forceinline__ void attn_pass_dma(const bf16* __restrict__ Qb, const bf16* __restrict__ Kh, const bf16* __restrict__ Vh, const int* __restrict__ posb, const float* __restrict__ posfb,
                                              float slope2, int q0, int T0, int NT, LAS unsigned char* lds, int tid_, f32x16 (&o)[4], float& l_out) {
    typedef Lds3<DQK> L; constexpr int KSUB = DQK / 64, SHM_K = L::SHM_K, NPT = KSUB + 2 + (ALIBI ? 1 : 0);
    const int wid = __builtin_amdgcn_readfirstlane(tid_ >> 6); int lane; asm volatile("v_mbcnt_lo_u32_b32 %0, -1, 0\n\tv_mbcnt_hi_u32_b32 %0, -1, %0" : "=v"(lane));
    const int r32 = lane & 31, hi = lane >> 5;
    LAS unsigned char* V_lds = lds + L::V_OFF; LAS unsigned char* K_lds = lds + L::K_OFF; LAS float* P_lds = (LAS float*)(lds + L::POS_OFF);
    float l_reg = 0.f;
#pragma unroll
    for (int d = 0; d < 4; ++d) o[d] = f32x16{};
    bf16x8 qr[DQK / 16];
    { const bf16* Qw = Qb + (size_t)(wid * QBLK) * DQK; unsigned qgo = (unsigned)(r32 * DQK + hi * 8) * 2u; asm volatile("" : "+v"(qgo));
#pragma unroll
      for (int d0 = 0; d0 < DQK / 16; ++d0) qr[d0] = ldg<bf16x8>(Qw + d0 * 16, qgo); }
    const float posq = ALIBI ? (float)posb[q0 + wid * QBLK + r32] : 0.f;
    const int tmax = NT - 4 + (wid >> 1);
    unsigned ksrc, vsrc, psrc;
    { const int kr = 8 * wid + (lane >> 3), kc = (lane & 7) ^ ((kr >> 1) & 7); ksrc = (unsigned)(kr * DQK + kc * 8) * 2u;
      const int vk = 8 * wid + ((lane & 31) >> 2), vc = (lane >> 5) * 32 + (lane & 3) * 8; vsrc = (unsigned)(vk * DV + vc) * 2u; psrc = (unsigned)lane * 4u;
      asm volatile("" : "+v"(ksrc), "+v"(vsrc), "+v"(psrc)); }
    const int vb0 = (int)(uintptr_t)V_lds + v_rd_base(lane);
#define FD_DMA(t, slot) do { unsigned kk_ = (unsigned)__builtin_amdgcn_readfirstlane((int)((t) * KVBLK)); asm volatile("" : "+s"(kk_)); const int sl_ = (slot); \
    const char* Kt_ = (const char*)(Kh + (size_t)kk_ * DQK); const char* Vt_ = (const char*)(Vh + (size_t)kk_ * DV); \
    _Pragma("unroll") for (int s_ = 0; s_ < KSUB; ++s_) __builtin_amdgcn_global_load_lds((const unsigned*)(Kt_ + s_ * 128 + ksrc), (LAS unsigned*)(K_lds + sl_ * SHM_K + s_ * 8192 + wid * 1024), 16, 0, 0); \
    _Pragma("unroll") for (int q_ = 0; q_ < 2; ++q_) __builtin_amdgcn_global_load_lds((const unsigned*)(Vt_ + q_ * 128 + vsrc), (LAS unsigned*)(V_lds + sl_ * SHM_V + (2 * wid + q_) * 1024), 16, 0, 0); \
    if (ALIBI) __builtin_amdgcn_global_load_lds((const unsigned*)((const char*)(posfb + kk_) + psrc), (LAS unsigned*)(P_lds + sl_ * 64), 4, 0, 0); } while (0)
    const int nt = NT - T0;
    FD_DMA(T0, 0); FD_DMA(T0 + 1, 1);
    asm volatile("s_waitcnt vmcnt(0) lgkmcnt(0)\n\ts_barrier" ::: "memory");
    int slot = 0;
    for (int j = 0; j < nt; ++j) {
        int b = slot; asm volatile("" : "+s"(b));
        if (j + 2 < nt) { int bn = b + 2; bn = bn >= 3 ? bn - 3 : bn; FD_DMA(T0 + j + 2, bn); }
        { f32x16 p0, p1; bf16x8 pa0, pa1, pa2, pa3;
          qkt<DQK, true>(p0, p1, K_lds + b * SHM_K, qr, r32, hi); fixup<ALIBI>(p0, p1, P_lds + b * 64, posq, slope2, T0 + j > tmax, hi);
          fr_softmax(p0, p1, l_reg, pa0, pa1, pa2, pa3); FA_SBAR();
          pv_d0(o, vb0 + b * SHM_V, pa0, pa1, pa2, pa3); }
        if (j + 2 < nt) asm volatile("s_waitcnt vmcnt(%0) lgkmcnt(0)\n\ts_barrier" :: "n"(NPT) : "memory");
        else asm volatile("s_waitcnt vmcnt(0) lgkmcnt(0)\n\ts_barrier" ::: "memory");
        slot = slot == 2 ? 0 : slot + 1;
    }
    { auto rr = __builtin_amdgcn_permlane32_swap(__float_as_uint(l_reg), __float_as_uint(l_reg), false, false); l_reg = __uint_as_float(rr[0]) + __uint_as_float(rr[1]); }
    l_out = l_reg;
#undef FD_DMA
}
__device__ __forceinline__ void row_bcast(float f, LAS float* al, int r32, int hi, float (&rf)[16]) {
    asm volatile("s_waitcnt lgkmcnt(0)" ::: "memory");
    if (hi == 0) al[r32] = f;
    asm volatile("s_waitcnt lgkmcnt(0)" ::: "memory");
#pragma unroll
    for (int r = 0; r < 16; ++r) rf[r] = al[crow(r, hi)];
    asm volatile("s_waitcnt lgkmcnt(0)" ::: "memory");
}

__device__ __forceinline__ void attn_pass_da5(const bf16* __restrict__ Qb, const bf16* __restrict__ Kh, const bf16* __restrict__ Vh, const int* __restrict__ posb, float slope2, int cw, int q0, int T0, int NT,
                                              LAS unsigned char* lds, int tid_, f32x16 (&o)[4], float& l_out) {
    typedef Lds<64> L; constexpr int DQK = 64, SHM_K = L::SHM_K, B_OFF = L::END;
    const int wid = __builtin_amdgcn_readfirstlane(tid_ >> 6); int lane; asm volatile("v_mbcnt_lo_u32_b32 %0, -1, 0\n\tv_mbcnt_hi_u32_b32 %0, -1, %0" : "=v"(lane));
    const int tid = wid * 64 + lane, r32 = lane & 31, hi = lane >> 5;
    LAS unsigned char* V_lds = lds + L::V_OFF; LAS unsigned char* K_lds = lds + L::K_OFF; LAS float* P_lds = (LAS float*)(lds + L::POS_OFF); LAS float* B_lds = (LAS float*)(lds + B_OFF);
    float l_reg = 0.f;
#pragma unroll
    for (int d = 0; d < 4; ++d) o[d] = f32x16{};
    bf16x8 qr[4];
    { const bf16* Qw = Qb + (size_t)(wid * QBLK) * DQK; unsigned qgo = (unsigned)(r32 * DQK + hi * 8) * 2u; asm volatile("" : "+v"(qgo));
#pragma unroll
      for (int d0 = 0; d0 < 4; ++d0) qr[d0] = ldg<bf16x8>(Qw + d0 * 16, qgo); }
    const float posq = (float)posb[q0 + wid * QBLK + r32];
    const float dl = slope2 * (posq - (float)cw);
    const int tmax = NT - 4 + (wid >> 1);
    const int sr = tid >> 4, sc = (tid & 15) * 8, vst0 = v_st_nat(sr, sc), vst1 = v_st_nat(32 + sr, sc);
    const int kr = tid >> 3, kc = (tid & 7) * 8, kst = kswz(kr, kc * 2);
    unsigned vgo = (unsigned)(sr * DV + sc) * 2u, kgo = (unsigned)(kr * DQK + kc) * 2u, pgo = (unsigned)(tid & 63) * 4u; asm volatile("" : "+v"(vgo), "+v"(kgo), "+v"(pgo));
    const int vb0 = (int)(uintptr_t)V_lds + v_rd_base(lane);
    int ka[4]; k_bases(ka, K_lds, r32, hi);
    bf16x8 vs0, vs1, ks0; int ps;
#define FD_SLOAD(k0) do { unsigned kk_ = (unsigned)__builtin_amdgcn_readfirstlane((int)(k0)); asm volatile("" : "+s"(kk_)); \
    const bf16* Vt_ = Vh + (size_t)kk_ * DV; const bf16* Kt_ = Kh + (size_t)kk_ * DQK; \
    vs0 = ldg<bf16x8>(Vt_, vgo); vs1 = ldg<bf16x8>(Vt_ + 32 * DV, vgo); ks0 = ldg<bf16x8>(Kt_, kgo); ps = ldg<int>(posb + kk_, pgo); } while (0)
#define FD_SWRITE(b) do { *(LAS bf16x8*)(V_lds + (b) * SHM_V + vst0) = vs0; *(LAS bf16x8*)(V_lds + (b) * SHM_V + vst1) = vs1; *(LAS bf16x8*)(K_lds + (b) * SHM_K + kst) = ks0; \
    B_lds[(b) * 512 + tid] = slope2 * (float)(ps - cw); if (tid < 64) P_lds[(b) * 64 + tid] = (float)ps; } while (0)
#define FD_LIN(b) do { f32x16 p0, p1; bf16x8 pa0, pa1, pa2, pa3; const LAS float* bl_ = B_lds + (b) * 512 + wid * 64 + 4 * hi; \
    _Pragma("unroll") for (int g = 0; g < 4; ++g) { const f32x4 k0 = *(const LAS f32x4*)(bl_ + 8 * g), k1 = *(const LAS f32x4*)(bl_ + 32 + 8 * g); \
        _Pragma("unroll") for (int e = 0; e < 4; ++e) { p0[4 * g + e] = k0[e]; p1[4 * g + e] = k1[e]; } } \
    if (PIPE_LIN) qkt_pipe<DQK, (b) * SHM_K>(p0, p1, ka, qr); else qkt<DQK, false>(p0, p1, K_lds + (b) * SHM_K, qr, r32, hi); fr_softmax(p0, p1, l_reg, pa0, pa1, pa2, pa3); FA_SBAR(); \
    pv_d0_pipe(o, vb0 + (b) * SHM_V, pa0, pa1, pa2, pa3); } while (0)
#define FD_GEN(b, t) do { if ((t) <= tmax) { f32x16 p0, p1; bf16x8 pa0, pa1, pa2, pa3; \
    _Pragma("unroll") for (int r = 0; r < 16; ++r) { p0[r] = dl; p1[r] = dl; } \
    if (PIPE_GEN) qkt_pipe<DQK, (b) * SHM_K>(p0, p1, ka, qr); else qkt<DQK, false>(p0, p1, K_lds + (b) * SHM_K, qr, r32, hi); fixup<true>(p0, p1, P_lds + (b) * 64, posq, slope2, false, hi); fr_softmax(p0, p1, l_reg, pa0, pa1, pa2, pa3); FA_SBAR(); \
    pv_d0_pipe(o, vb0 + (b) * SHM_V, pa0, pa1, pa2, pa3); } } while (0)
    FD_SLOAD(T0 * KVBLK); FD_SWRITE(0); FD_SLOAD((T0 + 1) * KVBLK); FD_SWRITE(1); FD_SLOAD((T0 + 2) * KVBLK);
    __syncthreads();
    int j = T0;
    for (; j < NT - 4; j += 2) {
        FD_LIN(0);
        __syncthreads();
        FD_SWRITE(0); FD_SLOAD((j + 3) * KVBLK);
        FD_LIN(1);
        __syncthreads();
        FD_SWRITE(1); FD_SLOAD((j + 4) * KVBLK);
    }
    for (; j < NT; j += 2) {
        FD_GEN(0, j);
        __syncthreads();
        if (j + 2 < NT) { FD_SWRITE(0); FD_SLOAD((j + 3) * KVBLK); }
        FD_GEN(1, j + 1);
        __syncthreads();
        if (j + 2 < NT) { FD_SWRITE(1); }
    }
    { auto rr = __builtin_amdgcn_permlane32_swap(__float_as_uint(l_reg), __float_as_uint(l_reg), false, false); l_reg = __uint_as_float(rr[0]) + __uint_as_float(rr[1]); }
    l_out = l_reg;
#undef FD_SLOAD
#undef FD_SWRITE
#undef FD_LIN
#undef FD_GEN
}

__device__ __forceinline__ void attn_pass_da5p(const bf16* __restrict__ Qb, const bf16* __restrict__ Kh, const bf16* __restrict__ Vh, const int* __restrict__ posb, float slope2, int cw, int q0, int T0, int NT,
                                               LAS unsigned char* lds, int tid_, f32x16 (&o)[4], float& l_out) {
    typedef Lds<64> L; constexpr int DQK = 64, SHM_K = L::SHM_K, B_OFF = L::END;
    const int wid = __builtin_amdgcn_readfirstlane(tid_ >> 6); int lane; asm volatile("v_mbcnt_lo_u32_b32 %0, -1, 0\n\tv_mbcnt_hi_u32_b32 %0, -1, %0" : "=v"(lane));
    const int tid = wid * 64 + lane, r32 = lane & 31, hi = lane >> 5;
    if (wid >= 4) __builtin_amdgcn_s_setprio(1);
    LAS unsigned char* V_lds = lds + L::V_OFF; LAS unsigned char* K_lds = lds + L::K_OFF; LAS float* P_lds = (LAS float*)(lds + L::POS_OFF); LAS float* B_lds = (LAS float*)(lds + B_OFF);
    float l_reg = 0.f;
#pragma unroll
    for (int d = 0; d < 4; ++d) o[d] = f32x16{};
    bf16x8 qr[4];
    { const bf16* Qw = Qb + (size_t)(wid * QBLK) * DQK; unsigned qgo = (unsigned)(r32 * DQK + hi * 8) * 2u; asm volatile("" : "+v"(qgo));
#pragma unroll
      for (int d0 = 0; d0 < 4; ++d0) qr[d0] = ldg<bf16x8>(Qw + d0 * 16, qgo); }
    const float posq = (float)posb[q0 + wid * QBLK + r32];
    const float dl = slope2 * (posq - (float)cw);
    const int tmax = NT - 4 + (wid >> 1);
    const int sr = tid >> 4, sc = (tid & 15) * 8, vst0 = v_st_nat(sr, sc), vst1 = v_st_nat(32 + sr, sc);
    const int kr = tid >> 3, kc = (tid & 7) * 8, kst = kswz(kr, kc * 2);
    unsigned vgo = (unsigned)(sr * DV + sc) * 2u, kgo = (unsigned)(kr * DQK + kc) * 2u, pgo = (unsigned)(tid & 63) * 4u; asm volatile("" : "+v"(vgo), "+v"(kgo), "+v"(pgo));
    const int vb0 = (int)(uintptr_t)V_lds + v_rd_base(lane);
    int ka[4]; k_bases(ka, K_lds, r32, hi);
    bf16x8 vs0, vs1, ks0; int ps;
#define FP_LOADV(t) do { unsigned kk_ = (unsigned)__builtin_amdgcn_readfirstlane((int)((t) * KVBLK)); asm volatile("" : "+s"(kk_)); const bf16* Vt_ = Vh + (size_t)kk_ * DV; \
    vs0 = ldg<bf16x8>(Vt_, vgo); vs1 = ldg<bf16x8>(Vt_ + 32 * DV, vgo); } while (0)
#define FP_LOADK(t) do { unsigned kk_ = (unsigned)__builtin_amdgcn_readfirstlane((int)((t) * KVBLK)); asm volatile("" : "+s"(kk_)); ks0 = ldg<bf16x8>(Kh + (size_t)kk_ * DQK, kgo); ps = ldg<int>(posb + kk_, pgo); } while (0)
#define FP_WRITEV(b) do { *(LAS bf16x8*)(V_lds + (b) * SHM_V + vst0) = vs0; *(LAS bf16x8*)(V_lds + (b) * SHM_V + vst1) = vs1; } while (0)
#define FP_WRITEK(b) do { *(LAS bf16x8*)(K_lds + (b) * SHM_K + kst) = ks0; B_lds[(b) * 512 + tid] = slope2 * (float)(ps - cw); if (tid < 64) P_lds[(b) * 64 + tid] = (float)ps; } while (0)
#define FP_BINIT(x0, x1, b) do { const LAS float* bl_ = B_lds + (b) * 512 + wid * 64 + 4 * hi; \
    _Pragma("unroll") for (int g = 0; g < 4; ++g) { const f32x4 k0 = *(const LAS f32x4*)(bl_ + 8 * g), k1 = *(const LAS f32x4*)(bl_ + 32 + 8 * g); \
        _Pragma("unroll") for (int e = 0; e < 4; ++e) { x0[4 * g + e] = k0[e]; x1[4 * g + e] = k1[e]; } } } while (0)
#define FP_QK(x0, x1, t, b) do { if ((t) < NT - 4) { FP_BINIT(x0, x1, b); qkt<DQK, false>(x0, x1, K_lds + (b) * SHM_K, qr, r32, hi); } \
    else { _Pragma("unroll") for (int r = 0; r < 16; ++r) { x0[r] = dl; x1[r] = dl; } qkt<DQK, false>(x0, x1, K_lds + (b) * SHM_K, qr, r32, hi); fixup<true>(x0, x1, P_lds + (b) * 64, posq, slope2, false, hi); } } while (0)
    f32x16 c0, c1;
    {
        FP_LOADV(T0); FP_LOADK(T0);
        bf16x8 vB0, vB1, kB; int pB;
        { unsigned kk_ = (unsigned)__builtin_amdgcn_readfirstlane((int)((T0 + 1) * KVBLK)); asm volatile("" : "+s"(kk_)); const bf16* Vt_ = Vh + (size_t)kk_ * DV;
          vB0 = ldg<bf16x8>(Vt_, vgo); vB1 = ldg<bf16x8>(Vt_ + 32 * DV, vgo); kB = ldg<bf16x8>(Kh + (size_t)kk_ * DQK, kgo); pB = ldg<int>(posb + kk_, pgo); }
        FP_WRITEV(0); FP_WRITEK(0);
        *(LAS bf16x8*)(V_lds + SHM_V + vst0) = vB0; *(LAS bf16x8*)(V_lds + SHM_V + vst1) = vB1; *(LAS bf16x8*)(K_lds + SHM_K + kst) = kB;
        B_lds[512 + tid] = slope2 * (float)(pB - cw); if (tid < 64) P_lds[64 + tid] = (float)pB;
        FP_LOADK(T0 + 2); FP_LOADV(T0 + 2);
        __syncthreads();
        FP_QK(c0, c1, T0, 0);
        __syncthreads();
        FP_WRITEK(0); FP_LOADK(T0 + 3);
    }
    int s = T0;
    for (; s <= NT - 6; ++s) {
        const int b = s & 1, nb = b ^ 1, kof = nb * SHM_K;
        f32x16 n0, n1; bf16x8 pa0, pa1, pa2, pa3;
        FP_BINIT(n0, n1, nb);
        const bf16x8 a0 = k_read<0>(ka[0] + kof), b0 = k_read<4096>(ka[0] + kof), a1 = k_read<0>(ka[1] + kof), b1 = k_read<4096>(ka[1] + kof);
        const bf16x8 a2 = k_read<0>(ka[2] + kof), b2 = k_read<4096>(ka[2] + kof), a3 = k_read<0>(ka[3] + kof), b3 = k_read<4096>(ka[3] + kof);
        float sa = 0.f, sb = 0.f;
#define FP_SM(d) do { _Pragma("unroll") for (int r = 4 * (d); r < 4 * (d) + 4; ++r) { c0[r] = __builtin_amdgcn_exp2f(c0[r]); c1[r] = __builtin_amdgcn_exp2f(c1[r]); sa += c0[r]; sb += c1[r]; } } while (0)
        FA_LGK(6); FA_SBAR(); n0 = __builtin_amdgcn_mfma_f32_32x32x16_bf16(a0, qr[0], n0, 0, 0, 0); n1 = __builtin_amdgcn_mfma_f32_32x32x16_bf16(b0, qr[0], n1, 0, 0, 0); FP_SM(0); FA_SBAR();
        FA_LGK(4); FA_SBAR(); n0 = __builtin_amdgcn_mfma_f32_32x32x16_bf16(a1, qr[1], n0, 0, 0, 0); n1 = __builtin_amdgcn_mfma_f32_32x32x16_bf16(b1, qr[1], n1, 0, 0, 0); FP_SM(1); FA_SBAR();
        FA_LGK(2); FA_SBAR(); n0 = __builtin_amdgcn_mfma_f32_32x32x16_bf16(a2, qr[2], n0, 0, 0, 0); n1 = __builtin_amdgcn_mfma_f32_32x32x16_bf16(b2, qr[2], n1, 0, 0, 0); FP_SM(2); FA_SBAR();
        FA_LGK(0); FA_SBAR(); n0 = __builtin_amdgcn_mfma_f32_32x32x16_bf16(a3, qr[3], n0, 0, 0, 0); n1 = __builtin_amdgcn_mfma_f32_32x32x16_bf16(b3, qr[3], n1, 0, 0, 0); FP_SM(3); FA_SBAR();
#undef FP_SM
        l_reg += sa + sb;
        typedef unsigned u32x4_t __attribute__((ext_vector_type(4)));
#define FA_PKS(P, BASE, OUT) do { u32x4_t w = {cvtpk(P[BASE + 0], P[BASE + 1]), cvtpk(P[BASE + 2], P[BASE + 3]), cvtpk(P[BASE + 4], P[BASE + 5]), cvtpk(P[BASE + 6], P[BASE + 7])}; OUT = __builtin_bit_cast(bf16x8, w); } while (0)
        FA_PKS(c0, 0, pa0); FA_PKS(c0, 8, pa1); FA_PKS(c1, 0, pa2); FA_PKS(c1, 8, pa3);
#undef FA_PKS
        FA_SBAR();
        pv_d0_pipe(o, vb0 + b * SHM_V, pa0, pa1, pa2, pa3);
        __syncthreads();
        FP_WRITEV(b); FP_WRITEK(nb); FP_LOADV(s + 3); FP_LOADK(s + 4);
        c0 = n0; c1 = n1;
    }
    for (; s < NT; ++s) {
        const int b = s & 1, nb = b ^ 1;
        f32x16 n0 = f32x16{}, n1 = f32x16{};
        if (s + 1 < NT && s + 1 <= tmax) FP_QK(n0, n1, s + 1, nb);
        if (s <= tmax) { bf16x8 pa0, pa1, pa2, pa3; fr_softmax(c0, c1, l_reg, pa0, pa1, pa2, pa3); FA_SBAR(); pv_d0_pipe(o, vb0 + b * SHM_V, pa0, pa1, pa2, pa3); }
        __syncthreads();
        if (s + 2 < NT) FP_WRITEV(b);
        if (s + 3 < NT) { FP_WRITEK(nb); FP_LOADV(s + 3); }
        if (s + 4 < NT) FP_LOADK(s + 4);
        c0 = n0; c1 = n1;
    }
    { auto rr = __builtin_amdgcn_permlane32_swap(__float_as_uint(l_reg), __float_as_uint(l_reg), false, false); l_reg = __uint_as_float(rr[0]) + __uint_as_float(rr[1]); }
    __builtin_amdgcn_s_setprio(0);
    l_out = l_reg;
#undef FP_LOADV
#undef FP_LOADK
#undef FP_WRITEV
#undef FP_WRITEK
#undef FP_BINIT
#undef FP_QK
}
}

constexpr int CW_BAR = 4096;
constexpr int CW_Q = 8192;
__device__ __forceinline__ int next_unit(Frame& F, unsigned* ctr) {
    LAS unsigned* uq = (LAS unsigned*)(F.lds + LDSCTL_OFF + 16);
    __syncthreads();
    if (F.tid == 0) *uq = atomicAdd(ctr, 1u);
    __syncthreads();
    return __builtin_amdgcn_readfirstlane((int)*uq);
}
template <int MODE = 0> __device__ __forceinline__ void ph_attn_da(Frame& F, int l, int rep = 0) {
    const bf16 *QD = WSP(bf16, WS_QD), *KD = WSP(bf16, WS_KD), *VD = WSP(bf16, WS_VD);
    bf16* MIX = rep == 2 ? WSP(bf16, WS_U) : WSP(bf16, WS_MIX); float* O1 = WSP(float, WS_O1);
    const int lane = F.lane;
    LAS float* al = (LAS float*)(F.lds + fa::Lds<64>::WS_OFF) + F.wave * 64;
    const float s1 = wave_sum(FIN(I_LQ1)[l * 64 + lane] * FIN(I_LK1)[l * 64 + lane]);
    const float s2 = wave_sum(FIN(I_LQ2)[l * 64 + lane] * FIN(I_LK2)[l * 64 + lane]);
    const float lam_init = __int_as_float(__builtin_amdgcn_readfirstlane(__float_as_int(LAM_INIT[l])));
    const float lam = __int_as_float(__builtin_amdgcn_readfirstlane(__float_as_int(expf(s1) - expf(s2) + lam_init)));
    float gqm = fabsf(FIN(I_DAQG)[l * 64 + lane]), gkm = fabsf(FIN(I_DAKG)[l * 64 + lane]);
    gqm = wave_max(gqm); gkm = wave_max(gkm);
    const float bound = __int_as_float(__builtin_amdgcn_readfirstlane(__float_as_int(1.01f * 11.5416f * gqm * gkm)));
    const float reach = __int_as_float(__builtin_amdgcn_readfirstlane(__float_as_int(2.0f * bound + 160.0f)));
    if ((MODE == 5) != (bound < 40.0f)) return;
    const int* posmm = WSP(int, WS_POSMM);
    unsigned* ctr = (unsigned*)(F.ws + WS_CTL) + (rep == 2 ? 20000 + 64 * (l * 2) : CW_Q + 64 * 8 * (l * 4 + 0 + rep));
    for (;;) {
        const int u = next_unit(F, ctr); if (u >= 384) break;
        const int qb = 31 - u / 12, bh = u % 12, b = bh / NH, h = bh % NH, q0 = qb * 256, NT = q0 / 64 + 4;
        const int* posb = F.pos + b * SEQ;
        const float slope2 = __int_as_float(__builtin_amdgcn_readfirstlane(__float_as_int(ALIBI_SLOPE[h] * LOG2E)));
        const size_t orow = (size_t)(b * SEQ + q0 + F.wave * 32);
        int T0 = 0, TL = 0; bool lin = false;
        { const int* qm = posmm + (size_t)(b * 128 + qb * 4) * 2; int qmin = qm[0], qmax = qm[1];
#pragma unroll
          for (int c = 1; c < 4; ++c) { qmin = qm[2 * c] < qmin ? qm[2 * c] : qmin; qmax = qm[2 * c + 1] > qmax ? qm[2 * c + 1] : qmax; }
          const int* km = posmm + (size_t)(b * 128) * 2;
          for (; T0 < NT - 4; ++T0) { const int kmin = km[2 * T0], kmax = km[2 * T0 + 1]; int dmin = qmin - kmax; if (kmin - qmax > dmin) dmin = kmin - qmax; if (dmin < 0) dmin = 0;
              if (!(slope2 * (float)dmin > reach)) break; }
          T0 &= ~1;
          for (TL = T0; TL < NT; ++TL) if (km[2 * TL + 1] > qmin) break;
          if (TL < NT - 4) TL = T0;
          int span = qm[1] - qm[0];
#pragma unroll
          for (int c = 1; c < 4; ++c) { const int sp = qm[2 * c + 1] - qm[2 * c]; span = sp > span ? sp : span; }
          lin = TL >= NT - 4 && slope2 * (float)span <= 24.0f;
        }
        for (int mp = 0; mp < 2; ++mp) {
            f32x16 o[4]; float l1;
            const bf16* Qp = QD + ((size_t)(bh * 2 + mp) * SEQ + q0) * 64; const int bhk = rep == 2 ? 0 : bh; const bf16* Kp = KD + (size_t)(bhk * 2 + mp) * SEQ * 64; const bf16* Vp = VD + (size_t)bhk * SEQ * 128;
            if (MODE == 5 && lin) { const int cw = posmm[(size_t)(b * 128 + qb * 4 + (__builtin_amdgcn_readfirstlane(F.tid >> 6) >> 1)) * 2];
                fa::attn_pass_da5p(Qp, Kp, Vp, posb, slope2, cw, q0, T0, NT, F.lds, F.tid, o, l1); }
            else fa::attn_pass<64, true, 1, MODE>(Qp, Kp, Vp, posb, slope2, bound, TL, q0, T0, NT, F.lds, F.tid, o, l1);
            int le_; asm volatile("v_mbcnt_lo_u32_b32 %0, -1, 0\n\tv_mbcnt_hi_u32_b32 %0, -1, %0" : "=v"(le_)); const int r32 = le_ & 31, hi = le_ >> 5;
            float f[16];
            if (mp == 0) {
                fa::row_bcast(1.0f / l1, al, r32, hi, f);
                float* ob = O1 + orow * 768 + h * 128; unsigned lo = (unsigned)(4 * hi * 768 + r32) * 4u; asm volatile("" : "+v"(lo));
#pragma unroll
                for (int r2 = 0; r2 < 16; ++r2)
#pragma unroll
                    for (int d = 0; d < 4; ++d) fa::stg<float>(ob, lo + (fa::crowc(r2) * 768 + d * 32) * 4, o[d][r2] * f[r2]);
            } else {
                fa::row_bcast(lam / l1, al, r32, hi, f);
                const float* hg = FIN(I_DAHG) + (size_t)l * 768 + h * 128;
                float hgv[4];
#pragma unroll
                for (int d = 0; d < 4; ++d) hgv[d] = fa::ldg<float>(hg + d * 32, (unsigned)r32 * 4u) * (1.0f - lam_init);
                const float* ob = O1 + orow * 768 + h * 128; unsigned lo = (unsigned)(4 * hi * 768 + r32) * 4u; asm volatile("" : "+v"(lo));
                bf16* mb = MIX + orow * D + h * 128; unsigned mo = (unsigned)(4 * hi * D + r32) * 2u; asm volatile("" : "+v"(mo));
#pragma unroll
                for (int r2 = 0; r2 < 16; ++r2)
#pragma unroll
                    for (int d = 0; d < 4; ++d) o[d][r2] = fa::ldg<float>(ob, lo + (fa::crowc(r2) * 768 + d * 32) * 4) - o[d][r2] * f[r2];
#pragma unroll
                for (int r2 = 0; r2 < 16; ++r2) {
                    float ss = 0.f;
#pragma unroll
                    for (int d = 0; d < 4; ++d) ss += o[d][r2] * o[d][r2];
                    ss = sum32(ss);
                    const float rn = rsqrtf(ss * (1.f / 128) + EPS);
#pragma unroll
                    for (int d = 0; d < 4; ++d) fa::stg<bf16>(mb, mo + (fa::crowc(r2) * D + d * 32) * 2, (bf16)f2bf(o[d][r2] * rn * hgv[d]));
                }
            }
        }
    }
}
template <int MODE> __device__ __forceinline__ void ph_attn_mla(Frame& F, int l, int rep = 0) {
    const bf16 *QM = WSP(bf16, WS_QM), *KM = WSP(bf16, WS_KM), *VM = WSP(bf16, WS_VM);
    bf16* MIX = rep >= 2 ? WSP(bf16, WS_U) : WSP(bf16, WS_MIX);
    const int lane = F.lane;
    LAS float* al = (LAS float*)(F.lds + fa::Lds<192>::WS_OFF) + F.wave * 64;
    float gqm = fmaxf(fmaxf(fabsf(FIN(I_MQG)[l * 192 + lane]), fabsf(FIN(I_MQG)[l * 192 + 64 + lane])), fabsf(FIN(I_MQG)[l * 192 + 128 + lane]));
    float gkm = fmaxf(fmaxf(fabsf(FIN(I_MKG)[l * 192 + lane]), fabsf(FIN(I_MKG)[l * 192 + 64 + lane])), fabsf(FIN(I_MKG)[l * 192 + 128 + lane]));
    gqm = wave_max(gqm); gkm = wave_max(gkm);
    const float bound = __int_as_float(__builtin_amdgcn_readfirstlane(__float_as_int(1.01f * 19.9907f * gqm * gkm)));
    if ((MODE == 5) != (bound < 60.0f)) return;
    unsigned* ctr = (unsigned*)(F.ws + WS_CTL) + (rep >= 2 ? 20000 + 64 * (l * 2 + 1) : CW_Q + 64 * 8 * (l * 4 + 2 + rep));
    for (;;) {
        const int u = next_unit(F, ctr); if (u >= 384) break;
        const int qb = 31 - u / 12, bh = u % 12, b = bh / NH, h = bh % NH, q0 = qb * 256, NT = q0 / 64 + 4;
        const size_t orow = (size_t)(b * SEQ + q0 + F.wave * 32);
        f32x16 o[4]; float l1;
        const int bhk = rep == 2 ? 0 : bh;
#if defined(PROBE_VAR)
        if (rep == 3) fa::attn_pass<192, false, 1, MODE, PROBE_VAR>(QM + ((size_t)bh * SEQ + q0) * 192, KM + (size_t)bhk * SEQ * 192, VM + (size_t)bhk * SEQ * 128, nullptr, 0.f, bound, 0, q0, 0, NT, F.lds, F.tid, o, l1); else
#endif
        fa::attn_pass<192, false, 1, MODE>(QM + ((size_t)bh * SEQ + q0) * 192, KM + (size_t)bhk * SEQ * 192, VM + (size_t)bhk * SEQ * 128, nullptr, 0.f, bound, 0, q0, 0, NT, F.lds, F.tid, o, l1);
        int le_; asm volatile("v_mbcnt_lo_u32_b32 %0, -1, 0\n\tv_mbcnt_hi_u32_b32 %0, -1, %0" : "=v"(le_)); const int r32 = le_ & 31, hi = le_ >> 5;
        float f[16]; fa::row_bcast(1.0f / l1, al, r32, hi, f);
        bf16* mb = MIX + orow * D + 768 + h * 128; unsigned mo = (unsigned)(4 * hi * D + r32) * 2u; asm volatile("" : "+v"(mo));
#pragma unroll
        for (int r2 = 0; r2 < 16; ++r2)
#pragma unroll
            for (int d = 0; d < 4; ++d) fa::stg<bf16>(mb, mo + (fa::crowc(r2) * D + d * 32) * 2, (bf16)f2bf(o[d][r2] * f[r2]));
    }
}
__device__ __forceinline__ void ph_sgu(Frame& F, int l, int rep = 0) {
    const float* UU = WSP(float, WS_UU); const bf16* GV = WSP(bf16, WS_GV); const float* SSQ = WSP(float, WS_SSQ_SGV); bf16* MIX = WSP(bf16, WS_MIX);
    LAS unsigned short* vs = (LAS unsigned short*)F.lds;
    LAS float* rs = (LAS float*)(F.lds + 128 * 128 * 2);
    const int lane = F.lane, r32 = lane & 31, hi = lane >> 5, tm = F.wave >> 1, tn0 = (F.wave & 1) * 2;
    __syncthreads();
    unsigned* sctr = (unsigned*)(F.ws + WS_CTL) + CW_Q + 64 * 8 * 16 + 64 * (l + 4 * rep);
    LAS float* wl = rs + 128;
    for (;;) { const int u = next_unit(F, sctr); if (u >= 512) break;
        const int g = u & 3, row0 = (u >> 2) * 128;
        const int t = 32 * tm + r32;
        const float* bias = FIN(I_SGB) + (l * 4 + g) * 128 + 32 * tm;
        const int c0 = g * 128 + 32 * tn0 + r32;
        float uu0[16], uu1[16], bvv[16];
#pragma unroll
        for (int r = 0; r < 16; ++r) { const int tt = crow(r, hi); const size_t row = (size_t)(row0 + 32 * tm + tt); uu0[r] = UU[row * 512 + c0]; uu1[r] = UU[row * 512 + c0 + 32]; bvv[r] = bias[tt]; }
        { const float* wb = FIN(I_SGW) + (size_t)(l * 4 + g) * 128 * 128;
          f32x4 wv_[8];
#pragma unroll
          for (int k = 0; k < 8; ++k) wv_[k] = *(const f32x4*)(wb + (size_t)(F.tid + k * NTHREADS) * 4);
#pragma unroll
          for (int k = 0; k < 8; ++k) { const int e = (F.tid + k * NTHREADS) * 4, tr = e >> 7, sc_ = e & 127; *(LAS f32x4*)(wl + tr * 132 + sc_) = wv_[k]; } }
        for (int i = F.tid; i < 128 * 16; i += NTHREADS) { const int s = i >> 4, c8 = i & 15; *(LAS bf16x8*)(vs + s * 128 + c8 * 8) = *(const bf16x8*)(GV + (size_t)(row0 + s) * 512 + g * 128 + c8 * 8); }
        if (F.tid < 128) { const f32x4 p = *(const f32x4*)(SSQ + (size_t)(row0 + F.tid) * 16 + g * 4); rs[F.tid] = rsqrtf(((p.x + p.y) + (p.z + p.w)) * (1.f / 128) + EPS); }
        __syncthreads();
        f32x16 acc0 = f32x16{}, acc1 = f32x16{};
        const LAS float* wrow = wl + t * 132;
        for (int ks = 0; ks < 2 * (tm + 1); ++ks) {
            const int s0 = 16 * ks + 8 * hi;
            const f32x4 w0 = *(const LAS f32x4*)(wrow + s0), w1 = *(const LAS f32x4*)(wrow + s0 + 4);
            float wv[8] = {w0.x, w0.y, w0.z, w0.w, w1.x, w1.y, w1.z, w1.w};
            bf16x8 af, b0, b1;
#pragma unroll
            for (int j = 0; j < 8; ++j) { af[j] = (short)f2bf(s0 + j <= t ? wv[j] * rs[s0 + j] : 0.f);
                b0[j] = (short)vs[(s0 + j) * 128 + 32 * tn0 + r32]; b1[j] = (short)vs[(s0 + j) * 128 + 32 * (tn0 + 1) + r32]; }
            acc0 = __builtin_amdgcn_mfma_f32_32x32x16_bf16(af, b0, acc0, 0, 0, 0);
            acc1 = __builtin_amdgcn_mfma_f32_32x32x16_bf16(af, b1, acc1, 0, 0, 0);
        }
#pragma unroll
        for (int r = 0; r < 16; ++r) { const int tt = crow(r, hi); const size_t row = (size_t)(row0 + 32 * tm + tt);
            MIX[row * D + 1536 + c0] = (bf16)f2bf(uu0[r] * (acc0[r] + bvv[r]));
            MIX[row * D + 1536 + c0 + 32] = (bf16)f2bf(uu1[r] * (acc1[r] + bvv[r])); }
        __syncthreads();
    }
}
__device__ __forceinline__ void ph_convfix(Frame& F, int l) {
    const float* EDGE = WSP(float, WS_EDGE); bf16* U = WSP(bf16, WS_U);
    const float* cw = FIN(I_CONVW) + (size_t)l * 3 * NUP; const float* cb = FIN(I_CONVB) + (size_t)l * NUP;
    const int gt = F.bid * NTHREADS + F.tid, nt = F.G * NTHREADS;
    constexpr int NIT = (M / 64) * 2 * (DFF / 4);
    auto item = [&](int i, unsigned long long& pk, size_t& dst) {
        const int ch = (i % (DFF / 4)) * 4, r = (i / (DFF / 4)) & 1, blk = i / (2 * (DFF / 4)); const bool first = (blk % (SEQ / 64)) == 0;
        f32x4 y[2];
#pragma unroll
        for (int bj = 0; bj < 2; ++bj) {
            const float* e0 = EDGE + ((size_t)(blk * 4) * 2 + bj) * DFF + ch;
            const f32x4 z = {0.f, 0.f, 0.f, 0.f};
            const f32x4 a0 = *(const f32x4*)(e0 + (size_t)r * 2 * DFF);
            const f32x4 a1 = r == 1 ? *(const f32x4*)e0 : (first ? z : *(const f32x4*)(e0 - (size_t)1 * 2 * DFF));
            const f32x4 a2 = first ? z : (r == 1 ? *(const f32x4*)(e0 - (size_t)1 * 2 * DFF) : *(const f32x4*)(e0 - (size_t)2 * 2 * DFF));
            y[bj] = *(const f32x4*)(cb + bj * DFF + ch) + *(const f32x4*)(cw + (size_t)2 * NUP + bj * DFF + ch) * a0 + *(const f32x4*)(cw + (size_t)NUP + bj * DFF + ch) * a1 + *(const f32x4*)(cw + bj * DFF + ch) * a2; }
        float o[4];
#pragma unroll
        for (int e = 0; e < 4; ++e) { const float g = y[0][e]; o[e] = g * __builtin_amdgcn_rcpf(1.0f + __expf(-g)) * y[1][e]; }
        pk = (unsigned long long)pk2(o[0], o[1]) | ((unsigned long long)pk2(o[2], o[3]) << 32); dst = (size_t)(blk * 64 + r) * DFF + ch; };
    for (int i = gt; i < NIT; i += 3 * nt) {
        unsigned long long p0 = 0, p1 = 0, p2 = 0; size_t d0 = 0, d1 = 0, d2 = 0;
        const bool h1 = i + nt < NIT, h2 = i + 2 * nt < NIT;
        item(i, p0, d0); if (h1) item(i + nt, p1, d1); if (h2) item(i + 2 * nt, p2, d2);
        *(unsigned long long*)(U + d0) = p0; if (h1) *(unsigned long long*)(U + d1) = p1; if (h2) *(unsigned long long*)(U + d2) = p2; }
}

__device__ __forceinline__ void ph_krope(Frame& F, int l) {
    const bf16* H = WSP(bf16, WS_H); const bf16* Wk = wptr(F, l, WL_IN) + (size_t)4096 * D; float* KR = WSP(float, WS_KR); float* SSQ = WSP(float, WS_SSQ_KR);
    constexpr int PITCH = 1024;
    LAS unsigned char* As = F.lds; LAS unsigned char* Bs = F.lds + 64 * PITCH;
    LAS float* red = (LAS float*)F.lds;
    const int lane = F.lane, r32 = lane & 31, hi = lane >> 5, w = F.wave;
    __syncthreads();
    for (int tb = F.bid; tb < M / 64; tb += F.G) {
        f32x16 acc[2][2];
#pragma unroll
        for (int i = 0; i < 2; ++i)
#pragma unroll
            for (int j = 0; j < 2; ++j) acc[i][j] = f32x16{};
        for (int kc = 0; kc < 4; ++kc) {
#pragma unroll
            for (int p = 0; p < 8; ++p) { const int q = p * NTHREADS + F.tid, row = q >> 6, c16 = q & 63;
                *(LAS v4u*)(As + row * PITCH + (c16 ^ (row & 7)) * 16) = *(const v4u*)(H + (size_t)(tb * 64 + row) * D + kc * 512 + c16 * 8);
                *(LAS v4u*)(Bs + row * PITCH + (c16 ^ (row & 7)) * 16) = *(const v4u*)(Wk + (size_t)row * D + kc * 512 + c16 * 8); }
            __syncthreads();
#pragma unroll
            for (int ks = 0; ks < 4; ++ks) { const int ko = (((w * 64 + ks * 16 + hi * 8) >> 3) ^ (r32 & 7)) * 16;
                const bf16x8 A0 = *(const LAS bf16x8*)(As + r32 * PITCH + ko), A1 = *(const LAS bf16x8*)(As + (32 + r32) * PITCH + ko);
                const bf16x8 B0 = *(const LAS bf16x8*)(Bs + r32 * PITCH + ko), B1 = *(const LAS bf16x8*)(Bs + (32 + r32) * PITCH + ko);
                acc[0][0] = __builtin_amdgcn_mfma_f32_32x32x16_bf16(A0, B0, acc[0][0], 0, 0, 0); acc[0][1] = __builtin_amdgcn_mfma_f32_32x32x16_bf16(A0, B1, acc[0][1], 0, 0, 0);
                acc[1][0] = __builtin_amdgcn_mfma_f32_32x32x16_bf16(A1, B0, acc[1][0], 0, 0, 0); acc[1][1] = __builtin_amdgcn_mfma_f32_32x32x16_bf16(A1, B1, acc[1][1], 0, 0, 0); }
            __syncthreads();
        }
#pragma unroll
        for (int i = 0; i < 2; ++i)
#pragma unroll
            for (int j = 0; j < 2; ++j)
#pragma unroll
                for (int r = 0; r < 16; ++r) red[(w * 64 + (i * 2 + j) * 16 + r) * 64 + lane] = acc[i][j][r];
        __syncthreads();
#pragma unroll
        for (int c = 0; c < 8; ++c) { const int cb = w * 8 + c, i = cb >> 5, j = (cb >> 4) & 1, r = cb & 15;
            float v = 0.f;
#pragma unroll
            for (int ww = 0; ww < 8; ++ww) v += red[(ww * 64 + cb) * 64 + lane];
            const int row = tb * 64 + 32 * i + crow(r, hi);
            KR[(size_t)row * 64 + 32 * j + r32] = v;
            const float ss = sum32(v * v);
            if (r32 == 0) SSQ[(size_t)row * 2 + j] = ss; }
        __syncthreads();
    }
}
__device__ __forceinline__ void frame_init(Frame& F, const Args& a, unsigned char* lds) {
    F.lds = (LAS unsigned char*)lds; F.tid = threadIdx.x; F.lane = F.tid & 63; F.wave = __builtin_amdgcn_readfirstlane(F.tid >> 6); F.wave0 = F.wave;
    F.bid = blockIdx.x; F.G = gridDim.x; F.gw = F.bid * NWAVES + F.wave; F.ngw = F.G * NWAVES;
    F.ka = (const __attribute__((address_space(4))) Args*)__builtin_amdgcn_kernarg_segment_ptr();
    F.pos = (const int*)a.in[I_POS]; F.out = a.out; F.ws = a.ws;
}
__device__ __forceinline__ void frame_retid(Frame& F) {
    int lane; asm volatile("v_mbcnt_lo_u32_b32 %0, -1, 0\n\tv_mbcnt_hi_u32_b32 %0, -1, %0" : "=v"(lane));
    int w = F.wave0; asm volatile("" : "+s"(w));
    F.lane = lane; F.wave = w; F.tid = w * 64 + lane;
    int bid = blockIdx.x, G = gridDim.x; asm volatile("" : "+s"(bid)); asm volatile("" : "+s"(G)); F.bid = bid; F.G = G;
    F.gw = bid * NWAVES + F.wave; F.ngw = G * NWAVES;
}
__device__ __forceinline__ void grid_bar(const XcdBarrier& bar, int wave0) {
    int lane_; asm volatile("v_mbcnt_lo_u32_b32 %0, -1, 0\n\tv_mbcnt_hi_u32_b32 %0, -1, %0" : "=v"(lane_)); const bool leader = (wave0 == 0) && (lane_ == 0);
    XcdBarrier b2 = bar; unsigned z_ = 0u; asm volatile("" : "+s"(b2.x), "+s"(z_)); b2.bar = bar.bar + z_; xcd_barrier(b2, leader); }
template <int PH> __device__ __forceinline__ void run_phase(Frame& F, int l) {
    frame_retid(F); asm volatile("; PHASE_BEGIN %0" :: "n"(PH));
    const float* mod = WSP(float, WS_MOD) + (size_t)l * 12 * D;
    if constexpr (PH == 0) ph_prologue(F);
    if constexpr (PH == 1) ph_modreduce(F);
    if constexpr (PH == 2) { if (l == 0) ph_norm<false>(F, l, FIN(I_X), 0, D); else ph_norm<true>(F, l, WSP(bf16, WS_XB), 0, D); }
    if constexpr (PH == 3) { pg8::Gemm g{WSP(bf16, WS_H), wptr(F, l, WL_IN), M, 4096, D}; pg8::StaticOrder S; S.init(M, 4096, F.G, F.bid);
        pg8::EpiInProj E{WSP(bf16, WS_QD), WSP(bf16, WS_KD), WSP(bf16, WS_VD), WSP(bf16, WS_QA), WSP(bf16, WS_KVA), WSP(bf16, WS_GV), WSP(float, WS_UU), WSP(float, WS_KR),
                         WSP(float, WS_SSQ_QA), WSP(float, WS_SSQ_KVA), WSP(float, WS_SSQ_SGV), WSP(float, WS_SSQ_KR), FIN(I_DAQG) + l * 64, FIN(I_DAKG) + l * 64, FIN(I_QAG) + l * 512, FIN(I_KVAG) + l * 256, FIN(I_SGVG) + l * 512};
        pg8::gemm_phase<pg8::EpiInProj, pg8::StaticOrder, true, true>(F.lds, g, S, E, F.tid); frame_retid(F); ph_krope(F, l); }
    if constexpr (PH == 5) {
        PG8_LAS float* X = (PG8_LAS float*)(F.lds + LDSCTL_OFF + 1024);
        { pg8::Gemm g{WSP(bf16, WS_QA), wptr(F, l, WL_UQ), M, UQ_PAD, QRANK}; pg8::StaticOrder S; S.init(M, UQ_PAD, F.G, F.bid);
          pg8::EpiMlaQ E{WSP(bf16, WS_QM), WSP(float, WS_SSQ_QA), WSP(float, WS_COS), WSP(float, WS_SIN), FIN(I_MQG) + l * 192, X};
          pg8::gemm_phase<pg8::EpiMlaQ, pg8::StaticOrder, true, true>(F.lds, g, S, E, F.tid); }
        __syncthreads(); frame_retid(F);
        { pg8::Gemm g{WSP(bf16, WS_KVA), wptr(F, l, WL_UKV), M, UKV_N, KVRANK}; pg8::StaticOrder S; S.init(M, UKV_N, F.G, F.G - 1 - F.bid);
          pg8::EpiMlaKV E{WSP(bf16, WS_KM), WSP(bf16, WS_VM), WSP(float, WS_SSQ_KVA), WSP(float, WS_SSQ_KR), WSP(float, WS_KR), WSP(float, WS_COS), WSP(float, WS_SIN), FIN(I_MKG) + l * 192, X};
          pg8::gemm_phase<pg8::EpiMlaKV, pg8::StaticOrder, true, true>(F.lds, g, S, E, F.tid); }
    }
    if constexpr (PH == 7) { ph_attn_da<5>(F, l); frame_retid(F); ph_attn_da<0>(F, l); frame_retid(F); asm volatile("; PHASE_BEGIN 71"); ph_attn_mla<5>(F, l); frame_retid(F); ph_attn_mla<0>(F, l); frame_retid(F); asm volatile("; PHASE_BEGIN 72"); ph_sgu(F, l); }
    if constexpr (PH == 8) { pg8::Gemm g{WSP(bf16, WS_MIX), wptr(F, l, WL_OUT), M, D, D}; pg8::StaticOrder S; S.init(M, D, F.G, F.bid);
        pg8::EpiResidP E{l == 0 ? (const void*)FIN(I_X) : (const void*)WSP(bf16, WS_XB), WSP(bf16, WS_XB), l != 0, 1, mod + 2 * D, 6 * D}; pg8::gemm_phase<pg8::EpiResidP, pg8::StaticOrder, true, true>(F.lds, g, S, E, F.tid); }
    if constexpr (PH == 9) ph_norm<true>(F, l, WSP(bf16, WS_XB), 3 * D, 4 * D);
    if constexpr (PH == 10) { pg8::Gemm g{WSP(bf16, WS_H), wptr(F, l, WL_UP), M, NUP, D}; pg8::StaticOrder S; S.init(M, NUP, F.G, F.bid);
        pg8::EpiConvGate E{WSP(bf16, WS_U), WSP(float, WS_EDGE), FIN(I_CONVW) + (size_t)l * 3 * NUP, FIN(I_CONVB) + (size_t)l * NUP}; pg8::gemm_phase<pg8::EpiConvGate, pg8::StaticOrder, true, true>(F.lds, g, S, E, F.tid); }
    if constexpr (PH == 11) ph_convfix(F, l);
    if constexpr (PH == 12) { pg8::Gemm g{WSP(bf16, WS_U), wptr(F, l, WL_DOWN), M, D, DFF}; pg8::StaticOrder S; S.init(M, D, F.G, F.bid);
        pg8::EpiResidP E{WSP(bf16, WS_XB), l + 1 < DEPTH ? (void*)WSP(bf16, WS_XB) : (void*)F.out, 1, l + 1 < DEPTH, mod + 5 * D, 6 * D}; pg8::gemm_phase<pg8::EpiResidP, pg8::StaticOrder, true, true>(F.lds, g, S, E, F.tid); }
}
__global__ void __launch_bounds__(NTHREADS, 2) mega_fwd(Args a) {
    extern __shared__ __attribute__((aligned(16))) unsigned char lds[];
    Frame F; frame_init(F, a, lds);
    if (F.tid < 16) ((LAS unsigned*)(F.lds + LDSCTL_OFF))[F.tid] = 0u;
    __syncthreads();
    XcdBarrier bar = xcd_barrier_post((unsigned*)(F.ws + WS_CTL) + CW_BAR, (volatile LAS unsigned*)(F.lds + LDSCTL_OFF + 32));
    run_phase<0>(F, 0); grid_bar(bar, F.wave0);
#if defined(PROBE_P0)
    run_phase<0>(F, 0); grid_bar(bar, F.wave0);
#endif
    run_phase<1>(F, 0); grid_bar(bar, F.wave0);
    for (int l = 0; l < DEPTH; ++l) {
        run_phase<2>(F, l); grid_bar(bar, F.wave0);
#if defined(PROBE_EW)
        run_phase<2>(F, l); grid_bar(bar, F.wave0);
#endif
        run_phase<3>(F, l); grid_bar(bar, F.wave0);
#if defined(PROBE_GEMM)
        run_phase<3>(F, l); grid_bar(bar, F.wave0);
#endif
        run_phase<5>(F, l); grid_bar(bar, F.wave0);
        run_phase<7>(F, l); grid_bar(bar, F.wave0);
#if defined(PROBE_P7)
        frame_retid(F); ph_attn_da<5>(F, l, 1); frame_retid(F); ph_attn_mla<5>(F, l, 1); grid_bar(bar, F.wave0);
#endif
#if defined(PROBE_LOC)
        frame_retid(F); ph_attn_da<5>(F, l, 2); frame_retid(F); ph_attn_mla<5>(F, l, 2); grid_bar(bar, F.wave0);
#endif
#if defined(PROBE_DA)
        frame_retid(F); ph_attn_da<5>(F, l, 1); grid_bar(bar, F.wave0);
#endif
#if defined(PROBE_VAR)
        frame_retid(F); ph_attn_mla<5>(F, l, 3); grid_bar(bar, F.wave0);
#endif
#if defined(PROBE_MLA)
        frame_retid(F); ph_attn_mla<5>(F, l, 1); grid_bar(bar, F.wave0);
#endif
#if defined(PROBE_SGU)
        frame_retid(F); ph_sgu(F, l, 1); grid_bar(bar, F.wave0);
#endif
        run_phase<8>(F, l); grid_bar(bar, F.wave0);
        run_phase<9>(F, l); grid_bar(bar, F.wave0);
        run_phase<10>(F, l); grid_bar(bar, F.wave0);
#if defined(PROBE_G10)
        frame_retid(F); run_phase<10>(F, l); grid_bar(bar, F.wave0);
#endif
#if defined(PROBE_G10N)
        frame_retid(F); { pg8::Gemm g{WSP(bf16, WS_H), wptr(F, l, WL_UP), M, NUP, D}; pg8::StaticOrder S; S.init(M, NUP, F.G, F.bid);
          pg8::EpiNull E{WSP(float, WS_MIX)}; pg8::gemm_phase<pg8::EpiNull, pg8::StaticOrder, true, true>(F.lds, g, S, E, F.tid); } grid_bar(bar, F.wave0);
#endif
#if defined(PROBE_GEMM)
        run_phase<10>(F, l); grid_bar(bar, F.wave0);
#endif
        run_phase<11>(F, l); grid_bar(bar, F.wave0);
#if defined(PROBE_EW)
        run_phase<11>(F, l); grid_bar(bar, F.wave0);
#endif
        run_phase<12>(F, l); if (l + 1 < DEPTH) grid_bar(bar, F.wave0);
    }
}

extern "C" void kernel_launch(void* const* d_in, const int* in_sizes, int n_in, void* d_out, int out_size, void* d_ws, size_t ws_size, hipStream_t stream) {
    static int grid = 0;
    if (grid == 0) {
        if (n_in != N_IN || in_sizes[0] != M * D || out_size != M * D || ws_size < WS_END) { fprintf(stderr, "kernel_launch: shape mismatch (n_in %d, ws %zu, need %zu)\n", n_in, ws_size, (size_t)WS_END); grid = -1; return; }
        int dev = 0, cus = 0, per_cu = 0;
        if (hipGetDevice(&dev) != hipSuccess || hipDeviceGetAttribute(&cus, hipDeviceAttributeMultiprocessorCount, dev) != hipSuccess) { grid = -1; return; }
        if (hipFuncSetAttribute((const void*)mega_fwd, hipFuncAttributeMaxDynamicSharedMemorySize, LDS_BYTES) != hipSuccess) { fprintf(stderr, "hipFuncSetAttribute failed\n"); grid = -1; return; }
        if (hipOccupancyMaxActiveBlocksPerMultiprocessor(&per_cu, (const void*)mega_fwd, NTHREADS, LDS_BYTES) != hipSuccess || per_cu < 1) fprintf(stderr, "kernel_launch: occupancy query reports %d\n", per_cu);
        (void)hipGetLastError();
        grid = cus > 0 ? cus : 256;
    }
    if (grid < 0) return;
    if (hipMemsetAsync((char*)d_ws + WS_CTL, 0, CTL_ZERO_BYTES, stream) != hipSuccess) { fprintf(stderr, "kernel_launch: memset failed\n"); return; }
    Args a{};
    for (int i = 0; i < N_IN; ++i) a.in[i] = d_in[i];
    a.out = (float*)d_out; a.ws = (unsigned char*)d_ws; a.ph = 0; a.l = 0;
    hipLaunchKernelGGL(mega_fwd, dim3(grid), dim3(NTHREADS), LDS_BYTES, stream, a);
    const hipError_t le = hipPeekAtLastError();
    if (le != hipSuccess) fprintf(stderr, "kernel_launch: launch failed: %s\n", hipGetErrorName(le));
}
```

```cpp
#include <hip/hip_runtime.h>
#include <cstdio>
#include <cstdint>
#include <cmath>
#define GAS __attribute__((address_space(1)))
#define LAS __attribute__((address_space(3)))
namespace pg8 {
#define PG8_LAS __attribute__((address_space(3)))
typedef unsigned short bf16_t;
typedef short bf16x8 __attribute__((ext_vector_type(8)));
typedef float f32x4 __attribute__((ext_vector_type(4)));
typedef unsigned u32x4 __attribute__((ext_vector_type(4)));
constexpr int BM = 256, BK = 64, HALF = 128, HTB = HALF * BK * 2  , STAGE_BYTES = 8 * HTB, NXCD = 8, WGM = 8;

__host__ __device__ __forceinline__ int lds_byte(int r, int c) { const int st = (r >> 4) * 2 + (c >> 5), rr = r & 15, cc = c & 31, ob = rr * 64 + cc * 2; return st * 1024 + (ob ^ (((ob >> 9) & 1) << 5)); }
__host__ __device__ __forceinline__ void stage_rc(int b, int& R, int& C) { const int st = b / 1024, sb = b % 1024, swz = sb ^ (((sb >> 9) & 1) << 5); R = (st >> 1) * 16 + swz / 64; C = (st & 1) * 32 + (swz % 64) / 2; }
__host__ __device__ __forceinline__ int perm32(int rho) { const int n = rho >> 4, i = rho & 15; return 8 * (i >> 2) + 4 * n + (i & 3); }

struct Unit { int pm, pn; };
struct Gemm { const bf16_t* A; const bf16_t* Bt; int M, N, K; };

struct StaticOrder {
    int nM, nN, nwg, G, c;
    __host__ __device__ void init(int M, int N, int G_, int c_) { nM = M / BM; nN = N / BM; nwg = nM * nN; G = G_; c = c_; }
    __host__ __device__ bool next(int i, Unit& u) const {
        const long L = (long)i * G + c; if (L >= nwg) return false;
        int wgid = (int)L; { const int q = nwg / NXCD, r = nwg % NXCD, xcd = wgid % NXCD, off = wgid / NXCD; wgid = (xcd < r ? xcd * (q + 1) : r * (q + 1) + (xcd - r) * q) + off; }
        const int nig = WGM * nN, gid = wgid / nig, fm = gid * WGM, gsz = (nM - fm) < WGM ? (nM - fm) : WGM;
        u.pm = fm + ((wgid % nig) % gsz); u.pn = (wgid % nig) / gsz; return true;
    }
    __device__ __forceinline__ void a_ready(const Unit&) const {}
    __device__ __forceinline__ void done(const Unit&) const {}
};

__device__ __forceinline__ unsigned cvt_pk_bf16(float lo, float hi) { unsigned r; asm volatile("v_cvt_pk_bf16_f32 %0, %1, %2" : "=v"(r) : "v"(lo), "v"(hi)); return r; }
typedef float f32x2 __attribute__((ext_vector_type(2)));
typedef _Float16 f16x2 __attribute__((ext_vector_type(2)));
__device__ __forceinline__ unsigned pkh2(float a, float b) { const f16x2 h = {(_Float16)a, (_Float16)b}; return __builtin_bit_cast(unsigned, h); }
__device__ __forceinline__ float uph_lo(unsigned w) { return (float)__builtin_bit_cast(f16x2, w).x; }
__device__ __forceinline__ float uph_hi(unsigned w) { return (float)__builtin_bit_cast(f16x2, w).y; }

template <class Epi, class Sched, bool ALIGN_EPI = false, bool SP2 = false>
__device__ __forceinline__ void gemm_phase(PG8_LAS unsigned char* lds, const Gemm g, const Sched& S, const Epi& E, int tid_in) {
    int tid_ = tid_in; asm volatile("" : "+v"(tid_));
    const int tid = tid_, wid = __builtin_amdgcn_readfirstlane(tid >> 6), lane = tid & 63, wr = wid >> 2, wc = wid & 3, fr = lane & 15, fq = lane >> 4;
    const int K = g.K, nt = K / BK;
    unsigned voffA[2], voffB[2];
#pragma unroll
    for (int i = 0; i < 2; ++i) { int R, C; stage_rc(tid * 16 + i * 8192, R, C); const int Rb = Epi::PERM ? ((R & ~31) + perm32(R & 31)) : R;
        voffA[i] = (unsigned)(R * K + C) * 2u; voffB[i] = (unsigned)(Rb * K + C) * 2u; }
    const size_t kstep = (size_t)(BK * 2);
    const size_t hstep = (size_t)HALF * K * 2;
    const size_t tstep = 2 * hstep;
    const unsigned ldsw = (unsigned)wid * 1024u;
    const int aoff = lds_byte(wr * 64 + fr, fq * 8), boff = lds_byte(wc * 32 + fr, fq * 8);
#define PG8_SA(b, h) (((b) * 2 + (h)) * HTB)
#define PG8_SB(b, h) ((4 + (b) * 2 + (h)) * HTB)
#define PG8_STAGE(bufoff, gbase, voff) do { _Pragma("unroll") for (int _i = 0; _i < 2; ++_i) \
        __builtin_amdgcn_global_load_lds((const unsigned*)((const char*)(gbase) + (voff)[_i]), (PG8_LAS unsigned*)(lds + (bufoff) + ldsw + _i * 8192), 16, 0, 0); } while (0)
#define PG8_LDA(dst, b, h) do { _Pragma("unroll") for (int m = 0; m < 4; ++m) _Pragma("unroll") for (int k = 0; k < 2; ++k) dst[m][k] = *(const PG8_LAS bf16x8*)(lds + PG8_SA(b, h) + aoff + m * 2048 + k * 1024); } while (0)
#define PG8_LDB(dst, b, h) do { _Pragma("unroll") for (int n = 0; n < 2; ++n) _Pragma("unroll") for (int k = 0; k < 2; ++k) dst[n][k] = *(const PG8_LAS bf16x8*)(lds + PG8_SB(b, h) + boff + n * 2048 + k * 1024); } while (0)
#define PG8_MMA(ai, bj, At, Bt) do { __builtin_amdgcn_s_setprio(1); _Pragma("unroll") for (int m = 0; m < 4; ++m) _Pragma("unroll") for (int n = 0; n < 2; ++n) _Pragma("unroll") for (int k = 0; k < 2; ++k) \
        acc[ai][bj][m][n] = __builtin_amdgcn_mfma_f32_16x16x32_bf16(Bt[n][k], At[m][k], acc[ai][bj][m][n], 0, 0, 0); __builtin_amdgcn_s_setprio(0); } while (0)
#define PG8_WAIT_V(n) asm volatile("s_waitcnt vmcnt(" #n ")" ::: "memory")
#define PG8_WAIT_L(n) asm volatile("s_waitcnt lgkmcnt(" #n ")" ::: "memory")
#define PG8_BAR __builtin_amdgcn_s_barrier()
#define PG8_SCHED __builtin_amdgcn_sched_barrier(0)
    Unit cur, nxt; int ui = 0;
    if (!S.next(0, cur)) return;
    f32x4 acc[2][2][4][2];
#pragma unroll
    for (int a = 0; a < 2; ++a)
#pragma unroll
        for (int b = 0; b < 2; ++b)
#pragma unroll
            for (int m = 0; m < 4; ++m)
#pragma unroll
                for (int n = 0; n < 2; ++n) acc[a][b][m][n] = (f32x4){0.f, 0.f, 0.f, 0.f};
    bf16x8 At[4][2], B0[2][2], B1[2][2];
    const char* cA = (const char*)g.A + (size_t)cur.pm * tstep; const char* cB = (const char*)g.Bt + (size_t)cur.pn * tstep;
    S.a_ready(cur);
    if constexpr (SP2) {
        PG8_STAGE(PG8_SB(0, 0), cB, voffB); PG8_STAGE(PG8_SB(0, 1), cB + hstep, voffB); PG8_STAGE(PG8_SA(0, 0), cA, voffA); PG8_STAGE(PG8_SA(0, 1), cA + hstep, voffA);
        if (wr == 1) PG8_BAR;
        PG8_WAIT_V(2); PG8_BAR;
        PG8_STAGE(PG8_SB(1, 0), cB + kstep, voffB); PG8_STAGE(PG8_SA(1, 0), cA + kstep, voffA); PG8_STAGE(PG8_SB(1, 1), cB + hstep + kstep, voffB);
        PG8_WAIT_V(6); PG8_BAR;
    } else {
        PG8_STAGE(PG8_SB(0, 0), cB, voffB); PG8_STAGE(PG8_SA(0, 0), cA, voffA); PG8_STAGE(PG8_SB(0, 1), cB + hstep, voffB); PG8_STAGE(PG8_SA(0, 1), cA + hstep, voffA);
        if (wr == 1) PG8_BAR;
        PG8_WAIT_V(4); PG8_BAR;
        PG8_STAGE(PG8_SB(1, 0), cB + kstep, voffB); PG8_STAGE(PG8_SA(1, 0), cA + kstep, voffA); PG8_STAGE(PG8_SB(1, 1), cB + hstep + kstep, voffB);
        PG8_WAIT_V(6); PG8_BAR;
    }
    for (;;) {
        const bool has_next = S.next(ui + 1, nxt);
        const char* nA = has_next ? (const char*)g.A + (size_t)nxt.pm * tstep : cA; const char* nB = has_next ? (const char*)g.Bt + (size_t)nxt.pn * tstep : cB;
        for (int t = 0; t < nt; t += 2) {
            const bool last = (t == nt - 2);
            const char* a1 = cA + (size_t)(t + 1) * kstep;
            const char* a2 = last ? nA : cA + (size_t)(t + 2) * kstep; const char* b2 = last ? nB : cB + (size_t)(t + 2) * kstep;
            const char* a3 = a2 + kstep; const char* b3 = b2 + kstep;
            if (last && has_next) S.a_ready(nxt);
            if constexpr (SP2) {
            PG8_LDB(B0, 0, 0); PG8_LDB(B1, 0, 1); PG8_SCHED; PG8_LDA(At, 0, 0); PG8_STAGE(PG8_SA(1, 1), a1 + hstep, voffA);
            PG8_WAIT_V(8); PG8_WAIT_L(0); PG8_BAR; PG8_MMA(0, 0, At, B0); PG8_MMA(0, 1, At, B1); PG8_BAR; PG8_SCHED;
            PG8_LDA(At, 0, 1); PG8_STAGE(PG8_SB(0, 0), b2, voffB); PG8_STAGE(PG8_SB(0, 1), b2 + hstep, voffB); PG8_STAGE(PG8_SA(0, 0), a2, voffA);
            PG8_WAIT_V(8); PG8_WAIT_L(0); PG8_BAR; PG8_MMA(1, 0, At, B0); PG8_MMA(1, 1, At, B1); PG8_BAR; PG8_SCHED;
            PG8_LDB(B0, 1, 0); PG8_LDB(B1, 1, 1); PG8_SCHED; PG8_LDA(At, 1, 0); PG8_STAGE(PG8_SA(0, 1), a2 + hstep, voffA);
            PG8_WAIT_V(8); PG8_WAIT_L(0); PG8_BAR; PG8_MMA(0, 0, At, B0); PG8_MMA(0, 1, At, B1); PG8_BAR; PG8_SCHED;
            PG8_LDA(At, 1, 1); PG8_STAGE(PG8_SB(1, 0), b3, voffB); PG8_STAGE(PG8_SB(1, 1), b3 + hstep, voffB); PG8_STAGE(PG8_SA(1, 0), a3, voffA);
            PG8_WAIT_V(8); PG8_WAIT_L(0); PG8_BAR; PG8_MMA(1, 0, At, B0); PG8_MMA(1, 1, At, B1); PG8_BAR; PG8_SCHED;
            } else {
            PG8_LDB(B0, 0, 0); PG8_SCHED; PG8_LDA(At, 0, 0); PG8_STAGE(PG8_SA(1, 1), a1 + hstep, voffA);
            PG8_WAIT_L(8); PG8_BAR; PG8_WAIT_L(0); PG8_MMA(0, 0, At, B0); PG8_BAR; PG8_SCHED;
            PG8_LDB(B1, 0, 1); PG8_STAGE(PG8_SB(0, 0), b2, voffB);
            PG8_BAR; PG8_WAIT_L(0); PG8_MMA(0, 1, At, B1); PG8_BAR;
            PG8_LDA(At, 0, 1); PG8_STAGE(PG8_SA(0, 0), a2, voffA);
            PG8_BAR; PG8_WAIT_L(0); PG8_MMA(1, 0, At, B0); PG8_BAR; PG8_SCHED;
            PG8_STAGE(PG8_SB(0, 1), b2 + hstep, voffB);
            PG8_WAIT_V(6); PG8_BAR; PG8_MMA(1, 1, At, B1); PG8_BAR;
            PG8_LDB(B0, 1, 0); PG8_SCHED; PG8_LDA(At, 1, 0); PG8_STAGE(PG8_SA(0, 1), a2 + hstep, voffA);
            PG8_WAIT_L(8); PG8_BAR; PG8_WAIT_L(0); PG8_MMA(0, 0, At, B0); PG8_BAR; PG8_SCHED;
            PG8_LDB(B1, 1, 1); PG8_STAGE(PG8_SB(1, 0), b3, voffB);
            PG8_BAR; PG8_WAIT_L(0); PG8_MMA(0, 1, At, B1); PG8_BAR;
            PG8_LDA(At, 1, 1); PG8_STAGE(PG8_SA(1, 0), a3, voffA);
            PG8_BAR; PG8_WAIT_L(0); PG8_MMA(1, 0, At, B0); PG8_BAR; PG8_SCHED;
            PG8_STAGE(PG8_SB(1, 1), b3 + hstep, voffB);
            PG8_WAIT_V(6); PG8_BAR; PG8_MMA(1, 1, At, B1); PG8_BAR;
            }
        }
        if constexpr (ALIGN_EPI) { if (wr == 0) PG8_BAR; }
        if constexpr (!Epi::AFTER_DRAIN) { E(acc, cur, wr, wc, fr, fq); S.done(cur); }
        if (!has_next) break;
#pragma unroll
        for (int a = 0; a < 2; ++a)
#pragma unroll
            for (int b = 0; b < 2; ++b)
#pragma unroll
                for (int m = 0; m < 4; ++m)
#pragma unroll
                    for (int n = 0; n < 2; ++n) acc[a][b][m][n] = (f32x4){0.f, 0.f, 0.f, 0.f};
        cur = nxt; cA = nA; cB = nB; ++ui;
        if constexpr (ALIGN_EPI) { if (wr == 1) PG8_BAR; }
    }
    PG8_WAIT_V(0);
    if constexpr (!ALIGN_EPI) { if (wr == 0) PG8_BAR; }
    PG8_BAR;
    if constexpr (Epi::AFTER_DRAIN) { E.fused(acc, cur, wr, wc, fr, fq, lds, wid, lane); S.done(cur); }
#undef PG8_SA
#undef PG8_SB
#undef PG8_STAGE
#undef PG8_LDA
#undef PG8_LDB
#undef PG8_MMA
#undef PG8_WAIT_V
#undef PG8_WAIT_L
#undef PG8_BAR
#undef PG8_SCHED
}
}
#define XB_TMO      128
#define XB_XCNT(j)  (256  + 64 * (j))
#define XB_XSUB(j)  (1280 + 64 * (j))
#define XB_XGEN(j)  (2304 + 64 * (j))
#define XB_TOP      3328
#define XB_TOPGEN   3392
#define XCD_BAR_WORDS 3456
#define XB_SPIN_CAP (1u << 18)

__device__ __forceinline__ unsigned xb_ld(unsigned* p)              { return __hip_atomic_load(p, __ATOMIC_RELAXED, __HIP_MEMORY_SCOPE_AGENT); }
__device__ __forceinline__ unsigned xb_add(unsigned* p, unsigned v) { return __hip_atomic_fetch_add(p, v, __ATOMIC_RELAXED, __HIP_MEMORY_SCOPE_AGENT); }
__device__ __forceinline__ unsigned xb_xcc_id() { return (unsigned)__builtin_amdgcn_s_getreg((3 << 11) | 20) & 0xFu; }
#define XB_SPIN(cond, bar) do { unsigned _sp = 0; while (cond) { __builtin_amdgcn_s_sleep(1); \
    if ((++_sp & 255u) == 0u) { if (xb_ld(&(bar)[XB_TMO])) break; if (_sp > XB_SPIN_CAP) { atomicAdd(&(bar)[XB_TMO], 1u); break; } } } } while (0)

struct XcdBarrier {
    unsigned* bar; unsigned x;
    volatile LAS unsigned* st;
};

__device__ __forceinline__ XcdBarrier xcd_barrier_post(unsigned* bar, volatile LAS unsigned* st) {
    XcdBarrier b; b.bar = bar; b.x = xb_xcc_id(); b.st = st;
    if (threadIdx.x == 0) (void)xb_add(&bar[XB_XCNT(b.x)], 1u);
    return b;
}
__device__ __forceinline__ void xcd_barrier_complete(unsigned* bar, unsigned x, unsigned& nloc, unsigned& nx) {
    const unsigned G = gridDim.x * gridDim.y * gridDim.z;
    unsigned sum, cnt, mine, sp = 0u;
    for (;;) {
        sum = 0u; cnt = 0u; mine = 0u;
#pragma unroll
        for (unsigned j = 0; j < 16; ++j) { const unsigned c = xb_ld(&bar[XB_XCNT(j)]); sum += c; cnt += (c > 0u) ? 1u : 0u; mine = (j == x) ? c : mine; }
        if (sum == G) break;
        __builtin_amdgcn_s_sleep(1);
        if ((++sp & 255u) == 0u) { if (xb_ld(&bar[XB_TMO])) break; if (sp > XB_SPIN_CAP) { atomicAdd(&bar[XB_TMO], 1u); break; } }
    }
    nloc = mine > 0u ? mine : 1u; nx = cnt > 0u ? cnt : 1u;
}

__device__ __forceinline__ void xcd_barrier(const XcdBarrier& b, bool leader) {
    asm volatile("s_waitcnt vmcnt(0)" ::: "memory");
    __syncthreads();
    if (leader) {
        unsigned* bar = b.bar;
        __builtin_amdgcn_s_waitcnt(0);
        unsigned nloc = b.st[0], nx = b.st[1];
        if (nloc == 0u) { xcd_barrier_complete(bar, b.x, nloc, nx); b.st[0] = nloc; b.st[1] = nx; }
        const unsigned old = xb_add(&bar[XB_XSUB(b.x)], 1u);
        const unsigned gen = old / nloc;
        if (old + 1u == (gen + 1u) * nloc) {
            __builtin_amdgcn_fence(__ATOMIC_RELEASE, "agent");
            asm volatile("s_waitcnt vmcnt(0)" ::: "memory");
            const unsigned og = xb_add(&bar[XB_TOP], 1u);
            const unsigned tg = og / nx;
            if (og + 1u == (tg + 1u) * nx) xb_add(&bar[XB_TOPGEN], 1u);
            else XB_SPIN(xb_ld(&bar[XB_TOPGEN]) == tg, bar);
            __builtin_amdgcn_fence(__ATOMIC_ACQUIRE, "agent");
            xb_add(&bar[XB_XGEN(b.x)], 1u);
            asm volatile("s_waitcnt vmcnt(0)" ::: "memory");
        } else {
            XB_SPIN(xb_ld(&bar[XB_XGEN(b.x)]) == gen, bar);
            __builtin_amdgcn_fence(__ATOMIC_ACQUIRE, "agent");
            asm volatile("s_waitcnt vmcnt(0)" ::: "memory");
        }
    }
    __syncthreads();
}

typedef unsigned short bf16;
typedef unsigned v4u __attribute__((ext_vector_type(4)));
typedef unsigned v2u __attribute__((ext_vector_type(2)));
typedef float f32x4 __attribute__((ext_vector_type(4)));
typedef float f32x16 __attribute__((ext_vector_type(16)));
typedef short bf16x8 __attribute__((ext_vector_type(8)));
#define LDS_WAIT() asm volatile("s_waitcnt lgkmcnt(0)" ::: "memory")
#define VM_WAIT() asm volatile("s_waitcnt vmcnt(0)" ::: "memory")

constexpr int NWAVES = 8, NTHREADS = 512;
constexpr int BATCH = 2, SEQ = 8192, M = BATCH * SEQ, D = 2048, DEPTH = 4;
constexpr int IN_COLS = 4160, IN_PAD = 4352;
constexpr int C_DAQ = 0, C_DAK = 768, C_DAV = 1536, C_QA = 2304, C_KVA = 2816, C_KR = 3072, C_SGU = 3136, C_SGV = 3648;
constexpr int DFF = 5632, NUP = 2 * DFF;
constexpr int UQ_N = 1152, UQ_PAD = 1536, UKV_N = 1536, QRANK = 512, KVRANK = 256;
constexpr int NH = 6;
constexpr float EPS = 1e-6f;
constexpr float LOG2E = 1.4426950408889634f;
constexpr float QS_DA = 0.125f * LOG2E;
constexpr float QS_MLA = 0.07216878364870322f * LOG2E;

enum { I_X = 0, I_C, I_POS, I_WADA, I_BADA, I_WIN, I_DAQG, I_DAKG, I_LQ1, I_LK1, I_LQ2, I_LK2, I_DAHG, I_QAG, I_WUQ, I_KVAG, I_WUKV, I_MQG, I_MKG, I_SGVG, I_SGW, I_SGB, I_WOUT, I_WUP, I_CONVW, I_CONVB, I_WDOWN, N_IN };

constexpr size_t MiB = 1u << 20;
constexpr size_t WS_CTL = 0, CTL_ZERO_BYTES = 1 * MiB;
constexpr size_t WS_MOD = 1 * MiB;
constexpr size_t WS_POSMM = 1 * MiB + 512 * 1024;
constexpr size_t WS_MODP = 2 * MiB;
constexpr size_t WS_W = 8 * MiB;
constexpr size_t WL_IN = 0, WL_UQ = 17 * MiB, WL_UKV = WL_UQ + 1572864, WL_OUT = 20 * MiB, WL_UP = 28 * MiB, WL_DOWN = 72 * MiB, WL_STRIDE = 94 * MiB;
constexpr size_t WS_H = 384 * MiB;
constexpr size_t WS_MIX = 448 * MiB;
constexpr size_t WS_U = 512 * MiB;
constexpr size_t WS_R = 688 * MiB;
constexpr size_t WS_KR = WS_R;
constexpr size_t WS_SSQ_QA = WS_R + 4 * MiB, WS_SSQ_KVA = WS_R + 5 * MiB, WS_SSQ_SGV = WS_R + 6 * MiB, WS_SSQ_KR = WS_R + 7 * MiB;
constexpr size_t WS_QD = WS_R + 272 * MiB, WS_KD = WS_R + 296 * MiB, WS_VD = WS_R + 320 * MiB;
constexpr size_t WS_QM = WS_R + 344 * MiB, WS_KM = WS_R + 380 * MiB, WS_VM = WS_R + 416 * MiB;
constexpr size_t WS_QA = WS_R + 440 * MiB, WS_KVA = WS_R + 456 * MiB;
constexpr size_t WS_MLQ = WS_R + 464 * MiB, WS_MLKV = WS_R + 544 * MiB;
constexpr size_t WS_XB = WS_R + 464 * MiB;
constexpr size_t WS_UU = WS_R + 640 * MiB, WS_GV = WS_R + 672 * MiB;
constexpr size_t WS_EDGE = WS_R;
constexpr size_t WS_A = WS_R;
constexpr size_t WS_O1 = WS_R + 704 * MiB;
constexpr size_t WS_COS = WS_R + 752 * MiB, WS_SIN = WS_R + 754 * MiB;
constexpr size_t WS_END = WS_R + 756 * MiB;

constexpr int RING_BYTES = 131072;
constexpr int LDSCTL_OFF = RING_BYTES;
constexpr int LDS_BYTES = 147456;

__device__ const float ROPE_INV[32] = {1.000000000e+00f, 7.498942614e-01f, 5.623413324e-01f, 4.216965139e-01f, 3.162277639e-01f, 2.371373773e-01f, 1.778279394e-01f, 1.333521307e-01f, 1.000000015e-01f, 7.498941571e-02f, 5.623413250e-02f, 4.216965288e-02f, 3.162277490e-02f, 2.371373773e-02f, 1.778279431e-02f, 1.333521493e-02f, 9.999999776e-03f, 7.498941850e-03f, 5.623413250e-03f, 4.216964822e-03f, 3.162277630e-03f, 2.371373586e-03f, 1.778279431e-03f, 1.333521446e-03f, 1.000000047e-03f, 7.498942432e-04f, 5.623413017e-04f, 4.216965172e-04f, 3.162277571e-04f, 2.371373703e-04f, 1.778279402e-04f, 1.333521504e-04f};
__device__ const float ALIBI_SLOPE[6] = {0.3968502629920499f, 0.15749013123685915f, 0.0625f, 0.024803141437003122f, 0.0098431332023036951f, 0.00390625f};
__device__ const float LAM_INIT[4] = {0.20000000000000007f, 0.35550906759096934f, 0.4707130183435842f, 0.5560582041556406f};

struct Args { const void* in[N_IN]; float* out; unsigned char* ws; int ph; int l; };

__device__ __forceinline__ unsigned f2bf(float f) { unsigned u = __builtin_bit_cast(unsigned, f); return (u + 0x7fffu + ((u >> 16) & 1u)) >> 16; }
__device__ __forceinline__ unsigned pk2(float lo, float hi) { return f2bf(lo) | (f2bf(hi) << 16); }
__device__ __forceinline__ float bf2f(unsigned short h) { return __builtin_bit_cast(float, (unsigned)h << 16); }
template <int CTRL> __device__ __forceinline__ float dpp_mov(float v) { return __builtin_bit_cast(float, __builtin_amdgcn_update_dpp(0, __builtin_bit_cast(int, v), CTRL, 0xF, 0xF, true)); }
__device__ __forceinline__ float sum16(float v) { v += dpp_mov<0xB1>(v); v += dpp_mov<0x4E>(v); v += dpp_mov<0x141>(v); v += dpp_mov<0x140>(v); return v; }
__device__ __forceinline__ float sum32(float v) { v = sum16(v); auto r = __builtin_amdgcn_permlane16_swap(__float_as_uint(v), __float_as_uint(v), false, false); return __uint_as_float(r[0]) + __uint_as_float(r[1]); }
__device__ __forceinline__ float wave_sum(float v) { v = sum32(v); auto r = __builtin_amdgcn_permlane32_swap(__float_as_uint(v), __float_as_uint(v), false, false); return __uint_as_float(r[0]) + __uint_as_float(r[1]); }
__device__ __forceinline__ float wave_max(float v) { v = fmaxf(v, dpp_mov<0xB1>(v)); v = fmaxf(v, dpp_mov<0x4E>(v)); v = fmaxf(v, dpp_mov<0x141>(v)); v = fmaxf(v, dpp_mov<0x140>(v));
    { auto r = __builtin_amdgcn_permlane16_swap(__float_as_uint(v), __float_as_uint(v), false, false); v = fmaxf(__uint_as_float(r[0]), __uint_as_float(r[1])); }
    { auto r = __builtin_amdgcn_permlane32_swap(__float_as_uint(v), __float_as_uint(v), false, false); v = fmaxf(__uint_as_float(r[0]), __uint_as_float(r[1])); } return v; }
__device__ __forceinline__ float xor32(float v, int lane) { auto r = __builtin_amdgcn_permlane32_swap(__float_as_uint(v), __float_as_uint(v), false, false); return lane < 32 ? __uint_as_float(r[1]) : __uint_as_float(r[0]); }
__device__ __forceinline__ float gelu_tanh(float x) {
    const float u = 0.7978845608028654f * (x + 0.044715f * x * x * x);
    const float e = __expf(2.0f * u);
    const float th = 1.0f - 2.0f / (e + 1.0f);
    return 0.5f * x * (1.0f + th);
}
__device__ __forceinline__ float silu_f(float x) { return x / (1.0f + __expf(-x)); }
__device__ __forceinline__ int crow(int r, int hi) { return (r & 3) + 8 * (r >> 2) + 4 * hi; }

namespace pg8 {
struct EpiF32 {
    static constexpr bool PERM = false, AFTER_DRAIN = false;
    float* C; int ldc;
    __device__ __forceinline__ void operator()(const f32x4 (&acc)[2][2][4][2], const Unit& u, int wr, int wc, int fr, int fq) const {
        const int row0 = u.pm * BM + wr * 64 + fr, col0 = u.pn * BM + wc * 32 + 4 * fq;
#pragma unroll
        for (int ai = 0; ai < 2; ++ai)
#pragma unroll
            for (int m = 0; m < 4; ++m) { float* rowp = C + (size_t)(row0 + ai * HALF + m * 16) * ldc + col0;
#pragma unroll
                for (int bj = 0; bj < 2; ++bj)
#pragma unroll
                    for (int n = 0; n < 2; ++n) *(f32x4*)(rowp + bj * HALF + n * 16) = acc[ai][bj][m][n]; }
    }
};
struct EpiNull {
    static constexpr bool PERM = true, AFTER_DRAIN = false;
    float* C;
    __device__ __forceinline__ void operator()(const f32x4 (&acc)[2][2][4][2], const Unit& u, int wr, int wc, int fr, int fq) const {
        f32x4 s = {0.f, 0.f, 0.f, 0.f};
#pragma unroll
        for (int ai = 0; ai < 2; ++ai)
#pragma unroll
            for (int bj = 0; bj < 2; ++bj)
#pragma unroll
                for (int m = 0; m < 4; ++m)
#pragma unroll
                    for (int n = 0; n < 2; ++n) s += acc[ai][bj][m][n];
        C[(size_t)(u.pm * 44 + u.pn) * 512 + (wr * 4 + wc) * 64 + fq * 16 + fr] = (s[0] + s[1]) + (s[2] + s[3]);
    }
};
struct EpiResid {
    static constexpr bool PERM = false, AFTER_DRAIN = false;
    const float* xin; float* out; int ldc; const float* gate; int gate_stride;
    __device__ __forceinline__ void operator()(const f32x4 (&acc)[2][2][4][2], const Unit& u, int wr, int wc, int fr, int fq) const {
        const int row0 = u.pm * BM + wr * 64 + fr, col0 = u.pn * BM + wc * 32 + 4 * fq;
        const float* gp = gate + (size_t)((u.pm * BM) / SEQ) * gate_stride + col0;
        f32x4 gv[2][2];
#pragma unroll
        for (int bj = 0; bj < 2; ++bj)
#pragma unroll
            for (int n = 0; n < 2; ++n) gv[bj][n] = *(const f32x4*)(gp + bj * HALF + n * 16);
#pragma unroll
        for (int ai = 0; ai < 2; ++ai) {
            f32x4 xv[4][2][2];
#pragma unroll
            for (int m = 0; m < 4; ++m) { const size_t off = (size_t)(row0 + ai * HALF + m * 16) * ldc + col0;
#pragma unroll
                for (int bj = 0; bj < 2; ++bj)
#pragma unroll
                    for (int n = 0; n < 2; ++n) xv[m][bj][n] = *(const f32x4*)(xin + off + bj * HALF + n * 16); }
#pragma unroll
            for (int m = 0; m < 4; ++m) { const size_t off = (size_t)(row0 + ai * HALF + m * 16) * ldc + col0;
#pragma unroll
                for (int bj = 0; bj < 2; ++bj)
#pragma unroll
                    for (int n = 0; n < 2; ++n) *(f32x4*)(out + off + bj * HALF + n * 16) = xv[m][bj][n] + gv[bj][n] * acc[ai][bj][m][n]; }
        }
    }
};
struct EpiResidP {
    static constexpr bool PERM = true, AFTER_DRAIN = false;
    const void* xin; void* out; int inb, outb; const float* gate; int gate_stride;
    __device__ __forceinline__ void put(unsigned eo, const f32x4 r0, const f32x4 r1) const {
        if (outb) *(u32x4*)((char*)out + eo * 2u) = (u32x4){pkh2(r0[0], r0[1]), pkh2(r0[2], r0[3]), pkh2(r1[0], r1[1]), pkh2(r1[2], r1[3])};
        else { *(f32x4*)((char*)out + eo * 4u) = r0; *(f32x4*)((char*)out + eo * 4u + 16u) = r1; } }
    __device__ __forceinline__ void operator()(const f32x4 (&acc)[2][2][4][2], const Unit& u, int wr, int wc, int fr_, int fq_) const {
        int fr = fr_, fq = fq_; asm volatile("" : "+v"(fr), "+v"(fq));
        const int row0 = u.pm * BM + wr * 64 + fr, col0 = u.pn * BM + wc * 32 + 8 * fq;
        const unsigned lo = (unsigned)(row0 * 2048 + col0);
        const float* gp = gate + (size_t)((u.pm * BM) / SEQ) * gate_stride + col0;
        f32x4 gv[2][2];
#pragma unroll
        for (int bj = 0; bj < 2; ++bj)
#pragma unroll
            for (int n = 0; n < 2; ++n) gv[bj][n] = *(const f32x4*)(gp + bj * HALF + 4 * n);
        if (inb) {
            u32x4 xb[2][4][2];
#pragma unroll
            for (int ai = 0; ai < 2; ++ai)
#pragma unroll
                for (int m = 0; m < 4; ++m)
#pragma unroll
                    for (int bj = 0; bj < 2; ++bj) xb[ai][m][bj] = *(const u32x4*)((const char*)xin + (lo + (unsigned)((ai * HALF + m * 16) * 2048 + bj * HALF)) * 2u);
#pragma unroll
            for (int ai = 0; ai < 2; ++ai)
#pragma unroll
                for (int m = 0; m < 4; ++m)
#pragma unroll
                    for (int bj = 0; bj < 2; ++bj) { const u32x4 w = xb[ai][m][bj];
                        const f32x4 x0 = {uph_lo(w.x), uph_hi(w.x), uph_lo(w.y), uph_hi(w.y)};
                        const f32x4 x1 = {uph_lo(w.z), uph_hi(w.z), uph_lo(w.w), uph_hi(w.w)};
                        put(lo + (unsigned)((ai * HALF + m * 16) * 2048 + bj * HALF), x0 + gv[bj][0] * acc[ai][bj][m][0], x1 + gv[bj][1] * acc[ai][bj][m][1]); }
        } else {
#pragma unroll
            for (int ai = 0; ai < 2; ++ai) {
                f32x4 xv[4][2][2];
#pragma unroll
                for (int m = 0; m < 4; ++m)
#pragma unroll
                    for (int bj = 0; bj < 2; ++bj)
#pragma unroll
                        for (int n = 0; n < 2; ++n) xv[m][bj][n] = *(const f32x4*)((const char*)xin + (lo + (unsigned)((ai * HALF + m * 16) * 2048 + bj * HALF + 4 * n)) * 4u);
#pragma unroll
                for (int m = 0; m < 4; ++m)
#pragma unroll
                    for (int bj = 0; bj < 2; ++bj) put(lo + (unsigned)((ai * HALF + m * 16) * 2048 + bj * HALF), xv[m][bj][0] + gv[bj][0] * acc[ai][bj][m][0], xv[m][bj][1] + gv[bj][1] * acc[ai][bj][m][1]);
            }
        }
    }
};
struct EpiBf16S {
    static constexpr bool PERM = true, AFTER_DRAIN = false;
    bf16_t* O; int ldc;
    __device__ __forceinline__ void operator()(const f32x4 (&acc)[2][2][4][2], const Unit& u, int wr, int wc, int fr, int fq) const {
        const int row0 = u.pm * BM + wr * 64 + fr, col0 = u.pn * BM + wc * 32 + 8 * fq;
#pragma unroll
        for (int ai = 0; ai < 2; ++ai)
#pragma unroll
            for (int m = 0; m < 4; ++m) { bf16_t* rowp = O + (size_t)(row0 + ai * HALF + m * 16) * ldc + col0;
#pragma unroll
                for (int bj = 0; bj < 2; ++bj) { const f32x4 v0 = acc[ai][bj][m][0], v1 = acc[ai][bj][m][1]; u32x4 w;
                    w.x = cvt_pk_bf16(v0[0], v0[1]); w.y = cvt_pk_bf16(v0[2], v0[3]); w.z = cvt_pk_bf16(v1[0], v1[1]); w.w = cvt_pk_bf16(v1[2], v1[3]);
                    *(u32x4*)(rowp + bj * HALF) = w; } }
    }
};
template <int CTRL> __device__ __forceinline__ float dppf(float old, float src) { return __builtin_bit_cast(float, __builtin_amdgcn_update_dpp(__builtin_bit_cast(int, old), __builtin_bit_cast(int, src), CTRL, 0xF, 0xF, false)); }
struct EpiConvGate {
    static constexpr bool PERM = true, AFTER_DRAIN = false;
    bf16_t* U; float* EDGE; const float* cw; const float* cb;
    __device__ __forceinline__ void operator()(const f32x4 (&acc)[2][2][4][2], const Unit& u, int wr, int wc, int fr, int fq) const {
        const int ch0 = u.pn * 128 + wc * 32 + 8 * fq, rowb = u.pm * BM + wr * 64;
#pragma unroll
        for (int ai = 0; ai < 2; ++ai) { const int blk = (rowb + ai * HALF) >> 6;
            if (fr < 2) { float* e = EDGE + ((size_t)(blk * 4 + fr) * 2) * DFF + ch0;
#pragma unroll
                for (int bj = 0; bj < 2; ++bj) { *(f32x4*)(e + bj * DFF) = acc[ai][bj][0][0]; *(f32x4*)(e + bj * DFF + 4) = acc[ai][bj][0][1]; } }
            if (fr >= 14) { float* e = EDGE + ((size_t)(blk * 4 + fr - 12) * 2) * DFF + ch0;
#pragma unroll
                for (int bj = 0; bj < 2; ++bj) { *(f32x4*)(e + bj * DFF) = acc[ai][bj][3][0]; *(f32x4*)(e + bj * DFF + 4) = acc[ai][bj][3][1]; } }
        }
        f32x4 w[2][2][3], bb[2][2];
#pragma unroll
        for (int n = 0; n < 2; ++n)
#pragma unroll
            for (int bj = 0; bj < 2; ++bj) { bb[n][bj] = *(const f32x4*)(cb + bj * DFF + ch0 + 4 * n);
#pragma unroll
                for (int j = 0; j < 3; ++j) w[n][bj][j] = *(const f32x4*)(cw + (size_t)j * (2 * DFF) + bj * DFF + ch0 + 4 * n); }
#pragma unroll
        for (int ai = 0; ai < 2; ++ai)
#pragma unroll
            for (int m = 0; m < 4; ++m) {
                unsigned pkw[4];
#pragma unroll
                for (int n = 0; n < 2; ++n) {
                    f32x4 y[2];
#pragma unroll
                    for (int bj = 0; bj < 2; ++bj) { const f32x4 cur = acc[ai][bj][m][n]; const f32x4 prv = m > 0 ? acc[ai][bj][m - 1][n] : (f32x4){0.f, 0.f, 0.f, 0.f};
                        f32x4 s1, s2;
#pragma unroll
                        for (int e = 0; e < 4; ++e) {
                            if (m > 0) { s1[e] = dppf<0x111>(dpp_mov<0x121>(prv[e]), cur[e]); s2[e] = dppf<0x112>(dpp_mov<0x122>(prv[e]), cur[e]); }
                            else { s1[e] = dpp_mov<0x111>(cur[e]); s2[e] = dpp_mov<0x112>(cur[e]); } }
                        y[bj] = bb[n][bj] + w[n][bj][2] * cur + w[n][bj][1] * s1 + w[n][bj][0] * s2; }
                    const f32x4 tg = y[0] * -1.4426950408889634f;
                    f32x4 ev; ev[0] = __builtin_amdgcn_exp2f(tg[0]); ev[1] = __builtin_amdgcn_exp2f(tg[1]); ev[2] = __builtin_amdgcn_exp2f(tg[2]); ev[3] = __builtin_amdgcn_exp2f(tg[3]);
                    const f32x4 dn = ev + 1.0f;
                    f32x4 rc; rc[0] = __builtin_amdgcn_rcpf(dn[0]); rc[1] = __builtin_amdgcn_rcpf(dn[1]); rc[2] = __builtin_amdgcn_rcpf(dn[2]); rc[3] = __builtin_amdgcn_rcpf(dn[3]);
                    const f32x4 o = (y[0] * rc) * y[1];
                    pkw[2 * n] = cvt_pk_bf16(o[0], o[1]); pkw[2 * n + 1] = cvt_pk_bf16(o[2], o[3]);
                }
                u32x4 pk; pk.x = pkw[0]; pk.y = pkw[1]; pk.z = pkw[2]; pk.w = pkw[3];
                *(u32x4*)(U + (size_t)(rowb + ai * HALF + m * 16 + fr) * DFF + ch0) = pk;
            }
    }
};
__device__ __forceinline__ float lane_xor16_sum(float v) { auto r = __builtin_amdgcn_permlane16_swap(__float_as_uint(v), __float_as_uint(v), false, false); return __uint_as_float(r[0]) + __uint_as_float(r[1]); }
__device__ __forceinline__ float lane_xor32_sum(float v) { auto r = __builtin_amdgcn_permlane32_swap(__float_as_uint(v), __float_as_uint(v), false, false); return __uint_as_float(r[0]) + __uint_as_float(r[1]); }
__device__ __forceinline__ float sq4(f32x4 v) { return (v[0] * v[0] + v[1] * v[1]) + (v[2] * v[2] + v[3] * v[3]); }
__device__ __forceinline__ u32x4 pk8(f32x4 a, f32x4 b) { u32x4 w; w.x = cvt_pk_bf16(a[0], a[1]); w.y = cvt_pk_bf16(a[2], a[3]); w.z = cvt_pk_bf16(b[0], b[1]); w.w = cvt_pk_bf16(b[2], b[3]); return w; }
__device__ __forceinline__ float gelu_t(float x) { const float u = 0.7978845608028654f * (x + 0.044715f * x * x * x); const float e = __expf(2.0f * u); return 0.5f * x * (2.0f - 2.0f * __builtin_amdgcn_rcpf(e + 1.0f)); }
__device__ __forceinline__ f32x4 gelu4(f32x4 v) { return (f32x4){gelu_t(v[0]), gelu_t(v[1]), gelu_t(v[2]), gelu_t(v[3])}; }
struct EpiInProj {
    static constexpr bool PERM = true, AFTER_DRAIN = false;
    bf16_t *QD, *KD, *VD, *QA, *KVA, *GV; float *UU, *KR, *SSQ_QA, *SSQ_KVA, *SSQ_SGV, *SSQ_KR;
    const float *qg, *kg, *qag, *kvag, *sgvg;
    __device__ __forceinline__ void operator()(const f32x4 (&acc)[2][2][4][2], const Unit& u, int wr, int wc, int fr, int fq) const {
        const int pn = u.pn, rowb = u.pm * BM + wr * 64 + fr, b = (u.pm * BM) / SEQ, c8 = wc * 32 + 8 * fq;
        if (pn < 6) {
            const bool isk = pn >= 3; const int G = 4 * (isk ? pn - 3 : pn) + wc;
            const float* gp = isk ? kg : qg;
            const f32x4 g00 = *(const f32x4*)(gp + 8 * fq), g01 = *(const f32x4*)(gp + 8 * fq + 4), g10 = *(const f32x4*)(gp + 32 + 8 * fq), g11 = *(const f32x4*)(gp + 32 + 8 * fq + 4);
            bf16_t* dst = (isk ? KD : QD) + ((size_t)(b * 12 + G) * SEQ) * 64 + 8 * fq;
            const float post = isk ? 1.0f : QS_DA;
#pragma unroll
            for (int ai = 0; ai < 2; ++ai)
#pragma unroll
                for (int m = 0; m < 4; ++m) { const f32x4 v00 = acc[ai][0][m][0], v01 = acc[ai][0][m][1], v10 = acc[ai][1][m][0], v11 = acc[ai][1][m][1];
                    float ss = (sq4(v00) + sq4(v01)) + (sq4(v10) + sq4(v11)); ss = lane_xor16_sum(ss); ss = lane_xor32_sum(ss);
                    const float r = rsqrtf(ss * (1.f / 64) + EPS) * post;
                    bf16_t* d = dst + (size_t)((rowb + ai * HALF + m * 16) & (SEQ - 1)) * 64;
                    *(u32x4*)d = pk8(v00 * g00 * r, v01 * g01 * r); *(u32x4*)(d + 32) = pk8(v10 * g10 * r, v11 * g11 * r); }
        } else if (pn < 9) {
#pragma unroll
            for (int bj = 0; bj < 2; ++bj) { bf16_t* dst = VD + ((size_t)(b * NH + 2 * (pn - 6) + bj) * SEQ) * 128 + c8;
#pragma unroll
                for (int ai = 0; ai < 2; ++ai)
#pragma unroll
                    for (int m = 0; m < 4; ++m) *(u32x4*)(dst + (size_t)((rowb + ai * HALF + m * 16) & (SEQ - 1)) * 128) = pk8(acc[ai][bj][m][0], acc[ai][bj][m][1]); }
        } else if (pn < 12) {
            const bool iskv = pn == 11; const int ct = iskv ? 0 : 256 * (pn - 9);
            const float* gp = (iskv ? kvag : qag) + ct + c8;
            const f32x4 g00 = *(const f32x4*)gp, g01 = *(const f32x4*)(gp + 4), g10 = *(const f32x4*)(gp + HALF), g11 = *(const f32x4*)(gp + HALF + 4);
            bf16_t* dst = (iskv ? KVA : QA) + ct + c8; const int ld = iskv ? KVRANK : QRANK;
            float* sq = iskv ? SSQ_KVA + wc : SSQ_QA + (pn - 9) * 4 + wc; const int sld = iskv ? 4 : 8;
#pragma unroll
            for (int ai = 0; ai < 2; ++ai)
#pragma unroll
                for (int m = 0; m < 4; ++m) { const int row = rowb + ai * HALF + m * 16;
                    const f32x4 v00 = acc[ai][0][m][0], v01 = acc[ai][0][m][1], v10 = acc[ai][1][m][0], v11 = acc[ai][1][m][1];
                    float ss = (sq4(v00) + sq4(v01)) + (sq4(v10) + sq4(v11)); ss = lane_xor16_sum(ss); ss = lane_xor32_sum(ss);
                    if (fq == 0) sq[(size_t)row * sld] = ss;
                    *(u32x4*)(dst + (size_t)row * ld) = pk8(v00 * g00, v01 * g01); *(u32x4*)(dst + (size_t)row * ld + HALF) = pk8(v10 * g10, v11 * g11); }
        } else if (pn < 14) {
            float* dst = UU + 256 * (pn - 12) + c8;
#pragma unroll
            for (int ai = 0; ai < 2; ++ai)
#pragma unroll
                for (int m = 0; m < 4; ++m) { float* d = dst + (size_t)(rowb + ai * HALF + m * 16) * 512;
#pragma unroll
                    for (int bj = 0; bj < 2; ++bj) { *(f32x4*)(d + bj * HALF) = gelu4(acc[ai][bj][m][0]); *(f32x4*)(d + bj * HALF + 4) = gelu4(acc[ai][bj][m][1]); } }
        } else if (pn < 16) {
            const int g0 = 2 * (pn - 14);
#pragma unroll
            for (int bj = 0; bj < 2; ++bj) { const float* gp = sgvg + (g0 + bj) * 128 + c8; const f32x4 ga = *(const f32x4*)gp, gb = *(const f32x4*)(gp + 4);
                bf16_t* dst = GV + (g0 + bj) * 128 + c8; float* sq = SSQ_SGV + (g0 + bj) * 4 + wc;
#pragma unroll
                for (int ai = 0; ai < 2; ++ai)
#pragma unroll
                    for (int m = 0; m < 4; ++m) { const int row = rowb + ai * HALF + m * 16; const f32x4 a = gelu4(acc[ai][bj][m][0]), c = gelu4(acc[ai][bj][m][1]);
                        float ss = sq4(a) + sq4(c); ss = lane_xor16_sum(ss); ss = lane_xor32_sum(ss);
                        if (fq == 0) sq[(size_t)row * 16] = ss;
                        *(u32x4*)(dst + (size_t)row * 512) = pk8(a * ga, c * gb); } }
        } else {
            if (wc < 2) {
#pragma unroll
                for (int ai = 0; ai < 2; ++ai)
#pragma unroll
                    for (int m = 0; m < 4; ++m) { const int row = rowb + ai * HALF + m * 16; float* d = KR + (size_t)row * 64 + c8; *(f32x4*)d = acc[ai][0][m][0]; *(f32x4*)(d + 4) = acc[ai][0][m][1];
                        float ss = sq4(acc[ai][0][m][0]) + sq4(acc[ai][0][m][1]); ss = lane_xor16_sum(ss); ss = lane_xor32_sum(ss); if (fq == 0) SSQ_KR[(size_t)row * 2 + wc] = ss; } }
        }
    }
};
struct EpiMlaQ {
    static constexpr bool PERM = true, AFTER_DRAIN = false;
    bf16_t* QM; const float *SSQ_QA, *COS, *SIN, *qg; PG8_LAS float* X;
    __device__ __forceinline__ void operator()(const f32x4 (&acc)[2][2][4][2], const Unit& u, int wr, int wc, int fr_, int fq_) const {
        float eps_ = EPS, k192 = 1.f / 192; asm volatile("" : "+s"(eps_), "+s"(k192));
        int fr = fr_, fq = fq_; asm volatile("" : "+v"(fr), "+v"(fq));
        const int h = u.pn, rowb = u.pm * BM + wr * 64 + fr, b = (u.pm * BM) / SEQ, c8 = wc * 32 + 8 * fq, rt = wr * 64 + fr;
#pragma unroll
        for (int ai = 0; ai < 2; ++ai)
#pragma unroll
            for (int m = 0; m < 4; ++m) { float ss = (sq4(acc[ai][0][m][0]) + sq4(acc[ai][0][m][1])) + (sq4(acc[ai][1][m][0]) + sq4(acc[ai][1][m][1])); ss = lane_xor16_sum(ss); ss = lane_xor32_sum(ss);
                if (fq == 0) X[(ai * HALF + m * 16 + rt) * 4 + wc] = ss; }
        asm volatile("s_waitcnt lgkmcnt(0)" ::: "memory"); __builtin_amdgcn_s_barrier(); asm volatile("" ::: "memory");
        const f32x4 g0a = *(const f32x4*)(qg + c8), g0b = *(const f32x4*)(qg + c8 + 4);
        const int i0 = 16 * wc + 4 * fq;
        f32x4 g1 = {0.f, 0.f, 0.f, 0.f}, g2 = g1; if (wc < 2) { g1 = *(const f32x4*)(qg + 128 + i0); g2 = *(const f32x4*)(qg + 160 + i0); }
        bf16_t* dst = QM + ((size_t)(b * NH + h) * SEQ) * 192;
#pragma unroll
        for (int ai = 0; ai < 2; ++ai)
#pragma unroll
        for (int mh = 0; mh < 4; mh += 2) {
        float rr[2][4]; f32x4 csv[2][4], snv[2][4];
#pragma unroll
            for (int m = mh; m < mh + 2; ++m) { const int row = rowb + ai * HALF + m * 16; const f32x4 xs = *(const PG8_LAS f32x4*)(X + (ai * HALF + m * 16 + rt) * 4);
                const f32x4 pa = *(const f32x4*)(SSQ_QA + (size_t)row * 8), pb = *(const f32x4*)(SSQ_QA + (size_t)row * 8 + 4);
                const float msq = (((pa[0] + pa[1]) + (pa[2] + pa[3])) + ((pb[0] + pb[1]) + (pb[2] + pb[3]))) * (1.f / 512) + eps_;
                rr[ai][m] = rsqrtf(((xs[0] + xs[1]) + (xs[2] + xs[3])) * k192 + eps_ * msq) * QS_MLA;
                if (wc < 2) { csv[ai][m] = *(const f32x4*)(COS + (size_t)row * 32 + i0); snv[ai][m] = *(const f32x4*)(SIN + (size_t)row * 32 + i0); } }
#pragma unroll
            for (int m = mh; m < mh + 2; ++m) { const int row = rowb + ai * HALF + m * 16; const float r = rr[ai][m];
                bf16_t* d = dst + (size_t)(row & (SEQ - 1)) * 192;
                *(u32x4*)(d + c8) = pk8(acc[ai][0][m][0] * g0a * r, acc[ai][0][m][1] * g0b * r);
                if (wc < 2) { const f32x4 cs = csv[ai][m], sn = snv[ai][m];
                    const f32x4 va = acc[ai][1][m][0], vb = acc[ai][1][m][1];
                    const f32x4 y1 = (f32x4){va[0], va[2], vb[0], vb[2]} * g1 * r, y2 = (f32x4){va[1], va[3], vb[1], vb[3]} * g2 * r;
                    const f32x4 o1 = y1 * cs - y2 * sn, o2 = y2 * cs + y1 * sn;
                    *(u32x4*)(d + 128 + c8) = pk8((f32x4){o1[0], o2[0], o1[1], o2[1]}, (f32x4){o1[2], o2[2], o1[3], o2[3]}); } }
        }
        asm volatile("s_waitcnt lgkmcnt(0)" ::: "memory"); __builtin_amdgcn_s_barrier(); asm volatile("" ::: "memory");
    }
};
struct EpiMlaKV {
    static constexpr bool PERM = true, AFTER_DRAIN = false;
    bf16_t *KM, *VM; const float *SSQ_KVA, *SSQ_KR, *KR, *COS, *SIN, *kg; PG8_LAS float* X;
    __device__ __forceinline__ void operator()(const f32x4 (&acc)[2][2][4][2], const Unit& u, int wr, int wc, int fr_, int fq_) const {
        float eps_ = EPS, k192 = 1.f / 192; asm volatile("" : "+s"(eps_), "+s"(k192));
        int fr = fr_, fq = fq_; asm volatile("" : "+v"(fr), "+v"(fq));
        const int h = u.pn, rowb = u.pm * BM + wr * 64 + fr, b = (u.pm * BM) / SEQ, c8 = wc * 32 + 8 * fq, rt = wr * 64 + fr;
#pragma unroll
        for (int ai = 0; ai < 2; ++ai)
#pragma unroll
            for (int m = 0; m < 4; ++m) { float ss = sq4(acc[ai][0][m][0]) + sq4(acc[ai][0][m][1]); ss = lane_xor16_sum(ss); ss = lane_xor32_sum(ss);
                if (fq == 0) X[(ai * HALF + m * 16 + rt) * 4 + wc] = ss; }
        asm volatile("s_waitcnt lgkmcnt(0)" ::: "memory"); __builtin_amdgcn_s_barrier(); asm volatile("" ::: "memory");
        const f32x4 g0a = *(const f32x4*)(kg + c8), g0b = *(const f32x4*)(kg + c8 + 4);
        const int i0 = 8 * wc + 2 * fq;
        const float g1a = kg[128 + i0], g1b = kg[128 + i0 + 1], g2a = kg[160 + i0], g2b = kg[160 + i0 + 1];
        bf16_t* kd = KM + ((size_t)(b * NH + h) * SEQ) * 192; bf16_t* vd = VM + ((size_t)(b * NH + h) * SEQ) * 128;
#pragma unroll
        for (int ai = 0; ai < 2; ++ai) {
        float rr[2][4], cv[2][4]; float2 k1v[2][4], k2v[2][4], cpv[2][4], spv[2][4];
#pragma unroll
            for (int m = 0; m < 4; ++m) { const int row = rowb + ai * HALF + m * 16; const f32x4 xs = *(const PG8_LAS f32x4*)(X + (ai * HALF + m * 16 + rt) * 4);
                const f32x4 pc = *(const f32x4*)(SSQ_KVA + (size_t)row * 4);
                const float c2 = 1.0f / (((pc[0] + pc[1]) + (pc[2] + pc[3])) * (1.f / 256) + eps_);
                const float2 sk = *(const float2*)(SSQ_KR + (size_t)row * 2);
                cv[ai][m] = sqrtf(c2); rr[ai][m] = rsqrtf((c2 * ((xs[0] + xs[1]) + (xs[2] + xs[3])) + (sk.x + sk.y)) * k192 + eps_);
                const float* kr = KR + (size_t)row * 64 + i0;
                k1v[ai][m] = *(const float2*)kr; k2v[ai][m] = *(const float2*)(kr + 32); cpv[ai][m] = *(const float2*)(COS + (size_t)row * 32 + i0); spv[ai][m] = *(const float2*)(SIN + (size_t)row * 32 + i0); }
#pragma unroll
            for (int m = 0; m < 4; ++m) { const int row = rowb + ai * HALF + m * 16; const float r = rr[ai][m], ckv = cv[ai][m];
                const int srow = row & (SEQ - 1);
                *(u32x4*)(kd + (size_t)srow * 192 + c8) = pk8(acc[ai][0][m][0] * g0a * (ckv * r), acc[ai][0][m][1] * g0b * (ckv * r));
                *(u32x4*)(vd + (size_t)srow * 128 + c8) = pk8(acc[ai][1][m][0] * ckv, acc[ai][1][m][1] * ckv);
                const float2 cp = cpv[ai][m], sp = spv[ai][m];
                const float y1a = k1v[ai][m].x * r * g1a, y1b = k1v[ai][m].y * r * g1b, y2a = k2v[ai][m].x * r * g2a, y2b = k2v[ai][m].y * r * g2b;
                const float oa1 = y1a * cp.x - y2a * sp.x, oa2 = y2a * cp.x + y1a * sp.x, ob1 = y1b * cp.y - y2b * sp.y, ob2 = y2b * cp.y + y1b * sp.y;
                *(unsigned long long*)(kd + (size_t)srow * 192 + 128 + 2 * i0) = (unsigned long long)cvt_pk_bf16(oa1, oa2) | ((unsigned long long)cvt_pk_bf16(ob1, ob2) << 32); }
        }
        asm volatile("s_waitcnt lgkmcnt(0)" ::: "memory"); __builtin_amdgcn_s_barrier(); asm volatile("" ::: "memory");
    }
};
}

struct Frame {
    LAS unsigned char* lds;
    int tid, lane, wave, wave0, gw, ngw, bid, G;
    const __attribute__((address_space(4))) Args* ka; const int* pos;
    float* out; unsigned char* ws;
};
__device__ __forceinline__ size_t opq(size_t v) { asm volatile("" : "+s"(v)); return v; }
#define WSP(T, off) ((T*)(F.ws + opq(off)))
#define FIN(i) ((const float*)F.ka->in[i])
__device__ __forceinline__ const bf16* wptr(const Frame& F, int l, size_t off) { return (const bf16*)(F.ws + WS_W + (size_t)l * WL_STRIDE + off); }

__device__ __forceinline__ void p0_transpose_item(const float* W, int K, int N, bf16* WT, int row_off, LAS float* scr, int item, int lane, int rstride = 1) {
    const int nblk = N / 32, kb = item / nblk, nb = item % nblk, k0 = 64 * kb, n0 = 32 * nb;
    float wv_[32];
#pragma unroll
    for (int i = 0; i < 32; ++i) { const int kk = 2 * i + (lane >> 5); wv_[i] = W[(size_t)(k0 + kk) * N + n0 + (lane & 31)]; }
#pragma unroll
    for (int i = 0; i < 32; ++i) { const int kk = 2 * i + (lane >> 5); scr[kk * 33 + (lane & 31)] = wv_[i]; }
    LDS_WAIT(); asm volatile("" ::: "memory");
    const int c = lane & 7;
#pragma unroll
    for (int j = 0; j < 4; ++j) { const int n = (lane >> 3) + 8 * j; const LAS float* s = scr + (8 * c) * 33 + n;
        v4u o; o.x = pk2(s[0 * 33], s[1 * 33]); o.y = pk2(s[2 * 33], s[3 * 33]); o.z = pk2(s[4 * 33], s[5 * 33]); o.w = pk2(s[6 * 33], s[7 * 33]);
        *(v4u*)(WT + (size_t)(row_off + n0 + rstride * n) * K + k0 + 8 * c) = o; }
    LDS_WAIT(); asm volatile("" ::: "memory");
}
__device__ __forceinline__ void ph_prologue(Frame& F) {
    LAS float* scr = (LAS float*)(F.lds + F.wave * 16384);
    constexpr int I_IN = (D / 64) * (IN_COLS / 32), I_UQ = (QRANK / 64) * (UQ_N / 32), I_UKV = (KVRANK / 64) * (UKV_N / 32), I_OUT = (D / 64) * (D / 32), I_UP = (D / 64) * (NUP / 32), I_DN = (DFF / 64) * (D / 32);
    constexpr int I_L = I_IN + I_UQ + I_UKV + I_OUT + I_UP + I_DN;
    for (int it = F.gw; it < DEPTH * I_L; it += F.ngw) {
        const int l = it / I_L; int r = it % I_L;
        bf16* wl = (bf16*)(F.ws + WS_W + (size_t)l * WL_STRIDE);
        if (r < I_IN) { const int n0 = 32 * (r % (IN_COLS / 32)); int dst;
            if (n0 < C_DAV) { const int q = n0 % 768, G = q / 64, e = q % 64; dst = (n0 - q) + 256 * (G / 4) + 128 * (e / 32) + 32 * (G % 4) + (e % 32); }
            else if (n0 < C_KR) dst = n0;
            else if (n0 < C_SGU) dst = 4096 + (n0 - C_KR);
            else dst = n0 - 64;
            p0_transpose_item(FIN(I_WIN) + (size_t)l * D * IN_COLS, D, IN_COLS, (bf16*)((unsigned char*)wl + WL_IN), dst - n0, scr, r, F.lane); continue; } r -= I_IN;
        if (r < I_UQ) { const int n0 = 32 * (r % (UQ_N / 32)), hh = n0 / 192, e = n0 % 192;
            const int dst = 256 * hh + (e < 128 ? e : 128 + (e - 128) / 32);
            p0_transpose_item(FIN(I_WUQ) + (size_t)l * QRANK * UQ_N, QRANK, UQ_N, (bf16*)((unsigned char*)wl + WL_UQ), dst - n0, scr, r, F.lane, e < 128 ? 1 : 2); continue; } r -= I_UQ;
        if (r < I_UKV) { p0_transpose_item(FIN(I_WUKV) + (size_t)l * KVRANK * UKV_N, KVRANK, UKV_N, (bf16*)((unsigned char*)wl + WL_UKV), 0, scr, r, F.lane); continue; } r -= I_UKV;
        if (r < I_OUT) { p0_transpose_item(FIN(I_WOUT) + (size_t)l * D * D, D, D, (bf16*)((unsigned char*)wl + WL_OUT), 0, scr, r, F.lane); continue; } r -= I_OUT;
        if (r < I_UP) { const int n0 = 32 * (r % (NUP / 32)), chn = n0 % DFF, dst = 256 * (chn / 128) + 128 * (n0 / DFF) + (chn % 128);
            p0_transpose_item(FIN(I_WUP) + (size_t)l * D * NUP, D, NUP, (bf16*)((unsigned char*)wl + WL_UP), dst - n0, scr, r, F.lane); continue; } r -= I_UP;
        p0_transpose_item(FIN(I_WDOWN) + (size_t)l * DFF * D, DFF, D, (bf16*)((unsigned char*)wl + WL_DOWN), 0, scr, r, F.lane);
    }
    {
        const int gt = F.bid * NTHREADS + F.tid, nt = F.G * NTHREADS;
        constexpr int Z_IN = (IN_PAD - IN_COLS) * D / 8, Z_UQ = NH * 64 * QRANK / 8;
        for (int i = gt; i < DEPTH * (Z_IN + Z_UQ); i += nt) { const int l = i / (Z_IN + Z_UQ); int r = i % (Z_IN + Z_UQ);
            unsigned char* wl = F.ws + WS_W + (size_t)l * WL_STRIDE;
            v4u z = {0u, 0u, 0u, 0u};
            if (r < Z_IN) *(v4u*)(wl + WL_IN + (size_t)IN_COLS * D * 2 + (size_t)r * 16) = z;
            else { r -= Z_IN; const int hh = r / (64 * QRANK / 8), q = r % (64 * QRANK / 8); *(v4u*)(wl + WL_UQ + ((size_t)(256 * hh + 192) * QRANK) * 2 + (size_t)q * 16) = z; } }
    }
    __syncthreads();
    LAS float* cond = (LAS float*)F.lds;
    for (int i = F.tid; i < 2 * D; i += NTHREADS) cond[i] = silu_f(FIN(I_C)[i]);
    __syncthreads();
    {
        const int gt = F.bid * NTHREADS + F.tid, nt = F.G * NTHREADS;
        float* part = WSP(float, WS_MODP);
        for (int it = gt; it < DEPTH * 16 * 3072; it += nt) {
            const int n4 = it % 3072, ks = (it / 3072) % 16, l = it / (3072 * 16);
            const float* w = FIN(I_WADA) + ((size_t)l * D + ks * 128) * (6 * D) + n4 * 4;
            f32x4 a0 = {0.f, 0.f, 0.f, 0.f}, a1 = {0.f, 0.f, 0.f, 0.f};
#pragma unroll 8
            for (int k = 0; k < 128; ++k) { const f32x4 wv = *(const f32x4*)(w + (size_t)k * (6 * D)); a0 += cond[ks * 128 + k] * wv; a1 += cond[D + ks * 128 + k] * wv; }
            *(f32x4*)(part + ((size_t)(l * 16 + ks) * 2 + 0) * (6 * D) + n4 * 4) = a0;
            *(f32x4*)(part + ((size_t)(l * 16 + ks) * 2 + 1) * (6 * D) + n4 * 4) = a1;
        }
    }
    __syncthreads();
}
__device__ __forceinline__ void ph_modreduce(Frame& F) {
    const int gt = F.bid * NTHREADS + F.tid, nt = F.G * NTHREADS;
    const float* part = WSP(float, WS_MODP); float* mod = WSP(float, WS_MOD);
    for (int i = gt; i < DEPTH * 2 * 6 * D; i += nt) { const int n = i % (6 * D), b = (i / (6 * D)) & 1, l = i / (12 * D);
        float s = FIN(I_BADA)[l * 6 * D + n];
#pragma unroll
        for (int ks = 0; ks < 16; ++ks) s += part[((size_t)(l * 16 + ks) * 2 + b) * (6 * D) + n];
        mod[i] = s; }
    { float* ct = WSP(float, WS_COS); float* st = WSP(float, WS_SIN);
      for (int i = gt; i < M * 32; i += nt) { const float ang = (float)F.pos[i >> 5] * ROPE_INV[i & 31];
          const double rev = (double)ang * 0.15915494309189535; const float fr = (float)(rev - floor(rev));
          ct[i] = __builtin_amdgcn_cosf(fr); st[i] = __builtin_amdgcn_sinf(fr); } }
    if (gt < M / 64) { int mn = 0x7fffffff, mx = -0x7fffffff - 1;
        for (int i = 0; i < 64; ++i) { const int p = F.pos[gt * 64 + i]; mn = p < mn ? p : mn; mx = p > mx ? p : mx; }
        int* mm = WSP(int, WS_POSMM); mm[gt * 2] = mn; mm[gt * 2 + 1] = mx; }
}
template <bool XBF> __device__ __forceinline__ void ph_norm(Frame& F, int l, const void* xsrc, int sh_off, int sc_off) {
    const float* mod = WSP(float, WS_MOD) + (size_t)l * 12 * D; bf16* H = WSP(bf16, WS_H);
    for (int row = F.gw; row < M; row += F.ngw) {
        const int b = row >> 13;
        const float* mb = mod + (size_t)b * 6 * D;
        if constexpr (XBF) {
            const v4u* xr = (const v4u*)((const bf16*)xsrc + (size_t)row * D) + F.lane;
            v4u w[4]; float v[4][8]; float s = 0.f;
#pragma unroll
            for (int j = 0; j < 4; ++j) w[j] = xr[64 * j];
#pragma unroll
            for (int j = 0; j < 4; ++j) { const unsigned ww[4] = {w[j].x, w[j].y, w[j].z, w[j].w};
#pragma unroll
                for (int q = 0; q < 4; ++q) { v[j][2 * q] = pg8::uph_lo(ww[q]); v[j][2 * q + 1] = pg8::uph_hi(ww[q]); s += v[j][2 * q] * v[j][2 * q] + v[j][2 * q + 1] * v[j][2 * q + 1]; } }
            const float r = rsqrtf(wave_sum(s) * (1.f / D) + EPS);
            v4u* o16 = (v4u*)(H + (size_t)row * D) + F.lane;
#pragma unroll
            for (int j = 0; j < 4; ++j) { const int c = 8 * F.lane + 512 * j;
                const f32x4 sc0 = *(const f32x4*)(mb + sc_off + c), sc1 = *(const f32x4*)(mb + sc_off + c + 4), sh0 = *(const f32x4*)(mb + sh_off + c), sh1 = *(const f32x4*)(mb + sh_off + c + 4);
                v4u o; o.x = pk2(v[j][0] * r * (1.0f + sc0.x) + sh0.x, v[j][1] * r * (1.0f + sc0.y) + sh0.y); o.y = pk2(v[j][2] * r * (1.0f + sc0.z) + sh0.z, v[j][3] * r * (1.0f + sc0.w) + sh0.w);
                o.z = pk2(v[j][4] * r * (1.0f + sc1.x) + sh1.x, v[j][5] * r * (1.0f + sc1.y) + sh1.y); o.w = pk2(v[j][6] * r * (1.0f + sc1.z) + sh1.z, v[j][7] * r * (1.0f + sc1.w) + sh1.w);
                o16[64 * j] = o; }
        } else {
        const f32x4* xr = (const f32x4*)((const float*)xsrc + (size_t)row * D) + F.lane;
        f32x4 v[8]; float s = 0.f;
#pragma unroll
        for (int j = 0; j < 8; ++j) { v[j] = xr[64 * j]; s += (v[j].x * v[j].x + v[j].y * v[j].y) + (v[j].z * v[j].z + v[j].w * v[j].w); }
        const float r = rsqrtf(wave_sum(s) * (1.f / D) + EPS);
        unsigned long long* o8 = (unsigned long long*)(H + (size_t)row * D) + F.lane;
#pragma unroll
        for (int j = 0; j < 8; ++j) { const int c = 4 * F.lane + 256 * j;
            const f32x4 sc = *(const f32x4*)(mb + sc_off + c), sh = *(const f32x4*)(mb + sh_off + c);
            const f32x4 y = v[j] * r * (1.0f + sc) + sh;
            o8[64 * j] = (unsigned long long)pk2(y.x, y.y) | ((unsigned long long)pk2(y.z, y.w) << 32); }
        }
    }
}

namespace fa {
#ifndef PIPE_MLA
#define PIPE_MLA 1
#endif
#ifndef PIPE_LIN
#define PIPE_LIN 0
#endif
#ifndef PIPE_GEN
#define PIPE_GEN 0
#endif
#ifndef PIPE_OLD64
#define PIPE_OLD64 0
#endif
template <typename T> __device__ __forceinline__ T ldg(const void* base, unsigned off) { return *(const T*)((const char*)base + off); }
template <typename T> __device__ __forceinline__ void stg(void* base, unsigned off, T v) { *(T*)((char*)base + off) = v; }
constexpr int crowc(int r) { return (r & 3) + 8 * (r >> 2); }
using s16x4 = __attribute__((ext_vector_type(4))) short;
using f32x8 = __attribute__((ext_vector_type(8))) float;
constexpr int QBLK = 32, KVBLK = 64, DV = 128;
constexpr int SHM_V = KVBLK * DV * 2;
constexpr float THR = 11.5f;
#define FA_SBAR() __builtin_amdgcn_sched_barrier(0)
__device__ __forceinline__ unsigned cvtpk(float lo, float hi) { unsigned r; asm volatile("v_cvt_pk_bf16_f32 %0, %1, %2" : "=v"(r) : "v"(lo), "v"(hi)); return r; }
__device__ __forceinline__ int kswz(int row, int colB) { return (colB >> 7) * 8192 + row * 128 + ((colB & 127) ^ (((row >> 1) & 7) << 4)); }
__device__ __forceinline__ int v_st(int k, int c) { const int kk = (k & ~0xC) | ((k & 4) << 1) | ((k & 8) >> 1); return ((kk >> 3) * 4 + (c >> 5)) * 512 + ((kk & 7) * 32 + (c & 31)) * 2; }
__device__ __forceinline__ int v_st_nat(int k, int c) { return ((k >> 3) * 4 + (c >> 5)) * 512 + ((k & 7) * 32 + (c & 31)) * 2; }
__device__ __forceinline__ int v_rd_base(int lane) { return ((lane & 3) << 3) | (((lane >> 2) & 3) << 6) | (((lane >> 4) & 1) << 5) | (((lane >> 5) & 1) << 8); }
constexpr int v_rd_off(int d0, int ks, int half) { return d0 * 512 + ks * 4096 + half * 2048; }
template <int OFF> __device__ __forceinline__ s16x4 tr_read(int vb) { s16x4 r; asm volatile("ds_read_b64_tr_b16 %0, %1 offset:%2" : "=&v"(r) : "v"(vb), "i"(OFF) : "memory"); return r; }
template <int D0> __device__ __forceinline__ void pv_one(f32x16& od, int vb, bf16x8 pa0, bf16x8 pa1, bf16x8 pa2, bf16x8 pa3) {
    const s16x4 l0 = tr_read<v_rd_off(D0, 0, 0)>(vb), h0 = tr_read<v_rd_off(D0, 0, 1)>(vb), l1 = tr_read<v_rd_off(D0, 1, 0)>(vb), h1 = tr_read<v_rd_off(D0, 1, 1)>(vb);
    const s16x4 l2 = tr_read<v_rd_off(D0, 2, 0)>(vb), h2 = tr_read<v_rd_off(D0, 2, 1)>(vb), l3 = tr_read<v_rd_off(D0, 3, 0)>(vb), h3 = tr_read<v_rd_off(D0, 3, 1)>(vb);
    asm volatile("s_waitcnt lgkmcnt(0)" ::: "memory"); FA_SBAR();
#define FA_PK(L, H) (bf16x8){L[0], L[1], L[2], L[3], H[0], H[1], H[2], H[3]}
    od = __builtin_amdgcn_mfma_f32_32x32x16_bf16(pa0, FA_PK(l0, h0), od, 0, 0, 0);
    od = __builtin_amdgcn_mfma_f32_32x32x16_bf16(pa1, FA_PK(l1, h1), od, 0, 0, 0);
    od = __builtin_amdgcn_mfma_f32_32x32x16_bf16(pa2, FA_PK(l2, h2), od, 0, 0, 0);
    od = __builtin_amdgcn_mfma_f32_32x32x16_bf16(pa3, FA_PK(l3, h3), od, 0, 0, 0);
#undef FA_PK
}
__device__ __forceinline__ void pv_d0(f32x16* o, int vb, bf16x8 pa0, bf16x8 pa1, bf16x8 pa2, bf16x8 pa3) {
    pv_one<0>(o[0], vb, pa0, pa1, pa2, pa3); pv_one<1>(o[1], vb, pa0, pa1, pa2, pa3); pv_one<2>(o[2], vb, pa0, pa1, pa2, pa3); pv_one<3>(o[3], vb, pa0, pa1, pa2, pa3);
}
template <int D0> __device__ __forceinline__ void pv_reads(s16x4 (&l)[4], s16x4 (&h)[4], int vb) {
    l[0] = tr_read<v_rd_off(D0, 0, 0)>(vb); h[0] = tr_read<v_rd_off(D0, 0, 1)>(vb); l[1] = tr_read<v_rd_off(D0, 1, 0)>(vb); h[1] = tr_read<v_rd_off(D0, 1, 1)>(vb);
    l[2] = tr_read<v_rd_off(D0, 2, 0)>(vb); h[2] = tr_read<v_rd_off(D0, 2, 1)>(vb); l[3] = tr_read<v_rd_off(D0, 3, 0)>(vb); h[3] = tr_read<v_rd_off(D0, 3, 1)>(vb);
}
__device__ __forceinline__ void pv_mfma(f32x16& od, const s16x4 (&l)[4], const s16x4 (&h)[4], bf16x8 pa0, bf16x8 pa1, bf16x8 pa2, bf16x8 pa3) {
#define FA_PK(L, H) (bf16x8){L[0], L[1], L[2], L[3], H[0], H[1], H[2], H[3]}
    od = __builtin_amdgcn_mfma_f32_32x32x16_bf16(pa0, FA_PK(l[0], h[0]), od, 0, 0, 0);
    od = __builtin_amdgcn_mfma_f32_32x32x16_bf16(pa1, FA_PK(l[1], h[1]), od, 0, 0, 0);
    od = __builtin_amdgcn_mfma_f32_32x32x16_bf16(pa2, FA_PK(l[2], h[2]), od, 0, 0, 0);
    od = __builtin_amdgcn_mfma_f32_32x32x16_bf16(pa3, FA_PK(l[3], h[3]), od, 0, 0, 0);
#undef FA_PK
}
__device__ __forceinline__ void pv_d0_pipe(f32x16* o, int vb, bf16x8 pa0, bf16x8 pa1, bf16x8 pa2, bf16x8 pa3) {
    s16x4 la[4], ha[4], lb[4], hb[4];
    pv_reads<0>(la, ha, vb); pv_reads<1>(lb, hb, vb);
    asm volatile("s_waitcnt lgkmcnt(8)" ::: "memory"); FA_SBAR(); pv_mfma(o[0], la, ha, pa0, pa1, pa2, pa3); FA_SBAR();
    pv_reads<2>(la, ha, vb);
    asm volatile("s_waitcnt lgkmcnt(8)" ::: "memory"); FA_SBAR(); pv_mfma(o[1], lb, hb, pa0, pa1, pa2, pa3); FA_SBAR();
    pv_reads<3>(lb, hb, vb);
    asm volatile("s_waitcnt lgkmcnt(8)" ::: "memory"); FA_SBAR(); pv_mfma(o[2], la, ha, pa0, pa1, pa2, pa3); FA_SBAR();
    asm volatile("s_waitcnt lgkmcnt(0)" ::: "memory"); FA_SBAR(); pv_mfma(o[3], lb, hb, pa0, pa1, pa2, pa3);
}
__device__ __forceinline__ void partialSM(f32x16& p0, f32x16& p1, float& m_reg, float& alpha) {
    float pmax = p0[0];
#pragma unroll
    for (int r = 1; r < 16; ++r) pmax = fmaxf(pmax, p0[r]);
#pragma unroll
    for (int r = 0; r < 16; ++r) pmax = fmaxf(pmax, p1[r]);
    { auto rr = __builtin_amdgcn_permlane32_swap(__float_as_uint(pmax), __float_as_uint(pmax), false, false); pmax = fmaxf(__uint_as_float(rr[0]), __uint_as_float(rr[1])); }
    float mn;
    if (__builtin_expect(__all(pmax - m_reg <= THR), 1)) { mn = m_reg; alpha = 1.f; }
    else { mn = fmaxf(m_reg, pmax); alpha = __builtin_amdgcn_exp2f(m_reg - mn); m_reg = mn; }
#pragma unroll
    for (int r = 0; r < 16; ++r) { p0[r] -= mn; p1[r] -= mn; }
#pragma unroll
    for (int r = 0; r < 16; ++r) p0[r] = __builtin_amdgcn_exp2f(p0[r]);
}
__device__ __forceinline__ void finishSM(f32x16& p0, f32x16& p1, float alpha, float& l_reg, bf16x8& pa0, bf16x8& pa1, bf16x8& pa2, bf16x8& pa3) {
#pragma unroll
    for (int r = 0; r < 16; ++r) p1[r] = __builtin_amdgcn_exp2f(p1[r]);
    float ps = 0;
#pragma unroll
    for (int r = 0; r < 16; ++r) ps += p0[r];
#pragma unroll
    for (int r = 0; r < 16; ++r) ps += p1[r];
    { auto rr = __builtin_amdgcn_permlane32_swap(__float_as_uint(ps), __float_as_uint(ps), false, false); ps = __uint_as_float(rr[0]) + __uint_as_float(rr[1]); }
    l_reg = l_reg * alpha + ps;
#define FA_PK4(P, BASE, OUT) do { unsigned a0 = cvtpk(P[BASE + 0], P[BASE + 1]), a1 = cvtpk(P[BASE + 2], P[BASE + 3]);   \
    unsigned b0 = cvtpk(P[BASE + 4], P[BASE + 5]), b1 = cvtpk(P[BASE + 6], P[BASE + 7]);                              \
    auto r0 = __builtin_amdgcn_permlane32_swap(a0, b0, false, false); auto r1 = __builtin_amdgcn_permlane32_swap(a1, b1, false, false); \
    u32x4_t w = {r0[0], r1[0], r0[1], r1[1]}; OUT = __builtin_bit_cast(bf16x8, w); } while (0)
    typedef unsigned u32x4_t __attribute__((ext_vector_type(4)));
    FA_PK4(p0, 0, pa0); FA_PK4(p0, 8, pa1); FA_PK4(p1, 0, pa2); FA_PK4(p1, 8, pa3);
#undef FA_PK4
}
template <bool ALIBI> __device__ __forceinline__ void fr_init(f32x16& p0, f32x16& p1, const LAS float* posl, float posq, float slope2, bool linear, int hi) {
    if (linear) {
        const float cl = -slope2 * posq;
#pragma unroll
        for (int g = 0; g < 4; ++g) { const f32x4 k0 = *(const LAS f32x4*)(posl + 8 * g + 4 * hi), k1 = *(const LAS f32x4*)(posl + 32 + 8 * g + 4 * hi);
#pragma unroll
            for (int e = 0; e < 4; ++e) { p0[4 * g + e] = fmaf(slope2, k0[e], cl); p1[4 * g + e] = fmaf(slope2, k1[e], cl); } }
    } else {
#pragma unroll
        for (int g = 0; g < 4; ++g) { const f32x4 k0 = *(const LAS f32x4*)(posl + 8 * g + 4 * hi), k1 = *(const LAS f32x4*)(posl + 32 + 8 * g + 4 * hi);
#pragma unroll
            for (int e = 0; e < 4; ++e) { p0[4 * g + e] = -slope2 * fabsf(posq - k0[e]); p1[4 * g + e] = -slope2 * fabsf(posq - k1[e]); } }
    }
}
__device__ __forceinline__ void fr_softmax(f32x16& p0, f32x16& p1, float& l_reg, bf16x8& pa0, bf16x8& pa1, bf16x8& pa2, bf16x8& pa3) {
#pragma unroll
    for (int r = 0; r < 16; ++r) { p0[r] = __builtin_amdgcn_exp2f(p0[r]); p1[r] = __builtin_amdgcn_exp2f(p1[r]); }
    float sa = 0.f, sb = 0.f;
#pragma unroll
    for (int r = 0; r < 16; ++r) { sa += p0[r]; sb += p1[r]; }
    l_reg += sa + sb;
    typedef unsigned u32x4_t __attribute__((ext_vector_type(4)));
#define FA_PKS(P, BASE, OUT) do { u32x4_t w = {cvtpk(P[BASE + 0], P[BASE + 1]), cvtpk(P[BASE + 2], P[BASE + 3]), cvtpk(P[BASE + 4], P[BASE + 5]), cvtpk(P[BASE + 6], P[BASE + 7])}; OUT = __builtin_bit_cast(bf16x8, w); } while (0)
    FA_PKS(p0, 0, pa0); FA_PKS(p0, 8, pa1); FA_PKS(p1, 0, pa2); FA_PKS(p1, 8, pa3);
#undef FA_PKS
}
template <int DQK> struct Lds {
    static constexpr int SHM_K = KVBLK * DQK * 2;
    static constexpr int V_OFF = 0, K_OFF = 2 * SHM_V, POS_OFF = K_OFF + 2 * SHM_K, WS_OFF = POS_OFF + 2 * 256, END = WS_OFF + 8 * 256;
};
template <int DQK, bool INIT = true> __device__ __forceinline__ void qkt(f32x16& p0, f32x16& p1, const LAS unsigned char* Ks, const bf16x8* qr, int r32, int hi) {
    if (INIT) { p0 = f32x16{}; p1 = f32x16{}; }
#pragma unroll
    for (int d0 = 0; d0 < DQK / 16; ++d0) { const int cb = (d0 * 16 + hi * 8) * 2;
        const bf16x8 b0 = *(const LAS bf16x8*)(Ks + kswz(r32, cb));
        const bf16x8 b1 = *(const LAS bf16x8*)(Ks + kswz(32 + r32, cb));
        p0 = __builtin_amdgcn_mfma_f32_32x32x16_bf16(b0, qr[d0], p0, 0, 0, 0);
        p1 = __builtin_amdgcn_mfma_f32_32x32x16_bf16(b1, qr[d0], p1, 0, 0, 0);
        if (DQK > 64 && (d0 & 3) == 3) FA_SBAR(); }
}
template <int OFF> __device__ __forceinline__ bf16x8 k_read(int addr) { bf16x8 r; asm volatile("ds_read_b128 %0, %1 offset:%2" : "=&v"(r) : "v"(addr), "i"(OFF) : "memory"); return r; }
__device__ __forceinline__ void k_bases(int (&ka)[4], const LAS unsigned char* K_lds, int r32, int hi) {
#pragma unroll
    for (int j = 0; j < 4; ++j) ka[j] = (int)(uintptr_t)K_lds + r32 * 128 + ((j * 32 + hi * 16) ^ (((r32 >> 1) & 7) << 4));
}
#define FA_LGK(n) asm volatile("s_waitcnt lgkmcnt(" #n ")" ::: "memory")
template <int DQK, int BOFF, int VAR = 0> __device__ __forceinline__ void qkt_pipe(f32x16& p0, f32x16& p1, const int (&ka)[4], const bf16x8* qr) {
    if constexpr (DQK == 64) {
        bf16x8 a0 = k_read<BOFF>(ka[0]), b0 = k_read<BOFF + 4096>(ka[0]), a1 = k_read<BOFF>(ka[1]), b1 = k_read<BOFF + 4096>(ka[1]);
        bf16x8 a2 = k_read<BOFF>(ka[2]), b2 = k_read<BOFF + 4096>(ka[2]), a3 = k_read<BOFF>(ka[3]), b3 = k_read<BOFF + 4096>(ka[3]);
        FA_LGK(6); FA_SBAR(); p0 = __builtin_amdgcn_mfma_f32_32x32x16_bf16(a0, qr[0], p0, 0, 0, 0); p1 = __builtin_amdgcn_mfma_f32_32x32x16_bf16(b0, qr[0], p1, 0, 0, 0); FA_SBAR();
        FA_LGK(4); FA_SBAR(); p0 = __builtin_amdgcn_mfma_f32_32x32x16_bf16(a1, qr[1], p0, 0, 0, 0); p1 = __builtin_amdgcn_mfma_f32_32x32x16_bf16(b1, qr[1], p1, 0, 0, 0); FA_SBAR();
        FA_LGK(2); FA_SBAR(); p0 = __builtin_amdgcn_mfma_f32_32x32x16_bf16(a2, qr[2], p0, 0, 0, 0); p1 = __builtin_amdgcn_mfma_f32_32x32x16_bf16(b2, qr[2], p1, 0, 0, 0); FA_SBAR();
        FA_LGK(0); FA_SBAR(); p0 = __builtin_amdgcn_mfma_f32_32x32x16_bf16(a3, qr[3], p0, 0, 0, 0); p1 = __builtin_amdgcn_mfma_f32_32x32x16_bf16(b3, qr[3], p1, 0, 0, 0); FA_SBAR();
    } else {
        static_assert(DQK == 192, "qkt_pipe: d = 64 or 192");
#define FA_KG(G, x0, y0, x1, y1) do { x0 = k_read<BOFF + ((2 * (G)) >> 2) * 8192>(ka[(2 * (G)) & 3]); y0 = k_read<BOFF + ((2 * (G)) >> 2) * 8192 + 4096>(ka[(2 * (G)) & 3]); \
        x1 = k_read<BOFF + ((2 * (G) + 1) >> 2) * 8192>(ka[(2 * (G) + 1) & 3]); y1 = k_read<BOFF + ((2 * (G) + 1) >> 2) * 8192 + 4096>(ka[(2 * (G) + 1) & 3]); } while (0)
#define FA_KM(G, x0, y0, x1, y1) do { FA_SBAR(); if (VAR == 6) { p0 = __builtin_amdgcn_mfma_f32_32x32x16_bf16(x0 ^ y0 ^ x1 ^ y1, qr[2 * (G)], p0, 0, 0, 0); } else { \
        p0 = __builtin_amdgcn_mfma_f32_32x32x16_bf16(x0, qr[2 * (G)], p0, 0, 0, 0); p1 = __builtin_amdgcn_mfma_f32_32x32x16_bf16(y0, qr[2 * (G)], p1, 0, 0, 0); \
        p0 = __builtin_amdgcn_mfma_f32_32x32x16_bf16(x1, qr[2 * (G) + 1], p0, 0, 0, 0); p1 = __builtin_amdgcn_mfma_f32_32x32x16_bf16(y1, qr[2 * (G) + 1], p1, 0, 0, 0); } FA_SBAR(); } while (0)
        bf16x8 a0, b0, a1, b1, c0, d0, c1, d1;
        if constexpr (VAR == 5) {
#pragma unroll
            for (int g = 0; g < 12; ++g) { FA_SBAR(); p0 = __builtin_amdgcn_mfma_f32_32x32x16_bf16(qr[(g + 1) % 12], qr[g], p0, 0, 0, 0); p1 = __builtin_amdgcn_mfma_f32_32x32x16_bf16(qr[(g + 5) % 12], qr[g], p1, 0, 0, 0); FA_SBAR(); }
            return; }
        FA_KG(0, a0, b0, a1, b1); FA_KG(1, c0, d0, c1, d1);
        FA_LGK(4); FA_KM(0, a0, b0, a1, b1); FA_KG(2, a0, b0, a1, b1);
        FA_LGK(4); FA_KM(1, c0, d0, c1, d1); FA_KG(3, c0, d0, c1, d1);
        FA_LGK(4); FA_KM(2, a0, b0, a1, b1); FA_KG(4, a0, b0, a1, b1);
        FA_LGK(4); FA_KM(3, c0, d0, c1, d1); FA_KG(5, c0, d0, c1, d1);
        FA_LGK(4); FA_KM(4, a0, b0, a1, b1);
        FA_LGK(0); FA_KM(5, c0, d0, c1, d1);
#undef FA_KG
#undef FA_KM
    }
}
template <bool ALIBI> __device__ __forceinline__ void fixup(f32x16& p0, f32x16& p1, const LAS float* posl, float posq, float slope2, bool masked, int hi) {
    if (ALIBI) {
#pragma unroll
        for (int g = 0; g < 4; ++g) { const f32x4 k0 = *(const LAS f32x4*)(posl + 8 * g + 4 * hi), k1 = *(const LAS f32x4*)(posl + 32 + 8 * g + 4 * hi);
#pragma unroll
            for (int e = 0; e < 4; ++e) { p0[4 * g + e] = fmaf(-slope2, fabsf(posq - k0[e]), p0[4 * g + e]); p1[4 * g + e] = fmaf(-slope2, fabsf(posq - k1[e]), p1[4 * g + e]); } }
    }
    if (masked) {
#pragma unroll
        for (int r = 0; r < 16; ++r) { p0[r] = -INFINITY; p1[r] = -INFINITY; }
    }
}
template <int DQK, bool ALIBI, int NSLOT, int MODE = 0, int VAR = 0>
__device__ __forceinline__ void attn_pass(const bf16* __restrict__ Qb, const bf16* __restrict__ Kh, const bf16* __restrict__ Vh, const int* __restrict__ posb, float slope2, float cref, int TL, int q0, int T0, int NT,
                                          LAS unsigned char* lds, int tid_, f32x16 (&o)[4], float& l_out) {
    typedef Lds<DQK> L; constexpr int KSUB = DQK / 64, SHM_K = L::SHM_K;
    const int wid = __builtin_amdgcn_readfirstlane(tid_ >> 6); int lane; asm volatile("v_mbcnt_lo_u32_b32 %0, -1, 0\n\tv_mbcnt_hi_u32_b32 %0, -1, %0" : "=v"(lane));
    const int tid = wid * 64 + lane, r32 = lane & 31, hi = lane >> 5;
    if (wid >= 4) __builtin_amdgcn_s_setprio(1);
    LAS unsigned char* V_lds = lds + L::V_OFF; LAS unsigned char* K_lds = lds + L::K_OFF; LAS float* P_lds = (LAS float*)(lds + L::POS_OFF);
    LAS float* al_l = (LAS float*)(lds + L::WS_OFF) + wid * 64;
    float m_reg = -1e30f, l_reg = 0.f;
#pragma unroll
    for (int d = 0; d < 4; ++d) o[d] = f32x16{};
    bf16x8 qr[DQK / 16];
    { const bf16* Qw = Qb + (size_t)(wid * QBLK) * DQK; unsigned qgo = (unsigned)(r32 * DQK + hi * 8) * 2u; asm volatile("" : "+v"(qgo));
#pragma unroll
      for (int d0 = 0; d0 < DQK / 16; ++d0) qr[d0] = ldg<bf16x8>(Qw + d0 * 16, qgo); }
    const float posq = ALIBI ? (float)posb[q0 + wid * QBLK + r32] : 0.f;
    const int tmax = NT - 4 + (wid >> 1);
    const int sr = tid >> 4, sc = (tid & 15) * 8, vst0 = MODE == 5 ? v_st_nat(sr, sc) : v_st(sr, sc), vst1 = MODE == 5 ? v_st_nat(32 + sr, sc) : v_st(32 + sr, sc);
    const int kr = tid >> 3, kc = (tid & 7) * 8, kst = kswz(kr, kc * 2);
    unsigned vgo = (unsigned)(sr * DV + sc) * 2u, kgo = (unsigned)(kr * DQK + kc) * 2u, pgo = (unsigned)(tid & 63) * 4u; asm volatile("" : "+v"(vgo), "+v"(kgo), "+v"(pgo));
    const int vb0 = (int)(uintptr_t)V_lds + v_rd_base(lane);
    int ka[4]; k_bases(ka, K_lds, r32, hi);
    struct Slot { bf16x8 vs0, vs1, ks[KSUB]; int ps; } sl_[NSLOT];
#define FA_SLOAD(i, k0) do { unsigned kk_ = (unsigned)__builtin_amdgcn_readfirstlane((int)(k0)); asm volatile("" : "+s"(kk_));     \
    const bf16* Vt_ = Vh + (size_t)kk_ * DV; const bf16* Kt_ = Kh + (size_t)kk_ * DQK; \
    sl_[i].vs0 = ldg<bf16x8>(Vt_, vgo); sl_[i].vs1 = ldg<bf16x8>(Vt_ + 32 * DV, vgo); \
    _Pragma("unroll") for (int s_ = 0; s_ < KSUB; ++s_) sl_[i].ks[s_] = ldg<bf16x8>(Kt_ + s_ * 64, kgo); \
    if (ALIBI) sl_[i].ps = ldg<int>(posb + kk_, pgo); } while (0)
#define FA_SWRITE(b, i) do { *(LAS bf16x8*)(V_lds + (b) * SHM_V + vst0) = sl_[i].vs0; *(LAS bf16x8*)(V_lds + (b) * SHM_V + vst1) = sl_[i].vs1; \
    _Pragma("unroll") for (int s_ = 0; s_ < KSUB; ++s_) *(LAS bf16x8*)(K_lds + (b) * SHM_K + s_ * 8192 + kst) = sl_[i].ks[s_]; \
    if (ALIBI) { if (tid < 64) P_lds[(b) * 64 + tid] = (float)sl_[i].ps; } } while (0)
#define FA_RESC(a) do { if (__any((a) < 1.f)) { if (hi == 0) al_l[r32] = (a); asm volatile("s_waitcnt lgkmcnt(0)" ::: "memory"); \
    _Pragma("unroll") for (int d = 0; d < 4; ++d) _Pragma("unroll") for (int r = 0; r < 16; ++r) o[d][r] *= al_l[crow(r, hi)]; } } while (0)
#define FA_COMPUTE(b, t, STAGE) do { bf16x8 pa0, pa1, pa2, pa3; const bool vis_ = (t) <= tmax;     \
    if (vis_) { f32x16 p0, p1; \
    if (MODE == 5) { if (VAR == 3) { p0 = f32x16{}; p1 = f32x16{}; _Pragma("unroll") for (int r_ = 0; r_ < 16; ++r_) { p0[r_] = l_reg; p1[r_] = l_reg; } } \
        else if ((DQK == 192 && PIPE_MLA) || (DQK == 64 && PIPE_OLD64)) { p0 = f32x16{}; p1 = f32x16{}; qkt_pipe<DQK, (b) * SHM_K, (VAR == 5 || VAR == 6) ? VAR : 0>(p0, p1, ka, qr); } else qkt<DQK, true>(p0, p1, K_lds + (b) * SHM_K, qr, r32, hi); fixup<ALIBI>(p0, p1, P_lds + (b) * 64, posq, slope2, false, hi); \
        if (VAR == 1) { l_reg += p0[0] + p1[5]; typedef unsigned u32x4_t __attribute__((ext_vector_type(4))); \
            u32x4_t w0_ = {cvtpk(p0[0], p0[1]), cvtpk(p0[2], p0[3]), cvtpk(p0[4], p0[5]), cvtpk(p0[6], p0[7])}, w1_ = {cvtpk(p0[8], p0[9]), cvtpk(p0[10], p0[11]), cvtpk(p0[12], p0[13]), cvtpk(p0[14], p0[15])}; \
            u32x4_t w2_ = {cvtpk(p1[0], p1[1]), cvtpk(p1[2], p1[3]), cvtpk(p1[4], p1[5]), cvtpk(p1[6], p1[7])}, w3_ = {cvtpk(p1[8], p1[9]), cvtpk(p1[10], p1[11]), cvtpk(p1[12], p1[13]), cvtpk(p1[14], p1[15])}; \
            pa0 = __builtin_bit_cast(bf16x8, w0_); pa1 = __builtin_bit_cast(bf16x8, w1_); pa2 = __builtin_bit_cast(bf16x8, w2_); pa3 = __builtin_bit_cast(bf16x8, w3_); } \
        else fr_softmax(p0, p1, l_reg, pa0, pa1, pa2, pa3); } \
    else { float alpha; qkt<DQK>(p0, p1, K_lds + (b) * SHM_K, qr, r32, hi); fixup<ALIBI>(p0, p1, P_lds + (b) * 64, posq, slope2, false, hi); \
        partialSM(p0, p1, m_reg, alpha); finishSM(p0, p1, alpha, l_reg, pa0, pa1, pa2, pa3); FA_RESC(alpha); } } \
    FA_SBAR(); STAGE; FA_SBAR();     \
    if (vis_) { \
    if (VAR == 2) { l_reg += __builtin_bit_cast(float, pa0[0] | (pa1[1] << 16)) + __builtin_bit_cast(float, pa2[0] | (pa3[1] << 16)); } else \
    if (MODE == 5 && DQK == 64) pv_d0_pipe(o, vb0 + (b) * SHM_V, pa0, pa1, pa2, pa3); else pv_d0(o, vb0 + (b) * SHM_V, pa0, pa1, pa2, pa3); } } while (0)
    constexpr int S1 = NSLOT - 1;
    FA_SLOAD(0, T0 * KVBLK); FA_SWRITE(0, 0); FA_SLOAD(S1, (T0 + 1) * KVBLK); FA_SWRITE(1, S1); FA_SLOAD(0, (T0 + 2) * KVBLK);
    if (NSLOT == 2) FA_SLOAD(1, (T0 + 3) * KVBLK);
    __syncthreads();
    static_assert(NSLOT == 1, "attn_pass: one staging slot");
    for (int j = T0; j < NT; j += 2) {
        FA_COMPUTE(0, j, { if (VAR != 4) if (j > T0) { FA_SWRITE(1, 0); if (j + 2 < NT) FA_SLOAD(0, (j + 2) * KVBLK); } });
        __syncthreads();
        FA_COMPUTE(1, j + 1, { if (VAR != 4) if (j + 2 < NT) { FA_SWRITE(0, 0); FA_SLOAD(0, (j + 3) * KVBLK); } });
        __syncthreads();
    }
    if (MODE == 5) { auto rr = __builtin_amdgcn_permlane32_swap(__float_as_uint(l_reg), __float_as_uint(l_reg), false, false); l_reg = __uint_as_float(rr[0]) + __uint_as_float(rr[1]); }
    __builtin_amdgcn_s_setprio(0);
    l_out = l_reg;
#undef FA_SLOAD
#undef FA_SWRITE
#undef FA_RESC
#undef FA_COMPUTE
}
template <int DQK> struct Lds3 {
    static constexpr int SHM_K = KVBLK * DQK * 2;
    static constexpr int V_OFF = 0, K_OFF = 3 * SHM_V, POS_OFF = K_OFF + 3 * SHM_K, WS_OFF = POS_OFF + 3 * 256, END = WS_OFF + 8 * 256;
};
template <int DQK, bool ALIBI>
__device__ __forceinline__ void attn_pass_stag(const bf16* __restrict__ Qb, const bf16* __restrict__ Kh, const bf16* __restrict__ Vh, const int* __restrict__ posb, float slope2, int q0, int T0, int NT,
                                               LAS unsigned char* lds, int tid, f32x16 (&o)[4], float& l_out) {
    typedef Lds3<DQK> L; constexpr int KSUB = DQK / 64, SHM_K = L::SHM_K;
    const int wid = __builtin_amdgcn_readfirstlane(tid >> 6), lane = tid & 63, r32 = lane & 31, hi = lane >> 5, grp = wid >> 2;
    LAS unsigned char* V_lds = lds + L::V_OFF; LAS unsigned char* K_lds = lds + L::K_OFF; LAS float* P_lds = (LAS float*)(lds + L::POS_OFF);
    float l_reg = 0.f;
#pragma unroll
    for (int d = 0; d < 4; ++d) o[d] = f32x16{};
    bf16x8 qr[DQK / 16];
    { const bf16* Qw = Qb + (size_t)(wid * QBLK) * DQK; unsigned qgo = (unsigned)(r32 * DQK + hi * 8) * 2u; asm volatile("" : "+v"(qgo));
#pragma unroll
      for (int d0 = 0; d0 < DQK / 16; ++d0) qr[d0] = ldg<bf16x8>(Qw + d0 * 16, qgo); }
    const float posq = ALIBI ? (float)posb[q0 + wid * QBLK + r32] : 0.f;
    const int tmax = NT - 4 + (wid >> 1);
    const int sr = tid >> 4, sc = (tid & 15) * 8, vst0 = v_st(sr, sc), vst1 = v_st(32 + sr, sc);
    const int kr = tid >> 3, kc = (tid & 7) * 8, kst = kswz(kr, kc * 2);
    unsigned vgo = (unsigned)(sr * DV + sc) * 2u, kgo = (unsigned)(kr * DQK + kc) * 2u, pgo = (unsigned)(tid & 63) * 4u; asm volatile("" : "+v"(vgo), "+v"(kgo), "+v"(pgo));
    const int vb0 = (int)(uintptr_t)V_lds + v_rd_base(lane);
    struct Slot { bf16x8 vs0, vs1, ks[KSUB]; int ps; } sl_;
#define FS_SLOAD(k0) do { unsigned kk_ = (unsigned)__builtin_amdgcn_readfirstlane((int)(k0)); asm volatile("" : "+s"(kk_)); \
    const bf16* Vt_ = Vh + (size_t)kk_ * DV; const bf16* Kt_ = Kh + (size_t)kk_ * DQK; \
    sl_.vs0 = ldg<bf16x8>(Vt_, vgo); sl_.vs1 = ldg<bf16x8>(Vt_ + 32 * DV, vgo); \
    _Pragma("unroll") for (int s_ = 0; s_ < KSUB; ++s_) sl_.ks[s_] = ldg<bf16x8>(Kt_ + s_ * 64, kgo); \
    if (ALIBI) sl_.ps = ldg<int>(posb + kk_, pgo); } while (0)
#define FS_SWRITE(b) do { *(LAS bf16x8*)(V_lds + (b) * SHM_V + vst0) = sl_.vs0; *(LAS bf16x8*)(V_lds + (b) * SHM_V + vst1) = sl_.vs1; \
    _Pragma("unroll") for (int s_ = 0; s_ < KSUB; ++s_) *(LAS bf16x8*)(K_lds + (b) * SHM_K + s_ * 8192 + kst) = sl_.ks[s_]; \
    if (ALIBI) { if (tid < 64) P_lds[(b) * 64 + tid] = (float)sl_.ps; } } while (0)
    const int nt = NT - T0;
    FS_SLOAD(T0 * KVBLK); FS_SWRITE(0); FS_SLOAD((T0 + 1) * KVBLK); FS_SWRITE(1); FS_SLOAD((T0 + 2) * KVBLK);
    __syncthreads();
#define FS_QKS(j_) do { int b_ = (j_) % 3; asm volatile("" : "+s"(b_)); f32x16 p0, p1; \
    qkt<DQK, true>(p0, p1, K_lds + b_ * SHM_K, qr, r32, hi); fixup<ALIBI>(p0, p1, P_lds + b_ * 64, posq, slope2, T0 + (j_) > tmax, hi); \
    fr_softmax(p0, p1, l_reg, pa0, pa1, pa2, pa3); } while (0)
#define FS_PV(j_) do { int b_ = (j_) % 3; asm volatile("" : "+s"(b_)); pv_d0(o, vb0 + b_ * SHM_V, pa0, pa1, pa2, pa3); } while (0)
#define FS_STAGE(j_) do { const int jn_ = (j_) + 2; if (jn_ < nt) { int bw_ = jn_ % 3; asm volatile("" : "+s"(bw_)); FS_SWRITE(bw_); if (jn_ + 1 < nt) FS_SLOAD((T0 + jn_ + 1) * KVBLK); } } while (0)
    bf16x8 pa0, pa1, pa2, pa3;
    if (grp == 0) {
        for (int j = 0; j < nt; ++j) { FS_QKS(j); __syncthreads(); FS_PV(j); __syncthreads(); FS_STAGE(j); }
        __syncthreads();
    } else {
        pa0 = bf16x8{}; pa1 = bf16x8{}; pa2 = bf16x8{}; pa3 = bf16x8{};
        for (int j = 0; j < nt; ++j) { if (j > 0) FS_PV(j - 1); __syncthreads(); FS_QKS(j); __syncthreads(); FS_STAGE(j); }
        FS_PV(nt - 1); __syncthreads();
    }
#undef FS_QKS
#undef FS_PV
#undef FS_STAGE
    { auto rr = __builtin_amdgcn_permlane32_swap(__float_as_uint(l_reg), __float_as_uint(l_reg), false, false); l_reg = __uint_as_float(rr[0]) + __uint_as_float(rr[1]); }
    l_out = l_reg;
#undef FS_SLOAD
#undef FS_SWRITE
}
template <int DQK, bool ALIBI>
__device__ __forceinline__ void attn_pass_p2(const bf16* __restrict__ Qb, const bf16* __restrict__ Kh, const bf16* __restrict__ Vh, const int* __restrict__ posb, float slope2, int q0, int T0, int NT,
                                             LAS unsigned char* lds, int tid, f32x16 (&o)[4], float& l_out) {
    typedef Lds<DQK> L; constexpr int KSUB = DQK / 64, SHM_K = L::SHM_K;
    const int wid = __builtin_amdgcn_readfirstlane(tid >> 6), lane = tid & 63, r32 = lane & 31, hi = lane >> 5;
    LAS unsigned char* V_lds = lds + L::V_OFF; LAS unsigned char* K_lds = lds + L::K_OFF; LAS float* P_lds = (LAS float*)(lds + L::POS_OFF);
    float l_reg = 0.f;
#pragma unroll
    for (int d = 0; d < 4; ++d) o[d] = f32x16{};
    bf16x8 qr[DQK / 16];
    { const bf16* Qw = Qb + (size_t)(wid * QBLK) * DQK; unsigned qgo = (unsigned)(r32 * DQK + hi * 8) * 2u; asm volatile("" : "+v"(qgo));
#pragma unroll
      for (int d0 = 0; d0 < DQK / 16; ++d0) qr[d0] = ldg<bf16x8>(Qw + d0 * 16, qgo); }
    const float posq = ALIBI ? (float)posb[q0 + wid * QBLK + r32] : 0.f;
    const int tmax = NT - 4 + (wid >> 1);
    const int sr = tid >> 4, sc = (tid & 15) * 8, vst0 = v_st(sr, sc), vst1 = v_st(32 + sr, sc);
    const int kr = tid >> 3, kc = (tid & 7) * 8, kst = kswz(kr, kc * 2);
    unsigned vgo = (unsigned)(sr * DV + sc) * 2u, kgo = (unsigned)(kr * DQK + kc) * 2u, pgo = (unsigned)(tid & 63) * 4u; asm volatile("" : "+v"(vgo), "+v"(kgo), "+v"(pgo));
    const int vb0 = (int)(uintptr_t)V_lds + v_rd_base(lane);
    struct Slot { bf16x8 vs0, vs1, ks[KSUB]; int ps; } sl_;
#define FP_LOADK(t) do { unsigned kk_ = (unsigned)__builtin_amdgcn_readfirstlane((int)((t) * KVBLK)); asm volatile("" : "+s"(kk_)); const bf16* Kt_ = Kh + (size_t)kk_ * DQK; \
    _Pragma("unroll") for (int s_ = 0; s_ < KSUB; ++s_) sl_.ks[s_] = ldg<bf16x8>(Kt_ + s_ * 64, kgo); if (ALIBI) sl_.ps = ldg<int>(posb + kk_, pgo); } while (0)
#define FP_LOADV(t) do { unsigned kk_ = (unsigned)__builtin_amdgcn_readfirstlane((int)((t) * KVBLK)); asm volatile("" : "+s"(kk_)); const bf16* Vt_ = Vh + (size_t)kk_ * DV; \
    sl_.vs0 = ldg<bf16x8>(Vt_, vgo); sl_.vs1 = ldg<bf16x8>(Vt_ + 32 * DV, vgo); } while (0)
#define FP_WRITEK(b) do { _Pragma("unroll") for (int s_ = 0; s_ < KSUB; ++s_) *(LAS bf16x8*)(K_lds + (b) * SHM_K + s_ * 8192 + kst) = sl_.ks[s_]; \
    if (ALIBI) { if (tid < 64) P_lds[(b) * 64 + tid] = (float)sl_.ps; } } while (0)
#define FP_WRITEV(b) do { *(LAS bf16x8*)(V_lds + (b) * SHM_V + vst0) = sl_.vs0; *(LAS bf16x8*)(V_lds + (b) * SHM_V + vst1) = sl_.vs1; } while (0)
#define FP_QK(P0, P1, b, t) do { qkt<DQK, true>(P0, P1, K_lds + (b) * SHM_K, qr, r32, hi); fixup<ALIBI>(P0, P1, P_lds + (b) * 64, posq, slope2, (t) > tmax, hi); } while (0)
    f32x16 pA0, pA1, pB0, pB1; bf16x8 pa0, pa1, pa2, pa3;
    const int nt = NT - T0;
    FP_LOADK(T0); FP_LOADV(T0); FP_WRITEK(0); FP_WRITEV(0); FP_LOADK(T0 + 1); FP_WRITEK(1); FP_LOADK(T0 + 2); FP_LOADV(T0 + 1);
    __syncthreads();
    FP_QK(pA0, pA1, 0, T0);
    __syncthreads();
    for (int r = 0; r < nt; r += 2) {
        if (r + 2 < nt) FP_WRITEK(0);
        FP_WRITEV(1);
        if (r + 3 < nt) FP_LOADK(T0 + r + 3);
        if (r + 2 < nt) FP_LOADV(T0 + r + 2);
        FA_SBAR(); FP_QK(pB0, pB1, 1, T0 + r + 1);
        fr_softmax(pA0, pA1, l_reg, pa0, pa1, pa2, pa3); FA_SBAR();
        pv_d0(o, vb0, pa0, pa1, pa2, pa3);
        __syncthreads();
        if (r + 3 < nt) FP_WRITEK(1);
        if (r + 2 < nt) FP_WRITEV(0);
        if (r + 4 < nt) FP_LOADK(T0 + r + 4);
        if (r + 3 < nt) FP_LOADV(T0 + r + 3);
        FA_SBAR(); if (r + 2 < nt) FP_QK(pA0, pA1, 0, T0 + r + 2);
        fr_softmax(pB0, pB1, l_reg, pa0, pa1, pa2, pa3); FA_SBAR();
        pv_d0(o, vb0 + SHM_V, pa0, pa1, pa2, pa3);
        __syncthreads();
    }
    { auto rr = __builtin_amdgcn_permlane32_swap(__float_as_uint(l_reg), __float_as_uint(l_reg), false, false); l_reg = __uint_as_float(rr[0]) + __uint_as_float(rr[1]); }
    l_out = l_reg;
#undef FP_LOADK
#undef FP_LOADV
#undef FP_WRITEK
#undef FP_WRITEV
#undef FP_QK
}
template <int DQK, bool ALIBI>
__device__ __forceinline__ void attn_pass_dma(const bf16* __restrict__ Qb, const bf16* __restrict__ Kh, const bf16* __restrict__ Vh, const int* __restrict__ posb, const float* __restrict__ posfb,
                                              float slope2, int q0, int T0, int NT, LAS unsigned char* lds, int tid_, f32x16 (&o)[4], float& l_out) {
    typedef Lds3<DQK> L; constexpr int KSUB = DQK / 64, SHM_K = L::SHM_K, NPT = KSUB + 2 + (ALIBI ? 1 : 0);
    const int wid = __builtin_amdgcn_readfirstlane(tid_ >> 6); int lane; asm volatile("v_mbcnt_lo_u32_b32 %0, -1, 0\n\tv_mbcnt_hi_u32_b32 %0, -1, %0" : "=v"(lane));
    const int r32 = lane & 31, hi = lane >> 5;
    LAS unsigned char* V_lds = lds + L::V_OFF; LAS unsigned char* K_lds = lds + L::K_OFF; LAS float* P_lds = (LAS float*)(lds + L::POS_OFF);
    float l_reg = 0.f;
#pragma unroll
    for (int d = 0; d < 4; ++d) o[d] = f32x16{};
    bf16x8 qr[DQK / 16];
    { const bf16* Qw = Qb + (size_t)(wid * QBLK) * DQK; unsigned qgo = (unsigned)(r32 * DQK + hi * 8) * 2u; asm volatile("" : "+v"(qgo));
#pragma unroll
      for (int d0 = 0; d0 < DQK / 16; ++d0) qr[d0] = ldg<bf16x8>(Qw + d0 * 16, qgo); }
    const float posq = ALIBI ? (float)posb[q0 + wid * QBLK + r32] : 0.f;
    const int tmax = NT - 4 + (wid >> 1);
    unsigned ksrc, vsrc, psrc;
    { const int kr = 8 * wid + (lane >> 3), kc = (lane & 7) ^ ((kr >> 1) & 7); ksrc = (unsigned)(kr * DQK + kc * 8) * 2u;
      const int vk = 8 * wid + ((lane & 31) >> 2), vc = (lane >> 5) * 32 + (lane & 3) * 8; vsrc = (unsigned)(vk * DV + vc) * 2u; psrc = (unsigned)lane * 4u;
      asm volatile("" : "+v"(ksrc), "+v"(vsrc), "+v"(psrc)); }
    const int vb0 = (int)(uintptr_t)V_lds + v_rd_base(lane);
#define FD_DMA(t, slot) do { unsigned kk_ = (unsigned)__builtin_amdgcn_readfirstlane((int)((t) * KVBLK)); asm volatile("" : "+s"(kk_)); const int sl_ = (slot); \
    const char* Kt_ = (const char*)(Kh + (size_t)kk_ * DQK); const char* Vt_ = (const char*)(Vh + (size_t)kk_ * DV); \
    _Pragma("unroll") for (int s_ = 0; s_ < KSUB; ++s_) __builtin_amdgcn_global_load_lds((const unsigned*)(Kt_ + s_ * 128 + ksrc), (LAS unsigned*)(K_lds + sl_ * SHM_K + s_ * 8192 + wid * 1024), 16, 0, 0); \
    _Pragma("unroll") for (int q_ = 0; q_ < 2; ++q_) __builtin_amdgcn_global_load_lds((const unsigned*)(Vt_ + q_ * 128 + vsrc), (LAS unsigned*)(V_lds + sl_ * SHM_V + (2 * wid + q_) * 1024), 16, 0, 0); \
    if (ALIBI) __builtin_amdgcn_global_load_lds((const unsigned*)((const char*)(posfb + kk_) + psrc), (LAS unsigned*)(P_lds + sl_ * 64), 4, 0, 0); } while (0)
    const int nt = NT - T0;
    FD_DMA(T0, 0); FD_DMA(T0 + 1, 1);
    asm volatile("s_waitcnt vmcnt(0) lgkmcnt(0)\n\ts_barrier" ::: "memory");
    int slot = 0;
    for (int j = 0; j < nt; ++j) {
        int b = slot; asm volatile("" : "+s"(b));
        if (j + 2 < nt) { int bn = b + 2; bn = bn >= 3 ? bn - 3 : bn; FD_DMA(T0 + j + 2, bn); }
        { f32x16 p0, p1; bf16x8 pa0, pa1, pa2, pa3;
          qkt<DQK, true>(p0, p1, K_lds + b * SHM_K, qr, r32, hi); fixup<ALIBI>(p0, p1, P_lds + b * 64, posq, slope2, T0 + j > tmax, hi);
          fr_softmax(p0, p1, l_reg, pa0, pa1, pa2, pa3); FA_SBAR();
          pv_d0(o, vb0 + b * SHM_V, pa0, pa1, pa2, pa3); }
        if (j + 2 < nt) asm volatile("s_waitcnt vmcnt(%0) lgkmcnt(0)\n\ts_barrier" :: "n"(NPT) : "memory");
        else asm volatile("s_waitcnt vmcnt(0) lgkmcnt(0)\n\ts_barrier" ::: "memory");
        slot = slot == 2 ? 0 : slot + 1;
    }
    { auto rr = __builtin_amdgcn_permlane32_swap(__float_as_uint(l_reg), __float_as_uint(l_reg), false, false); l_reg = __uint_as_float(rr[0]) + __uint_as_float(rr[1]); }
    l_out = l_reg;
#undef FD_DMA
}
__device__ __forceinline__ void row_bcast(float f, LAS float* al, int r32, int hi, float (&rf)[16]) {
    asm volatile("s_waitcnt lgkmcnt(0)" ::: "memory");
    if (hi == 0) al[r32] = f;
    asm volatile("s_waitcnt lgkmcnt(0)" ::: "memory");
#pragma unroll
    for (int r = 0; r < 16; ++r) rf[r] = al[crow(r, hi)];
    asm volatile("s_waitcnt lgkmcnt(0)" ::: "memory");
}

__device__ __forceinline__ void attn_pass_da5(const bf16* __restrict__ Qb, const bf16* __restrict__ Kh, const bf16* __restrict__ Vh, const int* __restrict__ posb, float slope2, int cw, int q0, int T0, int NT,
                                              LAS unsigned char* lds, int tid_, f32x16 (&o)[4], float& l_out) {
    typedef Lds<64> L; constexpr int DQK = 64, SHM_K = L::SHM_K, B_OFF = L::END;
    const int wid = __builtin_amdgcn_readfirstlane(tid_ >> 6); int lane; asm volatile("v_mbcnt_lo_u32_b32 %0, -1, 0\n\tv_mbcnt_hi_u32_b32 %0, -1, %0" : "=v"(lane));
    const int tid = wid * 64 + lane, r32 = lane & 31, hi = lane >> 5;
    LAS unsigned char* V_lds = lds + L::V_OFF; LAS unsigned char* K_lds = lds + L::K_OFF; LAS float* P_lds = (LAS float*)(lds + L::POS_OFF); LAS float* B_lds = (LAS float*)(lds + B_OFF);
    float l_reg = 0.f;
#pragma unroll
    for (int d = 0; d < 4; ++d) o[d] = f32x16{};
    bf16x8 qr[4];
    { const bf16* Qw = Qb + (size_t)(wid * QBLK) * DQK; unsigned qgo = (unsigned)(r32 * DQK + hi * 8) * 2u; asm volatile("" : "+v"(qgo));
#pragma unroll
      for (int d0 = 0; d0 < 4; ++d0) qr[d0] = ldg<bf16x8>(Qw + d0 * 16, qgo); }
    const float posq = (float)posb[q0 + wid * QBLK + r32];
    const float dl = slope2 * (posq - (float)cw);
    const int tmax = NT - 4 + (wid >> 1);
    const int sr = tid >> 4, sc = (tid & 15) * 8, vst0 = v_st_nat(sr, sc), vst1 = v_st_nat(32 + sr, sc);
    const int kr = tid >> 3, kc = (tid & 7) * 8, kst = kswz(kr, kc * 2);
    unsigned vgo = (unsigned)(sr * DV + sc) * 2u, kgo = (unsigned)(kr * DQK + kc) * 2u, pgo = (unsigned)(tid & 63) * 4u; asm volatile("" : "+v"(vgo), "+v"(kgo), "+v"(pgo));
    const int vb0 = (int)(uintptr_t)V_lds + v_rd_base(lane);
    int ka[4]; k_bases(ka, K_lds, r32, hi);
    bf16x8 vs0, vs1, ks0; int ps;
#define FD_SLOAD(k0) do { unsigned kk_ = (unsigned)__builtin_amdgcn_readfirstlane((int)(k0)); asm volatile("" : "+s"(kk_)); \
    const bf16* Vt_ = Vh + (size_t)kk_ * DV; const bf16* Kt_ = Kh + (size_t)kk_ * DQK; \
    vs0 = ldg<bf16x8>(Vt_, vgo); vs1 = ldg<bf16x8>(Vt_ + 32 * DV, vgo); ks0 = ldg<bf16x8>(Kt_, kgo); ps = ldg<int>(posb + kk_, pgo); } while (0)
#define FD_SWRITE(b) do { *(LAS bf16x8*)(V_lds + (b) * SHM_V + vst0) = vs0; *(LAS bf16x8*)(V_lds + (b) * SHM_V + vst1) = vs1; *(LAS bf16x8*)(K_lds + (b) * SHM_K + kst) = ks0; \
    B_lds[(b) * 512 + tid] = slope2 * (float)(ps - cw); if (tid < 64) P_lds[(b) * 64 + tid] = (float)ps; } while (0)
#define FD_LIN(b) do { f32x16 p0, p1; bf16x8 pa0, pa1, pa2, pa3; const LAS float* bl_ = B_lds + (b) * 512 + wid * 64 + 4 * hi; \
    _Pragma("unroll") for (int g = 0; g < 4; ++g) { const f32x4 k0 = *(const LAS f32x4*)(bl_ + 8 * g), k1 = *(const LAS f32x4*)(bl_ + 32 + 8 * g); \
        _Pragma("unroll") for (int e = 0; e < 4; ++e) { p0[4 * g + e] = k0[e]; p1[4 * g + e] = k1[e]; } } \
    if (PIPE_LIN) qkt_pipe<DQK, (b) * SHM_K>(p0, p1, ka, qr); else qkt<DQK, false>(p0, p1, K_lds + (b) * SHM_K, qr, r32, hi); fr_softmax(p0, p1, l_reg, pa0, pa1, pa2, pa3); FA_SBAR(); \
    pv_d0_pipe(o, vb0 + (b) * SHM_V, pa0, pa1, pa2, pa3); } while (0)
#define FD_GEN(b, t) do { if ((t) <= tmax) { f32x16 p0, p1; bf16x8 pa0, pa1, pa2, pa3; \
    _Pragma("unroll") for (int r = 0; r < 16; ++r) { p0[r] = dl; p1[r] = dl; } \
    if (PIPE_GEN) qkt_pipe<DQK, (b) * SHM_K>(p0, p1, ka, qr); else qkt<DQK, false>(p0, p1, K_lds + (b) * SHM_K, qr, r32, hi); fixup<true>(p0, p1, P_lds + (b) * 64, posq, slope2, false, hi); fr_softmax(p0, p1, l_reg, pa0, pa1, pa2, pa3); FA_SBAR(); \
    pv_d0_pipe(o, vb0 + (b) * SHM_V, pa0, pa1, pa2, pa3); } } while (0)
    FD_SLOAD(T0 * KVBLK); FD_SWRITE(0); FD_SLOAD((T0 + 1) * KVBLK); FD_SWRITE(1); FD_SLOAD((T0 + 2) * KVBLK);
    __syncthreads();
    int j = T0;
    for (; j < NT - 4; j += 2) {
        FD_LIN(0);
        __syncthreads();
        FD_SWRITE(0); FD_SLOAD((j + 3) * KVBLK);
        FD_LIN(1);
        __syncthreads();
        FD_SWRITE(1); FD_SLOAD((j + 4) * KVBLK);
    }
    for (; j < NT; j += 2) {
        FD_GEN(0, j);
        __syncthreads();
        if (j + 2 < NT) { FD_SWRITE(0); FD_SLOAD((j + 3) * KVBLK); }
        FD_GEN(1, j + 1);
        __syncthreads();
        if (j + 2 < NT) { FD_SWRITE(1); }
    }
    { auto rr = __builtin_amdgcn_permlane32_swap(__float_as_uint(l_reg), __float_as_uint(l_reg), false, false); l_reg = __uint_as_float(rr[0]) + __uint_as_float(rr[1]); }
    l_out = l_reg;
#undef FD_SLOAD
#undef FD_SWRITE
#undef FD_LIN
#undef FD_GEN
}

__device__ __forceinline__ void attn_pass_da5p(const bf16* __restrict__ Qb, const bf16* __restrict__ Kh, const bf16* __restrict__ Vh, const int* __restrict__ posb, float slope2, int cw, int q0, int T0, int NT,
                                               LAS unsigned char* lds, int tid_, f32x16 (&o)[4], float& l_out) {
    typedef Lds<64> L; constexpr int DQK = 64, SHM_K = L::SHM_K, B_OFF = L::END;
    const int wid = __builtin_amdgcn_readfirstlane(tid_ >> 6); int lane; asm volatile("v_mbcnt_lo_u32_b32 %0, -1, 0\n\tv_mbcnt_hi_u32_b32 %0, -1, %0" : "=v"(lane));
    const int tid = wid * 64 + lane, r32 = lane & 31, hi = lane >> 5;
    if (wid >= 4) __builtin_amdgcn_s_setprio(1);
    LAS unsigned char* V_lds = lds + L::V_OFF; LAS unsigned char* K_lds = lds + L::K_OFF; LAS float* P_lds = (LAS float*)(lds + L::POS_OFF); LAS float* B_lds = (LAS float*)(lds + B_OFF);
    float l_reg = 0.f;
#pragma unroll
    for (int d = 0; d < 4; ++d) o[d] = f32x16{};
    bf16x8 qr[4];
    { const bf16* Qw = Qb + (size_t)(wid * QBLK) * DQK; unsigned qgo = (unsigned)(r32 * DQK + hi * 8) * 2u; asm volatile("" : "+v"(qgo));
#pragma unroll
      for (int d0 = 0; d0 < 4; ++d0) qr[d0] = ldg<bf16x8>(Qw + d0 * 16, qgo); }
    const float posq = (float)posb[q0 + wid * QBLK + r32];
    const float dl = slope2 * (posq - (float)cw);
    const int tmax = NT - 4 + (wid >> 1);
    const int sr = tid >> 4, sc = (tid & 15) * 8, vst0 = v_st_nat(sr, sc), vst1 = v_st_nat(32 + sr, sc);
    const int kr = tid >> 3, kc = (tid & 7) * 8, kst = kswz(kr, kc * 2);
    unsigned vgo = (unsigned)(sr * DV + sc) * 2u, kgo = (unsigned)(kr * DQK + kc) * 2u, pgo = (unsigned)(tid & 63) * 4u; asm volatile("" : "+v"(vgo), "+v"(kgo), "+v"(pgo));
    const int vb0 = (int)(uintptr_t)V_lds + v_rd_base(lane);
    int ka[4]; k_bases(ka, K_lds, r32, hi);
    bf16x8 vs0, vs1, ks0; int ps;
#define FP_LOADV(t) do { unsigned kk_ = (unsigned)__builtin_amdgcn_readfirstlane((int)((t) * KVBLK)); asm volatile("" : "+s"(kk_)); const bf16* Vt_ = Vh + (size_t)kk_ * DV; \
    vs0 = ldg<bf16x8>(Vt_, vgo); vs1 = ldg<bf16x8>(Vt_ + 32 * DV, vgo); } while (0)
#define FP_LOADK(t) do { unsigned kk_ = (unsigned)__builtin_amdgcn_readfirstlane((int)((t) * KVBLK)); asm volatile("" : "+s"(kk_)); ks0 = ldg<bf16x8>(Kh + (size_t)kk_ * DQK, kgo); ps = ldg<int>(posb + kk_, pgo); } while (0)
#define FP_WRITEV(b) do { *(LAS bf16x8*)(V_lds + (b) * SHM_V + vst0) = vs0; *(LAS bf16x8*)(V_lds + (b) * SHM_V + vst1) = vs1; } while (0)
#define FP_WRITEK(b) do { *(LAS bf16x8*)(K_lds + (b) * SHM_K + kst) = ks0; B_lds[(b) * 512 + tid] = slope2 * (float)(ps - cw); if (tid < 64) P_lds[(b) * 64 + tid] = (float)ps; } while (0)
#define FP_BINIT(x0, x1, b) do { const LAS float* bl_ = B_lds + (b) * 512 + wid * 64 + 4 * hi; \
    _Pragma("unroll") for (int g = 0; g < 4; ++g) { const f32x4 k0 = *(const LAS f32x4*)(bl_ + 8 * g), k1 = *(const LAS f32x4*)(bl_ + 32 + 8 * g); \
        _Pragma("unroll") for (int e = 0; e < 4; ++e) { x0[4 * g + e] = k0[e]; x1[4 * g + e] = k1[e]; } } } while (0)
#define FP_QK(x0, x1, t, b) do { if ((t) < NT - 4) { FP_BINIT(x0, x1, b); qkt<DQK, false>(x0, x1, K_lds + (b) * SHM_K, qr, r32, hi); } \
    else { _Pragma("unroll") for (int r = 0; r < 16; ++r) { x0[r] = dl; x1[r] = dl; } qkt<DQK, false>(x0, x1, K_lds + (b) * SHM_K, qr, r32, hi); fixup<true>(x0, x1, P_lds + (b) * 64, posq, slope2, false, hi); } } while (0)
    f32x16 c0, c1;
    {
        FP_LOADV(T0); FP_LOADK(T0);
        bf16x8 vB0, vB1, kB; int pB;
        { unsigned kk_ = (unsigned)__builtin_amdgcn_readfirstlane((int)((T0 + 1) * KVBLK)); asm volatile("" : "+s"(kk_)); const bf16* Vt_ = Vh + (size_t)kk_ * DV;
          vB0 = ldg<bf16x8>(Vt_, vgo); vB1 = ldg<bf16x8>(Vt_ + 32 * DV, vgo); kB = ldg<bf16x8>(Kh + (size_t)kk_ * DQK, kgo); pB = ldg<int>(posb + kk_, pgo); }
        FP_WRITEV(0); FP_WRITEK(0);
        *(LAS bf16x8*)(V_lds + SHM_V + vst0) = vB0; *(LAS bf16x8*)(V_lds + SHM_V + vst1) = vB1; *(LAS bf16x8*)(K_lds + SHM_K + kst) = kB;
        B_lds[512 + tid] = slope2 * (float)(pB - cw); if (tid < 64) P_lds[64 + tid] = (float)pB;
        FP_LOADK(T0 + 2); FP_LOADV(T0 + 2);
        __syncthreads();
        FP_QK(c0, c1, T0, 0);
        __syncthreads();
        FP_WRITEK(0); FP_LOADK(T0 + 3);
    }
    int s = T0;
    for (; s <= NT - 6; ++s) {
        const int b = s & 1, nb = b ^ 1, kof = nb * SHM_K;
        f32x16 n0, n1; bf16x8 pa0, pa1, pa2, pa3;
        FP_BINIT(n0, n1, nb);
        const bf16x8 a0 = k_read<0>(ka[0] + kof), b0 = k_read<4096>(ka[0] + kof), a1 = k_read<0>(ka[1] + kof), b1 = k_read<4096>(ka[1] + kof);
        const bf16x8 a2 = k_read<0>(ka[2] + kof), b2 = k_read<4096>(ka[2] + kof), a3 = k_read<0>(ka[3] + kof), b3 = k_read<4096>(ka[3] + kof);
        float sa = 0.f, sb = 0.f;
#define FP_SM(d) do { _Pragma("unroll") for (int r = 4 * (d); r < 4 * (d) + 4; ++r) { c0[r] = __builtin_amdgcn_exp2f(c0[r]); c1[r] = __builtin_amdgcn_exp2f(c1[r]); sa += c0[r]; sb += c1[r]; } } while (0)
        FA_LGK(6); FA_SBAR(); n0 = __builtin_amdgcn_mfma_f32_32x32x16_bf16(a0, qr[0], n0, 0, 0, 0); n1 = __builtin_amdgcn_mfma_f32_32x32x16_bf16(b0, qr[0], n1, 0, 0, 0); FP_SM(0); FA_SBAR();
        FA_LGK(4); FA_SBAR(); n0 = __builtin_amdgcn_mfma_f32_32x32x16_bf16(a1, qr[1], n0, 0, 0, 0); n1 = __builtin_amdgcn_mfma_f32_32x32x16_bf16(b1, qr[1], n1, 0, 0, 0); FP_SM(1); FA_SBAR();
        FA_LGK(2); FA_SBAR(); n0 = __builtin_amdgcn_mfma_f32_32x32x16_bf16(a2, qr[2], n0, 0, 0, 0); n1 = __builtin_amdgcn_mfma_f32_32x32x16_bf16(b2, qr[2], n1, 0, 0, 0); FP_SM(2); FA_SBAR();
        FA_LGK(0); FA_SBAR(); n0 = __builtin_amdgcn_mfma_f32_32x32x16_bf16(a3, qr[3], n0, 0, 0, 0); n1 = __builtin_amdgcn_mfma_f32_32x32x16_bf16(b3, qr[3], n1, 0, 0, 0); FP_SM(3); FA_SBAR();
#undef FP_SM
        l_reg += sa + sb;
        typedef unsigned u32x4_t __attribute__((ext_vector_type(4)));
#define FA_PKS(P, BASE, OUT) do { u32x4_t w = {cvtpk(P[BASE + 0], P[BASE + 1]), cvtpk(P[BASE + 2], P[BASE + 3]), cvtpk(P[BASE + 4], P[BASE + 5]), cvtpk(P[BASE + 6], P[BASE + 7])}; OUT = __builtin_bit_cast(bf16x8, w); } while (0)
        FA_PKS(c0, 0, pa0); FA_PKS(c0, 8, pa1); FA_PKS(c1, 0, pa2); FA_PKS(c1, 8, pa3);
#undef FA_PKS
        FA_SBAR();
        pv_d0_pipe(o, vb0 + b * SHM_V, pa0, pa1, pa2, pa3);
        __syncthreads();
        FP_WRITEV(b); FP_WRITEK(nb); FP_LOADV(s + 3); FP_LOADK(s + 4);
        c0 = n0; c1 = n1;
    }
    for (; s < NT; ++s) {
        const int b = s & 1, nb = b ^ 1;
        f32x16 n0 = f32x16{}, n1 = f32x16{};
        if (s + 1 < NT && s + 1 <= tmax) FP_QK(n0, n1, s + 1, nb);
        if (s <= tmax) { bf16x8 pa0, pa1, pa2, pa3; fr_softmax(c0, c1, l_reg, pa0, pa1, pa2, pa3); FA_SBAR(); pv_d0_pipe(o, vb0 + b * SHM_V, pa0, pa1, pa2, pa3); }
        __syncthreads();
        if (s + 2 < NT) FP_WRITEV(b);
        if (s + 3 < NT) { FP_WRITEK(nb); FP_LOADV(s + 3); }
        if (s + 4 < NT) FP_LOADK(s + 4);
        c0 = n0; c1 = n1;
    }
    { auto rr = __builtin_amdgcn_permlane32_swap(__float_as_uint(l_reg), __float_as_uint(l_reg), false, false); l_reg = __uint_as_float(rr[0]) + __uint_as_float(rr[1]); }
    __builtin_amdgcn_s_setprio(0);
    l_out = l_reg;
#undef FP_LOADV
#undef FP_LOADK
#undef FP_WRITEV
#undef FP_WRITEK
#undef FP_BINIT
#undef FP_QK
}
}

constexpr int CW_BAR = 4096;
constexpr int CW_Q = 8192;
__device__ __forceinline__ int next_unit(Frame& F, unsigned* ctr) {
    LAS unsigned* uq = (LAS unsigned*)(F.lds + LDSCTL_OFF + 16);
    __syncthreads();
    if (F.tid == 0) *uq = atomicAdd(ctr, 1u);
    __syncthreads();
    return __builtin_amdgcn_readfirstlane((int)*uq);
}
template <int MODE = 0> __device__ __forceinline__ void ph_attn_da(Frame& F, int l, int rep = 0) {
    const bf16 *QD = WSP(bf16, WS_QD), *KD = WSP(bf16, WS_KD), *VD = WSP(bf16, WS_VD);
    bf16* MIX = rep == 2 ? WSP(bf16, WS_U) : WSP(bf16, WS_MIX); float* O1 = WSP(float, WS_O1);
    const int lane = F.lane;
    LAS float* al = (LAS float*)(F.lds + fa::Lds<64>::WS_OFF) + F.wave * 64;
    const float s1 = wave_sum(FIN(I_LQ1)[l * 64 + lane] * FIN(I_LK1)[l * 64 + lane]);
    const float s2 = wave_sum(FIN(I_LQ2)[l * 64 + lane] * FIN(I_LK2)[l * 64 + lane]);
    const float lam_init = __int_as_float(__builtin_amdgcn_readfirstlane(__float_as_int(LAM_INIT[l])));
    const float lam = __int_as_float(__builtin_amdgcn_readfirstlane(__float_as_int(expf(s1) - expf(s2) + lam_init)));
    float gqm = fabsf(FIN(I_DAQG)[l * 64 + lane]), gkm = fabsf(FIN(I_DAKG)[l * 64 + lane]);
    gqm = wave_max(gqm); gkm = wave_max(gkm);
    const float bound = __int_as_float(__builtin_amdgcn_readfirstlane(__float_as_int(1.01f * 11.5416f * gqm * gkm)));
    const float reach = __int_as_float(__builtin_amdgcn_readfirstlane(__float_as_int(2.0f * bound + 160.0f)));
    if ((MODE == 5) != (bound < 40.0f)) return;
    const int* posmm = WSP(int, WS_POSMM);
    unsigned* ctr = (unsigned*)(F.ws + WS_CTL) + (rep == 2 ? 20000 + 64 * (l * 2) : CW_Q + 64 * 8 * (l * 4 + 0 + rep));
    for (;;) {
        const int u = next_unit(F, ctr); if (u >= 384) break;
        const int qb = 31 - u / 12, bh = u % 12, b = bh / NH, h = bh % NH, q0 = qb * 256, NT = q0 / 64 + 4;
        const int* posb = F.pos + b * SEQ;
        const float slope2 = __int_as_float(__builtin_amdgcn_readfirstlane(__float_as_int(ALIBI_SLOPE[h] * LOG2E)));
        const size_t orow = (size_t)(b * SEQ + q0 + F.wave * 32);
        int T0 = 0, TL = 0; bool lin = false;
        { const int* qm = posmm + (size_t)(b * 128 + qb * 4) * 2; int qmin = qm[0], qmax = qm[1];
#pragma unroll
          for (int c = 1; c < 4; ++c) { qmin = qm[2 * c] < qmin ? qm[2 * c] : qmin; qmax = qm[2 * c + 1] > qmax ? qm[2 * c + 1] : qmax; }
          const int* km = posmm + (size_t)(b * 128) * 2;
          for (; T0 < NT - 4; ++T0) { const int kmin = km[2 * T0], kmax = km[2 * T0 + 1]; int dmin = qmin - kmax; if (kmin - qmax > dmin) dmin = kmin - qmax; if (dmin < 0) dmin = 0;
              if (!(slope2 * (float)dmin > reach)) break; }
          T0 &= ~1;
          for (TL = T0; TL < NT; ++TL) if (km[2 * TL + 1] > qmin) break;
          if (TL < NT - 4) TL = T0;
          int span = qm[1] - qm[0];
#pragma unroll
          for (int c = 1; c < 4; ++c) { const int sp = qm[2 * c + 1] - qm[2 * c]; span = sp > span ? sp : span; }
          lin = TL >= NT - 4 && slope2 * (float)span <= 24.0f;
        }
        for (int mp = 0; mp < 2; ++mp) {
            f32x16 o[4]; float l1;
            const bf16* Qp = QD + ((size_t)(bh * 2 + mp) * SEQ + q0) * 64; const int bhk = rep == 2 ? 0 : bh; const bf16* Kp = KD + (size_t)(bhk * 2 + mp) * SEQ * 64; const bf16* Vp = VD + (size_t)bhk * SEQ * 128;
            if (MODE == 5 && lin) { const int cw = posmm[(size_t)(b * 128 + qb * 4 + (__builtin_amdgcn_readfirstlane(F.tid >> 6) >> 1)) * 2];
                fa::attn_pass_da5p(Qp, Kp, Vp, posb, slope2, cw, q0, T0, NT, F.lds, F.tid, o, l1); }
            else fa::attn_pass<64, true, 1, MODE>(Qp, Kp, Vp, posb, slope2, bound, TL, q0, T0, NT, F.lds, F.tid, o, l1);
            int le_; asm volatile("v_mbcnt_lo_u32_b32 %0, -1, 0\n\tv_mbcnt_hi_u32_b32 %0, -1, %0" : "=v"(le_)); const int r32 = le_ & 31, hi = le_ >> 5;
            float f[16];
            if (mp == 0) {
                fa::row_bcast(1.0f / l1, al, r32, hi, f);
                unsigned lo = (unsigned)(((u * 8 + F.wave) * 8) * 64 + le_) * 16u; asm volatile("" : "+v"(lo));
#pragma unroll
                for (int j = 0; j < 8; ++j) { const int d = j >> 1, rb = (j & 1) * 8; v4u w;
                    w.x = pg8::pkh2(o[d][rb + 0] * f[rb + 0], o[d][rb + 1] * f[rb + 1]); w.y = pg8::pkh2(o[d][rb + 2] * f[rb + 2], o[d][rb + 3] * f[rb + 3]);
                    w.z = pg8::pkh2(o[d][rb + 4] * f[rb + 4], o[d][rb + 5] * f[rb + 5]); w.w = pg8::pkh2(o[d][rb + 6] * f[rb + 6], o[d][rb + 7] * f[rb + 7]);
                    fa::stg<v4u>(O1, lo + j * 1024, w); }
            } else {
                fa::row_bcast(lam / l1, al, r32, hi, f);
                const float* hg = FIN(I_DAHG) + (size_t)l * 768 + h * 128;
                float hgv[4];
#pragma unroll
                for (int d = 0; d < 4; ++d) hgv[d] = fa::ldg<float>(hg + d * 32, (unsigned)r32 * 4u) * (1.0f - lam_init);
                unsigned lo = (unsigned)(((u * 8 + F.wave) * 8) * 64 + le_) * 16u; asm volatile("" : "+v"(lo));
                bf16* mb = MIX + orow * D + h * 128; unsigned mo = (unsigned)(4 * hi * D + r32) * 2u; asm volatile("" : "+v"(mo));
                v4u w1[8];
#pragma unroll
                for (int j = 0; j < 8; ++j) w1[j] = fa::ldg<v4u>(O1, lo + j * 1024);
#pragma unroll
                for (int j = 0; j < 8; ++j) { const int d = j >> 1, rb = (j & 1) * 8; const unsigned ww[4] = {w1[j].x, w1[j].y, w1[j].z, w1[j].w};
#pragma unroll
                    for (int q = 0; q < 4; ++q) { o[d][rb + 2 * q] = pg8::uph_lo(ww[q]) - o[d][rb + 2 * q] * f[rb + 2 * q]; o[d][rb + 2 * q + 1] = pg8::uph_hi(ww[q]) - o[d][rb + 2 * q + 1] * f[rb + 2 * q + 1]; } }
#pragma unroll
                for (int r2 = 0; r2 < 16; ++r2) {
                    float ss = 0.f;
#pragma unroll
                    for (int d = 0; d < 4; ++d) ss += o[d][r2] * o[d][r2];
                    ss = sum32(ss);
                    const float rn = rsqrtf(ss * (1.f / 128) + EPS);
#pragma unroll
                    for (int d = 0; d < 4; ++d) fa::stg<bf16>(mb, mo + (fa::crowc(r2) * D + d * 32) * 2, (bf16)f2bf(o[d][r2] * rn * hgv[d]));
                }
            }
        }
    }
}
template <int MODE> __device__ __forceinline__ void ph_attn_mla(Frame& F, int l, int rep = 0) {
    const bf16 *QM = WSP(bf16, WS_QM), *KM = WSP(bf16, WS_KM), *VM = WSP(bf16, WS_VM);
    bf16* MIX = rep >= 2 ? WSP(bf16, WS_U) : WSP(bf16, WS_MIX);
    const int lane = F.lane;
    LAS float* al = (LAS float*)(F.lds + fa::Lds<192>::WS_OFF) + F.wave * 64;
    float gqm = fmaxf(fmaxf(fabsf(FIN(I_MQG)[l * 192 + lane]), fabsf(FIN(I_MQG)[l * 192 + 64 + lane])), fabsf(FIN(I_MQG)[l * 192 + 128 + lane]));
    float gkm = fmaxf(fmaxf(fabsf(FIN(I_MKG)[l * 192 + lane]), fabsf(FIN(I_MKG)[l * 192 + 64 + lane])), fabsf(FIN(I_MKG)[l * 192 + 128 + lane]));
    gqm = wave_max(gqm); gkm = wave_max(gkm);
    const float bound = __int_as_float(__builtin_amdgcn_readfirstlane(__float_as_int(1.01f * 19.9907f * gqm * gkm)));
    if ((MODE == 5) != (bound < 60.0f)) return;
    unsigned* ctr = (unsigned*)(F.ws + WS_CTL) + (rep >= 2 ? 20000 + 64 * (l * 2 + 1) : CW_Q + 64 * 8 * (l * 4 + 2 + rep));
    for (;;) {
        const int u = next_unit(F, ctr); if (u >= 384) break;
        const int qb = 31 - u / 12, bh = u % 12, b = bh / NH, h = bh % NH, q0 = qb * 256, NT = q0 / 64 + 4;
        const size_t orow = (size_t)(b * SEQ + q0 + F.wave * 32);
        f32x16 o[4]; float l1;
        const int bhk = rep == 2 ? 0 : bh;
#if defined(PROBE_VAR)
        if (rep == 3) fa::attn_pass<192, false, 1, MODE, PROBE_VAR>(QM + ((size_t)bh * SEQ + q0) * 192, KM + (size_t)bhk * SEQ * 192, VM + (size_t)bhk * SEQ * 128, nullptr, 0.f, bound, 0, q0, 0, NT, F.lds, F.tid, o, l1); else
#endif
        fa::attn_pass<192, false, 1, MODE>(QM + ((size_t)bh * SEQ + q0) * 192, KM + (size_t)bhk * SEQ * 192, VM + (size_t)bhk * SEQ * 128, nullptr, 0.f, bound, 0, q0, 0, NT, F.lds, F.tid, o, l1);
        int le_; asm volatile("v_mbcnt_lo_u32_b32 %0, -1, 0\n\tv_mbcnt_hi_u32_b32 %0, -1, %0" : "=v"(le_)); const int r32 = le_ & 31, hi = le_ >> 5;
        float f[16]; fa::row_bcast(1.0f / l1, al, r32, hi, f);
        bf16* mb = MIX + orow * D + 768 + h * 128; unsigned mo = (unsigned)(4 * hi * D + r32) * 2u; asm volatile("" : "+v"(mo));
#pragma unroll
        for (int r2 = 0; r2 < 16; ++r2)
#pragma unroll
            for (int d = 0; d < 4; ++d) fa::stg<bf16>(mb, mo + (fa::crowc(r2) * D + d * 32) * 2, (bf16)f2bf(o[d][r2] * f[r2]));
    }
}
__device__ __forceinline__ void ph_sgu(Frame& F, int l, int rep = 0) {
    const float* UU = WSP(float, WS_UU); const bf16* GV = WSP(bf16, WS_GV); const float* SSQ = WSP(float, WS_SSQ_SGV); bf16* MIX = WSP(bf16, WS_MIX);
    LAS unsigned short* vs = (LAS unsigned short*)F.lds;
    LAS float* rs = (LAS float*)(F.lds + 128 * 128 * 2);
    const int lane = F.lane, r32 = lane & 31, hi = lane >> 5, tm = F.wave >> 1, tn0 = (F.wave & 1) * 2;
    __syncthreads();
    unsigned* sctr = (unsigned*)(F.ws + WS_CTL) + CW_Q + 64 * 8 * 16 + 64 * (l + 4 * rep);
    LAS float* wl = rs + 128;
    for (;;) { const int u = next_unit(F, sctr); if (u >= 512) break;
        const int g = u & 3, row0 = (u >> 2) * 128;
        const int t = 32 * tm + r32;
        const float* bias = FIN(I_SGB) + (l * 4 + g) * 128 + 32 * tm;
        const int c0 = g * 128 + 32 * tn0 + r32;
        float uu0[16], uu1[16], bvv[16];
#pragma unroll
        for (int r = 0; r < 16; ++r) { const int tt = crow(r, hi); const size_t row = (size_t)(row0 + 32 * tm + tt); uu0[r] = UU[row * 512 + c0]; uu1[r] = UU[row * 512 + c0 + 32]; bvv[r] = bias[tt]; }
        { const float* wb = FIN(I_SGW) + (size_t)(l * 4 + g) * 128 * 128;
          f32x4 wv_[8];
#pragma unroll
          for (int k = 0; k < 8; ++k) wv_[k] = *(const f32x4*)(wb + (size_t)(F.tid + k * NTHREADS) * 4);
#pragma unroll
          for (int k = 0; k < 8; ++k) { const int e = (F.tid + k * NTHREADS) * 4, tr = e >> 7, sc_ = e & 127; *(LAS f32x4*)(wl + tr * 132 + sc_) = wv_[k]; } }
        for (int i = F.tid; i < 128 * 16; i += NTHREADS) { const int s = i >> 4, c8 = i & 15; *(LAS bf16x8*)(vs + s * 128 + c8 * 8) = *(const bf16x8*)(GV + (size_t)(row0 + s) * 512 + g * 128 + c8 * 8); }
        if (F.tid < 128) { const f32x4 p = *(const f32x4*)(SSQ + (size_t)(row0 + F.tid) * 16 + g * 4); rs[F.tid] = rsqrtf(((p.x + p.y) + (p.z + p.w)) * (1.f / 128) + EPS); }
        __syncthreads();
        f32x16 acc0 = f32x16{}, acc1 = f32x16{};
        const LAS float* wrow = wl + t * 132;
        for (int ks = 0; ks < 2 * (tm + 1); ++ks) {
            const int s0 = 16 * ks + 8 * hi;
            const f32x4 w0 = *(const LAS f32x4*)(wrow + s0), w1 = *(const LAS f32x4*)(wrow + s0 + 4);
            float wv[8] = {w0.x, w0.y, w0.z, w0.w, w1.x, w1.y, w1.z, w1.w};
            bf16x8 af, b0, b1;
#pragma unroll
            for (int j = 0; j < 8; ++j) { af[j] = (short)f2bf(s0 + j <= t ? wv[j] * rs[s0 + j] : 0.f);
                b0[j] = (short)vs[(s0 + j) * 128 + 32 * tn0 + r32]; b1[j] = (short)vs[(s0 + j) * 128 + 32 * (tn0 + 1) + r32]; }
            acc0 = __builtin_amdgcn_mfma_f32_32x32x16_bf16(af, b0, acc0, 0, 0, 0);
            acc1 = __builtin_amdgcn_mfma_f32_32x32x16_bf16(af, b1, acc1, 0, 0, 0);
        }
#pragma unroll
        for (int r = 0; r < 16; ++r) { const int tt = crow(r, hi); const size_t row = (size_t)(row0 + 32 * tm + tt);
            MIX[row * D + 1536 + c0] = (bf16)f2bf(uu0[r] * (acc0[r] + bvv[r]));
            MIX[row * D + 1536 + c0 + 32] = (bf16)f2bf(uu1[r] * (acc1[r] + bvv[r])); }
        __syncthreads();
    }
}
__device__ __forceinline__ void ph_convfix(Frame& F, int l) {
    const float* EDGE = WSP(float, WS_EDGE); bf16* U = WSP(bf16, WS_U);
    const float* cw = FIN(I_CONVW) + (size_t)l * 3 * NUP; const float* cb = FIN(I_CONVB) + (size_t)l * NUP;
    const int gt = F.bid * NTHREADS + F.tid, nt = F.G * NTHREADS;
    constexpr int NIT = (M / 64) * 2 * (DFF / 4);
    auto item = [&](int i, unsigned long long& pk, size_t& dst) {
        const int ch = (i % (DFF / 4)) * 4, r = (i / (DFF / 4)) & 1, blk = i / (2 * (DFF / 4)); const bool first = (blk % (SEQ / 64)) == 0;
        f32x4 y[2];
#pragma unroll
        for (int bj = 0; bj < 2; ++bj) {
            const float* e0 = EDGE + ((size_t)(blk * 4) * 2 + bj) * DFF + ch;
            const f32x4 z = {0.f, 0.f, 0.f, 0.f};
            const f32x4 a0 = *(const f32x4*)(e0 + (size_t)r * 2 * DFF);
            const f32x4 a1 = r == 1 ? *(const f32x4*)e0 : (first ? z : *(const f32x4*)(e0 - (size_t)1 * 2 * DFF));
            const f32x4 a2 = first ? z : (r == 1 ? *(const f32x4*)(e0 - (size_t)1 * 2 * DFF) : *(const f32x4*)(e0 - (size_t)2 * 2 * DFF));
            y[bj] = *(const f32x4*)(cb + bj * DFF + ch) + *(const f32x4*)(cw + (size_t)2 * NUP + bj * DFF + ch) * a0 + *(const f32x4*)(cw + (size_t)NUP + bj * DFF + ch) * a1 + *(const f32x4*)(cw + bj * DFF + ch) * a2; }
        float o[4];
#pragma unroll
        for (int e = 0; e < 4; ++e) { const float g = y[0][e]; o[e] = g * __builtin_amdgcn_rcpf(1.0f + __expf(-g)) * y[1][e]; }
        pk = (unsigned long long)pk2(o[0], o[1]) | ((unsigned long long)pk2(o[2], o[3]) << 32); dst = (size_t)(blk * 64 + r) * DFF + ch; };
    for (int i = gt; i < NIT; i += 3 * nt) {
        unsigned long long p0 = 0, p1 = 0, p2 = 0; size_t d0 = 0, d1 = 0, d2 = 0;
        const bool h1 = i + nt < NIT, h2 = i + 2 * nt < NIT;
        item(i, p0, d0); if (h1) item(i + nt, p1, d1); if (h2) item(i + 2 * nt, p2, d2);
        *(unsigned long long*)(U + d0) = p0; if (h1) *(unsigned long long*)(U + d1) = p1; if (h2) *(unsigned long long*)(U + d2) = p2; }
}

__device__ __forceinline__ void ph_krope(Frame& F, int l) {
    const bf16* H = WSP(bf16, WS_H); const bf16* Wk = wptr(F, l, WL_IN) + (size_t)4096 * D; float* KR = WSP(float, WS_KR); float* SSQ = WSP(float, WS_SSQ_KR);
    constexpr int PITCH = 1024;
    LAS unsigned char* As = F.lds; LAS unsigned char* Bs = F.lds + 64 * PITCH;
    LAS float* red = (LAS float*)F.lds;
    const int lane = F.lane, r32 = lane & 31, hi = lane >> 5, w = F.wave;
    __syncthreads();
    for (int tb = F.bid; tb < M / 64; tb += F.G) {
        f32x16 acc[2][2];
#pragma unroll
        for (int i = 0; i < 2; ++i)
#pragma unroll
            for (int j = 0; j < 2; ++j) acc[i][j] = f32x16{};
        for (int kc = 0; kc < 4; ++kc) {
#pragma unroll
            for (int p = 0; p < 8; ++p) { const int q = p * NTHREADS + F.tid, row = q >> 6, c16 = q & 63;
                *(LAS v4u*)(As + row * PITCH + (c16 ^ (row & 7)) * 16) = *(const v4u*)(H + (size_t)(tb * 64 + row) * D + kc * 512 + c16 * 8);
                *(LAS v4u*)(Bs + row * PITCH + (c16 ^ (row & 7)) * 16) = *(const v4u*)(Wk + (size_t)row * D + kc * 512 + c16 * 8); }
            __syncthreads();
#pragma unroll
            for (int ks = 0; ks < 4; ++ks) { const int ko = (((w * 64 + ks * 16 + hi * 8) >> 3) ^ (r32 & 7)) * 16;
                const bf16x8 A0 = *(const LAS bf16x8*)(As + r32 * PITCH + ko), A1 = *(const LAS bf16x8*)(As + (32 + r32) * PITCH + ko);
                const bf16x8 B0 = *(const LAS bf16x8*)(Bs + r32 * PITCH + ko), B1 = *(const LAS bf16x8*)(Bs + (32 + r32) * PITCH + ko);
                acc[0][0] = __builtin_amdgcn_mfma_f32_32x32x16_bf16(A0, B0, acc[0][0], 0, 0, 0); acc[0][1] = __builtin_amdgcn_mfma_f32_32x32x16_bf16(A0, B1, acc[0][1], 0, 0, 0);
                acc[1][0] = __builtin_amdgcn_mfma_f32_32x32x16_bf16(A1, B0, acc[1][0], 0, 0, 0); acc[1][1] = __builtin_amdgcn_mfma_f32_32x32x16_bf16(A1, B1, acc[1][1], 0, 0, 0); }
            __syncthreads();
        }
#pragma unroll
        for (int i = 0; i < 2; ++i)
#pragma unroll
            for (int j = 0; j < 2; ++j)
#pragma unroll
                for (int r = 0; r < 16; ++r) red[(w * 64 + (i * 2 + j) * 16 + r) * 64 + lane] = acc[i][j][r];
        __syncthreads();
#pragma unroll
        for (int c = 0; c < 8; ++c) { const int cb = w * 8 + c, i = cb >> 5, j = (cb >> 4) & 1, r = cb & 15;
            float v = 0.f;
#pragma unroll
            for (int ww = 0; ww < 8; ++ww) v += red[(ww * 64 + cb) * 64 + lane];
            const int row = tb * 64 + 32 * i + crow(r, hi);
            KR[(size_t)row * 64 + 32 * j + r32] = v;
            const float ss = sum32(v * v);
            if (r32 == 0) SSQ[(size_t)row * 2 + j] = ss; }
        __syncthreads();
    }
}
__device__ __forceinline__ void frame_init(Frame& F, const Args& a, unsigned char* lds) {
    F.lds = (LAS unsigned char*)lds; F.tid = threadIdx.x; F.lane = F.tid & 63; F.wave = __builtin_amdgcn_readfirstlane(F.tid >> 6); F.wave0 = F.wave;
    F.bid = blockIdx.x; F.G = gridDim.x; F.gw = F.bid * NWAVES + F.wave; F.ngw = F.G * NWAVES;
    F.ka = (const __attribute__((address_space(4))) Args*)__builtin_amdgcn_kernarg_segment_ptr();
    F.pos = (const int*)a.in[I_POS]; F.out = a.out; F.ws = a.ws;
}
__device__ __forceinline__ void frame_retid(Frame& F) {
    int lane; asm volatile("v_mbcnt_lo_u32_b32 %0, -1, 0\n\tv_mbcnt_hi_u32_b32 %0, -1, %0" : "=v"(lane));
    int w = F.wave0; asm volatile("" : "+s"(w));
    F.lane = lane; F.wave = w; F.tid = w * 64 + lane;
    int bid = blockIdx.x, G = gridDim.x; asm volatile("" : "+s"(bid)); asm volatile("" : "+s"(G)); F.bid = bid; F.G = G;
    F.gw = bid * NWAVES + F.wave; F.ngw = G * NWAVES;
}
__device__ __forceinline__ void grid_bar(const XcdBarrier& bar, int wave0) {
    int lane_; asm volatile("v_mbcnt_lo_u32_b32 %0, -1, 0\n\tv_mbcnt_hi_u32_b32 %0, -1, %0" : "=v"(lane_)); const bool leader = (wave0 == 0) && (lane_ == 0);
    XcdBarrier b2 = bar; unsigned z_ = 0u; asm volatile("" : "+s"(b2.x), "+s"(z_)); b2.bar = bar.bar + z_; xcd_barrier(b2, leader); }
template <int PH> __device__ __forceinline__ void run_phase(Frame& F, int l) {
    frame_retid(F); asm volatile("; PHASE_BEGIN %0" :: "n"(PH));
    const float* mod = WSP(float, WS_MOD) + (size_t)l * 12 * D;
    if constexpr (PH == 0) ph_prologue(F);
    if constexpr (PH == 1) ph_modreduce(F);
    if constexpr (PH == 2) { if (l == 0) ph_norm<false>(F, l, FIN(I_X), 0, D); else ph_norm<true>(F, l, WSP(bf16, WS_XB), 0, D); }
    if constexpr (PH == 3) { pg8::Gemm g{WSP(bf16, WS_H), wptr(F, l, WL_IN), M, 4096, D}; pg8::StaticOrder S; S.init(M, 4096, F.G, F.bid);
        pg8::EpiInProj E{WSP(bf16, WS_QD), WSP(bf16, WS_KD), WSP(bf16, WS_VD), WSP(bf16, WS_QA), WSP(bf16, WS_KVA), WSP(bf16, WS_GV), WSP(float, WS_UU), WSP(float, WS_KR),
                         WSP(float, WS_SSQ_QA), WSP(float, WS_SSQ_KVA), WSP(float, WS_SSQ_SGV), WSP(float, WS_SSQ_KR), FIN(I_DAQG) + l * 64, FIN(I_DAKG) + l * 64, FIN(I_QAG) + l * 512, FIN(I_KVAG) + l * 256, FIN(I_SGVG) + l * 512};
        pg8::gemm_phase<pg8::EpiInProj, pg8::StaticOrder, true, true>(F.lds, g, S, E, F.tid); frame_retid(F); ph_krope(F, l); }
    if constexpr (PH == 5) {
        PG8_LAS float* X = (PG8_LAS float*)(F.lds + LDSCTL_OFF + 1024);
        { pg8::Gemm g{WSP(bf16, WS_QA), wptr(F, l, WL_UQ), M, UQ_PAD, QRANK}; pg8::StaticOrder S; S.init(M, UQ_PAD, F.G, F.bid);
          pg8::EpiMlaQ E{WSP(bf16, WS_QM), WSP(float, WS_SSQ_QA), WSP(float, WS_COS), WSP(float, WS_SIN), FIN(I_MQG) + l * 192, X};
          pg8::gemm_phase<pg8::EpiMlaQ, pg8::StaticOrder, true, true>(F.lds, g, S, E, F.tid); }
        __syncthreads(); frame_retid(F);
        { pg8::Gemm g{WSP(bf16, WS_KVA), wptr(F, l, WL_UKV), M, UKV_N, KVRANK}; pg8::StaticOrder S; S.init(M, UKV_N, F.G, F.G - 1 - F.bid);
          pg8::EpiMlaKV E{WSP(bf16, WS_KM), WSP(bf16, WS_VM), WSP(float, WS_SSQ_KVA), WSP(float, WS_SSQ_KR), WSP(float, WS_KR), WSP(float, WS_COS), WSP(float, WS_SIN), FIN(I_MKG) + l * 192, X};
          pg8::gemm_phase<pg8::EpiMlaKV, pg8::StaticOrder, true, true>(F.lds, g, S, E, F.tid); }
    }
    if constexpr (PH == 7) { ph_attn_da<5>(F, l); frame_retid(F); ph_attn_da<0>(F, l); frame_retid(F); asm volatile("; PHASE_BEGIN 71"); ph_attn_mla<5>(F, l); frame_retid(F); ph_attn_mla<0>(F, l); frame_retid(F); asm volatile("; PHASE_BEGIN 72"); ph_sgu(F, l); }
    if constexpr (PH == 8) { pg8::Gemm g{WSP(bf16, WS_MIX), wptr(F, l, WL_OUT), M, D, D}; pg8::StaticOrder S; S.init(M, D, F.G, F.bid);
        pg8::EpiResidP E{l == 0 ? (const void*)FIN(I_X) : (const void*)WSP(bf16, WS_XB), WSP(bf16, WS_XB), l != 0, 1, mod + 2 * D, 6 * D}; pg8::gemm_phase<pg8::EpiResidP, pg8::StaticOrder, true, true>(F.lds, g, S, E, F.tid); }
    if constexpr (PH == 9) ph_norm<true>(F, l, WSP(bf16, WS_XB), 3 * D, 4 * D);
    if constexpr (PH == 10) { pg8::Gemm g{WSP(bf16, WS_H), wptr(F, l, WL_UP), M, NUP, D}; pg8::StaticOrder S; S.init(M, NUP, F.G, F.bid);
        pg8::EpiConvGate E{WSP(bf16, WS_U), WSP(float, WS_EDGE), FIN(I_CONVW) + (size_t)l * 3 * NUP, FIN(I_CONVB) + (size_t)l * NUP}; pg8::gemm_phase<pg8::EpiConvGate, pg8::StaticOrder, true, true>(F.lds, g, S, E, F.tid); }
    if constexpr (PH == 11) ph_convfix(F, l);
    if constexpr (PH == 12) { pg8::Gemm g{WSP(bf16, WS_U), wptr(F, l, WL_DOWN), M, D, DFF}; pg8::StaticOrder S; S.init(M, D, F.G, F.bid);
        pg8::EpiResidP E{WSP(bf16, WS_XB), l + 1 < DEPTH ? (void*)WSP(bf16, WS_XB) : (void*)F.out, 1, l + 1 < DEPTH, mod + 5 * D, 6 * D}; pg8::gemm_phase<pg8::EpiResidP, pg8::StaticOrder, true, true>(F.lds, g, S, E, F.tid); }
}
__global__ void __launch_bounds__(NTHREADS, 2) mega_fwd(Args a) {
    extern __shared__ __attribute__((aligned(16))) unsigned char lds[];
    Frame F; frame_init(F, a, lds);
    if (F.tid < 16) ((LAS unsigned*)(F.lds + LDSCTL_OFF))[F.tid] = 0u;
    __syncthreads();
    XcdBarrier bar = xcd_barrier_post((unsigned*)(F.ws + WS_CTL) + CW_BAR, (volatile LAS unsigned*)(F.lds + LDSCTL_OFF + 32));
    run_phase<0>(F, 0); grid_bar(bar, F.wave0);
#if defined(PROBE_P0)
    run_phase<0>(F, 0); grid_bar(bar, F.wave0);
#endif
    run_phase<1>(F, 0); grid_bar(bar, F.wave0);
    for (int l = 0; l < DEPTH; ++l) {
        run_phase<2>(F, l); grid_bar(bar, F.wave0);
#if defined(PROBE_EW)
        run_phase<2>(F, l); grid_bar(bar, F.wave0);
#endif
        run_phase<3>(F, l); grid_bar(bar, F.wave0);
#if defined(PROBE_GEMM)
        run_phase<3>(F, l); grid_bar(bar, F.wave0);
#endif
        run_phase<5>(F, l); grid_bar(bar, F.wave0);
        run_phase<7>(F, l); grid_bar(bar, F.wave0);
#if defined(PROBE_P7)
        frame_retid(F); ph_attn_da<5>(F, l, 1); frame_retid(F); ph_attn_mla<5>(F, l, 1); grid_bar(bar, F.wave0);
#endif
#if defined(PROBE_LOC)
        frame_retid(F); ph_attn_da<5>(F, l, 2); frame_retid(F); ph_attn_mla<5>(F, l, 2); grid_bar(bar, F.wave0);
#endif
#if defined(PROBE_DA)
        frame_retid(F); ph_attn_da<5>(F, l, 1); grid_bar(bar, F.wave0);
#endif
#if defined(PROBE_VAR)
        frame_retid(F); ph_attn_mla<5>(F, l, 3); grid_bar(bar, F.wave0);
#endif
#if defined(PROBE_MLA)
        frame_retid(F); ph_attn_mla<5>(F, l, 1); grid_bar(bar, F.wave0);
#endif
#if defined(PROBE_SGU)
        frame_retid(F); ph_sgu(F, l, 1); grid_bar(bar, F.wave0);
#endif
        run_phase<8>(F, l); grid_bar(bar, F.wave0);
        run_phase<9>(F, l); grid_bar(bar, F.wave0);
        run_phase<10>(F, l); grid_bar(bar, F.wave0);
#if defined(PROBE_G10)
        frame_retid(F); run_phase<10>(F, l); grid_bar(bar, F.wave0);
#endif
#if defined(PROBE_G10N)
        frame_retid(F); { pg8::Gemm g{WSP(bf16, WS_H), wptr(F, l, WL_UP), M, NUP, D}; pg8::StaticOrder S; S.init(M, NUP, F.G, F.bid);
          pg8::EpiNull E{WSP(float, WS_MIX)}; pg8::gemm_phase<pg8::EpiNull, pg8::StaticOrder, true, true>(F.lds, g, S, E, F.tid); } grid_bar(bar, F.wave0);
#endif
#if defined(PROBE_GEMM)
        run_phase<10>(F, l); grid_bar(bar, F.wave0);
#endif
        run_phase<11>(F, l); grid_bar(bar, F.wave0);
#if defined(PROBE_EW)
        run_phase<11>(F, l); grid_bar(bar, F.wave0);
#endif
        run_phase<12>(F, l); if (l + 1 < DEPTH) grid_bar(bar, F.wave0);
    }
}

extern "C" void kernel_launch(void* const* d_in, const int* in_sizes, int n_in, void* d_out, int out_size, void* d_ws, size_t ws_size, hipStream_t stream) {
    static int grid = 0;
    if (grid == 0) {
        if (n_in != N_IN || in_sizes[0] != M * D || out_size != M * D || ws_size < WS_END) { fprintf(stderr, "kernel_launch: shape mismatch (n_in %d, ws %zu, need %zu)\n", n_in, ws_size, (size_t)WS_END); grid = -1; return; }
        int dev = 0, cus = 0, per_cu = 0;
        if (hipGetDevice(&dev) != hipSuccess || hipDeviceGetAttribute(&cus, hipDeviceAttributeMultiprocessorCount, dev) != hipSuccess) { grid = -1; return; }
        if (hipFuncSetAttribute((const void*)mega_fwd, hipFuncAttributeMaxDynamicSharedMemorySize, LDS_BYTES) != hipSuccess) { fprintf(stderr, "hipFuncSetAttribute failed\n"); grid = -1; return; }
        if (hipOccupancyMaxActiveBlocksPerMultiprocessor(&per_cu, (const void*)mega_fwd, NTHREADS, LDS_BYTES) != hipSuccess || per_cu < 1) fprintf(stderr, "kernel_launch: occupancy query reports %d\n", per_cu);
        (void)hipGetLastError();
        grid = cus > 0 ? cus : 256;
    }
    if (grid < 0) return;
    if (hipMemsetAsync((char*)d_ws + WS_CTL, 0, CTL_ZERO_BYTES, stream) != hipSuccess) { fprintf(stderr, "kernel_launch: memset failed\n"); return; }
    Args a{};
    for (int i = 0; i < N_IN; ++i) a.in[i] = d_in[i];
    a.out = (float*)d_out; a.ws = (unsigned char*)d_ws; a.ph = 0; a.l = 0;
    hipLaunchKernelGGL(mega_fwd, dim3(grid), dim3(NTHREADS), LDS_BYTES, stream, a);
    const hipError_t le = hipPeekAtLastError();
    if (le != hipSuccess) fprintf(stderr, "kernel_launch: launch failed: %s\n", hipGetErrorName(le));
}
```

```cpp
#include <hip/hip_runtime.h>
#include <cstdio>
#include <cstdint>
#include <cmath>
#define GAS __attribute__((address_space(1)))
#define LAS __attribute__((address_space(3)))
namespace pg8 {
#define PG8_LAS __attribute__((address_space(3)))
typedef unsigned short bf16_t;
typedef short bf16x8 __attribute__((ext_vector_type(8)));
typedef float f32x4 __attribute__((ext_vector_type(4)));
typedef unsigned u32x4 __attribute__((ext_vector_type(4)));
constexpr int BM = 256, BK = 64, HALF = 128, HTB = HALF * BK * 2  , STAGE_BYTES = 8 * HTB, NXCD = 8, WGM = 8;

__host__ __device__ __forceinline__ int lds_byte(int r, int c) { const int st = (r >> 4) * 2 + (c >> 5), rr = r & 15, cc = c & 31, ob = rr * 64 + cc * 2; return st * 1024 + (ob ^ (((ob >> 9) & 1) << 5)); }
__host__ __device__ __forceinline__ void stage_rc(int b, int& R, int& C) { const int st = b / 1024, sb = b % 1024, swz = sb ^ (((sb >> 9) & 1) << 5); R = (st >> 1) * 16 + swz / 64; C = (st & 1) * 32 + (swz % 64) / 2; }
__host__ __device__ __forceinline__ int perm32(int rho) { const int n = rho >> 4, i = rho & 15; return 8 * (i >> 2) + 4 * n + (i & 3); }

struct Unit { int pm, pn; };
struct Gemm { const bf16_t* A; const bf16_t* Bt; int M, N, K; };

struct StaticOrder {
    int nM, nN, nwg, G, c;
    __host__ __device__ void init(int M, int N, int G_, int c_) { nM = M / BM; nN = N / BM; nwg = nM * nN; G = G_; c = c_; }
    __host__ __device__ bool next(int i, Unit& u) const {
        const long L = (long)i * G + c; if (L >= nwg) return false;
        int wgid = (int)L; { const int q = nwg / NXCD, r = nwg % NXCD, xcd = wgid % NXCD, off = wgid / NXCD; wgid = (xcd < r ? xcd * (q + 1) : r * (q + 1) + (xcd - r) * q) + off; }
        const int nig = WGM * nN, gid = wgid / nig, fm = gid * WGM, gsz = (nM - fm) < WGM ? (nM - fm) : WGM;
        u.pm = fm + ((wgid % nig) % gsz); u.pn = (wgid % nig) / gsz; return true;
    }
    __device__ __forceinline__ void a_ready(const Unit&) const {}
    __device__ __forceinline__ void done(const Unit&) const {}
};

__device__ __forceinline__ unsigned cvt_pk_bf16(float lo, float hi) { unsigned r; asm volatile("v_cvt_pk_bf16_f32 %0, %1, %2" : "=v"(r) : "v"(lo), "v"(hi)); return r; }
typedef float f32x2 __attribute__((ext_vector_type(2)));
typedef _Float16 f16x2 __attribute__((ext_vector_type(2)));
__device__ __forceinline__ unsigned pkh2(float a, float b) { const f16x2 h = {(_Float16)a, (_Float16)b}; return __builtin_bit_cast(unsigned, h); }
__device__ __forceinline__ float uph_lo(unsigned w) { return (float)__builtin_bit_cast(f16x2, w).x; }
__device__ __forceinline__ float uph_hi(unsigned w) { return (float)__builtin_bit_cast(f16x2, w).y; }

template <class Epi, class Sched, bool ALIGN_EPI = false, bool SP2 = false>
__device__ __forceinline__ void gemm_phase(PG8_LAS unsigned char* lds, const Gemm g, const Sched& S, const Epi& E, int tid_in) {
    int tid_ = tid_in; asm volatile("" : "+v"(tid_));
    const int tid = tid_, wid = __builtin_amdgcn_readfirstlane(tid >> 6), lane = tid & 63, wr = wid >> 2, wc = wid & 3, fr = lane & 15, fq = lane >> 4;
    const int K = g.K, nt = K / BK;
    unsigned voffA[2], voffB[2];
#pragma unroll
    for (int i = 0; i < 2; ++i) { int R, C; stage_rc(tid * 16 + i * 8192, R, C); const int Rb = Epi::PERM ? ((R & ~31) + perm32(R & 31)) : R;
        voffA[i] = (unsigned)(R * K + C) * 2u; voffB[i] = (unsigned)(Rb * K + C) * 2u; }
    const size_t kstep = (size_t)(BK * 2);
    const size_t hstep = (size_t)HALF * K * 2;
    const size_t tstep = 2 * hstep;
    const unsigned ldsw = (unsigned)wid * 1024u;
    const int aoff = lds_byte(wr * 64 + fr, fq * 8), boff = lds_byte(wc * 32 + fr, fq * 8);
#define PG8_SA(b, h) (((b) * 2 + (h)) * HTB)
#define PG8_SB(b, h) ((4 + (b) * 2 + (h)) * HTB)
#define PG8_STAGE(bufoff, gbase, voff) do { _Pragma("unroll") for (int _i = 0; _i < 2; ++_i) \
        __builtin_amdgcn_global_load_lds((const unsigned*)((const char*)(gbase) + (voff)[_i]), (PG8_LAS unsigned*)(lds + (bufoff) + ldsw + _i * 8192), 16, 0, 0); } while (0)
#define PG8_LDA(dst, b, h) do { _Pragma("unroll") for (int m = 0; m < 4; ++m) _Pragma("unroll") for (int k = 0; k < 2; ++k) dst[m][k] = *(const PG8_LAS bf16x8*)(lds + PG8_SA(b, h) + aoff + m * 2048 + k * 1024); } while (0)
#define PG8_LDB(dst, b, h) do { _Pragma("unroll") for (int n = 0; n < 2; ++n) _Pragma("unroll") for (int k = 0; k < 2; ++k) dst[n][k] = *(const PG8_LAS bf16x8*)(lds + PG8_SB(b, h) + boff + n * 2048 + k * 1024); } while (0)
#define PG8_MMA(ai, bj, At, Bt) do { __builtin_amdgcn_s_setprio(1); _Pragma("unroll") for (int m = 0; m < 4; ++m) _Pragma("unroll") for (int n = 0; n < 2; ++n) _Pragma("unroll") for (int k = 0; k < 2; ++k) \
        acc[ai][bj][m][n] = __builtin_amdgcn_mfma_f32_16x16x32_bf16(Bt[n][k], At[m][k], acc[ai][bj][m][n], 0, 0, 0); __builtin_amdgcn_s_setprio(0); } while (0)
#define PG8_WAIT_V(n) asm volatile("s_waitcnt vmcnt(" #n ")" ::: "memory")
#define PG8_WAIT_L(n) asm volatile("s_waitcnt lgkmcnt(" #n ")" ::: "memory")
#define PG8_BAR __builtin_amdgcn_s_barrier()
#define PG8_SCHED __builtin_amdgcn_sched_barrier(0)
    Unit cur, nxt; int ui = 0;
    if (!S.next(0, cur)) return;
    f32x4 acc[2][2][4][2];
#pragma unroll
    for (int a = 0; a < 2; ++a)
#pragma unroll
        for (int b = 0; b < 2; ++b)
#pragma unroll
            for (int m = 0; m < 4; ++m)
#pragma unroll
                for (int n = 0; n < 2; ++n) acc[a][b][m][n] = (f32x4){0.f, 0.f, 0.f, 0.f};
    bf16x8 At[4][2], B0[2][2], B1[2][2];
    const char* cA = (const char*)g.A + (size_t)cur.pm * tstep; const char* cB = (const char*)g.Bt + (size_t)cur.pn * tstep;
    S.a_ready(cur);
    if constexpr (SP2) {
        PG8_STAGE(PG8_SB(0, 0), cB, voffB); PG8_STAGE(PG8_SB(0, 1), cB + hstep, voffB); PG8_STAGE(PG8_SA(0, 0), cA, voffA); PG8_STAGE(PG8_SA(0, 1), cA + hstep, voffA);
        if (wr == 1) PG8_BAR;
        PG8_WAIT_V(2); PG8_BAR;
        PG8_STAGE(PG8_SB(1, 0), cB + kstep, voffB); PG8_STAGE(PG8_SA(1, 0), cA + kstep, voffA); PG8_STAGE(PG8_SB(1, 1), cB + hstep + kstep, voffB);
        PG8_WAIT_V(6); PG8_BAR;
    } else {
        PG8_STAGE(PG8_SB(0, 0), cB, voffB); PG8_STAGE(PG8_SA(0, 0), cA, voffA); PG8_STAGE(PG8_SB(0, 1), cB + hstep, voffB); PG8_STAGE(PG8_SA(0, 1), cA + hstep, voffA);
        if (wr == 1) PG8_BAR;
        PG8_WAIT_V(4); PG8_BAR;
        PG8_STAGE(PG8_SB(1, 0), cB + kstep, voffB); PG8_STAGE(PG8_SA(1, 0), cA + kstep, voffA); PG8_STAGE(PG8_SB(1, 1), cB + hstep + kstep, voffB);
        PG8_WAIT_V(6); PG8_BAR;
    }
    for (;;) {
        const bool has_next = S.next(ui + 1, nxt);
        const char* nA = has_next ? (const char*)g.A + (size_t)nxt.pm * tstep : cA; const char* nB = has_next ? (const char*)g.Bt + (size_t)nxt.pn * tstep : cB;
        for (int t = 0; t < nt; t += 2) {
            const bool last = (t == nt - 2);
            const char* a1 = cA + (size_t)(t + 1) * kstep;
            const char* a2 = last ? nA : cA + (size_t)(t + 2) * kstep; const char* b2 = last ? nB : cB + (size_t)(t + 2) * kstep;
            const char* a3 = a2 + kstep; const char* b3 = b2 + kstep;
            if (last && has_next) S.a_ready(nxt);
            if constexpr (SP2) {
            PG8_LDB(B0, 0, 0); PG8_LDB(B1, 0, 1); PG8_SCHED; PG8_LDA(At, 0, 0); PG8_STAGE(PG8_SA(1, 1), a1 + hstep, voffA);
            PG8_WAIT_V(8); PG8_WAIT_L(0); PG8_BAR; PG8_MMA(0, 0, At, B0); PG8_MMA(0, 1, At, B1); PG8_BAR; PG8_SCHED;
            PG8_LDA(At, 0, 1); PG8_STAGE(PG8_SB(0, 0), b2, voffB); PG8_STAGE(PG8_SB(0, 1), b2 + hstep, voffB); PG8_STAGE(PG8_SA(0, 0), a2, voffA);
            PG8_WAIT_V(8); PG8_WAIT_L(0); PG8_BAR; PG8_MMA(1, 0, At, B0); PG8_MMA(1, 1, At, B1); PG8_BAR; PG8_SCHED;
            PG8_LDB(B0, 1, 0); PG8_LDB(B1, 1, 1); PG8_SCHED; PG8_LDA(At, 1, 0); PG8_STAGE(PG8_SA(0, 1), a2 + hstep, voffA);
            PG8_WAIT_V(8); PG8_WAIT_L(0); PG8_BAR; PG8_MMA(0, 0, At, B0); PG8_MMA(0, 1, At, B1); PG8_BAR; PG8_SCHED;
            PG8_LDA(At, 1, 1); PG8_STAGE(PG8_SB(1, 0), b3, voffB); PG8_STAGE(PG8_SB(1, 1), b3 + hstep, voffB); PG8_STAGE(PG8_SA(1, 0), a3, voffA);
            PG8_WAIT_V(8); PG8_WAIT_L(0); PG8_BAR; PG8_MMA(1, 0, At, B0); PG8_MMA(1, 1, At, B1); PG8_BAR; PG8_SCHED;
            } else {
            PG8_LDB(B0, 0, 0); PG8_SCHED; PG8_LDA(At, 0, 0); PG8_STAGE(PG8_SA(1, 1), a1 + hstep, voffA);
            PG8_WAIT_L(8); PG8_BAR; PG8_WAIT_L(0); PG8_MMA(0, 0, At, B0); PG8_BAR; PG8_SCHED;
            PG8_LDB(B1, 0, 1); PG8_STAGE(PG8_SB(0, 0), b2, voffB);
            PG8_BAR; PG8_WAIT_L(0); PG8_MMA(0, 1, At, B1); PG8_BAR;
            PG8_LDA(At, 0, 1); PG8_STAGE(PG8_SA(0, 0), a2, voffA);
            PG8_BAR; PG8_WAIT_L(0); PG8_MMA(1, 0, At, B0); PG8_BAR; PG8_SCHED;
            PG8_STAGE(PG8_SB(0, 1), b2 + hstep, voffB);
            PG8_WAIT_V(6); PG8_BAR; PG8_MMA(1, 1, At, B1); PG8_BAR;
            PG8_LDB(B0, 1, 0); PG8_SCHED; PG8_LDA(At, 1, 0); PG8_STAGE(PG8_SA(0, 1), a2 + hstep, voffA);
            PG8_WAIT_L(8); PG8_BAR; PG8_WAIT_L(0); PG8_MMA(0, 0, At, B0); PG8_BAR; PG8_SCHED;
            PG8_LDB(B1, 1, 1); PG8_STAGE(PG8_SB(1, 0), b3, voffB);
            PG8_BAR; PG8_WAIT_L(0); PG8_MMA(0, 1, At, B1); PG8_BAR;
            PG8_LDA(At, 1, 1); PG8_STAGE(PG8_SA(1, 0), a3, voffA);
            PG8_BAR; PG8_WAIT_L(0); PG8_MMA(1, 0, At, B0); PG8_BAR; PG8_SCHED;
            PG8_STAGE(PG8_SB(1, 1), b3 + hstep, voffB);
            PG8_WAIT_V(6); PG8_BAR; PG8_MMA(1, 1, At, B1); PG8_BAR;
            }
        }
        if constexpr (ALIGN_EPI) { if (wr == 0) PG8_BAR; }
        if constexpr (!Epi::AFTER_DRAIN) { E(acc, cur, wr, wc, fr, fq); S.done(cur); }
        if (!has_next) break;
#pragma unroll
        for (int a = 0; a < 2; ++a)
#pragma unroll
            for (int b = 0; b < 2; ++b)
#pragma unroll
                for (int m = 0; m < 4; ++m)
#pragma unroll
                    for (int n = 0; n < 2; ++n) acc[a][b][m][n] = (f32x4){0.f, 0.f, 0.f, 0.f};
        cur = nxt; cA = nA; cB = nB; ++ui;
        if constexpr (ALIGN_EPI) { if (wr == 1) PG8_BAR; }
    }
    PG8_WAIT_V(0);
    if constexpr (!ALIGN_EPI) { if (wr == 0) PG8_BAR; }
    PG8_BAR;
    if constexpr (Epi::AFTER_DRAIN) { E.fused(acc, cur, wr, wc, fr, fq, lds, wid, lane); S.done(cur); }
#undef PG8_SA
#undef PG8_SB
#undef PG8_STAGE
#undef PG8_LDA
#undef PG8_LDB
#undef PG8_MMA
#undef PG8_WAIT_V
#undef PG8_WAIT_L
#undef PG8_BAR
#undef PG8_SCHED
}
}
#define XB_TMO      128
#define XB_XCNT(j)  (256  + 64 * (j))
#define XB_XSUB(j)  (1280 + 64 * (j))
#define XB_XGEN(j)  (2304 + 64 * (j))
#define XB_TOP      3328
#define XB_TOPGEN   3392
#define XCD_BAR_WORDS 3456
#define XB_SPIN_CAP (1u << 18)

__device__ __forceinline__ unsigned xb_ld(unsigned* p)              { return __hip_atomic_load(p, __ATOMIC_RELAXED, __HIP_MEMORY_SCOPE_AGENT); }
__device__ __forceinline__ unsigned xb_add(unsigned* p, unsigned v) { return __hip_atomic_fetch_add(p, v, __ATOMIC_RELAXED, __HIP_MEMORY_SCOPE_AGENT); }
__device__ __forceinline__ unsigned xb_xcc_id() { return (unsigned)__builtin_amdgcn_s_getreg((3 << 11) | 20) & 0xFu; }
#define XB_SPIN(cond, bar) do { unsigned _sp = 0; while (cond) { __builtin_amdgcn_s_sleep(1); \
    if ((++_sp & 255u) == 0u) { if (xb_ld(&(bar)[XB_TMO])) break; if (_sp > XB_SPIN_CAP) { atomicAdd(&(bar)[XB_TMO], 1u); break; } } } } while (0)

struct XcdBarrier {
    unsigned* bar; unsigned x;
    volatile LAS unsigned* st;
};

__device__ __forceinline__ XcdBarrier xcd_barrier_post(unsigned* bar, volatile LAS unsigned* st) {
    XcdBarrier b; b.bar = bar; b.x = xb_xcc_id(); b.st = st;
    if (threadIdx.x == 0) (void)xb_add(&bar[XB_XCNT(b.x)], 1u);
    return b;
}
__device__ __forceinline__ void xcd_barrier_complete(unsigned* bar, unsigned x, unsigned& nloc, unsigned& nx) {
    const unsigned G = gridDim.x * gridDim.y * gridDim.z;
    unsigned sum, cnt, mine, sp = 0u;
    for (;;) {
        sum = 0u; cnt = 0u; mine = 0u;
#pragma unroll
        for (unsigned j = 0; j < 16; ++j) { const unsigned c = xb_ld(&bar[XB_XCNT(j)]); sum += c; cnt += (c > 0u) ? 1u : 0u; mine = (j == x) ? c : mine; }
        if (sum == G) break;
        __builtin_amdgcn_s_sleep(1);
        if ((++sp & 255u) == 0u) { if (xb_ld(&bar[XB_TMO])) break; if (sp > XB_SPIN_CAP) { atomicAdd(&bar[XB_TMO], 1u); break; } }
    }
    nloc = mine > 0u ? mine : 1u; nx = cnt > 0u ? cnt : 1u;
}

__device__ __forceinline__ void xcd_barrier(const XcdBarrier& b, bool leader) {
    asm volatile("s_waitcnt vmcnt(0)" ::: "memory");
    __syncthreads();
    if (leader) {
        unsigned* bar = b.bar;
        __builtin_amdgcn_s_waitcnt(0);
        unsigned nloc = b.st[0], nx = b.st[1];
        if (nloc == 0u) { xcd_barrier_complete(bar, b.x, nloc, nx); b.st[0] = nloc; b.st[1] = nx; }
        const unsigned old = xb_add(&bar[XB_XSUB(b.x)], 1u);
        const unsigned gen = old / nloc;
        if (old + 1u == (gen + 1u) * nloc) {
            __builtin_amdgcn_fence(__ATOMIC_RELEASE, "agent");
            asm volatile("s_waitcnt vmcnt(0)" ::: "memory");
            const unsigned og = xb_add(&bar[XB_TOP], 1u);
            const unsigned tg = og / nx;
            if (og + 1u == (tg + 1u) * nx) xb_add(&bar[XB_TOPGEN], 1u);
            else XB_SPIN(xb_ld(&bar[XB_TOPGEN]) == tg, bar);
            __builtin_amdgcn_fence(__ATOMIC_ACQUIRE, "agent");
            xb_add(&bar[XB_XGEN(b.x)], 1u);
            asm volatile("s_waitcnt vmcnt(0)" ::: "memory");
        } else {
            XB_SPIN(xb_ld(&bar[XB_XGEN(b.x)]) == gen, bar);
            __builtin_amdgcn_fence(__ATOMIC_ACQUIRE, "agent");
            asm volatile("s_waitcnt vmcnt(0)" ::: "memory");
        }
    }
    __syncthreads();
}

typedef unsigned short bf16;
typedef unsigned v4u __attribute__((ext_vector_type(4)));
typedef unsigned v2u __attribute__((ext_vector_type(2)));
typedef float f32x4 __attribute__((ext_vector_type(4)));
typedef float f32x16 __attribute__((ext_vector_type(16)));
typedef short bf16x8 __attribute__((ext_vector_type(8)));
#define LDS_WAIT() asm volatile("s_waitcnt lgkmcnt(0)" ::: "memory")
#define VM_WAIT() asm volatile("s_waitcnt vmcnt(0)" ::: "memory")

constexpr int NWAVES = 8, NTHREADS = 512;
constexpr int BATCH = 2, SEQ = 8192, M = BATCH * SEQ, D = 2048, DEPTH = 4;
constexpr int IN_COLS = 4160, IN_PAD = 4352;
constexpr int C_DAQ = 0, C_DAK = 768, C_DAV = 1536, C_QA = 2304, C_KVA = 2816, C_KR = 3072, C_SGU = 3136, C_SGV = 3648;
constexpr int DFF = 5632, NUP = 2 * DFF;
constexpr int UQ_N = 1152, UQ_PAD = 1536, UKV_N = 1536, QRANK = 512, KVRANK = 256;
constexpr int NH = 6;
constexpr float EPS = 1e-6f;
constexpr float LOG2E = 1.4426950408889634f;
constexpr float QS_DA = 0.125f * LOG2E;
constexpr float QS_MLA = 0.07216878364870322f * LOG2E;

enum { I_X = 0, I_C, I_POS, I_WADA, I_BADA, I_WIN, I_DAQG, I_DAKG, I_LQ1, I_LK1, I_LQ2, I_LK2, I_DAHG, I_QAG, I_WUQ, I_KVAG, I_WUKV, I_MQG, I_MKG, I_SGVG, I_SGW, I_SGB, I_WOUT, I_WUP, I_CONVW, I_CONVB, I_WDOWN, N_IN };

constexpr size_t MiB = 1u << 20;
constexpr size_t WS_CTL = 0, CTL_ZERO_BYTES = 1 * MiB;
constexpr size_t WS_MOD = 1 * MiB;
constexpr size_t WS_POSMM = 1 * MiB + 512 * 1024;
constexpr size_t WS_MODP = 2 * MiB;
constexpr size_t WS_W = 8 * MiB;
constexpr size_t WL_IN = 0, WL_UQ = 17 * MiB, WL_UKV = WL_UQ + 1572864, WL_OUT = 20 * MiB, WL_UP = 28 * MiB, WL_DOWN = 72 * MiB, WL_STRIDE = 94 * MiB;
constexpr size_t WS_H = 384 * MiB;
constexpr size_t WS_MIX = 448 * MiB;
constexpr size_t WS_U = 512 * MiB;
constexpr size_t WS_R = 688 * MiB;
constexpr size_t WS_KR = WS_R;
constexpr size_t WS_SSQ_QA = WS_R + 4 * MiB, WS_SSQ_KVA = WS_R + 5 * MiB, WS_SSQ_SGV = WS_R + 6 * MiB, WS_SSQ_KR = WS_R + 7 * MiB;
constexpr size_t WS_QD = WS_R + 272 * MiB, WS_KD = WS_R + 296 * MiB, WS_VD = WS_R + 320 * MiB;
constexpr size_t WS_QM = WS_R + 344 * MiB, WS_KM = WS_R + 380 * MiB, WS_VM = WS_R + 416 * MiB;
constexpr size_t WS_QA = WS_R + 440 * MiB, WS_KVA = WS_R + 456 * MiB;
constexpr size_t WS_MLQ = WS_R + 464 * MiB, WS_MLKV = WS_R + 544 * MiB;
constexpr size_t WS_XB = WS_R + 464 * MiB;
constexpr size_t WS_UU = WS_R + 640 * MiB, WS_GV = WS_R + 672 * MiB;
constexpr size_t WS_EDGE = WS_R;
constexpr size_t WS_A = WS_R;
constexpr size_t WS_O1 = WS_R + 704 * MiB;
constexpr size_t WS_COS = WS_R + 752 * MiB, WS_SIN = WS_R + 754 * MiB;
constexpr size_t WS_END = WS_R + 756 * MiB;

constexpr int RING_BYTES = 131072;
constexpr int LDSCTL_OFF = RING_BYTES;
constexpr int LDS_BYTES = 147456;

__device__ const float ROPE_INV[32] = {1.000000000e+00f, 7.498942614e-01f, 5.623413324e-01f, 4.216965139e-01f, 3.162277639e-01f, 2.371373773e-01f, 1.778279394e-01f, 1.333521307e-01f, 1.000000015e-01f, 7.498941571e-02f, 5.623413250e-02f, 4.216965288e-02f, 3.162277490e-02f, 2.371373773e-02f, 1.778279431e-02f, 1.333521493e-02f, 9.999999776e-03f, 7.498941850e-03f, 5.623413250e-03f, 4.216964822e-03f, 3.162277630e-03f, 2.371373586e-03f, 1.778279431e-03f, 1.333521446e-03f, 1.000000047e-03f, 7.498942432e-04f, 5.623413017e-04f, 4.216965172e-04f, 3.162277571e-04f, 2.371373703e-04f, 1.778279402e-04f, 1.333521504e-04f};
__device__ const float ALIBI_SLOPE[6] = {0.3968502629920499f, 0.15749013123685915f, 0.0625f, 0.024803141437003122f, 0.0098431332023036951f, 0.00390625f};
__device__ const float LAM_INIT[4] = {0.20000000000000007f, 0.35550906759096934f, 0.4707130183435842f, 0.5560582041556406f};

struct Args { const void* in[N_IN]; float* out; unsigned char* ws; int ph; int l; };

__device__ __forceinline__ unsigned f2bf(float f) { unsigned u = __builtin_bit_cast(unsigned, f); return (u + 0x7fffu + ((u >> 16) & 1u)) >> 16; }
__device__ __forceinline__ unsigned pk2(float lo, float hi) { return f2bf(lo) | (f2bf(hi) << 16); }
__device__ __forceinline__ float bf2f(unsigned short h) { return __builtin_bit_cast(float, (unsigned)h << 16); }
template <int CTRL> __device__ __forceinline__ float dpp_mov(float v) { return __builtin_bit_cast(float, __builtin_amdgcn_update_dpp(0, __builtin_bit_cast(int, v), CTRL, 0xF, 0xF, true)); }
__device__ __forceinline__ float sum16(float v) { v += dpp_mov<0xB1>(v); v += dpp_mov<0x4E>(v); v += dpp_mov<0x141>(v); v += dpp_mov<0x140>(v); return v; }
__device__ __forceinline__ float sum32(float v) { v = sum16(v); auto r = __builtin_amdgcn_permlane16_swap(__float_as_uint(v), __float_as_uint(v), false, false); return __uint_as_float(r[0]) + __uint_as_float(r[1]); }
__device__ __forceinline__ float wave_sum(float v) { v = sum32(v); auto r = __builtin_amdgcn_permlane32_swap(__float_as_uint(v), __float_as_uint(v), false, false); return __uint_as_float(r[0]) + __uint_as_float(r[1]); }
__device__ __forceinline__ float wave_max(float v) { v = fmaxf(v, dpp_mov<0xB1>(v)); v = fmaxf(v, dpp_mov<0x4E>(v)); v = fmaxf(v, dpp_mov<0x141>(v)); v = fmaxf(v, dpp_mov<0x140>(v));
    { auto r = __builtin_amdgcn_permlane16_swap(__float_as_uint(v), __float_as_uint(v), false, false); v = fmaxf(__uint_as_float(r[0]), __uint_as_float(r[1])); }
    { auto r = __builtin_amdgcn_permlane32_swap(__float_as_uint(v), __float_as_uint(v), false, false); v = fmaxf(__uint_as_float(r[0]), __uint_as_float(r[1])); } return v; }
__device__ __forceinline__ float xor32(float v, int lane) { auto r = __builtin_amdgcn_permlane32_swap(__float_as_uint(v), __float_as_uint(v), false, false); return lane < 32 ? __uint_as_float(r[1]) : __uint_as_float(r[0]); }
__device__ __forceinline__ float gelu_tanh(float x) {
    const float u = 0.7978845608028654f * (x + 0.044715f * x * x * x);
    const float e = __expf(2.0f * u);
    const float th = 1.0f - 2.0f / (e + 1.0f);
    return 0.5f * x * (1.0f + th);
}
__device__ __forceinline__ float silu_f(float x) { return x / (1.0f + __expf(-x)); }
__device__ __forceinline__ int crow(int r, int hi) { return (r & 3) + 8 * (r >> 2) + 4 * hi; }

namespace pg8 {
struct EpiF32 {
    static constexpr bool PERM = false, AFTER_DRAIN = false;
    float* C; int ldc;
    __device__ __forceinline__ void operator()(const f32x4 (&acc)[2][2][4][2], const Unit& u, int wr, int wc, int fr, int fq) const {
        const int row0 = u.pm * BM + wr * 64 + fr, col0 = u.pn * BM + wc * 32 + 4 * fq;
#pragma unroll
        for (int ai = 0; ai < 2; ++ai)
#pragma unroll
            for (int m = 0; m < 4; ++m) { float* rowp = C + (size_t)(row0 + ai * HALF + m * 16) * ldc + col0;
#pragma unroll
                for (int bj = 0; bj < 2; ++bj)
#pragma unroll
                    for (int n = 0; n < 2; ++n) *(f32x4*)(rowp + bj * HALF + n * 16) = acc[ai][bj][m][n]; }
    }
};
struct EpiNull {
    static constexpr bool PERM = true, AFTER_DRAIN = false;
    float* C;
    __device__ __forceinline__ void operator()(const f32x4 (&acc)[2][2][4][2], const Unit& u, int wr, int wc, int fr, int fq) const {
        f32x4 s = {0.f, 0.f, 0.f, 0.f};
#pragma unroll
        for (int ai = 0; ai < 2; ++ai)
#pragma unroll
            for (int bj = 0; bj < 2; ++bj)
#pragma unroll
                for (int m = 0; m < 4; ++m)
#pragma unroll
                    for (int n = 0; n < 2; ++n) s += acc[ai][bj][m][n];
        C[(size_t)(u.pm * 44 + u.pn) * 512 + (wr * 4 + wc) * 64 + fq * 16 + fr] = (s[0] + s[1]) + (s[2] + s[3]);
    }
};
struct EpiResid {
    static constexpr bool PERM = false, AFTER_DRAIN = false;
    const float* xin; float* out; int ldc; const float* gate; int gate_stride;
    __device__ __forceinline__ void operator()(const f32x4 (&acc)[2][2][4][2], const Unit& u, int wr, int wc, int fr, int fq) const {
        const int row0 = u.pm * BM + wr * 64 + fr, col0 = u.pn * BM + wc * 32 + 4 * fq;
        const float* gp = gate + (size_t)((u.pm * BM) / SEQ) * gate_stride + col0;
        f32x4 gv[2][2];
#pragma unroll
        for (int bj = 0; bj < 2; ++bj)
#pragma unroll
            for (int n = 0; n < 2; ++n) gv[bj][n] = *(const f32x4*)(gp + bj * HALF + n * 16);
#pragma unroll
        for (int ai = 0; ai < 2; ++ai) {
            f32x4 xv[4][2][2];
#pragma unroll
            for (int m = 0; m < 4; ++m) { const size_t off = (size_t)(row0 + ai * HALF + m * 16) * ldc + col0;
#pragma unroll
                for (int bj = 0; bj < 2; ++bj)
#pragma unroll
                    for (int n = 0; n < 2; ++n) xv[m][bj][n] = *(const f32x4*)(xin + off + bj * HALF + n * 16); }
#pragma unroll
            for (int m = 0; m < 4; ++m) { const size_t off = (size_t)(row0 + ai * HALF + m * 16) * ldc + col0;
#pragma unroll
                for (int bj = 0; bj < 2; ++bj)
#pragma unroll
                    for (int n = 0; n < 2; ++n) *(f32x4*)(out + off + bj * HALF + n * 16) = xv[m][bj][n] + gv[bj][n] * acc[ai][bj][m][n]; }
        }
    }
};
struct EpiResidP {
    static constexpr bool PERM = true, AFTER_DRAIN = false;
    const void* xin; void* out; int inb, outb; const float* gate; int gate_stride;
    __device__ __forceinline__ void put(unsigned eo, const f32x4 r0, const f32x4 r1) const {
        if (outb) *(u32x4*)((char*)out + eo * 2u) = (u32x4){pkh2(r0[0], r0[1]), pkh2(r0[2], r0[3]), pkh2(r1[0], r1[1]), pkh2(r1[2], r1[3])};
        else { *(f32x4*)((char*)out + eo * 4u) = r0; *(f32x4*)((char*)out + eo * 4u + 16u) = r1; } }
    __device__ __forceinline__ void operator()(const f32x4 (&acc)[2][2][4][2], const Unit& u, int wr, int wc, int fr_, int fq_) const {
        int fr = fr_, fq = fq_; asm volatile("" : "+v"(fr), "+v"(fq));
        const int row0 = u.pm * BM + wr * 64 + fr, col0 = u.pn * BM + wc * 32 + 8 * fq;
        const unsigned lo = (unsigned)(row0 * 2048 + col0);
        const float* gp = gate + (size_t)((u.pm * BM) / SEQ) * gate_stride + col0;
        f32x4 gv[2][2];
#pragma unroll
        for (int bj = 0; bj < 2; ++bj)
#pragma unroll
            for (int n = 0; n < 2; ++n) gv[bj][n] = *(const f32x4*)(gp + bj * HALF + 4 * n);
        if (inb) {
            u32x4 xb[2][4][2];
#pragma unroll
            for (int ai = 0; ai < 2; ++ai)
#pragma unroll
                for (int m = 0; m < 4; ++m)
#pragma unroll
                    for (int bj = 0; bj < 2; ++bj) xb[ai][m][bj] = *(const u32x4*)((const char*)xin + (lo + (unsigned)((ai * HALF + m * 16) * 2048 + bj * HALF)) * 2u);
#pragma unroll
            for (int ai = 0; ai < 2; ++ai)
#pragma unroll
                for (int m = 0; m < 4; ++m)
#pragma unroll
                    for (int bj = 0; bj < 2; ++bj) { const u32x4 w = xb[ai][m][bj];
                        const f32x4 x0 = {uph_lo(w.x), uph_hi(w.x), uph_lo(w.y), uph_hi(w.y)};
                        const f32x4 x1 = {uph_lo(w.z), uph_hi(w.z), uph_lo(w.w), uph_hi(w.w)};
                        put(lo + (unsigned)((ai * HALF + m * 16) * 2048 + bj * HALF), x0 + gv[bj][0] * acc[ai][bj][m][0], x1 + gv[bj][1] * acc[ai][bj][m][1]); }
        } else {
#pragma unroll
            for (int ai = 0; ai < 2; ++ai) {
                f32x4 xv[4][2][2];
#pragma unroll
                for (int m = 0; m < 4; ++m)
#pragma unroll
                    for (int bj = 0; bj < 2; ++bj)
#pragma unroll
                        for (int n = 0; n < 2; ++n) xv[m][bj][n] = *(const f32x4*)((const char*)xin + (lo + (unsigned)((ai * HALF + m * 16) * 2048 + bj * HALF + 4 * n)) * 4u);
#pragma unroll
                for (int m = 0; m < 4; ++m)
#pragma unroll
                    for (int bj = 0; bj < 2; ++bj) put(lo + (unsigned)((ai * HALF + m * 16) * 2048 + bj * HALF), xv[m][bj][0] + gv[bj][0] * acc[ai][bj][m][0], xv[m][bj][1] + gv[bj][1] * acc[ai][bj][m][1]);
            }
        }
    }
};
struct EpiBf16S {
    static constexpr bool PERM = true, AFTER_DRAIN = false;
    bf16_t* O; int ldc;
    __device__ __forceinline__ void operator()(const f32x4 (&acc)[2][2][4][2], const Unit& u, int wr, int wc, int fr, int fq) const {
        const int row0 = u.pm * BM + wr * 64 + fr, col0 = u.pn * BM + wc * 32 + 8 * fq;
#pragma unroll
        for (int ai = 0; ai < 2; ++ai)
#pragma unroll
            for (int m = 0; m < 4; ++m) { bf16_t* rowp = O + (size_t)(row0 + ai * HALF + m * 16) * ldc + col0;
#pragma unroll
                for (int bj = 0; bj < 2; ++bj) { const f32x4 v0 = acc[ai][bj][m][0], v1 = acc[ai][bj][m][1]; u32x4 w;
                    w.x = cvt_pk_bf16(v0[0], v0[1]); w.y = cvt_pk_bf16(v0[2], v0[3]); w.z = cvt_pk_bf16(v1[0], v1[1]); w.w = cvt_pk_bf16(v1[2], v1[3]);
                    *(u32x4*)(rowp + bj * HALF) = w; } }
    }
};
template <int CTRL> __device__ __forceinline__ float dppf(float old, float src) { return __builtin_bit_cast(float, __builtin_amdgcn_update_dpp(__builtin_bit_cast(int, old), __builtin_bit_cast(int, src), CTRL, 0xF, 0xF, false)); }
struct EpiConvGate {
    static constexpr bool PERM = true, AFTER_DRAIN = false;
    bf16_t* U; unsigned short* EDGE; const float* cw; const float* cb;
    __device__ __forceinline__ void operator()(const f32x4 (&acc)[2][2][4][2], const Unit& u, int wr, int wc, int fr, int fq) const {
        const int ch0 = u.pn * 128 + wc * 32 + 8 * fq, rowb = u.pm * BM + wr * 64;
#pragma unroll
        for (int ai = 0; ai < 2; ++ai) { const int blk = (rowb + ai * HALF) >> 6;
            if (fr < 2) { unsigned short* e = EDGE + ((size_t)(blk * 4 + fr) * 2) * DFF + ch0;
#pragma unroll
                for (int bj = 0; bj < 2; ++bj) { const f32x4 a0 = acc[ai][bj][0][0], a1 = acc[ai][bj][0][1]; *(u32x4*)(e + bj * DFF) = (u32x4){pkh2(a0[0], a0[1]), pkh2(a0[2], a0[3]), pkh2(a1[0], a1[1]), pkh2(a1[2], a1[3])}; } }
            if (fr >= 14) { unsigned short* e = EDGE + ((size_t)(blk * 4 + fr - 12) * 2) * DFF + ch0;
#pragma unroll
                for (int bj = 0; bj < 2; ++bj) { const f32x4 a0 = acc[ai][bj][3][0], a1 = acc[ai][bj][3][1]; *(u32x4*)(e + bj * DFF) = (u32x4){pkh2(a0[0], a0[1]), pkh2(a0[2], a0[3]), pkh2(a1[0], a1[1]), pkh2(a1[2], a1[3])}; } }
        }
        f32x4 w[2][2][3], bb[2][2];
#pragma unroll
        for (int n = 0; n < 2; ++n)
#pragma unroll
            for (int bj = 0; bj < 2; ++bj) { bb[n][bj] = *(const f32x4*)(cb + bj * DFF + ch0 + 4 * n);
#pragma unroll
                for (int j = 0; j < 3; ++j) w[n][bj][j] = *(const f32x4*)(cw + (size_t)j * (2 * DFF) + bj * DFF + ch0 + 4 * n); }
#pragma unroll
        for (int ai = 0; ai < 2; ++ai)
#pragma unroll
            for (int m = 0; m < 4; ++m) {
                unsigned pkw[4];
#pragma unroll
                for (int n = 0; n < 2; ++n) {
                    f32x4 y[2];
#pragma unroll
                    for (int bj = 0; bj < 2; ++bj) { const f32x4 cur = acc[ai][bj][m][n]; const f32x4 prv = m > 0 ? acc[ai][bj][m - 1][n] : (f32x4){0.f, 0.f, 0.f, 0.f};
                        f32x4 s1, s2;
#pragma unroll
                        for (int e = 0; e < 4; ++e) {
                            if (m > 0) { s1[e] = dppf<0x111>(dpp_mov<0x121>(prv[e]), cur[e]); s2[e] = dppf<0x112>(dpp_mov<0x122>(prv[e]), cur[e]); }
                            else { s1[e] = dpp_mov<0x111>(cur[e]); s2[e] = dpp_mov<0x112>(cur[e]); } }
                        y[bj] = bb[n][bj] + w[n][bj][2] * cur + w[n][bj][1] * s1 + w[n][bj][0] * s2; }
                    const f32x4 tg = y[0] * -1.4426950408889634f;
                    f32x4 ev; ev[0] = __builtin_amdgcn_exp2f(tg[0]); ev[1] = __builtin_amdgcn_exp2f(tg[1]); ev[2] = __builtin_amdgcn_exp2f(tg[2]); ev[3] = __builtin_amdgcn_exp2f(tg[3]);
                    const f32x4 dn = ev + 1.0f;
                    f32x4 rc; rc[0] = __builtin_amdgcn_rcpf(dn[0]); rc[1] = __builtin_amdgcn_rcpf(dn[1]); rc[2] = __builtin_amdgcn_rcpf(dn[2]); rc[3] = __builtin_amdgcn_rcpf(dn[3]);
                    const f32x4 o = (y[0] * rc) * y[1];
                    pkw[2 * n] = cvt_pk_bf16(o[0], o[1]); pkw[2 * n + 1] = cvt_pk_bf16(o[2], o[3]);
                }
                u32x4 pk; pk.x = pkw[0]; pk.y = pkw[1]; pk.z = pkw[2]; pk.w = pkw[3];
                *(u32x4*)(U + (size_t)(rowb + ai * HALF + m * 16 + fr) * DFF + ch0) = pk;
            }
    }
};
__device__ __forceinline__ float lane_xor16_sum(float v) { auto r = __builtin_amdgcn_permlane16_swap(__float_as_uint(v), __float_as_uint(v), false, false); return __uint_as_float(r[0]) + __uint_as_float(r[1]); }
__device__ __forceinline__ float lane_xor32_sum(float v) { auto r = __builtin_amdgcn_permlane32_swap(__float_as_uint(v), __float_as_uint(v), false, false); return __uint_as_float(r[0]) + __uint_as_float(r[1]); }
__device__ __forceinline__ float sq4(f32x4 v) { return (v[0] * v[0] + v[1] * v[1]) + (v[2] * v[2] + v[3] * v[3]); }
__device__ __forceinline__ u32x4 pk8(f32x4 a, f32x4 b) { u32x4 w; w.x = cvt_pk_bf16(a[0], a[1]); w.y = cvt_pk_bf16(a[2], a[3]); w.z = cvt_pk_bf16(b[0], b[1]); w.w = cvt_pk_bf16(b[2], b[3]); return w; }
__device__ __forceinline__ float gelu_t(float x) { const float u = 0.7978845608028654f * (x + 0.044715f * x * x * x); const float e = __expf(2.0f * u); return 0.5f * x * (2.0f - 2.0f * __builtin_amdgcn_rcpf(e + 1.0f)); }
__device__ __forceinline__ f32x4 gelu4(f32x4 v) { return (f32x4){gelu_t(v[0]), gelu_t(v[1]), gelu_t(v[2]), gelu_t(v[3])}; }
struct EpiInProj {
    static constexpr bool PERM = true, AFTER_DRAIN = false;
    bf16_t *QD, *KD, *VD, *QA, *KVA, *GV; unsigned short* UU; float *KR, *SSQ_QA, *SSQ_KVA, *SSQ_SGV, *SSQ_KR;
    const float *qg, *kg, *qag, *kvag, *sgvg;
    __device__ __forceinline__ void operator()(const f32x4 (&acc)[2][2][4][2], const Unit& u, int wr, int wc, int fr, int fq) const {
        const int pn = u.pn, rowb = u.pm * BM + wr * 64 + fr, b = (u.pm * BM) / SEQ, c8 = wc * 32 + 8 * fq;
        if (pn < 6) {
            const bool isk = pn >= 3; const int G = 4 * (isk ? pn - 3 : pn) + wc;
            const float* gp = isk ? kg : qg;
            const f32x4 g00 = *(const f32x4*)(gp + 8 * fq), g01 = *(const f32x4*)(gp + 8 * fq + 4), g10 = *(const f32x4*)(gp + 32 + 8 * fq), g11 = *(const f32x4*)(gp + 32 + 8 * fq + 4);
            bf16_t* dst = (isk ? KD : QD) + ((size_t)(b * 12 + G) * SEQ) * 64 + 8 * fq;
            const float post = isk ? 1.0f : QS_DA;
#pragma unroll
            for (int ai = 0; ai < 2; ++ai)
#pragma unroll
                for (int m = 0; m < 4; ++m) { const f32x4 v00 = acc[ai][0][m][0], v01 = acc[ai][0][m][1], v10 = acc[ai][1][m][0], v11 = acc[ai][1][m][1];
                    float ss = (sq4(v00) + sq4(v01)) + (sq4(v10) + sq4(v11)); ss = lane_xor16_sum(ss); ss = lane_xor32_sum(ss);
                    const float r = rsqrtf(ss * (1.f / 64) + EPS) * post;
                    bf16_t* d = dst + (size_t)((rowb + ai * HALF + m * 16) & (SEQ - 1)) * 64;
                    *(u32x4*)d = pk8(v00 * g00 * r, v01 * g01 * r); *(u32x4*)(d + 32) = pk8(v10 * g10 * r, v11 * g11 * r); }
        } else if (pn < 9) {
#pragma unroll
            for (int bj = 0; bj < 2; ++bj) { bf16_t* dst = VD + ((size_t)(b * NH + 2 * (pn - 6) + bj) * SEQ) * 128 + c8;
#pragma unroll
                for (int ai = 0; ai < 2; ++ai)
#pragma unroll
                    for (int m = 0; m < 4; ++m) *(u32x4*)(dst + (size_t)((rowb + ai * HALF + m * 16) & (SEQ - 1)) * 128) = pk8(acc[ai][bj][m][0], acc[ai][bj][m][1]); }
        } else if (pn < 12) {
            const bool iskv = pn == 11; const int ct = iskv ? 0 : 256 * (pn - 9);
            const float* gp = (iskv ? kvag : qag) + ct + c8;
            const f32x4 g00 = *(const f32x4*)gp, g01 = *(const f32x4*)(gp + 4), g10 = *(const f32x4*)(gp + HALF), g11 = *(const f32x4*)(gp + HALF + 4);
            bf16_t* dst = (iskv ? KVA : QA) + ct + c8; const int ld = iskv ? KVRANK : QRANK;
            float* sq = iskv ? SSQ_KVA + wc : SSQ_QA + (pn - 9) * 4 + wc; const int sld = iskv ? 4 : 8;
#pragma unroll
            for (int ai = 0; ai < 2; ++ai)
#pragma unroll
                for (int m = 0; m < 4; ++m) { const int row = rowb + ai * HALF + m * 16;
                    const f32x4 v00 = acc[ai][0][m][0], v01 = acc[ai][0][m][1], v10 = acc[ai][1][m][0], v11 = acc[ai][1][m][1];
                    float ss = (sq4(v00) + sq4(v01)) + (sq4(v10) + sq4(v11)); ss = lane_xor16_sum(ss); ss = lane_xor32_sum(ss);
                    if (fq == 0) sq[(size_t)row * sld] = ss;
                    *(u32x4*)(dst + (size_t)row * ld) = pk8(v00 * g00, v01 * g01); *(u32x4*)(dst + (size_t)row * ld + HALF) = pk8(v10 * g10, v11 * g11); }
        } else if (pn < 14) {
            unsigned short* dst = UU + 256 * (pn - 12) + c8;
#pragma unroll
            for (int ai = 0; ai < 2; ++ai)
#pragma unroll
                for (int m = 0; m < 4; ++m) { unsigned short* d = dst + (size_t)(rowb + ai * HALF + m * 16) * 512;
#pragma unroll
                    for (int bj = 0; bj < 2; ++bj) { const f32x4 a = gelu4(acc[ai][bj][m][0]), c = gelu4(acc[ai][bj][m][1]);
                        *(u32x4*)(d + bj * HALF) = (u32x4){pkh2(a[0], a[1]), pkh2(a[2], a[3]), pkh2(c[0], c[1]), pkh2(c[2], c[3])}; } }
        } else if (pn < 16) {
            const int g0 = 2 * (pn - 14);
#pragma unroll
            for (int bj = 0; bj < 2; ++bj) { const float* gp = sgvg + (g0 + bj) * 128 + c8; const f32x4 ga = *(const f32x4*)gp, gb = *(const f32x4*)(gp + 4);
                bf16_t* dst = GV + (g0 + bj) * 128 + c8; float* sq = SSQ_SGV + (g0 + bj) * 4 + wc;
#pragma unroll
                for (int ai = 0; ai < 2; ++ai)
#pragma unroll
                    for (int m = 0; m < 4; ++m) { const int row = rowb + ai * HALF + m * 16; const f32x4 a = gelu4(acc[ai][bj][m][0]), c = gelu4(acc[ai][bj][m][1]);
                        float ss = sq4(a) + sq4(c); ss = lane_xor16_sum(ss); ss = lane_xor32_sum(ss);
                        if (fq == 0) sq[(size_t)row * 16] = ss;
                        *(u32x4*)(dst + (size_t)row * 512) = pk8(a * ga, c * gb); } }
        } else {
            if (wc < 2) {
#pragma unroll
                for (int ai = 0; ai < 2; ++ai)
#pragma unroll
                    for (int m = 0; m < 4; ++m) { const int row = rowb + ai * HALF + m * 16; float* d = KR + (size_t)row * 64 + c8; *(f32x4*)d = acc[ai][0][m][0]; *(f32x4*)(d + 4) = acc[ai][0][m][1];
                        float ss = sq4(acc[ai][0][m][0]) + sq4(acc[ai][0][m][1]); ss = lane_xor16_sum(ss); ss = lane_xor32_sum(ss); if (fq == 0) SSQ_KR[(size_t)row * 2 + wc] = ss; } }
        }
    }
};
struct EpiMlaQ {
    static constexpr bool PERM = true, AFTER_DRAIN = false;
    bf16_t* QM; const float *SSQ_QA, *COS, *SIN, *qg; PG8_LAS float* X;
    __device__ __forceinline__ void operator()(const f32x4 (&acc)[2][2][4][2], const Unit& u, int wr, int wc, int fr_, int fq_) const {
        float eps_ = EPS, k192 = 1.f / 192; asm volatile("" : "+s"(eps_), "+s"(k192));
        int fr = fr_, fq = fq_; asm volatile("" : "+v"(fr), "+v"(fq));
        const int h = u.pn, rowb = u.pm * BM + wr * 64 + fr, b = (u.pm * BM) / SEQ, c8 = wc * 32 + 8 * fq, rt = wr * 64 + fr;
#pragma unroll
        for (int ai = 0; ai < 2; ++ai)
#pragma unroll
            for (int m = 0; m < 4; ++m) { float ss = (sq4(acc[ai][0][m][0]) + sq4(acc[ai][0][m][1])) + (sq4(acc[ai][1][m][0]) + sq4(acc[ai][1][m][1])); ss = lane_xor16_sum(ss); ss = lane_xor32_sum(ss);
                if (fq == 0) X[(ai * HALF + m * 16 + rt) * 4 + wc] = ss; }
        asm volatile("s_waitcnt lgkmcnt(0)" ::: "memory"); __builtin_amdgcn_s_barrier(); asm volatile("" ::: "memory");
        const f32x4 g0a = *(const f32x4*)(qg + c8), g0b = *(const f32x4*)(qg + c8 + 4);
        const int i0 = 16 * wc + 4 * fq;
        f32x4 g1 = {0.f, 0.f, 0.f, 0.f}, g2 = g1; if (wc < 2) { g1 = *(const f32x4*)(qg + 128 + i0); g2 = *(const f32x4*)(qg + 160 + i0); }
        bf16_t* dst = QM + ((size_t)(b * NH + h) * SEQ) * 192;
#pragma unroll
        for (int ai = 0; ai < 2; ++ai)
#pragma unroll
        for (int mh = 0; mh < 4; mh += 2) {
        float rr[2][4]; f32x4 csv[2][4], snv[2][4];
#pragma unroll
            for (int m = mh; m < mh + 2; ++m) { const int row = rowb + ai * HALF + m * 16; const f32x4 xs = *(const PG8_LAS f32x4*)(X + (ai * HALF + m * 16 + rt) * 4);
                const f32x4 pa = *(const f32x4*)(SSQ_QA + (size_t)row * 8), pb = *(const f32x4*)(SSQ_QA + (size_t)row * 8 + 4);
                const float msq = (((pa[0] + pa[1]) + (pa[2] + pa[3])) + ((pb[0] + pb[1]) + (pb[2] + pb[3]))) * (1.f / 512) + eps_;
                rr[ai][m] = rsqrtf(((xs[0] + xs[1]) + (xs[2] + xs[3])) * k192 + eps_ * msq) * QS_MLA;
                if (wc < 2) { csv[ai][m] = *(const f32x4*)(COS + (size_t)row * 32 + i0); snv[ai][m] = *(const f32x4*)(SIN + (size_t)row * 32 + i0); } }
#pragma unroll
            for (int m = mh; m < mh + 2; ++m) { const int row = rowb + ai * HALF + m * 16; const float r = rr[ai][m];
                bf16_t* d = dst + (size_t)(row & (SEQ - 1)) * 192;
                *(u32x4*)(d + c8) = pk8(acc[ai][0][m][0] * g0a * r, acc[ai][0][m][1] * g0b * r);
                if (wc < 2) { const f32x4 cs = csv[ai][m], sn = snv[ai][m];
                    const f32x4 va = acc[ai][1][m][0], vb = acc[ai][1][m][1];
                    const f32x4 y1 = (f32x4){va[0], va[2], vb[0], vb[2]} * g1 * r, y2 = (f32x4){va[1], va[3], vb[1], vb[3]} * g2 * r;
                    const f32x4 o1 = y1 * cs - y2 * sn, o2 = y2 * cs + y1 * sn;
                    *(u32x4*)(d + 128 + c8) = pk8((f32x4){o1[0], o2[0], o1[1], o2[1]}, (f32x4){o1[2], o2[2], o1[3], o2[3]}); } }
        }
        asm volatile("s_waitcnt lgkmcnt(0)" ::: "memory"); __builtin_amdgcn_s_barrier(); asm volatile("" ::: "memory");
    }
};
struct EpiMlaKV {
    static constexpr bool PERM = true, AFTER_DRAIN = false;
    bf16_t *KM, *VM; const float *SSQ_KVA, *SSQ_KR, *KR, *COS, *SIN, *kg; PG8_LAS float* X;
    __device__ __forceinline__ void operator()(const f32x4 (&acc)[2][2][4][2], const Unit& u, int wr, int wc, int fr_, int fq_) const {
        float eps_ = EPS, k192 = 1.f / 192; asm volatile("" : "+s"(eps_), "+s"(k192));
        int fr = fr_, fq = fq_; asm volatile("" : "+v"(fr), "+v"(fq));
        const int h = u.pn, rowb = u.pm * BM + wr * 64 + fr, b = (u.pm * BM) / SEQ, c8 = wc * 32 + 8 * fq, rt = wr * 64 + fr;
#pragma unroll
        for (int ai = 0; ai < 2; ++ai)
#pragma unroll
            for (int m = 0; m < 4; ++m) { float ss = sq4(acc[ai][0][m][0]) + sq4(acc[ai][0][m][1]); ss = lane_xor16_sum(ss); ss = lane_xor32_sum(ss);
                if (fq == 0) X[(ai * HALF + m * 16 + rt) * 4 + wc] = ss; }
        asm volatile("s_waitcnt lgkmcnt(0)" ::: "memory"); __builtin_amdgcn_s_barrier(); asm volatile("" ::: "memory");
        const f32x4 g0a = *(const f32x4*)(kg + c8), g0b = *(const f32x4*)(kg + c8 + 4);
        const int i0 = 8 * wc + 2 * fq;
        const float g1a = kg[128 + i0], g1b = kg[128 + i0 + 1], g2a = kg[160 + i0], g2b = kg[160 + i0 + 1];
        bf16_t* kd = KM + ((size_t)(b * NH + h) * SEQ) * 192; bf16_t* vd = VM + ((size_t)(b * NH + h) * SEQ) * 128;
#pragma unroll
        for (int ai = 0; ai < 2; ++ai) {
        float rr[2][4], cv[2][4]; float2 k1v[2][4], k2v[2][4], cpv[2][4], spv[2][4];
#pragma unroll
            for (int m = 0; m < 4; ++m) { const int row = rowb + ai * HALF + m * 16; const f32x4 xs = *(const PG8_LAS f32x4*)(X + (ai * HALF + m * 16 + rt) * 4);
                const f32x4 pc = *(const f32x4*)(SSQ_KVA + (size_t)row * 4);
                const float c2 = 1.0f / (((pc[0] + pc[1]) + (pc[2] + pc[3])) * (1.f / 256) + eps_);
                const float2 sk = *(const float2*)(SSQ_KR + (size_t)row * 2);
                cv[ai][m] = sqrtf(c2); rr[ai][m] = rsqrtf((c2 * ((xs[0] + xs[1]) + (xs[2] + xs[3])) + (sk.x + sk.y)) * k192 + eps_);
                const float* kr = KR + (size_t)row * 64 + i0;
                k1v[ai][m] = *(const float2*)kr; k2v[ai][m] = *(const float2*)(kr + 32); cpv[ai][m] = *(const float2*)(COS + (size_t)row * 32 + i0); spv[ai][m] = *(const float2*)(SIN + (size_t)row * 32 + i0); }
#pragma unroll
            for (int m = 0; m < 4; ++m) { const int row = rowb + ai * HALF + m * 16; const float r = rr[ai][m], ckv = cv[ai][m];
                const int srow = row & (SEQ - 1);
                *(u32x4*)(kd + (size_t)srow * 192 + c8) = pk8(acc[ai][0][m][0] * g0a * (ckv * r), acc[ai][0][m][1] * g0b * (ckv * r));
                *(u32x4*)(vd + (size_t)srow * 128 + c8) = pk8(acc[ai][1][m][0] * ckv, acc[ai][1][m][1] * ckv);
                const float2 cp = cpv[ai][m], sp = spv[ai][m];
                const float y1a = k1v[ai][m].x * r * g1a, y1b = k1v[ai][m].y * r * g1b, y2a = k2v[ai][m].x * r * g2a, y2b = k2v[ai][m].y * r * g2b;
                const float oa1 = y1a * cp.x - y2a * sp.x, oa2 = y2a * cp.x + y1a * sp.x, ob1 = y1b * cp.y - y2b * sp.y, ob2 = y2b * cp.y + y1b * sp.y;
                *(unsigned long long*)(kd + (size_t)srow * 192 + 128 + 2 * i0) = (unsigned long long)cvt_pk_bf16(oa1, oa2) | ((unsigned long long)cvt_pk_bf16(ob1, ob2) << 32); }
        }
        asm volatile("s_waitcnt lgkmcnt(0)" ::: "memory"); __builtin_amdgcn_s_barrier(); asm volatile("" ::: "memory");
    }
};
}

struct Frame {
    LAS unsigned char* lds;
    int tid, lane, wave, wave0, gw, ngw, bid, G;
    const __attribute__((address_space(4))) Args* ka; const int* pos;
    float* out; unsigned char* ws;
};
__device__ __forceinline__ size_t opq(size_t v) { asm volatile("" : "+s"(v)); return v; }
#define WSP(T, off) ((T*)(F.ws + opq(off)))
#define FIN(i) ((const float*)F.ka->in[i])
__device__ __forceinline__ const bf16* wptr(const Frame& F, int l, size_t off) { return (const bf16*)(F.ws + WS_W + (size_t)l * WL_STRIDE + off); }

__device__ __forceinline__ void p0_transpose_item(const float* W, int K, int N, bf16* WT, int row_off, LAS float* scr, int item, int lane, int rstride = 1) {
    const int nblk = N / 32, kb = item / nblk, nb = item % nblk, k0 = 64 * kb, n0 = 32 * nb;
    float wv_[32];
#pragma unroll
    for (int i = 0; i < 32; ++i) { const int kk = 2 * i + (lane >> 5); wv_[i] = W[(size_t)(k0 + kk) * N + n0 + (lane & 31)]; }
#pragma unroll
    for (int i = 0; i < 32; ++i) { const int kk = 2 * i + (lane >> 5); scr[kk * 33 + (lane & 31)] = wv_[i]; }
    LDS_WAIT(); asm volatile("" ::: "memory");
    const int c = lane & 7;
#pragma unroll
    for (int j = 0; j < 4; ++j) { const int n = (lane >> 3) + 8 * j; const LAS float* s = scr + (8 * c) * 33 + n;
        v4u o; o.x = pk2(s[0 * 33], s[1 * 33]); o.y = pk2(s[2 * 33], s[3 * 33]); o.z = pk2(s[4 * 33], s[5 * 33]); o.w = pk2(s[6 * 33], s[7 * 33]);
        *(v4u*)(WT + (size_t)(row_off + n0 + rstride * n) * K + k0 + 8 * c) = o; }
    LDS_WAIT(); asm volatile("" ::: "memory");
}
__device__ __forceinline__ void ph_prologue(Frame& F) {
    LAS float* scr = (LAS float*)(F.lds + F.wave * 16384);
    constexpr int I_IN = (D / 64) * (IN_COLS / 32), I_UQ = (QRANK / 64) * (UQ_N / 32), I_UKV = (KVRANK / 64) * (UKV_N / 32), I_OUT = (D / 64) * (D / 32), I_UP = (D / 64) * (NUP / 32), I_DN = (DFF / 64) * (D / 32);
    constexpr int I_L = I_IN + I_UQ + I_UKV + I_OUT + I_UP + I_DN;
    for (int it = F.gw; it < DEPTH * I_L; it += F.ngw) {
        const int l = it / I_L; int r = it % I_L;
        bf16* wl = (bf16*)(F.ws + WS_W + (size_t)l * WL_STRIDE);
        if (r < I_IN) { const int n0 = 32 * (r % (IN_COLS / 32)); int dst;
            if (n0 < C_DAV) { const int q = n0 % 768, G = q / 64, e = q % 64; dst = (n0 - q) + 256 * (G / 4) + 128 * (e / 32) + 32 * (G % 4) + (e % 32); }
            else if (n0 < C_KR) dst = n0;
            else if (n0 < C_SGU) dst = 4096 + (n0 - C_KR);
            else dst = n0 - 64;
            p0_transpose_item(FIN(I_WIN) + (size_t)l * D * IN_COLS, D, IN_COLS, (bf16*)((unsigned char*)wl + WL_IN), dst - n0, scr, r, F.lane); continue; } r -= I_IN;
        if (r < I_UQ) { const int n0 = 32 * (r % (UQ_N / 32)), hh = n0 / 192, e = n0 % 192;
            const int dst = 256 * hh + (e < 128 ? e : 128 + (e - 128) / 32);
            p0_transpose_item(FIN(I_WUQ) + (size_t)l * QRANK * UQ_N, QRANK, UQ_N, (bf16*)((unsigned char*)wl + WL_UQ), dst - n0, scr, r, F.lane, e < 128 ? 1 : 2); continue; } r -= I_UQ;
        if (r < I_UKV) { p0_transpose_item(FIN(I_WUKV) + (size_t)l * KVRANK * UKV_N, KVRANK, UKV_N, (bf16*)((unsigned char*)wl + WL_UKV), 0, scr, r, F.lane); continue; } r -= I_UKV;
        if (r < I_OUT) { p0_transpose_item(FIN(I_WOUT) + (size_t)l * D * D, D, D, (bf16*)((unsigned char*)wl + WL_OUT), 0, scr, r, F.lane); continue; } r -= I_OUT;
        if (r < I_UP) { const int n0 = 32 * (r % (NUP / 32)), chn = n0 % DFF, dst = 256 * (chn / 128) + 128 * (n0 / DFF) + (chn % 128);
            p0_transpose_item(FIN(I_WUP) + (size_t)l * D * NUP, D, NUP, (bf16*)((unsigned char*)wl + WL_UP), dst - n0, scr, r, F.lane); continue; } r -= I_UP;
        p0_transpose_item(FIN(I_WDOWN) + (size_t)l * DFF * D, DFF, D, (bf16*)((unsigned char*)wl + WL_DOWN), 0, scr, r, F.lane);
    }
    {
        const int gt = F.bid * NTHREADS + F.tid, nt = F.G * NTHREADS;
        constexpr int Z_IN = (IN_PAD - IN_COLS) * D / 8, Z_UQ = NH * 64 * QRANK / 8;
        for (int i = gt; i < DEPTH * (Z_IN + Z_UQ); i += nt) { const int l = i / (Z_IN + Z_UQ); int r = i % (Z_IN + Z_UQ);
            unsigned char* wl = F.ws + WS_W + (size_t)l * WL_STRIDE;
            v4u z = {0u, 0u, 0u, 0u};
            if (r < Z_IN) *(v4u*)(wl + WL_IN + (size_t)IN_COLS * D * 2 + (size_t)r * 16) = z;
            else { r -= Z_IN; const int hh = r / (64 * QRANK / 8), q = r % (64 * QRANK / 8); *(v4u*)(wl + WL_UQ + ((size_t)(256 * hh + 192) * QRANK) * 2 + (size_t)q * 16) = z; } }
    }
    __syncthreads();
    LAS float* cond = (LAS float*)F.lds;
    for (int i = F.tid; i < 2 * D; i += NTHREADS) cond[i] = silu_f(FIN(I_C)[i]);
    __syncthreads();
    {
        const int gt = F.bid * NTHREADS + F.tid, nt = F.G * NTHREADS;
        float* part = WSP(float, WS_MODP);
        for (int it = gt; it < DEPTH * 16 * 3072; it += nt) {
            const int n4 = it % 3072, ks = (it / 3072) % 16, l = it / (3072 * 16);
            const float* w = FIN(I_WADA) + ((size_t)l * D + ks * 128) * (6 * D) + n4 * 4;
            f32x4 a0 = {0.f, 0.f, 0.f, 0.f}, a1 = {0.f, 0.f, 0.f, 0.f};
#pragma unroll 8
            for (int k = 0; k < 128; ++k) { const f32x4 wv = *(const f32x4*)(w + (size_t)k * (6 * D)); a0 += cond[ks * 128 + k] * wv; a1 += cond[D + ks * 128 + k] * wv; }
            *(f32x4*)(part + ((size_t)(l * 16 + ks) * 2 + 0) * (6 * D) + n4 * 4) = a0;
            *(f32x4*)(part + ((size_t)(l * 16 + ks) * 2 + 1) * (6 * D) + n4 * 4) = a1;
        }
    }
    __syncthreads();
}
__device__ __forceinline__ void ph_modreduce(Frame& F) {
    const int gt = F.bid * NTHREADS + F.tid, nt = F.G * NTHREADS;
    const float* part = WSP(float, WS_MODP); float* mod = WSP(float, WS_MOD);
    for (int i = gt; i < DEPTH * 2 * 6 * D; i += nt) { const int n = i % (6 * D), b = (i / (6 * D)) & 1, l = i / (12 * D);
        float s = FIN(I_BADA)[l * 6 * D + n];
#pragma unroll
        for (int ks = 0; ks < 16; ++ks) s += part[((size_t)(l * 16 + ks) * 2 + b) * (6 * D) + n];
        mod[i] = s; }
    { float* ct = WSP(float, WS_COS); float* st = WSP(float, WS_SIN);
      for (int i = gt; i < M * 32; i += nt) { const float ang = (float)F.pos[i >> 5] * ROPE_INV[i & 31];
          const double rev = (double)ang * 0.15915494309189535; const float fr = (float)(rev - floor(rev));
          ct[i] = __builtin_amdgcn_cosf(fr); st[i] = __builtin_amdgcn_sinf(fr); } }
    if (gt < M / 64) { int mn = 0x7fffffff, mx = -0x7fffffff - 1;
        for (int i = 0; i < 64; ++i) { const int p = F.pos[gt * 64 + i]; mn = p < mn ? p : mn; mx = p > mx ? p : mx; }
        int* mm = WSP(int, WS_POSMM); mm[gt * 2] = mn; mm[gt * 2 + 1] = mx; }
}
template <bool XBF> __device__ __forceinline__ void ph_norm(Frame& F, int l, const void* xsrc, int sh_off, int sc_off) {
    const float* mod = WSP(float, WS_MOD) + (size_t)l * 12 * D; bf16* H = WSP(bf16, WS_H);
    for (int row = F.gw; row < M; row += F.ngw) {
        const int b = row >> 13;
        const float* mb = mod + (size_t)b * 6 * D;
        if constexpr (XBF) {
            const v4u* xr = (const v4u*)((const bf16*)xsrc + (size_t)row * D) + F.lane;
            v4u w[4]; float v[4][8]; float s = 0.f;
#pragma unroll
            for (int j = 0; j < 4; ++j) w[j] = xr[64 * j];
#pragma unroll
            for (int j = 0; j < 4; ++j) { const unsigned ww[4] = {w[j].x, w[j].y, w[j].z, w[j].w};
#pragma unroll
                for (int q = 0; q < 4; ++q) { v[j][2 * q] = pg8::uph_lo(ww[q]); v[j][2 * q + 1] = pg8::uph_hi(ww[q]); s += v[j][2 * q] * v[j][2 * q] + v[j][2 * q + 1] * v[j][2 * q + 1]; } }
            const float r = rsqrtf(wave_sum(s) * (1.f / D) + EPS);
            v4u* o16 = (v4u*)(H + (size_t)row * D) + F.lane;
#pragma unroll
            for (int j = 0; j < 4; ++j) { const int c = 8 * F.lane + 512 * j;
                const f32x4 sc0 = *(const f32x4*)(mb + sc_off + c), sc1 = *(const f32x4*)(mb + sc_off + c + 4), sh0 = *(const f32x4*)(mb + sh_off + c), sh1 = *(const f32x4*)(mb + sh_off + c + 4);
                v4u o; o.x = pk2(v[j][0] * r * (1.0f + sc0.x) + sh0.x, v[j][1] * r * (1.0f + sc0.y) + sh0.y); o.y = pk2(v[j][2] * r * (1.0f + sc0.z) + sh0.z, v[j][3] * r * (1.0f + sc0.w) + sh0.w);
                o.z = pk2(v[j][4] * r * (1.0f + sc1.x) + sh1.x, v[j][5] * r * (1.0f + sc1.y) + sh1.y); o.w = pk2(v[j][6] * r * (1.0f + sc1.z) + sh1.z, v[j][7] * r * (1.0f + sc1.w) + sh1.w);
                o16[64 * j] = o; }
        } else {
        const f32x4* xr = (const f32x4*)((const float*)xsrc + (size_t)row * D) + F.lane;
        f32x4 v[8]; float s = 0.f;
#pragma unroll
        for (int j = 0; j < 8; ++j) { v[j] = xr[64 * j]; s += (v[j].x * v[j].x + v[j].y * v[j].y) + (v[j].z * v[j].z + v[j].w * v[j].w); }
        const float r = rsqrtf(wave_sum(s) * (1.f / D) + EPS);
        unsigned long long* o8 = (unsigned long long*)(H + (size_t)row * D) + F.lane;
#pragma unroll
        for (int j = 0; j < 8; ++j) { const int c = 4 * F.lane + 256 * j;
            const f32x4 sc = *(const f32x4*)(mb + sc_off + c), sh = *(const f32x4*)(mb + sh_off + c);
            const f32x4 y = v[j] * r * (1.0f + sc) + sh;
            o8[64 * j] = (unsigned long long)pk2(y.x, y.y) | ((unsigned long long)pk2(y.z, y.w) << 32); }
        }
    }
}

namespace fa {
#ifndef PIPE_MLA
#define PIPE_MLA 1
#endif
#ifndef PIPE_LIN
#define PIPE_LIN 0
#endif
#ifndef PIPE_GEN
#define PIPE_GEN 0
#endif
#ifndef PIPE_OLD64
#define PIPE_OLD64 0
#endif
template <typename T> __device__ __forceinline__ T ldg(const void* base, unsigned off) { return *(const T*)((const char*)base + off); }
template <typename T> __device__ __forceinline__ void stg(void* base, unsigned off, T v) { *(T*)((char*)base + off) = v; }
constexpr int crowc(int r) { return (r & 3) + 8 * (r >> 2); }
using s16x4 = __attribute__((ext_vector_type(4))) short;
using f32x8 = __attribute__((ext_vector_type(8))) float;
constexpr int QBLK = 32, KVBLK = 64, DV = 128;
constexpr int SHM_V = KVBLK * DV * 2;
constexpr float THR = 11.5f;
#define FA_SBAR() __builtin_amdgcn_sched_barrier(0)
__device__ __forceinline__ unsigned cvtpk(float lo, float hi) { unsigned r; asm volatile("v_cvt_pk_bf16_f32 %0, %1, %2" : "=v"(r) : "v"(lo), "v"(hi)); return r; }
__device__ __forceinline__ int kswz(int row, int colB) { return (colB >> 7) * 8192 + row * 128 + ((colB & 127) ^ (((row >> 1) & 7) << 4)); }
__device__ __forceinline__ int v_st(int k, int c) { const int kk = (k & ~0xC) | ((k & 4) << 1) | ((k & 8) >> 1); return ((kk >> 3) * 4 + (c >> 5)) * 512 + ((kk & 7) * 32 + (c & 31)) * 2; }
__device__ __forceinline__ int v_st_nat(int k, int c) { return ((k >> 3) * 4 + (c >> 5)) * 512 + ((k & 7) * 32 + (c & 31)) * 2; }
__device__ __forceinline__ int v_rd_base(int lane) { return ((lane & 3) << 3) | (((lane >> 2) & 3) << 6) | (((lane >> 4) & 1) << 5) | (((lane >> 5) & 1) << 8); }
constexpr int v_rd_off(int d0, int ks, int half) { return d0 * 512 + ks * 4096 + half * 2048; }
template <int OFF> __device__ __forceinline__ s16x4 tr_read(int vb) { s16x4 r; asm volatile("ds_read_b64_tr_b16 %0, %1 offset:%2" : "=&v"(r) : "v"(vb), "i"(OFF) : "memory"); return r; }
template <int D0> __device__ __forceinline__ void pv_one(f32x16& od, int vb, bf16x8 pa0, bf16x8 pa1, bf16x8 pa2, bf16x8 pa3) {
    const s16x4 l0 = tr_read<v_rd_off(D0, 0, 0)>(vb), h0 = tr_read<v_rd_off(D0, 0, 1)>(vb), l1 = tr_read<v_rd_off(D0, 1, 0)>(vb), h1 = tr_read<v_rd_off(D0, 1, 1)>(vb);
    const s16x4 l2 = tr_read<v_rd_off(D0, 2, 0)>(vb), h2 = tr_read<v_rd_off(D0, 2, 1)>(vb), l3 = tr_read<v_rd_off(D0, 3, 0)>(vb), h3 = tr_read<v_rd_off(D0, 3, 1)>(vb);
    asm volatile("s_waitcnt lgkmcnt(0)" ::: "memory"); FA_SBAR();
#define FA_PK(L, H) (bf16x8){L[0], L[1], L[2], L[3], H[0], H[1], H[2], H[3]}
    od = __builtin_amdgcn_mfma_f32_32x32x16_bf16(pa0, FA_PK(l0, h0), od, 0, 0, 0);
    od = __builtin_amdgcn_mfma_f32_32x32x16_bf16(pa1, FA_PK(l1, h1), od, 0, 0, 0);
    od = __builtin_amdgcn_mfma_f32_32x32x16_bf16(pa2, FA_PK(l2, h2), od, 0, 0, 0);
    od = __builtin_amdgcn_mfma_f32_32x32x16_bf16(pa3, FA_PK(l3, h3), od, 0, 0, 0);
#undef FA_PK
}
__device__ __forceinline__ void pv_d0(f32x16* o, int vb, bf16x8 pa0, bf16x8 pa1, bf16x8 pa2, bf16x8 pa3) {
    pv_one<0>(o[0], vb, pa0, pa1, pa2, pa3); pv_one<1>(o[1], vb, pa0, pa1, pa2, pa3); pv_one<2>(o[2], vb, pa0, pa1, pa2, pa3); pv_one<3>(o[3], vb, pa0, pa1, pa2, pa3);
}
template <int D0> __device__ __forceinline__ void pv_reads(s16x4 (&l)[4], s16x4 (&h)[4], int vb) {
    l[0] = tr_read<v_rd_off(D0, 0, 0)>(vb); h[0] = tr_read<v_rd_off(D0, 0, 1)>(vb); l[1] = tr_read<v_rd_off(D0, 1, 0)>(vb); h[1] = tr_read<v_rd_off(D0, 1, 1)>(vb);
    l[2] = tr_read<v_rd_off(D0, 2, 0)>(vb); h[2] = tr_read<v_rd_off(D0, 2, 1)>(vb); l[3] = tr_read<v_rd_off(D0, 3, 0)>(vb); h[3] = tr_read<v_rd_off(D0, 3, 1)>(vb);
}
__device__ __forceinline__ void pv_mfma(f32x16& od, const s16x4 (&l)[4], const s16x4 (&h)[4], bf16x8 pa0, bf16x8 pa1, bf16x8 pa2, bf16x8 pa3) {
#define FA_PK(L, H) (bf16x8){L[0], L[1], L[2], L[3], H[0], H[1], H[2], H[3]}
    od = __builtin_amdgcn_mfma_f32_32x32x16_bf16(pa0, FA_PK(l[0], h[0]), od, 0, 0, 0);
    od = __builtin_amdgcn_mfma_f32_32x32x16_bf16(pa1, FA_PK(l[1], h[1]), od, 0, 0, 0);
    od = __builtin_amdgcn_mfma_f32_32x32x16_bf16(pa2, FA_PK(l[2], h[2]), od, 0, 0, 0);
    od = __builtin_amdgcn_mfma_f32_32x32x16_bf16(pa3, FA_PK(l[3], h[3]), od, 0, 0, 0);
#undef FA_PK
}
__device__ __forceinline__ void pv_d0_pipe(f32x16* o, int vb, bf16x8 pa0, bf16x8 pa1, bf16x8 pa2, bf16x8 pa3) {
    s16x4 la[4], ha[4], lb[4], hb[4];
    pv_reads<0>(la, ha, vb); pv_reads<1>(lb, hb, vb);
    asm volatile("s_waitcnt lgkmcnt(8)" ::: "memory"); FA_SBAR(); pv_mfma(o[0], la, ha, pa0, pa1, pa2, pa3); FA_SBAR();
    pv_reads<2>(la, ha, vb);
    asm volatile("s_waitcnt lgkmcnt(8)" ::: "memory"); FA_SBAR(); pv_mfma(o[1], lb, hb, pa0, pa1, pa2, pa3); FA_SBAR();
    pv_reads<3>(lb, hb, vb);
    asm volatile("s_waitcnt lgkmcnt(8)" ::: "memory"); FA_SBAR(); pv_mfma(o[2], la, ha, pa0, pa1, pa2, pa3); FA_SBAR();
    asm volatile("s_waitcnt lgkmcnt(0)" ::: "memory"); FA_SBAR(); pv_mfma(o[3], lb, hb, pa0, pa1, pa2, pa3);
}
__device__ __forceinline__ void partialSM(f32x16& p0, f32x16& p1, float& m_reg, float& alpha) {
    float pmax = p0[0];
#pragma unroll
    for (int r = 1; r < 16; ++r) pmax = fmaxf(pmax, p0[r]);
#pragma unroll
    for (int r = 0; r < 16; ++r) pmax = fmaxf(pmax, p1[r]);
    { auto rr = __builtin_amdgcn_permlane32_swap(__float_as_uint(pmax), __float_as_uint(pmax), false, false); pmax = fmaxf(__uint_as_float(rr[0]), __uint_as_float(rr[1])); }
    float mn;
    if (__builtin_expect(__all(pmax - m_reg <= THR), 1)) { mn = m_reg; alpha = 1.f; }
    else { mn = fmaxf(m_reg, pmax); alpha = __builtin_amdgcn_exp2f(m_reg - mn); m_reg = mn; }
#pragma unroll
    for (int r = 0; r < 16; ++r) { p0[r] -= mn; p1[r] -= mn; }
#pragma unroll
    for (int r = 0; r < 16; ++r) p0[r] = __builtin_amdgcn_exp2f(p0[r]);
}
__device__ __forceinline__ void finishSM(f32x16& p0, f32x16& p1, float alpha, float& l_reg, bf16x8& pa0, bf16x8& pa1, bf16x8& pa2, bf16x8& pa3) {
#pragma unroll
    for (int r = 0; r < 16; ++r) p1[r] = __builtin_amdgcn_exp2f(p1[r]);
    float ps = 0;
#pragma unroll
    for (int r = 0; r < 16; ++r) ps += p0[r];
#pragma unroll
    for (int r = 0; r < 16; ++r) ps += p1[r];
    { auto rr = __builtin_amdgcn_permlane32_swap(__float_as_uint(ps), __float_as_uint(ps), false, false); ps = __uint_as_float(rr[0]) + __uint_as_float(rr[1]); }
    l_reg = l_reg * alpha + ps;
#define FA_PK4(P, BASE, OUT) do { unsigned a0 = cvtpk(P[BASE + 0], P[BASE + 1]), a1 = cvtpk(P[BASE + 2], P[BASE + 3]);   \
    unsigned b0 = cvtpk(P[BASE + 4], P[BASE + 5]), b1 = cvtpk(P[BASE + 6], P[BASE + 7]);                              \
    auto r0 = __builtin_amdgcn_permlane32_swap(a0, b0, false, false); auto r1 = __builtin_amdgcn_permlane32_swap(a1, b1, false, false); \
    u32x4_t w = {r0[0], r1[0], r0[1], r1[1]}; OUT = __builtin_bit_cast(bf16x8, w); } while (0)
    typedef unsigned u32x4_t __attribute__((ext_vector_type(4)));
    FA_PK4(p0, 0, pa0); FA_PK4(p0, 8, pa1); FA_PK4(p1, 0, pa2); FA_PK4(p1, 8, pa3);
#undef FA_PK4
}
template <bool ALIBI> __device__ __forceinline__ void fr_init(f32x16& p0, f32x16& p1, const LAS float* posl, float posq, float slope2, bool linear, int hi) {
    if (linear) {
        const float cl = -slope2 * posq;
#pragma unroll
        for (int g = 0; g < 4; ++g) { const f32x4 k0 = *(const LAS f32x4*)(posl + 8 * g + 4 * hi), k1 = *(const LAS f32x4*)(posl + 32 + 8 * g + 4 * hi);
#pragma unroll
            for (int e = 0; e < 4; ++e) { p0[4 * g + e] = fmaf(slope2, k0[e], cl); p1[4 * g + e] = fmaf(slope2, k1[e], cl); } }
    } else {
#pragma unroll
        for (int g = 0; g < 4; ++g) { const f32x4 k0 = *(const LAS f32x4*)(posl + 8 * g + 4 * hi), k1 = *(const LAS f32x4*)(posl + 32 + 8 * g + 4 * hi);
#pragma unroll
            for (int e = 0; e < 4; ++e) { p0[4 * g + e] = -slope2 * fabsf(posq - k0[e]); p1[4 * g + e] = -slope2 * fabsf(posq - k1[e]); } }
    }
}
__device__ __forceinline__ void fr_softmax(f32x16& p0, f32x16& p1, float& l_reg, bf16x8& pa0, bf16x8& pa1, bf16x8& pa2, bf16x8& pa3) {
#pragma unroll
    for (int r = 0; r < 16; ++r) { p0[r] = __builtin_amdgcn_exp2f(p0[r]); p1[r] = __builtin_amdgcn_exp2f(p1[r]); }
    float sa = 0.f, sb = 0.f;
#pragma unroll
    for (int r = 0; r < 16; ++r) { sa += p0[r]; sb += p1[r]; }
    l_reg += sa + sb;
    typedef unsigned u32x4_t __attribute__((ext_vector_type(4)));
#define FA_PKS(P, BASE, OUT) do { u32x4_t w = {cvtpk(P[BASE + 0], P[BASE + 1]), cvtpk(P[BASE + 2], P[BASE + 3]), cvtpk(P[BASE + 4], P[BASE + 5]), cvtpk(P[BASE + 6], P[BASE + 7])}; OUT = __builtin_bit_cast(bf16x8, w); } while (0)
    FA_PKS(p0, 0, pa0); FA_PKS(p0, 8, pa1); FA_PKS(p1, 0, pa2); FA_PKS(p1, 8, pa3);
#undef FA_PKS
}
template <int DQK> struct Lds {
    static constexpr int SHM_K = KVBLK * DQK * 2;
    static constexpr int V_OFF = 0, K_OFF = 2 * SHM_V, POS_OFF = K_OFF + 2 * SHM_K, WS_OFF = POS_OFF + 2 * 256, END = WS_OFF + 8 * 256;
};
template <int DQK, bool INIT = true> __device__ __forceinline__ void qkt(f32x16& p0, f32x16& p1, const LAS unsigned char* Ks, const bf16x8* qr, int r32, int hi) {
    if (INIT) { p0 = f32x16{}; p1 = f32x16{}; }
#pragma unroll
    for (int d0 = 0; d0 < DQK / 16; ++d0) { const int cb = (d0 * 16 + hi * 8) * 2;
        const bf16x8 b0 = *(const LAS bf16x8*)(Ks + kswz(r32, cb));
        const bf16x8 b1 = *(const LAS bf16x8*)(Ks + kswz(32 + r32, cb));
        p0 = __builtin_amdgcn_mfma_f32_32x32x16_bf16(b0, qr[d0], p0, 0, 0, 0);
        p1 = __builtin_amdgcn_mfma_f32_32x32x16_bf16(b1, qr[d0], p1, 0, 0, 0);
        if (DQK > 64 && (d0 & 3) == 3) FA_SBAR(); }
}
template <int OFF> __device__ __forceinline__ bf16x8 k_read(int addr) { bf16x8 r; asm volatile("ds_read_b128 %0, %1 offset:%2" : "=&v"(r) : "v"(addr), "i"(OFF) : "memory"); return r; }
__device__ __forceinline__ void k_bases(int (&ka)[4], const LAS unsigned char* K_lds, int r32, int hi) {
#pragma unroll
    for (int j = 0; j < 4; ++j) ka[j] = (int)(uintptr_t)K_lds + r32 * 128 + ((j * 32 + hi * 16) ^ (((r32 >> 1) & 7) << 4));
}
#define FA_LGK(n) asm volatile("s_waitcnt lgkmcnt(" #n ")" ::: "memory")
template <int DQK, int BOFF, int VAR = 0> __device__ __forceinline__ void qkt_pipe(f32x16& p0, f32x16& p1, const int (&ka)[4], const bf16x8* qr) {
    if constexpr (DQK == 64) {
        bf16x8 a0 = k_read<BOFF>(ka[0]), b0 = k_read<BOFF + 4096>(ka[0]), a1 = k_read<BOFF>(ka[1]), b1 = k_read<BOFF + 4096>(ka[1]);
        bf16x8 a2 = k_read<BOFF>(ka[2]), b2 = k_read<BOFF + 4096>(ka[2]), a3 = k_read<BOFF>(ka[3]), b3 = k_read<BOFF + 4096>(ka[3]);
        FA_LGK(6); FA_SBAR(); p0 = __builtin_amdgcn_mfma_f32_32x32x16_bf16(a0, qr[0], p0, 0, 0, 0); p1 = __builtin_amdgcn_mfma_f32_32x32x16_bf16(b0, qr[0], p1, 0, 0, 0); FA_SBAR();
        FA_LGK(4); FA_SBAR(); p0 = __builtin_amdgcn_mfma_f32_32x32x16_bf16(a1, qr[1], p0, 0, 0, 0); p1 = __builtin_amdgcn_mfma_f32_32x32x16_bf16(b1, qr[1], p1, 0, 0, 0); FA_SBAR();
        FA_LGK(2); FA_SBAR(); p0 = __builtin_amdgcn_mfma_f32_32x32x16_bf16(a2, qr[2], p0, 0, 0, 0); p1 = __builtin_amdgcn_mfma_f32_32x32x16_bf16(b2, qr[2], p1, 0, 0, 0); FA_SBAR();
        FA_LGK(0); FA_SBAR(); p0 = __builtin_amdgcn_mfma_f32_32x32x16_bf16(a3, qr[3], p0, 0, 0, 0); p1 = __builtin_amdgcn_mfma_f32_32x32x16_bf16(b3, qr[3], p1, 0, 0, 0); FA_SBAR();
    } else {
        static_assert(DQK == 192, "qkt_pipe: d = 64 or 192");
#define FA_KG(G, x0, y0, x1, y1) do { x0 = k_read<BOFF + ((2 * (G)) >> 2) * 8192>(ka[(2 * (G)) & 3]); y0 = k_read<BOFF + ((2 * (G)) >> 2) * 8192 + 4096>(ka[(2 * (G)) & 3]); \
        x1 = k_read<BOFF + ((2 * (G) + 1) >> 2) * 8192>(ka[(2 * (G) + 1) & 3]); y1 = k_read<BOFF + ((2 * (G) + 1) >> 2) * 8192 + 4096>(ka[(2 * (G) + 1) & 3]); } while (0)
#define FA_KM(G, x0, y0, x1, y1) do { FA_SBAR(); if (VAR == 6) { p0 = __builtin_amdgcn_mfma_f32_32x32x16_bf16(x0 ^ y0 ^ x1 ^ y1, qr[2 * (G)], p0, 0, 0, 0); } else { \
        p0 = __builtin_amdgcn_mfma_f32_32x32x16_bf16(x0, qr[2 * (G)], p0, 0, 0, 0); p1 = __builtin_amdgcn_mfma_f32_32x32x16_bf16(y0, qr[2 * (G)], p1, 0, 0, 0); \
        p0 = __builtin_amdgcn_mfma_f32_32x32x16_bf16(x1, qr[2 * (G) + 1], p0, 0, 0, 0); p1 = __builtin_amdgcn_mfma_f32_32x32x16_bf16(y1, qr[2 * (G) + 1], p1, 0, 0, 0); } FA_SBAR(); } while (0)
        bf16x8 a0, b0, a1, b1, c0, d0, c1, d1;
        if constexpr (VAR == 5) {
#pragma unroll
            for (int g = 0; g < 12; ++g) { FA_SBAR(); p0 = __builtin_amdgcn_mfma_f32_32x32x16_bf16(qr[(g + 1) % 12], qr[g], p0, 0, 0, 0); p1 = __builtin_amdgcn_mfma_f32_32x32x16_bf16(qr[(g + 5) % 12], qr[g], p1, 0, 0, 0); FA_SBAR(); }
            return; }
        FA_KG(0, a0, b0, a1, b1); FA_KG(1, c0, d0, c1, d1);
        FA_LGK(4); FA_KM(0, a0, b0, a1, b1); FA_KG(2, a0, b0, a1, b1);
        FA_LGK(4); FA_KM(1, c0, d0, c1, d1); FA_KG(3, c0, d0, c1, d1);
        FA_LGK(4); FA_KM(2, a0, b0, a1, b1); FA_KG(4, a0, b0, a1, b1);
        FA_LGK(4); FA_KM(3, c0, d0, c1, d1); FA_KG(5, c0, d0, c1, d1);
        FA_LGK(4); FA_KM(4, a0, b0, a1, b1);
        FA_LGK(0); FA_KM(5, c0, d0, c1, d1);
#undef FA_KG
#undef FA_KM
    }
}
template <bool ALIBI> __device__ __forceinline__ void fixup(f32x16& p0, f32x16& p1, const LAS float* posl, float posq, float slope2, bool masked, int hi) {
    if (ALIBI) {
#pragma unroll
        for (int g = 0; g < 4; ++g) { const f32x4 k0 = *(const LAS f32x4*)(posl + 8 * g + 4 * hi), k1 = *(const LAS f32x4*)(posl + 32 + 8 * g + 4 * hi);
#pragma unroll
            for (int e = 0; e < 4; ++e) { p0[4 * g + e] = fmaf(-slope2, fabsf(posq - k0[e]), p0[4 * g + e]); p1[4 * g + e] = fmaf(-slope2, fabsf(posq - k1[e]), p1[4 * g + e]); } }
    }
    if (masked) {
#pragma unroll
        for (int r = 0; r < 16; ++r) { p0[r] = -INFINITY; p1[r] = -INFINITY; }
    }
}
template <int DQK, bool ALIBI, int NSLOT, int MODE = 0, int VAR = 0>
__device__ __forceinline__ void attn_pass(const bf16* __restrict__ Qb, const bf16* __restrict__ Kh, const bf16* __restrict__ Vh, const int* __restrict__ posb, float slope2, float cref, int TL, int q0, int T0, int NT,
                                          LAS unsigned char* lds, int tid_, f32x16 (&o)[4], float& l_out) {
    typedef Lds<DQK> L; constexpr int KSUB = DQK / 64, SHM_K = L::SHM_K;
    const int wid = __builtin_amdgcn_readfirstlane(tid_ >> 6); int lane; asm volatile("v_mbcnt_lo_u32_b32 %0, -1, 0\n\tv_mbcnt_hi_u32_b32 %0, -1, %0" : "=v"(lane));
    const int tid = wid * 64 + lane, r32 = lane & 31, hi = lane >> 5;
    if (wid >= 4) __builtin_amdgcn_s_setprio(1);
    LAS unsigned char* V_lds = lds + L::V_OFF; LAS unsigned char* K_lds = lds + L::K_OFF; LAS float* P_lds = (LAS float*)(lds + L::POS_OFF);
    LAS float* al_l = (LAS float*)(lds + L::WS_OFF) + wid * 64;
    float m_reg = -1e30f, l_reg = 0.f;
#pragma unroll
    for (int d = 0; d < 4; ++d) o[d] = f32x16{};
    bf16x8 qr[DQK / 16];
    { const bf16* Qw = Qb + (size_t)(wid * QBLK) * DQK; unsigned qgo = (unsigned)(r32 * DQK + hi * 8) * 2u; asm volatile("" : "+v"(qgo));
#pragma unroll
      for (int d0 = 0; d0 < DQK / 16; ++d0) qr[d0] = ldg<bf16x8>(Qw + d0 * 16, qgo); }
    const float posq = ALIBI ? (float)posb[q0 + wid * QBLK + r32] : 0.f;
    const int tmax = NT - 4 + (wid >> 1);
    const int sr = tid >> 4, sc = (tid & 15) * 8, vst0 = MODE == 5 ? v_st_nat(sr, sc) : v_st(sr, sc), vst1 = MODE == 5 ? v_st_nat(32 + sr, sc) : v_st(32 + sr, sc);
    const int kr = tid >> 3, kc = (tid & 7) * 8, kst = kswz(kr, kc * 2);
    unsigned vgo = (unsigned)(sr * DV + sc) * 2u, kgo = (unsigned)(kr * DQK + kc) * 2u, pgo = (unsigned)(tid & 63) * 4u; asm volatile("" : "+v"(vgo), "+v"(kgo), "+v"(pgo));
    const int vb0 = (int)(uintptr_t)V_lds + v_rd_base(lane);
    int ka[4]; k_bases(ka, K_lds, r32, hi);
    struct Slot { bf16x8 vs0, vs1, ks[KSUB]; int ps; } sl_[NSLOT];
#define FA_SLOAD(i, k0) do { unsigned kk_ = (unsigned)__builtin_amdgcn_readfirstlane((int)(k0)); asm volatile("" : "+s"(kk_));     \
    const bf16* Vt_ = Vh + (size_t)kk_ * DV; const bf16* Kt_ = Kh + (size_t)kk_ * DQK; \
    sl_[i].vs0 = ldg<bf16x8>(Vt_, vgo); sl_[i].vs1 = ldg<bf16x8>(Vt_ + 32 * DV, vgo); \
    _Pragma("unroll") for (int s_ = 0; s_ < KSUB; ++s_) sl_[i].ks[s_] = ldg<bf16x8>(Kt_ + s_ * 64, kgo); \
    if (ALIBI) sl_[i].ps = ldg<int>(posb + kk_, pgo); } while (0)
#define FA_SWRITE(b, i) do { *(LAS bf16x8*)(V_lds + (b) * SHM_V + vst0) = sl_[i].vs0; *(LAS bf16x8*)(V_lds + (b) * SHM_V + vst1) = sl_[i].vs1; \
    _Pragma("unroll") for (int s_ = 0; s_ < KSUB; ++s_) *(LAS bf16x8*)(K_lds + (b) * SHM_K + s_ * 8192 + kst) = sl_[i].ks[s_]; \
    if (ALIBI) { if (tid < 64) P_lds[(b) * 64 + tid] = (float)sl_[i].ps; } } while (0)
#define FA_RESC(a) do { if (__any((a) < 1.f)) { if (hi == 0) al_l[r32] = (a); asm volatile("s_waitcnt lgkmcnt(0)" ::: "memory"); \
    _Pragma("unroll") for (int d = 0; d < 4; ++d) _Pragma("unroll") for (int r = 0; r < 16; ++r) o[d][r] *= al_l[crow(r, hi)]; } } while (0)
#define FA_COMPUTE(b, t, STAGE) do { bf16x8 pa0, pa1, pa2, pa3; const bool vis_ = (t) <= tmax;     \
    if (vis_) { f32x16 p0, p1; \
    if (MODE == 5) { if (VAR == 3) { p0 = f32x16{}; p1 = f32x16{}; _Pragma("unroll") for (int r_ = 0; r_ < 16; ++r_) { p0[r_] = l_reg; p1[r_] = l_reg; } } \
        else if ((DQK == 192 && PIPE_MLA) || (DQK == 64 && PIPE_OLD64)) { p0 = f32x16{}; p1 = f32x16{}; qkt_pipe<DQK, (b) * SHM_K, (VAR == 5 || VAR == 6) ? VAR : 0>(p0, p1, ka, qr); } else qkt<DQK, true>(p0, p1, K_lds + (b) * SHM_K, qr, r32, hi); fixup<ALIBI>(p0, p1, P_lds + (b) * 64, posq, slope2, false, hi); \
        if (VAR == 1) { l_reg += p0[0] + p1[5]; typedef unsigned u32x4_t __attribute__((ext_vector_type(4))); \
            u32x4_t w0_ = {cvtpk(p0[0], p0[1]), cvtpk(p0[2], p0[3]), cvtpk(p0[4], p0[5]), cvtpk(p0[6], p0[7])}, w1_ = {cvtpk(p0[8], p0[9]), cvtpk(p0[10], p0[11]), cvtpk(p0[12], p0[13]), cvtpk(p0[14], p0[15])}; \
            u32x4_t w2_ = {cvtpk(p1[0], p1[1]), cvtpk(p1[2], p1[3]), cvtpk(p1[4], p1[5]), cvtpk(p1[6], p1[7])}, w3_ = {cvtpk(p1[8], p1[9]), cvtpk(p1[10], p1[11]), cvtpk(p1[12], p1[13]), cvtpk(p1[14], p1[15])}; \
            pa0 = __builtin_bit_cast(bf16x8, w0_); pa1 = __builtin_bit_cast(bf16x8, w1_); pa2 = __builtin_bit_cast(bf16x8, w2_); pa3 = __builtin_bit_cast(bf16x8, w3_); } \
        else fr_softmax(p0, p1, l_reg, pa0, pa1, pa2, pa3); } \
    else { float alpha; qkt<DQK>(p0, p1, K_lds + (b) * SHM_K, qr, r32, hi); fixup<ALIBI>(p0, p1, P_lds + (b) * 64, posq, slope2, false, hi); \
        partialSM(p0, p1, m_reg, alpha); finishSM(p0, p1, alpha, l_reg, pa0, pa1, pa2, pa3); FA_RESC(alpha); } } \
    FA_SBAR(); STAGE; FA_SBAR();     \
    if (vis_) { \
    if (VAR == 2) { l_reg += __builtin_bit_cast(float, pa0[0] | (pa1[1] << 16)) + __builtin_bit_cast(float, pa2[0] | (pa3[1] << 16)); } else \
    if (MODE == 5 && DQK == 64) pv_d0_pipe(o, vb0 + (b) * SHM_V, pa0, pa1, pa2, pa3); else pv_d0(o, vb0 + (b) * SHM_V, pa0, pa1, pa2, pa3); } } while (0)
    constexpr int S1 = NSLOT - 1;
    FA_SLOAD(0, T0 * KVBLK); FA_SWRITE(0, 0); FA_SLOAD(S1, (T0 + 1) * KVBLK); FA_SWRITE(1, S1); FA_SLOAD(0, (T0 + 2) * KVBLK);
    if (NSLOT == 2) FA_SLOAD(1, (T0 + 3) * KVBLK);
    __syncthreads();
    static_assert(NSLOT == 1, "attn_pass: one staging slot");
    for (int j = T0; j < NT; j += 2) {
        FA_COMPUTE(0, j, { if (VAR != 4) if (j > T0) { FA_SWRITE(1, 0); if (j + 2 < NT) FA_SLOAD(0, (j + 2) * KVBLK); } });
        __syncthreads();
        FA_COMPUTE(1, j + 1, { if (VAR != 4) if (j + 2 < NT) { FA_SWRITE(0, 0); FA_SLOAD(0, (j + 3) * KVBLK); } });
        __syncthreads();
    }
    if (MODE == 5) { auto rr = __builtin_amdgcn_permlane32_swap(__float_as_uint(l_reg), __float_as_uint(l_reg), false, false); l_reg = __uint_as_float(rr[0]) + __uint_as_float(rr[1]); }
    __builtin_amdgcn_s_setprio(0);
    l_out = l_reg;
#undef FA_SLOAD
#undef FA_SWRITE
#undef FA_RESC
#undef FA_COMPUTE
}
template <int DQK> struct Lds3 {
    static constexpr int SHM_K = KVBLK * DQK * 2;
    static constexpr int V_OFF = 0, K_OFF = 3 * SHM_V, POS_OFF = K_OFF + 3 * SHM_K, WS_OFF = POS_OFF + 3 * 256, END = WS_OFF + 8 * 256;
};
template <int DQK, bool ALIBI>
__device__ __forceinline__ void attn_pass_stag(const bf16* __restrict__ Qb, const bf16* __restrict__ Kh, const bf16* __restrict__ Vh, const int* __restrict__ posb, float slope2, int q0, int T0, int NT,
                                               LAS unsigned char* lds, int tid, f32x16 (&o)[4], float& l_out) {
    typedef Lds3<DQK> L; constexpr int KSUB = DQK / 64, SHM_K = L::SHM_K;
    const int wid = __builtin_amdgcn_readfirstlane(tid >> 6), lane = tid & 63, r32 = lane & 31, hi = lane >> 5, grp = wid >> 2;
    LAS unsigned char* V_lds = lds + L::V_OFF; LAS unsigned char* K_lds = lds + L::K_OFF; LAS float* P_lds = (LAS float*)(lds + L::POS_OFF);
    float l_reg = 0.f;
#pragma unroll
    for (int d = 0; d < 4; ++d) o[d] = f32x16{};
    bf16x8 qr[DQK / 16];
    { const bf16* Qw = Qb + (size_t)(wid * QBLK) * DQK; unsigned qgo = (unsigned)(r32 * DQK + hi * 8) * 2u; asm volatile("" : "+v"(qgo));
#pragma unroll
      for (int d0 = 0; d0 < DQK / 16; ++d0) qr[d0] = ldg<bf16x8>(Qw + d0 * 16, qgo); }
    const float posq = ALIBI ? (float)posb[q0 + wid * QBLK + r32] : 0.f;
    const int tmax = NT - 4 + (wid >> 1);
    const int sr = tid >> 4, sc = (tid & 15) * 8, vst0 = v_st(sr, sc), vst1 = v_st(32 + sr, sc);
    const int kr = tid >> 3, kc = (tid & 7) * 8, kst = kswz(kr, kc * 2);
    unsigned vgo = (unsigned)(sr * DV + sc) * 2u, kgo = (unsigned)(kr * DQK + kc) * 2u, pgo = (unsigned)(tid & 63) * 4u; asm volatile("" : "+v"(vgo), "+v"(kgo), "+v"(pgo));
    const int vb0 = (int)(uintptr_t)V_lds + v_rd_base(lane);
    struct Slot { bf16x8 vs0, vs1, ks[KSUB]; int ps; } sl_;
#define FS_SLOAD(k0) do { unsigned kk_ = (unsigned)__builtin_amdgcn_readfirstlane((int)(k0)); asm volatile("" : "+s"(kk_)); \
    const bf16* Vt_ = Vh + (size_t)kk_ * DV; const bf16* Kt_ = Kh + (size_t)kk_ * DQK; \
    sl_.vs0 = ldg<bf16x8>(Vt_, vgo); sl_.vs1 = ldg<bf16x8>(Vt_ + 32 * DV, vgo); \
    _Pragma("unroll") for (int s_ = 0; s_ < KSUB; ++s_) sl_.ks[s_] = ldg<bf16x8>(Kt_ + s_ * 64, kgo); \
    if (ALIBI) sl_.ps = ldg<int>(posb + kk_, pgo); } while (0)
#define FS_SWRITE(b) do { *(LAS bf16x8*)(V_lds + (b) * SHM_V + vst0) = sl_.vs0; *(LAS bf16x8*)(V_lds + (b) * SHM_V + vst1) = sl_.vs1; \
    _Pragma("unroll") for (int s_ = 0; s_ < KSUB; ++s_) *(LAS bf16x8*)(K_lds + (b) * SHM_K + s_ * 8192 + kst) = sl_.ks[s_]; \
    if (ALIBI) { if (tid < 64) P_lds[(b) * 64 + tid] = (float)sl_.ps; } } while (0)
    const int nt = NT - T0;
    FS_SLOAD(T0 * KVBLK); FS_SWRITE(0); FS_SLOAD((T0 + 1) * KVBLK); FS_SWRITE(1); FS_SLOAD((T0 + 2) * KVBLK);
    __syncthreads();
#define FS_QKS(j_) do { int b_ = (j_) % 3; asm volatile("" : "+s"(b_)); f32x16 p0, p1; \
    qkt<DQK, true>(p0, p1, K_lds + b_ * SHM_K, qr, r32, hi); fixup<ALIBI>(p0, p1, P_lds + b_ * 64, posq, slope2, T0 + (j_) > tmax, hi); \
    fr_softmax(p0, p1, l_reg, pa0, pa1, pa2, pa3); } while (0)
#define FS_PV(j_) do { int b_ = (j_) % 3; asm volatile("" : "+s"(b_)); pv_d0(o, vb0 + b_ * SHM_V, pa0, pa1, pa2, pa3); } while (0)
#define FS_STAGE(j_) do { const int jn_ = (j_) + 2; if (jn_ < nt) { int bw_ = jn_ % 3; asm volatile("" : "+s"(bw_)); FS_SWRITE(bw_); if (jn_ + 1 < nt) FS_SLOAD((T0 + jn_ + 1) * KVBLK); } } while (0)
    bf16x8 pa0, pa1, pa2, pa3;
    if (grp == 0) {
        for (int j = 0; j < nt; ++j) { FS_QKS(j); __syncthreads(); FS_PV(j); __syncthreads(); FS_STAGE(j); }
        __syncthreads();
    } else {
        pa0 = bf16x8{}; pa1 = bf16x8{}; pa2 = bf16x8{}; pa3 = bf16x8{};
        for (int j = 0; j < nt; ++j) { if (j > 0) FS_PV(j - 1); __syncthreads(); FS_QKS(j); __syncthreads(); FS_STAGE(j); }
        FS_PV(nt - 1); __syncthreads();
    }
#undef FS_QKS
#undef FS_PV
#undef FS_STAGE
    { auto rr = __builtin_amdgcn_permlane32_swap(__float_as_uint(l_reg), __float_as_uint(l_reg), false, false); l_reg = __uint_as_float(rr[0]) + __uint_as_float(rr[1]); }
    l_out = l_reg;
#undef FS_SLOAD
#undef FS_SWRITE
}
template <int DQK, bool ALIBI>
__device__ __forceinline__ void attn_pass_p2(const bf16* __restrict__ Qb, const bf16* __restrict__ Kh, const bf16* __restrict__ Vh, const int* __restrict__ posb, float slope2, int q0, int T0, int NT,
                                             LAS unsigned char* lds, int tid, f32x16 (&o)[4], float& l_out) {
    typedef Lds<DQK> L; constexpr int KSUB = DQK / 64, SHM_K = L::SHM_K;
    const int wid = __builtin_amdgcn_readfirstlane(tid >> 6), lane = tid & 63, r32 = lane & 31, hi = lane >> 5;
    LAS unsigned char* V_lds = lds + L::V_OFF; LAS unsigned char* K_lds = lds + L::K_OFF; LAS float* P_lds = (LAS float*)(lds + L::POS_OFF);
    float l_reg = 0.f;
#pragma unroll
    for (int d = 0; d < 4; ++d) o[d] = f32x16{};
    bf16x8 qr[DQK / 16];
    { const bf16* Qw = Qb + (size_t)(wid * QBLK) * DQK; unsigned qgo = (unsigned)(r32 * DQK + hi * 8) * 2u; asm volatile("" : "+v"(qgo));
#pragma unroll
      for (int d0 = 0; d0 < DQK / 16; ++d0) qr[d0] = ldg<bf16x8>(Qw + d0 * 16, qgo); }
    const float posq = ALIBI ? (float)posb[q0 + wid * QBLK + r32] : 0.f;
    const int tmax = NT - 4 + (wid >> 1);
    const int sr = tid >> 4, sc = (tid & 15) * 8, vst0 = v_st(sr, sc), vst1 = v_st(32 + sr, sc);
    const int kr = tid >> 3, kc = (tid & 7) * 8, kst = kswz(kr, kc * 2);
    unsigned vgo = (unsigned)(sr * DV + sc) * 2u, kgo = (unsigned)(kr * DQK + kc) * 2u, pgo = (unsigned)(tid & 63) * 4u; asm volatile("" : "+v"(vgo), "+v"(kgo), "+v"(pgo));
    const int vb0 = (int)(uintptr_t)V_lds + v_rd_base(lane);
    struct Slot { bf16x8 vs0, vs1, ks[KSUB]; int ps; } sl_;
#define FP_LOADK(t) do { unsigned kk_ = (unsigned)__builtin_amdgcn_readfirstlane((int)((t) * KVBLK)); asm volatile("" : "+s"(kk_)); const bf16* Kt_ = Kh + (size_t)kk_ * DQK; \
    _Pragma("unroll") for (int s_ = 0; s_ < KSUB; ++s_) sl_.ks[s_] = ldg<bf16x8>(Kt_ + s_ * 64, kgo); if (ALIBI) sl_.ps = ldg<int>(posb + kk_, pgo); } while (0)
#define FP_LOADV(t) do { unsigned kk_ = (unsigned)__builtin_amdgcn_readfirstlane((int)((t) * KVBLK)); asm volatile("" : "+s"(kk_)); const bf16* Vt_ = Vh + (size_t)kk_ * DV; \
    sl_.vs0 = ldg<bf16x8>(Vt_, vgo); sl_.vs1 = ldg<bf16x8>(Vt_ + 32 * DV, vgo); } while (0)
#define FP_WRITEK(b) do { _Pragma("unroll") for (int s_ = 0; s_ < KSUB; ++s_) *(LAS bf16x8*)(K_lds + (b) * SHM_K + s_ * 8192 + kst) = sl_.ks[s_]; \
    if (ALIBI) { if (tid < 64) P_lds[(b) * 64 + tid] = (float)sl_.ps; } } while (0)
#define FP_WRITEV(b) do { *(LAS bf16x8*)(V_lds + (b) * SHM_V + vst0) = sl_.vs0; *(LAS bf16x8*)(V_lds + (b) * SHM_V + vst1) = sl_.vs1; } while (0)
#define FP_QK(P0, P1, b, t) do { qkt<DQK, true>(P0, P1, K_lds + (b) * SHM_K, qr, r32, hi); fixup<ALIBI>(P0, P1, P_lds + (b) * 64, posq, slope2, (t) > tmax, hi); } while (0)
    f32x16 pA0, pA1, pB0, pB1; bf16x8 pa0, pa1, pa2, pa3;
    const int nt = NT - T0;
    FP_LOADK(T0); FP_LOADV(T0); FP_WRITEK(0); FP_WRITEV(0); FP_LOADK(T0 + 1); FP_WRITEK(1); FP_LOADK(T0 + 2); FP_LOADV(T0 + 1);
    __syncthreads();
    FP_QK(pA0, pA1, 0, T0);
    __syncthreads();
    for (int r = 0; r < nt; r += 2) {
        if (r + 2 < nt) FP_WRITEK(0);
        FP_WRITEV(1);
        if (r + 3 < nt) FP_LOADK(T0 + r + 3);
        if (r + 2 < nt) FP_LOADV(T0 + r + 2);
        FA_SBAR(); FP_QK(pB0, pB1, 1, T0 + r + 1);
        fr_softmax(pA0, pA1, l_reg, pa0, pa1, pa2, pa3); FA_SBAR();
        pv_d0(o, vb0, pa0, pa1, pa2, pa3);
        __syncthreads();
        if (r + 3 < nt) FP_WRITEK(1);
        if (r + 2 < nt) FP_WRITEV(0);
        if (r + 4 < nt) FP_LOADK(T0 + r + 4);
        if (r + 3 < nt) FP_LOADV(T0 + r + 3);
        FA_SBAR(); if (r + 2 < nt) FP_QK(pA0, pA1, 0, T0 + r + 2);
        fr_softmax(pB0, pB1, l_reg, pa0, pa1, pa2, pa3); FA_SBAR();
        pv_d0(o, vb0 + SHM_V, pa0, pa1, pa2, pa3);
        __syncthreads();
    }
    { auto rr = __builtin_amdgcn_permlane32_swap(__float_as_uint(l_reg), __float_as_uint(l_reg), false, false); l_reg = __uint_as_float(rr[0]) + __uint_as_float(rr[1]); }
    l_out = l_reg;
#undef FP_LOADK
#undef FP_LOADV
#undef FP_WRITEK
#undef FP_WRITEV
#undef FP_QK
}
template <int DQK, bool ALIBI>
__device__ __forceinline__ void attn_pass_dma(const bf16* __restrict__ Qb, const bf16* __restrict__ Kh, const bf16* __restrict__ Vh, const int* __restrict__ posb, const float* __restrict__ posfb,
                                              float slope2, int q0, int T0, int NT, LAS unsigned char* lds, int tid_, f32x16 (&o)[4], float& l_out) {
    typedef Lds3<DQK> L; constexpr int KSUB = DQK / 64, SHM_K = L::SHM_K, NPT = KSUB + 2 + (ALIBI ? 1 : 0);
    const int wid = __builtin_amdgcn_readfirstlane(tid_ >> 6); int lane; asm volatile("v_mbcnt_lo_u32_b32 %0, -1, 0\n\tv_mbcnt_hi_u32_b32 %0, -1, %0" : "=v"(lane));
    const int r32 = lane & 31, hi = lane >> 5;
    LAS unsigned char* V_lds = lds + L::V_OFF; LAS unsigned char* K_lds = lds + L::K_OFF; LAS float* P_lds = (LAS float*)(lds + L::POS_OFF);
    float l_reg = 0.f;
#pragma unroll
    for (int d = 0; d < 4; ++d) o[d] = f32x16{};
    bf16x8 qr[DQK / 16];
    { const bf16* Qw = Qb + (size_t)(wid * QBLK) * DQK; unsigned qgo = (unsigned)(r32 * DQK + hi * 8) * 2u; asm volatile("" : "+v"(qgo));
#pragma unroll
      for (int d0 = 0; d0 < DQK / 16; ++d0) qr[d0] = ldg<bf16x8>(Qw + d0 * 16, qgo); }
    const float posq = ALIBI ? (float)posb[q0 + wid * QBLK + r32] : 0.f;
    const int tmax = NT - 4 + (wid >> 1);
    unsigned ksrc, vsrc, psrc;
    { const int kr = 8 * wid + (lane >> 3), kc = (lane & 7) ^ ((kr >> 1) & 7); ksrc = (unsigned)(kr * DQK + kc * 8) * 2u;
      const int vk = 8 * wid + ((lane & 31) >> 2), vc = (lane >> 5) * 32 + (lane & 3) * 8; vsrc = (unsigned)(vk * DV + vc) * 2u; psrc = (unsigned)lane * 4u;
      asm volatile("" : "+v"(ksrc), "+v"(vsrc), "+v"(psrc)); }
    const int vb0 = (int)(uintptr_t)V_lds + v_rd_base(lane);
#define FD_DMA(t, slot) do { unsigned kk_ = (unsigned)__builtin_amdgcn_readfirstlane((int)((t) * KVBLK)); asm volatile("" : "+s"(kk_)); const int sl_ = (slot); \
    const char* Kt_ = (const char*)(Kh + (size_t)kk_ * DQK); const char* Vt_ = (const char*)(Vh + (size_t)kk_ * DV); \
    _Pragma("unroll") for (int s_ = 0; s_ < KSUB; ++s_) __builtin_amdgcn_global_load_lds((const unsigned*)(Kt_ + s_ * 128 + ksrc), (LAS unsigned*)(K_lds + sl_ * SHM_K + s_ * 8192 + wid * 1024), 16, 0, 0); \
    _Pragma("unroll") for (int q_ = 0; q_ < 2; ++q_) __builtin_amdgcn_global_load_lds((const unsigned*)(Vt_ + q_ * 128 + vsrc), (LAS unsigned*)(V_lds + sl_ * SHM_V + (2 * wid + q_) * 1024), 16, 0, 0); \
    if (ALIBI) __builtin_amdgcn_global_load_lds((const unsigned*)((const char*)(posfb + kk_) + psrc), (LAS unsigned*)(P_lds + sl_ * 64), 4, 0, 0); } while (0)
    const int nt = NT - T0;
    FD_DMA(T0, 0); FD_DMA(T0 + 1, 1);
    asm volatile("s_waitcnt vmcnt(0) lgkmcnt(0)\n\ts_barrier" ::: "memory");
    int slot = 0;
    for (int j = 0; j < nt; ++j) {
        int b = slot; asm volatile("" : "+s"(b));
        if (j + 2 < nt) { int bn = b + 2; bn = bn >= 3 ? bn - 3 : bn; FD_DMA(T0 + j + 2, bn); }
        { f32x16 p0, p1; bf16x8 pa0, pa1, pa2, pa3;
          qkt<DQK, true>(p0, p1, K_lds + b * SHM_K, qr, r32, hi); fixup<ALIBI>(p0, p1, P_lds + b * 64, posq, slope2, T0 + j > tmax, hi);
          fr_softmax(p0, p1, l_reg, pa0, pa1, pa2, pa3); FA_SBAR();
          pv_d0(o, vb0 + b * SHM_V, pa0, pa1, pa2, pa3); }
        if (j + 2 < nt) asm volatile("s_waitcnt vmcnt(%0) lgkmcnt(0)\n\ts_barrier" :: "n"(NPT) : "memory");
        else asm volatile("s_waitcnt vmcnt(0) lgkmcnt(0)\n\ts_barrier" ::: "memory");
        slot = slot == 2 ? 0 : slot + 1;
    }
    { auto rr = __builtin_amdgcn_permlane32_swap(__float_as_uint(l_reg), __float_as_uint(l_reg), false, false); l_reg = __uint_as_float(rr[0]) + __uint_as_float(rr[1]); }
    l_out = l_reg;
#undef FD_DMA
}
__device__ __forceinline__ void row_bcast(float f, LAS float* al, int r32, int hi, float (&rf)[16]) {
    asm volatile("s_waitcnt lgkmcnt(0)" ::: "memory");
    if (hi == 0) al[r32] = f;
    asm volatile("s_waitcnt lgkmcnt(0)" ::: "memory");
#pragma unroll
    for (int r = 0; r < 16; ++r) rf[r] = al[crow(r, hi)];
    asm volatile("s_waitcnt lgkmcnt(0)" ::: "memory");
}

__device__ __forceinline__ void attn_pass_da5(const bf16* __restrict__ Qb, const bf16* __restrict__ Kh, const bf16* __restrict__ Vh, const int* __restrict__ posb, float slope2, int cw, int q0, int T0, int NT,
                                              LAS unsigned char* lds, int tid_, f32x16 (&o)[4], float& l_out) {
    typedef Lds<64> L; constexpr int DQK = 64, SHM_K = L::SHM_K, B_OFF = L::END;
    const int wid = __builtin_amdgcn_readfirstlane(tid_ >> 6); int lane; asm volatile("v_mbcnt_lo_u32_b32 %0, -1, 0\n\tv_mbcnt_hi_u32_b32 %0, -1, %0" : "=v"(lane));
    const int tid = wid * 64 + lane, r32 = lane & 31, hi = lane >> 5;
    LAS unsigned char* V_lds = lds + L::V_OFF; LAS unsigned char* K_lds = lds + L::K_OFF; LAS float* P_lds = (LAS float*)(lds + L::POS_OFF); LAS float* B_lds = (LAS float*)(lds + B_OFF);
    float l_reg = 0.f;
#pragma unroll
    for (int d = 0; d < 4; ++d) o[d] = f32x16{};
    bf16x8 qr[4];
    { const bf16* Qw = Qb + (size_t)(wid * QBLK) * DQK; unsigned qgo = (unsigned)(r32 * DQK + hi * 8) * 2u; asm volatile("" : "+v"(qgo));
#pragma unroll
      for (int d0 = 0; d0 < 4; ++d0) qr[d0] = ldg<bf16x8>(Qw + d0 * 16, qgo); }
    const float posq = (float)posb[q0 + wid * QBLK + r32];
    const float dl = slope2 * (posq - (float)cw);
    const int tmax = NT - 4 + (wid >> 1);
    const int sr = tid >> 4, sc = (tid & 15) * 8, vst0 = v_st_nat(sr, sc), vst1 = v_st_nat(32 + sr, sc);
    const int kr = tid >> 3, kc = (tid & 7) * 8, kst = kswz(kr, kc * 2);
    unsigned vgo = (unsigned)(sr * DV + sc) * 2u, kgo = (unsigned)(kr * DQK + kc) * 2u, pgo = (unsigned)(tid & 63) * 4u; asm volatile("" : "+v"(vgo), "+v"(kgo), "+v"(pgo));
    const int vb0 = (int)(uintptr_t)V_lds + v_rd_base(lane);
    int ka[4]; k_bases(ka, K_lds, r32, hi);
    bf16x8 vs0, vs1, ks0; int ps;
#define FD_SLOAD(k0) do { unsigned kk_ = (unsigned)__builtin_amdgcn_readfirstlane((int)(k0)); asm volatile("" : "+s"(kk_)); \
    const bf16* Vt_ = Vh + (size_t)kk_ * DV; const bf16* Kt_ = Kh + (size_t)kk_ * DQK; \
    vs0 = ldg<bf16x8>(Vt_, vgo); vs1 = ldg<bf16x8>(Vt_ + 32 * DV, vgo); ks0 = ldg<bf16x8>(Kt_, kgo); ps = ldg<int>(posb + kk_, pgo); } while (0)
#define FD_SWRITE(b) do { *(LAS bf16x8*)(V_lds + (b) * SHM_V + vst0) = vs0; *(LAS bf16x8*)(V_lds + (b) * SHM_V + vst1) = vs1; *(LAS bf16x8*)(K_lds + (b) * SHM_K + kst) = ks0; \
    B_lds[(b) * 512 + tid] = slope2 * (float)(ps - cw); if (tid < 64) P_lds[(b) * 64 + tid] = (float)ps; } while (0)
#define FD_LIN(b) do { f32x16 p0, p1; bf16x8 pa0, pa1, pa2, pa3; const LAS float* bl_ = B_lds + (b) * 512 + wid * 64 + 4 * hi; \
    _Pragma("unroll") for (int g = 0; g < 4; ++g) { const f32x4 k0 = *(const LAS f32x4*)(bl_ + 8 * g), k1 = *(const LAS f32x4*)(bl_ + 32 + 8 * g); \
        _Pragma("unroll") for (int e = 0; e < 4; ++e) { p0[4 * g + e] = k0[e]; p1[4 * g + e] = k1[e]; } } \
    if (PIPE_LIN) qkt_pipe<DQK, (b) * SHM_K>(p0, p1, ka, qr); else qkt<DQK, false>(p0, p1, K_lds + (b) * SHM_K, qr, r32, hi); fr_softmax(p0, p1, l_reg, pa0, pa1, pa2, pa3); FA_SBAR(); \
    pv_d0_pipe(o, vb0 + (b) * SHM_V, pa0, pa1, pa2, pa3); } while (0)
#define FD_GEN(b, t) do { if ((t) <= tmax) { f32x16 p0, p1; bf16x8 pa0, pa1, pa2, pa3; \
    _Pragma("unroll") for (int r = 0; r < 16; ++r) { p0[r] = dl; p1[r] = dl; } \
    if (PIPE_GEN) qkt_pipe<DQK, (b) * SHM_K>(p0, p1, ka, qr); else qkt<DQK, false>(p0, p1, K_lds + (b) * SHM_K, qr, r32, hi); fixup<true>(p0, p1, P_lds + (b) * 64, posq, slope2, false, hi); fr_softmax(p0, p1, l_reg, pa0, pa1, pa2, pa3); FA_SBAR(); \
    pv_d0_pipe(o, vb0 + (b) * SHM_V, pa0, pa1, pa2, pa3); } } while (0)
    FD_SLOAD(T0 * KVBLK); FD_SWRITE(0); FD_SLOAD((T0 + 1) * KVBLK); FD_SWRITE(1); FD_SLOAD((T0 + 2) * KVBLK);
    __syncthreads();
    int j = T0;
    for (; j < NT - 4; j += 2) {
        FD_LIN(0);
        __syncthreads();
        FD_SWRITE(0); FD_SLOAD((j + 3) * KVBLK);
        FD_LIN(1);
        __syncthreads();
        FD_SWRITE(1); FD_SLOAD((j + 4) * KVBLK);
    }
    for (; j < NT; j += 2) {
        FD_GEN(0, j);
        __syncthreads();
        if (j + 2 < NT) { FD_SWRITE(0); FD_SLOAD((j + 3) * KVBLK); }
        FD_GEN(1, j + 1);
        __syncthreads();
        if (j + 2 < NT) { FD_SWRITE(1); }
    }
    { auto rr = __builtin_amdgcn_permlane32_swap(__float_as_uint(l_reg), __float_as_uint(l_reg), false, false); l_reg = __uint_as_float(rr[0]) + __uint_as_float(rr[1]); }
    l_out = l_reg;
#undef FD_SLOAD
#undef FD_SWRITE
#undef FD_LIN
#undef FD_GEN
}

__device__ __forceinline__ void attn_pass_da5p(const bf16* __restrict__ Qb, const bf16* __restrict__ Kh, const bf16* __restrict__ Vh, const int* __restrict__ posb, float slope2, int cw, int q0, int T0, int NT,
                                               LAS unsigned char* lds, int tid_, f32x16 (&o)[4], float& l_out) {
    typedef Lds<64> L; constexpr int DQK = 64, SHM_K = L::SHM_K, B_OFF = L::END;
    const int wid = __builtin_amdgcn_readfirstlane(tid_ >> 6); int lane; asm volatile("v_mbcnt_lo_u32_b32 %0, -1, 0\n\tv_mbcnt_hi_u32_b32 %0, -1, %0" : "=v"(lane));
    const int tid = wid * 64 + lane, r32 = lane & 31, hi = lane >> 5;
    if (wid >= 4) __builtin_amdgcn_s_setprio(1);
    LAS unsigned char* V_lds = lds + L::V_OFF; LAS unsigned char* K_lds = lds + L::K_OFF; LAS float* P_lds = (LAS float*)(lds + L::POS_OFF); LAS float* B_lds = (LAS float*)(lds + B_OFF);
    float l_reg = 0.f;
#pragma unroll
    for (int d = 0; d < 4; ++d) o[d] = f32x16{};
    bf16x8 qr[4];
    { const bf16* Qw = Qb + (size_t)(wid * QBLK) * DQK; unsigned qgo = (unsigned)(r32 * DQK + hi * 8) * 2u; asm volatile("" : "+v"(qgo));
#pragma unroll
      for (int d0 = 0; d0 < 4; ++d0) qr[d0] = ldg<bf16x8>(Qw + d0 * 16, qgo); }
    const float posq = (float)posb[q0 + wid * QBLK + r32];
    const float dl = slope2 * (posq - (float)cw);
    const int tmax = NT - 4 + (wid >> 1);
    const int sr = tid >> 4, sc = (tid & 15) * 8, vst0 = v_st_nat(sr, sc), vst1 = v_st_nat(32 + sr, sc);
    const int kr = tid >> 3, kc = (tid & 7) * 8, kst = kswz(kr, kc * 2);
    unsigned vgo = (unsigned)(sr * DV + sc) * 2u, kgo = (unsigned)(kr * DQK + kc) * 2u, pgo = (unsigned)(tid & 63) * 4u; asm volatile("" : "+v"(vgo), "+v"(kgo), "+v"(pgo));
    const int vb0 = (int)(uintptr_t)V_lds + v_rd_base(lane);
    int ka[4]; k_bases(ka, K_lds, r32, hi);
    bf16x8 vs0, vs1, ks0; int ps;
#define FP_LOADV(t) do { unsigned kk_ = (unsigned)__builtin_amdgcn_readfirstlane((int)((t) * KVBLK)); asm volatile("" : "+s"(kk_)); const bf16* Vt_ = Vh + (size_t)kk_ * DV; \
    vs0 = ldg<bf16x8>(Vt_, vgo); vs1 = ldg<bf16x8>(Vt_ + 32 * DV, vgo); } while (0)
#define FP_LOADK(t) do { unsigned kk_ = (unsigned)__builtin_amdgcn_readfirstlane((int)((t) * KVBLK)); asm volatile("" : "+s"(kk_)); ks0 = ldg<bf16x8>(Kh + (size_t)kk_ * DQK, kgo); ps = ldg<int>(posb + kk_, pgo); } while (0)
#define FP_WRITEV(b) do { *(LAS bf16x8*)(V_lds + (b) * SHM_V + vst0) = vs0; *(LAS bf16x8*)(V_lds + (b) * SHM_V + vst1) = vs1; } while (0)
#define FP_WRITEK(b) do { *(LAS bf16x8*)(K_lds + (b) * SHM_K + kst) = ks0; B_lds[(b) * 512 + tid] = slope2 * (float)(ps - cw); if (tid < 64) P_lds[(b) * 64 + tid] = (float)ps; } while (0)
#define FP_BINIT(x0, x1, b) do { const LAS float* bl_ = B_lds + (b) * 512 + wid * 64 + 4 * hi; \
    _Pragma("unroll") for (int g = 0; g < 4; ++g) { const f32x4 k0 = *(const LAS f32x4*)(bl_ + 8 * g), k1 = *(const LAS f32x4*)(bl_ + 32 + 8 * g); \
        _Pragma("unroll") for (int e = 0; e < 4; ++e) { x0[4 * g + e] = k0[e]; x1[4 * g + e] = k1[e]; } } } while (0)
#define FP_QK(x0, x1, t, b) do { if ((t) < NT - 4) { FP_BINIT(x0, x1, b); qkt<DQK, false>(x0, x1, K_lds + (b) * SHM_K, qr, r32, hi); } \
    else { _Pragma("unroll") for (int r = 0; r < 16; ++r) { x0[r] = dl; x1[r] = dl; } qkt<DQK, false>(x0, x1, K_lds + (b) * SHM_K, qr, r32, hi); fixup<true>(x0, x1, P_lds + (b) * 64, posq, slope2, false, hi); } } while (0)
    f32x16 c0, c1;
    {
        FP_LOADV(T0); FP_LOADK(T0);
        bf16x8 vB0, vB1, kB; int pB;
        { unsigned kk_ = (unsigned)__builtin_amdgcn_readfirstlane((int)((T0 + 1) * KVBLK)); asm volatile("" : "+s"(kk_)); const bf16* Vt_ = Vh + (size_t)kk_ * DV;
          vB0 = ldg<bf16x8>(Vt_, vgo); vB1 = ldg<bf16x8>(Vt_ + 32 * DV, vgo); kB = ldg<bf16x8>(Kh + (size_t)kk_ * DQK, kgo); pB = ldg<int>(posb + kk_, pgo); }
        FP_WRITEV(0); FP_WRITEK(0);
        *(LAS bf16x8*)(V_lds + SHM_V + vst0) = vB0; *(LAS bf16x8*)(V_lds + SHM_V + vst1) = vB1; *(LAS bf16x8*)(K_lds + SHM_K + kst) = kB;
        B_lds[512 + tid] = slope2 * (float)(pB - cw); if (tid < 64) P_lds[64 + tid] = (float)pB;
        FP_LOADK(T0 + 2); FP_LOADV(T0 + 2);
        __syncthreads();
        FP_QK(c0, c1, T0, 0);
        __syncthreads();
        FP_WRITEK(0); FP_LOADK(T0 + 3);
    }
    int s = T0;
    for (; s <= NT - 6; ++s) {
        const int b = s & 1, nb = b ^ 1, kof = nb * SHM_K;
        f32x16 n0, n1; bf16x8 pa0, pa1, pa2, pa3;
        FP_BINIT(n0, n1, nb);
        const bf16x8 a0 = k_read<0>(ka[0] + kof), b0 = k_read<4096>(ka[0] + kof), a1 = k_read<0>(ka[1] + kof), b1 = k_read<4096>(ka[1] + kof);
        const bf16x8 a2 = k_read<0>(ka[2] + kof), b2 = k_read<4096>(ka[2] + kof), a3 = k_read<0>(ka[3] + kof), b3 = k_read<4096>(ka[3] + kof);
        float sa = 0.f, sb = 0.f;
#define FP_SM(d) do { _Pragma("unroll") for (int r = 4 * (d); r < 4 * (d) + 4; ++r) { c0[r] = __builtin_amdgcn_exp2f(c0[r]); c1[r] = __builtin_amdgcn_exp2f(c1[r]); sa += c0[r]; sb += c1[r]; } } while (0)
        FA_LGK(6); FA_SBAR(); n0 = __builtin_amdgcn_mfma_f32_32x32x16_bf16(a0, qr[0], n0, 0, 0, 0); n1 = __builtin_amdgcn_mfma_f32_32x32x16_bf16(b0, qr[0], n1, 0, 0, 0); FP_SM(0); FA_SBAR();
        FA_LGK(4); FA_SBAR(); n0 = __builtin_amdgcn_mfma_f32_32x32x16_bf16(a1, qr[1], n0, 0, 0, 0); n1 = __builtin_amdgcn_mfma_f32_32x32x16_bf16(b1, qr[1], n1, 0, 0, 0); FP_SM(1); FA_SBAR();
        FA_LGK(2); FA_SBAR(); n0 = __builtin_amdgcn_mfma_f32_32x32x16_bf16(a2, qr[2], n0, 0, 0, 0); n1 = __builtin_amdgcn_mfma_f32_32x32x16_bf16(b2, qr[2], n1, 0, 0, 0); FP_SM(2); FA_SBAR();
        FA_LGK(0); FA_SBAR(); n0 = __builtin_amdgcn_mfma_f32_32x32x16_bf16(a3, qr[3], n0, 0, 0, 0); n1 = __builtin_amdgcn_mfma_f32_32x32x16_bf16(b3, qr[3], n1, 0, 0, 0); FP_SM(3); FA_SBAR();
#undef FP_SM
        l_reg += sa + sb;
        typedef unsigned u32x4_t __attribute__((ext_vector_type(4)));
#define FA_PKS(P, BASE, OUT) do { u32x4_t w = {cvtpk(P[BASE + 0], P[BASE + 1]), cvtpk(P[BASE + 2], P[BASE + 3]), cvtpk(P[BASE + 4], P[BASE + 5]), cvtpk(P[BASE + 6], P[BASE + 7])}; OUT = __builtin_bit_cast(bf16x8, w); } while (0)
        FA_PKS(c0, 0, pa0); FA_PKS(c0, 8, pa1); FA_PKS(c1, 0, pa2); FA_PKS(c1, 8, pa3);
#undef FA_PKS
        FA_SBAR();
        pv_d0_pipe(o, vb0 + b * SHM_V, pa0, pa1, pa2, pa3);
        __syncthreads();
        FP_WRITEV(b); FP_WRITEK(nb); FP_LOADV(s + 3); FP_LOADK(s + 4);
        c0 = n0; c1 = n1;
    }
    for (; s < NT; ++s) {
        const int b = s & 1, nb = b ^ 1;
        f32x16 n0 = f32x16{}, n1 = f32x16{};
        if (s + 1 < NT && s + 1 <= tmax) FP_QK(n0, n1, s + 1, nb);
        if (s <= tmax) { bf16x8 pa0, pa1, pa2, pa3; fr_softmax(c0, c1, l_reg, pa0, pa1, pa2, pa3); FA_SBAR(); pv_d0_pipe(o, vb0 + b * SHM_V, pa0, pa1, pa2, pa3); }
        __syncthreads();
        if (s + 2 < NT) FP_WRITEV(b);
        if (s + 3 < NT) { FP_WRITEK(nb); FP_LOADV(s + 3); }
        if (s + 4 < NT) FP_LOADK(s + 4);
        c0 = n0; c1 = n1;
    }
    { auto rr = __builtin_amdgcn_permlane32_swap(__float_as_uint(l_reg), __float_as_uint(l_reg), false, false); l_reg = __uint_as_float(rr[0]) + __uint_as_float(rr[1]); }
    __builtin_amdgcn_s_setprio(0);
    l_out = l_reg;
#undef FP_LOADV
#undef FP_LOADK
#undef FP_WRITEV
#undef FP_WRITEK
#undef FP_BINIT
#undef FP_QK
}
}

constexpr int CW_BAR = 4096;
constexpr int CW_Q = 8192;
__device__ __forceinline__ int next_unit(Frame& F, unsigned* ctr) {
    LAS unsigned* uq = (LAS unsigned*)(F.lds + LDSCTL_OFF + 16);
    __syncthreads();
    if (F.tid == 0) *uq = atomicAdd(ctr, 1u);
    __syncthreads();
    return __builtin_amdgcn_readfirstlane((int)*uq);
}
template <int MODE = 0> __device__ __forceinline__ void ph_attn_da(Frame& F, int l, int rep = 0) {
    const bf16 *QD = WSP(bf16, WS_QD), *KD = WSP(bf16, WS_KD), *VD = WSP(bf16, WS_VD);
    bf16* MIX = rep == 2 ? WSP(bf16, WS_U) : WSP(bf16, WS_MIX); float* O1 = WSP(float, WS_O1);
    const int lane = F.lane;
    LAS float* al = (LAS float*)(F.lds + fa::Lds<64>::WS_OFF) + F.wave * 64;
    const float s1 = wave_sum(FIN(I_LQ1)[l * 64 + lane] * FIN(I_LK1)[l * 64 + lane]);
    const float s2 = wave_sum(FIN(I_LQ2)[l * 64 + lane] * FIN(I_LK2)[l * 64 + lane]);
    const float lam_init = __int_as_float(__builtin_amdgcn_readfirstlane(__float_as_int(LAM_INIT[l])));
    const float lam = __int_as_float(__builtin_amdgcn_readfirstlane(__float_as_int(expf(s1) - expf(s2) + lam_init)));
    float gqm = fabsf(FIN(I_DAQG)[l * 64 + lane]), gkm = fabsf(FIN(I_DAKG)[l * 64 + lane]);
    gqm = wave_max(gqm); gkm = wave_max(gkm);
    const float bound = __int_as_float(__builtin_amdgcn_readfirstlane(__float_as_int(1.01f * 11.5416f * gqm * gkm)));
    const float reach = __int_as_float(__builtin_amdgcn_readfirstlane(__float_as_int(2.0f * bound + 160.0f)));
    if ((MODE == 5) != (bound < 40.0f)) return;
    const int* posmm = WSP(int, WS_POSMM);
    unsigned* ctr = (unsigned*)(F.ws + WS_CTL) + (rep == 2 ? 20000 + 64 * (l * 2) : CW_Q + 64 * 8 * (l * 4 + 0 + rep));
    for (;;) {
        const int u = next_unit(F, ctr); if (u >= 384) break;
        const int qb = 31 - u / 12, bh = u % 12, b = bh / NH, h = bh % NH, q0 = qb * 256, NT = q0 / 64 + 4;
        const int* posb = F.pos + b * SEQ;
        const float slope2 = __int_as_float(__builtin_amdgcn_readfirstlane(__float_as_int(ALIBI_SLOPE[h] * LOG2E)));
        const size_t orow = (size_t)(b * SEQ + q0 + F.wave * 32);
        int T0 = 0, TL = 0; bool lin = false;
        { const int* qm = posmm + (size_t)(b * 128 + qb * 4) * 2; int qmin = qm[0], qmax = qm[1];
#pragma unroll
          for (int c = 1; c < 4; ++c) { qmin = qm[2 * c] < qmin ? qm[2 * c] : qmin; qmax = qm[2 * c + 1] > qmax ? qm[2 * c + 1] : qmax; }
          const int* km = posmm + (size_t)(b * 128) * 2;
          for (; T0 < NT - 4; ++T0) { const int kmin = km[2 * T0], kmax = km[2 * T0 + 1]; int dmin = qmin - kmax; if (kmin - qmax > dmin) dmin = kmin - qmax; if (dmin < 0) dmin = 0;
              if (!(slope2 * (float)dmin > reach)) break; }
          T0 &= ~1;
          for (TL = T0; TL < NT; ++TL) if (km[2 * TL + 1] > qmin) break;
          if (TL < NT - 4) TL = T0;
          int span = qm[1] - qm[0];
#pragma unroll
          for (int c = 1; c < 4; ++c) { const int sp = qm[2 * c + 1] - qm[2 * c]; span = sp > span ? sp : span; }
          lin = TL >= NT - 4 && slope2 * (float)span <= 24.0f;
        }
        for (int mp = 0; mp < 2; ++mp) {
            f32x16 o[4]; float l1;
            const bf16* Qp = QD + ((size_t)(bh * 2 + mp) * SEQ + q0) * 64; const int bhk = rep == 2 ? 0 : bh; const bf16* Kp = KD + (size_t)(bhk * 2 + mp) * SEQ * 64; const bf16* Vp = VD + (size_t)bhk * SEQ * 128;
            if (MODE == 5 && lin) { const int cw = posmm[(size_t)(b * 128 + qb * 4 + (__builtin_amdgcn_readfirstlane(F.tid >> 6) >> 1)) * 2];
                fa::attn_pass_da5p(Qp, Kp, Vp, posb, slope2, cw, q0, T0, NT, F.lds, F.tid, o, l1); }
            else fa::attn_pass<64, true, 1, MODE>(Qp, Kp, Vp, posb, slope2, bound, TL, q0, T0, NT, F.lds, F.tid, o, l1);
            int le_; asm volatile("v_mbcnt_lo_u32_b32 %0, -1, 0\n\tv_mbcnt_hi_u32_b32 %0, -1, %0" : "=v"(le_)); const int r32 = le_ & 31, hi = le_ >> 5;
            float f[16];
            if (mp == 0) {
                fa::row_bcast(1.0f / l1, al, r32, hi, f);
                unsigned lo = (unsigned)(((u * 8 + F.wave) * 8) * 64 + le_) * 16u; asm volatile("" : "+v"(lo));
#pragma unroll
                for (int j = 0; j < 8; ++j) { const int d = j >> 1, rb = (j & 1) * 8; v4u w;
                    w.x = pg8::pkh2(o[d][rb + 0] * f[rb + 0], o[d][rb + 1] * f[rb + 1]); w.y = pg8::pkh2(o[d][rb + 2] * f[rb + 2], o[d][rb + 3] * f[rb + 3]);
                    w.z = pg8::pkh2(o[d][rb + 4] * f[rb + 4], o[d][rb + 5] * f[rb + 5]); w.w = pg8::pkh2(o[d][rb + 6] * f[rb + 6], o[d][rb + 7] * f[rb + 7]);
                    fa::stg<v4u>(O1, lo + j * 1024, w); }
            } else {
                fa::row_bcast(lam / l1, al, r32, hi, f);
                const float* hg = FIN(I_DAHG) + (size_t)l * 768 + h * 128;
                float hgv[4];
#pragma unroll
                for (int d = 0; d < 4; ++d) hgv[d] = fa::ldg<float>(hg + d * 32, (unsigned)r32 * 4u) * (1.0f - lam_init);
                unsigned lo = (unsigned)(((u * 8 + F.wave) * 8) * 64 + le_) * 16u; asm volatile("" : "+v"(lo));
                bf16* mb = MIX + orow * D + h * 128; unsigned mo = (unsigned)(4 * hi * D + r32) * 2u; asm volatile("" : "+v"(mo));
                v4u w1[8];
#pragma unroll
                for (int j = 0; j < 8; ++j) w1[j] = fa::ldg<v4u>(O1, lo + j * 1024);
#pragma unroll
                for (int j = 0; j < 8; ++j) { const int d = j >> 1, rb = (j & 1) * 8; const unsigned ww[4] = {w1[j].x, w1[j].y, w1[j].z, w1[j].w};
#pragma unroll
                    for (int q = 0; q < 4; ++q) { o[d][rb + 2 * q] = pg8::uph_lo(ww[q]) - o[d][rb + 2 * q] * f[rb + 2 * q]; o[d][rb + 2 * q + 1] = pg8::uph_hi(ww[q]) - o[d][rb + 2 * q + 1] * f[rb + 2 * q + 1]; } }
#pragma unroll
                for (int r2 = 0; r2 < 16; ++r2) {
                    float ss = 0.f;
#pragma unroll
                    for (int d = 0; d < 4; ++d) ss += o[d][r2] * o[d][r2];
                    ss = sum32(ss);
                    const float rn = rsqrtf(ss * (1.f / 128) + EPS);
#pragma unroll
                    for (int d = 0; d < 4; ++d) fa::stg<bf16>(mb, mo + (fa::crowc(r2) * D + d * 32) * 2, (bf16)f2bf(o[d][r2] * rn * hgv[d]));
                }
            }
        }
    }
}
template <int MODE> __device__ __forceinline__ void ph_attn_mla(Frame& F, int l, int rep = 0) {
    const bf16 *QM = WSP(bf16, WS_QM), *KM = WSP(bf16, WS_KM), *VM = WSP(bf16, WS_VM);
    bf16* MIX = rep >= 2 ? WSP(bf16, WS_U) : WSP(bf16, WS_MIX);
    const int lane = F.lane;
    LAS float* al = (LAS float*)(F.lds + fa::Lds<192>::WS_OFF) + F.wave * 64;
    float gqm = fmaxf(fmaxf(fabsf(FIN(I_MQG)[l * 192 + lane]), fabsf(FIN(I_MQG)[l * 192 + 64 + lane])), fabsf(FIN(I_MQG)[l * 192 + 128 + lane]));
    float gkm = fmaxf(fmaxf(fabsf(FIN(I_MKG)[l * 192 + lane]), fabsf(FIN(I_MKG)[l * 192 + 64 + lane])), fabsf(FIN(I_MKG)[l * 192 + 128 + lane]));
    gqm = wave_max(gqm); gkm = wave_max(gkm);
    const float bound = __int_as_float(__builtin_amdgcn_readfirstlane(__float_as_int(1.01f * 19.9907f * gqm * gkm)));
    if ((MODE == 5) != (bound < 60.0f)) return;
    unsigned* ctr = (unsigned*)(F.ws + WS_CTL) + (rep >= 2 ? 20000 + 64 * (l * 2 + 1) : CW_Q + 64 * 8 * (l * 4 + 2 + rep));
    for (;;) {
        const int u = next_unit(F, ctr); if (u >= 384) break;
        const int qb = 31 - u / 12, bh = u % 12, b = bh / NH, h = bh % NH, q0 = qb * 256, NT = q0 / 64 + 4;
        const size_t orow = (size_t)(b * SEQ + q0 + F.wave * 32);
        f32x16 o[4]; float l1;
        const int bhk = rep == 2 ? 0 : bh;
#if defined(PROBE_VAR)
        if (rep == 3) fa::attn_pass<192, false, 1, MODE, PROBE_VAR>(QM + ((size_t)bh * SEQ + q0) * 192, KM + (size_t)bhk * SEQ * 192, VM + (size_t)bhk * SEQ * 128, nullptr, 0.f, bound, 0, q0, 0, NT, F.lds, F.tid, o, l1); else
#endif
        fa::attn_pass<192, false, 1, MODE>(QM + ((size_t)bh * SEQ + q0) * 192, KM + (size_t)bhk * SEQ * 192, VM + (size_t)bhk * SEQ * 128, nullptr, 0.f, bound, 0, q0, 0, NT, F.lds, F.tid, o, l1);
        int le_; asm volatile("v_mbcnt_lo_u32_b32 %0, -1, 0\n\tv_mbcnt_hi_u32_b32 %0, -1, %0" : "=v"(le_)); const int r32 = le_ & 31, hi = le_ >> 5;
        float f[16]; fa::row_bcast(1.0f / l1, al, r32, hi, f);
        bf16* mb = MIX + orow * D + 768 + h * 128; unsigned mo = (unsigned)(4 * hi * D + r32) * 2u; asm volatile("" : "+v"(mo));
#pragma unroll
        for (int r2 = 0; r2 < 16; ++r2)
#pragma unroll
            for (int d = 0; d < 4; ++d) fa::stg<bf16>(mb, mo + (fa::crowc(r2) * D + d * 32) * 2, (bf16)f2bf(o[d][r2] * f[r2]));
    }
}
__device__ __forceinline__ void ph_sgu(Frame& F, int l, int rep = 0) {
    const _Float16* UU = WSP(_Float16, WS_UU); const bf16* GV = WSP(bf16, WS_GV); const float* SSQ = WSP(float, WS_SSQ_SGV); bf16* MIX = WSP(bf16, WS_MIX);
    LAS unsigned short* vs = (LAS unsigned short*)F.lds;
    LAS float* rs = (LAS float*)(F.lds + 128 * 128 * 2);
    const int lane = F.lane, r32 = lane & 31, hi = lane >> 5, tm = F.wave >> 1, tn0 = (F.wave & 1) * 2;
    __syncthreads();
    unsigned* sctr = (unsigned*)(F.ws + WS_CTL) + CW_Q + 64 * 8 * 16 + 64 * (l + 4 * rep);
    LAS float* wl = rs + 128;
    for (;;) { const int u = next_unit(F, sctr); if (u >= 512) break;
        const int g = u & 3, row0 = (u >> 2) * 128;
        const int t = 32 * tm + r32;
        const float* bias = FIN(I_SGB) + (l * 4 + g) * 128 + 32 * tm;
        const int c0 = g * 128 + 32 * tn0 + r32;
        float uu0[16], uu1[16], bvv[16];
#pragma unroll
        for (int r = 0; r < 16; ++r) { const int tt = crow(r, hi); const size_t row = (size_t)(row0 + 32 * tm + tt); uu0[r] = (float)UU[row * 512 + c0]; uu1[r] = (float)UU[row * 512 + c0 + 32]; bvv[r] = bias[tt]; }
        { const float* wb = FIN(I_SGW) + (size_t)(l * 4 + g) * 128 * 128;
          f32x4 wv_[8];
#pragma unroll
          for (int k = 0; k < 8; ++k) wv_[k] = *(const f32x4*)(wb + (size_t)(F.tid + k * NTHREADS) * 4);
#pragma unroll
          for (int k = 0; k < 8; ++k) { const int e = (F.tid + k * NTHREADS) * 4, tr = e >> 7, sc_ = e & 127; *(LAS f32x4*)(wl + tr * 132 + sc_) = wv_[k]; } }
        for (int i = F.tid; i < 128 * 16; i += NTHREADS) { const int s = i >> 4, c8 = i & 15; *(LAS bf16x8*)(vs + s * 128 + c8 * 8) = *(const bf16x8*)(GV + (size_t)(row0 + s) * 512 + g * 128 + c8 * 8); }
        if (F.tid < 128) { const f32x4 p = *(const f32x4*)(SSQ + (size_t)(row0 + F.tid) * 16 + g * 4); rs[F.tid] = rsqrtf(((p.x + p.y) + (p.z + p.w)) * (1.f / 128) + EPS); }
        __syncthreads();
        f32x16 acc0 = f32x16{}, acc1 = f32x16{};
        const LAS float* wrow = wl + t * 132;
        for (int ks = 0; ks < 2 * (tm + 1); ++ks) {
            const int s0 = 16 * ks + 8 * hi;
            const f32x4 w0 = *(const LAS f32x4*)(wrow + s0), w1 = *(const LAS f32x4*)(wrow + s0 + 4);
            float wv[8] = {w0.x, w0.y, w0.z, w0.w, w1.x, w1.y, w1.z, w1.w};
            bf16x8 af, b0, b1;
#pragma unroll
            for (int j = 0; j < 8; ++j) { af[j] = (short)f2bf(s0 + j <= t ? wv[j] * rs[s0 + j] : 0.f);
                b0[j] = (short)vs[(s0 + j) * 128 + 32 * tn0 + r32]; b1[j] = (short)vs[(s0 + j) * 128 + 32 * (tn0 + 1) + r32]; }
            acc0 = __builtin_amdgcn_mfma_f32_32x32x16_bf16(af, b0, acc0, 0, 0, 0);
            acc1 = __builtin_amdgcn_mfma_f32_32x32x16_bf16(af, b1, acc1, 0, 0, 0);
        }
#pragma unroll
        for (int r = 0; r < 16; ++r) { const int tt = crow(r, hi); const size_t row = (size_t)(row0 + 32 * tm + tt);
            MIX[row * D + 1536 + c0] = (bf16)f2bf(uu0[r] * (acc0[r] + bvv[r]));
            MIX[row * D + 1536 + c0 + 32] = (bf16)f2bf(uu1[r] * (acc1[r] + bvv[r])); }
        __syncthreads();
    }
}
__device__ __forceinline__ void ph_convfix(Frame& F, int l) {
    const unsigned short* EDGE = WSP(unsigned short, WS_EDGE); bf16* U = WSP(bf16, WS_U);
    auto ldh4 = [](const unsigned short* p) { const uint2 w = *(const uint2*)p; return (f32x4){pg8::uph_lo(w.x), pg8::uph_hi(w.x), pg8::uph_lo(w.y), pg8::uph_hi(w.y)}; };
    const float* cw = FIN(I_CONVW) + (size_t)l * 3 * NUP; const float* cb = FIN(I_CONVB) + (size_t)l * NUP;
    const int gt = F.bid * NTHREADS + F.tid, nt = F.G * NTHREADS;
    constexpr int NIT = (M / 64) * 2 * (DFF / 4);
    auto item = [&](int i, unsigned long long& pk, size_t& dst) {
        const int ch = (i % (DFF / 4)) * 4, r = (i / (DFF / 4)) & 1, blk = i / (2 * (DFF / 4)); const bool first = (blk % (SEQ / 64)) == 0;
        f32x4 y[2];
#pragma unroll
        for (int bj = 0; bj < 2; ++bj) {
            const unsigned short* e0 = EDGE + ((size_t)(blk * 4) * 2 + bj) * DFF + ch;
            const f32x4 z = {0.f, 0.f, 0.f, 0.f};
            const f32x4 a0 = ldh4(e0 + (size_t)r * 2 * DFF);
            const f32x4 a1 = r == 1 ? ldh4(e0) : (first ? z : ldh4(e0 - (size_t)1 * 2 * DFF));
            const f32x4 a2 = first ? z : (r == 1 ? ldh4(e0 - (size_t)1 * 2 * DFF) : ldh4(e0 - (size_t)2 * 2 * DFF));
            y[bj] = *(const f32x4*)(cb + bj * DFF + ch) + *(const f32x4*)(cw + (size_t)2 * NUP + bj * DFF + ch) * a0 + *(const f32x4*)(cw + (size_t)NUP + bj * DFF + ch) * a1 + *(const f32x4*)(cw + bj * DFF + ch) * a2; }
        float o[4];
#pragma unroll
        for (int e = 0; e < 4; ++e) { const float g = y[0][e]; o[e] = g * __builtin_amdgcn_rcpf(1.0f + __expf(-g)) * y[1][e]; }
        pk = (unsigned long long)pk2(o[0], o[1]) | ((unsigned long long)pk2(o[2], o[3]) << 32); dst = (size_t)(blk * 64 + r) * DFF + ch; };
    for (int i = gt; i < NIT; i += 3 * nt) {
        unsigned long long p0 = 0, p1 = 0, p2 = 0; size_t d0 = 0, d1 = 0, d2 = 0;
        const bool h1 = i + nt < NIT, h2 = i + 2 * nt < NIT;
        item(i, p0, d0); if (h1) item(i + nt, p1, d1); if (h2) item(i + 2 * nt, p2, d2);
        *(unsigned long long*)(U + d0) = p0; if (h1) *(unsigned long long*)(U + d1) = p1; if (h2) *(unsigned long long*)(U + d2) = p2; }
}

__device__ __forceinline__ void ph_krope(Frame& F, int l) {
    const bf16* H = WSP(bf16, WS_H); const bf16* Wk = wptr(F, l, WL_IN) + (size_t)4096 * D; float* KR = WSP(float, WS_KR); float* SSQ = WSP(float, WS_SSQ_KR);
    constexpr int PITCH = 1024;
    LAS unsigned char* As = F.lds; LAS unsigned char* Bs = F.lds + 64 * PITCH;
    LAS float* red = (LAS float*)F.lds;
    const int lane = F.lane, r32 = lane & 31, hi = lane >> 5, w = F.wave;
    __syncthreads();
    for (int tb = F.bid; tb < M / 64; tb += F.G) {
        f32x16 acc[2][2];
#pragma unroll
        for (int i = 0; i < 2; ++i)
#pragma unroll
            for (int j = 0; j < 2; ++j) acc[i][j] = f32x16{};
        for (int kc = 0; kc < 4; ++kc) {
#pragma unroll
            for (int p = 0; p < 8; ++p) { const int q = p * NTHREADS + F.tid, row = q >> 6, c16 = q & 63;
                *(LAS v4u*)(As + row * PITCH + (c16 ^ (row & 7)) * 16) = *(const v4u*)(H + (size_t)(tb * 64 + row) * D + kc * 512 + c16 * 8);
                *(LAS v4u*)(Bs + row * PITCH + (c16 ^ (row & 7)) * 16) = *(const v4u*)(Wk + (size_t)row * D + kc * 512 + c16 * 8); }
            __syncthreads();
#pragma unroll
            for (int ks = 0; ks < 4; ++ks) { const int ko = (((w * 64 + ks * 16 + hi * 8) >> 3) ^ (r32 & 7)) * 16;
                const bf16x8 A0 = *(const LAS bf16x8*)(As + r32 * PITCH + ko), A1 = *(const LAS bf16x8*)(As + (32 + r32) * PITCH + ko);
                const bf16x8 B0 = *(const LAS bf16x8*)(Bs + r32 * PITCH + ko), B1 = *(const LAS bf16x8*)(Bs + (32 + r32) * PITCH + ko);
                acc[0][0] = __builtin_amdgcn_mfma_f32_32x32x16_bf16(A0, B0, acc[0][0], 0, 0, 0); acc[0][1] = __builtin_amdgcn_mfma_f32_32x32x16_bf16(A0, B1, acc[0][1], 0, 0, 0);
                acc[1][0] = __builtin_amdgcn_mfma_f32_32x32x16_bf16(A1, B0, acc[1][0], 0, 0, 0); acc[1][1] = __builtin_amdgcn_mfma_f32_32x32x16_bf16(A1, B1, acc[1][1], 0, 0, 0); }
            __syncthreads();
        }
#pragma unroll
        for (int i = 0; i < 2; ++i)
#pragma unroll
            for (int j = 0; j < 2; ++j)
#pragma unroll
                for (int r = 0; r < 16; ++r) red[(w * 64 + (i * 2 + j) * 16 + r) * 64 + lane] = acc[i][j][r];
        __syncthreads();
#pragma unroll
        for (int c = 0; c < 8; ++c) { const int cb = w * 8 + c, i = cb >> 5, j = (cb >> 4) & 1, r = cb & 15;
            float v = 0.f;
#pragma unroll
            for (int ww = 0; ww < 8; ++ww) v += red[(ww * 64 + cb) * 64 + lane];
            const int row = tb * 64 + 32 * i + crow(r, hi);
            KR[(size_t)row * 64 + 32 * j + r32] = v;
            const float ss = sum32(v * v);
            if (r32 == 0) SSQ[(size_t)row * 2 + j] = ss; }
        __syncthreads();
    }
}
__device__ __forceinline__ void frame_init(Frame& F, const Args& a, unsigned char* lds) {
    F.lds = (LAS unsigned char*)lds; F.tid = threadIdx.x; F.lane = F.tid & 63; F.wave = __builtin_amdgcn_readfirstlane(F.tid >> 6); F.wave0 = F.wave;
    F.bid = blockIdx.x; F.G = gridDim.x; F.gw = F.bid * NWAVES + F.wave; F.ngw = F.G * NWAVES;
    F.ka = (const __attribute__((address_space(4))) Args*)__builtin_amdgcn_kernarg_segment_ptr();
    F.pos = (const int*)a.in[I_POS]; F.out = a.out; F.ws = a.ws;
}
__device__ __forceinline__ void frame_retid(Frame& F) {
    int lane; asm volatile("v_mbcnt_lo_u32_b32 %0, -1, 0\n\tv_mbcnt_hi_u32_b32 %0, -1, %0" : "=v"(lane));
    int w = F.wave0; asm volatile("" : "+s"(w));
    F.lane = lane; F.wave = w; F.tid = w * 64 + lane;
    int bid = blockIdx.x, G = gridDim.x; asm volatile("" : "+s"(bid)); asm volatile("" : "+s"(G)); F.bid = bid; F.G = G;
    F.gw = bid * NWAVES + F.wave; F.ngw = G * NWAVES;
}
__device__ __forceinline__ void grid_bar(const XcdBarrier& bar, int wave0) {
    int lane_; asm volatile("v_mbcnt_lo_u32_b32 %0, -1, 0\n\tv_mbcnt_hi_u32_b32 %0, -1, %0" : "=v"(lane_)); const bool leader = (wave0 == 0) && (lane_ == 0);
    XcdBarrier b2 = bar; unsigned z_ = 0u; asm volatile("" : "+s"(b2.x), "+s"(z_)); b2.bar = bar.bar + z_; xcd_barrier(b2, leader); }
template <int PH> __device__ __forceinline__ void run_phase(Frame& F, int l) {
    frame_retid(F); asm volatile("; PHASE_BEGIN %0" :: "n"(PH));
    const float* mod = WSP(float, WS_MOD) + (size_t)l * 12 * D;
    if constexpr (PH == 0) ph_prologue(F);
    if constexpr (PH == 1) ph_modreduce(F);
    if constexpr (PH == 2) { if (l == 0) ph_norm<false>(F, l, FIN(I_X), 0, D); else ph_norm<true>(F, l, WSP(bf16, WS_XB), 0, D); }
    if constexpr (PH == 3) { pg8::Gemm g{WSP(bf16, WS_H), wptr(F, l, WL_IN), M, 4096, D}; pg8::StaticOrder S; S.init(M, 4096, F.G, F.bid);
        pg8::EpiInProj E{WSP(bf16, WS_QD), WSP(bf16, WS_KD), WSP(bf16, WS_VD), WSP(bf16, WS_QA), WSP(bf16, WS_KVA), WSP(bf16, WS_GV), WSP(unsigned short, WS_UU), WSP(float, WS_KR),
                         WSP(float, WS_SSQ_QA), WSP(float, WS_SSQ_KVA), WSP(float, WS_SSQ_SGV), WSP(float, WS_SSQ_KR), FIN(I_DAQG) + l * 64, FIN(I_DAKG) + l * 64, FIN(I_QAG) + l * 512, FIN(I_KVAG) + l * 256, FIN(I_SGVG) + l * 512};
        pg8::gemm_phase<pg8::EpiInProj, pg8::StaticOrder, true, true>(F.lds, g, S, E, F.tid); frame_retid(F); ph_krope(F, l); }
    if constexpr (PH == 5) {
        PG8_LAS float* X = (PG8_LAS float*)(F.lds + LDSCTL_OFF + 1024);
        { pg8::Gemm g{WSP(bf16, WS_QA), wptr(F, l, WL_UQ), M, UQ_PAD, QRANK}; pg8::StaticOrder S; S.init(M, UQ_PAD, F.G, F.bid);
          pg8::EpiMlaQ E{WSP(bf16, WS_QM), WSP(float, WS_SSQ_QA), WSP(float, WS_COS), WSP(float, WS_SIN), FIN(I_MQG) + l * 192, X};
          pg8::gemm_phase<pg8::EpiMlaQ, pg8::StaticOrder, true, true>(F.lds, g, S, E, F.tid); }
        __syncthreads(); frame_retid(F);
        { pg8::Gemm g{WSP(bf16, WS_KVA), wptr(F, l, WL_UKV), M, UKV_N, KVRANK}; pg8::StaticOrder S; S.init(M, UKV_N, F.G, F.G - 1 - F.bid);
          pg8::EpiMlaKV E{WSP(bf16, WS_KM), WSP(bf16, WS_VM), WSP(float, WS_SSQ_KVA), WSP(float, WS_SSQ_KR), WSP(float, WS_KR), WSP(float, WS_COS), WSP(float, WS_SIN), FIN(I_MKG) + l * 192, X};
          pg8::gemm_phase<pg8::EpiMlaKV, pg8::StaticOrder, true, true>(F.lds, g, S, E, F.tid); }
    }
    if constexpr (PH == 7) { ph_attn_da<5>(F, l); frame_retid(F); ph_attn_da<0>(F, l); frame_retid(F); asm volatile("; PHASE_BEGIN 71"); ph_attn_mla<5>(F, l); frame_retid(F); ph_attn_mla<0>(F, l); frame_retid(F); asm volatile("; PHASE_BEGIN 72"); ph_sgu(F, l); }
    if constexpr (PH == 8) { pg8::Gemm g{WSP(bf16, WS_MIX), wptr(F, l, WL_OUT), M, D, D}; pg8::StaticOrder S; S.init(M, D, F.G, F.bid);
        pg8::EpiResidP E{l == 0 ? (const void*)FIN(I_X) : (const void*)WSP(bf16, WS_XB), WSP(bf16, WS_XB), l != 0, 1, mod + 2 * D, 6 * D}; pg8::gemm_phase<pg8::EpiResidP, pg8::StaticOrder, true, true>(F.lds, g, S, E, F.tid); }
    if constexpr (PH == 9) ph_norm<true>(F, l, WSP(bf16, WS_XB), 3 * D, 4 * D);
    if constexpr (PH == 10) { pg8::Gemm g{WSP(bf16, WS_H), wptr(F, l, WL_UP), M, NUP, D}; pg8::StaticOrder S; S.init(M, NUP, F.G, F.bid);
        pg8::EpiConvGate E{WSP(bf16, WS_U), WSP(unsigned short, WS_EDGE), FIN(I_CONVW) + (size_t)l * 3 * NUP, FIN(I_CONVB) + (size_t)l * NUP}; pg8::gemm_phase<pg8::EpiConvGate, pg8::StaticOrder, true, true>(F.lds, g, S, E, F.tid); }
    if constexpr (PH == 11) ph_convfix(F, l);
    if constexpr (PH == 12) { pg8::Gemm g{WSP(bf16, WS_U), wptr(F, l, WL_DOWN), M, D, DFF}; pg8::StaticOrder S; S.init(M, D, F.G, F.bid);
        pg8::EpiResidP E{WSP(bf16, WS_XB), l + 1 < DEPTH ? (void*)WSP(bf16, WS_XB) : (void*)F.out, 1, l + 1 < DEPTH, mod + 5 * D, 6 * D}; pg8::gemm_phase<pg8::EpiResidP, pg8::StaticOrder, true, true>(F.lds, g, S, E, F.tid); }
}
__global__ void __launch_bounds__(NTHREADS, 2) mega_fwd(Args a) {
    extern __shared__ __attribute__((aligned(16))) unsigned char lds[];
    Frame F; frame_init(F, a, lds);
    if (F.tid < 16) ((LAS unsigned*)(F.lds + LDSCTL_OFF))[F.tid] = 0u;
    __syncthreads();
    XcdBarrier bar = xcd_barrier_post((unsigned*)(F.ws + WS_CTL) + CW_BAR, (volatile LAS unsigned*)(F.lds + LDSCTL_OFF + 32));
    run_phase<0>(F, 0); grid_bar(bar, F.wave0);
#if defined(PROBE_P0)
    run_phase<0>(F, 0); grid_bar(bar, F.wave0);
#endif
    run_phase<1>(F, 0); grid_bar(bar, F.wave0);
    for (int l = 0; l < DEPTH; ++l) {
        run_phase<2>(F, l); grid_bar(bar, F.wave0);
#if defined(PROBE_EW)
        run_phase<2>(F, l); grid_bar(bar, F.wave0);
#endif
        run_phase<3>(F, l); grid_bar(bar, F.wave0);
#if defined(PROBE_GEMM)
        run_phase<3>(F, l); grid_bar(bar, F.wave0);
#endif
        run_phase<5>(F, l); grid_bar(bar, F.wave0);
        run_phase<7>(F, l); grid_bar(bar, F.wave0);
#if defined(PROBE_P7)
        frame_retid(F); ph_attn_da<5>(F, l, 1); frame_retid(F); ph_attn_mla<5>(F, l, 1); grid_bar(bar, F.wave0);
#endif
#if defined(PROBE_LOC)
        frame_retid(F); ph_attn_da<5>(F, l, 2); frame_retid(F); ph_attn_mla<5>(F, l, 2); grid_bar(bar, F.wave0);
#endif
#if defined(PROBE_DA)
        frame_retid(F); ph_attn_da<5>(F, l, 1); grid_bar(bar, F.wave0);
#endif
#if defined(PROBE_VAR)
        frame_retid(F); ph_attn_mla<5>(F, l, 3); grid_bar(bar, F.wave0);
#endif
#if defined(PROBE_MLA)
        frame_retid(F); ph_attn_mla<5>(F, l, 1); grid_bar(bar, F.wave0);
#endif
#if defined(PROBE_SGU)
        frame_retid(F); ph_sgu(F, l, 1); grid_bar(bar, F.wave0);
#endif
        run_phase<8>(F, l); grid_bar(bar, F.wave0);
        run_phase<9>(F, l); grid_bar(bar, F.wave0);
        run_phase<10>(F, l); grid_bar(bar, F.wave0);
#if defined(PROBE_G10)
        frame_retid(F); run_phase<10>(F, l); grid_bar(bar, F.wave0);
#endif
#if defined(PROBE_G10N)
        frame_retid(F); { pg8::Gemm g{WSP(bf16, WS_H), wptr(F, l, WL_UP), M, NUP, D}; pg8::StaticOrder S; S.init(M, NUP, F.G, F.bid);
          pg8::EpiNull E{WSP(float, WS_MIX)}; pg8::gemm_phase<pg8::EpiNull, pg8::StaticOrder, true, true>(F.lds, g, S, E, F.tid); } grid_bar(bar, F.wave0);
#endif
#if defined(PROBE_GEMM)
        run_phase<10>(F, l); grid_bar(bar, F.wave0);
#endif
        run_phase<11>(F, l); grid_bar(bar, F.wave0);
#if defined(PROBE_EW)
        run_phase<11>(F, l); grid_bar(bar, F.wave0);
#endif
        run_phase<12>(F, l); if (l + 1 < DEPTH) grid_bar(bar, F.wave0);
    }
}

extern "C" void kernel_launch(void* const* d_in, const int* in_sizes, int n_in, void* d_out, int out_size, void* d_ws, size_t ws_size, hipStream_t stream) {
    static int grid = 0;
    if (grid == 0) {
        if (n_in != N_IN || in_sizes[0] != M * D || out_size != M * D || ws_size < WS_END) { fprintf(stderr, "kernel_launch: shape mismatch (n_in %d, ws %zu, need %zu)\n", n_in, ws_size, (size_t)WS_END); grid = -1; return; }
        int dev = 0, cus = 0, per_cu = 0;
        if (hipGetDevice(&dev) != hipSuccess || hipDeviceGetAttribute(&cus, hipDeviceAttributeMultiprocessorCount, dev) != hipSuccess) { grid = -1; return; }
        if (hipFuncSetAttribute((const void*)mega_fwd, hipFuncAttributeMaxDynamicSharedMemorySize, LDS_BYTES) != hipSuccess) { fprintf(stderr, "hipFuncSetAttribute failed\n"); grid = -1; return; }
        if (hipOccupancyMaxActiveBlocksPerMultiprocessor(&per_cu, (const void*)mega_fwd, NTHREADS, LDS_BYTES) != hipSuccess || per_cu < 1) fprintf(stderr, "kernel_launch: occupancy query reports %d\n", per_cu);
        (void)hipGetLastError();
        grid = cus > 0 ? cus : 256;
    }
    if (grid < 0) return;
    if (hipMemsetAsync((char*)d_ws + WS_CTL, 0, CTL_ZERO_BYTES, stream) != hipSuccess) { fprintf(stderr, "kernel_launch: memset failed\n"); return; }
    Args a{};
    for (int i = 0; i < N_IN; ++i) a.in[i] = d_in[i];
    a.out = (float*)d_out; a.ws = (unsigned char*)d_ws; a.ph = 0; a.l = 0;
    hipLaunchKernelGGL(mega_fwd, dim3(grid), dim3(NTHREADS), LDS_BYTES, stream, a);
    const hipError_t le = hipPeekAtLastError();
    if (le != hipSuccess) fprintf(stderr, "kernel_launch: launch failed: %s\n", hipGetErrorName(le));
}
```

```cpp
#include <hip/hip_runtime.h>
#include <cstdio>
#include <cstdint>
#include <cmath>
#define GAS __attribute__((address_space(1)))
#define LAS __attribute__((address_space(3)))
namespace pg8 {
#define PG8_LAS __attribute__((address_space(3)))
typedef unsigned short bf16_t;
typedef short bf16x8 __attribute__((ext_vector_type(8)));
typedef float f32x4 __attribute__((ext_vector_type(4)));
typedef unsigned u32x4 __attribute__((ext_vector_type(4)));
constexpr int BM = 256, BK = 64, HALF = 128, HTB = HALF * BK * 2  , STAGE_BYTES = 8 * HTB, NXCD = 8, WGM = 8;

__host__ __device__ __forceinline__ int lds_byte(int r, int c) { const int st = (r >> 4) * 2 + (c >> 5), rr = r & 15, cc = c & 31, ob = rr * 64 + cc * 2; return st * 1024 + (ob ^ (((ob >> 9) & 1) << 5)); }
__host__ __device__ __forceinline__ void stage_rc(int b, int& R, int& C) { const int st = b / 1024, sb = b % 1024, swz = sb ^ (((sb >> 9) & 1) << 5); R = (st >> 1) * 16 + swz / 64; C = (st & 1) * 32 + (swz % 64) / 2; }
__host__ __device__ __forceinline__ int perm32(int rho) { const int n = rho >> 4, i = rho & 15; return 8 * (i >> 2) + 4 * n + (i & 3); }

struct Unit { int pm, pn; };
struct Gemm { const bf16_t* A; const bf16_t* Bt; int M, N, K; };

struct StaticOrder {
    int nM, nN, nwg, G, c;
    __host__ __device__ void init(int M, int N, int G_, int c_) { nM = M / BM; nN = N / BM; nwg = nM * nN; G = G_; c = c_; }
    __host__ __device__ bool next(int i, Unit& u) const {
        const long L = (long)i * G + c; if (L >= nwg) return false;
        int wgid = (int)L; { const int q = nwg / NXCD, r = nwg % NXCD, xcd = wgid % NXCD, off = wgid / NXCD; wgid = (xcd < r ? xcd * (q + 1) : r * (q + 1) + (xcd - r) * q) + off; }
        const int nig = WGM * nN, gid = wgid / nig, fm = gid * WGM, gsz = (nM - fm) < WGM ? (nM - fm) : WGM;
        u.pm = fm + ((wgid % nig) % gsz); u.pn = (wgid % nig) / gsz; return true;
    }
    __device__ __forceinline__ void a_ready(const Unit&) const {}
    __device__ __forceinline__ void done(const Unit&) const {}
};

__device__ __forceinline__ unsigned cvt_pk_bf16(float lo, float hi) { unsigned r; asm volatile("v_cvt_pk_bf16_f32 %0, %1, %2" : "=v"(r) : "v"(lo), "v"(hi)); return r; }
typedef float f32x2 __attribute__((ext_vector_type(2)));
typedef _Float16 f16x2 __attribute__((ext_vector_type(2)));
__device__ __forceinline__ unsigned pkh2(float a, float b) { const f16x2 h = {(_Float16)a, (_Float16)b}; return __builtin_bit_cast(unsigned, h); }
__device__ __forceinline__ float uph_lo(unsigned w) { return (float)__builtin_bit_cast(f16x2, w).x; }
__device__ __forceinline__ float uph_hi(unsigned w) { return (float)__builtin_bit_cast(f16x2, w).y; }

template <class Epi, class Sched, bool ALIGN_EPI = false, bool SP2 = false>
__device__ __forceinline__ void gemm_phase(PG8_LAS unsigned char* lds, const Gemm g, const Sched& S, const Epi& E, int tid_in) {
    int tid_ = tid_in; asm volatile("" : "+v"(tid_));
    const int tid = tid_, wid = __builtin_amdgcn_readfirstlane(tid >> 6), lane = tid & 63, wr = wid >> 2, wc = wid & 3, fr = lane & 15, fq = lane >> 4;
    const int K = g.K, nt = K / BK;
    unsigned voffA[2], voffB[2];
#pragma unroll
    for (int i = 0; i < 2; ++i) { int R, C; stage_rc(tid * 16 + i * 8192, R, C); const int Rb = Epi::PERM ? ((R & ~31) + perm32(R & 31)) : R;
        voffA[i] = (unsigned)(R * K + C) * 2u; voffB[i] = (unsigned)(Rb * K + C) * 2u; }
    const size_t kstep = (size_t)(BK * 2);
    const size_t hstep = (size_t)HALF * K * 2;
    const size_t tstep = 2 * hstep;
    const unsigned ldsw = (unsigned)wid * 1024u;
    const int aoff = lds_byte(wr * 64 + fr, fq * 8), boff = lds_byte(wc * 32 + fr, fq * 8);
#define PG8_SA(b, h) (((b) * 2 + (h)) * HTB)
#define PG8_SB(b, h) ((4 + (b) * 2 + (h)) * HTB)
#define PG8_STAGE(bufoff, gbase, voff) do { _Pragma("unroll") for (int _i = 0; _i < 2; ++_i) \
        __builtin_amdgcn_global_load_lds((const unsigned*)((const char*)(gbase) + (voff)[_i]), (PG8_LAS unsigned*)(lds + (bufoff) + ldsw + _i * 8192), 16, 0, 0); } while (0)
#define PG8_LDA(dst, b, h) do { _Pragma("unroll") for (int m = 0; m < 4; ++m) _Pragma("unroll") for (int k = 0; k < 2; ++k) dst[m][k] = *(const PG8_LAS bf16x8*)(lds + PG8_SA(b, h) + aoff + m * 2048 + k * 1024); } while (0)
#define PG8_LDB(dst, b, h) do { _Pragma("unroll") for (int n = 0; n < 2; ++n) _Pragma("unroll") for (int k = 0; k < 2; ++k) dst[n][k] = *(const PG8_LAS bf16x8*)(lds + PG8_SB(b, h) + boff + n * 2048 + k * 1024); } while (0)
#define PG8_MMA(ai, bj, At, Bt) do { __builtin_amdgcn_s_setprio(1); _Pragma("unroll") for (int m = 0; m < 4; ++m) _Pragma("unroll") for (int n = 0; n < 2; ++n) _Pragma("unroll") for (int k = 0; k < 2; ++k) \
        acc[ai][bj][m][n] = __builtin_amdgcn_mfma_f32_16x16x32_bf16(Bt[n][k], At[m][k], acc[ai][bj][m][n], 0, 0, 0); __builtin_amdgcn_s_setprio(0); } while (0)
#define PG8_WAIT_V(n) asm volatile("s_waitcnt vmcnt(" #n ")" ::: "memory")
#define PG8_WAIT_L(n) asm volatile("s_waitcnt lgkmcnt(" #n ")" ::: "memory")
#define PG8_BAR __builtin_amdgcn_s_barrier()
#define PG8_SCHED __builtin_amdgcn_sched_barrier(0)
    Unit cur, nxt; int ui = 0;
    if (!S.next(0, cur)) return;
    f32x4 acc[2][2][4][2];
#pragma unroll
    for (int a = 0; a < 2; ++a)
#pragma unroll
        for (int b = 0; b < 2; ++b)
#pragma unroll
            for (int m = 0; m < 4; ++m)
#pragma unroll
                for (int n = 0; n < 2; ++n) acc[a][b][m][n] = (f32x4){0.f, 0.f, 0.f, 0.f};
    bf16x8 At[4][2], B0[2][2], B1[2][2];
    const char* cA = (const char*)g.A + (size_t)cur.pm * tstep; const char* cB = (const char*)g.Bt + (size_t)cur.pn * tstep;
    S.a_ready(cur);
    if constexpr (SP2) {
        PG8_STAGE(PG8_SB(0, 0), cB, voffB); PG8_STAGE(PG8_SB(0, 1), cB + hstep, voffB); PG8_STAGE(PG8_SA(0, 0), cA, voffA); PG8_STAGE(PG8_SA(0, 1), cA + hstep, voffA);
        if (wr == 1) PG8_BAR;
        PG8_WAIT_V(2); PG8_BAR;
        PG8_STAGE(PG8_SB(1, 0), cB + kstep, voffB); PG8_STAGE(PG8_SA(1, 0), cA + kstep, voffA); PG8_STAGE(PG8_SB(1, 1), cB + hstep + kstep, voffB);
        PG8_WAIT_V(6); PG8_BAR;
    } else {
        PG8_STAGE(PG8_SB(0, 0), cB, voffB); PG8_STAGE(PG8_SA(0, 0), cA, voffA); PG8_STAGE(PG8_SB(0, 1), cB + hstep, voffB); PG8_STAGE(PG8_SA(0, 1), cA + hstep, voffA);
        if (wr == 1) PG8_BAR;
        PG8_WAIT_V(4); PG8_BAR;
        PG8_STAGE(PG8_SB(1, 0), cB + kstep, voffB); PG8_STAGE(PG8_SA(1, 0), cA + kstep, voffA); PG8_STAGE(PG8_SB(1, 1), cB + hstep + kstep, voffB);
        PG8_WAIT_V(6); PG8_BAR;
    }
    for (;;) {
        const bool has_next = S.next(ui + 1, nxt);
        const char* nA = has_next ? (const char*)g.A + (size_t)nxt.pm * tstep : cA; const char* nB = has_next ? (const char*)g.Bt + (size_t)nxt.pn * tstep : cB;
        for (int t = 0; t < nt; t += 2) {
            const bool last = (t == nt - 2);
            const char* a1 = cA + (size_t)(t + 1) * kstep;
            const char* a2 = last ? nA : cA + (size_t)(t + 2) * kstep; const char* b2 = last ? nB : cB + (size_t)(t + 2) * kstep;
            const char* a3 = a2 + kstep; const char* b3 = b2 + kstep;
            if (last && has_next) S.a_ready(nxt);
            if constexpr (SP2) {
            PG8_LDB(B0, 0, 0); PG8_LDB(B1, 0, 1); PG8_SCHED; PG8_LDA(At, 0, 0); PG8_STAGE(PG8_SA(1, 1), a1 + hstep, voffA);
            PG8_WAIT_V(8); PG8_WAIT_L(0); PG8_BAR; PG8_MMA(0, 0, At, B0); PG8_MMA(0, 1, At, B1); PG8_BAR; PG8_SCHED;
            PG8_LDA(At, 0, 1); PG8_STAGE(PG8_SB(0, 0), b2, voffB); PG8_STAGE(PG8_SB(0, 1), b2 + hstep, voffB); PG8_STAGE(PG8_SA(0, 0), a2, voffA);
            PG8_WAIT_V(8); PG8_WAIT_L(0); PG8_BAR; PG8_MMA(1, 0, At, B0); PG8_MMA(1, 1, At, B1); PG8_BAR; PG8_SCHED;
            PG8_LDB(B0, 1, 0); PG8_LDB(B1, 1, 1); PG8_SCHED; PG8_LDA(At, 1, 0); PG8_STAGE(PG8_SA(0, 1), a2 + hstep, voffA);
            PG8_WAIT_V(8); PG8_WAIT_L(0); PG8_BAR; PG8_MMA(0, 0, At, B0); PG8_MMA(0, 1, At, B1); PG8_BAR; PG8_SCHED;
            PG8_LDA(At, 1, 1); PG8_STAGE(PG8_SB(1, 0), b3, voffB); PG8_STAGE(PG8_SB(1, 1), b3 + hstep, voffB); PG8_STAGE(PG8_SA(1, 0), a3, voffA);
            PG8_WAIT_V(8); PG8_WAIT_L(0); PG8_BAR; PG8_MMA(1, 0, At, B0); PG8_MMA(1, 1, At, B1); PG8_BAR; PG8_SCHED;
            } else {
            PG8_LDB(B0, 0, 0); PG8_SCHED; PG8_LDA(At, 0, 0); PG8_STAGE(PG8_SA(1, 1), a1 + hstep, voffA);
            PG8_WAIT_L(8); PG8_BAR; PG8_WAIT_L(0); PG8_MMA(0, 0, At, B0); PG8_BAR; PG8_SCHED;
            PG8_LDB(B1, 0, 1); PG8_STAGE(PG8_SB(0, 0), b2, voffB);
            PG8_BAR; PG8_WAIT_L(0); PG8_MMA(0, 1, At, B1); PG8_BAR;
            PG8_LDA(At, 0, 1); PG8_STAGE(PG8_SA(0, 0), a2, voffA);
            PG8_BAR; PG8_WAIT_L(0); PG8_MMA(1, 0, At, B0); PG8_BAR; PG8_SCHED;
            PG8_STAGE(PG8_SB(0, 1), b2 + hstep, voffB);
            PG8_WAIT_V(6); PG8_BAR; PG8_MMA(1, 1, At, B1); PG8_BAR;
            PG8_LDB(B0, 1, 0); PG8_SCHED; PG8_LDA(At, 1, 0); PG8_STAGE(PG8_SA(0, 1), a2 + hstep, voffA);
            PG8_WAIT_L(8); PG8_BAR; PG8_WAIT_L(0); PG8_MMA(0, 0, At, B0); PG8_BAR; PG8_SCHED;
            PG8_LDB(B1, 1, 1); PG8_STAGE(PG8_SB(1, 0), b3, voffB);
            PG8_BAR; PG8_WAIT_L(0); PG8_MMA(0, 1, At, B1); PG8_BAR;
            PG8_LDA(At, 1, 1); PG8_STAGE(PG8_SA(1, 0), a3, voffA);
            PG8_BAR; PG8_WAIT_L(0); PG8_MMA(1, 0, At, B0); PG8_BAR; PG8_SCHED;
            PG8_STAGE(PG8_SB(1, 1), b3 + hstep, voffB);
            PG8_WAIT_V(6); PG8_BAR; PG8_MMA(1, 1, At, B1); PG8_BAR;
            }
        }
        if constexpr (ALIGN_EPI) { if (wr == 0) PG8_BAR; }
        if constexpr (!Epi::AFTER_DRAIN) { E(acc, cur, wr, wc, fr, fq); S.done(cur); }
        if (!has_next) break;
#pragma unroll
        for (int a = 0; a < 2; ++a)
#pragma unroll
            for (int b = 0; b < 2; ++b)
#pragma unroll
                for (int m = 0; m < 4; ++m)
#pragma unroll
                    for (int n = 0; n < 2; ++n) acc[a][b][m][n] = (f32x4){0.f, 0.f, 0.f, 0.f};
        cur = nxt; cA = nA; cB = nB; ++ui;
        if constexpr (ALIGN_EPI) { if (wr == 1) PG8_BAR; }
    }
    PG8_WAIT_V(0);
    if constexpr (!ALIGN_EPI) { if (wr == 0) PG8_BAR; }
    PG8_BAR;
    if constexpr (Epi::AFTER_DRAIN) { E.fused(acc, cur, wr, wc, fr, fq, lds, wid, lane); S.done(cur); }
#undef PG8_SA
#undef PG8_SB
#undef PG8_STAGE
#undef PG8_LDA
#undef PG8_LDB
#undef PG8_MMA
#undef PG8_WAIT_V
#undef PG8_WAIT_L
#undef PG8_BAR
#undef PG8_SCHED
}
}
#define XB_TMO      128
#define XB_XCNT(j)  (256  + 64 * (j))
#define XB_XSUB(j)  (1280 + 64 * (j))
#define XB_XGEN(j)  (2304 + 64 * (j))
#define XB_TOP      3328
#define XB_TOPGEN   3392
#define XCD_BAR_WORDS 3456
#define XB_SPIN_CAP (1u << 18)

__device__ __forceinline__ unsigned xb_ld(unsigned* p)              { return __hip_atomic_load(p, __ATOMIC_RELAXED, __HIP_MEMORY_SCOPE_AGENT); }
__device__ __forceinline__ unsigned xb_add(unsigned* p, unsigned v) { return __hip_atomic_fetch_add(p, v, __ATOMIC_RELAXED, __HIP_MEMORY_SCOPE_AGENT); }
__device__ __forceinline__ unsigned xb_xcc_id() { return (unsigned)__builtin_amdgcn_s_getreg((3 << 11) | 20) & 0xFu; }
#define XB_SPIN(cond, bar) do { unsigned _sp = 0; while (cond) { __builtin_amdgcn_s_sleep(1); \
    if ((++_sp & 255u) == 0u) { if (xb_ld(&(bar)[XB_TMO])) break; if (_sp > XB_SPIN_CAP) { atomicAdd(&(bar)[XB_TMO], 1u); break; } } } } while (0)

struct XcdBarrier {
    unsigned* bar; unsigned x;
    volatile LAS unsigned* st;
};

__device__ __forceinline__ XcdBarrier xcd_barrier_post(unsigned* bar, volatile LAS unsigned* st) {
    XcdBarrier b; b.bar = bar; b.x = xb_xcc_id(); b.st = st;
    if (threadIdx.x == 0) (void)xb_add(&bar[XB_XCNT(b.x)], 1u);
    return b;
}
__device__ __forceinline__ void xcd_barrier_complete(unsigned* bar, unsigned x, unsigned& nloc, unsigned& nx) {
    const unsigned G = gridDim.x * gridDim.y * gridDim.z;
    unsigned sum, cnt, mine, sp = 0u;
    for (;;) {
        sum = 0u; cnt = 0u; mine = 0u;
#pragma unroll
        for (unsigned j = 0; j < 16; ++j) { const unsigned c = xb_ld(&bar[XB_XCNT(j)]); sum += c; cnt += (c > 0u) ? 1u : 0u; mine = (j == x) ? c : mine; }
        if (sum == G) break;
        __builtin_amdgcn_s_sleep(1);
        if ((++sp & 255u) == 0u) { if (xb_ld(&bar[XB_TMO])) break; if (sp > XB_SPIN_CAP) { atomicAdd(&bar[XB_TMO], 1u); break; } }
    }
    nloc = mine > 0u ? mine : 1u; nx = cnt > 0u ? cnt : 1u;
}

__device__ __forceinline__ void xcd_barrier(const XcdBarrier& b, bool leader) {
    asm volatile("s_waitcnt vmcnt(0)" ::: "memory");
    __syncthreads();
    if (leader) {
        unsigned* bar = b.bar;
        __builtin_amdgcn_s_waitcnt(0);
        unsigned nloc = b.st[0], nx = b.st[1];
        if (nloc == 0u) { xcd_barrier_complete(bar, b.x, nloc, nx); b.st[0] = nloc; b.st[1] = nx; }
        const unsigned old = xb_add(&bar[XB_XSUB(b.x)], 1u);
        const unsigned gen = old / nloc;
        if (old + 1u == (gen + 1u) * nloc) {
            __builtin_amdgcn_fence(__ATOMIC_RELEASE, "agent");
            asm volatile("s_waitcnt vmcnt(0)" ::: "memory");
            const unsigned og = xb_add(&bar[XB_TOP], 1u);
            const unsigned tg = og / nx;
            if (og + 1u == (tg + 1u) * nx) xb_add(&bar[XB_TOPGEN], 1u);
            else XB_SPIN(xb_ld(&bar[XB_TOPGEN]) == tg, bar);
            __builtin_amdgcn_fence(__ATOMIC_ACQUIRE, "agent");
            xb_add(&bar[XB_XGEN(b.x)], 1u);
            asm volatile("s_waitcnt vmcnt(0)" ::: "memory");
        } else {
            XB_SPIN(xb_ld(&bar[XB_XGEN(b.x)]) == gen, bar);
            __builtin_amdgcn_fence(__ATOMIC_ACQUIRE, "agent");
            asm volatile("s_waitcnt vmcnt(0)" ::: "memory");
        }
    }
    __syncthreads();
}

typedef unsigned short bf16;
typedef unsigned v4u __attribute__((ext_vector_type(4)));
typedef unsigned v2u __attribute__((ext_vector_type(2)));
typedef float f32x4 __attribute__((ext_vector_type(4)));
typedef float f32x16 __attribute__((ext_vector_type(16)));
typedef short bf16x8 __attribute__((ext_vector_type(8)));
#define LDS_WAIT() asm volatile("s_waitcnt lgkmcnt(0)" ::: "memory")
#define VM_WAIT() asm volatile("s_waitcnt vmcnt(0)" ::: "memory")

constexpr int NWAVES = 8, NTHREADS = 512;
constexpr int BATCH = 2, SEQ = 8192, M = BATCH * SEQ, D = 2048, DEPTH = 4;
constexpr int IN_COLS = 4160, IN_PAD = 4352;
constexpr int C_DAQ = 0, C_DAK = 768, C_DAV = 1536, C_QA = 2304, C_KVA = 2816, C_KR = 3072, C_SGU = 3136, C_SGV = 3648;
constexpr int DFF = 5632, NUP = 2 * DFF;
constexpr int UQ_N = 1152, UQ_PAD = 1536, UKV_N = 1536, QRANK = 512, KVRANK = 256;
constexpr int NH = 6;
constexpr float EPS = 1e-6f;
constexpr float LOG2E = 1.4426950408889634f;
constexpr float QS_DA = 0.125f * LOG2E;
constexpr float QS_MLA = 0.07216878364870322f * LOG2E;

enum { I_X = 0, I_C, I_POS, I_WADA, I_BADA, I_WIN, I_DAQG, I_DAKG, I_LQ1, I_LK1, I_LQ2, I_LK2, I_DAHG, I_QAG, I_WUQ, I_KVAG, I_WUKV, I_MQG, I_MKG, I_SGVG, I_SGW, I_SGB, I_WOUT, I_WUP, I_CONVW, I_CONVB, I_WDOWN, N_IN };

constexpr size_t MiB = 1u << 20;
constexpr size_t WS_CTL = 0, CTL_ZERO_BYTES = 1 * MiB;
constexpr size_t WS_MOD = 1 * MiB;
constexpr size_t WS_POSMM = 1 * MiB + 512 * 1024;
constexpr size_t WS_MODP = 2 * MiB;
constexpr size_t WS_W = 8 * MiB;
constexpr size_t WL_IN = 0, WL_UQ = 17 * MiB, WL_UKV = WL_UQ + 1572864, WL_OUT = 20 * MiB, WL_UP = 28 * MiB, WL_DOWN = 72 * MiB, WL_STRIDE = 94 * MiB;
constexpr size_t WS_H = 384 * MiB;
constexpr size_t WS_MIX = 448 * MiB;
constexpr size_t WS_U = 512 * MiB;
constexpr size_t WS_R = 688 * MiB;
constexpr size_t WS_KR = WS_R;
constexpr size_t WS_SSQ_QA = WS_R + 4 * MiB, WS_SSQ_KVA = WS_R + 5 * MiB, WS_SSQ_SGV = WS_R + 6 * MiB, WS_SSQ_KR = WS_R + 7 * MiB;
constexpr size_t WS_QD = WS_R + 272 * MiB, WS_KD = WS_R + 296 * MiB, WS_VD = WS_R + 320 * MiB;
constexpr size_t WS_QM = WS_R + 344 * MiB, WS_KM = WS_R + 380 * MiB, WS_VM = WS_R + 416 * MiB;
constexpr size_t WS_QA = WS_R + 440 * MiB, WS_KVA = WS_R + 456 * MiB;
constexpr size_t WS_MLQ = WS_R + 464 * MiB, WS_MLKV = WS_R + 544 * MiB;
constexpr size_t WS_XB = WS_R + 464 * MiB;
constexpr size_t WS_UU = WS_R + 640 * MiB, WS_GV = WS_R + 672 * MiB;
constexpr size_t WS_EDGE = WS_R;
constexpr size_t WS_A = WS_R;
constexpr size_t WS_O1 = WS_R + 704 * MiB;
constexpr size_t WS_COS = WS_R + 752 * MiB, WS_SIN = WS_R + 754 * MiB;
constexpr size_t WS_END = WS_R + 756 * MiB;

constexpr int RING_BYTES = 131072;
constexpr int LDSCTL_OFF = RING_BYTES;
constexpr int LDS_BYTES = 147456;

__device__ const float ROPE_INV[32] = {1.000000000e+00f, 7.498942614e-01f, 5.623413324e-01f, 4.216965139e-01f, 3.162277639e-01f, 2.371373773e-01f, 1.778279394e-01f, 1.333521307e-01f, 1.000000015e-01f, 7.498941571e-02f, 5.623413250e-02f, 4.216965288e-02f, 3.162277490e-02f, 2.371373773e-02f, 1.778279431e-02f, 1.333521493e-02f, 9.999999776e-03f, 7.498941850e-03f, 5.623413250e-03f, 4.216964822e-03f, 3.162277630e-03f, 2.371373586e-03f, 1.778279431e-03f, 1.333521446e-03f, 1.000000047e-03f, 7.498942432e-04f, 5.623413017e-04f, 4.216965172e-04f, 3.162277571e-04f, 2.371373703e-04f, 1.778279402e-04f, 1.333521504e-04f};
__device__ const float ALIBI_SLOPE[6] = {0.3968502629920499f, 0.15749013123685915f, 0.0625f, 0.024803141437003122f, 0.0098431332023036951f, 0.00390625f};
__device__ const float LAM_INIT[4] = {0.20000000000000007f, 0.35550906759096934f, 0.4707130183435842f, 0.5560582041556406f};

struct Args { const void* in[N_IN]; float* out; unsigned char* ws; int ph; int l; };

__device__ __forceinline__ unsigned f2bf(float f) { unsigned u = __builtin_bit_cast(unsigned, f); return (u + 0x7fffu + ((u >> 16) & 1u)) >> 16; }
__device__ __forceinline__ unsigned pk2(float lo, float hi) { return f2bf(lo) | (f2bf(hi) << 16); }
__device__ __forceinline__ float bf2f(unsigned short h) { return __builtin_bit_cast(float, (unsigned)h << 16); }
template <int CTRL> __device__ __forceinline__ float dpp_mov(float v) { return __builtin_bit_cast(float, __builtin_amdgcn_update_dpp(0, __builtin_bit_cast(int, v), CTRL, 0xF, 0xF, true)); }
__device__ __forceinline__ float sum16(float v) { v += dpp_mov<0xB1>(v); v += dpp_mov<0x4E>(v); v += dpp_mov<0x141>(v); v += dpp_mov<0x140>(v); return v; }
__device__ __forceinline__ float sum32(float v) { v = sum16(v); auto r = __builtin_amdgcn_permlane16_swap(__float_as_uint(v), __float_as_uint(v), false, false); return __uint_as_float(r[0]) + __uint_as_float(r[1]); }
__device__ __forceinline__ float wave_sum(float v) { v = sum32(v); auto r = __builtin_amdgcn_permlane32_swap(__float_as_uint(v), __float_as_uint(v), false, false); return __uint_as_float(r[0]) + __uint_as_float(r[1]); }
__device__ __forceinline__ float wave_max(float v) { v = fmaxf(v, dpp_mov<0xB1>(v)); v = fmaxf(v, dpp_mov<0x4E>(v)); v = fmaxf(v, dpp_mov<0x141>(v)); v = fmaxf(v, dpp_mov<0x140>(v));
    { auto r = __builtin_amdgcn_permlane16_swap(__float_as_uint(v), __float_as_uint(v), false, false); v = fmaxf(__uint_as_float(r[0]), __uint_as_float(r[1])); }
    { auto r = __builtin_amdgcn_permlane32_swap(__float_as_uint(v), __float_as_uint(v), false, false); v = fmaxf(__uint_as_float(r[0]), __uint_as_float(r[1])); } return v; }
__device__ __forceinline__ float xor32(float v, int lane) { auto r = __builtin_amdgcn_permlane32_swap(__float_as_uint(v), __float_as_uint(v), false, false); return lane < 32 ? __uint_as_float(r[1]) : __uint_as_float(r[0]); }
__device__ __forceinline__ float gelu_tanh(float x) {
    const float u = 0.7978845608028654f * (x + 0.044715f * x * x * x);
    const float e = __expf(2.0f * u);
    const float th = 1.0f - 2.0f / (e + 1.0f);
    return 0.5f * x * (1.0f + th);
}
__device__ __forceinline__ float silu_f(float x) { return x / (1.0f + __expf(-x)); }
__device__ __forceinline__ int crow(int r, int hi) { return (r & 3) + 8 * (r >> 2) + 4 * hi; }

namespace pg8 {
struct EpiF32 {
    static constexpr bool PERM = false, AFTER_DRAIN = false;
    float* C; int ldc;
    __device__ __forceinline__ void operator()(const f32x4 (&acc)[2][2][4][2], const Unit& u, int wr, int wc, int fr, int fq) const {
        const int row0 = u.pm * BM + wr * 64 + fr, col0 = u.pn * BM + wc * 32 + 4 * fq;
#pragma unroll
        for (int ai = 0; ai < 2; ++ai)
#pragma unroll
            for (int m = 0; m < 4; ++m) { float* rowp = C + (size_t)(row0 + ai * HALF + m * 16) * ldc + col0;
#pragma unroll
                for (int bj = 0; bj < 2; ++bj)
#pragma unroll
                    for (int n = 0; n < 2; ++n) *(f32x4*)(rowp + bj * HALF + n * 16) = acc[ai][bj][m][n]; }
    }
};
struct EpiNull {
    static constexpr bool PERM = true, AFTER_DRAIN = false;
    float* C;
    __device__ __forceinline__ void operator()(const f32x4 (&acc)[2][2][4][2], const Unit& u, int wr, int wc, int fr, int fq) const {
        f32x4 s = {0.f, 0.f, 0.f, 0.f};
#pragma unroll
        for (int ai = 0; ai < 2; ++ai)
#pragma unroll
            for (int bj = 0; bj < 2; ++bj)
#pragma unroll
                for (int m = 0; m < 4; ++m)
#pragma unroll
                    for (int n = 0; n < 2; ++n) s += acc[ai][bj][m][n];
        C[(size_t)(u.pm * 44 + u.pn) * 512 + (wr * 4 + wc) * 64 + fq * 16 + fr] = (s[0] + s[1]) + (s[2] + s[3]);
    }
};
struct EpiResid {
    static constexpr bool PERM = false, AFTER_DRAIN = false;
    const float* xin; float* out; int ldc; const float* gate; int gate_stride;
    __device__ __forceinline__ void operator()(const f32x4 (&acc)[2][2][4][2], const Unit& u, int wr, int wc, int fr, int fq) const {
        const int row0 = u.pm * BM + wr * 64 + fr, col0 = u.pn * BM + wc * 32 + 4 * fq;
        const float* gp = gate + (size_t)((u.pm * BM) / SEQ) * gate_stride + col0;
        f32x4 gv[2][2];
#pragma unroll
        for (int bj = 0; bj < 2; ++bj)
#pragma unroll
            for (int n = 0; n < 2; ++n) gv[bj][n] = *(const f32x4*)(gp + bj * HALF + n * 16);
#pragma unroll
        for (int ai = 0; ai < 2; ++ai) {
            f32x4 xv[4][2][2];
#pragma unroll
            for (int m = 0; m < 4; ++m) { const size_t off = (size_t)(row0 + ai * HALF + m * 16) * ldc + col0;
#pragma unroll
                for (int bj = 0; bj < 2; ++bj)
#pragma unroll
                    for (int n = 0; n < 2; ++n) xv[m][bj][n] = *(const f32x4*)(xin + off + bj * HALF + n * 16); }
#pragma unroll
            for (int m = 0; m < 4; ++m) { const size_t off = (size_t)(row0 + ai * HALF + m * 16) * ldc + col0;
#pragma unroll
                for (int bj = 0; bj < 2; ++bj)
#pragma unroll
                    for (int n = 0; n < 2; ++n) *(f32x4*)(out + off + bj * HALF + n * 16) = xv[m][bj][n] + gv[bj][n] * acc[ai][bj][m][n]; }
        }
    }
};
struct EpiResidP {
    static constexpr bool PERM = true, AFTER_DRAIN = false;
    const void* xin; void* out; int inb, outb; const float* gate; int gate_stride;
    __device__ __forceinline__ void put(unsigned eo, const f32x4 r0, const f32x4 r1) const {
        if (outb) *(u32x4*)((char*)out + eo * 2u) = (u32x4){pkh2(r0[0], r0[1]), pkh2(r0[2], r0[3]), pkh2(r1[0], r1[1]), pkh2(r1[2], r1[3])};
        else { *(f32x4*)((char*)out + eo * 4u) = r0; *(f32x4*)((char*)out + eo * 4u + 16u) = r1; } }
    __device__ __forceinline__ void operator()(const f32x4 (&acc)[2][2][4][2], const Unit& u, int wr, int wc, int fr_, int fq_) const {
        int fr = fr_, fq = fq_; asm volatile("" : "+v"(fr), "+v"(fq));
        const int row0 = u.pm * BM + wr * 64 + fr, col0 = u.pn * BM + wc * 32 + 8 * fq;
        const unsigned lo = (unsigned)(row0 * 2048 + col0);
        const float* gp = gate + (size_t)((u.pm * BM) / SEQ) * gate_stride + col0;
        f32x4 gv[2][2];
#pragma unroll
        for (int bj = 0; bj < 2; ++bj)
#pragma unroll
            for (int n = 0; n < 2; ++n) gv[bj][n] = *(const f32x4*)(gp + bj * HALF + 4 * n);
        if (inb) {
            u32x4 xb[2][4][2];
#pragma unroll
            for (int ai = 0; ai < 2; ++ai)
#pragma unroll
                for (int m = 0; m < 4; ++m)
#pragma unroll
                    for (int bj = 0; bj < 2; ++bj) xb[ai][m][bj] = *(const u32x4*)((const char*)xin + (lo + (unsigned)((ai * HALF + m * 16) * 2048 + bj * HALF)) * 2u);
#pragma unroll
            for (int ai = 0; ai < 2; ++ai)
#pragma unroll
                for (int m = 0; m < 4; ++m)
#pragma unroll
                    for (int bj = 0; bj < 2; ++bj) { const u32x4 w = xb[ai][m][bj];
                        const f32x4 x0 = {uph_lo(w.x), uph_hi(w.x), uph_lo(w.y), uph_hi(w.y)};
                        const f32x4 x1 = {uph_lo(w.z), uph_hi(w.z), uph_lo(w.w), uph_hi(w.w)};
                        put(lo + (unsigned)((ai * HALF + m * 16) * 2048 + bj * HALF), x0 + gv[bj][0] * acc[ai][bj][m][0], x1 + gv[bj][1] * acc[ai][bj][m][1]); }
        } else {
#pragma unroll
            for (int ai = 0; ai < 2; ++ai) {
                f32x4 xv[4][2][2];
#pragma unroll
                for (int m = 0; m < 4; ++m)
#pragma unroll
                    for (int bj = 0; bj < 2; ++bj)
#pragma unroll
                        for (int n = 0; n < 2; ++n) xv[m][bj][n] = *(const f32x4*)((const char*)xin + (lo + (unsigned)((ai * HALF + m * 16) * 2048 + bj * HALF + 4 * n)) * 4u);
#pragma unroll
                for (int m = 0; m < 4; ++m)
#pragma unroll
                    for (int bj = 0; bj < 2; ++bj) put(lo + (unsigned)((ai * HALF + m * 16) * 2048 + bj * HALF), xv[m][bj][0] + gv[bj][0] * acc[ai][bj][m][0], xv[m][bj][1] + gv[bj][1] * acc[ai][bj][m][1]);
            }
        }
    }
};
struct EpiBf16S {
    static constexpr bool PERM = true, AFTER_DRAIN = false;
    bf16_t* O; int ldc;
    __device__ __forceinline__ void operator()(const f32x4 (&acc)[2][2][4][2], const Unit& u, int wr, int wc, int fr, int fq) const {
        const int row0 = u.pm * BM + wr * 64 + fr, col0 = u.pn * BM + wc * 32 + 8 * fq;
#pragma unroll
        for (int ai = 0; ai < 2; ++ai)
#pragma unroll
            for (int m = 0; m < 4; ++m) { bf16_t* rowp = O + (size_t)(row0 + ai * HALF + m * 16) * ldc + col0;
#pragma unroll
                for (int bj = 0; bj < 2; ++bj) { const f32x4 v0 = acc[ai][bj][m][0], v1 = acc[ai][bj][m][1]; u32x4 w;
                    w.x = cvt_pk_bf16(v0[0], v0[1]); w.y = cvt_pk_bf16(v0[2], v0[3]); w.z = cvt_pk_bf16(v1[0], v1[1]); w.w = cvt_pk_bf16(v1[2], v1[3]);
                    *(u32x4*)(rowp + bj * HALF) = w; } }
    }
};
template <int CTRL> __device__ __forceinline__ float dppf(float old, float src) { return __builtin_bit_cast(float, __builtin_amdgcn_update_dpp(__builtin_bit_cast(int, old), __builtin_bit_cast(int, src), CTRL, 0xF, 0xF, false)); }
struct EpiConvGate {
    static constexpr bool PERM = true, AFTER_DRAIN = false;
    bf16_t* U; unsigned short* EDGE; const float* cw; const float* cb;
    __device__ __forceinline__ void operator()(const f32x4 (&acc)[2][2][4][2], const Unit& u, int wr, int wc, int fr, int fq) const {
        const int ch0 = u.pn * 128 + wc * 32 + 8 * fq, rowb = u.pm * BM + wr * 64;
#pragma unroll
        for (int ai = 0; ai < 2; ++ai) { const int blk = (rowb + ai * HALF) >> 6;
            if (fr < 2) { unsigned short* e = EDGE + ((size_t)(blk * 4 + fr) * 2) * DFF + ch0;
#pragma unroll
                for (int bj = 0; bj < 2; ++bj) { const f32x4 a0 = acc[ai][bj][0][0], a1 = acc[ai][bj][0][1]; *(u32x4*)(e + bj * DFF) = (u32x4){pkh2(a0[0], a0[1]), pkh2(a0[2], a0[3]), pkh2(a1[0], a1[1]), pkh2(a1[2], a1[3])}; } }
            if (fr >= 14) { unsigned short* e = EDGE + ((size_t)(blk * 4 + fr - 12) * 2) * DFF + ch0;
#pragma unroll
                for (int bj = 0; bj < 2; ++bj) { const f32x4 a0 = acc[ai][bj][3][0], a1 = acc[ai][bj][3][1]; *(u32x4*)(e + bj * DFF) = (u32x4){pkh2(a0[0], a0[1]), pkh2(a0[2], a0[3]), pkh2(a1[0], a1[1]), pkh2(a1[2], a1[3])}; } }
        }
        f32x4 w[2][2][3], bb[2][2];
#pragma unroll
        for (int n = 0; n < 2; ++n)
#pragma unroll
            for (int bj = 0; bj < 2; ++bj) { bb[n][bj] = *(const f32x4*)(cb + bj * DFF + ch0 + 4 * n);
#pragma unroll
                for (int j = 0; j < 3; ++j) w[n][bj][j] = *(const f32x4*)(cw + (size_t)j * (2 * DFF) + bj * DFF + ch0 + 4 * n); }
#pragma unroll
        for (int ai = 0; ai < 2; ++ai)
#pragma unroll
            for (int m = 0; m < 4; ++m) {
                unsigned pkw[4];
#pragma unroll
                for (int n = 0; n < 2; ++n) {
                    f32x4 y[2];
#pragma unroll
                    for (int bj = 0; bj < 2; ++bj) { const f32x4 cur = acc[ai][bj][m][n]; const f32x4 prv = m > 0 ? acc[ai][bj][m - 1][n] : (f32x4){0.f, 0.f, 0.f, 0.f};
                        f32x4 s1, s2;
#pragma unroll
                        for (int e = 0; e < 4; ++e) {
                            if (m > 0) { s1[e] = dppf<0x111>(dpp_mov<0x121>(prv[e]), cur[e]); s2[e] = dppf<0x112>(dpp_mov<0x122>(prv[e]), cur[e]); }
                            else { s1[e] = dpp_mov<0x111>(cur[e]); s2[e] = dpp_mov<0x112>(cur[e]); } }
                        y[bj] = bb[n][bj] + w[n][bj][2] * cur + w[n][bj][1] * s1 + w[n][bj][0] * s2; }
                    const f32x4 tg = y[0] * -1.4426950408889634f;
                    f32x4 ev; ev[0] = __builtin_amdgcn_exp2f(tg[0]); ev[1] = __builtin_amdgcn_exp2f(tg[1]); ev[2] = __builtin_amdgcn_exp2f(tg[2]); ev[3] = __builtin_amdgcn_exp2f(tg[3]);
                    const f32x4 dn = ev + 1.0f;
                    f32x4 rc; rc[0] = __builtin_amdgcn_rcpf(dn[0]); rc[1] = __builtin_amdgcn_rcpf(dn[1]); rc[2] = __builtin_amdgcn_rcpf(dn[2]); rc[3] = __builtin_amdgcn_rcpf(dn[3]);
                    const f32x4 o = (y[0] * rc) * y[1];
                    pkw[2 * n] = cvt_pk_bf16(o[0], o[1]); pkw[2 * n + 1] = cvt_pk_bf16(o[2], o[3]);
                }
                u32x4 pk; pk.x = pkw[0]; pk.y = pkw[1]; pk.z = pkw[2]; pk.w = pkw[3];
                *(u32x4*)(U + (size_t)(rowb + ai * HALF + m * 16 + fr) * DFF + ch0) = pk;
            }
    }
};
__device__ __forceinline__ float lane_xor16_sum(float v) { auto r = __builtin_amdgcn_permlane16_swap(__float_as_uint(v), __float_as_uint(v), false, false); return __uint_as_float(r[0]) + __uint_as_float(r[1]); }
__device__ __forceinline__ float lane_xor32_sum(float v) { auto r = __builtin_amdgcn_permlane32_swap(__float_as_uint(v), __float_as_uint(v), false, false); return __uint_as_float(r[0]) + __uint_as_float(r[1]); }
__device__ __forceinline__ float sq4(f32x4 v) { return (v[0] * v[0] + v[1] * v[1]) + (v[2] * v[2] + v[3] * v[3]); }
__device__ __forceinline__ u32x4 pk8(f32x4 a, f32x4 b) { u32x4 w; w.x = cvt_pk_bf16(a[0], a[1]); w.y = cvt_pk_bf16(a[2], a[3]); w.z = cvt_pk_bf16(b[0], b[1]); w.w = cvt_pk_bf16(b[2], b[3]); return w; }
__device__ __forceinline__ float gelu_t(float x) { const float u = 0.7978845608028654f * (x + 0.044715f * x * x * x); const float e = __expf(2.0f * u); return 0.5f * x * (2.0f - 2.0f * __builtin_amdgcn_rcpf(e + 1.0f)); }
__device__ __forceinline__ f32x4 gelu4(f32x4 v) { return (f32x4){gelu_t(v[0]), gelu_t(v[1]), gelu_t(v[2]), gelu_t(v[3])}; }
struct EpiInProj {
    static constexpr bool PERM = true, AFTER_DRAIN = false;
    bf16_t *QD, *KD, *VD, *QA, *KVA, *GV; unsigned short* UU; float *KR, *SSQ_QA, *SSQ_KVA, *SSQ_SGV, *SSQ_KR;
    const float *qg, *kg, *qag, *kvag, *sgvg;
    __device__ __forceinline__ void operator()(const f32x4 (&acc)[2][2][4][2], const Unit& u, int wr, int wc, int fr, int fq) const {
        const int pn = u.pn, rowb = u.pm * BM + wr * 64 + fr, b = (u.pm * BM) / SEQ, c8 = wc * 32 + 8 * fq;
        if (pn < 6) {
            const bool isk = pn >= 3; const int G = 4 * (isk ? pn - 3 : pn) + wc;
            const float* gp = isk ? kg : qg;
            const f32x4 g00 = *(const f32x4*)(gp + 8 * fq), g01 = *(const f32x4*)(gp + 8 * fq + 4), g10 = *(const f32x4*)(gp + 32 + 8 * fq), g11 = *(const f32x4*)(gp + 32 + 8 * fq + 4);
            bf16_t* dst = (isk ? KD : QD) + ((size_t)(b * 12 + G) * SEQ) * 64 + 8 * fq;
            const float post = isk ? 1.0f : QS_DA;
#pragma unroll
            for (int ai = 0; ai < 2; ++ai)
#pragma unroll
                for (int m = 0; m < 4; ++m) { const f32x4 v00 = acc[ai][0][m][0], v01 = acc[ai][0][m][1], v10 = acc[ai][1][m][0], v11 = acc[ai][1][m][1];
                    float ss = (sq4(v00) + sq4(v01)) + (sq4(v10) + sq4(v11)); ss = lane_xor16_sum(ss); ss = lane_xor32_sum(ss);
                    const float r = rsqrtf(ss * (1.f / 64) + EPS) * post;
                    bf16_t* d = dst + (size_t)((rowb + ai * HALF + m * 16) & (SEQ - 1)) * 64;
                    *(u32x4*)d = pk8(v00 * g00 * r, v01 * g01 * r); *(u32x4*)(d + 32) = pk8(v10 * g10 * r, v11 * g11 * r); }
        } else if (pn < 9) {
#pragma unroll
            for (int bj = 0; bj < 2; ++bj) { bf16_t* dst = VD + ((size_t)(b * NH + 2 * (pn - 6) + bj) * SEQ) * 128 + c8;
#pragma unroll
                for (int ai = 0; ai < 2; ++ai)
#pragma unroll
                    for (int m = 0; m < 4; ++m) *(u32x4*)(dst + (size_t)((rowb + ai * HALF + m * 16) & (SEQ - 1)) * 128) = pk8(acc[ai][bj][m][0], acc[ai][bj][m][1]); }
        } else if (pn < 12) {
            const bool iskv = pn == 11; const int ct = iskv ? 0 : 256 * (pn - 9);
            const float* gp = (iskv ? kvag : qag) + ct + c8;
            const f32x4 g00 = *(const f32x4*)gp, g01 = *(const f32x4*)(gp + 4), g10 = *(const f32x4*)(gp + HALF), g11 = *(const f32x4*)(gp + HALF + 4);
            bf16_t* dst = (iskv ? KVA : QA) + ct + c8; const int ld = iskv ? KVRANK : QRANK;
            float* sq = iskv ? SSQ_KVA + wc : SSQ_QA + (pn - 9) * 4 + wc; const int sld = iskv ? 4 : 8;
#pragma unroll
            for (int ai = 0; ai < 2; ++ai)
#pragma unroll
                for (int m = 0; m < 4; ++m) { const int row = rowb + ai * HALF + m * 16;
                    const f32x4 v00 = acc[ai][0][m][0], v01 = acc[ai][0][m][1], v10 = acc[ai][1][m][0], v11 = acc[ai][1][m][1];
                    float ss = (sq4(v00) + sq4(v01)) + (sq4(v10) + sq4(v11)); ss = lane_xor16_sum(ss); ss = lane_xor32_sum(ss);
                    if (fq == 0) sq[(size_t)row * sld] = ss;
                    *(u32x4*)(dst + (size_t)row * ld) = pk8(v00 * g00, v01 * g01); *(u32x4*)(dst + (size_t)row * ld + HALF) = pk8(v10 * g10, v11 * g11); }
        } else if (pn < 14) {
            unsigned short* dst = UU + 256 * (pn - 12) + c8;
#pragma unroll
            for (int ai = 0; ai < 2; ++ai)
#pragma unroll
                for (int m = 0; m < 4; ++m) { unsigned short* d = dst + (size_t)(rowb + ai * HALF + m * 16) * 512;
#pragma unroll
                    for (int bj = 0; bj < 2; ++bj) { const f32x4 a = gelu4(acc[ai][bj][m][0]), c = gelu4(acc[ai][bj][m][1]);
                        *(u32x4*)(d + bj * HALF) = (u32x4){pkh2(a[0], a[1]), pkh2(a[2], a[3]), pkh2(c[0], c[1]), pkh2(c[2], c[3])}; } }
        } else if (pn < 16) {
            const int g0 = 2 * (pn - 14);
#pragma unroll
            for (int bj = 0; bj < 2; ++bj) { const float* gp = sgvg + (g0 + bj) * 128 + c8; const f32x4 ga = *(const f32x4*)gp, gb = *(const f32x4*)(gp + 4);
                bf16_t* dst = GV + (g0 + bj) * 128 + c8; float* sq = SSQ_SGV + (g0 + bj) * 4 + wc;
#pragma unroll
                for (int ai = 0; ai < 2; ++ai)
#pragma unroll
                    for (int m = 0; m < 4; ++m) { const int row = rowb + ai * HALF + m * 16; const f32x4 a = gelu4(acc[ai][bj][m][0]), c = gelu4(acc[ai][bj][m][1]);
                        float ss = sq4(a) + sq4(c); ss = lane_xor16_sum(ss); ss = lane_xor32_sum(ss);
                        if (fq == 0) sq[(size_t)row * 16] = ss;
                        *(u32x4*)(dst + (size_t)row * 512) = pk8(a * ga, c * gb); } }
        } else {
            if (wc < 2) {
#pragma unroll
                for (int ai = 0; ai < 2; ++ai)
#pragma unroll
                    for (int m = 0; m < 4; ++m) { const int row = rowb + ai * HALF + m * 16; float* d = KR + (size_t)row * 64 + c8; *(f32x4*)d = acc[ai][0][m][0]; *(f32x4*)(d + 4) = acc[ai][0][m][1];
                        float ss = sq4(acc[ai][0][m][0]) + sq4(acc[ai][0][m][1]); ss = lane_xor16_sum(ss); ss = lane_xor32_sum(ss); if (fq == 0) SSQ_KR[(size_t)row * 2 + wc] = ss; } }
        }
    }
};
struct EpiMlaQ {
    static constexpr bool PERM = true, AFTER_DRAIN = false;
    bf16_t* QM; const float *SSQ_QA, *COS, *SIN, *qg; PG8_LAS float* X;
    __device__ __forceinline__ void operator()(const f32x4 (&acc)[2][2][4][2], const Unit& u, int wr, int wc, int fr_, int fq_) const {
        float eps_ = EPS, k192 = 1.f / 192; asm volatile("" : "+s"(eps_), "+s"(k192));
        int fr = fr_, fq = fq_; asm volatile("" : "+v"(fr), "+v"(fq));
        const int h = u.pn, rowb = u.pm * BM + wr * 64 + fr, b = (u.pm * BM) / SEQ, c8 = wc * 32 + 8 * fq, rt = wr * 64 + fr;
#pragma unroll
        for (int ai = 0; ai < 2; ++ai)
#pragma unroll
            for (int m = 0; m < 4; ++m) { float ss = (sq4(acc[ai][0][m][0]) + sq4(acc[ai][0][m][1])) + (sq4(acc[ai][1][m][0]) + sq4(acc[ai][1][m][1])); ss = lane_xor16_sum(ss); ss = lane_xor32_sum(ss);
                if (fq == 0) X[(ai * HALF + m * 16 + rt) * 4 + wc] = ss; }
        asm volatile("s_waitcnt lgkmcnt(0)" ::: "memory"); __builtin_amdgcn_s_barrier(); asm volatile("" ::: "memory");
        const f32x4 g0a = *(const f32x4*)(qg + c8), g0b = *(const f32x4*)(qg + c8 + 4);
        const int i0 = 16 * wc + 4 * fq;
        f32x4 g1 = {0.f, 0.f, 0.f, 0.f}, g2 = g1; if (wc < 2) { g1 = *(const f32x4*)(qg + 128 + i0); g2 = *(const f32x4*)(qg + 160 + i0); }
        bf16_t* dst = QM + ((size_t)(b * NH + h) * SEQ) * 192;
#pragma unroll
        for (int ai = 0; ai < 2; ++ai)
#pragma unroll
        for (int mh = 0; mh < 4; mh += 2) {
        float rr[2][4]; f32x4 csv[2][4], snv[2][4];
#pragma unroll
            for (int m = mh; m < mh + 2; ++m) { const int row = rowb + ai * HALF + m * 16; const f32x4 xs = *(const PG8_LAS f32x4*)(X + (ai * HALF + m * 16 + rt) * 4);
                const f32x4 pa = *(const f32x4*)(SSQ_QA + (size_t)row * 8), pb = *(const f32x4*)(SSQ_QA + (size_t)row * 8 + 4);
                const float msq = (((pa[0] + pa[1]) + (pa[2] + pa[3])) + ((pb[0] + pb[1]) + (pb[2] + pb[3]))) * (1.f / 512) + eps_;
                rr[ai][m] = rsqrtf(((xs[0] + xs[1]) + (xs[2] + xs[3])) * k192 + eps_ * msq) * QS_MLA;
                if (wc < 2) { csv[ai][m] = *(const f32x4*)(COS + (size_t)row * 32 + i0); snv[ai][m] = *(const f32x4*)(SIN + (size_t)row * 32 + i0); } }
#pragma unroll
            for (int m = mh; m < mh + 2; ++m) { const int row = rowb + ai * HALF + m * 16; const float r = rr[ai][m];
                bf16_t* d = dst + (size_t)(row & (SEQ - 1)) * 192;
                *(u32x4*)(d + c8) = pk8(acc[ai][0][m][0] * g0a * r, acc[ai][0][m][1] * g0b * r);
                if (wc < 2) { const f32x4 cs = csv[ai][m], sn = snv[ai][m];
                    const f32x4 va = acc[ai][1][m][0], vb = acc[ai][1][m][1];
                    const f32x4 y1 = (f32x4){va[0], va[2], vb[0], vb[2]} * g1 * r, y2 = (f32x4){va[1], va[3], vb[1], vb[3]} * g2 * r;
                    const f32x4 o1 = y1 * cs - y2 * sn, o2 = y2 * cs + y1 * sn;
                    *(u32x4*)(d + 128 + c8) = pk8((f32x4){o1[0], o2[0], o1[1], o2[1]}, (f32x4){o1[2], o2[2], o1[3], o2[3]}); } }
        }
        asm volatile("s_waitcnt lgkmcnt(0)" ::: "memory"); __builtin_amdgcn_s_barrier(); asm volatile("" ::: "memory");
    }
};
struct EpiMlaKV {
    static constexpr bool PERM = true, AFTER_DRAIN = false;
    bf16_t *KM, *VM; const float *SSQ_KVA, *SSQ_KR, *KR, *COS, *SIN, *kg; PG8_LAS float* X;
    __device__ __forceinline__ void operator()(const f32x4 (&acc)[2][2][4][2], const Unit& u, int wr, int wc, int fr_, int fq_) const {
        float eps_ = EPS, k192 = 1.f / 192; asm volatile("" : "+s"(eps_), "+s"(k192));
        int fr = fr_, fq = fq_; asm volatile("" : "+v"(fr), "+v"(fq));
        const int h = u.pn, rowb = u.pm * BM + wr * 64 + fr, b = (u.pm * BM) / SEQ, c8 = wc * 32 + 8 * fq, rt = wr * 64 + fr;
#pragma unroll
        for (int ai = 0; ai < 2; ++ai)
#pragma unroll
            for (int m = 0; m < 4; ++m) { float ss = sq4(acc[ai][0][m][0]) + sq4(acc[ai][0][m][1]); ss = lane_xor16_sum(ss); ss = lane_xor32_sum(ss);
                if (fq == 0) X[(ai * HALF + m * 16 + rt) * 4 + wc] = ss; }
        asm volatile("s_waitcnt lgkmcnt(0)" ::: "memory"); __builtin_amdgcn_s_barrier(); asm volatile("" ::: "memory");
        const f32x4 g0a = *(const f32x4*)(kg + c8), g0b = *(const f32x4*)(kg + c8 + 4);
        const int i0 = 8 * wc + 2 * fq;
        const float g1a = kg[128 + i0], g1b = kg[128 + i0 + 1], g2a = kg[160 + i0], g2b = kg[160 + i0 + 1];
        bf16_t* kd = KM + ((size_t)(b * NH + h) * SEQ) * 192; bf16_t* vd = VM + ((size_t)(b * NH + h) * SEQ) * 128;
#pragma unroll
        for (int ai = 0; ai < 2; ++ai) {
        float rr[2][4], cv[2][4]; float2 k1v[2][4], k2v[2][4], cpv[2][4], spv[2][4];
#pragma unroll
            for (int m = 0; m < 4; ++m) { const int row = rowb + ai * HALF + m * 16; const f32x4 xs = *(const PG8_LAS f32x4*)(X + (ai * HALF + m * 16 + rt) * 4);
                const f32x4 pc = *(const f32x4*)(SSQ_KVA + (size_t)row * 4);
                const float c2 = 1.0f / (((pc[0] + pc[1]) + (pc[2] + pc[3])) * (1.f / 256) + eps_);
                const float2 sk = *(const float2*)(SSQ_KR + (size_t)row * 2);
                cv[ai][m] = sqrtf(c2); rr[ai][m] = rsqrtf((c2 * ((xs[0] + xs[1]) + (xs[2] + xs[3])) + (sk.x + sk.y)) * k192 + eps_);
                const float* kr = KR + (size_t)row * 64 + i0;
                k1v[ai][m] = *(const float2*)kr; k2v[ai][m] = *(const float2*)(kr + 32); cpv[ai][m] = *(const float2*)(COS + (size_t)row * 32 + i0); spv[ai][m] = *(const float2*)(SIN + (size_t)row * 32 + i0); }
#pragma unroll
            for (int m = 0; m < 4; ++m) { const int row = rowb + ai * HALF + m * 16; const float r = rr[ai][m], ckv = cv[ai][m];
                const int srow = row & (SEQ - 1);
                *(u32x4*)(kd + (size_t)srow * 192 + c8) = pk8(acc[ai][0][m][0] * g0a * (ckv * r), acc[ai][0][m][1] * g0b * (ckv * r));
                *(u32x4*)(vd + (size_t)srow * 128 + c8) = pk8(acc[ai][1][m][0] * ckv, acc[ai][1][m][1] * ckv);
                const float2 cp = cpv[ai][m], sp = spv[ai][m];
                const float y1a = k1v[ai][m].x * r * g1a, y1b = k1v[ai][m].y * r * g1b, y2a = k2v[ai][m].x * r * g2a, y2b = k2v[ai][m].y * r * g2b;
                const float oa1 = y1a * cp.x - y2a * sp.x, oa2 = y2a * cp.x + y1a * sp.x, ob1 = y1b * cp.y - y2b * sp.y, ob2 = y2b * cp.y + y1b * sp.y;
                *(unsigned long long*)(kd + (size_t)srow * 192 + 128 + 2 * i0) = (unsigned long long)cvt_pk_bf16(oa1, oa2) | ((unsigned long long)cvt_pk_bf16(ob1, ob2) << 32); }
        }
        asm volatile("s_waitcnt lgkmcnt(0)" ::: "memory"); __builtin_amdgcn_s_barrier(); asm volatile("" ::: "memory");
    }
};
}

struct Frame {
    LAS unsigned char* lds;
    int tid, lane, wave, wave0, gw, ngw, bid, G;
    const __attribute__((address_space(4))) Args* ka; const int* pos;
    float* out; unsigned char* ws;
};
__device__ __forceinline__ size_t opq(size_t v) { asm volatile("" : "+s"(v)); return v; }
#define WSP(T, off) ((T*)(F.ws + opq(off)))
#define FIN(i) ((const float*)F.ka->in[i])
__device__ __forceinline__ const bf16* wptr(const Frame& F, int l, size_t off) { return (const bf16*)(F.ws + WS_W + (size_t)l * WL_STRIDE + off); }

__device__ __forceinline__ void p0_transpose_item(const float* W, int K, int N, bf16* WT, int row_off, LAS float* scr, int item, int lane, int rstride = 1) {
    const int nblk = N / 32, kb = item / nblk, nb = item % nblk, k0 = 64 * kb, n0 = 32 * nb;
    float wv_[32];
#pragma unroll
    for (int i = 0; i < 32; ++i) { const int kk = 2 * i + (lane >> 5); wv_[i] = W[(size_t)(k0 + kk) * N + n0 + (lane & 31)]; }
#pragma unroll
    for (int i = 0; i < 32; ++i) { const int kk = 2 * i + (lane >> 5); scr[kk * 33 + (lane & 31)] = wv_[i]; }
    LDS_WAIT(); asm volatile("" ::: "memory");
    const int c = lane & 7;
#pragma unroll
    for (int j = 0; j < 4; ++j) { const int n = (lane >> 3) + 8 * j; const LAS float* s = scr + (8 * c) * 33 + n;
        v4u o; o.x = pk2(s[0 * 33], s[1 * 33]); o.y = pk2(s[2 * 33], s[3 * 33]); o.z = pk2(s[4 * 33], s[5 * 33]); o.w = pk2(s[6 * 33], s[7 * 33]);
        *(v4u*)(WT + (size_t)(row_off + n0 + rstride * n) * K + k0 + 8 * c) = o; }
    LDS_WAIT(); asm volatile("" ::: "memory");
}
__device__ __forceinline__ void ph_prologue(Frame& F) {
    LAS float* scr = (LAS float*)(F.lds + F.wave * 16384);
    constexpr int I_IN = (D / 64) * (IN_COLS / 32), I_UQ = (QRANK / 64) * (UQ_N / 32), I_UKV = (KVRANK / 64) * (UKV_N / 32), I_OUT = (D / 64) * (D / 32), I_UP = (D / 64) * (NUP / 32), I_DN = (DFF / 64) * (D / 32);
    constexpr int I_L = I_IN + I_UQ + I_UKV + I_OUT + I_UP + I_DN;
    for (int it = F.gw; it < DEPTH * I_L; it += F.ngw) {
        const int l = it / I_L; int r = it % I_L;
        bf16* wl = (bf16*)(F.ws + WS_W + (size_t)l * WL_STRIDE);
        if (r < I_IN) { const int n0 = 32 * (r % (IN_COLS / 32)); int dst;
            if (n0 < C_DAV) { const int q = n0 % 768, G = q / 64, e = q % 64; dst = (n0 - q) + 256 * (G / 4) + 128 * (e / 32) + 32 * (G % 4) + (e % 32); }
            else if (n0 < C_KR) dst = n0;
            else if (n0 < C_SGU) dst = 4096 + (n0 - C_KR);
            else dst = n0 - 64;
            p0_transpose_item(FIN(I_WIN) + (size_t)l * D * IN_COLS, D, IN_COLS, (bf16*)((unsigned char*)wl + WL_IN), dst - n0, scr, r, F.lane); continue; } r -= I_IN;
        if (r < I_UQ) { const int n0 = 32 * (r % (UQ_N / 32)), hh = n0 / 192, e = n0 % 192;
            const int dst = 256 * hh + (e < 128 ? e : 128 + (e - 128) / 32);
            p0_transpose_item(FIN(I_WUQ) + (size_t)l * QRANK * UQ_N, QRANK, UQ_N, (bf16*)((unsigned char*)wl + WL_UQ), dst - n0, scr, r, F.lane, e < 128 ? 1 : 2); continue; } r -= I_UQ;
        if (r < I_UKV) { p0_transpose_item(FIN(I_WUKV) + (size_t)l * KVRANK * UKV_N, KVRANK, UKV_N, (bf16*)((unsigned char*)wl + WL_UKV), 0, scr, r, F.lane); continue; } r -= I_UKV;
        if (r < I_OUT) { p0_transpose_item(FIN(I_WOUT) + (size_t)l * D * D, D, D, (bf16*)((unsigned char*)wl + WL_OUT), 0, scr, r, F.lane); continue; } r -= I_OUT;
        if (r < I_UP) { const int n0 = 32 * (r % (NUP / 32)), chn = n0 % DFF, dst = 256 * (chn / 128) + 128 * (n0 / DFF) + (chn % 128);
            p0_transpose_item(FIN(I_WUP) + (size_t)l * D * NUP, D, NUP, (bf16*)((unsigned char*)wl + WL_UP), dst - n0, scr, r, F.lane); continue; } r -= I_UP;
        p0_transpose_item(FIN(I_WDOWN) + (size_t)l * DFF * D, DFF, D, (bf16*)((unsigned char*)wl + WL_DOWN), 0, scr, r, F.lane);
    }
    {
        const int gt = F.bid * NTHREADS + F.tid, nt = F.G * NTHREADS;
        constexpr int Z_IN = (IN_PAD - IN_COLS) * D / 8, Z_UQ = NH * 64 * QRANK / 8;
        for (int i = gt; i < DEPTH * (Z_IN + Z_UQ); i += nt) { const int l = i / (Z_IN + Z_UQ); int r = i % (Z_IN + Z_UQ);
            unsigned char* wl = F.ws + WS_W + (size_t)l * WL_STRIDE;
            v4u z = {0u, 0u, 0u, 0u};
            if (r < Z_IN) *(v4u*)(wl + WL_IN + (size_t)IN_COLS * D * 2 + (size_t)r * 16) = z;
            else { r -= Z_IN; const int hh = r / (64 * QRANK / 8), q = r % (64 * QRANK / 8); *(v4u*)(wl + WL_UQ + ((size_t)(256 * hh + 192) * QRANK) * 2 + (size_t)q * 16) = z; } }
    }
    __syncthreads();
    LAS float* cond = (LAS float*)F.lds;
    for (int i = F.tid; i < 2 * D; i += NTHREADS) cond[i] = silu_f(FIN(I_C)[i]);
    __syncthreads();
    {
        const int gt = F.bid * NTHREADS + F.tid, nt = F.G * NTHREADS;
        float* part = WSP(float, WS_MODP);
        for (int it = gt; it < DEPTH * 16 * 3072; it += nt) {
            const int n4 = it % 3072, ks = (it / 3072) % 16, l = it / (3072 * 16);
            const float* w = FIN(I_WADA) + ((size_t)l * D + ks * 128) * (6 * D) + n4 * 4;
            f32x4 a0 = {0.f, 0.f, 0.f, 0.f}, a1 = {0.f, 0.f, 0.f, 0.f};
#pragma unroll 8
            for (int k = 0; k < 128; ++k) { const f32x4 wv = *(const f32x4*)(w + (size_t)k * (6 * D)); a0 += cond[ks * 128 + k] * wv; a1 += cond[D + ks * 128 + k] * wv; }
            *(f32x4*)(part + ((size_t)(l * 16 + ks) * 2 + 0) * (6 * D) + n4 * 4) = a0;
            *(f32x4*)(part + ((size_t)(l * 16 + ks) * 2 + 1) * (6 * D) + n4 * 4) = a1;
        }
    }
    __syncthreads();
}
__device__ __forceinline__ void ph_modreduce(Frame& F) {
    const int gt = F.bid * NTHREADS + F.tid, nt = F.G * NTHREADS;
    const float* part = WSP(float, WS_MODP); float* mod = WSP(float, WS_MOD);
    for (int i = gt; i < DEPTH * 2 * 6 * D; i += nt) { const int n = i % (6 * D), b = (i / (6 * D)) & 1, l = i / (12 * D);
        float s = FIN(I_BADA)[l * 6 * D + n];
#pragma unroll
        for (int ks = 0; ks < 16; ++ks) s += part[((size_t)(l * 16 + ks) * 2 + b) * (6 * D) + n];
        mod[i] = s; }
    { float* ct = WSP(float, WS_COS); float* st = WSP(float, WS_SIN);
      for (int i = gt; i < M * 32; i += nt) { const float ang = (float)F.pos[i >> 5] * ROPE_INV[i & 31];
          const double rev = (double)ang * 0.15915494309189535; const float fr = (float)(rev - floor(rev));
          ct[i] = __builtin_amdgcn_cosf(fr); st[i] = __builtin_amdgcn_sinf(fr); } }
    if (gt < M / 64) { int mn = 0x7fffffff, mx = -0x7fffffff - 1;
        for (int i = 0; i < 64; ++i) { const int p = F.pos[gt * 64 + i]; mn = p < mn ? p : mn; mx = p > mx ? p : mx; }
        int* mm = WSP(int, WS_POSMM); mm[gt * 2] = mn; mm[gt * 2 + 1] = mx; }
}
template <bool XBF> __device__ __forceinline__ void ph_norm(Frame& F, int l, const void* xsrc, int sh_off, int sc_off) {
    const float* mod = WSP(float, WS_MOD) + (size_t)l * 12 * D; bf16* H = WSP(bf16, WS_H);
    for (int row = F.gw; row < M; row += F.ngw) {
        const int b = row >> 13;
        const float* mb = mod + (size_t)b * 6 * D;
        if constexpr (XBF) {
            const v4u* xr = (const v4u*)((const bf16*)xsrc + (size_t)row * D) + F.lane;
            v4u w[4]; float v[4][8]; float s = 0.f;
#pragma unroll
            for (int j = 0; j < 4; ++j) w[j] = xr[64 * j];
#pragma unroll
            for (int j = 0; j < 4; ++j) { const unsigned ww[4] = {w[j].x, w[j].y, w[j].z, w[j].w};
#pragma unroll
                for (int q = 0; q < 4; ++q) { v[j][2 * q] = pg8::uph_lo(ww[q]); v[j][2 * q + 1] = pg8::uph_hi(ww[q]); s += v[j][2 * q] * v[j][2 * q] + v[j][2 * q + 1] * v[j][2 * q + 1]; } }
            const float r = rsqrtf(wave_sum(s) * (1.f / D) + EPS);
            v4u* o16 = (v4u*)(H + (size_t)row * D) + F.lane;
#pragma unroll
            for (int j = 0; j < 4; ++j) { const int c = 8 * F.lane + 512 * j;
                const f32x4 sc0 = *(const f32x4*)(mb + sc_off + c), sc1 = *(const f32x4*)(mb + sc_off + c + 4), sh0 = *(const f32x4*)(mb + sh_off + c), sh1 = *(const f32x4*)(mb + sh_off + c + 4);
                v4u o; o.x = pk2(v[j][0] * r * (1.0f + sc0.x) + sh0.x, v[j][1] * r * (1.0f + sc0.y) + sh0.y); o.y = pk2(v[j][2] * r * (1.0f + sc0.z) + sh0.z, v[j][3] * r * (1.0f + sc0.w) + sh0.w);
                o.z = pk2(v[j][4] * r * (1.0f + sc1.x) + sh1.x, v[j][5] * r * (1.0f + sc1.y) + sh1.y); o.w = pk2(v[j][6] * r * (1.0f + sc1.z) + sh1.z, v[j][7] * r * (1.0f + sc1.w) + sh1.w);
                o16[64 * j] = o; }
        } else {
        const f32x4* xr = (const f32x4*)((const float*)xsrc + (size_t)row * D) + F.lane;
        f32x4 v[8]; float s = 0.f;
#pragma unroll
        for (int j = 0; j < 8; ++j) { v[j] = xr[64 * j]; s += (v[j].x * v[j].x + v[j].y * v[j].y) + (v[j].z * v[j].z + v[j].w * v[j].w); }
        const float r = rsqrtf(wave_sum(s) * (1.f / D) + EPS);
        unsigned long long* o8 = (unsigned long long*)(H + (size_t)row * D) + F.lane;
#pragma unroll
        for (int j = 0; j < 8; ++j) { const int c = 4 * F.lane + 256 * j;
            const f32x4 sc = *(const f32x4*)(mb + sc_off + c), sh = *(const f32x4*)(mb + sh_off + c);
            const f32x4 y = v[j] * r * (1.0f + sc) + sh;
            o8[64 * j] = (unsigned long long)pk2(y.x, y.y) | ((unsigned long long)pk2(y.z, y.w) << 32); }
        }
    }
}

namespace fa {
#ifndef PIPE_MLA
#define PIPE_MLA 1
#endif
#ifndef PIPE_LIN
#define PIPE_LIN 0
#endif
#ifndef PIPE_GEN
#define PIPE_GEN 0
#endif
#ifndef PIPE_OLD64
#define PIPE_OLD64 0
#endif
template <typename T> __device__ __forceinline__ T ldg(const void* base, unsigned off) { return *(const T*)((const char*)base + off); }
template <typename T> __device__ __forceinline__ void stg(void* base, unsigned off, T v) { *(T*)((char*)base + off) = v; }
constexpr int crowc(int r) { return (r & 3) + 8 * (r >> 2); }
using s16x4 = __attribute__((ext_vector_type(4))) short;
using f32x8 = __attribute__((ext_vector_type(8))) float;
constexpr int QBLK = 32, KVBLK = 64, DV = 128;
constexpr int SHM_V = KVBLK * DV * 2;
constexpr float THR = 11.5f;
#define FA_SBAR() __builtin_amdgcn_sched_barrier(0)
__device__ __forceinline__ unsigned cvtpk(float lo, float hi) { unsigned r; asm volatile("v_cvt_pk_bf16_f32 %0, %1, %2" : "=v"(r) : "v"(lo), "v"(hi)); return r; }
__device__ __forceinline__ int kswz(int row, int colB) { return (colB >> 7) * 8192 + row * 128 + ((colB & 127) ^ (((row >> 1) & 7) << 4)); }
__device__ __forceinline__ int v_st(int k, int c) { const int kk = (k & ~0xC) | ((k & 4) << 1) | ((k & 8) >> 1); return ((kk >> 3) * 4 + (c >> 5)) * 512 + ((kk & 7) * 32 + (c & 31)) * 2; }
__device__ __forceinline__ int v_st_nat(int k, int c) { return ((k >> 3) * 4 + (c >> 5)) * 512 + ((k & 7) * 32 + (c & 31)) * 2; }
__device__ __forceinline__ int v_rd_base(int lane) { return ((lane & 3) << 3) | (((lane >> 2) & 3) << 6) | (((lane >> 4) & 1) << 5) | (((lane >> 5) & 1) << 8); }
constexpr int v_rd_off(int d0, int ks, int half) { return d0 * 512 + ks * 4096 + half * 2048; }
template <int OFF> __device__ __forceinline__ s16x4 tr_read(int vb) { s16x4 r; asm volatile("ds_read_b64_tr_b16 %0, %1 offset:%2" : "=&v"(r) : "v"(vb), "i"(OFF) : "memory"); return r; }
template <int D0> __device__ __forceinline__ void pv_one(f32x16& od, int vb, bf16x8 pa0, bf16x8 pa1, bf16x8 pa2, bf16x8 pa3) {
    const s16x4 l0 = tr_read<v_rd_off(D0, 0, 0)>(vb), h0 = tr_read<v_rd_off(D0, 0, 1)>(vb), l1 = tr_read<v_rd_off(D0, 1, 0)>(vb), h1 = tr_read<v_rd_off(D0, 1, 1)>(vb);
    const s16x4 l2 = tr_read<v_rd_off(D0, 2, 0)>(vb), h2 = tr_read<v_rd_off(D0, 2, 1)>(vb), l3 = tr_read<v_rd_off(D0, 3, 0)>(vb), h3 = tr_read<v_rd_off(D0, 3, 1)>(vb);
    asm volatile("s_waitcnt lgkmcnt(0)" ::: "memory"); FA_SBAR();
#define FA_PK(L, H) (bf16x8){L[0], L[1], L[2], L[3], H[0], H[1], H[2], H[3]}
    od = __builtin_amdgcn_mfma_f32_32x32x16_bf16(pa0, FA_PK(l0, h0), od, 0, 0, 0);
    od = __builtin_amdgcn_mfma_f32_32x32x16_bf16(pa1, FA_PK(l1, h1), od, 0, 0, 0);
    od = __builtin_amdgcn_mfma_f32_32x32x16_bf16(pa2, FA_PK(l2, h2), od, 0, 0, 0);
    od = __builtin_amdgcn_mfma_f32_32x32x16_bf16(pa3, FA_PK(l3, h3), od, 0, 0, 0);
#undef FA_PK
}
__device__ __forceinline__ void pv_d0(f32x16* o, int vb, bf16x8 pa0, bf16x8 pa1, bf16x8 pa2, bf16x8 pa3) {
    pv_one<0>(o[0], vb, pa0, pa1, pa2, pa3); pv_one<1>(o[1], vb, pa0, pa1, pa2, pa3); pv_one<2>(o[2], vb, pa0, pa1, pa2, pa3); pv_one<3>(o[3], vb, pa0, pa1, pa2, pa3);
}
template <int D0> __device__ __forceinline__ void pv_reads(s16x4 (&l)[4], s16x4 (&h)[4], int vb) {
    l[0] = tr_read<v_rd_off(D0, 0, 0)>(vb); h[0] = tr_read<v_rd_off(D0, 0, 1)>(vb); l[1] = tr_read<v_rd_off(D0, 1, 0)>(vb); h[1] = tr_read<v_rd_off(D0, 1, 1)>(vb);
    l[2] = tr_read<v_rd_off(D0, 2, 0)>(vb); h[2] = tr_read<v_rd_off(D0, 2, 1)>(vb); l[3] = tr_read<v_rd_off(D0, 3, 0)>(vb); h[3] = tr_read<v_rd_off(D0, 3, 1)>(vb);
}
__device__ __forceinline__ void pv_mfma(f32x16& od, const s16x4 (&l)[4], const s16x4 (&h)[4], bf16x8 pa0, bf16x8 pa1, bf16x8 pa2, bf16x8 pa3) {
#define FA_PK(L, H) (bf16x8){L[0], L[1], L[2], L[3], H[0], H[1], H[2], H[3]}
    od = __builtin_amdgcn_mfma_f32_32x32x16_bf16(pa0, FA_PK(l[0], h[0]), od, 0, 0, 0);
    od = __builtin_amdgcn_mfma_f32_32x32x16_bf16(pa1, FA_PK(l[1], h[1]), od, 0, 0, 0);
    od = __builtin_amdgcn_mfma_f32_32x32x16_bf16(pa2, FA_PK(l[2], h[2]), od, 0, 0, 0);
    od = __builtin_amdgcn_mfma_f32_32x32x16_bf16(pa3, FA_PK(l[3], h[3]), od, 0, 0, 0);
#undef FA_PK
}
__device__ __forceinline__ void pv_d0_pipe(f32x16* o, int vb, bf16x8 pa0, bf16x8 pa1, bf16x8 pa2, bf16x8 pa3) {
    s16x4 la[4], ha[4], lb[4], hb[4];
    pv_reads<0>(la, ha, vb); pv_reads<1>(lb, hb, vb);
    asm volatile("s_waitcnt lgkmcnt(8)" ::: "memory"); FA_SBAR(); pv_mfma(o[0], la, ha, pa0, pa1, pa2, pa3); FA_SBAR();
    pv_reads<2>(la, ha, vb);
    asm volatile("s_waitcnt lgkmcnt(8)" ::: "memory"); FA_SBAR(); pv_mfma(o[1], lb, hb, pa0, pa1, pa2, pa3); FA_SBAR();
    pv_reads<3>(lb, hb, vb);
    asm volatile("s_waitcnt lgkmcnt(8)" ::: "memory"); FA_SBAR(); pv_mfma(o[2], la, ha, pa0, pa1, pa2, pa3); FA_SBAR();
    asm volatile("s_waitcnt lgkmcnt(0)" ::: "memory"); FA_SBAR(); pv_mfma(o[3], lb, hb, pa0, pa1, pa2, pa3);
}
__device__ __forceinline__ void partialSM(f32x16& p0, f32x16& p1, float& m_reg, float& alpha) {
    float pmax = p0[0];
#pragma unroll
    for (int r = 1; r < 16; ++r) pmax = fmaxf(pmax, p0[r]);
#pragma unroll
    for (int r = 0; r < 16; ++r) pmax = fmaxf(pmax, p1[r]);
    { auto rr = __builtin_amdgcn_permlane32_swap(__float_as_uint(pmax), __float_as_uint(pmax), false, false); pmax = fmaxf(__uint_as_float(rr[0]), __uint_as_float(rr[1])); }
    float mn;
    if (__builtin_expect(__all(pmax - m_reg <= THR), 1)) { mn = m_reg; alpha = 1.f; }
    else { mn = fmaxf(m_reg, pmax); alpha = __builtin_amdgcn_exp2f(m_reg - mn); m_reg = mn; }
#pragma unroll
    for (int r = 0; r < 16; ++r) { p0[r] -= mn; p1[r] -= mn; }
#pragma unroll
    for (int r = 0; r < 16; ++r) p0[r] = __builtin_amdgcn_exp2f(p0[r]);
}
__device__ __forceinline__ void finishSM(f32x16& p0, f32x16& p1, float alpha, float& l_reg, bf16x8& pa0, bf16x8& pa1, bf16x8& pa2, bf16x8& pa3) {
#pragma unroll
    for (int r = 0; r < 16; ++r) p1[r] = __builtin_amdgcn_exp2f(p1[r]);
    float ps = 0;
#pragma unroll
    for (int r = 0; r < 16; ++r) ps += p0[r];
#pragma unroll
    for (int r = 0; r < 16; ++r) ps += p1[r];
    { auto rr = __builtin_amdgcn_permlane32_swap(__float_as_uint(ps), __float_as_uint(ps), false, false); ps = __uint_as_float(rr[0]) + __uint_as_float(rr[1]); }
    l_reg = l_reg * alpha + ps;
#define FA_PK4(P, BASE, OUT) do { unsigned a0 = cvtpk(P[BASE + 0], P[BASE + 1]), a1 = cvtpk(P[BASE + 2], P[BASE + 3]);   \
    unsigned b0 = cvtpk(P[BASE + 4], P[BASE + 5]), b1 = cvtpk(P[BASE + 6], P[BASE + 7]);                              \
    auto r0 = __builtin_amdgcn_permlane32_swap(a0, b0, false, false); auto r1 = __builtin_amdgcn_permlane32_swap(a1, b1, false, false); \
    u32x4_t w = {r0[0], r1[0], r0[1], r1[1]}; OUT = __builtin_bit_cast(bf16x8, w); } while (0)
    typedef unsigned u32x4_t __attribute__((ext_vector_type(4)));
    FA_PK4(p0, 0, pa0); FA_PK4(p0, 8, pa1); FA_PK4(p1, 0, pa2); FA_PK4(p1, 8, pa3);
#undef FA_PK4
}
template <bool ALIBI> __device__ __forceinline__ void fr_init(f32x16& p0, f32x16& p1, const LAS float* posl, float posq, float slope2, bool linear, int hi) {
    if (linear) {
        const float cl = -slope2 * posq;
#pragma unroll
        for (int g = 0; g < 4; ++g) { const f32x4 k0 = *(const LAS f32x4*)(posl + 8 * g + 4 * hi), k1 = *(const LAS f32x4*)(posl + 32 + 8 * g + 4 * hi);
#pragma unroll
            for (int e = 0; e < 4; ++e) { p0[4 * g + e] = fmaf(slope2, k0[e], cl); p1[4 * g + e] = fmaf(slope2, k1[e], cl); } }
    } else {
#pragma unroll
        for (int g = 0; g < 4; ++g) { const f32x4 k0 = *(const LAS f32x4*)(posl + 8 * g + 4 * hi), k1 = *(const LAS f32x4*)(posl + 32 + 8 * g + 4 * hi);
#pragma unroll
            for (int e = 0; e < 4; ++e) { p0[4 * g + e] = -slope2 * fabsf(posq - k0[e]); p1[4 * g + e] = -slope2 * fabsf(posq - k1[e]); } }
    }
}
__device__ __forceinline__ void fr_softmax(f32x16& p0, f32x16& p1, float& l_reg, bf16x8& pa0, bf16x8& pa1, bf16x8& pa2, bf16x8& pa3) {
#pragma unroll
    for (int r = 0; r < 16; ++r) { p0[r] = __builtin_amdgcn_exp2f(p0[r]); p1[r] = __builtin_amdgcn_exp2f(p1[r]); }
    float sa = 0.f, sb = 0.f;
#pragma unroll
    for (int r = 0; r < 16; ++r) { sa += p0[r]; sb += p1[r]; }
    l_reg += sa + sb;
    typedef unsigned u32x4_t __attribute__((ext_vector_type(4)));
#define FA_PKS(P, BASE, OUT) do { u32x4_t w = {cvtpk(P[BASE + 0], P[BASE + 1]), cvtpk(P[BASE + 2], P[BASE + 3]), cvtpk(P[BASE + 4], P[BASE + 5]), cvtpk(P[BASE + 6], P[BASE + 7])}; OUT = __builtin_bit_cast(bf16x8, w); } while (0)
    FA_PKS(p0, 0, pa0); FA_PKS(p0, 8, pa1); FA_PKS(p1, 0, pa2); FA_PKS(p1, 8, pa3);
#undef FA_PKS
}
template <int DQK> struct Lds {
    static constexpr int SHM_K = KVBLK * DQK * 2;
    static constexpr int V_OFF = 0, K_OFF = 2 * SHM_V, POS_OFF = K_OFF + 2 * SHM_K, WS_OFF = POS_OFF + 2 * 256, END = WS_OFF + 8 * 256;
};
template <int DQK, bool INIT = true> __device__ __forceinline__ void qkt(f32x16& p0, f32x16& p1, const LAS unsigned char* Ks, const bf16x8* qr, int r32, int hi) {
    if (INIT) { p0 = f32x16{}; p1 = f32x16{}; }
#pragma unroll
    for (int d0 = 0; d0 < DQK / 16; ++d0) { const int cb = (d0 * 16 + hi * 8) * 2;
        const bf16x8 b0 = *(const LAS bf16x8*)(Ks + kswz(r32, cb));
        const bf16x8 b1 = *(const LAS bf16x8*)(Ks + kswz(32 + r32, cb));
        p0 = __builtin_amdgcn_mfma_f32_32x32x16_bf16(b0, qr[d0], p0, 0, 0, 0);
        p1 = __builtin_amdgcn_mfma_f32_32x32x16_bf16(b1, qr[d0], p1, 0, 0, 0);
        if (DQK > 64 && (d0 & 3) == 3) FA_SBAR(); }
}
template <int OFF> __device__ __forceinline__ bf16x8 k_read(int addr) { bf16x8 r; asm volatile("ds_read_b128 %0, %1 offset:%2" : "=&v"(r) : "v"(addr), "i"(OFF) : "memory"); return r; }
__device__ __forceinline__ void k_bases(int (&ka)[4], const LAS unsigned char* K_lds, int r32, int hi) {
#pragma unroll
    for (int j = 0; j < 4; ++j) ka[j] = (int)(uintptr_t)K_lds + r32 * 128 + ((j * 32 + hi * 16) ^ (((r32 >> 1) & 7) << 4));
}
#define FA_LGK(n) asm volatile("s_waitcnt lgkmcnt(" #n ")" ::: "memory")
template <int DQK, int BOFF, int VAR = 0> __device__ __forceinline__ void qkt_pipe(f32x16& p0, f32x16& p1, const int (&ka)[4], const bf16x8* qr) {
    if constexpr (DQK == 64) {
        bf16x8 a0 = k_read<BOFF>(ka[0]), b0 = k_read<BOFF + 4096>(ka[0]), a1 = k_read<BOFF>(ka[1]), b1 = k_read<BOFF + 4096>(ka[1]);
        bf16x8 a2 = k_read<BOFF>(ka[2]), b2 = k_read<BOFF + 4096>(ka[2]), a3 = k_read<BOFF>(ka[3]), b3 = k_read<BOFF + 4096>(ka[3]);
        FA_LGK(6); FA_SBAR(); p0 = __builtin_amdgcn_mfma_f32_32x32x16_bf16(a0, qr[0], p0, 0, 0, 0); p1 = __builtin_amdgcn_mfma_f32_32x32x16_bf16(b0, qr[0], p1, 0, 0, 0); FA_SBAR();
        FA_LGK(4); FA_SBAR(); p0 = __builtin_amdgcn_mfma_f32_32x32x16_bf16(a1, qr[1], p0, 0, 0, 0); p1 = __builtin_amdgcn_mfma_f32_32x32x16_bf16(b1, qr[1], p1, 0, 0, 0); FA_SBAR();
        FA_LGK(2); FA_SBAR(); p0 = __builtin_amdgcn_mfma_f32_32x32x16_bf16(a2, qr[2], p0, 0, 0, 0); p1 = __builtin_amdgcn_mfma_f32_32x32x16_bf16(b2, qr[2], p1, 0, 0, 0); FA_SBAR();
        FA_LGK(0); FA_SBAR(); p0 = __builtin_amdgcn_mfma_f32_32x32x16_bf16(a3, qr[3], p0, 0, 0, 0); p1 = __builtin_amdgcn_mfma_f32_32x32x16_bf16(b3, qr[3], p1, 0, 0, 0); FA_SBAR();
    } else {
        static_assert(DQK == 192, "qkt_pipe: d = 64 or 192");
#define FA_KG(G, x0, y0, x1, y1) do { x0 = k_read<BOFF + ((2 * (G)) >> 2) * 8192>(ka[(2 * (G)) & 3]); y0 = k_read<BOFF + ((2 * (G)) >> 2) * 8192 + 4096>(ka[(2 * (G)) & 3]); \
        x1 = k_read<BOFF + ((2 * (G) + 1) >> 2) * 8192>(ka[(2 * (G) + 1) & 3]); y1 = k_read<BOFF + ((2 * (G) + 1) >> 2) * 8192 + 4096>(ka[(2 * (G) + 1) & 3]); } while (0)
#define FA_KM(G, x0, y0, x1, y1) do { FA_SBAR(); if (VAR == 6) { p0 = __builtin_amdgcn_mfma_f32_32x32x16_bf16(x0 ^ y0 ^ x1 ^ y1, qr[2 * (G)], p0, 0, 0, 0); } else { \
        p0 = __builtin_amdgcn_mfma_f32_32x32x16_bf16(x0, qr[2 * (G)], p0, 0, 0, 0); p1 = __builtin_amdgcn_mfma_f32_32x32x16_bf16(y0, qr[2 * (G)], p1, 0, 0, 0); \
        p0 = __builtin_amdgcn_mfma_f32_32x32x16_bf16(x1, qr[2 * (G) + 1], p0, 0, 0, 0); p1 = __builtin_amdgcn_mfma_f32_32x32x16_bf16(y1, qr[2 * (G) + 1], p1, 0, 0, 0); } FA_SBAR(); } while (0)
        bf16x8 a0, b0, a1, b1, c0, d0, c1, d1;
        if constexpr (VAR == 5) {
#pragma unroll
            for (int g = 0; g < 12; ++g) { FA_SBAR(); p0 = __builtin_amdgcn_mfma_f32_32x32x16_bf16(qr[(g + 1) % 12], qr[g], p0, 0, 0, 0); p1 = __builtin_amdgcn_mfma_f32_32x32x16_bf16(qr[(g + 5) % 12], qr[g], p1, 0, 0, 0); FA_SBAR(); }
            return; }
        FA_KG(0, a0, b0, a1, b1); FA_KG(1, c0, d0, c1, d1);
        FA_LGK(4); FA_KM(0, a0, b0, a1, b1); FA_KG(2, a0, b0, a1, b1);
        FA_LGK(4); FA_KM(1, c0, d0, c1, d1); FA_KG(3, c0, d0, c1, d1);
        FA_LGK(4); FA_KM(2, a0, b0, a1, b1); FA_KG(4, a0, b0, a1, b1);
        FA_LGK(4); FA_KM(3, c0, d0, c1, d1); FA_KG(5, c0, d0, c1, d1);
        FA_LGK(4); FA_KM(4, a0, b0, a1, b1);
        FA_LGK(0); FA_KM(5, c0, d0, c1, d1);
#undef FA_KG
#undef FA_KM
    }
}
template <bool ALIBI> __device__ __forceinline__ void fixup(f32x16& p0, f32x16& p1, const LAS float* posl, float posq, float slope2, bool masked, int hi) {
    if (ALIBI) {
#pragma unroll
        for (int g = 0; g < 4; ++g) { const f32x4 k0 = *(const LAS f32x4*)(posl + 8 * g + 4 * hi), k1 = *(const LAS f32x4*)(posl + 32 + 8 * g + 4 * hi);
#pragma unroll
            for (int e = 0; e < 4; ++e) { p0[4 * g + e] = fmaf(-slope2, fabsf(posq - k0[e]), p0[4 * g + e]); p1[4 * g + e] = fmaf(-slope2, fabsf(posq - k1[e]), p1[4 * g + e]); } }
    }
    if (masked) {
#pragma unroll
        for (int r = 0; r < 16; ++r) { p0[r] = -INFINITY; p1[r] = -INFINITY; }
    }
}
template <int DQK, bool ALIBI, int NSLOT, int MODE = 0, int VAR = 0>
__device__ __forceinline__ void attn_pass(const bf16* __restrict__ Qb, const bf16* __restrict__ Kh, const bf16* __restrict__ Vh, const int* __restrict__ posb, float slope2, float cref, int TL, int q0, int T0, int NT,
                                          LAS unsigned char* lds, int tid_, f32x16 (&o)[4], float& l_out) {
    typedef Lds<DQK> L; constexpr int KSUB = DQK / 64, SHM_K = L::SHM_K;
    const int wid = __builtin_amdgcn_readfirstlane(tid_ >> 6); int lane; asm volatile("v_mbcnt_lo_u32_b32 %0, -1, 0\n\tv_mbcnt_hi_u32_b32 %0, -1, %0" : "=v"(lane));
    const int tid = wid * 64 + lane, r32 = lane & 31, hi = lane >> 5;
    if (wid >= 4) __builtin_amdgcn_s_setprio(1);
    LAS unsigned char* V_lds = lds + L::V_OFF; LAS unsigned char* K_lds = lds + L::K_OFF; LAS float* P_lds = (LAS float*)(lds + L::POS_OFF);
    LAS float* al_l = (LAS float*)(lds + L::WS_OFF) + wid * 64;
    float m_reg = -1e30f, l_reg = 0.f;
#pragma unroll
    for (int d = 0; d < 4; ++d) o[d] = f32x16{};
    bf16x8 qr[DQK / 16];
    { const bf16* Qw = Qb + (size_t)(wid * QBLK) * DQK; unsigned qgo = (unsigned)(r32 * DQK + hi * 8) * 2u; asm volatile("" : "+v"(qgo));
#pragma unroll
      for (int d0 = 0; d0 < DQK / 16; ++d0) qr[d0] = ldg<bf16x8>(Qw + d0 * 16, qgo); }
    const float posq = ALIBI ? (float)posb[q0 + wid * QBLK + r32] : 0.f;
    const int tmax = NT - 4 + (wid >> 1);
    const int sr = tid >> 4, sc = (tid & 15) * 8, vst0 = MODE == 5 ? v_st_nat(sr, sc) : v_st(sr, sc), vst1 = MODE == 5 ? v_st_nat(32 + sr, sc) : v_st(32 + sr, sc);
    const int kr = tid >> 3, kc = (tid & 7) * 8, kst = kswz(kr, kc * 2);
    unsigned vgo = (unsigned)(sr * DV + sc) * 2u, kgo = (unsigned)(kr * DQK + kc) * 2u, pgo = (unsigned)(tid & 63) * 4u; asm volatile("" : "+v"(vgo), "+v"(kgo), "+v"(pgo));
    const int vb0 = (int)(uintptr_t)V_lds + v_rd_base(lane);
    int ka[4]; k_bases(ka, K_lds, r32, hi);
    struct Slot { bf16x8 vs0, vs1, ks[KSUB]; int ps; } sl_[NSLOT];
#define FA_SLOAD(i, k0) do { unsigned kk_ = (unsigned)__builtin_amdgcn_readfirstlane((int)(k0)); asm volatile("" : "+s"(kk_));     \
    const bf16* Vt_ = Vh + (size_t)kk_ * DV; const bf16* Kt_ = Kh + (size_t)kk_ * DQK; \
    sl_[i].vs0 = ldg<bf16x8>(Vt_, vgo); sl_[i].vs1 = ldg<bf16x8>(Vt_ + 32 * DV, vgo); \
    _Pragma("unroll") for (int s_ = 0; s_ < KSUB; ++s_) sl_[i].ks[s_] = ldg<bf16x8>(Kt_ + s_ * 64, kgo); \
    if (ALIBI) sl_[i].ps = ldg<int>(posb + kk_, pgo); } while (0)
#define FA_SWRITE(b, i) do { *(LAS bf16x8*)(V_lds + (b) * SHM_V + vst0) = sl_[i].vs0; *(LAS bf16x8*)(V_lds + (b) * SHM_V + vst1) = sl_[i].vs1; \
    _Pragma("unroll") for (int s_ = 0; s_ < KSUB; ++s_) *(LAS bf16x8*)(K_lds + (b) * SHM_K + s_ * 8192 + kst) = sl_[i].ks[s_]; \
    if (ALIBI) { if (tid < 64) P_lds[(b) * 64 + tid] = (float)sl_[i].ps; } } while (0)
#define FA_RESC(a) do { if (__any((a) < 1.f)) { if (hi == 0) al_l[r32] = (a); asm volatile("s_waitcnt lgkmcnt(0)" ::: "memory"); \
    _Pragma("unroll") for (int d = 0; d < 4; ++d) _Pragma("unroll") for (int r = 0; r < 16; ++r) o[d][r] *= al_l[crow(r, hi)]; } } while (0)
#define FA_COMPUTE(b, t, STAGE) do { bf16x8 pa0, pa1, pa2, pa3; const bool vis_ = (t) <= tmax;     \
    if (vis_) { f32x16 p0, p1; \
    if (MODE == 5) { if (VAR == 3) { p0 = f32x16{}; p1 = f32x16{}; _Pragma("unroll") for (int r_ = 0; r_ < 16; ++r_) { p0[r_] = l_reg; p1[r_] = l_reg; } } \
        else if ((DQK == 192 && PIPE_MLA) || (DQK == 64 && PIPE_OLD64)) { p0 = f32x16{}; p1 = f32x16{}; qkt_pipe<DQK, (b) * SHM_K, (VAR == 5 || VAR == 6) ? VAR : 0>(p0, p1, ka, qr); } else qkt<DQK, true>(p0, p1, K_lds + (b) * SHM_K, qr, r32, hi); fixup<ALIBI>(p0, p1, P_lds + (b) * 64, posq, slope2, false, hi); \
        if (VAR == 1) { l_reg += p0[0] + p1[5]; typedef unsigned u32x4_t __attribute__((ext_vector_type(4))); \
            u32x4_t w0_ = {cvtpk(p0[0], p0[1]), cvtpk(p0[2], p0[3]), cvtpk(p0[4], p0[5]), cvtpk(p0[6], p0[7])}, w1_ = {cvtpk(p0[8], p0[9]), cvtpk(p0[10], p0[11]), cvtpk(p0[12], p0[13]), cvtpk(p0[14], p0[15])}; \
            u32x4_t w2_ = {cvtpk(p1[0], p1[1]), cvtpk(p1[2], p1[3]), cvtpk(p1[4], p1[5]), cvtpk(p1[6], p1[7])}, w3_ = {cvtpk(p1[8], p1[9]), cvtpk(p1[10], p1[11]), cvtpk(p1[12], p1[13]), cvtpk(p1[14], p1[15])}; \
            pa0 = __builtin_bit_cast(bf16x8, w0_); pa1 = __builtin_bit_cast(bf16x8, w1_); pa2 = __builtin_bit_cast(bf16x8, w2_); pa3 = __builtin_bit_cast(bf16x8, w3_); } \
        else fr_softmax(p0, p1, l_reg, pa0, pa1, pa2, pa3); } \
    else { float alpha; qkt<DQK>(p0, p1, K_lds + (b) * SHM_K, qr, r32, hi); fixup<ALIBI>(p0, p1, P_lds + (b) * 64, posq, slope2, false, hi); \
        partialSM(p0, p1, m_reg, alpha); finishSM(p0, p1, alpha, l_reg, pa0, pa1, pa2, pa3); FA_RESC(alpha); } } \
    FA_SBAR(); STAGE; FA_SBAR();     \
    if (vis_) { \
    if (VAR == 2) { l_reg += __builtin_bit_cast(float, pa0[0] | (pa1[1] << 16)) + __builtin_bit_cast(float, pa2[0] | (pa3[1] << 16)); } else \
    if (MODE == 5 && DQK == 64) pv_d0_pipe(o, vb0 + (b) * SHM_V, pa0, pa1, pa2, pa3); else pv_d0(o, vb0 + (b) * SHM_V, pa0, pa1, pa2, pa3); } } while (0)
    constexpr int S1 = NSLOT - 1;
    FA_SLOAD(0, T0 * KVBLK); FA_SWRITE(0, 0); FA_SLOAD(S1, (T0 + 1) * KVBLK); FA_SWRITE(1, S1); FA_SLOAD(0, (T0 + 2) * KVBLK);
    if (NSLOT == 2) FA_SLOAD(1, (T0 + 3) * KVBLK);
    __syncthreads();
    static_assert(NSLOT == 1, "attn_pass: one staging slot");
    for (int j = T0; j < NT; j += 2) {
        FA_COMPUTE(0, j, { if (VAR != 4) if (j > T0) { FA_SWRITE(1, 0); if (j + 2 < NT) FA_SLOAD(0, (j + 2) * KVBLK); } });
        __syncthreads();
        FA_COMPUTE(1, j + 1, { if (VAR != 4) if (j + 2 < NT) { FA_SWRITE(0, 0); FA_SLOAD(0, (j + 3) * KVBLK); } });
        __syncthreads();
    }
    if (MODE == 5) { auto rr = __builtin_amdgcn_permlane32_swap(__float_as_uint(l_reg), __float_as_uint(l_reg), false, false); l_reg = __uint_as_float(rr[0]) + __uint_as_float(rr[1]); }
    __builtin_amdgcn_s_setprio(0);
    l_out = l_reg;
#undef FA_SLOAD
#undef FA_SWRITE
#undef FA_RESC
#undef FA_COMPUTE
}
template <int DQK> struct Lds3 {
    static constexpr int SHM_K = KVBLK * DQK * 2;
    static constexpr int V_OFF = 0, K_OFF = 3 * SHM_V, POS_OFF = K_OFF + 3 * SHM_K, WS_OFF = POS_OFF + 3 * 256, END = WS_OFF + 8 * 256;
};
template <int DQK, bool ALIBI>
__device__ __forceinline__ void attn_pass_stag(const bf16* __restrict__ Qb, const bf16* __restrict__ Kh, const bf16* __restrict__ Vh, const int* __restrict__ posb, float slope2, int q0, int T0, int NT,
                                               LAS unsigned char* lds, int tid, f32x16 (&o)[4], float& l_out) {
    typedef Lds3<DQK> L; constexpr int KSUB = DQK / 64, SHM_K = L::SHM_K;
    const int wid = __builtin_amdgcn_readfirstlane(tid >> 6), lane = tid & 63, r32 = lane & 31, hi = lane >> 5, grp = wid >> 2;
    LAS unsigned char* V_lds = lds + L::V_OFF; LAS unsigned char* K_lds = lds + L::K_OFF; LAS float* P_lds = (LAS float*)(lds + L::POS_OFF);
    float l_reg = 0.f;
#pragma unroll
    for (int d = 0; d < 4; ++d) o[d] = f32x16{};
    bf16x8 qr[DQK / 16];
    { const bf16* Qw = Qb + (size_t)(wid * QBLK) * DQK; unsigned qgo = (unsigned)(r32 * DQK + hi * 8) * 2u; asm volatile("" : "+v"(qgo));
#pragma unroll
      for (int d0 = 0; d0 < DQK / 16; ++d0) qr[d0] = ldg<bf16x8>(Qw + d0 * 16, qgo); }
    const float posq = ALIBI ? (float)posb[q0 + wid * QBLK + r32] : 0.f;
    const int tmax = NT - 4 + (wid >> 1);
    const int sr = tid >> 4, sc = (tid & 15) * 8, vst0 = v_st(sr, sc), vst1 = v_st(32 + sr, sc);
    const int kr = tid >> 3, kc = (tid & 7) * 8, kst = kswz(kr, kc * 2);
    unsigned vgo = (unsigned)(sr * DV + sc) * 2u, kgo = (unsigned)(kr * DQK + kc) * 2u, pgo = (unsigned)(tid & 63) * 4u; asm volatile("" : "+v"(vgo), "+v"(kgo), "+v"(pgo));
    const int vb0 = (int)(uintptr_t)V_lds + v_rd_base(lane);
    struct Slot { bf16x8 vs0, vs1, ks[KSUB]; int ps; } sl_;
#define FS_SLOAD(k0) do { unsigned kk_ = (unsigned)__builtin_amdgcn_readfirstlane((int)(k0)); asm volatile("" : "+s"(kk_)); \
    const bf16* Vt_ = Vh + (size_t)kk_ * DV; const bf16* Kt_ = Kh + (size_t)kk_ * DQK; \
    sl_.vs0 = ldg<bf16x8>(Vt_, vgo); sl_.vs1 = ldg<bf16x8>(Vt_ + 32 * DV, vgo); \
    _Pragma("unroll") for (int s_ = 0; s_ < KSUB; ++s_) sl_.ks[s_] = ldg<bf16x8>(Kt_ + s_ * 64, kgo); \
    if (ALIBI) sl_.ps = ldg<int>(posb + kk_, pgo); } while (0)
#define FS_SWRITE(b) do { *(LAS bf16x8*)(V_lds + (b) * SHM_V + vst0) = sl_.vs0; *(LAS bf16x8*)(V_lds + (b) * SHM_V + vst1) = sl_.vs1; \
    _Pragma("unroll") for (int s_ = 0; s_ < KSUB; ++s_) *(LAS bf16x8*)(K_lds + (b) * SHM_K + s_ * 8192 + kst) = sl_.ks[s_]; \
    if (ALIBI) { if (tid < 64) P_lds[(b) * 64 + tid] = (float)sl_.ps; } } while (0)
    const int nt = NT - T0;
    FS_SLOAD(T0 * KVBLK); FS_SWRITE(0); FS_SLOAD((T0 + 1) * KVBLK); FS_SWRITE(1); FS_SLOAD((T0 + 2) * KVBLK);
    __syncthreads();
#define FS_QKS(j_) do { int b_ = (j_) % 3; asm volatile("" : "+s"(b_)); f32x16 p0, p1; \
    qkt<DQK, true>(p0, p1, K_lds + b_ * SHM_K, qr, r32, hi); fixup<ALIBI>(p0, p1, P_lds + b_ * 64, posq, slope2, T0 + (j_) > tmax, hi); \
    fr_softmax(p0, p1, l_reg, pa0, pa1, pa2, pa3); } while (0)
#define FS_PV(j_) do { int b_ = (j_) % 3; asm volatile("" : "+s"(b_)); pv_d0(o, vb0 + b_ * SHM_V, pa0, pa1, pa2, pa3); } while (0)
#define FS_STAGE(j_) do { const int jn_ = (j_) + 2; if (jn_ < nt) { int bw_ = jn_ % 3; asm volatile("" : "+s"(bw_)); FS_SWRITE(bw_); if (jn_ + 1 < nt) FS_SLOAD((T0 + jn_ + 1) * KVBLK); } } while (0)
    bf16x8 pa0, pa1, pa2, pa3;
    if (grp == 0) {
        for (int j = 0; j < nt; ++j) { FS_QKS(j); __syncthreads(); FS_PV(j); __syncthreads(); FS_STAGE(j); }
        __syncthreads();
    } else {
        pa0 = bf16x8{}; pa1 = bf16x8{}; pa2 = bf16x8{}; pa3 = bf16x8{};
        for (int j = 0; j < nt; ++j) { if (j > 0) FS_PV(j - 1); __syncthreads(); FS_QKS(j); __syncthreads(); FS_STAGE(j); }
        FS_PV(nt - 1); __syncthreads();
    }
#undef FS_QKS
#undef FS_PV
#undef FS_STAGE
    { auto rr = __builtin_amdgcn_permlane32_swap(__float_as_uint(l_reg), __float_as_uint(l_reg), false, false); l_reg = __uint_as_float(rr[0]) + __uint_as_float(rr[1]); }
    l_out = l_reg;
#undef FS_SLOAD
#undef FS_SWRITE
}
template <int DQK, bool ALIBI>
__device__ __forceinline__ void attn_pass_p2(const bf16* __restrict__ Qb, const bf16* __restrict__ Kh, const bf16* __restrict__ Vh, const int* __restrict__ posb, float slope2, int q0, int T0, int NT,
                                             LAS unsigned char* lds, int tid, f32x16 (&o)[4], float& l_out) {
    typedef Lds<DQK> L; constexpr int KSUB = DQK / 64, SHM_K = L::SHM_K;
    const int wid = __builtin_amdgcn_readfirstlane(tid >> 6), lane = tid & 63, r32 = lane & 31, hi = lane >> 5;
    LAS unsigned char* V_lds = lds + L::V_OFF; LAS unsigned char* K_lds = lds + L::K_OFF; LAS float* P_lds = (LAS float*)(lds + L::POS_OFF);
    float l_reg = 0.f;
#pragma unroll
    for (int d = 0; d < 4; ++d) o[d] = f32x16{};
    bf16x8 qr[DQK / 16];
    { const bf16* Qw = Qb + (size_t)(wid * QBLK) * DQK; unsigned qgo = (unsigned)(r32 * DQK + hi * 8) * 2u; asm volatile("" : "+v"(qgo));
#pragma unroll
      for (int d0 = 0; d0 < DQK / 16; ++d0) qr[d0] = ldg<bf16x8>(Qw + d0 * 16, qgo); }
    const float posq = ALIBI ? (float)posb[q0 + wid * QBLK + r32] : 0.f;
    const int tmax = NT - 4 + (wid >> 1);
    const int sr = tid >> 4, sc = (tid & 15) * 8, vst0 = v_st(sr, sc), vst1 = v_st(32 + sr, sc);
    const int kr = tid >> 3, kc = (tid & 7) * 8, kst = kswz(kr, kc * 2);
    unsigned vgo = (unsigned)(sr * DV + sc) * 2u, kgo = (unsigned)(kr * DQK + kc) * 2u, pgo = (unsigned)(tid & 63) * 4u; asm volatile("" : "+v"(vgo), "+v"(kgo), "+v"(pgo));
    const int vb0 = (int)(uintptr_t)V_lds + v_rd_base(lane);
    struct Slot { bf16x8 vs0, vs1, ks[KSUB]; int ps; } sl_;
#define FP_LOADK(t) do { unsigned kk_ = (unsigned)__builtin_amdgcn_readfirstlane((int)((t) * KVBLK)); asm volatile("" : "+s"(kk_)); const bf16* Kt_ = Kh + (size_t)kk_ * DQK; \
    _Pragma("unroll") for (int s_ = 0; s_ < KSUB; ++s_) sl_.ks[s_] = ldg<bf16x8>(Kt_ + s_ * 64, kgo); if (ALIBI) sl_.ps = ldg<int>(posb + kk_, pgo); } while (0)
#define FP_LOADV(t) do { unsigned kk_ = (unsigned)__builtin_amdgcn_readfirstlane((int)((t) * KVBLK)); asm volatile("" : "+s"(kk_)); const bf16* Vt_ = Vh + (size_t)kk_ * DV; \
    sl_.vs0 = ldg<bf16x8>(Vt_, vgo); sl_.vs1 = ldg<bf16x8>(Vt_ + 32 * DV, vgo); } while (0)
#define FP_WRITEK(b) do { _Pragma("unroll") for (int s_ = 0; s_ < KSUB; ++s_) *(LAS bf16x8*)(K_lds + (b) * SHM_K + s_ * 8192 + kst) = sl_.ks[s_]; \
    if (ALIBI) { if (tid < 64) P_lds[(b) * 64 + tid] = (float)sl_.ps; } } while (0)
#define FP_WRITEV(b) do { *(LAS bf16x8*)(V_lds + (b) * SHM_V + vst0) = sl_.vs0; *(LAS bf16x8*)(V_lds + (b) * SHM_V + vst1) = sl_.vs1; } while (0)
#define FP_QK(P0, P1, b, t) do { qkt<DQK, true>(P0, P1, K_lds + (b) * SHM_K, qr, r32, hi); fixup<ALIBI>(P0, P1, P_lds + (b) * 64, posq, slope2, (t) > tmax, hi); } while (0)
    f32x16 pA0, pA1, pB0, pB1; bf16x8 pa0, pa1, pa2, pa3;
    const int nt = NT - T0;
    FP_LOADK(T0); FP_LOADV(T0); FP_WRITEK(0); FP_WRITEV(0); FP_LOADK(T0 + 1); FP_WRITEK(1); FP_LOADK(T0 + 2); FP_LOADV(T0 + 1);
    __syncthreads();
    FP_QK(pA0, pA1, 0, T0);
    __syncthreads();
    for (int r = 0; r < nt; r += 2) {
        if (r + 2 < nt) FP_WRITEK(0);
        FP_WRITEV(1);
        if (r + 3 < nt) FP_LOADK(T0 + r + 3);
        if (r + 2 < nt) FP_LOADV(T0 + r + 2);
        FA_SBAR(); FP_QK(pB0, pB1, 1, T0 + r + 1);
        fr_softmax(pA0, pA1, l_reg, pa0, pa1, pa2, pa3); FA_SBAR();
        pv_d0(o, vb0, pa0, pa1, pa2, pa3);
        __syncthreads();
        if (r + 3 < nt) FP_WRITEK(1);
        if (r + 2 < nt) FP_WRITEV(0);
        if (r + 4 < nt) FP_LOADK(T0 + r + 4);
        if (r + 3 < nt) FP_LOADV(T0 + r + 3);
        FA_SBAR(); if (r + 2 < nt) FP_QK(pA0, pA1, 0, T0 + r + 2);
        fr_softmax(pB0, pB1, l_reg, pa0, pa1, pa2, pa3); FA_SBAR();
        pv_d0(o, vb0 + SHM_V, pa0, pa1, pa2, pa3);
        __syncthreads();
    }
    { auto rr = __builtin_amdgcn_permlane32_swap(__float_as_uint(l_reg), __float_as_uint(l_reg), false, false); l_reg = __uint_as_float(rr[0]) + __uint_as_float(rr[1]); }
    l_out = l_reg;
#undef FP_LOADK
#undef FP_LOADV
#undef FP_WRITEK
#undef FP_WRITEV
#undef FP_QK
}
template <int DQK, bool ALIBI>
__device__ __forceinline__ void attn_pass_dma(const bf16* __restrict__ Qb, const bf16* __restrict__ Kh, const bf16* __restrict__ Vh, const int* __restrict__ posb, const float* __restrict__ posfb,
                                              float slope2, int q0, int T0, int NT, LAS unsigned char* lds, int tid_, f32x16 (&o)[4], float& l_out) {
    typedef Lds3<DQK> L; constexpr int KSUB = DQK / 64, SHM_K = L::SHM_K, NPT = KSUB + 2 + (ALIBI ? 1 : 0);
    const int wid = __builtin_amdgcn_readfirstlane(tid_ >> 6); int lane; asm volatile("v_mbcnt_lo_u32_b32 %0, -1, 0\n\tv_mbcnt_hi_u32_b32 %0, -1, %0" : "=v"(lane));
    const int r32 = lane & 31, hi = lane >> 5;
    LAS unsigned char* V_lds = lds + L::V_OFF; LAS unsigned char* K_lds = lds + L::K_OFF; LAS float* P_lds = (LAS float*)(lds + L::POS_OFF);
    float l_reg = 0.f;
#pragma unroll
    for (int d = 0; d < 4; ++d) o[d] = f32x16{};
    bf16x8 qr[DQK / 16];
    { const bf16* Qw = Qb + (size_t)(wid * QBLK) * DQK; unsigned qgo = (unsigned)(r32 * DQK + hi * 8) * 2u; asm volatile("" : "+v"(qgo));
#pragma unroll
      for (int d0 = 0; d0 < DQK / 16; ++d0) qr[d0] = ldg<bf16x8>(Qw + d0 * 16, qgo); }
    const float posq = ALIBI ? (float)posb[q0 + wid * QBLK + r32] : 0.f;
    const int tmax = NT - 4 + (wid >> 1);
    unsigned ksrc, vsrc, psrc;
    { const int kr = 8 * wid + (lane >> 3), kc = (lane & 7) ^ ((kr >> 1) & 7); ksrc = (unsigned)(kr * DQK + kc * 8) * 2u;
      const int vk = 8 * wid + ((lane & 31) >> 2), vc = (lane >> 5) * 32 + (lane & 3) * 8; vsrc = (unsigned)(vk * DV + vc) * 2u; psrc = (unsigned)lane * 4u;
      asm volatile("" : "+v"(ksrc), "+v"(vsrc), "+v"(psrc)); }
    const int vb0 = (int)(uintptr_t)V_lds + v_rd_base(lane);
#define FD_DMA(t, slot) do { unsigned kk_ = (unsigned)__builtin_amdgcn_readfirstlane((int)((t) * KVBLK)); asm volatile("" : "+s"(kk_)); const int sl_ = (slot); \
    const char* Kt_ = (const char*)(Kh + (size_t)kk_ * DQK); const char* Vt_ = (const char*)(Vh + (size_t)kk_ * DV); \
    _Pragma("unroll") for (int s_ = 0; s_ < KSUB; ++s_) __builtin_amdgcn_global_load_lds((const unsigned*)(Kt_ + s_ * 128 + ksrc), (LAS unsigned*)(K_lds + sl_ * SHM_K + s_ * 8192 + wid * 1024), 16, 0, 0); \
    _Pragma("unroll") for (int q_ = 0; q_ < 2; ++q_) __builtin_amdgcn_global_load_lds((const unsigned*)(Vt_ + q_ * 128 + vsrc), (LAS unsigned*)(V_lds + sl_ * SHM_V + (2 * wid + q_) * 1024), 16, 0, 0); \
    if (ALIBI) __builtin_amdgcn_global_load_lds((const unsigned*)((const char*)(posfb + kk_) + psrc), (LAS unsigned*)(P_lds + sl_ * 64), 4, 0, 0); } while (0)
    const int nt = NT - T0;
    FD_DMA(T0, 0); FD_DMA(T0 + 1, 1);
    asm volatile("s_waitcnt vmcnt(0) lgkmcnt(0)\n\ts_barrier" ::: "memory");
    int slot = 0;
    for (int j = 0; j < nt; ++j) {
        int b = slot; asm volatile("" : "+s"(b));
        if (j + 2 < nt) { int bn = b + 2; bn = bn >= 3 ? bn - 3 : bn; FD_DMA(T0 + j + 2, bn); }
        { f32x16 p0, p1; bf16x8 pa0, pa1, pa2, pa3;
          qkt<DQK, true>(p0, p1, K_lds + b * SHM_K, qr, r32, hi); fixup<ALIBI>(p0, p1, P_lds + b * 64, posq, slope2, T0 + j > tmax, hi);
          fr_softmax(p0, p1, l_reg, pa0, pa1, pa2, pa3); FA_SBAR();
          pv_d0(o, vb0 + b * SHM_V, pa0, pa1, pa2, pa3); }
        if (j + 2 < nt) asm volatile("s_waitcnt vmcnt(%0) lgkmcnt(0)\n\ts_barrier" :: "n"(NPT) : "memory");
        else asm volatile("s_waitcnt vmcnt(0) lgkmcnt(0)\n\ts_barrier" ::: "memory");
        slot = slot == 2 ? 0 : slot + 1;
    }
    { auto rr = __builtin_amdgcn_permlane32_swap(__float_as_uint(l_reg), __float_as_uint(l_reg), false, false); l_reg = __uint_as_float(rr[0]) + __uint_as_float(rr[1]); }
    l_out = l_reg;
#undef FD_DMA
}
__device__ __forceinline__ void row_bcast(float f, LAS float* al, int r32, int hi, float (&rf)[16]) {
    asm volatile("s_waitcnt lgkmcnt(0)" ::: "memory");
    if (hi == 0) al[r32] = f;
    asm volatile("s_waitcnt lgkmcnt(0)" ::: "memory");
#pragma unroll
    for (int r = 0; r < 16; ++r) rf[r] = al[crow(r, hi)];
    asm volatile("s_waitcnt lgkmcnt(0)" ::: "memory");
}

__device__ __forceinline__ void attn_pass_da5(const bf16* __restrict__ Qb, const bf16* __restrict__ Kh, const bf16* __restrict__ Vh, const int* __restrict__ posb, float slope2, int cw, int q0, int T0, int NT,
                                              LAS unsigned char* lds, int tid_, f32x16 (&o)[4], float& l_out) {
    typedef Lds<64> L; constexpr int DQK = 64, SHM_K = L::SHM_K, B_OFF = L::END;
    const int wid = __builtin_amdgcn_readfirstlane(tid_ >> 6); int lane; asm volatile("v_mbcnt_lo_u32_b32 %0, -1, 0\n\tv_mbcnt_hi_u32_b32 %0, -1, %0" : "=v"(lane));
    const int tid = wid * 64 + lane, r32 = lane & 31, hi = lane >> 5;
    LAS unsigned char* V_lds = lds + L::V_OFF; LAS unsigned char* K_lds = lds + L::K_OFF; LAS float* P_lds = (LAS float*)(lds + L::POS_OFF); LAS float* B_lds = (LAS float*)(lds + B_OFF);
    float l_reg = 0.f;
#pragma unroll
    for (int d = 0; d < 4; ++d) o[d] = f32x16{};
    bf16x8 qr[4];
    { const bf16* Qw = Qb + (size_t)(wid * QBLK) * DQK; unsigned qgo = (unsigned)(r32 * DQK + hi * 8) * 2u; asm volatile("" : "+v"(qgo));
#pragma unroll
      for (int d0 = 0; d0 < 4; ++d0) qr[d0] = ldg<bf16x8>(Qw + d0 * 16, qgo); }
    const float posq = (float)posb[q0 + wid * QBLK + r32];
    const float dl = slope2 * (posq - (float)cw);
    const int tmax = NT - 4 + (wid >> 1);
    const int sr = tid >> 4, sc = (tid & 15) * 8, vst0 = v_st_nat(sr, sc), vst1 = v_st_nat(32 + sr, sc);
    const int kr = tid >> 3, kc = (tid & 7) * 8, kst = kswz(kr, kc * 2);
    unsigned vgo = (unsigned)(sr * DV + sc) * 2u, kgo = (unsigned)(kr * DQK + kc) * 2u, pgo = (unsigned)(tid & 63) * 4u; asm volatile("" : "+v"(vgo), "+v"(kgo), "+v"(pgo));
    const int vb0 = (int)(uintptr_t)V_lds + v_rd_base(lane);
    int ka[4]; k_bases(ka, K_lds, r32, hi);
    bf16x8 vs0, vs1, ks0; int ps;
#define FD_SLOAD(k0) do { unsigned kk_ = (unsigned)__builtin_amdgcn_readfirstlane((int)(k0)); asm volatile("" : "+s"(kk_)); \
    const bf16* Vt_ = Vh + (size_t)kk_ * DV; const bf16* Kt_ = Kh + (size_t)kk_ * DQK; \
    vs0 = ldg<bf16x8>(Vt_, vgo); vs1 = ldg<bf16x8>(Vt_ + 32 * DV, vgo); ks0 = ldg<bf16x8>(Kt_, kgo); ps = ldg<int>(posb + kk_, pgo); } while (0)
#define FD_SWRITE(b) do { *(LAS bf16x8*)(V_lds + (b) * SHM_V + vst0) = vs0; *(LAS bf16x8*)(V_lds + (b) * SHM_V + vst1) = vs1; *(LAS bf16x8*)(K_lds + (b) * SHM_K + kst) = ks0; \
    B_lds[(b) * 512 + tid] = slope2 * (float)(ps - cw); if (tid < 64) P_lds[(b) * 64 + tid] = (float)ps; } while (0)
#define FD_LIN(b) do { f32x16 p0, p1; bf16x8 pa0, pa1, pa2, pa3; const LAS float* bl_ = B_lds + (b) * 512 + wid * 64 + 4 * hi; \
    _Pragma("unroll") for (int g = 0; g < 4; ++g) { const f32x4 k0 = *(const LAS f32x4*)(bl_ + 8 * g), k1 = *(const LAS f32x4*)(bl_ + 32 + 8 * g); \
        _Pragma("unroll") for (int e = 0; e < 4; ++e) { p0[4 * g + e] = k0[e]; p1[4 * g + e] = k1[e]; } } \
    if (PIPE_LIN) qkt_pipe<DQK, (b) * SHM_K>(p0, p1, ka, qr); else qkt<DQK, false>(p0, p1, K_lds + (b) * SHM_K, qr, r32, hi); fr_softmax(p0, p1, l_reg, pa0, pa1, pa2, pa3); FA_SBAR(); \
    pv_d0_pipe(o, vb0 + (b) * SHM_V, pa0, pa1, pa2, pa3); } while (0)
#define FD_GEN(b, t) do { if ((t) <= tmax) { f32x16 p0, p1; bf16x8 pa0, pa1, pa2, pa3; \
    _Pragma("unroll") for (int r = 0; r < 16; ++r) { p0[r] = dl; p1[r] = dl; } \
    if (PIPE_GEN) qkt_pipe<DQK, (b) * SHM_K>(p0, p1, ka, qr); else qkt<DQK, false>(p0, p1, K_lds + (b) * SHM_K, qr, r32, hi); fixup<true>(p0, p1, P_lds + (b) * 64, posq, slope2, false, hi); fr_softmax(p0, p1, l_reg, pa0, pa1, pa2, pa3); FA_SBAR(); \
    pv_d0_pipe(o, vb0 + (b) * SHM_V, pa0, pa1, pa2, pa3); } } while (0)
    FD_SLOAD(T0 * KVBLK); FD_SWRITE(0); FD_SLOAD((T0 + 1) * KVBLK); FD_SWRITE(1); FD_SLOAD((T0 + 2) * KVBLK);
    __syncthreads();
    int j = T0;
    for (; j < NT - 4; j += 2) {
        FD_LIN(0);
        __syncthreads();
        FD_SWRITE(0); FD_SLOAD((j + 3) * KVBLK);
        FD_LIN(1);
        __syncthreads();
        FD_SWRITE(1); FD_SLOAD((j + 4) * KVBLK);
    }
    for (; j < NT; j += 2) {
        FD_GEN(0, j);
        __syncthreads();
        if (j + 2 < NT) { FD_SWRITE(0); FD_SLOAD((j + 3) * KVBLK); }
        FD_GEN(1, j + 1);
        __syncthreads();
        if (j + 2 < NT) { FD_SWRITE(1); }
    }
    { auto rr = __builtin_amdgcn_permlane32_swap(__float_as_uint(l_reg), __float_as_uint(l_reg), false, false); l_reg = __uint_as_float(rr[0]) + __uint_as_float(rr[1]); }
    l_out = l_reg;
#undef FD_SLOAD
#undef FD_SWRITE
#undef FD_LIN
#undef FD_GEN
}

__device__ __forceinline__ void attn_pass_da5p(const bf16* __restrict__ Qb, const bf16* __restrict__ Kh, const bf16* __restrict__ Vh, const int* __restrict__ posb, float slope2, int cw, int q0, int T0, int NT,
                                               LAS unsigned char* lds, int tid_, f32x16 (&o)[4], float& l_out) {
    typedef Lds<64> L; constexpr int DQK = 64, SHM_K = L::SHM_K, B_OFF = L::END;
    const int wid = __builtin_amdgcn_readfirstlane(tid_ >> 6); int lane; asm volatile("v_mbcnt_lo_u32_b32 %0, -1, 0\n\tv_mbcnt_hi_u32_b32 %0, -1, %0" : "=v"(lane));
    const int tid = wid * 64 + lane, r32 = lane & 31, hi = lane >> 5;
    if (wid >= 4) __builtin_amdgcn_s_setprio(1);
    LAS unsigned char* V_lds = lds + L::V_OFF; LAS unsigned char* K_lds = lds + L::K_OFF; LAS float* P_lds = (LAS float*)(lds + L::POS_OFF); LAS float* B_lds = (LAS float*)(lds + B_OFF);
    float l_reg = 0.f;
#pragma unroll
    for (int d = 0; d < 4; ++d) o[d] = f32x16{};
    bf16x8 qr[4];
    { const bf16* Qw = Qb + (size_t)(wid * QBLK) * DQK; unsigned qgo = (unsigned)(r32 * DQK + hi * 8) * 2u; asm volatile("" : "+v"(qgo));
#pragma unroll
      for (int d0 = 0; d0 < 4; ++d0) qr[d0] = ldg<bf16x8>(Qw + d0 * 16, qgo); }
    const float posq = (float)posb[q0 + wid * QBLK + r32];
    const float dl = slope2 * (posq - (float)cw);
    const int tmax = NT - 4 + (wid >> 1);
    const int sr = tid >> 4, sc = (tid & 15) * 8, vst0 = v_st_nat(sr, sc), vst1 = v_st_nat(32 + sr, sc);
    const int kr = tid >> 3, kc = (tid & 7) * 8, kst = kswz(kr, kc * 2);
    unsigned vgo = (unsigned)(sr * DV + sc) * 2u, kgo = (unsigned)(kr * DQK + kc) * 2u, pgo = (unsigned)(tid & 63) * 4u; asm volatile("" : "+v"(vgo), "+v"(kgo), "+v"(pgo));
    const int vb0 = (int)(uintptr_t)V_lds + v_rd_base(lane);
    int ka[4]; k_bases(ka, K_lds, r32, hi);
    bf16x8 vs0, vs1, ks0; int ps;
#define FP_LOADV(t) do { unsigned kk_ = (unsigned)__builtin_amdgcn_readfirstlane((int)((t) * KVBLK)); asm volatile("" : "+s"(kk_)); const bf16* Vt_ = Vh + (size_t)kk_ * DV; \
    vs0 = ldg<bf16x8>(Vt_, vgo); vs1 = ldg<bf16x8>(Vt_ + 32 * DV, vgo); } while (0)
#define FP_LOADK(t) do { unsigned kk_ = (unsigned)__builtin_amdgcn_readfirstlane((int)((t) * KVBLK)); asm volatile("" : "+s"(kk_)); ks0 = ldg<bf16x8>(Kh + (size_t)kk_ * DQK, kgo); ps = ldg<int>(posb + kk_, pgo); } while (0)
#define FP_WRITEV(b) do { *(LAS bf16x8*)(V_lds + (b) * SHM_V + vst0) = vs0; *(LAS bf16x8*)(V_lds + (b) * SHM_V + vst1) = vs1; } while (0)
#define FP_WRITEK(b) do { *(LAS bf16x8*)(K_lds + (b) * SHM_K + kst) = ks0; B_lds[(b) * 512 + tid] = slope2 * (float)(ps - cw); if (tid < 64) P_lds[(b) * 64 + tid] = (float)ps; } while (0)
#define FP_BINIT(x0, x1, b) do { const LAS float* bl_ = B_lds + (b) * 512 + wid * 64 + 4 * hi; \
    _Pragma("unroll") for (int g = 0; g < 4; ++g) { const f32x4 k0 = *(const LAS f32x4*)(bl_ + 8 * g), k1 = *(const LAS f32x4*)(bl_ + 32 + 8 * g); \
        _Pragma("unroll") for (int e = 0; e < 4; ++e) { x0[4 * g + e] = k0[e]; x1[4 * g + e] = k1[e]; } } } while (0)
#define FP_QK(x0, x1, t, b) do { if ((t) < NT - 4) { FP_BINIT(x0, x1, b); qkt<DQK, false>(x0, x1, K_lds + (b) * SHM_K, qr, r32, hi); } \
    else { _Pragma("unroll") for (int r = 0; r < 16; ++r) { x0[r] = dl; x1[r] = dl; } qkt<DQK, false>(x0, x1, K_lds + (b) * SHM_K, qr, r32, hi); fixup<true>(x0, x1, P_lds + (b) * 64, posq, slope2, false, hi); } } while (0)
    f32x16 c0, c1;
    {
        FP_LOADV(T0); FP_LOADK(T0);
        bf16x8 vB0, vB1, kB; int pB;
        { unsigned kk_ = (unsigned)__builtin_amdgcn_readfirstlane((int)((T0 + 1) * KVBLK)); asm volatile("" : "+s"(kk_)); const bf16* Vt_ = Vh + (size_t)kk_ * DV;
          vB0 = ldg<bf16x8>(Vt_, vgo); vB1 = ldg<bf16x8>(Vt_ + 32 * DV, vgo); kB = ldg<bf16x8>(Kh + (size_t)kk_ * DQK, kgo); pB = ldg<int>(posb + kk_, pgo); }
        FP_WRITEV(0); FP_WRITEK(0);
        *(LAS bf16x8*)(V_lds + SHM_V + vst0) = vB0; *(LAS bf16x8*)(V_lds + SHM_V + vst1) = vB1; *(LAS bf16x8*)(K_lds + SHM_K + kst) = kB;
        B_lds[512 + tid] = slope2 * (float)(pB - cw); if (tid < 64) P_lds[64 + tid] = (float)pB;
        FP_LOADK(T0 + 2); FP_LOADV(T0 + 2);
        __syncthreads();
        FP_QK(c0, c1, T0, 0);
        __syncthreads();
        FP_WRITEK(0); FP_LOADK(T0 + 3);
    }
    int s = T0;
    for (; s <= NT - 6; ++s) {
        const int b = s & 1, nb = b ^ 1, kof = nb * SHM_K;
        f32x16 n0, n1; bf16x8 pa0, pa1, pa2, pa3;
        FP_BINIT(n0, n1, nb);
        const bf16x8 a0 = k_read<0>(ka[0] + kof), b0 = k_read<4096>(ka[0] + kof), a1 = k_read<0>(ka[1] + kof), b1 = k_read<4096>(ka[1] + kof);
        const bf16x8 a2 = k_read<0>(ka[2] + kof), b2 = k_read<4096>(ka[2] + kof), a3 = k_read<0>(ka[3] + kof), b3 = k_read<4096>(ka[3] + kof);
        float sa = 0.f, sb = 0.f;
#define FP_SM(d) do { _Pragma("unroll") for (int r = 4 * (d); r < 4 * (d) + 4; ++r) { c0[r] = __builtin_amdgcn_exp2f(c0[r]); c1[r] = __builtin_amdgcn_exp2f(c1[r]); sa += c0[r]; sb += c1[r]; } } while (0)
        FA_LGK(6); FA_SBAR(); n0 = __builtin_amdgcn_mfma_f32_32x32x16_bf16(a0, qr[0], n0, 0, 0, 0); n1 = __builtin_amdgcn_mfma_f32_32x32x16_bf16(b0, qr[0], n1, 0, 0, 0); FP_SM(0); FA_SBAR();
        FA_LGK(4); FA_SBAR(); n0 = __builtin_amdgcn_mfma_f32_32x32x16_bf16(a1, qr[1], n0, 0, 0, 0); n1 = __builtin_amdgcn_mfma_f32_32x32x16_bf16(b1, qr[1], n1, 0, 0, 0); FP_SM(1); FA_SBAR();
        FA_LGK(2); FA_SBAR(); n0 = __builtin_amdgcn_mfma_f32_32x32x16_bf16(a2, qr[2], n0, 0, 0, 0); n1 = __builtin_amdgcn_mfma_f32_32x32x16_bf16(b2, qr[2], n1, 0, 0, 0); FP_SM(2); FA_SBAR();
        FA_LGK(0); FA_SBAR(); n0 = __builtin_amdgcn_mfma_f32_32x32x16_bf16(a3, qr[3], n0, 0, 0, 0); n1 = __builtin_amdgcn_mfma_f32_32x32x16_bf16(b3, qr[3], n1, 0, 0, 0); FP_SM(3); FA_SBAR();
#undef FP_SM
        l_reg += sa + sb;
        typedef unsigned u32x4_t __attribute__((ext_vector_type(4)));
#define FA_PKS(P, BASE, OUT) do { u32x4_t w = {cvtpk(P[BASE + 0], P[BASE + 1]), cvtpk(P[BASE + 2], P[BASE + 3]), cvtpk(P[BASE + 4], P[BASE + 5]), cvtpk(P[BASE + 6], P[BASE + 7])}; OUT = __builtin_bit_cast(bf16x8, w); } while (0)
        FA_PKS(c0, 0, pa0); FA_PKS(c0, 8, pa1); FA_PKS(c1, 0, pa2); FA_PKS(c1, 8, pa3);
#undef FA_PKS
        FA_SBAR();
        pv_d0_pipe(o, vb0 + b * SHM_V, pa0, pa1, pa2, pa3);
        __syncthreads();
        FP_WRITEV(b); FP_WRITEK(nb); FP_LOADV(s + 3); FP_LOADK(s + 4);
        c0 = n0; c1 = n1;
    }
    for (; s < NT; ++s) {
        const int b = s & 1, nb = b ^ 1;
        f32x16 n0 = f32x16{}, n1 = f32x16{};
        if (s + 1 < NT && s + 1 <= tmax) FP_QK(n0, n1, s + 1, nb);
        if (s <= tmax) { bf16x8 pa0, pa1, pa2, pa3; fr_softmax(c0, c1, l_reg, pa0, pa1, pa2, pa3); FA_SBAR(); pv_d0_pipe(o, vb0 + b * SHM_V, pa0, pa1, pa2, pa3); }
        __syncthreads();
        if (s + 2 < NT) FP_WRITEV(b);
        if (s + 3 < NT) { FP_WRITEK(nb); FP_LOADV(s + 3); }
        if (s + 4 < NT) FP_LOADK(s + 4);
        c0 = n0; c1 = n1;
    }
    { auto rr = __builtin_amdgcn_permlane32_swap(__float_as_uint(l_reg), __float_as_uint(l_reg), false, false); l_reg = __uint_as_float(rr[0]) + __uint_as_float(rr[1]); }
    __builtin_amdgcn_s_setprio(0);
    l_out = l_reg;
#undef FP_LOADV
#undef FP_LOADK
#undef FP_WRITEV
#undef FP_WRITEK
#undef FP_BINIT
#undef FP_QK
}
}

constexpr int CW_BAR = 4096;
constexpr int CW_Q = 8192;
__device__ __forceinline__ int next_unit(Frame& F, unsigned* ctr) {
    LAS unsigned* uq = (LAS unsigned*)(F.lds + LDSCTL_OFF + 16);
    __syncthreads();
    if (F.tid == 0) *uq = atomicAdd(ctr, 1u);
    __syncthreads();
    return __builtin_amdgcn_readfirstlane((int)*uq);
}
template <int MODE = 0> __device__ __forceinline__ void ph_attn_da(Frame& F, int l, int rep = 0) {
    const bf16 *QD = WSP(bf16, WS_QD), *KD = WSP(bf16, WS_KD), *VD = WSP(bf16, WS_VD);
    bf16* MIX = rep == 2 ? WSP(bf16, WS_U) : WSP(bf16, WS_MIX); float* O1 = WSP(float, WS_O1);
    const int lane = F.lane;
    LAS float* al = (LAS float*)(F.lds + fa::Lds<64>::WS_OFF) + F.wave * 64;
    const float s1 = wave_sum(FIN(I_LQ1)[l * 64 + lane] * FIN(I_LK1)[l * 64 + lane]);
    const float s2 = wave_sum(FIN(I_LQ2)[l * 64 + lane] * FIN(I_LK2)[l * 64 + lane]);
    const float lam_init = __int_as_float(__builtin_amdgcn_readfirstlane(__float_as_int(LAM_INIT[l])));
    const float lam = __int_as_float(__builtin_amdgcn_readfirstlane(__float_as_int(expf(s1) - expf(s2) + lam_init)));
    float gqm = fabsf(FIN(I_DAQG)[l * 64 + lane]), gkm = fabsf(FIN(I_DAKG)[l * 64 + lane]);
    gqm = wave_max(gqm); gkm = wave_max(gkm);
    const float bound = __int_as_float(__builtin_amdgcn_readfirstlane(__float_as_int(1.01f * 11.5416f * gqm * gkm)));
    const float reach = __int_as_float(__builtin_amdgcn_readfirstlane(__float_as_int(2.0f * bound + 160.0f)));
    if ((MODE == 5) != (bound < 40.0f)) return;
    const int* posmm = WSP(int, WS_POSMM);
    unsigned* ctr = (unsigned*)(F.ws + WS_CTL) + (rep == 2 ? 20000 + 64 * (l * 2) : CW_Q + 64 * 8 * (l * 4 + 0 + rep));
    for (;;) {
        const int u = next_unit(F, ctr); if (u >= 384) break;
        const int qb = 31 - u / 12, bh = u % 12, b = bh / NH, h = bh % NH, q0 = qb * 256, NT = q0 / 64 + 4;
        const int* posb = F.pos + b * SEQ;
        const float slope2 = __int_as_float(__builtin_amdgcn_readfirstlane(__float_as_int(ALIBI_SLOPE[h] * LOG2E)));
        const size_t orow = (size_t)(b * SEQ + q0 + F.wave * 32);
        int T0 = 0, TL = 0; bool lin = false;
        { const int* qm = posmm + (size_t)(b * 128 + qb * 4) * 2; int qmin = qm[0], qmax = qm[1];
#pragma unroll
          for (int c = 1; c < 4; ++c) { qmin = qm[2 * c] < qmin ? qm[2 * c] : qmin; qmax = qm[2 * c + 1] > qmax ? qm[2 * c + 1] : qmax; }
          const int* km = posmm + (size_t)(b * 128) * 2;
          for (; T0 < NT - 4; ++T0) { const int kmin = km[2 * T0], kmax = km[2 * T0 + 1]; int dmin = qmin - kmax; if (kmin - qmax > dmin) dmin = kmin - qmax; if (dmin < 0) dmin = 0;
              if (!(slope2 * (float)dmin > reach)) break; }
          T0 &= ~1;
          for (TL = T0; TL < NT; ++TL) if (km[2 * TL + 1] > qmin) break;
          if (TL < NT - 4) TL = T0;
          int span = qm[1] - qm[0];
#pragma unroll
          for (int c = 1; c < 4; ++c) { const int sp = qm[2 * c + 1] - qm[2 * c]; span = sp > span ? sp : span; }
          lin = TL >= NT - 4 && slope2 * (float)span <= 24.0f;
        }
        for (int mp = 0; mp < 2; ++mp) {
            f32x16 o[4]; float l1;
            const bf16* Qp = QD + ((size_t)(bh * 2 + mp) * SEQ + q0) * 64; const int bhk = rep == 2 ? 0 : bh; const bf16* Kp = KD + (size_t)(bhk * 2 + mp) * SEQ * 64; const bf16* Vp = VD + (size_t)bhk * SEQ * 128;
            if (MODE == 5 && lin) { const int cw = posmm[(size_t)(b * 128 + qb * 4 + (__builtin_amdgcn_readfirstlane(F.tid >> 6) >> 1)) * 2];
                fa::attn_pass_da5p(Qp, Kp, Vp, posb, slope2, cw, q0, T0, NT, F.lds, F.tid, o, l1); }
            else fa::attn_pass<64, true, 1, MODE>(Qp, Kp, Vp, posb, slope2, bound, TL, q0, T0, NT, F.lds, F.tid, o, l1);
            int le_; asm volatile("v_mbcnt_lo_u32_b32 %0, -1, 0\n\tv_mbcnt_hi_u32_b32 %0, -1, %0" : "=v"(le_)); const int r32 = le_ & 31, hi = le_ >> 5;
            float f[16];
            if (mp == 0) {
                fa::row_bcast(1.0f / l1, al, r32, hi, f);
                unsigned lo = (unsigned)(((u * 8 + F.wave) * 8) * 64 + le_) * 16u; asm volatile("" : "+v"(lo));
#pragma unroll
                for (int j = 0; j < 8; ++j) { const int d = j >> 1, rb = (j & 1) * 8; v4u w;
                    w.x = pg8::pkh2(o[d][rb + 0] * f[rb + 0], o[d][rb + 1] * f[rb + 1]); w.y = pg8::pkh2(o[d][rb + 2] * f[rb + 2], o[d][rb + 3] * f[rb + 3]);
                    w.z = pg8::pkh2(o[d][rb + 4] * f[rb + 4], o[d][rb + 5] * f[rb + 5]); w.w = pg8::pkh2(o[d][rb + 6] * f[rb + 6], o[d][rb + 7] * f[rb + 7]);
                    fa::stg<v4u>(O1, lo + j * 1024, w); }
            } else {
                fa::row_bcast(lam / l1, al, r32, hi, f);
                const float* hg = FIN(I_DAHG) + (size_t)l * 768 + h * 128;
                float hgv[4];
#pragma unroll
                for (int d = 0; d < 4; ++d) hgv[d] = fa::ldg<float>(hg + d * 32, (unsigned)r32 * 4u) * (1.0f - lam_init);
                unsigned lo = (unsigned)(((u * 8 + F.wave) * 8) * 64 + le_) * 16u; asm volatile("" : "+v"(lo));
                bf16* mb = MIX + orow * D + h * 128; unsigned mo = (unsigned)(4 * hi * D + r32) * 2u; asm volatile("" : "+v"(mo));
                v4u w1[8];
#pragma unroll
                for (int j = 0; j < 8; ++j) w1[j] = fa::ldg<v4u>(O1, lo + j * 1024);
#pragma unroll
                for (int j = 0; j < 8; ++j) { const int d = j >> 1, rb = (j & 1) * 8; const unsigned ww[4] = {w1[j].x, w1[j].y, w1[j].z, w1[j].w};
#pragma unroll
                    for (int q = 0; q < 4; ++q) { o[d][rb + 2 * q] = pg8::uph_lo(ww[q]) - o[d][rb + 2 * q] * f[rb + 2 * q]; o[d][rb + 2 * q + 1] = pg8::uph_hi(ww[q]) - o[d][rb + 2 * q + 1] * f[rb + 2 * q + 1]; } }
#pragma unroll
                for (int r2 = 0; r2 < 16; ++r2) {
                    float ss = 0.f;
#pragma unroll
                    for (int d = 0; d < 4; ++d) ss += o[d][r2] * o[d][r2];
                    ss = sum32(ss);
                    const float rn = rsqrtf(ss * (1.f / 128) + EPS);
#pragma unroll
                    for (int d = 0; d < 4; ++d) fa::stg<bf16>(mb, mo + (fa::crowc(r2) * D + d * 32) * 2, (bf16)f2bf(o[d][r2] * rn * hgv[d]));
                }
            }
        }
    }
}
template <int MODE> __device__ __forceinline__ void ph_attn_mla(Frame& F, int l, int rep = 0, int ubase = 0, int ucount = 384, int cslot = 2) {
    const bf16 *QM = WSP(bf16, WS_QM), *KM = WSP(bf16, WS_KM), *VM = WSP(bf16, WS_VM);
    bf16* MIX = rep >= 2 ? WSP(bf16, WS_U) : WSP(bf16, WS_MIX);
    const int lane = F.lane;
    LAS float* al = (LAS float*)(F.lds + fa::Lds<192>::WS_OFF) + F.wave * 64;
    float gqm = fmaxf(fmaxf(fabsf(FIN(I_MQG)[l * 192 + lane]), fabsf(FIN(I_MQG)[l * 192 + 64 + lane])), fabsf(FIN(I_MQG)[l * 192 + 128 + lane]));
    float gkm = fmaxf(fmaxf(fabsf(FIN(I_MKG)[l * 192 + lane]), fabsf(FIN(I_MKG)[l * 192 + 64 + lane])), fabsf(FIN(I_MKG)[l * 192 + 128 + lane]));
    gqm = wave_max(gqm); gkm = wave_max(gkm);
    const float bound = __int_as_float(__builtin_amdgcn_readfirstlane(__float_as_int(1.01f * 19.9907f * gqm * gkm)));
    if ((MODE == 5) != (bound < 60.0f)) return;
    unsigned* ctr = (unsigned*)(F.ws + WS_CTL) + (rep >= 2 ? 20000 + 64 * (l * 2 + 1) : CW_Q + 64 * 8 * (l * 4 + cslot + rep));
    for (;;) {
        const int ui = next_unit(F, ctr); if (ui >= ucount) break;
        const int u = ubase + ui;
        const int qb = 31 - u / 12, bh = u % 12, b = bh / NH, h = bh % NH, q0 = qb * 256, NT = q0 / 64 + 4;
        const size_t orow = (size_t)(b * SEQ + q0 + F.wave * 32);
        f32x16 o[4]; float l1;
        const int bhk = rep == 2 ? 0 : bh;
#if defined(PROBE_VAR)
        if (rep == 3) fa::attn_pass<192, false, 1, MODE, PROBE_VAR>(QM + ((size_t)bh * SEQ + q0) * 192, KM + (size_t)bhk * SEQ * 192, VM + (size_t)bhk * SEQ * 128, nullptr, 0.f, bound, 0, q0, 0, NT, F.lds, F.tid, o, l1); else
#endif
        fa::attn_pass<192, false, 1, MODE>(QM + ((size_t)bh * SEQ + q0) * 192, KM + (size_t)bhk * SEQ * 192, VM + (size_t)bhk * SEQ * 128, nullptr, 0.f, bound, 0, q0, 0, NT, F.lds, F.tid, o, l1);
        int le_; asm volatile("v_mbcnt_lo_u32_b32 %0, -1, 0\n\tv_mbcnt_hi_u32_b32 %0, -1, %0" : "=v"(le_)); const int r32 = le_ & 31, hi = le_ >> 5;
        float f[16]; fa::row_bcast(1.0f / l1, al, r32, hi, f);
        bf16* mb = MIX + orow * D + 768 + h * 128; unsigned mo = (unsigned)(4 * hi * D + r32) * 2u; asm volatile("" : "+v"(mo));
#pragma unroll
        for (int r2 = 0; r2 < 16; ++r2)
#pragma unroll
            for (int d = 0; d < 4; ++d) fa::stg<bf16>(mb, mo + (fa::crowc(r2) * D + d * 32) * 2, (bf16)f2bf(o[d][r2] * f[r2]));
    }
}
__device__ __forceinline__ void ph_sgu(Frame& F, int l, int rep = 0) {
    const _Float16* UU = WSP(_Float16, WS_UU); const bf16* GV = WSP(bf16, WS_GV); const float* SSQ = WSP(float, WS_SSQ_SGV); bf16* MIX = WSP(bf16, WS_MIX);
    LAS unsigned short* vs = (LAS unsigned short*)F.lds;
    LAS float* rs = (LAS float*)(F.lds + 128 * 128 * 2);
    const int lane = F.lane, r32 = lane & 31, hi = lane >> 5, tm = F.wave >> 1, tn0 = (F.wave & 1) * 2;
    __syncthreads();
    unsigned* sctr = (unsigned*)(F.ws + WS_CTL) + CW_Q + 64 * 8 * 16 + 64 * (l + 4 * rep);
    LAS float* wl = rs + 128;
    for (;;) { const int u = next_unit(F, sctr); if (u >= 512) break;
        const int g = u & 3, row0 = (u >> 2) * 128;
        const int t = 32 * tm + r32;
        const float* bias = FIN(I_SGB) + (l * 4 + g) * 128 + 32 * tm;
        const int c0 = g * 128 + 32 * tn0 + r32;
        float uu0[16], uu1[16], bvv[16];
#pragma unroll
        for (int r = 0; r < 16; ++r) { const int tt = crow(r, hi); const size_t row = (size_t)(row0 + 32 * tm + tt); uu0[r] = (float)UU[row * 512 + c0]; uu1[r] = (float)UU[row * 512 + c0 + 32]; bvv[r] = bias[tt]; }
        { const float* wb = FIN(I_SGW) + (size_t)(l * 4 + g) * 128 * 128;
          f32x4 wv_[8];
#pragma unroll
          for (int k = 0; k < 8; ++k) wv_[k] = *(const f32x4*)(wb + (size_t)(F.tid + k * NTHREADS) * 4);
#pragma unroll
          for (int k = 0; k < 8; ++k) { const int e = (F.tid + k * NTHREADS) * 4, tr = e >> 7, sc_ = e & 127; *(LAS f32x4*)(wl + tr * 132 + sc_) = wv_[k]; } }
        for (int i = F.tid; i < 128 * 16; i += NTHREADS) { const int s = i >> 4, c8 = i & 15; *(LAS bf16x8*)(vs + s * 128 + c8 * 8) = *(const bf16x8*)(GV + (size_t)(row0 + s) * 512 + g * 128 + c8 * 8); }
        if (F.tid < 128) { const f32x4 p = *(const f32x4*)(SSQ + (size_t)(row0 + F.tid) * 16 + g * 4); rs[F.tid] = rsqrtf(((p.x + p.y) + (p.z + p.w)) * (1.f / 128) + EPS); }
        __syncthreads();
        f32x16 acc0 = f32x16{}, acc1 = f32x16{};
        const LAS float* wrow = wl + t * 132;
        for (int ks = 0; ks < 2 * (tm + 1); ++ks) {
            const int s0 = 16 * ks + 8 * hi;
            const f32x4 w0 = *(const LAS f32x4*)(wrow + s0), w1 = *(const LAS f32x4*)(wrow + s0 + 4);
            float wv[8] = {w0.x, w0.y, w0.z, w0.w, w1.x, w1.y, w1.z, w1.w};
            bf16x8 af, b0, b1;
#pragma unroll
            for (int j = 0; j < 8; ++j) { af[j] = (short)f2bf(s0 + j <= t ? wv[j] * rs[s0 + j] : 0.f);
                b0[j] = (short)vs[(s0 + j) * 128 + 32 * tn0 + r32]; b1[j] = (short)vs[(s0 + j) * 128 + 32 * (tn0 + 1) + r32]; }
            acc0 = __builtin_amdgcn_mfma_f32_32x32x16_bf16(af, b0, acc0, 0, 0, 0);
            acc1 = __builtin_amdgcn_mfma_f32_32x32x16_bf16(af, b1, acc1, 0, 0, 0);
        }
#pragma unroll
        for (int r = 0; r < 16; ++r) { const int tt = crow(r, hi); const size_t row = (size_t)(row0 + 32 * tm + tt);
            MIX[row * D + 1536 + c0] = (bf16)f2bf(uu0[r] * (acc0[r] + bvv[r]));
            MIX[row * D + 1536 + c0 + 32] = (bf16)f2bf(uu1[r] * (acc1[r] + bvv[r])); }
        __syncthreads();
    }
}
__device__ __forceinline__ void ph_convfix(Frame& F, int l) {
    const unsigned short* EDGE = WSP(unsigned short, WS_EDGE); bf16* U = WSP(bf16, WS_U);
    auto ldh4 = [](const unsigned short* p) { const uint2 w = *(const uint2*)p; return (f32x4){pg8::uph_lo(w.x), pg8::uph_hi(w.x), pg8::uph_lo(w.y), pg8::uph_hi(w.y)}; };
    const float* cw = FIN(I_CONVW) + (size_t)l * 3 * NUP; const float* cb = FIN(I_CONVB) + (size_t)l * NUP;
    const int gt = F.bid * NTHREADS + F.tid, nt = F.G * NTHREADS;
    constexpr int NIT = (M / 64) * 2 * (DFF / 4);
    auto item = [&](int i, unsigned long long& pk, size_t& dst) {
        const int ch = (i % (DFF / 4)) * 4, r = (i / (DFF / 4)) & 1, blk = i / (2 * (DFF / 4)); const bool first = (blk % (SEQ / 64)) == 0;
        f32x4 y[2];
#pragma unroll
        for (int bj = 0; bj < 2; ++bj) {
            const unsigned short* e0 = EDGE + ((size_t)(blk * 4) * 2 + bj) * DFF + ch;
            const f32x4 z = {0.f, 0.f, 0.f, 0.f};
            const f32x4 a0 = ldh4(e0 + (size_t)r * 2 * DFF);
            const f32x4 a1 = r == 1 ? ldh4(e0) : (first ? z : ldh4(e0 - (size_t)1 * 2 * DFF));
            const f32x4 a2 = first ? z : (r == 1 ? ldh4(e0 - (size_t)1 * 2 * DFF) : ldh4(e0 - (size_t)2 * 2 * DFF));
            y[bj] = *(const f32x4*)(cb + bj * DFF + ch) + *(const f32x4*)(cw + (size_t)2 * NUP + bj * DFF + ch) * a0 + *(const f32x4*)(cw + (size_t)NUP + bj * DFF + ch) * a1 + *(const f32x4*)(cw + bj * DFF + ch) * a2; }
        float o[4];
#pragma unroll
        for (int e = 0; e < 4; ++e) { const float g = y[0][e]; o[e] = g * __builtin_amdgcn_rcpf(1.0f + __expf(-g)) * y[1][e]; }
        pk = (unsigned long long)pk2(o[0], o[1]) | ((unsigned long long)pk2(o[2], o[3]) << 32); dst = (size_t)(blk * 64 + r) * DFF + ch; };
    for (int i = gt; i < NIT; i += 3 * nt) {
        unsigned long long p0 = 0, p1 = 0, p2 = 0; size_t d0 = 0, d1 = 0, d2 = 0;
        const bool h1 = i + nt < NIT, h2 = i + 2 * nt < NIT;
        item(i, p0, d0); if (h1) item(i + nt, p1, d1); if (h2) item(i + 2 * nt, p2, d2);
        *(unsigned long long*)(U + d0) = p0; if (h1) *(unsigned long long*)(U + d1) = p1; if (h2) *(unsigned long long*)(U + d2) = p2; }
}

__device__ __forceinline__ void ph_krope(Frame& F, int l) {
    const bf16* H = WSP(bf16, WS_H); const bf16* Wk = wptr(F, l, WL_IN) + (size_t)4096 * D; float* KR = WSP(float, WS_KR); float* SSQ = WSP(float, WS_SSQ_KR);
    constexpr int PITCH = 1024;
    LAS unsigned char* As = F.lds; LAS unsigned char* Bs = F.lds + 64 * PITCH;
    LAS float* red = (LAS float*)F.lds;
    const int lane = F.lane, r32 = lane & 31, hi = lane >> 5, w = F.wave;
    __syncthreads();
    for (int tb = F.bid; tb < M / 64; tb += F.G) {
        f32x16 acc[2][2];
#pragma unroll
        for (int i = 0; i < 2; ++i)
#pragma unroll
            for (int j = 0; j < 2; ++j) acc[i][j] = f32x16{};
        for (int kc = 0; kc < 4; ++kc) {
#pragma unroll
            for (int p = 0; p < 8; ++p) { const int q = p * NTHREADS + F.tid, row = q >> 6, c16 = q & 63;
                *(LAS v4u*)(As + row * PITCH + (c16 ^ (row & 7)) * 16) = *(const v4u*)(H + (size_t)(tb * 64 + row) * D + kc * 512 + c16 * 8);
                *(LAS v4u*)(Bs + row * PITCH + (c16 ^ (row & 7)) * 16) = *(const v4u*)(Wk + (size_t)row * D + kc * 512 + c16 * 8); }
            __syncthreads();
#pragma unroll
            for (int ks = 0; ks < 4; ++ks) { const int ko = (((w * 64 + ks * 16 + hi * 8) >> 3) ^ (r32 & 7)) * 16;
                const bf16x8 A0 = *(const LAS bf16x8*)(As + r32 * PITCH + ko), A1 = *(const LAS bf16x8*)(As + (32 + r32) * PITCH + ko);
                const bf16x8 B0 = *(const LAS bf16x8*)(Bs + r32 * PITCH + ko), B1 = *(const LAS bf16x8*)(Bs + (32 + r32) * PITCH + ko);
                acc[0][0] = __builtin_amdgcn_mfma_f32_32x32x16_bf16(A0, B0, acc[0][0], 0, 0, 0); acc[0][1] = __builtin_amdgcn_mfma_f32_32x32x16_bf16(A0, B1, acc[0][1], 0, 0, 0);
                acc[1][0] = __builtin_amdgcn_mfma_f32_32x32x16_bf16(A1, B0, acc[1][0], 0, 0, 0); acc[1][1] = __builtin_amdgcn_mfma_f32_32x32x16_bf16(A1, B1, acc[1][1], 0, 0, 0); }
            __syncthreads();
        }
#pragma unroll
        for (int i = 0; i < 2; ++i)
#pragma unroll
            for (int j = 0; j < 2; ++j)
#pragma unroll
                for (int r = 0; r < 16; ++r) red[(w * 64 + (i * 2 + j) * 16 + r) * 64 + lane] = acc[i][j][r];
        __syncthreads();
#pragma unroll
        for (int c = 0; c < 8; ++c) { const int cb = w * 8 + c, i = cb >> 5, j = (cb >> 4) & 1, r = cb & 15;
            float v = 0.f;
#pragma unroll
            for (int ww = 0; ww < 8; ++ww) v += red[(ww * 64 + cb) * 64 + lane];
            const int row = tb * 64 + 32 * i + crow(r, hi);
            KR[(size_t)row * 64 + 32 * j + r32] = v;
            const float ss = sum32(v * v);
            if (r32 == 0) SSQ[(size_t)row * 2 + j] = ss; }
        __syncthreads();
    }
}
__device__ __forceinline__ void frame_init(Frame& F, const Args& a, unsigned char* lds) {
    F.lds = (LAS unsigned char*)lds; F.tid = threadIdx.x; F.lane = F.tid & 63; F.wave = __builtin_amdgcn_readfirstlane(F.tid >> 6); F.wave0 = F.wave;
    F.bid = blockIdx.x; F.G = gridDim.x; F.gw = F.bid * NWAVES + F.wave; F.ngw = F.G * NWAVES;
    F.ka = (const __attribute__((address_space(4))) Args*)__builtin_amdgcn_kernarg_segment_ptr();
    F.pos = (const int*)a.in[I_POS]; F.out = a.out; F.ws = a.ws;
}
__device__ __forceinline__ void frame_retid(Frame& F) {
    int lane; asm volatile("v_mbcnt_lo_u32_b32 %0, -1, 0\n\tv_mbcnt_hi_u32_b32 %0, -1, %0" : "=v"(lane));
    int w = F.wave0; asm volatile("" : "+s"(w));
    F.lane = lane; F.wave = w; F.tid = w * 64 + lane;
    int bid = blockIdx.x, G = gridDim.x; asm volatile("" : "+s"(bid)); asm volatile("" : "+s"(G)); F.bid = bid; F.G = G;
    F.gw = bid * NWAVES + F.wave; F.ngw = G * NWAVES;
}
__device__ __forceinline__ void grid_bar(const XcdBarrier& bar, int wave0) {
    int lane_; asm volatile("v_mbcnt_lo_u32_b32 %0, -1, 0\n\tv_mbcnt_hi_u32_b32 %0, -1, %0" : "=v"(lane_)); const bool leader = (wave0 == 0) && (lane_ == 0);
    XcdBarrier b2 = bar; unsigned z_ = 0u; asm volatile("" : "+s"(b2.x), "+s"(z_)); b2.bar = bar.bar + z_; xcd_barrier(b2, leader); }
template <int PH> __device__ __forceinline__ void run_phase(Frame& F, int l) {
    frame_retid(F); asm volatile("; PHASE_BEGIN %0" :: "n"(PH));
    const float* mod = WSP(float, WS_MOD) + (size_t)l * 12 * D;
    if constexpr (PH == 0) ph_prologue(F);
    if constexpr (PH == 1) ph_modreduce(F);
    if constexpr (PH == 2) { if (l == 0) ph_norm<false>(F, l, FIN(I_X), 0, D); else ph_norm<true>(F, l, WSP(bf16, WS_XB), 0, D); }
    if constexpr (PH == 3) { pg8::Gemm g{WSP(bf16, WS_H), wptr(F, l, WL_IN), M, 4096, D}; pg8::StaticOrder S; S.init(M, 4096, F.G, F.bid);
        pg8::EpiInProj E{WSP(bf16, WS_QD), WSP(bf16, WS_KD), WSP(bf16, WS_VD), WSP(bf16, WS_QA), WSP(bf16, WS_KVA), WSP(bf16, WS_GV), WSP(unsigned short, WS_UU), WSP(float, WS_KR),
                         WSP(float, WS_SSQ_QA), WSP(float, WS_SSQ_KVA), WSP(float, WS_SSQ_SGV), WSP(float, WS_SSQ_KR), FIN(I_DAQG) + l * 64, FIN(I_DAKG) + l * 64, FIN(I_QAG) + l * 512, FIN(I_KVAG) + l * 256, FIN(I_SGVG) + l * 512};
        pg8::gemm_phase<pg8::EpiInProj, pg8::StaticOrder, true, true>(F.lds, g, S, E, F.tid); frame_retid(F); ph_krope(F, l); }
    if constexpr (PH == 5) {
        PG8_LAS float* X = (PG8_LAS float*)(F.lds + LDSCTL_OFF + 1024);
        { pg8::Gemm g{WSP(bf16, WS_QA), wptr(F, l, WL_UQ), M, UQ_PAD, QRANK}; pg8::StaticOrder S; S.init(M, UQ_PAD, F.G, F.bid);
          pg8::EpiMlaQ E{WSP(bf16, WS_QM), WSP(float, WS_SSQ_QA), WSP(float, WS_COS), WSP(float, WS_SIN), FIN(I_MQG) + l * 192, X};
          pg8::gemm_phase<pg8::EpiMlaQ, pg8::StaticOrder, true, true>(F.lds, g, S, E, F.tid); }
        __syncthreads(); frame_retid(F);
        { pg8::Gemm g{WSP(bf16, WS_KVA), wptr(F, l, WL_UKV), M, UKV_N, KVRANK}; pg8::StaticOrder S; S.init(M, UKV_N, F.G, F.G - 1 - F.bid);
          pg8::EpiMlaKV E{WSP(bf16, WS_KM), WSP(bf16, WS_VM), WSP(float, WS_SSQ_KVA), WSP(float, WS_SSQ_KR), WSP(float, WS_KR), WSP(float, WS_COS), WSP(float, WS_SIN), FIN(I_MKG) + l * 192, X};
          pg8::gemm_phase<pg8::EpiMlaKV, pg8::StaticOrder, true, true>(F.lds, g, S, E, F.tid); }
    }
#ifndef MLA_FRONT
#define MLA_FRONT 192
#endif
    if constexpr (PH == 7) { ph_attn_mla<5>(F, l, 0, 0, MLA_FRONT, 3); frame_retid(F); ph_attn_mla<0>(F, l, 0, 0, MLA_FRONT, 3); frame_retid(F);
        ph_attn_da<5>(F, l); frame_retid(F); ph_attn_da<0>(F, l); frame_retid(F); asm volatile("; PHASE_BEGIN 71");
        ph_attn_mla<5>(F, l, 0, MLA_FRONT, 384 - MLA_FRONT, 2); frame_retid(F); ph_attn_mla<0>(F, l, 0, MLA_FRONT, 384 - MLA_FRONT, 2); frame_retid(F); asm volatile("; PHASE_BEGIN 72"); ph_sgu(F, l); }
    if constexpr (PH == 8) { pg8::Gemm g{WSP(bf16, WS_MIX), wptr(F, l, WL_OUT), M, D, D}; pg8::StaticOrder S; S.init(M, D, F.G, F.bid);
        pg8::EpiResidP E{l == 0 ? (const void*)FIN(I_X) : (const void*)WSP(bf16, WS_XB), WSP(bf16, WS_XB), l != 0, 1, mod + 2 * D, 6 * D}; pg8::gemm_phase<pg8::EpiResidP, pg8::StaticOrder, true, true>(F.lds, g, S, E, F.tid); }
    if constexpr (PH == 9) ph_norm<true>(F, l, WSP(bf16, WS_XB), 3 * D, 4 * D);
    if constexpr (PH == 10) { pg8::Gemm g{WSP(bf16, WS_H), wptr(F, l, WL_UP), M, NUP, D}; pg8::StaticOrder S; S.init(M, NUP, F.G, F.bid);
        pg8::EpiConvGate E{WSP(bf16, WS_U), WSP(unsigned short, WS_EDGE), FIN(I_CONVW) + (size_t)l * 3 * NUP, FIN(I_CONVB) + (size_t)l * NUP}; pg8::gemm_phase<pg8::EpiConvGate, pg8::StaticOrder, true, true>(F.lds, g, S, E, F.tid); }
    if constexpr (PH == 11) ph_convfix(F, l);
    if constexpr (PH == 12) { pg8::Gemm g{WSP(bf16, WS_U), wptr(F, l, WL_DOWN), M, D, DFF}; pg8::StaticOrder S; S.init(M, D, F.G, F.bid);
        pg8::EpiResidP E{WSP(bf16, WS_XB), l + 1 < DEPTH ? (void*)WSP(bf16, WS_XB) : (void*)F.out, 1, l + 1 < DEPTH, mod + 5 * D, 6 * D}; pg8::gemm_phase<pg8::EpiResidP, pg8::StaticOrder, true, true>(F.lds, g, S, E, F.tid); }
}
__global__ void __launch_bounds__(NTHREADS, 2) mega_fwd(Args a) {
    extern __shared__ __attribute__((aligned(16))) unsigned char lds[];
    Frame F; frame_init(F, a, lds);
    if (F.tid < 16) ((LAS unsigned*)(F.lds + LDSCTL_OFF))[F.tid] = 0u;
    __syncthreads();
    XcdBarrier bar = xcd_barrier_post((unsigned*)(F.ws + WS_CTL) + CW_BAR, (volatile LAS unsigned*)(F.lds + LDSCTL_OFF + 32));
    run_phase<0>(F, 0); grid_bar(bar, F.wave0);
#if defined(PROBE_P0)
    run_phase<0>(F, 0); grid_bar(bar, F.wave0);
#endif
    run_phase<1>(F, 0); grid_bar(bar, F.wave0);
    for (int l = 0; l < DEPTH; ++l) {
        run_phase<2>(F, l); grid_bar(bar, F.wave0);
#if defined(PROBE_EW)
        run_phase<2>(F, l); grid_bar(bar, F.wave0);
#endif
        run_phase<3>(F, l); grid_bar(bar, F.wave0);
#if defined(PROBE_GEMM)
        run_phase<3>(F, l); grid_bar(bar, F.wave0);
#endif
        run_phase<5>(F, l); grid_bar(bar, F.wave0);
        run_phase<7>(F, l); grid_bar(bar, F.wave0);
#if defined(PROBE_P7)
        frame_retid(F); ph_attn_da<5>(F, l, 1); frame_retid(F); ph_attn_mla<5>(F, l, 1); grid_bar(bar, F.wave0);
#endif
#if defined(PROBE_LOC)
        frame_retid(F); ph_attn_da<5>(F, l, 2); frame_retid(F); ph_attn_mla<5>(F, l, 2); grid_bar(bar, F.wave0);
#endif
#if defined(PROBE_DA)
        frame_retid(F); ph_attn_da<5>(F, l, 1); grid_bar(bar, F.wave0);
#endif
#if defined(PROBE_VAR)
        frame_retid(F); ph_attn_mla<5>(F, l, 3); grid_bar(bar, F.wave0);
#endif
#if defined(PROBE_MLA)
        frame_retid(F); ph_attn_mla<5>(F, l, 1); grid_bar(bar, F.wave0);
#endif
#if defined(PROBE_SGU)
        frame_retid(F); ph_sgu(F, l, 1); grid_bar(bar, F.wave0);
#endif
        run_phase<8>(F, l); grid_bar(bar, F.wave0);
        run_phase<9>(F, l); grid_bar(bar, F.wave0);
        run_phase<10>(F, l); grid_bar(bar, F.wave0);
#if defined(PROBE_G10)
        frame_retid(F); run_phase<10>(F, l); grid_bar(bar, F.wave0);
#endif
#if defined(PROBE_G10N)
        frame_retid(F); { pg8::Gemm g{WSP(bf16, WS_H), wptr(F, l, WL_UP), M, NUP, D}; pg8::StaticOrder S; S.init(M, NUP, F.G, F.bid);
          pg8::EpiNull E{WSP(float, WS_MIX)}; pg8::gemm_phase<pg8::EpiNull, pg8::StaticOrder, true, true>(F.lds, g, S, E, F.tid); } grid_bar(bar, F.wave0);
#endif
#if defined(PROBE_GEMM)
        run_phase<10>(F, l); grid_bar(bar, F.wave0);
#endif
        run_phase<11>(F, l); grid_bar(bar, F.wave0);
#if defined(PROBE_EW)
        run_phase<11>(F, l); grid_bar(bar, F.wave0);
#endif
        run_phase<12>(F, l); if (l + 1 < DEPTH) grid_bar(bar, F.wave0);
    }
}

extern "C" void kernel_launch(void* const* d_in, const int* in_sizes, int n_in, void* d_out, int out_size, void* d_ws, size_t ws_size, hipStream_t stream) {
    static int grid = 0;
    if (grid == 0) {
        if (n_in != N_IN || in_sizes[0] != M * D || out_size != M * D || ws_size < WS_END) { fprintf(stderr, "kernel_launch: shape mismatch (n_in %d, ws %zu, need %zu)\n", n_in, ws_size, (size_t)WS_END); grid = -1; return; }
        int dev = 0, cus = 0, per_cu = 0;
        if (hipGetDevice(&dev) != hipSuccess || hipDeviceGetAttribute(&cus, hipDeviceAttributeMultiprocessorCount, dev) != hipSuccess) { grid = -1; return; }
        if (hipFuncSetAttribute((const void*)mega_fwd, hipFuncAttributeMaxDynamicSharedMemorySize, LDS_BYTES) != hipSuccess) { fprintf(stderr, "hipFuncSetAttribute failed\n"); grid = -1; return; }
        if (hipOccupancyMaxActiveBlocksPerMultiprocessor(&per_cu, (const void*)mega_fwd, NTHREADS, LDS_BYTES) != hipSuccess || per_cu < 1) fprintf(stderr, "kernel_launch: occupancy query reports %d\n", per_cu);
        (void)hipGetLastError();
        grid = cus > 0 ? cus : 256;
    }
    if (grid < 0) return;
    if (hipMemsetAsync((char*)d_ws + WS_CTL, 0, CTL_ZERO_BYTES, stream) != hipSuccess) { fprintf(stderr, "kernel_launch: memset failed\n"); return; }
    Args a{};
    for (int i = 0; i < N_IN; ++i) a.in[i] = d_in[i];
    a.out = (float*)d_out; a.ws = (unsigned char*)d_ws; a.ph = 0; a.l = 0;
    hipLaunchKernelGGL(mega_fwd, dim3(grid), dim3(NTHREADS), LDS_BYTES, stream, a);
    const hipError_t le = hipPeekAtLastError();
    if (le != hipSuccess) fprintf(stderr, "kernel_launch: launch failed: %s\n", hipGetErrorName(le));
}
```

```cpp
#include <hip/hip_runtime.h>
#include <cstdio>
#include <cstdint>
#include <cmath>
#define GAS __attribute__((address_space(1)))
#define LAS __attribute__((address_space(3)))
namespace pg8 {
#define PG8_LAS __attribute__((address_space(3)))
typedef unsigned short bf16_t;
typedef short bf16x8 __attribute__((ext_vector_type(8)));
typedef float f32x4 __attribute__((ext_vector_type(4)));
typedef unsigned u32x4 __attribute__((ext_vector_type(4)));
constexpr int BM = 256, BK = 64, HALF = 128, HTB = HALF * BK * 2  , STAGE_BYTES = 8 * HTB, NXCD = 8, WGM = 8;

__host__ __device__ __forceinline__ int lds_byte(int r, int c) { const int st = (r >> 4) * 2 + (c >> 5), rr = r & 15, cc = c & 31, ob = rr * 64 + cc * 2; return st * 1024 + (ob ^ (((ob >> 9) & 1) << 5)); }
__host__ __device__ __forceinline__ void stage_rc(int b, int& R, int& C) { const int st = b / 1024, sb = b % 1024, swz = sb ^ (((sb >> 9) & 1) << 5); R = (st >> 1) * 16 + swz / 64; C = (st & 1) * 32 + (swz % 64) / 2; }
__host__ __device__ __forceinline__ int perm32(int rho) { const int n = rho >> 4, i = rho & 15; return 8 * (i >> 2) + 4 * n + (i & 3); }

struct Unit { int pm, pn; };
struct Gemm { const bf16_t* A; const bf16_t* Bt; int M, N, K; };

struct StaticOrder {
    int nM, nN, nwg, G, c;
    __host__ __device__ void init(int M, int N, int G_, int c_) { nM = M / BM; nN = N / BM; nwg = nM * nN; G = G_; c = c_; }
    __host__ __device__ bool next(int i, Unit& u) const {
        const long L = (long)i * G + c; if (L >= nwg) return false;
        int wgid = (int)L; { const int q = nwg / NXCD, r = nwg % NXCD, xcd = wgid % NXCD, off = wgid / NXCD; wgid = (xcd < r ? xcd * (q + 1) : r * (q + 1) + (xcd - r) * q) + off; }
        const int nig = WGM * nN, gid = wgid / nig, fm = gid * WGM, gsz = (nM - fm) < WGM ? (nM - fm) : WGM;
        u.pm = fm + ((wgid % nig) % gsz); u.pn = (wgid % nig) / gsz; return true;
    }
    __device__ __forceinline__ void a_ready(const Unit&) const {}
    __device__ __forceinline__ void done(const Unit&) const {}
};

__device__ __forceinline__ unsigned cvt_pk_bf16(float lo, float hi) { unsigned r; asm volatile("v_cvt_pk_bf16_f32 %0, %1, %2" : "=v"(r) : "v"(lo), "v"(hi)); return r; }
typedef float f32x2 __attribute__((ext_vector_type(2)));
typedef _Float16 f16x2 __attribute__((ext_vector_type(2)));
__device__ __forceinline__ unsigned pkh2(float a, float b) { const f16x2 h = {(_Float16)a, (_Float16)b}; return __builtin_bit_cast(unsigned, h); }
__device__ __forceinline__ float uph_lo(unsigned w) { return (float)__builtin_bit_cast(f16x2, w).x; }
__device__ __forceinline__ float uph_hi(unsigned w) { return (float)__builtin_bit_cast(f16x2, w).y; }

template <class Epi, class Sched, bool ALIGN_EPI = false, bool SP2 = false>
__device__ __forceinline__ void gemm_phase(PG8_LAS unsigned char* lds, const Gemm g, const Sched& S, const Epi& E, int tid_in) {
    int tid_ = tid_in; asm volatile("" : "+v"(tid_));
    const int tid = tid_, wid = __builtin_amdgcn_readfirstlane(tid >> 6), lane = tid & 63, wr = wid >> 2, wc = wid & 3, fr = lane & 15, fq = lane >> 4;
    const int K = g.K, nt = K / BK;
    unsigned voffA[2], voffB[2];
#pragma unroll
    for (int i = 0; i < 2; ++i) { int R, C; stage_rc(tid * 16 + i * 8192, R, C); const int Rb = Epi::PERM ? ((R & ~31) + perm32(R & 31)) : R;
        voffA[i] = (unsigned)(R * K + C) * 2u; voffB[i] = (unsigned)(Rb * K + C) * 2u; }
    const size_t kstep = (size_t)(BK * 2);
    const size_t hstep = (size_t)HALF * K * 2;
    const size_t tstep = 2 * hstep;
    const unsigned ldsw = (unsigned)wid * 1024u;
    const int aoff = lds_byte(wr * 64 + fr, fq * 8), boff = lds_byte(wc * 32 + fr, fq * 8);
#define PG8_SA(b, h) (((b) * 2 + (h)) * HTB)
#define PG8_SB(b, h) ((4 + (b) * 2 + (h)) * HTB)
#define PG8_STAGE(bufoff, gbase, voff) do { _Pragma("unroll") for (int _i = 0; _i < 2; ++_i) \
        __builtin_amdgcn_global_load_lds((const unsigned*)((const char*)(gbase) + (voff)[_i]), (PG8_LAS unsigned*)(lds + (bufoff) + ldsw + _i * 8192), 16, 0, 0); } while (0)
#define PG8_LDA(dst, b, h) do { _Pragma("unroll") for (int m = 0; m < 4; ++m) _Pragma("unroll") for (int k = 0; k < 2; ++k) dst[m][k] = *(const PG8_LAS bf16x8*)(lds + PG8_SA(b, h) + aoff + m * 2048 + k * 1024); } while (0)
#define PG8_LDB(dst, b, h) do { _Pragma("unroll") for (int n = 0; n < 2; ++n) _Pragma("unroll") for (int k = 0; k < 2; ++k) dst[n][k] = *(const PG8_LAS bf16x8*)(lds + PG8_SB(b, h) + boff + n * 2048 + k * 1024); } while (0)
#define PG8_MMA(ai, bj, At, Bt) do { __builtin_amdgcn_s_setprio(1); _Pragma("unroll") for (int m = 0; m < 4; ++m) _Pragma("unroll") for (int n = 0; n < 2; ++n) _Pragma("unroll") for (int k = 0; k < 2; ++k) \
        acc[ai][bj][m][n] = __builtin_amdgcn_mfma_f32_16x16x32_bf16(Bt[n][k], At[m][k], acc[ai][bj][m][n], 0, 0, 0); __builtin_amdgcn_s_setprio(0); } while (0)
#define PG8_WAIT_V(n) asm volatile("s_waitcnt vmcnt(" #n ")" ::: "memory")
#define PG8_WAIT_L(n) asm volatile("s_waitcnt lgkmcnt(" #n ")" ::: "memory")
#define PG8_BAR __builtin_amdgcn_s_barrier()
#define PG8_SCHED __builtin_amdgcn_sched_barrier(0)
    Unit cur, nxt; int ui = 0;
    if (!S.next(0, cur)) return;
    f32x4 acc[2][2][4][2];
#pragma unroll
    for (int a = 0; a < 2; ++a)
#pragma unroll
        for (int b = 0; b < 2; ++b)
#pragma unroll
            for (int m = 0; m < 4; ++m)
#pragma unroll
                for (int n = 0; n < 2; ++n) acc[a][b][m][n] = (f32x4){0.f, 0.f, 0.f, 0.f};
    bf16x8 At[4][2], B0[2][2], B1[2][2];
    const char* cA = (const char*)g.A + (size_t)cur.pm * tstep; const char* cB = (const char*)g.Bt + (size_t)cur.pn * tstep;
    S.a_ready(cur);
    if constexpr (SP2) {
        PG8_STAGE(PG8_SB(0, 0), cB, voffB); PG8_STAGE(PG8_SB(0, 1), cB + hstep, voffB); PG8_STAGE(PG8_SA(0, 0), cA, voffA); PG8_STAGE(PG8_SA(0, 1), cA + hstep, voffA);
        if (wr == 1) PG8_BAR;
        PG8_WAIT_V(2); PG8_BAR;
        PG8_STAGE(PG8_SB(1, 0), cB + kstep, voffB); PG8_STAGE(PG8_SA(1, 0), cA + kstep, voffA); PG8_STAGE(PG8_SB(1, 1), cB + hstep + kstep, voffB);
        PG8_WAIT_V(6); PG8_BAR;
    } else {
        PG8_STAGE(PG8_SB(0, 0), cB, voffB); PG8_STAGE(PG8_SA(0, 0), cA, voffA); PG8_STAGE(PG8_SB(0, 1), cB + hstep, voffB); PG8_STAGE(PG8_SA(0, 1), cA + hstep, voffA);
        if (wr == 1) PG8_BAR;
        PG8_WAIT_V(4); PG8_BAR;
        PG8_STAGE(PG8_SB(1, 0), cB + kstep, voffB); PG8_STAGE(PG8_SA(1, 0), cA + kstep, voffA); PG8_STAGE(PG8_SB(1, 1), cB + hstep + kstep, voffB);
        PG8_WAIT_V(6); PG8_BAR;
    }
    for (;;) {
        const bool has_next = S.next(ui + 1, nxt);
        const char* nA = has_next ? (const char*)g.A + (size_t)nxt.pm * tstep : cA; const char* nB = has_next ? (const char*)g.Bt + (size_t)nxt.pn * tstep : cB;
        for (int t = 0; t < nt; t += 2) {
            const bool last = (t == nt - 2);
            const char* a1 = cA + (size_t)(t + 1) * kstep;
            const char* a2 = last ? nA : cA + (size_t)(t + 2) * kstep; const char* b2 = last ? nB : cB + (size_t)(t + 2) * kstep;
            const char* a3 = a2 + kstep; const char* b3 = b2 + kstep;
            if (last && has_next) S.a_ready(nxt);
            if constexpr (SP2) {
            PG8_LDB(B0, 0, 0); PG8_LDB(B1, 0, 1); PG8_SCHED; PG8_LDA(At, 0, 0); PG8_STAGE(PG8_SA(1, 1), a1 + hstep, voffA);
            PG8_WAIT_V(8); PG8_WAIT_L(0); PG8_BAR; PG8_MMA(0, 0, At, B0); PG8_MMA(0, 1, At, B1); PG8_BAR; PG8_SCHED;
            PG8_LDA(At, 0, 1); PG8_STAGE(PG8_SB(0, 0), b2, voffB); PG8_STAGE(PG8_SB(0, 1), b2 + hstep, voffB); PG8_STAGE(PG8_SA(0, 0), a2, voffA);
            PG8_WAIT_V(8); PG8_WAIT_L(0); PG8_BAR; PG8_MMA(1, 0, At, B0); PG8_MMA(1, 1, At, B1); PG8_BAR; PG8_SCHED;
            PG8_LDB(B0, 1, 0); PG8_LDB(B1, 1, 1); PG8_SCHED; PG8_LDA(At, 1, 0); PG8_STAGE(PG8_SA(0, 1), a2 + hstep, voffA);
            PG8_WAIT_V(8); PG8_WAIT_L(0); PG8_BAR; PG8_MMA(0, 0, At, B0); PG8_MMA(0, 1, At, B1); PG8_BAR; PG8_SCHED;
            PG8_LDA(At, 1, 1); PG8_STAGE(PG8_SB(1, 0), b3, voffB); PG8_STAGE(PG8_SB(1, 1), b3 + hstep, voffB); PG8_STAGE(PG8_SA(1, 0), a3, voffA);
            PG8_WAIT_V(8); PG8_WAIT_L(0); PG8_BAR; PG8_MMA(1, 0, At, B0); PG8_MMA(1, 1, At, B1); PG8_BAR; PG8_SCHED;
            } else {
            PG8_LDB(B0, 0, 0); PG8_SCHED; PG8_LDA(At, 0, 0); PG8_STAGE(PG8_SA(1, 1), a1 + hstep, voffA);
            PG8_WAIT_L(8); PG8_BAR; PG8_WAIT_L(0); PG8_MMA(0, 0, At, B0); PG8_BAR; PG8_SCHED;
            PG8_LDB(B1, 0, 1); PG8_STAGE(PG8_SB(0, 0), b2, voffB);
            PG8_BAR; PG8_WAIT_L(0); PG8_MMA(0, 1, At, B1); PG8_BAR;
            PG8_LDA(At, 0, 1); PG8_STAGE(PG8_SA(0, 0), a2, voffA);
            PG8_BAR; PG8_WAIT_L(0); PG8_MMA(1, 0, At, B0); PG8_BAR; PG8_SCHED;
            PG8_STAGE(PG8_SB(0, 1), b2 + hstep, voffB);
            PG8_WAIT_V(6); PG8_BAR; PG8_MMA(1, 1, At, B1); PG8_BAR;
            PG8_LDB(B0, 1, 0); PG8_SCHED; PG8_LDA(At, 1, 0); PG8_STAGE(PG8_SA(0, 1), a2 + hstep, voffA);
            PG8_WAIT_L(8); PG8_BAR; PG8_WAIT_L(0); PG8_MMA(0, 0, At, B0); PG8_BAR; PG8_SCHED;
            PG8_LDB(B1, 1, 1); PG8_STAGE(PG8_SB(1, 0), b3, voffB);
            PG8_BAR; PG8_WAIT_L(0); PG8_MMA(0, 1, At, B1); PG8_BAR;
            PG8_LDA(At, 1, 1); PG8_STAGE(PG8_SA(1, 0), a3, voffA);
            PG8_BAR; PG8_WAIT_L(0); PG8_MMA(1, 0, At, B0); PG8_BAR; PG8_SCHED;
            PG8_STAGE(PG8_SB(1, 1), b3 + hstep, voffB);
            PG8_WAIT_V(6); PG8_BAR; PG8_MMA(1, 1, At, B1); PG8_BAR;
            }
        }
        if constexpr (ALIGN_EPI) { if (wr == 0) PG8_BAR; }
        if constexpr (!Epi::AFTER_DRAIN) { E(acc, cur, wr, wc, fr, fq); S.done(cur); }
        if (!has_next) break;
#pragma unroll
        for (int a = 0; a < 2; ++a)
#pragma unroll
            for (int b = 0; b < 2; ++b)
#pragma unroll
                for (int m = 0; m < 4; ++m)
#pragma unroll
                    for (int n = 0; n < 2; ++n) acc[a][b][m][n] = (f32x4){0.f, 0.f, 0.f, 0.f};
        cur = nxt; cA = nA; cB = nB; ++ui;
        if constexpr (ALIGN_EPI) { if (wr == 1) PG8_BAR; }
    }
    PG8_WAIT_V(0);
    if constexpr (!ALIGN_EPI) { if (wr == 0) PG8_BAR; }
    PG8_BAR;
    if constexpr (Epi::AFTER_DRAIN) { E.fused(acc, cur, wr, wc, fr, fq, lds, wid, lane); S.done(cur); }
#undef PG8_SA
#undef PG8_SB
#undef PG8_STAGE
#undef PG8_LDA
#undef PG8_LDB
#undef PG8_MMA
#undef PG8_WAIT_V
#undef PG8_WAIT_L
#undef PG8_BAR
#undef PG8_SCHED
}
}
#define XB_TMO      128
#define XB_XCNT(j)  (256  + 64 * (j))
#define XB_XSUB(j)  (1280 + 64 * (j))
#define XB_XGEN(j)  (2304 + 64 * (j))
#define XB_TOP      3328
#define XB_TOPGEN   3392
#define XCD_BAR_WORDS 3456
#define XB_SPIN_CAP (1u << 18)

__device__ __forceinline__ unsigned xb_ld(unsigned* p)              { return __hip_atomic_load(p, __ATOMIC_RELAXED, __HIP_MEMORY_SCOPE_AGENT); }
__device__ __forceinline__ unsigned xb_add(unsigned* p, unsigned v) { return __hip_atomic_fetch_add(p, v, __ATOMIC_RELAXED, __HIP_MEMORY_SCOPE_AGENT); }
__device__ __forceinline__ unsigned xb_xcc_id() { return (unsigned)__builtin_amdgcn_s_getreg((3 << 11) | 20) & 0xFu; }
#define XB_SPIN(cond, bar) do { unsigned _sp = 0; while (cond) { __builtin_amdgcn_s_sleep(1); \
    if ((++_sp & 255u) == 0u) { if (xb_ld(&(bar)[XB_TMO])) break; if (_sp > XB_SPIN_CAP) { atomicAdd(&(bar)[XB_TMO], 1u); break; } } } } while (0)

struct XcdBarrier {
    unsigned* bar; unsigned x;
    volatile LAS unsigned* st;
};

__device__ __forceinline__ XcdBarrier xcd_barrier_post(unsigned* bar, volatile LAS unsigned* st) {
    XcdBarrier b; b.bar = bar; b.x = xb_xcc_id(); b.st = st;
    if (threadIdx.x == 0) (void)xb_add(&bar[XB_XCNT(b.x)], 1u);
    return b;
}
__device__ __forceinline__ void xcd_barrier_complete(unsigned* bar, unsigned x, unsigned& nloc, unsigned& nx) {
    const unsigned G = gridDim.x * gridDim.y * gridDim.z;
    unsigned sum, cnt, mine, sp = 0u;
    for (;;) {
        sum = 0u; cnt = 0u; mine = 0u;
#pragma unroll
        for (unsigned j = 0; j < 16; ++j) { const unsigned c = xb_ld(&bar[XB_XCNT(j)]); sum += c; cnt += (c > 0u) ? 1u : 0u; mine = (j == x) ? c : mine; }
        if (sum == G) break;
        __builtin_amdgcn_s_sleep(1);
        if ((++sp & 255u) == 0u) { if (xb_ld(&bar[XB_TMO])) break; if (sp > XB_SPIN_CAP) { atomicAdd(&bar[XB_TMO], 1u); break; } }
    }
    nloc = mine > 0u ? mine : 1u; nx = cnt > 0u ? cnt : 1u;
}

__device__ __forceinline__ void xcd_barrier(const XcdBarrier& b, bool leader) {
    asm volatile("s_waitcnt vmcnt(0)" ::: "memory");
    __syncthreads();
    if (leader) {
        unsigned* bar = b.bar;
        __builtin_amdgcn_s_waitcnt(0);
        unsigned nloc = b.st[0], nx = b.st[1];
        if (nloc == 0u) { xcd_barrier_complete(bar, b.x, nloc, nx); b.st[0] = nloc; b.st[1] = nx; }
        const unsigned old = xb_add(&bar[XB_XSUB(b.x)], 1u);
        const unsigned gen = old / nloc;
        if (old + 1u == (gen + 1u) * nloc) {
            __builtin_amdgcn_fence(__ATOMIC_RELEASE, "agent");
            asm volatile("s_waitcnt vmcnt(0)" ::: "memory");
            const unsigned og = xb_add(&bar[XB_TOP], 1u);
            const unsigned tg = og / nx;
            if (og + 1u == (tg + 1u) * nx) xb_add(&bar[XB_TOPGEN], 1u);
            else XB_SPIN(xb_ld(&bar[XB_TOPGEN]) == tg, bar);
            __builtin_amdgcn_fence(__ATOMIC_ACQUIRE, "agent");
            xb_add(&bar[XB_XGEN(b.x)], 1u);
            asm volatile("s_waitcnt vmcnt(0)" ::: "memory");
        } else {
            XB_SPIN(xb_ld(&bar[XB_XGEN(b.x)]) == gen, bar);
            __builtin_amdgcn_fence(__ATOMIC_ACQUIRE, "agent");
            asm volatile("s_waitcnt vmcnt(0)" ::: "memory");
        }
    }
    __syncthreads();
}

typedef unsigned short bf16;
typedef unsigned v4u __attribute__((ext_vector_type(4)));
typedef unsigned v2u __attribute__((ext_vector_type(2)));
typedef float f32x4 __attribute__((ext_vector_type(4)));
typedef float f32x16 __attribute__((ext_vector_type(16)));
typedef short bf16x8 __attribute__((ext_vector_type(8)));
#define LDS_WAIT() asm volatile("s_waitcnt lgkmcnt(0)" ::: "memory")
#define VM_WAIT() asm volatile("s_waitcnt vmcnt(0)" ::: "memory")

constexpr int NWAVES = 8, NTHREADS = 512;
constexpr int BATCH = 2, SEQ = 8192, M = BATCH * SEQ, D = 2048, DEPTH = 4;
constexpr int IN_COLS = 4160, IN_PAD = 4352;
constexpr int C_DAQ = 0, C_DAK = 768, C_DAV = 1536, C_QA = 2304, C_KVA = 2816, C_KR = 3072, C_SGU = 3136, C_SGV = 3648;
constexpr int DFF = 5632, NUP = 2 * DFF;
constexpr int UQ_N = 1152, UQ_PAD = 1536, UKV_N = 1536, QRANK = 512, KVRANK = 256;
constexpr int NH = 6;
constexpr float EPS = 1e-6f;
constexpr float LOG2E = 1.4426950408889634f;
constexpr float QS_DA = 0.125f * LOG2E;
constexpr float QS_MLA = 0.07216878364870322f * LOG2E;

enum { I_X = 0, I_C, I_POS, I_WADA, I_BADA, I_WIN, I_DAQG, I_DAKG, I_LQ1, I_LK1, I_LQ2, I_LK2, I_DAHG, I_QAG, I_WUQ, I_KVAG, I_WUKV, I_MQG, I_MKG, I_SGVG, I_SGW, I_SGB, I_WOUT, I_WUP, I_CONVW, I_CONVB, I_WDOWN, N_IN };

constexpr size_t MiB = 1u << 20;
constexpr size_t WS_CTL = 0, CTL_ZERO_BYTES = 1 * MiB;
constexpr size_t WS_MOD = 1 * MiB;
constexpr size_t WS_POSMM = 1 * MiB + 512 * 1024;
constexpr size_t WS_MODP = 2 * MiB;
constexpr size_t WS_W = 8 * MiB;
constexpr size_t WL_IN = 0, WL_UQ = 17 * MiB, WL_UKV = WL_UQ + 1572864, WL_OUT = 20 * MiB, WL_UP = 28 * MiB, WL_DOWN = 72 * MiB, WL_STRIDE = 94 * MiB;
constexpr size_t WS_H = 384 * MiB;
constexpr size_t WS_MIX = 448 * MiB;
constexpr size_t WS_U = 512 * MiB;
constexpr size_t WS_R = 688 * MiB;
constexpr size_t WS_KR = WS_R;
constexpr size_t WS_SSQ_QA = WS_R + 4 * MiB, WS_SSQ_KVA = WS_R + 5 * MiB, WS_SSQ_SGV = WS_R + 6 * MiB, WS_SSQ_KR = WS_R + 7 * MiB;
constexpr size_t WS_QD = WS_R + 272 * MiB, WS_KD = WS_R + 296 * MiB, WS_VD = WS_R + 320 * MiB;
constexpr size_t WS_QM = WS_R + 344 * MiB, WS_KM = WS_R + 380 * MiB, WS_VM = WS_R + 416 * MiB;
constexpr size_t WS_QA = WS_R + 440 * MiB, WS_KVA = WS_R + 456 * MiB;
constexpr size_t WS_MLQ = WS_R + 464 * MiB, WS_MLKV = WS_R + 544 * MiB;
constexpr size_t WS_XB = WS_R + 464 * MiB;
constexpr size_t WS_UU = WS_R + 640 * MiB, WS_GV = WS_R + 672 * MiB;
constexpr size_t WS_EDGE = WS_R;
constexpr size_t WS_A = WS_R;
constexpr size_t WS_O1 = WS_R + 704 * MiB;
constexpr size_t WS_COS = WS_R + 752 * MiB, WS_SIN = WS_R + 754 * MiB;
constexpr size_t WS_END = WS_R + 756 * MiB;

constexpr int RING_BYTES = 131072;
constexpr int LDSCTL_OFF = RING_BYTES;
constexpr int LDS_BYTES = 147456;

__device__ const float ROPE_INV[32] = {1.000000000e+00f, 7.498942614e-01f, 5.623413324e-01f, 4.216965139e-01f, 3.162277639e-01f, 2.371373773e-01f, 1.778279394e-01f, 1.333521307e-01f, 1.000000015e-01f, 7.498941571e-02f, 5.623413250e-02f, 4.216965288e-02f, 3.162277490e-02f, 2.371373773e-02f, 1.778279431e-02f, 1.333521493e-02f, 9.999999776e-03f, 7.498941850e-03f, 5.623413250e-03f, 4.216964822e-03f, 3.162277630e-03f, 2.371373586e-03f, 1.778279431e-03f, 1.333521446e-03f, 1.000000047e-03f, 7.498942432e-04f, 5.623413017e-04f, 4.216965172e-04f, 3.162277571e-04f, 2.371373703e-04f, 1.778279402e-04f, 1.333521504e-04f};
__device__ const float ALIBI_SLOPE[6] = {0.3968502629920499f, 0.15749013123685915f, 0.0625f, 0.024803141437003122f, 0.0098431332023036951f, 0.00390625f};
__device__ const float LAM_INIT[4] = {0.20000000000000007f, 0.35550906759096934f, 0.4707130183435842f, 0.5560582041556406f};

struct Args { const void* in[N_IN]; float* out; unsigned char* ws; int ph; int l; };

__device__ __forceinline__ unsigned f2bf(float f) { unsigned u = __builtin_bit_cast(unsigned, f); return (u + 0x7fffu + ((u >> 16) & 1u)) >> 16; }
__device__ __forceinline__ unsigned pk2(float lo, float hi) { return f2bf(lo) | (f2bf(hi) << 16); }
__device__ __forceinline__ float bf2f(unsigned short h) { return __builtin_bit_cast(float, (unsigned)h << 16); }
template <int CTRL> __device__ __forceinline__ float dpp_mov(float v) { return __builtin_bit_cast(float, __builtin_amdgcn_update_dpp(0, __builtin_bit_cast(int, v), CTRL, 0xF, 0xF, true)); }
__device__ __forceinline__ float sum16(float v) { v += dpp_mov<0xB1>(v); v += dpp_mov<0x4E>(v); v += dpp_mov<0x141>(v); v += dpp_mov<0x140>(v); return v; }
__device__ __forceinline__ float sum32(float v) { v = sum16(v); auto r = __builtin_amdgcn_permlane16_swap(__float_as_uint(v), __float_as_uint(v), false, false); return __uint_as_float(r[0]) + __uint_as_float(r[1]); }
__device__ __forceinline__ float wave_sum(float v) { v = sum32(v); auto r = __builtin_amdgcn_permlane32_swap(__float_as_uint(v), __float_as_uint(v), false, false); return __uint_as_float(r[0]) + __uint_as_float(r[1]); }
__device__ __forceinline__ float wave_max(float v) { v = fmaxf(v, dpp_mov<0xB1>(v)); v = fmaxf(v, dpp_mov<0x4E>(v)); v = fmaxf(v, dpp_mov<0x141>(v)); v = fmaxf(v, dpp_mov<0x140>(v));
    { auto r = __builtin_amdgcn_permlane16_swap(__float_as_uint(v), __float_as_uint(v), false, false); v = fmaxf(__uint_as_float(r[0]), __uint_as_float(r[1])); }
    { auto r = __builtin_amdgcn_permlane32_swap(__float_as_uint(v), __float_as_uint(v), false, false); v = fmaxf(__uint_as_float(r[0]), __uint_as_float(r[1])); } return v; }
__device__ __forceinline__ float xor32(float v, int lane) { auto r = __builtin_amdgcn_permlane32_swap(__float_as_uint(v), __float_as_uint(v), false, false); return lane < 32 ? __uint_as_float(r[1]) : __uint_as_float(r[0]); }
__device__ __forceinline__ float gelu_tanh(float x) {
    const float u = 0.7978845608028654f * (x + 0.044715f * x * x * x);
    const float e = __expf(2.0f * u);
    const float th = 1.0f - 2.0f / (e + 1.0f);
    return 0.5f * x * (1.0f + th);
}
__device__ __forceinline__ float silu_f(float x) { return x / (1.0f + __expf(-x)); }
__device__ __forceinline__ int crow(int r, int hi) { return (r & 3) + 8 * (r >> 2) + 4 * hi; }

namespace pg8 {
struct EpiF32 {
    static constexpr bool PERM = false, AFTER_DRAIN = false;
    float* C; int ldc;
    __device__ __forceinline__ void operator()(const f32x4 (&acc)[2][2][4][2], const Unit& u, int wr, int wc, int fr, int fq) const {
        const int row0 = u.pm * BM + wr * 64 + fr, col0 = u.pn * BM + wc * 32 + 4 * fq;
#pragma unroll
        for (int ai = 0; ai < 2; ++ai)
#pragma unroll
            for (int m = 0; m < 4; ++m) { float* rowp = C + (size_t)(row0 + ai * HALF + m * 16) * ldc + col0;
#pragma unroll
                for (int bj = 0; bj < 2; ++bj)
#pragma unroll
                    for (int n = 0; n < 2; ++n) *(f32x4*)(rowp + bj * HALF + n * 16) = acc[ai][bj][m][n]; }
    }
};
struct EpiNull {
    static constexpr bool PERM = true, AFTER_DRAIN = false;
    float* C;
    __device__ __forceinline__ void operator()(const f32x4 (&acc)[2][2][4][2], const Unit& u, int wr, int wc, int fr, int fq) const {
        f32x4 s = {0.f, 0.f, 0.f, 0.f};
#pragma unroll
        for (int ai = 0; ai < 2; ++ai)
#pragma unroll
            for (int bj = 0; bj < 2; ++bj)
#pragma unroll
                for (int m = 0; m < 4; ++m)
#pragma unroll
                    for (int n = 0; n < 2; ++n) s += acc[ai][bj][m][n];
        C[(size_t)(u.pm * 44 + u.pn) * 512 + (wr * 4 + wc) * 64 + fq * 16 + fr] = (s[0] + s[1]) + (s[2] + s[3]);
    }
};
struct EpiResid {
    static constexpr bool PERM = false, AFTER_DRAIN = false;
    const float* xin; float* out; int ldc; const float* gate; int gate_stride;
    __device__ __forceinline__ void operator()(const f32x4 (&acc)[2][2][4][2], const Unit& u, int wr, int wc, int fr, int fq) const {
        const int row0 = u.pm * BM + wr * 64 + fr, col0 = u.pn * BM + wc * 32 + 4 * fq;
        const float* gp = gate + (size_t)((u.pm * BM) / SEQ) * gate_stride + col0;
        f32x4 gv[2][2];
#pragma unroll
        for (int bj = 0; bj < 2; ++bj)
#pragma unroll
            for (int n = 0; n < 2; ++n) gv[bj][n] = *(const f32x4*)(gp + bj * HALF + n * 16);
#pragma unroll
        for (int ai = 0; ai < 2; ++ai) {
            f32x4 xv[4][2][2];
#pragma unroll
            for (int m = 0; m < 4; ++m) { const size_t off = (size_t)(row0 + ai * HALF + m * 16) * ldc + col0;
#pragma unroll
                for (int bj = 0; bj < 2; ++bj)
#pragma unroll
                    for (int n = 0; n < 2; ++n) xv[m][bj][n] = *(const f32x4*)(xin + off + bj * HALF + n * 16); }
#pragma unroll
            for (int m = 0; m < 4; ++m) { const size_t off = (size_t)(row0 + ai * HALF + m * 16) * ldc + col0;
#pragma unroll
                for (int bj = 0; bj < 2; ++bj)
#pragma unroll
                    for (int n = 0; n < 2; ++n) *(f32x4*)(out + off + bj * HALF + n * 16) = xv[m][bj][n] + gv[bj][n] * acc[ai][bj][m][n]; }
        }
    }
};
struct EpiResidP {
    static constexpr bool PERM = true, AFTER_DRAIN = false;
    const void* xin; void* out; int inb, outb; const float* gate; int gate_stride;
    __device__ __forceinline__ void put(unsigned eo, const f32x4 r0, const f32x4 r1) const {
        if (outb) *(u32x4*)((char*)out + eo * 2u) = (u32x4){pkh2(r0[0], r0[1]), pkh2(r0[2], r0[3]), pkh2(r1[0], r1[1]), pkh2(r1[2], r1[3])};
        else { *(f32x4*)((char*)out + eo * 4u) = r0; *(f32x4*)((char*)out + eo * 4u + 16u) = r1; } }
    __device__ __forceinline__ void operator()(const f32x4 (&acc)[2][2][4][2], const Unit& u, int wr, int wc, int fr_, int fq_) const {
        int fr = fr_, fq = fq_; asm volatile("" : "+v"(fr), "+v"(fq));
        const int row0 = u.pm * BM + wr * 64 + fr, col0 = u.pn * BM + wc * 32 + 8 * fq;
        const unsigned lo = (unsigned)(row0 * 2048 + col0);
        const float* gp = gate + (size_t)((u.pm * BM) / SEQ) * gate_stride + col0;
        f32x4 gv[2][2];
#pragma unroll
        for (int bj = 0; bj < 2; ++bj)
#pragma unroll
            for (int n = 0; n < 2; ++n) gv[bj][n] = *(const f32x4*)(gp + bj * HALF + 4 * n);
        if (inb) {
            u32x4 xb[2][4][2];
#pragma unroll
            for (int ai = 0; ai < 2; ++ai)
#pragma unroll
                for (int m = 0; m < 4; ++m)
#pragma unroll
                    for (int bj = 0; bj < 2; ++bj) xb[ai][m][bj] = *(const u32x4*)((const char*)xin + (lo + (unsigned)((ai * HALF + m * 16) * 2048 + bj * HALF)) * 2u);
#pragma unroll
            for (int ai = 0; ai < 2; ++ai)
#pragma unroll
                for (int m = 0; m < 4; ++m)
#pragma unroll
                    for (int bj = 0; bj < 2; ++bj) { const u32x4 w = xb[ai][m][bj];
                        const f32x4 x0 = {uph_lo(w.x), uph_hi(w.x), uph_lo(w.y), uph_hi(w.y)};
                        const f32x4 x1 = {uph_lo(w.z), uph_hi(w.z), uph_lo(w.w), uph_hi(w.w)};
                        put(lo + (unsigned)((ai * HALF + m * 16) * 2048 + bj * HALF), x0 + gv[bj][0] * acc[ai][bj][m][0], x1 + gv[bj][1] * acc[ai][bj][m][1]); }
        } else {
#pragma unroll
            for (int ai = 0; ai < 2; ++ai) {
                f32x4 xv[4][2][2];
#pragma unroll
                for (int m = 0; m < 4; ++m)
#pragma unroll
                    for (int bj = 0; bj < 2; ++bj)
#pragma unroll
                        for (int n = 0; n < 2; ++n) xv[m][bj][n] = *(const f32x4*)((const char*)xin + (lo + (unsigned)((ai * HALF + m * 16) * 2048 + bj * HALF + 4 * n)) * 4u);
#pragma unroll
                for (int m = 0; m < 4; ++m)
#pragma unroll
                    for (int bj = 0; bj < 2; ++bj) put(lo + (unsigned)((ai * HALF + m * 16) * 2048 + bj * HALF), xv[m][bj][0] + gv[bj][0] * acc[ai][bj][m][0], xv[m][bj][1] + gv[bj][1] * acc[ai][bj][m][1]);
            }
        }
    }
};
struct EpiBf16S {
    static constexpr bool PERM = true, AFTER_DRAIN = false;
    bf16_t* O; int ldc;
    __device__ __forceinline__ void operator()(const f32x4 (&acc)[2][2][4][2], const Unit& u, int wr, int wc, int fr, int fq) const {
        const int row0 = u.pm * BM + wr * 64 + fr, col0 = u.pn * BM + wc * 32 + 8 * fq;
#pragma unroll
        for (int ai = 0; ai < 2; ++ai)
#pragma unroll
            for (int m = 0; m < 4; ++m) { bf16_t* rowp = O + (size_t)(row0 + ai * HALF + m * 16) * ldc + col0;
#pragma unroll
                for (int bj = 0; bj < 2; ++bj) { const f32x4 v0 = acc[ai][bj][m][0], v1 = acc[ai][bj][m][1]; u32x4 w;
                    w.x = cvt_pk_bf16(v0[0], v0[1]); w.y = cvt_pk_bf16(v0[2], v0[3]); w.z = cvt_pk_bf16(v1[0], v1[1]); w.w = cvt_pk_bf16(v1[2], v1[3]);
                    *(u32x4*)(rowp + bj * HALF) = w; } }
    }
};
template <int CTRL> __device__ __forceinline__ float dppf(float old, float src) { return __builtin_bit_cast(float, __builtin_amdgcn_update_dpp(__builtin_bit_cast(int, old), __builtin_bit_cast(int, src), CTRL, 0xF, 0xF, false)); }
struct EpiConvGate {
    static constexpr bool PERM = true, AFTER_DRAIN = false;
    bf16_t* U; unsigned short* EDGE; const float* cw; const float* cb;
    __device__ __forceinline__ void operator()(const f32x4 (&acc)[2][2][4][2], const Unit& u, int wr, int wc, int fr, int fq) const {
        const int ch0 = u.pn * 128 + wc * 32 + 8 * fq, rowb = u.pm * BM + wr * 64;
#pragma unroll
        for (int ai = 0; ai < 2; ++ai) { const int blk = (rowb + ai * HALF) >> 6;
            if (fr < 2) { unsigned short* e = EDGE + ((size_t)(blk * 4 + fr) * 2) * DFF + ch0;
#pragma unroll
                for (int bj = 0; bj < 2; ++bj) { const f32x4 a0 = acc[ai][bj][0][0], a1 = acc[ai][bj][0][1]; *(u32x4*)(e + bj * DFF) = (u32x4){pkh2(a0[0], a0[1]), pkh2(a0[2], a0[3]), pkh2(a1[0], a1[1]), pkh2(a1[2], a1[3])}; } }
            if (fr >= 14) { unsigned short* e = EDGE + ((size_t)(blk * 4 + fr - 12) * 2) * DFF + ch0;
#pragma unroll
                for (int bj = 0; bj < 2; ++bj) { const f32x4 a0 = acc[ai][bj][3][0], a1 = acc[ai][bj][3][1]; *(u32x4*)(e + bj * DFF) = (u32x4){pkh2(a0[0], a0[1]), pkh2(a0[2], a0[3]), pkh2(a1[0], a1[1]), pkh2(a1[2], a1[3])}; } }
        }
        f32x4 w[2][2][3], bb[2][2];
#pragma unroll
        for (int n = 0; n < 2; ++n)
#pragma unroll
            for (int bj = 0; bj < 2; ++bj) { bb[n][bj] = *(const f32x4*)(cb + bj * DFF + ch0 + 4 * n);
#pragma unroll
                for (int j = 0; j < 3; ++j) w[n][bj][j] = *(const f32x4*)(cw + (size_t)j * (2 * DFF) + bj * DFF + ch0 + 4 * n); }
#pragma unroll
        for (int ai = 0; ai < 2; ++ai)
#pragma unroll
            for (int m = 0; m < 4; ++m) {
                unsigned pkw[4];
#pragma unroll
                for (int n = 0; n < 2; ++n) {
                    f32x4 y[2];
#pragma unroll
                    for (int bj = 0; bj < 2; ++bj) { const f32x4 cur = acc[ai][bj][m][n]; const f32x4 prv = m > 0 ? acc[ai][bj][m - 1][n] : (f32x4){0.f, 0.f, 0.f, 0.f};
                        f32x4 s1, s2;
#pragma unroll
                        for (int e = 0; e < 4; ++e) {
                            if (m > 0) { s1[e] = dppf<0x111>(dpp_mov<0x121>(prv[e]), cur[e]); s2[e] = dppf<0x112>(dpp_mov<0x122>(prv[e]), cur[e]); }
                            else { s1[e] = dpp_mov<0x111>(cur[e]); s2[e] = dpp_mov<0x112>(cur[e]); } }
                        y[bj] = bb[n][bj] + w[n][bj][2] * cur + w[n][bj][1] * s1 + w[n][bj][0] * s2; }
                    const f32x4 tg = y[0] * -1.4426950408889634f;
                    f32x4 ev; ev[0] = __builtin_amdgcn_exp2f(tg[0]); ev[1] = __builtin_amdgcn_exp2f(tg[1]); ev[2] = __builtin_amdgcn_exp2f(tg[2]); ev[3] = __builtin_amdgcn_exp2f(tg[3]);
                    const f32x4 dn = ev + 1.0f;
                    f32x4 rc; rc[0] = __builtin_amdgcn_rcpf(dn[0]); rc[1] = __builtin_amdgcn_rcpf(dn[1]); rc[2] = __builtin_amdgcn_rcpf(dn[2]); rc[3] = __builtin_amdgcn_rcpf(dn[3]);
                    const f32x4 o = (y[0] * rc) * y[1];
                    pkw[2 * n] = cvt_pk_bf16(o[0], o[1]); pkw[2 * n + 1] = cvt_pk_bf16(o[2], o[3]);
                }
                u32x4 pk; pk.x = pkw[0]; pk.y = pkw[1]; pk.z = pkw[2]; pk.w = pkw[3];
                *(u32x4*)(U + (size_t)(rowb + ai * HALF + m * 16 + fr) * DFF + ch0) = pk;
            }
    }
};
__device__ __forceinline__ float lane_xor16_sum(float v) { auto r = __builtin_amdgcn_permlane16_swap(__float_as_uint(v), __float_as_uint(v), false, false); return __uint_as_float(r[0]) + __uint_as_float(r[1]); }
__device__ __forceinline__ float lane_xor32_sum(float v) { auto r = __builtin_amdgcn_permlane32_swap(__float_as_uint(v), __float_as_uint(v), false, false); return __uint_as_float(r[0]) + __uint_as_float(r[1]); }
__device__ __forceinline__ float sq4(f32x4 v) { return (v[0] * v[0] + v[1] * v[1]) + (v[2] * v[2] + v[3] * v[3]); }
__device__ __forceinline__ u32x4 pk8(f32x4 a, f32x4 b) { u32x4 w; w.x = cvt_pk_bf16(a[0], a[1]); w.y = cvt_pk_bf16(a[2], a[3]); w.z = cvt_pk_bf16(b[0], b[1]); w.w = cvt_pk_bf16(b[2], b[3]); return w; }
__device__ __forceinline__ float gelu_t(float x) { const float u = 0.7978845608028654f * (x + 0.044715f * x * x * x); const float e = __expf(2.0f * u); return 0.5f * x * (2.0f - 2.0f * __builtin_amdgcn_rcpf(e + 1.0f)); }
__device__ __forceinline__ f32x4 gelu4(f32x4 v) { return (f32x4){gelu_t(v[0]), gelu_t(v[1]), gelu_t(v[2]), gelu_t(v[3])}; }
struct EpiInProj {
    static constexpr bool PERM = true, AFTER_DRAIN = false;
    bf16_t *QD, *KD, *VD, *QA, *KVA, *GV; unsigned short* UU; float *KR, *SSQ_QA, *SSQ_KVA, *SSQ_SGV, *SSQ_KR;
    const float *qg, *kg, *qag, *kvag, *sgvg;
    __device__ __forceinline__ void operator()(const f32x4 (&acc)[2][2][4][2], const Unit& u, int wr, int wc, int fr, int fq) const {
        const int pn = u.pn, rowb = u.pm * BM + wr * 64 + fr, b = (u.pm * BM) / SEQ, c8 = wc * 32 + 8 * fq;
        if (pn < 6) {
            const bool isk = pn >= 3; const int G = 4 * (isk ? pn - 3 : pn) + wc;
            const float* gp = isk ? kg : qg;
            const f32x4 g00 = *(const f32x4*)(gp + 8 * fq), g01 = *(const f32x4*)(gp + 8 * fq + 4), g10 = *(const f32x4*)(gp + 32 + 8 * fq), g11 = *(const f32x4*)(gp + 32 + 8 * fq + 4);
            bf16_t* dst = (isk ? KD : QD) + ((size_t)(b * 12 + G) * SEQ) * 64 + 8 * fq;
            const float post = isk ? 1.0f : QS_DA;
#pragma unroll
            for (int ai = 0; ai < 2; ++ai)
#pragma unroll
                for (int m = 0; m < 4; ++m) { const f32x4 v00 = acc[ai][0][m][0], v01 = acc[ai][0][m][1], v10 = acc[ai][1][m][0], v11 = acc[ai][1][m][1];
                    float ss = (sq4(v00) + sq4(v01)) + (sq4(v10) + sq4(v11)); ss = lane_xor16_sum(ss); ss = lane_xor32_sum(ss);
                    const float r = rsqrtf(ss * (1.f / 64) + EPS) * post;
                    bf16_t* d = dst + (size_t)((rowb + ai * HALF + m * 16) & (SEQ - 1)) * 64;
                    *(u32x4*)d = pk8(v00 * g00 * r, v01 * g01 * r); *(u32x4*)(d + 32) = pk8(v10 * g10 * r, v11 * g11 * r); }
        } else if (pn < 9) {
#pragma unroll
            for (int bj = 0; bj < 2; ++bj) { bf16_t* dst = VD + ((size_t)(b * NH + 2 * (pn - 6) + bj) * SEQ) * 128 + c8;
#pragma unroll
                for (int ai = 0; ai < 2; ++ai)
#pragma unroll
                    for (int m = 0; m < 4; ++m) *(u32x4*)(dst + (size_t)((rowb + ai * HALF + m * 16) & (SEQ - 1)) * 128) = pk8(acc[ai][bj][m][0], acc[ai][bj][m][1]); }
        } else if (pn < 12) {
            const bool iskv = pn == 11; const int ct = iskv ? 0 : 256 * (pn - 9);
            const float* gp = (iskv ? kvag : qag) + ct + c8;
            const f32x4 g00 = *(const f32x4*)gp, g01 = *(const f32x4*)(gp + 4), g10 = *(const f32x4*)(gp + HALF), g11 = *(const f32x4*)(gp + HALF + 4);
            bf16_t* dst = (iskv ? KVA : QA) + ct + c8; const int ld = iskv ? KVRANK : QRANK;
            float* sq = iskv ? SSQ_KVA + wc : SSQ_QA + (pn - 9) * 4 + wc; const int sld = iskv ? 4 : 8;
#pragma unroll
            for (int ai = 0; ai < 2; ++ai)
#pragma unroll
                for (int m = 0; m < 4; ++m) { const int row = rowb + ai * HALF + m * 16;
                    const f32x4 v00 = acc[ai][0][m][0], v01 = acc[ai][0][m][1], v10 = acc[ai][1][m][0], v11 = acc[ai][1][m][1];
                    float ss = (sq4(v00) + sq4(v01)) + (sq4(v10) + sq4(v11)); ss = lane_xor16_sum(ss); ss = lane_xor32_sum(ss);
                    if (fq == 0) sq[(size_t)row * sld] = ss;
                    *(u32x4*)(dst + (size_t)row * ld) = pk8(v00 * g00, v01 * g01); *(u32x4*)(dst + (size_t)row * ld + HALF) = pk8(v10 * g10, v11 * g11); }
        } else if (pn < 14) {
            unsigned short* dst = UU + 256 * (pn - 12) + c8;
#pragma unroll
            for (int ai = 0; ai < 2; ++ai)
#pragma unroll
                for (int m = 0; m < 4; ++m) { unsigned short* d = dst + (size_t)(rowb + ai * HALF + m * 16) * 512;
#pragma unroll
                    for (int bj = 0; bj < 2; ++bj) { const f32x4 a = gelu4(acc[ai][bj][m][0]), c = gelu4(acc[ai][bj][m][1]);
                        *(u32x4*)(d + bj * HALF) = (u32x4){pkh2(a[0], a[1]), pkh2(a[2], a[3]), pkh2(c[0], c[1]), pkh2(c[2], c[3])}; } }
        } else if (pn < 16) {
            const int g0 = 2 * (pn - 14);
#pragma unroll
            for (int bj = 0; bj < 2; ++bj) { const float* gp = sgvg + (g0 + bj) * 128 + c8; const f32x4 ga = *(const f32x4*)gp, gb = *(const f32x4*)(gp + 4);
                bf16_t* dst = GV + (g0 + bj) * 128 + c8; float* sq = SSQ_SGV + (g0 + bj) * 4 + wc;
#pragma unroll
                for (int ai = 0; ai < 2; ++ai)
#pragma unroll
                    for (int m = 0; m < 4; ++m) { const int row = rowb + ai * HALF + m * 16; const f32x4 a = gelu4(acc[ai][bj][m][0]), c = gelu4(acc[ai][bj][m][1]);
                        float ss = sq4(a) + sq4(c); ss = lane_xor16_sum(ss); ss = lane_xor32_sum(ss);
                        if (fq == 0) sq[(size_t)row * 16] = ss;
                        *(u32x4*)(dst + (size_t)row * 512) = pk8(a * ga, c * gb); } }
        } else {
            if (wc < 2) {
#pragma unroll
                for (int ai = 0; ai < 2; ++ai)
#pragma unroll
                    for (int m = 0; m < 4; ++m) { const int row = rowb + ai * HALF + m * 16; float* d = KR + (size_t)row * 64 + c8; *(f32x4*)d = acc[ai][0][m][0]; *(f32x4*)(d + 4) = acc[ai][0][m][1];
                        float ss = sq4(acc[ai][0][m][0]) + sq4(acc[ai][0][m][1]); ss = lane_xor16_sum(ss); ss = lane_xor32_sum(ss); if (fq == 0) SSQ_KR[(size_t)row * 2 + wc] = ss; } }
        }
    }
};
struct EpiMlaQ {
    static constexpr bool PERM = true, AFTER_DRAIN = false;
    bf16_t* QM; const float *SSQ_QA, *COS, *SIN, *qg; PG8_LAS float* X;
    __device__ __forceinline__ void operator()(const f32x4 (&acc)[2][2][4][2], const Unit& u, int wr, int wc, int fr_, int fq_) const {
        float eps_ = EPS, k192 = 1.f / 192; asm volatile("" : "+s"(eps_), "+s"(k192));
        int fr = fr_, fq = fq_; asm volatile("" : "+v"(fr), "+v"(fq));
        const int h = u.pn, rowb = u.pm * BM + wr * 64 + fr, b = (u.pm * BM) / SEQ, c8 = wc * 32 + 8 * fq, rt = wr * 64 + fr;
#pragma unroll
        for (int ai = 0; ai < 2; ++ai)
#pragma unroll
            for (int m = 0; m < 4; ++m) { float ss = (sq4(acc[ai][0][m][0]) + sq4(acc[ai][0][m][1])) + (sq4(acc[ai][1][m][0]) + sq4(acc[ai][1][m][1])); ss = lane_xor16_sum(ss); ss = lane_xor32_sum(ss);
                if (fq == 0) X[(ai * HALF + m * 16 + rt) * 4 + wc] = ss; }
        asm volatile("s_waitcnt lgkmcnt(0)" ::: "memory"); __builtin_amdgcn_s_barrier(); asm volatile("" ::: "memory");
        const f32x4 g0a = *(const f32x4*)(qg + c8), g0b = *(const f32x4*)(qg + c8 + 4);
        const int i0 = 16 * wc + 4 * fq;
        f32x4 g1 = {0.f, 0.f, 0.f, 0.f}, g2 = g1; if (wc < 2) { g1 = *(const f32x4*)(qg + 128 + i0); g2 = *(const f32x4*)(qg + 160 + i0); }
        bf16_t* dst = QM + ((size_t)(b * NH + h) * SEQ) * 192;
#pragma unroll
        for (int ai = 0; ai < 2; ++ai)
#pragma unroll
        for (int mh = 0; mh < 4; mh += 2) {
        float rr[2][4]; f32x4 csv[2][4], snv[2][4];
#pragma unroll
            for (int m = mh; m < mh + 2; ++m) { const int row = rowb + ai * HALF + m * 16; const f32x4 xs = *(const PG8_LAS f32x4*)(X + (ai * HALF + m * 16 + rt) * 4);
                const f32x4 pa = *(const f32x4*)(SSQ_QA + (size_t)row * 8), pb = *(const f32x4*)(SSQ_QA + (size_t)row * 8 + 4);
                const float msq = (((pa[0] + pa[1]) + (pa[2] + pa[3])) + ((pb[0] + pb[1]) + (pb[2] + pb[3]))) * (1.f / 512) + eps_;
                rr[ai][m] = rsqrtf(((xs[0] + xs[1]) + (xs[2] + xs[3])) * k192 + eps_ * msq) * QS_MLA;
                if (wc < 2) { csv[ai][m] = *(const f32x4*)(COS + (size_t)row * 32 + i0); snv[ai][m] = *(const f32x4*)(SIN + (size_t)row * 32 + i0); } }
#pragma unroll
            for (int m = mh; m < mh + 2; ++m) { const int row = rowb + ai * HALF + m * 16; const float r = rr[ai][m];
                bf16_t* d = dst + (size_t)(row & (SEQ - 1)) * 192;
                *(u32x4*)(d + c8) = pk8(acc[ai][0][m][0] * g0a * r, acc[ai][0][m][1] * g0b * r);
                if (wc < 2) { const f32x4 cs = csv[ai][m], sn = snv[ai][m];
                    const f32x4 va = acc[ai][1][m][0], vb = acc[ai][1][m][1];
                    const f32x4 y1 = (f32x4){va[0], va[2], vb[0], vb[2]} * g1 * r, y2 = (f32x4){va[1], va[3], vb[1], vb[3]} * g2 * r;
                    const f32x4 o1 = y1 * cs - y2 * sn, o2 = y2 * cs + y1 * sn;
                    *(u32x4*)(d + 128 + c8) = pk8((f32x4){o1[0], o2[0], o1[1], o2[1]}, (f32x4){o1[2], o2[2], o1[3], o2[3]}); } }
        }
        asm volatile("s_waitcnt lgkmcnt(0)" ::: "memory"); __builtin_amdgcn_s_barrier(); asm volatile("" ::: "memory");
    }
};
struct EpiMlaKV {
    static constexpr bool PERM = true, AFTER_DRAIN = false;
    bf16_t *KM, *VM; const float *SSQ_KVA, *SSQ_KR, *KR, *COS, *SIN, *kg; PG8_LAS float* X;
    __device__ __forceinline__ void operator()(const f32x4 (&acc)[2][2][4][2], const Unit& u, int wr, int wc, int fr_, int fq_) const {
        float eps_ = EPS, k192 = 1.f / 192; asm volatile("" : "+s"(eps_), "+s"(k192));
        int fr = fr_, fq = fq_; asm volatile("" : "+v"(fr), "+v"(fq));
        const int h = u.pn, rowb = u.pm * BM + wr * 64 + fr, b = (u.pm * BM) / SEQ, c8 = wc * 32 + 8 * fq, rt = wr * 64 + fr;
#pragma unroll
        for (int ai = 0; ai < 2; ++ai)
#pragma unroll
            for (int m = 0; m < 4; ++m) { float ss = sq4(acc[ai][0][m][0]) + sq4(acc[ai][0][m][1]); ss = lane_xor16_sum(ss); ss = lane_xor32_sum(ss);
                if (fq == 0) X[(ai * HALF + m * 16 + rt) * 4 + wc] = ss; }
        asm volatile("s_waitcnt lgkmcnt(0)" ::: "memory"); __builtin_amdgcn_s_barrier(); asm volatile("" ::: "memory");
        const f32x4 g0a = *(const f32x4*)(kg + c8), g0b = *(const f32x4*)(kg + c8 + 4);
        const int i0 = 8 * wc + 2 * fq;
        const float g1a = kg[128 + i0], g1b = kg[128 + i0 + 1], g2a = kg[160 + i0], g2b = kg[160 + i0 + 1];
        bf16_t* kd = KM + ((size_t)(b * NH + h) * SEQ) * 192; bf16_t* vd = VM + ((size_t)(b * NH + h) * SEQ) * 128;
#pragma unroll
        for (int ai = 0; ai < 2; ++ai) {
        float rr[2][4], cv[2][4]; float2 k1v[2][4], k2v[2][4], cpv[2][4], spv[2][4];
#pragma unroll
            for (int m = 0; m < 4; ++m) { const int row = rowb + ai * HALF + m * 16; const f32x4 xs = *(const PG8_LAS f32x4*)(X + (ai * HALF + m * 16 + rt) * 4);
                const f32x4 pc = *(const f32x4*)(SSQ_KVA + (size_t)row * 4);
                const float c2 = 1.0f / (((pc[0] + pc[1]) + (pc[2] + pc[3])) * (1.f / 256) + eps_);
                const float2 sk = *(const float2*)(SSQ_KR + (size_t)row * 2);
                cv[ai][m] = sqrtf(c2); rr[ai][m] = rsqrtf((c2 * ((xs[0] + xs[1]) + (xs[2] + xs[3])) + (sk.x + sk.y)) * k192 + eps_);
                const float* kr = KR + (size_t)row * 64 + i0;
                k1v[ai][m] = *(const float2*)kr; k2v[ai][m] = *(const float2*)(kr + 32); cpv[ai][m] = *(const float2*)(COS + (size_t)row * 32 + i0); spv[ai][m] = *(const float2*)(SIN + (size_t)row * 32 + i0); }
#pragma unroll
            for (int m = 0; m < 4; ++m) { const int row = rowb + ai * HALF + m * 16; const float r = rr[ai][m], ckv = cv[ai][m];
                const int srow = row & (SEQ - 1);
                *(u32x4*)(kd + (size_t)srow * 192 + c8) = pk8(acc[ai][0][m][0] * g0a * (ckv * r), acc[ai][0][m][1] * g0b * (ckv * r));
                *(u32x4*)(vd + (size_t)srow * 128 + c8) = pk8(acc[ai][1][m][0] * ckv, acc[ai][1][m][1] * ckv);
                const float2 cp = cpv[ai][m], sp = spv[ai][m];
                const float y1a = k1v[ai][m].x * r * g1a, y1b = k1v[ai][m].y * r * g1b, y2a = k2v[ai][m].x * r * g2a, y2b = k2v[ai][m].y * r * g2b;
                const float oa1 = y1a * cp.x - y2a * sp.x, oa2 = y2a * cp.x + y1a * sp.x, ob1 = y1b * cp.y - y2b * sp.y, ob2 = y2b * cp.y + y1b * sp.y;
                *(unsigned long long*)(kd + (size_t)srow * 192 + 128 + 2 * i0) = (unsigned long long)cvt_pk_bf16(oa1, oa2) | ((unsigned long long)cvt_pk_bf16(ob1, ob2) << 32); }
        }
        asm volatile("s_waitcnt lgkmcnt(0)" ::: "memory"); __builtin_amdgcn_s_barrier(); asm volatile("" ::: "memory");
    }
};
}

struct Frame {
    LAS unsigned char* lds;
    int tid, lane, wave, wave0, gw, ngw, bid, G;
    const __attribute__((address_space(4))) Args* ka; const int* pos;
    float* out; unsigned char* ws;
};
__device__ __forceinline__ size_t opq(size_t v) { asm volatile("" : "+s"(v)); return v; }
#define WSP(T, off) ((T*)(F.ws + opq(off)))
#define FIN(i) ((const float*)F.ka->in[i])
__device__ __forceinline__ const bf16* wptr(const Frame& F, int l, size_t off) { return (const bf16*)(F.ws + WS_W + (size_t)l * WL_STRIDE + off); }

__device__ __forceinline__ void p0_transpose_item(const float* W, int K, int N, bf16* WT, int row_off, LAS float* scr, int item, int lane, int rstride = 1) {
    const int nblk = N / 32, kb = item / nblk, nb = item % nblk, k0 = 64 * kb, n0 = 32 * nb;
    float wv_[32];
#pragma unroll
    for (int i = 0; i < 32; ++i) { const int kk = 2 * i + (lane >> 5); wv_[i] = W[(size_t)(k0 + kk) * N + n0 + (lane & 31)]; }
#pragma unroll
    for (int i = 0; i < 32; ++i) { const int kk = 2 * i + (lane >> 5); scr[kk * 33 + (lane & 31)] = wv_[i]; }
    LDS_WAIT(); asm volatile("" ::: "memory");
    const int c = lane & 7;
#pragma unroll
    for (int j = 0; j < 4; ++j) { const int n = (lane >> 3) + 8 * j; const LAS float* s = scr + (8 * c) * 33 + n;
        v4u o; o.x = pk2(s[0 * 33], s[1 * 33]); o.y = pk2(s[2 * 33], s[3 * 33]); o.z = pk2(s[4 * 33], s[5 * 33]); o.w = pk2(s[6 * 33], s[7 * 33]);
        *(v4u*)(WT + (size_t)(row_off + n0 + rstride * n) * K + k0 + 8 * c) = o; }
    LDS_WAIT(); asm volatile("" ::: "memory");
}
__device__ __forceinline__ void ph_prologue(Frame& F) {
    LAS float* scr = (LAS float*)(F.lds + F.wave * 16384);
    constexpr int I_IN = (D / 64) * (IN_COLS / 32), I_UQ = (QRANK / 64) * (UQ_N / 32), I_UKV = (KVRANK / 64) * (UKV_N / 32), I_OUT = (D / 64) * (D / 32), I_UP = (D / 64) * (NUP / 32), I_DN = (DFF / 64) * (D / 32);
    constexpr int I_L = I_IN + I_UQ + I_UKV + I_OUT + I_UP + I_DN;
    for (int it = F.gw; it < DEPTH * I_L; it += F.ngw) {
        const int l = it / I_L; int r = it % I_L;
        bf16* wl = (bf16*)(F.ws + WS_W + (size_t)l * WL_STRIDE);
        if (r < I_IN) { const int n0 = 32 * (r % (IN_COLS / 32)); int dst;
            if (n0 < C_DAV) { const int q = n0 % 768, G = q / 64, e = q % 64; dst = (n0 - q) + 256 * (G / 4) + 128 * (e / 32) + 32 * (G % 4) + (e % 32); }
            else if (n0 < C_KR) dst = n0;
            else if (n0 < C_SGU) dst = 4096 + (n0 - C_KR);
            else dst = n0 - 64;
            p0_transpose_item(FIN(I_WIN) + (size_t)l * D * IN_COLS, D, IN_COLS, (bf16*)((unsigned char*)wl + WL_IN), dst - n0, scr, r, F.lane); continue; } r -= I_IN;
        if (r < I_UQ) { const int n0 = 32 * (r % (UQ_N / 32)), hh = n0 / 192, e = n0 % 192;
            const int dst = 256 * hh + (e < 128 ? e : 128 + (e - 128) / 32);
            p0_transpose_item(FIN(I_WUQ) + (size_t)l * QRANK * UQ_N, QRANK, UQ_N, (bf16*)((unsigned char*)wl + WL_UQ), dst - n0, scr, r, F.lane, e < 128 ? 1 : 2); continue; } r -= I_UQ;
        if (r < I_UKV) { p0_transpose_item(FIN(I_WUKV) + (size_t)l * KVRANK * UKV_N, KVRANK, UKV_N, (bf16*)((unsigned char*)wl + WL_UKV), 0, scr, r, F.lane); continue; } r -= I_UKV;
        if (r < I_OUT) { p0_transpose_item(FIN(I_WOUT) + (size_t)l * D * D, D, D, (bf16*)((unsigned char*)wl + WL_OUT), 0, scr, r, F.lane); continue; } r -= I_OUT;
        if (r < I_UP) { const int n0 = 32 * (r % (NUP / 32)), chn = n0 % DFF, dst = 256 * (chn / 128) + 128 * (n0 / DFF) + (chn % 128);
            p0_transpose_item(FIN(I_WUP) + (size_t)l * D * NUP, D, NUP, (bf16*)((unsigned char*)wl + WL_UP), dst - n0, scr, r, F.lane); continue; } r -= I_UP;
        p0_transpose_item(FIN(I_WDOWN) + (size_t)l * DFF * D, DFF, D, (bf16*)((unsigned char*)wl + WL_DOWN), 0, scr, r, F.lane);
    }
    {
        const int gt = F.bid * NTHREADS + F.tid, nt = F.G * NTHREADS;
        constexpr int Z_IN = (IN_PAD - IN_COLS) * D / 8, Z_UQ = NH * 64 * QRANK / 8;
        for (int i = gt; i < DEPTH * (Z_IN + Z_UQ); i += nt) { const int l = i / (Z_IN + Z_UQ); int r = i % (Z_IN + Z_UQ);
            unsigned char* wl = F.ws + WS_W + (size_t)l * WL_STRIDE;
            v4u z = {0u, 0u, 0u, 0u};
            if (r < Z_IN) *(v4u*)(wl + WL_IN + (size_t)IN_COLS * D * 2 + (size_t)r * 16) = z;
            else { r -= Z_IN; const int hh = r / (64 * QRANK / 8), q = r % (64 * QRANK / 8); *(v4u*)(wl + WL_UQ + ((size_t)(256 * hh + 192) * QRANK) * 2 + (size_t)q * 16) = z; } }
    }
    __syncthreads();
    LAS float* cond = (LAS float*)F.lds;
    for (int i = F.tid; i < 2 * D; i += NTHREADS) cond[i] = silu_f(FIN(I_C)[i]);
    __syncthreads();
    {
        const int gt = F.bid * NTHREADS + F.tid, nt = F.G * NTHREADS;
        float* part = WSP(float, WS_MODP);
        for (int it = gt; it < DEPTH * 16 * 3072; it += nt) {
            const int n4 = it % 3072, ks = (it / 3072) % 16, l = it / (3072 * 16);
            const float* w = FIN(I_WADA) + ((size_t)l * D + ks * 128) * (6 * D) + n4 * 4;
            f32x4 a0 = {0.f, 0.f, 0.f, 0.f}, a1 = {0.f, 0.f, 0.f, 0.f};
#pragma unroll 8
            for (int k = 0; k < 128; ++k) { const f32x4 wv = *(const f32x4*)(w + (size_t)k * (6 * D)); a0 += cond[ks * 128 + k] * wv; a1 += cond[D + ks * 128 + k] * wv; }
            *(f32x4*)(part + ((size_t)(l * 16 + ks) * 2 + 0) * (6 * D) + n4 * 4) = a0;
            *(f32x4*)(part + ((size_t)(l * 16 + ks) * 2 + 1) * (6 * D) + n4 * 4) = a1;
        }
    }
    __syncthreads();
}
__device__ __forceinline__ void ph_modreduce(Frame& F) {
    const int gt = F.bid * NTHREADS + F.tid, nt = F.G * NTHREADS;
    const float* part = WSP(float, WS_MODP); float* mod = WSP(float, WS_MOD);
    for (int i = gt; i < DEPTH * 2 * 6 * D; i += nt) { const int n = i % (6 * D), b = (i / (6 * D)) & 1, l = i / (12 * D);
        float s = FIN(I_BADA)[l * 6 * D + n];
#pragma unroll
        for (int ks = 0; ks < 16; ++ks) s += part[((size_t)(l * 16 + ks) * 2 + b) * (6 * D) + n];
        mod[i] = s; }
    { float* ct = WSP(float, WS_COS); float* st = WSP(float, WS_SIN);
      for (int i = gt; i < M * 32; i += nt) { const float ang = (float)F.pos[i >> 5] * ROPE_INV[i & 31];
          const double rev = (double)ang * 0.15915494309189535; const float fr = (float)(rev - floor(rev));
          ct[i] = __builtin_amdgcn_cosf(fr); st[i] = __builtin_amdgcn_sinf(fr); } }
    if (gt < M / 64) { int mn = 0x7fffffff, mx = -0x7fffffff - 1;
        for (int i = 0; i < 64; ++i) { const int p = F.pos[gt * 64 + i]; mn = p < mn ? p : mn; mx = p > mx ? p : mx; }
        int* mm = WSP(int, WS_POSMM); mm[gt * 2] = mn; mm[gt * 2 + 1] = mx; }
}
template <bool XBF> __device__ __forceinline__ void ph_norm(Frame& F, int l, const void* xsrc, int sh_off, int sc_off) {
    const float* mod = WSP(float, WS_MOD) + (size_t)l * 12 * D; bf16* H = WSP(bf16, WS_H);
    for (int row = F.gw; row < M; row += F.ngw) {
        const int b = row >> 13;
        const float* mb = mod + (size_t)b * 6 * D;
        if constexpr (XBF) {
            const v4u* xr = (const v4u*)((const bf16*)xsrc + (size_t)row * D) + F.lane;
            v4u w[4]; float v[4][8]; float s = 0.f;
#pragma unroll
            for (int j = 0; j < 4; ++j) w[j] = xr[64 * j];
#pragma unroll
            for (int j = 0; j < 4; ++j) { const unsigned ww[4] = {w[j].x, w[j].y, w[j].z, w[j].w};
#pragma unroll
                for (int q = 0; q < 4; ++q) { v[j][2 * q] = pg8::uph_lo(ww[q]); v[j][2 * q + 1] = pg8::uph_hi(ww[q]); s += v[j][2 * q] * v[j][2 * q] + v[j][2 * q + 1] * v[j][2 * q + 1]; } }
            const float r = rsqrtf(wave_sum(s) * (1.f / D) + EPS);
            v4u* o16 = (v4u*)(H + (size_t)row * D) + F.lane;
#pragma unroll
            for (int j = 0; j < 4; ++j) { const int c = 8 * F.lane + 512 * j;
                const f32x4 sc0 = *(const f32x4*)(mb + sc_off + c), sc1 = *(const f32x4*)(mb + sc_off + c + 4), sh0 = *(const f32x4*)(mb + sh_off + c), sh1 = *(const f32x4*)(mb + sh_off + c + 4);
                v4u o; o.x = pk2(v[j][0] * r * (1.0f + sc0.x) + sh0.x, v[j][1] * r * (1.0f + sc0.y) + sh0.y); o.y = pk2(v[j][2] * r * (1.0f + sc0.z) + sh0.z, v[j][3] * r * (1.0f + sc0.w) + sh0.w);
                o.z = pk2(v[j][4] * r * (1.0f + sc1.x) + sh1.x, v[j][5] * r * (1.0f + sc1.y) + sh1.y); o.w = pk2(v[j][6] * r * (1.0f + sc1.z) + sh1.z, v[j][7] * r * (1.0f + sc1.w) + sh1.w);
                o16[64 * j] = o; }
        } else {
        const f32x4* xr = (const f32x4*)((const float*)xsrc + (size_t)row * D) + F.lane;
        f32x4 v[8]; float s = 0.f;
#pragma unroll
        for (int j = 0; j < 8; ++j) { v[j] = xr[64 * j]; s += (v[j].x * v[j].x + v[j].y * v[j].y) + (v[j].z * v[j].z + v[j].w * v[j].w); }
        const float r = rsqrtf(wave_sum(s) * (1.f / D) + EPS);
        unsigned long long* o8 = (unsigned long long*)(H + (size_t)row * D) + F.lane;
#pragma unroll
        for (int j = 0; j < 8; ++j) { const int c = 4 * F.lane + 256 * j;
            const f32x4 sc = *(const f32x4*)(mb + sc_off + c), sh = *(const f32x4*)(mb + sh_off + c);
            const f32x4 y = v[j] * r * (1.0f + sc) + sh;
            o8[64 * j] = (unsigned long long)pk2(y.x, y.y) | ((unsigned long long)pk2(y.z, y.w) << 32); }
        }
    }
}

namespace fa {
#ifndef PIPE_MLA
#define PIPE_MLA 1
#endif
#ifndef PIPE_LIN
#define PIPE_LIN 0
#endif
#ifndef PIPE_GEN
#define PIPE_GEN 0
#endif
#ifndef PIPE_OLD64
#define PIPE_OLD64 0
#endif
template <typename T> __device__ __forceinline__ T ldg(const void* base, unsigned off) { return *(const T*)((const char*)base + off); }
template <typename T> __device__ __forceinline__ void stg(void* base, unsigned off, T v) { *(T*)((char*)base + off) = v; }
constexpr int crowc(int r) { return (r & 3) + 8 * (r >> 2); }
using s16x4 = __attribute__((ext_vector_type(4))) short;
using f32x8 = __attribute__((ext_vector_type(8))) float;
constexpr int QBLK = 32, KVBLK = 64, DV = 128;
constexpr int SHM_V = KVBLK * DV * 2;
constexpr float THR = 11.5f;
#define FA_SBAR() __builtin_amdgcn_sched_barrier(0)
__device__ __forceinline__ unsigned cvtpk(float lo, float hi) { unsigned r; asm volatile("v_cvt_pk_bf16_f32 %0, %1, %2" : "=v"(r) : "v"(lo), "v"(hi)); return r; }
__device__ __forceinline__ int kswz(int row, int colB) { return (colB >> 7) * 8192 + row * 128 + ((colB & 127) ^ (((row >> 1) & 7) << 4)); }
__device__ __forceinline__ int v_st(int k, int c) { const int kk = (k & ~0xC) | ((k & 4) << 1) | ((k & 8) >> 1); return ((kk >> 3) * 4 + (c >> 5)) * 512 + ((kk & 7) * 32 + (c & 31)) * 2; }
__device__ __forceinline__ int v_st_nat(int k, int c) { return ((k >> 3) * 4 + (c >> 5)) * 512 + ((k & 7) * 32 + (c & 31)) * 2; }
__device__ __forceinline__ int v_rd_base(int lane) { return ((lane & 3) << 3) | (((lane >> 2) & 3) << 6) | (((lane >> 4) & 1) << 5) | (((lane >> 5) & 1) << 8); }
constexpr int v_rd_off(int d0, int ks, int half) { return d0 * 512 + ks * 4096 + half * 2048; }
template <int OFF> __device__ __forceinline__ s16x4 tr_read(int vb) { s16x4 r; asm volatile("ds_read_b64_tr_b16 %0, %1 offset:%2" : "=&v"(r) : "v"(vb), "i"(OFF) : "memory"); return r; }
template <int D0> __device__ __forceinline__ void pv_one(f32x16& od, int vb, bf16x8 pa0, bf16x8 pa1, bf16x8 pa2, bf16x8 pa3) {
    const s16x4 l0 = tr_read<v_rd_off(D0, 0, 0)>(vb), h0 = tr_read<v_rd_off(D0, 0, 1)>(vb), l1 = tr_read<v_rd_off(D0, 1, 0)>(vb), h1 = tr_read<v_rd_off(D0, 1, 1)>(vb);
    const s16x4 l2 = tr_read<v_rd_off(D0, 2, 0)>(vb), h2 = tr_read<v_rd_off(D0, 2, 1)>(vb), l3 = tr_read<v_rd_off(D0, 3, 0)>(vb), h3 = tr_read<v_rd_off(D0, 3, 1)>(vb);
    asm volatile("s_waitcnt lgkmcnt(0)" ::: "memory"); FA_SBAR();
#define FA_PK(L, H) (bf16x8){L[0], L[1], L[2], L[3], H[0], H[1], H[2], H[3]}
    od = __builtin_amdgcn_mfma_f32_32x32x16_bf16(pa0, FA_PK(l0, h0), od, 0, 0, 0);
    od = __builtin_amdgcn_mfma_f32_32x32x16_bf16(pa1, FA_PK(l1, h1), od, 0, 0, 0);
    od = __builtin_amdgcn_mfma_f32_32x32x16_bf16(pa2, FA_PK(l2, h2), od, 0, 0, 0);
    od = __builtin_amdgcn_mfma_f32_32x32x16_bf16(pa3, FA_PK(l3, h3), od, 0, 0, 0);
#undef FA_PK
}
__device__ __forceinline__ void pv_d0(f32x16* o, int vb, bf16x8 pa0, bf16x8 pa1, bf16x8 pa2, bf16x8 pa3) {
    pv_one<0>(o[0], vb, pa0, pa1, pa2, pa3); pv_one<1>(o[1], vb, pa0, pa1, pa2, pa3); pv_one<2>(o[2], vb, pa0, pa1, pa2, pa3); pv_one<3>(o[3], vb, pa0, pa1, pa2, pa3);
}
template <int D0> __device__ __forceinline__ void pv_reads(s16x4 (&l)[4], s16x4 (&h)[4], int vb) {
    l[0] = tr_read<v_rd_off(D0, 0, 0)>(vb); h[0] = tr_read<v_rd_off(D0, 0, 1)>(vb); l[1] = tr_read<v_rd_off(D0, 1, 0)>(vb); h[1] = tr_read<v_rd_off(D0, 1, 1)>(vb);
    l[2] = tr_read<v_rd_off(D0, 2, 0)>(vb); h[2] = tr_read<v_rd_off(D0, 2, 1)>(vb); l[3] = tr_read<v_rd_off(D0, 3, 0)>(vb); h[3] = tr_read<v_rd_off(D0, 3, 1)>(vb);
}
__device__ __forceinline__ void pv_mfma(f32x16& od, const s16x4 (&l)[4], const s16x4 (&h)[4], bf16x8 pa0, bf16x8 pa1, bf16x8 pa2, bf16x8 pa3) {
#define FA_PK(L, H) (bf16x8){L[0], L[1], L[2], L[3], H[0], H[1], H[2], H[3]}
    od = __builtin_amdgcn_mfma_f32_32x32x16_bf16(pa0, FA_PK(l[0], h[0]), od, 0, 0, 0);
    od = __builtin_amdgcn_mfma_f32_32x32x16_bf16(pa1, FA_PK(l[1], h[1]), od, 0, 0, 0);
    od = __builtin_amdgcn_mfma_f32_32x32x16_bf16(pa2, FA_PK(l[2], h[2]), od, 0, 0, 0);
    od = __builtin_amdgcn_mfma_f32_32x32x16_bf16(pa3, FA_PK(l[3], h[3]), od, 0, 0, 0);
#undef FA_PK
}
__device__ __forceinline__ void pv_d0_pipe(f32x16* o, int vb, bf16x8 pa0, bf16x8 pa1, bf16x8 pa2, bf16x8 pa3) {
    s16x4 la[4], ha[4], lb[4], hb[4];
    pv_reads<0>(la, ha, vb); pv_reads<1>(lb, hb, vb);
    asm volatile("s_waitcnt lgkmcnt(8)" ::: "memory"); FA_SBAR(); pv_mfma(o[0], la, ha, pa0, pa1, pa2, pa3); FA_SBAR();
    pv_reads<2>(la, ha, vb);
    asm volatile("s_waitcnt lgkmcnt(8)" ::: "memory"); FA_SBAR(); pv_mfma(o[1], lb, hb, pa0, pa1, pa2, pa3); FA_SBAR();
    pv_reads<3>(lb, hb, vb);
    asm volatile("s_waitcnt lgkmcnt(8)" ::: "memory"); FA_SBAR(); pv_mfma(o[2], la, ha, pa0, pa1, pa2, pa3); FA_SBAR();
    asm volatile("s_waitcnt lgkmcnt(0)" ::: "memory"); FA_SBAR(); pv_mfma(o[3], lb, hb, pa0, pa1, pa2, pa3);
}
__device__ __forceinline__ void partialSM(f32x16& p0, f32x16& p1, float& m_reg, float& alpha) {
    float pmax = p0[0];
#pragma unroll
    for (int r = 1; r < 16; ++r) pmax = fmaxf(pmax, p0[r]);
#pragma unroll
    for (int r = 0; r < 16; ++r) pmax = fmaxf(pmax, p1[r]);
    { auto rr = __builtin_amdgcn_permlane32_swap(__float_as_uint(pmax), __float_as_uint(pmax), false, false); pmax = fmaxf(__uint_as_float(rr[0]), __uint_as_float(rr[1])); }
    float mn;
    if (__builtin_expect(__all(pmax - m_reg <= THR), 1)) { mn = m_reg; alpha = 1.f; }
    else { mn = fmaxf(m_reg, pmax); alpha = __builtin_amdgcn_exp2f(m_reg - mn); m_reg = mn; }
#pragma unroll
    for (int r = 0; r < 16; ++r) { p0[r] -= mn; p1[r] -= mn; }
#pragma unroll
    for (int r = 0; r < 16; ++r) p0[r] = __builtin_amdgcn_exp2f(p0[r]);
}
__device__ __forceinline__ void finishSM(f32x16& p0, f32x16& p1, float alpha, float& l_reg, bf16x8& pa0, bf16x8& pa1, bf16x8& pa2, bf16x8& pa3) {
#pragma unroll
    for (int r = 0; r < 16; ++r) p1[r] = __builtin_amdgcn_exp2f(p1[r]);
    float ps = 0;
#pragma unroll
    for (int r = 0; r < 16; ++r) ps += p0[r];
#pragma unroll
    for (int r = 0; r < 16; ++r) ps += p1[r];
    { auto rr = __builtin_amdgcn_permlane32_swap(__float_as_uint(ps), __float_as_uint(ps), false, false); ps = __uint_as_float(rr[0]) + __uint_as_float(rr[1]); }
    l_reg = l_reg * alpha + ps;
#define FA_PK4(P, BASE, OUT) do { unsigned a0 = cvtpk(P[BASE + 0], P[BASE + 1]), a1 = cvtpk(P[BASE + 2], P[BASE + 3]);   \
    unsigned b0 = cvtpk(P[BASE + 4], P[BASE + 5]), b1 = cvtpk(P[BASE + 6], P[BASE + 7]);                              \
    auto r0 = __builtin_amdgcn_permlane32_swap(a0, b0, false, false); auto r1 = __builtin_amdgcn_permlane32_swap(a1, b1, false, false); \
    u32x4_t w = {r0[0], r1[0], r0[1], r1[1]}; OUT = __builtin_bit_cast(bf16x8, w); } while (0)
    typedef unsigned u32x4_t __attribute__((ext_vector_type(4)));
    FA_PK4(p0, 0, pa0); FA_PK4(p0, 8, pa1); FA_PK4(p1, 0, pa2); FA_PK4(p1, 8, pa3);
#undef FA_PK4
}
template <bool ALIBI> __device__ __forceinline__ void fr_init(f32x16& p0, f32x16& p1, const LAS float* posl, float posq, float slope2, bool linear, int hi) {
    if (linear) {
        const float cl = -slope2 * posq;
#pragma unroll
        for (int g = 0; g < 4; ++g) { const f32x4 k0 = *(const LAS f32x4*)(posl + 8 * g + 4 * hi), k1 = *(const LAS f32x4*)(posl + 32 + 8 * g + 4 * hi);
#pragma unroll
            for (int e = 0; e < 4; ++e) { p0[4 * g + e] = fmaf(slope2, k0[e], cl); p1[4 * g + e] = fmaf(slope2, k1[e], cl); } }
    } else {
#pragma unroll
        for (int g = 0; g < 4; ++g) { const f32x4 k0 = *(const LAS f32x4*)(posl + 8 * g + 4 * hi), k1 = *(const LAS f32x4*)(posl + 32 + 8 * g + 4 * hi);
#pragma unroll
            for (int e = 0; e < 4; ++e) { p0[4 * g + e] = -slope2 * fabsf(posq - k0[e]); p1[4 * g + e] = -slope2 * fabsf(posq - k1[e]); } }
    }
}
__device__ __forceinline__ void fr_softmax(f32x16& p0, f32x16& p1, float& l_reg, bf16x8& pa0, bf16x8& pa1, bf16x8& pa2, bf16x8& pa3) {
#pragma unroll
    for (int r = 0; r < 16; ++r) { p0[r] = __builtin_amdgcn_exp2f(p0[r]); p1[r] = __builtin_amdgcn_exp2f(p1[r]); }
    float sa = 0.f, sb = 0.f;
#pragma unroll
    for (int r = 0; r < 16; ++r) { sa += p0[r]; sb += p1[r]; }
    l_reg += sa + sb;
    typedef unsigned u32x4_t __attribute__((ext_vector_type(4)));
#define FA_PKS(P, BASE, OUT) do { u32x4_t w = {cvtpk(P[BASE + 0], P[BASE + 1]), cvtpk(P[BASE + 2], P[BASE + 3]), cvtpk(P[BASE + 4], P[BASE + 5]), cvtpk(P[BASE + 6], P[BASE + 7])}; OUT = __builtin_bit_cast(bf16x8, w); } while (0)
    FA_PKS(p0, 0, pa0); FA_PKS(p0, 8, pa1); FA_PKS(p1, 0, pa2); FA_PKS(p1, 8, pa3);
#undef FA_PKS
}
template <int DQK> struct Lds {
    static constexpr int SHM_K = KVBLK * DQK * 2;
    static constexpr int V_OFF = 0, K_OFF = 2 * SHM_V, POS_OFF = K_OFF + 2 * SHM_K, WS_OFF = POS_OFF + 2 * 256, END = WS_OFF + 8 * 256;
};
template <int DQK, bool INIT = true> __device__ __forceinline__ void qkt(f32x16& p0, f32x16& p1, const LAS unsigned char* Ks, const bf16x8* qr, int r32, int hi) {
    if (INIT) { p0 = f32x16{}; p1 = f32x16{}; }
#pragma unroll
    for (int d0 = 0; d0 < DQK / 16; ++d0) { const int cb = (d0 * 16 + hi * 8) * 2;
        const bf16x8 b0 = *(const LAS bf16x8*)(Ks + kswz(r32, cb));
        const bf16x8 b1 = *(const LAS bf16x8*)(Ks + kswz(32 + r32, cb));
        p0 = __builtin_amdgcn_mfma_f32_32x32x16_bf16(b0, qr[d0], p0, 0, 0, 0);
        p1 = __builtin_amdgcn_mfma_f32_32x32x16_bf16(b1, qr[d0], p1, 0, 0, 0);
        if (DQK > 64 && (d0 & 3) == 3) FA_SBAR(); }
}
template <int OFF> __device__ __forceinline__ bf16x8 k_read(int addr) { bf16x8 r; asm volatile("ds_read_b128 %0, %1 offset:%2" : "=&v"(r) : "v"(addr), "i"(OFF) : "memory"); return r; }
__device__ __forceinline__ void k_bases(int (&ka)[4], const LAS unsigned char* K_lds, int r32, int hi) {
#pragma unroll
    for (int j = 0; j < 4; ++j) ka[j] = (int)(uintptr_t)K_lds + r32 * 128 + ((j * 32 + hi * 16) ^ (((r32 >> 1) & 7) << 4));
}
#define FA_LGK(n) asm volatile("s_waitcnt lgkmcnt(" #n ")" ::: "memory")
template <int DQK, int BOFF, int VAR = 0> __device__ __forceinline__ void qkt_pipe(f32x16& p0, f32x16& p1, const int (&ka)[4], const bf16x8* qr) {
    if constexpr (DQK == 64) {
        bf16x8 a0 = k_read<BOFF>(ka[0]), b0 = k_read<BOFF + 4096>(ka[0]), a1 = k_read<BOFF>(ka[1]), b1 = k_read<BOFF + 4096>(ka[1]);
        bf16x8 a2 = k_read<BOFF>(ka[2]), b2 = k_read<BOFF + 4096>(ka[2]), a3 = k_read<BOFF>(ka[3]), b3 = k_read<BOFF + 4096>(ka[3]);
        FA_LGK(6); FA_SBAR(); p0 = __builtin_amdgcn_mfma_f32_32x32x16_bf16(a0, qr[0], p0, 0, 0, 0); p1 = __builtin_amdgcn_mfma_f32_32x32x16_bf16(b0, qr[0], p1, 0, 0, 0); FA_SBAR();
        FA_LGK(4); FA_SBAR(); p0 = __builtin_amdgcn_mfma_f32_32x32x16_bf16(a1, qr[1], p0, 0, 0, 0); p1 = __builtin_amdgcn_mfma_f32_32x32x16_bf16(b1, qr[1], p1, 0, 0, 0); FA_SBAR();
        FA_LGK(2); FA_SBAR(); p0 = __builtin_amdgcn_mfma_f32_32x32x16_bf16(a2, qr[2], p0, 0, 0, 0); p1 = __builtin_amdgcn_mfma_f32_32x32x16_bf16(b2, qr[2], p1, 0, 0, 0); FA_SBAR();
        FA_LGK(0); FA_SBAR(); p0 = __builtin_amdgcn_mfma_f32_32x32x16_bf16(a3, qr[3], p0, 0, 0, 0); p1 = __builtin_amdgcn_mfma_f32_32x32x16_bf16(b3, qr[3], p1, 0, 0, 0); FA_SBAR();
    } else {
        static_assert(DQK == 192, "qkt_pipe: d = 64 or 192");
#define FA_KG(G, x0, y0, x1, y1) do { x0 = k_read<BOFF + ((2 * (G)) >> 2) * 8192>(ka[(2 * (G)) & 3]); y0 = k_read<BOFF + ((2 * (G)) >> 2) * 8192 + 4096>(ka[(2 * (G)) & 3]); \
        x1 = k_read<BOFF + ((2 * (G) + 1) >> 2) * 8192>(ka[(2 * (G) + 1) & 3]); y1 = k_read<BOFF + ((2 * (G) + 1) >> 2) * 8192 + 4096>(ka[(2 * (G) + 1) & 3]); } while (0)
#define FA_KM(G, x0, y0, x1, y1) do { FA_SBAR(); if (VAR == 6) { p0 = __builtin_amdgcn_mfma_f32_32x32x16_bf16(x0 ^ y0 ^ x1 ^ y1, qr[2 * (G)], p0, 0, 0, 0); } else { \
        p0 = __builtin_amdgcn_mfma_f32_32x32x16_bf16(x0, qr[2 * (G)], p0, 0, 0, 0); p1 = __builtin_amdgcn_mfma_f32_32x32x16_bf16(y0, qr[2 * (G)], p1, 0, 0, 0); \
        p0 = __builtin_amdgcn_mfma_f32_32x32x16_bf16(x1, qr[2 * (G) + 1], p0, 0, 0, 0); p1 = __builtin_amdgcn_mfma_f32_32x32x16_bf16(y1, qr[2 * (G) + 1], p1, 0, 0, 0); } FA_SBAR(); } while (0)
        bf16x8 a0, b0, a1, b1, c0, d0, c1, d1;
        if constexpr (VAR == 5) {
#pragma unroll
            for (int g = 0; g < 12; ++g) { FA_SBAR(); p0 = __builtin_amdgcn_mfma_f32_32x32x16_bf16(qr[(g + 1) % 12], qr[g], p0, 0, 0, 0); p1 = __builtin_amdgcn_mfma_f32_32x32x16_bf16(qr[(g + 5) % 12], qr[g], p1, 0, 0, 0); FA_SBAR(); }
            return; }
        FA_KG(0, a0, b0, a1, b1); FA_KG(1, c0, d0, c1, d1);
        FA_LGK(4); FA_KM(0, a0, b0, a1, b1); FA_KG(2, a0, b0, a1, b1);
        FA_LGK(4); FA_KM(1, c0, d0, c1, d1); FA_KG(3, c0, d0, c1, d1);
        FA_LGK(4); FA_KM(2, a0, b0, a1, b1); FA_KG(4, a0, b0, a1, b1);
        FA_LGK(4); FA_KM(3, c0, d0, c1, d1); FA_KG(5, c0, d0, c1, d1);
        FA_LGK(4); FA_KM(4, a0, b0, a1, b1);
        FA_LGK(0); FA_KM(5, c0, d0, c1, d1);
#undef FA_KG
#undef FA_KM
    }
}
template <bool ALIBI> __device__ __forceinline__ void fixup(f32x16& p0, f32x16& p1, const LAS float* posl, float posq, float slope2, bool masked, int hi) {
    if (ALIBI) {
#pragma unroll
        for (int g = 0; g < 4; ++g) { const f32x4 k0 = *(const LAS f32x4*)(posl + 8 * g + 4 * hi), k1 = *(const LAS f32x4*)(posl + 32 + 8 * g + 4 * hi);
#pragma unroll
            for (int e = 0; e < 4; ++e) { p0[4 * g + e] = fmaf(-slope2, fabsf(posq - k0[e]), p0[4 * g + e]); p1[4 * g + e] = fmaf(-slope2, fabsf(posq - k1[e]), p1[4 * g + e]); } }
    }
    if (masked) {
#pragma unroll
        for (int r = 0; r < 16; ++r) { p0[r] = -INFINITY; p1[r] = -INFINITY; }
    }
}
template <int DQK, bool ALIBI, int NSLOT, int MODE = 0, int VAR = 0>
__device__ __forceinline__ void attn_pass(const bf16* __restrict__ Qb, const bf16* __restrict__ Kh, const bf16* __restrict__ Vh, const int* __restrict__ posb, float slope2, float cref, int TL, int q0, int T0, int NT,
                                          LAS unsigned char* lds, int tid_, f32x16 (&o)[4], float& l_out) {
    typedef Lds<DQK> L; constexpr int KSUB = DQK / 64, SHM_K = L::SHM_K;
    const int wid = __builtin_amdgcn_readfirstlane(tid_ >> 6); int lane; asm volatile("v_mbcnt_lo_u32_b32 %0, -1, 0\n\tv_mbcnt_hi_u32_b32 %0, -1, %0" : "=v"(lane));
    const int tid = wid * 64 + lane, r32 = lane & 31, hi = lane >> 5;
    if (wid >= 4) __builtin_amdgcn_s_setprio(1);
    LAS unsigned char* V_lds = lds + L::V_OFF; LAS unsigned char* K_lds = lds + L::K_OFF; LAS float* P_lds = (LAS float*)(lds + L::POS_OFF);
    LAS float* al_l = (LAS float*)(lds + L::WS_OFF) + wid * 64;
    float m_reg = -1e30f, l_reg = 0.f;
#pragma unroll
    for (int d = 0; d < 4; ++d) o[d] = f32x16{};
    bf16x8 qr[DQK / 16];
    { const bf16* Qw = Qb + (size_t)(wid * QBLK) * DQK; unsigned qgo = (unsigned)(r32 * DQK + hi * 8) * 2u; asm volatile("" : "+v"(qgo));
#pragma unroll
      for (int d0 = 0; d0 < DQK / 16; ++d0) qr[d0] = ldg<bf16x8>(Qw + d0 * 16, qgo); }
    const float posq = ALIBI ? (float)posb[q0 + wid * QBLK + r32] : 0.f;
    const int tmax = NT - 4 + (wid >> 1);
    const int sr = tid >> 4, sc = (tid & 15) * 8, vst0 = MODE == 5 ? v_st_nat(sr, sc) : v_st(sr, sc), vst1 = MODE == 5 ? v_st_nat(32 + sr, sc) : v_st(32 + sr, sc);
    const int kr = tid >> 3, kc = (tid & 7) * 8, kst = kswz(kr, kc * 2);
    unsigned vgo = (unsigned)(sr * DV + sc) * 2u, kgo = (unsigned)(kr * DQK + kc) * 2u, pgo = (unsigned)(tid & 63) * 4u; asm volatile("" : "+v"(vgo), "+v"(kgo), "+v"(pgo));
    const int vb0 = (int)(uintptr_t)V_lds + v_rd_base(lane);
    int ka[4]; k_bases(ka, K_lds, r32, hi);
    struct Slot { bf16x8 vs0, vs1, ks[KSUB]; int ps; } sl_[NSLOT];
#define FA_SLOAD(i, k0) do { unsigned kk_ = (unsigned)__builtin_amdgcn_readfirstlane((int)(k0)); asm volatile("" : "+s"(kk_));     \
    const bf16* Vt_ = Vh + (size_t)kk_ * DV; const bf16* Kt_ = Kh + (size_t)kk_ * DQK; \
    sl_[i].vs0 = ldg<bf16x8>(Vt_, vgo); sl_[i].vs1 = ldg<bf16x8>(Vt_ + 32 * DV, vgo); \
    _Pragma("unroll") for (int s_ = 0; s_ < KSUB; ++s_) sl_[i].ks[s_] = ldg<bf16x8>(Kt_ + s_ * 64, kgo); \
    if (ALIBI) sl_[i].ps = ldg<int>(posb + kk_, pgo); } while (0)
#define FA_SWRITE(b, i) do { *(LAS bf16x8*)(V_lds + (b) * SHM_V + vst0) = sl_[i].vs0; *(LAS bf16x8*)(V_lds + (b) * SHM_V + vst1) = sl_[i].vs1; \
    _Pragma("unroll") for (int s_ = 0; s_ < KSUB; ++s_) *(LAS bf16x8*)(K_lds + (b) * SHM_K + s_ * 8192 + kst) = sl_[i].ks[s_]; \
    if (ALIBI) { if (tid < 64) P_lds[(b) * 64 + tid] = (float)sl_[i].ps; } } while (0)
#define FA_RESC(a) do { if (__any((a) < 1.f)) { if (hi == 0) al_l[r32] = (a); asm volatile("s_waitcnt lgkmcnt(0)" ::: "memory"); \
    _Pragma("unroll") for (int d = 0; d < 4; ++d) _Pragma("unroll") for (int r = 0; r < 16; ++r) o[d][r] *= al_l[crow(r, hi)]; } } while (0)
#define FA_COMPUTE(b, t, STAGE) do { bf16x8 pa0, pa1, pa2, pa3; const bool vis_ = (t) <= tmax;     \
    if (vis_) { f32x16 p0, p1; \
    if (MODE == 5) { if (VAR == 3) { p0 = f32x16{}; p1 = f32x16{}; _Pragma("unroll") for (int r_ = 0; r_ < 16; ++r_) { p0[r_] = l_reg; p1[r_] = l_reg; } } \
        else if ((DQK == 192 && PIPE_MLA) || (DQK == 64 && PIPE_OLD64)) { p0 = f32x16{}; p1 = f32x16{}; qkt_pipe<DQK, (b) * SHM_K, (VAR == 5 || VAR == 6) ? VAR : 0>(p0, p1, ka, qr); } else qkt<DQK, true>(p0, p1, K_lds + (b) * SHM_K, qr, r32, hi); fixup<ALIBI>(p0, p1, P_lds + (b) * 64, posq, slope2, false, hi); \
        if (VAR == 1) { l_reg += p0[0] + p1[5]; typedef unsigned u32x4_t __attribute__((ext_vector_type(4))); \
            u32x4_t w0_ = {cvtpk(p0[0], p0[1]), cvtpk(p0[2], p0[3]), cvtpk(p0[4], p0[5]), cvtpk(p0[6], p0[7])}, w1_ = {cvtpk(p0[8], p0[9]), cvtpk(p0[10], p0[11]), cvtpk(p0[12], p0[13]), cvtpk(p0[14], p0[15])}; \
            u32x4_t w2_ = {cvtpk(p1[0], p1[1]), cvtpk(p1[2], p1[3]), cvtpk(p1[4], p1[5]), cvtpk(p1[6], p1[7])}, w3_ = {cvtpk(p1[8], p1[9]), cvtpk(p1[10], p1[11]), cvtpk(p1[12], p1[13]), cvtpk(p1[14], p1[15])}; \
            pa0 = __builtin_bit_cast(bf16x8, w0_); pa1 = __builtin_bit_cast(bf16x8, w1_); pa2 = __builtin_bit_cast(bf16x8, w2_); pa3 = __builtin_bit_cast(bf16x8, w3_); } \
        else fr_softmax(p0, p1, l_reg, pa0, pa1, pa2, pa3); } \
    else { float alpha; qkt<DQK>(p0, p1, K_lds + (b) * SHM_K, qr, r32, hi); fixup<ALIBI>(p0, p1, P_lds + (b) * 64, posq, slope2, false, hi); \
        partialSM(p0, p1, m_reg, alpha); finishSM(p0, p1, alpha, l_reg, pa0, pa1, pa2, pa3); FA_RESC(alpha); } } \
    FA_SBAR(); STAGE; FA_SBAR();     \
    if (vis_) { \
    if (VAR == 2) { l_reg += __builtin_bit_cast(float, pa0[0] | (pa1[1] << 16)) + __builtin_bit_cast(float, pa2[0] | (pa3[1] << 16)); } else \
    if (MODE == 5 && DQK == 64) pv_d0_pipe(o, vb0 + (b) * SHM_V, pa0, pa1, pa2, pa3); else pv_d0(o, vb0 + (b) * SHM_V, pa0, pa1, pa2, pa3); } } while (0)
    constexpr int S1 = NSLOT - 1;
    FA_SLOAD(0, T0 * KVBLK); FA_SWRITE(0, 0); FA_SLOAD(S1, (T0 + 1) * KVBLK); FA_SWRITE(1, S1); FA_SLOAD(0, (T0 + 2) * KVBLK);
    if (NSLOT == 2) FA_SLOAD(1, (T0 + 3) * KVBLK);
    __syncthreads();
    static_assert(NSLOT == 1, "attn_pass: one staging slot");
    for (int j = T0; j < NT; j += 2) {
        FA_COMPUTE(0, j, { if (VAR != 4) if (j > T0) { FA_SWRITE(1, 0); if (j + 2 < NT) FA_SLOAD(0, (j + 2) * KVBLK); } });
        __syncthreads();
        FA_COMPUTE(1, j + 1, { if (VAR != 4) if (j + 2 < NT) { FA_SWRITE(0, 0); FA_SLOAD(0, (j + 3) * KVBLK); } });
        __syncthreads();
    }
    if (MODE == 5) { auto rr = __builtin_amdgcn_permlane32_swap(__float_as_uint(l_reg), __float_as_uint(l_reg), false, false); l_reg = __uint_as_float(rr[0]) + __uint_as_float(rr[1]); }
    __builtin_amdgcn_s_setprio(0);
    l_out = l_reg;
#undef FA_SLOAD
#undef FA_SWRITE
#undef FA_RESC
#undef FA_COMPUTE
}
template <int DQK> struct Lds3 {
    static constexpr int SHM_K = KVBLK * DQK * 2;
    static constexpr int V_OFF = 0, K_OFF = 3 * SHM_V, POS_OFF = K_OFF + 3 * SHM_K, WS_OFF = POS_OFF + 3 * 256, END = WS_OFF + 8 * 256;
};
template <int DQK, bool ALIBI>
__device__ __forceinline__ void attn_pass_stag(const bf16* __restrict__ Qb, const bf16* __restrict__ Kh, const bf16* __restrict__ Vh, const int* __restrict__ posb, float slope2, int q0, int T0, int NT,
                                               LAS unsigned char* lds, int tid, f32x16 (&o)[4], float& l_out) {
    typedef Lds3<DQK> L; constexpr int KSUB = DQK / 64, SHM_K = L::SHM_K;
    const int wid = __builtin_amdgcn_readfirstlane(tid >> 6), lane = tid & 63, r32 = lane & 31, hi = lane >> 5, grp = wid >> 2;
    LAS unsigned char* V_lds = lds + L::V_OFF; LAS unsigned char* K_lds = lds + L::K_OFF; LAS float* P_lds = (LAS float*)(lds + L::POS_OFF);
    float l_reg = 0.f;
#pragma unroll
    for (int d = 0; d < 4; ++d) o[d] = f32x16{};
    bf16x8 qr[DQK / 16];
    { const bf16* Qw = Qb + (size_t)(wid * QBLK) * DQK; unsigned qgo = (unsigned)(r32 * DQK + hi * 8) * 2u; asm volatile("" : "+v"(qgo));
#pragma unroll
      for (int d0 = 0; d0 < DQK / 16; ++d0) qr[d0] = ldg<bf16x8>(Qw + d0 * 16, qgo); }
    const float posq = ALIBI ? (float)posb[q0 + wid * QBLK + r32] : 0.f;
    const int tmax = NT - 4 + (wid >> 1);
    const int sr = tid >> 4, sc = (tid & 15) * 8, vst0 = v_st(sr, sc), vst1 = v_st(32 + sr, sc);
    const int kr = tid >> 3, kc = (tid & 7) * 8, kst = kswz(kr, kc * 2);
    unsigned vgo = (unsigned)(sr * DV + sc) * 2u, kgo = (unsigned)(kr * DQK + kc) * 2u, pgo = (unsigned)(tid & 63) * 4u; asm volatile("" : "+v"(vgo), "+v"(kgo), "+v"(pgo));
    const int vb0 = (int)(uintptr_t)V_lds + v_rd_base(lane);
    struct Slot { bf16x8 vs0, vs1, ks[KSUB]; int ps; } sl_;
#define FS_SLOAD(k0) do { unsigned kk_ = (unsigned)__builtin_amdgcn_readfirstlane((int)(k0)); asm volatile("" : "+s"(kk_)); \
    const bf16* Vt_ = Vh + (size_t)kk_ * DV; const bf16* Kt_ = Kh + (size_t)kk_ * DQK; \
    sl_.vs0 = ldg<bf16x8>(Vt_, vgo); sl_.vs1 = ldg<bf16x8>(Vt_ + 32 * DV, vgo); \
    _Pragma("unroll") for (int s_ = 0; s_ < KSUB; ++s_) sl_.ks[s_] = ldg<bf16x8>(Kt_ + s_ * 64, kgo); \
    if (ALIBI) sl_.ps = ldg<int>(posb + kk_, pgo); } while (0)
#define FS_SWRITE(b) do { *(LAS bf16x8*)(V_lds + (b) * SHM_V + vst0) = sl_.vs0; *(LAS bf16x8*)(V_lds + (b) * SHM_V + vst1) = sl_.vs1; \
    _Pragma("unroll") for (int s_ = 0; s_ < KSUB; ++s_) *(LAS bf16x8*)(K_lds + (b) * SHM_K + s_ * 8192 + kst) = sl_.ks[s_]; \
    if (ALIBI) { if (tid < 64) P_lds[(b) * 64 + tid] = (float)sl_.ps; } } while (0)
    const int nt = NT - T0;
    FS_SLOAD(T0 * KVBLK); FS_SWRITE(0); FS_SLOAD((T0 + 1) * KVBLK); FS_SWRITE(1); FS_SLOAD((T0 + 2) * KVBLK);
    __syncthreads();
#define FS_QKS(j_) do { int b_ = (j_) % 3; asm volatile("" : "+s"(b_)); f32x16 p0, p1; \
    qkt<DQK, true>(p0, p1, K_lds + b_ * SHM_K, qr, r32, hi); fixup<ALIBI>(p0, p1, P_lds + b_ * 64, posq, slope2, T0 + (j_) > tmax, hi); \
    fr_softmax(p0, p1, l_reg, pa0, pa1, pa2, pa3); } while (0)
#define FS_PV(j_) do { int b_ = (j_) % 3; asm volatile("" : "+s"(b_)); pv_d0(o, vb0 + b_ * SHM_V, pa0, pa1, pa2, pa3); } while (0)
#define FS_STAGE(j_) do { const int jn_ = (j_) + 2; if (jn_ < nt) { int bw_ = jn_ % 3; asm volatile("" : "+s"(bw_)); FS_SWRITE(bw_); if (jn_ + 1 < nt) FS_SLOAD((T0 + jn_ + 1) * KVBLK); } } while (0)
    bf16x8 pa0, pa1, pa2, pa3;
    if (grp == 0) {
        for (int j = 0; j < nt; ++j) { FS_QKS(j); __syncthreads(); FS_PV(j); __syncthreads(); FS_STAGE(j); }
        __syncthreads();
    } else {
        pa0 = bf16x8{}; pa1 = bf16x8{}; pa2 = bf16x8{}; pa3 = bf16x8{};
        for (int j = 0; j < nt; ++j) { if (j > 0) FS_PV(j - 1); __syncthreads(); FS_QKS(j); __syncthreads(); FS_STAGE(j); }
        FS_PV(nt - 1); __syncthreads();
    }
#undef FS_QKS
#undef FS_PV
#undef FS_STAGE
    { auto rr = __builtin_amdgcn_permlane32_swap(__float_as_uint(l_reg), __float_as_uint(l_reg), false, false); l_reg = __uint_as_float(rr[0]) + __uint_as_float(rr[1]); }
    l_out = l_reg;
#undef FS_SLOAD
#undef FS_SWRITE
}
template <int DQK, bool ALIBI>
__device__ __forceinline__ void attn_pass_p2(const bf16* __restrict__ Qb, const bf16* __restrict__ Kh, const bf16* __restrict__ Vh, const int* __restrict__ posb, float slope2, int q0, int T0, int NT,
                                             LAS unsigned char* lds, int tid, f32x16 (&o)[4], float& l_out) {
    typedef Lds<DQK> L; constexpr int KSUB = DQK / 64, SHM_K = L::SHM_K;
    const int wid = __builtin_amdgcn_readfirstlane(tid >> 6), lane = tid & 63, r32 = lane & 31, hi = lane >> 5;
    LAS unsigned char* V_lds = lds + L::V_OFF; LAS unsigned char* K_lds = lds + L::K_OFF; LAS float* P_lds = (LAS float*)(lds + L::POS_OFF);
    float l_reg = 0.f;
#pragma unroll
    for (int d = 0; d < 4; ++d) o[d] = f32x16{};
    bf16x8 qr[DQK / 16];
    { const bf16* Qw = Qb + (size_t)(wid * QBLK) * DQK; unsigned qgo = (unsigned)(r32 * DQK + hi * 8) * 2u; asm volatile("" : "+v"(qgo));
#pragma unroll
      for (int d0 = 0; d0 < DQK / 16; ++d0) qr[d0] = ldg<bf16x8>(Qw + d0 * 16, qgo); }
    const float posq = ALIBI ? (float)posb[q0 + wid * QBLK + r32] : 0.f;
    const int tmax = NT - 4 + (wid >> 1);
    const int sr = tid >> 4, sc = (tid & 15) * 8, vst0 = v_st(sr, sc), vst1 = v_st(32 + sr, sc);
    const int kr = tid >> 3, kc = (tid & 7) * 8, kst = kswz(kr, kc * 2);
    unsigned vgo = (unsigned)(sr * DV + sc) * 2u, kgo = (unsigned)(kr * DQK + kc) * 2u, pgo = (unsigned)(tid & 63) * 4u; asm volatile("" : "+v"(vgo), "+v"(kgo), "+v"(pgo));
    const int vb0 = (int)(uintptr_t)V_lds + v_rd_base(lane);
    struct Slot { bf16x8 vs0, vs1, ks[KSUB]; int ps; } sl_;
#define FP_LOADK(t) do { unsigned kk_ = (unsigned)__builtin_amdgcn_readfirstlane((int)((t) * KVBLK)); asm volatile("" : "+s"(kk_)); const bf16* Kt_ = Kh + (size_t)kk_ * DQK; \
    _Pragma("unroll") for (int s_ = 0; s_ < KSUB; ++s_) sl_.ks[s_] = ldg<bf16x8>(Kt_ + s_ * 64, kgo); if (ALIBI) sl_.ps = ldg<int>(posb + kk_, pgo); } while (0)
#define FP_LOADV(t) do { unsigned kk_ = (unsigned)__builtin_amdgcn_readfirstlane((int)((t) * KVBLK)); asm volatile("" : "+s"(kk_)); const bf16* Vt_ = Vh + (size_t)kk_ * DV; \
    sl_.vs0 = ldg<bf16x8>(Vt_, vgo); sl_.vs1 = ldg<bf16x8>(Vt_ + 32 * DV, vgo); } while (0)
#define FP_WRITEK(b) do { _Pragma("unroll") for (int s_ = 0; s_ < KSUB; ++s_) *(LAS bf16x8*)(K_lds + (b) * SHM_K + s_ * 8192 + kst) = sl_.ks[s_]; \
    if (ALIBI) { if (tid < 64) P_lds[(b) * 64 + tid] = (float)sl_.ps; } } while (0)
#define FP_WRITEV(b) do { *(LAS bf16x8*)(V_lds + (b) * SHM_V + vst0) = sl_.vs0; *(LAS bf16x8*)(V_lds + (b) * SHM_V + vst1) = sl_.vs1; } while (0)
#define FP_QK(P0, P1, b, t) do { qkt<DQK, true>(P0, P1, K_lds + (b) * SHM_K, qr, r32, hi); fixup<ALIBI>(P0, P1, P_lds + (b) * 64, posq, slope2, (t) > tmax, hi); } while (0)
    f32x16 pA0, pA1, pB0, pB1; bf16x8 pa0, pa1, pa2, pa3;
    const int nt = NT - T0;
    FP_LOADK(T0); FP_LOADV(T0); FP_WRITEK(0); FP_WRITEV(0); FP_LOADK(T0 + 1); FP_WRITEK(1); FP_LOADK(T0 + 2); FP_LOADV(T0 + 1);
    __syncthreads();
    FP_QK(pA0, pA1, 0, T0);
    __syncthreads();
    for (int r = 0; r < nt; r += 2) {
        if (r + 2 < nt) FP_WRITEK(0);
        FP_WRITEV(1);
        if (r + 3 < nt) FP_LOADK(T0 + r + 3);
        if (r + 2 < nt) FP_LOADV(T0 + r + 2);
        FA_SBAR(); FP_QK(pB0, pB1, 1, T0 + r + 1);
        fr_softmax(pA0, pA1, l_reg, pa0, pa1, pa2, pa3); FA_SBAR();
        pv_d0(o, vb0, pa0, pa1, pa2, pa3);
        __syncthreads();
        if (r + 3 < nt) FP_WRITEK(1);
        if (r + 2 < nt) FP_WRITEV(0);
        if (r + 4 < nt) FP_LOADK(T0 + r + 4);
        if (r + 3 < nt) FP_LOADV(T0 + r + 3);
        FA_SBAR(); if (r + 2 < nt) FP_QK(pA0, pA1, 0, T0 + r + 2);
        fr_softmax(pB0, pB1, l_reg, pa0, pa1, pa2, pa3); FA_SBAR();
        pv_d0(o, vb0 + SHM_V, pa0, pa1, pa2, pa3);
        __syncthreads();
    }
    { auto rr = __builtin_amdgcn_permlane32_swap(__float_as_uint(l_reg), __float_as_uint(l_reg), false, false); l_reg = __uint_as_float(rr[0]) + __uint_as_float(rr[1]); }
    l_out = l_reg;
#undef FP_LOADK
#undef FP_LOADV
#undef FP_WRITEK
#undef FP_WRITEV
#undef FP_QK
}
template <int DQK, bool ALIBI>
__device__ __forceinline__ void attn_pass_dma(const bf16* __restrict__ Qb, const bf16* __restrict__ Kh, const bf16* __restrict__ Vh, const int* __restrict__ posb, const float* __restrict__ posfb,
                                              float slope2, int q0, int T0, int NT, LAS unsigned char* lds, int tid_, f32x16 (&o)[4], float& l_out) {
    typedef Lds3<DQK> L; constexpr int KSUB = DQK / 64, SHM_K = L::SHM_K, NPT = KSUB + 2 + (ALIBI ? 1 : 0);
    const int wid = __builtin_amdgcn_readfirstlane(tid_ >> 6); int lane; asm volatile("v_mbcnt_lo_u32_b32 %0, -1, 0\n\tv_mbcnt_hi_u32_b32 %0, -1, %0" : "=v"(lane));
    const int r32 = lane & 31, hi = lane >> 5;
    LAS unsigned char* V_lds = lds + L::V_OFF; LAS unsigned char* K_lds = lds + L::K_OFF; LAS float* P_lds = (LAS float*)(lds + L::POS_OFF);
    float l_reg = 0.f;
#pragma unroll
    for (int d = 0; d < 4; ++d) o[d] = f32x16{};
    bf16x8 qr[DQK / 16];
    { const bf16* Qw = Qb + (size_t)(wid * QBLK) * DQK; unsigned qgo = (unsigned)(r32 * DQK + hi * 8) * 2u; asm volatile("" : "+v"(qgo));
#pragma unroll
      for (int d0 = 0; d0 < DQK / 16; ++d0) qr[d0] = ldg<bf16x8>(Qw + d0 * 16, qgo); }
    const float posq = ALIBI ? (float)posb[q0 + wid * QBLK + r32] : 0.f;
    const int tmax = NT - 4 + (wid >> 1);
    unsigned ksrc, vsrc, psrc;
    { const int kr = 8 * wid + (lane >> 3), kc = (lane & 7) ^ ((kr >> 1) & 7); ksrc = (unsigned)(kr * DQK + kc * 8) * 2u;
      const int vk = 8 * wid + ((lane & 31) >> 2), vc = (lane >> 5) * 32 + (lane & 3) * 8; vsrc = (unsigned)(vk * DV + vc) * 2u; psrc = (unsigned)lane * 4u;
      asm volatile("" : "+v"(ksrc), "+v"(vsrc), "+v"(psrc)); }
    const int vb0 = (int)(uintptr_t)V_lds + v_rd_base(lane);
#define FD_DMA(t, slot) do { unsigned kk_ = (unsigned)__builtin_amdgcn_readfirstlane((int)((t) * KVBLK)); asm volatile("" : "+s"(kk_)); const int sl_ = (slot); \
    const char* Kt_ = (const char*)(Kh + (size_t)kk_ * DQK); const char* Vt_ = (const char*)(Vh + (size_t)kk_ * DV); \
    _Pragma("unroll") for (int s_ = 0; s_ < KSUB; ++s_) __builtin_amdgcn_global_load_lds((const unsigned*)(Kt_ + s_ * 128 + ksrc), (LAS unsigned*)(K_lds + sl_ * SHM_K + s_ * 8192 + wid * 1024), 16, 0, 0); \
    _Pragma("unroll") for (int q_ = 0; q_ < 2; ++q_) __builtin_amdgcn_global_load_lds((const unsigned*)(Vt_ + q_ * 128 + vsrc), (LAS unsigned*)(V_lds + sl_ * SHM_V + (2 * wid + q_) * 1024), 16, 0, 0); \
    if (ALIBI) __builtin_amdgcn_global_load_lds((const unsigned*)((const char*)(posfb + kk_) + psrc), (LAS unsigned*)(P_lds + sl_ * 64), 4, 0, 0); } while (0)
    const int nt = NT - T0;
    FD_DMA(T0, 0); FD_DMA(T0 + 1, 1);
    asm volatile("s_waitcnt vmcnt(0) lgkmcnt(0)\n\ts_barrier" ::: "memory");
    int slot = 0;
    for (int j = 0; j < nt; ++j) {
        int b = slot; asm volatile("" : "+s"(b));
        if (j + 2 < nt) { int bn = b + 2; bn = bn >= 3 ? bn - 3 : bn; FD_DMA(T0 + j + 2, bn); }
        { f32x16 p0, p1; bf16x8 pa0, pa1, pa2, pa3;
          qkt<DQK, true>(p0, p1, K_lds + b * SHM_K, qr, r32, hi); fixup<ALIBI>(p0, p1, P_lds + b * 64, posq, slope2, T0 + j > tmax, hi);
          fr_softmax(p0, p1, l_reg, pa0, pa1, pa2, pa3); FA_SBAR();
          pv_d0(o, vb0 + b * SHM_V, pa0, pa1, pa2, pa3); }
        if (j + 2 < nt) asm volatile("s_waitcnt vmcnt(%0) lgkmcnt(0)\n\ts_barrier" :: "n"(NPT) : "memory");
        else asm volatile("s_waitcnt vmcnt(0) lgkmcnt(0)\n\ts_barrier" ::: "memory");
        slot = slot == 2 ? 0 : slot + 1;
    }
    { auto rr = __builtin_amdgcn_permlane32_swap(__float_as_uint(l_reg), __float_as_uint(l_reg), false, false); l_reg = __uint_as_float(rr[0]) + __uint_as_float(rr[1]); }
    l_out = l_reg;
#undef FD_DMA
}
__device__ __forceinline__ void row_bcast(float f, LAS float* al, int r32, int hi, float (&rf)[16]) {
    asm volatile("s_waitcnt lgkmcnt(0)" ::: "memory");
    if (hi == 0) al[r32] = f;
    asm volatile("s_waitcnt lgkmcnt(0)" ::: "memory");
#pragma unroll
    for (int r = 0; r < 16; ++r) rf[r] = al[crow(r, hi)];
    asm volatile("s_waitcnt lgkmcnt(0)" ::: "memory");
}

__device__ __forceinline__ void attn_pass_da5(const bf16* __restrict__ Qb, const bf16* __restrict__ Kh, const bf16* __restrict__ Vh, const int* __restrict__ posb, float slope2, int cw, int q0, int T0, int NT,
                                              LAS unsigned char* lds, int tid_, f32x16 (&o)[4], float& l_out) {
    typedef Lds<64> L; constexpr int DQK = 64, SHM_K = L::SHM_K, B_OFF = L::END;
    const int wid = __builtin_amdgcn_readfirstlane(tid_ >> 6); int lane; asm volatile("v_mbcnt_lo_u32_b32 %0, -1, 0\n\tv_mbcnt_hi_u32_b32 %0, -1, %0" : "=v"(lane));
    const int tid = wid * 64 + lane, r32 = lane & 31, hi = lane >> 5;
    LAS unsigned char* V_lds = lds + L::V_OFF; LAS unsigned char* K_lds = lds + L::K_OFF; LAS float* P_lds = (LAS float*)(lds + L::POS_OFF); LAS float* B_lds = (LAS float*)(lds + B_OFF);
    float l_reg = 0.f;
#pragma unroll
    for (int d = 0; d < 4; ++d) o[d] = f32x16{};
    bf16x8 qr[4];
    { const bf16* Qw = Qb + (size_t)(wid * QBLK) * DQK; unsigned qgo = (unsigned)(r32 * DQK + hi * 8) * 2u; asm volatile("" : "+v"(qgo));
#pragma unroll
      for (int d0 = 0; d0 < 4; ++d0) qr[d0] = ldg<bf16x8>(Qw + d0 * 16, qgo); }
    const float posq = (float)posb[q0 + wid * QBLK + r32];
    const float dl = slope2 * (posq - (float)cw);
    const int tmax = NT - 4 + (wid >> 1);
    const int sr = tid >> 4, sc = (tid & 15) * 8, vst0 = v_st_nat(sr, sc), vst1 = v_st_nat(32 + sr, sc);
    const int kr = tid >> 3, kc = (tid & 7) * 8, kst = kswz(kr, kc * 2);
    unsigned vgo = (unsigned)(sr * DV + sc) * 2u, kgo = (unsigned)(kr * DQK + kc) * 2u, pgo = (unsigned)(tid & 63) * 4u; asm volatile("" : "+v"(vgo), "+v"(kgo), "+v"(pgo));
    const int vb0 = (int)(uintptr_t)V_lds + v_rd_base(lane);
    int ka[4]; k_bases(ka, K_lds, r32, hi);
    bf16x8 vs0, vs1, ks0; int ps;
#define FD_SLOAD(k0) do { unsigned kk_ = (unsigned)__builtin_amdgcn_readfirstlane((int)(k0)); asm volatile("" : "+s"(kk_)); \
    const bf16* Vt_ = Vh + (size_t)kk_ * DV; const bf16* Kt_ = Kh + (size_t)kk_ * DQK; \
    vs0 = ldg<bf16x8>(Vt_, vgo); vs1 = ldg<bf16x8>(Vt_ + 32 * DV, vgo); ks0 = ldg<bf16x8>(Kt_, kgo); ps = ldg<int>(posb + kk_, pgo); } while (0)
#define FD_SWRITE(b) do { *(LAS bf16x8*)(V_lds + (b) * SHM_V + vst0) = vs0; *(LAS bf16x8*)(V_lds + (b) * SHM_V + vst1) = vs1; *(LAS bf16x8*)(K_lds + (b) * SHM_K + kst) = ks0; \
    B_lds[(b) * 512 + tid] = slope2 * (float)(ps - cw); if (tid < 64) P_lds[(b) * 64 + tid] = (float)ps; } while (0)
#define FD_LIN(b) do { f32x16 p0, p1; bf16x8 pa0, pa1, pa2, pa3; const LAS float* bl_ = B_lds + (b) * 512 + wid * 64 + 4 * hi; \
    _Pragma("unroll") for (int g = 0; g < 4; ++g) { const f32x4 k0 = *(const LAS f32x4*)(bl_ + 8 * g), k1 = *(const LAS f32x4*)(bl_ + 32 + 8 * g); \
        _Pragma("unroll") for (int e = 0; e < 4; ++e) { p0[4 * g + e] = k0[e]; p1[4 * g + e] = k1[e]; } } \
    if (PIPE_LIN) qkt_pipe<DQK, (b) * SHM_K>(p0, p1, ka, qr); else qkt<DQK, false>(p0, p1, K_lds + (b) * SHM_K, qr, r32, hi); fr_softmax(p0, p1, l_reg, pa0, pa1, pa2, pa3); FA_SBAR(); \
    pv_d0_pipe(o, vb0 + (b) * SHM_V, pa0, pa1, pa2, pa3); } while (0)
#define FD_GEN(b, t) do { if ((t) <= tmax) { f32x16 p0, p1; bf16x8 pa0, pa1, pa2, pa3; \
    _Pragma("unroll") for (int r = 0; r < 16; ++r) { p0[r] = dl; p1[r] = dl; } \
    if (PIPE_GEN) qkt_pipe<DQK, (b) * SHM_K>(p0, p1, ka, qr); else qkt<DQK, false>(p0, p1, K_lds + (b) * SHM_K, qr, r32, hi); fixup<true>(p0, p1, P_lds + (b) * 64, posq, slope2, false, hi); fr_softmax(p0, p1, l_reg, pa0, pa1, pa2, pa3); FA_SBAR(); \
    pv_d0_pipe(o, vb0 + (b) * SHM_V, pa0, pa1, pa2, pa3); } } while (0)
    FD_SLOAD(T0 * KVBLK); FD_SWRITE(0); FD_SLOAD((T0 + 1) * KVBLK); FD_SWRITE(1); FD_SLOAD((T0 + 2) * KVBLK);
    __syncthreads();
    int j = T0;
    for (; j < NT - 4; j += 2) {
        FD_LIN(0);
        __syncthreads();
        FD_SWRITE(0); FD_SLOAD((j + 3) * KVBLK);
        FD_LIN(1);
        __syncthreads();
        FD_SWRITE(1); FD_SLOAD((j + 4) * KVBLK);
    }
    for (; j < NT; j += 2) {
        FD_GEN(0, j);
        __syncthreads();
        if (j + 2 < NT) { FD_SWRITE(0); FD_SLOAD((j + 3) * KVBLK); }
        FD_GEN(1, j + 1);
        __syncthreads();
        if (j + 2 < NT) { FD_SWRITE(1); }
    }
    { auto rr = __builtin_amdgcn_permlane32_swap(__float_as_uint(l_reg), __float_as_uint(l_reg), false, false); l_reg = __uint_as_float(rr[0]) + __uint_as_float(rr[1]); }
    l_out = l_reg;
#undef FD_SLOAD
#undef FD_SWRITE
#undef FD_LIN
#undef FD_GEN
}

__device__ __forceinline__ void attn_pass_da5p(const bf16* __restrict__ Qb, const bf16* __restrict__ Kh, const bf16* __restrict__ Vh, const int* __restrict__ posb, float slope2, int cw, int q0, int T0, int NT,
                                               LAS unsigned char* lds, int tid_, f32x16 (&o)[4], float& l_out) {
    typedef Lds<64> L; constexpr int DQK = 64, SHM_K = L::SHM_K, B_OFF = L::END;
    const int wid = __builtin_amdgcn_readfirstlane(tid_ >> 6); int lane; asm volatile("v_mbcnt_lo_u32_b32 %0, -1, 0\n\tv_mbcnt_hi_u32_b32 %0, -1, %0" : "=v"(lane));
    const int tid = wid * 64 + lane, r32 = lane & 31, hi = lane >> 5;
    if (wid >= 4) __builtin_amdgcn_s_setprio(1);
    LAS unsigned char* V_lds = lds + L::V_OFF; LAS unsigned char* K_lds = lds + L::K_OFF; LAS float* P_lds = (LAS float*)(lds + L::POS_OFF); LAS float* B_lds = (LAS float*)(lds + B_OFF);
    float l_reg = 0.f;
#pragma unroll
    for (int d = 0; d < 4; ++d) o[d] = f32x16{};
    bf16x8 qr[4];
    { const bf16* Qw = Qb + (size_t)(wid * QBLK) * DQK; unsigned qgo = (unsigned)(r32 * DQK + hi * 8) * 2u; asm volatile("" : "+v"(qgo));
#pragma unroll
      for (int d0 = 0; d0 < 4; ++d0) qr[d0] = ldg<bf16x8>(Qw + d0 * 16, qgo); }
    const float posq = (float)posb[q0 + wid * QBLK + r32];
    const float dl = slope2 * (posq - (float)cw);
    const int tmax = NT - 4 + (wid >> 1);
    const int sr = tid >> 4, sc = (tid & 15) * 8, vst0 = v_st_nat(sr, sc), vst1 = v_st_nat(32 + sr, sc);
    const int kr = tid >> 3, kc = (tid & 7) * 8, kst = kswz(kr, kc * 2);
    unsigned vgo = (unsigned)(sr * DV + sc) * 2u, kgo = (unsigned)(kr * DQK + kc) * 2u, pgo = (unsigned)(tid & 63) * 4u; asm volatile("" : "+v"(vgo), "+v"(kgo), "+v"(pgo));
    const int vb0 = (int)(uintptr_t)V_lds + v_rd_base(lane);
    int ka[4]; k_bases(ka, K_lds, r32, hi);
    bf16x8 vs0, vs1, ks0; int ps;
#define FP_LOADV(t) do { unsigned kk_ = (unsigned)__builtin_amdgcn_readfirstlane((int)((t) * KVBLK)); asm volatile("" : "+s"(kk_)); const bf16* Vt_ = Vh + (size_t)kk_ * DV; \
    vs0 = ldg<bf16x8>(Vt_, vgo); vs1 = ldg<bf16x8>(Vt_ + 32 * DV, vgo); } while (0)
#define FP_LOADK(t) do { unsigned kk_ = (unsigned)__builtin_amdgcn_readfirstlane((int)((t) * KVBLK)); asm volatile("" : "+s"(kk_)); ks0 = ldg<bf16x8>(Kh + (size_t)kk_ * DQK, kgo); ps = ldg<int>(posb + kk_, pgo); } while (0)
#define FP_WRITEV(b) do { *(LAS bf16x8*)(V_lds + (b) * SHM_V + vst0) = vs0; *(LAS bf16x8*)(V_lds + (b) * SHM_V + vst1) = vs1; } while (0)
#define FP_WRITEK(b) do { *(LAS bf16x8*)(K_lds + (b) * SHM_K + kst) = ks0; B_lds[(b) * 512 + tid] = slope2 * (float)(ps - cw); if (tid < 64) P_lds[(b) * 64 + tid] = (float)ps; } while (0)
#define FP_BINIT(x0, x1, b) do { const LAS float* bl_ = B_lds + (b) * 512 + wid * 64 + 4 * hi; \
    _Pragma("unroll") for (int g = 0; g < 4; ++g) { const f32x4 k0 = *(const LAS f32x4*)(bl_ + 8 * g), k1 = *(const LAS f32x4*)(bl_ + 32 + 8 * g); \
        _Pragma("unroll") for (int e = 0; e < 4; ++e) { x0[4 * g + e] = k0[e]; x1[4 * g + e] = k1[e]; } } } while (0)
#define FP_QK(x0, x1, t, b) do { if ((t) < NT - 4) { FP_BINIT(x0, x1, b); qkt<DQK, false>(x0, x1, K_lds + (b) * SHM_K, qr, r32, hi); } \
    else { _Pragma("unroll") for (int r = 0; r < 16; ++r) { x0[r] = dl; x1[r] = dl; } qkt<DQK, false>(x0, x1, K_lds + (b) * SHM_K, qr, r32, hi); fixup<true>(x0, x1, P_lds + (b) * 64, posq, slope2, false, hi); } } while (0)
    f32x16 c0, c1;
    {
        FP_LOADV(T0); FP_LOADK(T0);
        bf16x8 vB0, vB1, kB; int pB;
        { unsigned kk_ = (unsigned)__builtin_amdgcn_readfirstlane((int)((T0 + 1) * KVBLK)); asm volatile("" : "+s"(kk_)); const bf16* Vt_ = Vh + (size_t)kk_ * DV;
          vB0 = ldg<bf16x8>(Vt_, vgo); vB1 = ldg<bf16x8>(Vt_ + 32 * DV, vgo); kB = ldg<bf16x8>(Kh + (size_t)kk_ * DQK, kgo); pB = ldg<int>(posb + kk_, pgo); }
        FP_WRITEV(0); FP_WRITEK(0);
        *(LAS bf16x8*)(V_lds + SHM_V + vst0) = vB0; *(LAS bf16x8*)(V_lds + SHM_V + vst1) = vB1; *(LAS bf16x8*)(K_lds + SHM_K + kst) = kB;
        B_lds[512 + tid] = slope2 * (float)(pB - cw); if (tid < 64) P_lds[64 + tid] = (float)pB;
        FP_LOADK(T0 + 2); FP_LOADV(T0 + 2);
        __syncthreads();
        FP_QK(c0, c1, T0, 0);
        __syncthreads();
        FP_WRITEK(0); FP_LOADK(T0 + 3);
    }
    int s = T0;
    for (; s <= NT - 6; ++s) {
        const int b = s & 1, nb = b ^ 1, kof = nb * SHM_K;
        f32x16 n0, n1; bf16x8 pa0, pa1, pa2, pa3;
        FP_BINIT(n0, n1, nb);
        const bf16x8 a0 = k_read<0>(ka[0] + kof), b0 = k_read<4096>(ka[0] + kof), a1 = k_read<0>(ka[1] + kof), b1 = k_read<4096>(ka[1] + kof);
        const bf16x8 a2 = k_read<0>(ka[2] + kof), b2 = k_read<4096>(ka[2] + kof), a3 = k_read<0>(ka[3] + kof), b3 = k_read<4096>(ka[3] + kof);
        float sa = 0.f, sb = 0.f;
#define FP_SM(d) do { _Pragma("unroll") for (int r = 4 * (d); r < 4 * (d) + 4; ++r) { c0[r] = __builtin_amdgcn_exp2f(c0[r]); c1[r] = __builtin_amdgcn_exp2f(c1[r]); sa += c0[r]; sb += c1[r]; } } while (0)
        FA_LGK(6); FA_SBAR(); n0 = __builtin_amdgcn_mfma_f32_32x32x16_bf16(a0, qr[0], n0, 0, 0, 0); n1 = __builtin_amdgcn_mfma_f32_32x32x16_bf16(b0, qr[0], n1, 0, 0, 0); FP_SM(0); FA_SBAR();
        FA_LGK(4); FA_SBAR(); n0 = __builtin_amdgcn_mfma_f32_32x32x16_bf16(a1, qr[1], n0, 0, 0, 0); n1 = __builtin_amdgcn_mfma_f32_32x32x16_bf16(b1, qr[1], n1, 0, 0, 0); FP_SM(1); FA_SBAR();
        FA_LGK(2); FA_SBAR(); n0 = __builtin_amdgcn_mfma_f32_32x32x16_bf16(a2, qr[2], n0, 0, 0, 0); n1 = __builtin_amdgcn_mfma_f32_32x32x16_bf16(b2, qr[2], n1, 0, 0, 0); FP_SM(2); FA_SBAR();
        FA_LGK(0); FA_SBAR(); n0 = __builtin_amdgcn_mfma_f32_32x32x16_bf16(a3, qr[3], n0, 0, 0, 0); n1 = __builtin_amdgcn_mfma_f32_32x32x16_bf16(b3, qr[3], n1, 0, 0, 0); FP_SM(3); FA_SBAR();
#undef FP_SM
        l_reg += sa + sb;
        typedef unsigned u32x4_t __attribute__((ext_vector_type(4)));
#define FA_PKS(P, BASE, OUT) do { u32x4_t w = {cvtpk(P[BASE + 0], P[BASE + 1]), cvtpk(P[BASE + 2], P[BASE + 3]), cvtpk(P[BASE + 4], P[BASE + 5]), cvtpk(P[BASE + 6], P[BASE + 7])}; OUT = __builtin_bit_cast(bf16x8, w); } while (0)
        FA_PKS(c0, 0, pa0); FA_PKS(c0, 8, pa1); FA_PKS(c1, 0, pa2); FA_PKS(c1, 8, pa3);
#undef FA_PKS
        FA_SBAR();
        pv_d0_pipe(o, vb0 + b * SHM_V, pa0, pa1, pa2, pa3);
        __syncthreads();
        FP_WRITEV(b); FP_WRITEK(nb); FP_LOADV(s + 3); FP_LOADK(s + 4);
        c0 = n0; c1 = n1;
    }
    for (; s < NT; ++s) {
        const int b = s & 1, nb = b ^ 1;
        f32x16 n0 = f32x16{}, n1 = f32x16{};
        if (s + 1 < NT && s + 1 <= tmax) FP_QK(n0, n1, s + 1, nb);
        if (s <= tmax) { bf16x8 pa0, pa1, pa2, pa3; fr_softmax(c0, c1, l_reg, pa0, pa1, pa2, pa3); FA_SBAR(); pv_d0_pipe(o, vb0 + b * SHM_V, pa0, pa1, pa2, pa3); }
        __syncthreads();
        if (s + 2 < NT) FP_WRITEV(b);
        if (s + 3 < NT) { FP_WRITEK(nb); FP_LOADV(s + 3); }
        if (s + 4 < NT) FP_LOADK(s + 4);
        c0 = n0; c1 = n1;
    }
    { auto rr = __builtin_amdgcn_permlane32_swap(__float_as_uint(l_reg), __float_as_uint(l_reg), false, false); l_reg = __uint_as_float(rr[0]) + __uint_as_float(rr[1]); }
    __builtin_amdgcn_s_setprio(0);
    l_out = l_reg;
#undef FP_LOADV
#undef FP_LOADK
#undef FP_WRITEV
#undef FP_WRITEK
#undef FP_BINIT
#undef FP_QK
}
}

constexpr int CW_BAR = 4096;
constexpr int CW_Q = 8192;
__device__ __forceinline__ int next_unit(Frame& F, unsigned* ctr) {
    LAS unsigned* uq = (LAS unsigned*)(F.lds + LDSCTL_OFF + 16);
    __syncthreads();
    if (F.tid == 0) *uq = atomicAdd(ctr, 1u);
    __syncthreads();
    return __builtin_amdgcn_readfirstlane((int)*uq);
}
template <int MODE = 0> __device__ __forceinline__ void ph_attn_da(Frame& F, int l, int rep = 0) {
    const bf16 *QD = WSP(bf16, WS_QD), *KD = WSP(bf16, WS_KD), *VD = WSP(bf16, WS_VD);
    bf16* MIX = rep == 2 ? WSP(bf16, WS_U) : WSP(bf16, WS_MIX); float* O1 = WSP(float, WS_O1);
    const int lane = F.lane;
    LAS float* al = (LAS float*)(F.lds + fa::Lds<64>::WS_OFF) + F.wave * 64;
    const float s1 = wave_sum(FIN(I_LQ1)[l * 64 + lane] * FIN(I_LK1)[l * 64 + lane]);
    const float s2 = wave_sum(FIN(I_LQ2)[l * 64 + lane] * FIN(I_LK2)[l * 64 + lane]);
    const float lam_init = __int_as_float(__builtin_amdgcn_readfirstlane(__float_as_int(LAM_INIT[l])));
    const float lam = __int_as_float(__builtin_amdgcn_readfirstlane(__float_as_int(expf(s1) - expf(s2) + lam_init)));
    float gqm = fabsf(FIN(I_DAQG)[l * 64 + lane]), gkm = fabsf(FIN(I_DAKG)[l * 64 + lane]);
    gqm = wave_max(gqm); gkm = wave_max(gkm);
    const float bound = __int_as_float(__builtin_amdgcn_readfirstlane(__float_as_int(1.01f * 11.5416f * gqm * gkm)));
    const float reach = __int_as_float(__builtin_amdgcn_readfirstlane(__float_as_int(2.0f * bound + 160.0f)));
    if ((MODE == 5) != (bound < 40.0f)) return;
    const int* posmm = WSP(int, WS_POSMM);
    unsigned* ctr = (unsigned*)(F.ws + WS_CTL) + (rep == 2 ? 20000 + 64 * (l * 2) : CW_Q + 64 * 8 * (l * 4 + 0 + rep));
    for (;;) {
        const int u = next_unit(F, ctr); if (u >= 384) break;
        const int qb = 31 - u / 12, bh = u % 12, b = bh / NH, h = bh % NH, q0 = qb * 256, NT = q0 / 64 + 4;
        const int* posb = F.pos + b * SEQ;
        const float slope2 = __int_as_float(__builtin_amdgcn_readfirstlane(__float_as_int(ALIBI_SLOPE[h] * LOG2E)));
        const size_t orow = (size_t)(b * SEQ + q0 + F.wave * 32);
        int T0 = 0, TL = 0; bool lin = false;
        { const int* qm = posmm + (size_t)(b * 128 + qb * 4) * 2; int qmin = qm[0], qmax = qm[1];
#pragma unroll
          for (int c = 1; c < 4; ++c) { qmin = qm[2 * c] < qmin ? qm[2 * c] : qmin; qmax = qm[2 * c + 1] > qmax ? qm[2 * c + 1] : qmax; }
          const int* km = posmm + (size_t)(b * 128) * 2;
          for (; T0 < NT - 4; ++T0) { const int kmin = km[2 * T0], kmax = km[2 * T0 + 1]; int dmin = qmin - kmax; if (kmin - qmax > dmin) dmin = kmin - qmax; if (dmin < 0) dmin = 0;
              if (!(slope2 * (float)dmin > reach)) break; }
          T0 &= ~1;
          for (TL = T0; TL < NT; ++TL) if (km[2 * TL + 1] > qmin) break;
          if (TL < NT - 4) TL = T0;
          int span = qm[1] - qm[0];
#pragma unroll
          for (int c = 1; c < 4; ++c) { const int sp = qm[2 * c + 1] - qm[2 * c]; span = sp > span ? sp : span; }
          lin = TL >= NT - 4 && slope2 * (float)span <= 24.0f;
        }
        for (int mp = 0; mp < 2; ++mp) {
            f32x16 o[4]; float l1;
            const bf16* Qp = QD + ((size_t)(bh * 2 + mp) * SEQ + q0) * 64; const int bhk = rep == 2 ? 0 : bh; const bf16* Kp = KD + (size_t)(bhk * 2 + mp) * SEQ * 64; const bf16* Vp = VD + (size_t)bhk * SEQ * 128;
            if (MODE == 5 && lin) { const int cw = posmm[(size_t)(b * 128 + qb * 4 + (__builtin_amdgcn_readfirstlane(F.tid >> 6) >> 1)) * 2];
                fa::attn_pass_da5p(Qp, Kp, Vp, posb, slope2, cw, q0, T0, NT, F.lds, F.tid, o, l1); }
            else fa::attn_pass<64, true, 1, MODE>(Qp, Kp, Vp, posb, slope2, bound, TL, q0, T0, NT, F.lds, F.tid, o, l1);
            int le_; asm volatile("v_mbcnt_lo_u32_b32 %0, -1, 0\n\tv_mbcnt_hi_u32_b32 %0, -1, %0" : "=v"(le_)); const int r32 = le_ & 31, hi = le_ >> 5;
            float f[16];
            if (mp == 0) {
                fa::row_bcast(1.0f / l1, al, r32, hi, f);
                unsigned lo = (unsigned)(((u * 8 + F.wave) * 8) * 64 + le_) * 16u; asm volatile("" : "+v"(lo));
#pragma unroll
                for (int j = 0; j < 8; ++j) { const int d = j >> 1, rb = (j & 1) * 8; v4u w;
                    w.x = pg8::pkh2(o[d][rb + 0] * f[rb + 0], o[d][rb + 1] * f[rb + 1]); w.y = pg8::pkh2(o[d][rb + 2] * f[rb + 2], o[d][rb + 3] * f[rb + 3]);
                    w.z = pg8::pkh2(o[d][rb + 4] * f[rb + 4], o[d][rb + 5] * f[rb + 5]); w.w = pg8::pkh2(o[d][rb + 6] * f[rb + 6], o[d][rb + 7] * f[rb + 7]);
                    fa::stg<v4u>(O1, lo + j * 1024, w); }
            } else {
                fa::row_bcast(lam / l1, al, r32, hi, f);
                const float* hg = FIN(I_DAHG) + (size_t)l * 768 + h * 128;
                float hgv[4];
#pragma unroll
                for (int d = 0; d < 4; ++d) hgv[d] = fa::ldg<float>(hg + d * 32, (unsigned)r32 * 4u) * (1.0f - lam_init);
                unsigned lo = (unsigned)(((u * 8 + F.wave) * 8) * 64 + le_) * 16u; asm volatile("" : "+v"(lo));
                bf16* mb = MIX + orow * D + h * 128; unsigned mo = (unsigned)(4 * hi * D + r32) * 2u; asm volatile("" : "+v"(mo));
                v4u w1[8];
#pragma unroll
                for (int j = 0; j < 8; ++j) w1[j] = fa::ldg<v4u>(O1, lo + j * 1024);
#pragma unroll
                for (int j = 0; j < 8; ++j) { const int d = j >> 1, rb = (j & 1) * 8; const unsigned ww[4] = {w1[j].x, w1[j].y, w1[j].z, w1[j].w};
#pragma unroll
                    for (int q = 0; q < 4; ++q) { o[d][rb + 2 * q] = pg8::uph_lo(ww[q]) - o[d][rb + 2 * q] * f[rb + 2 * q]; o[d][rb + 2 * q + 1] = pg8::uph_hi(ww[q]) - o[d][rb + 2 * q + 1] * f[rb + 2 * q + 1]; } }
#pragma unroll
                for (int r2 = 0; r2 < 16; ++r2) {
                    float ss = 0.f;
#pragma unroll
                    for (int d = 0; d < 4; ++d) ss += o[d][r2] * o[d][r2];
                    ss = sum32(ss);
                    const float rn = rsqrtf(ss * (1.f / 128) + EPS);
#pragma unroll
                    for (int d = 0; d < 4; ++d) fa::stg<bf16>(mb, mo + (fa::crowc(r2) * D + d * 32) * 2, (bf16)f2bf(o[d][r2] * rn * hgv[d]));
                }
            }
        }
    }
}
template <int MODE> __device__ __forceinline__ void ph_attn_mla(Frame& F, int l, int rep = 0, int ubase = 0, int ucount = 384, int cslot = 2, int xstat = 0) {
    const bf16 *QM = WSP(bf16, WS_QM), *KM = WSP(bf16, WS_KM), *VM = WSP(bf16, WS_VM);
    bf16* MIX = rep >= 2 ? WSP(bf16, WS_U) : WSP(bf16, WS_MIX);
    const int lane = F.lane;
    LAS float* al = (LAS float*)(F.lds + fa::Lds<192>::WS_OFF) + F.wave * 64;
    float gqm = fmaxf(fmaxf(fabsf(FIN(I_MQG)[l * 192 + lane]), fabsf(FIN(I_MQG)[l * 192 + 64 + lane])), fabsf(FIN(I_MQG)[l * 192 + 128 + lane]));
    float gkm = fmaxf(fmaxf(fabsf(FIN(I_MKG)[l * 192 + lane]), fabsf(FIN(I_MKG)[l * 192 + 64 + lane])), fabsf(FIN(I_MKG)[l * 192 + 128 + lane]));
    gqm = wave_max(gqm); gkm = wave_max(gkm);
    const float bound = __int_as_float(__builtin_amdgcn_readfirstlane(__float_as_int(1.01f * 19.9907f * gqm * gkm)));
    if ((MODE == 5) != (bound < 60.0f)) return;
    unsigned* ctr = (unsigned*)(F.ws + WS_CTL) + (rep >= 2 ? 20000 + 64 * (l * 2 + 1) : CW_Q + 64 * 8 * (l * 4 + cslot + rep));
    const bool xs = xstat != 0 && F.G == 256;
    for (int it_ = 0;; ++it_) {
        int qb, bh;
        if (xs) { if (it_ > 0 || F.bid >= 192) break; const int idx = (F.bid & 7) * 24 + (F.bid >> 3); bh = idx >> 4; qb = 31 - (idx & 15); __syncthreads(); }
        else { const int ui = next_unit(F, ctr); if (ui >= ucount) break; const int u = ubase + ui; qb = 31 - u / 12; bh = u % 12; }
        const int b = bh / NH, h = bh % NH, q0 = qb * 256, NT = q0 / 64 + 4;
        const size_t orow = (size_t)(b * SEQ + q0 + F.wave * 32);
        f32x16 o[4]; float l1;
        const int bhk = rep == 2 ? 0 : bh;
#if defined(PROBE_VAR)
        if (rep == 3) fa::attn_pass<192, false, 1, MODE, PROBE_VAR>(QM + ((size_t)bh * SEQ + q0) * 192, KM + (size_t)bhk * SEQ * 192, VM + (size_t)bhk * SEQ * 128, nullptr, 0.f, bound, 0, q0, 0, NT, F.lds, F.tid, o, l1); else
#endif
        fa::attn_pass<192, false, 1, MODE>(QM + ((size_t)bh * SEQ + q0) * 192, KM + (size_t)bhk * SEQ * 192, VM + (size_t)bhk * SEQ * 128, nullptr, 0.f, bound, 0, q0, 0, NT, F.lds, F.tid, o, l1);
        int le_; asm volatile("v_mbcnt_lo_u32_b32 %0, -1, 0\n\tv_mbcnt_hi_u32_b32 %0, -1, %0" : "=v"(le_)); const int r32 = le_ & 31, hi = le_ >> 5;
        float f[16]; fa::row_bcast(1.0f / l1, al, r32, hi, f);
        bf16* mb = MIX + orow * D + 768 + h * 128; unsigned mo = (unsigned)(4 * hi * D + r32) * 2u; asm volatile("" : "+v"(mo));
#pragma unroll
        for (int r2 = 0; r2 < 16; ++r2)
#pragma unroll
            for (int d = 0; d < 4; ++d) fa::stg<bf16>(mb, mo + (fa::crowc(r2) * D + d * 32) * 2, (bf16)f2bf(o[d][r2] * f[r2]));
    }
}
__device__ __forceinline__ void ph_sgu(Frame& F, int l, int rep = 0) {
    const _Float16* UU = WSP(_Float16, WS_UU); const bf16* GV = WSP(bf16, WS_GV); const float* SSQ = WSP(float, WS_SSQ_SGV); bf16* MIX = WSP(bf16, WS_MIX);
    LAS unsigned short* vs = (LAS unsigned short*)F.lds;
    LAS float* rs = (LAS float*)(F.lds + 128 * 128 * 2);
    const int lane = F.lane, r32 = lane & 31, hi = lane >> 5, tm = F.wave >> 1, tn0 = (F.wave & 1) * 2;
    __syncthreads();
    unsigned* sctr = (unsigned*)(F.ws + WS_CTL) + CW_Q + 64 * 8 * 16 + 64 * (l + 4 * rep);
    LAS float* wl = rs + 128;
    for (;;) { const int u = next_unit(F, sctr); if (u >= 512) break;
        const int g = u & 3, row0 = (u >> 2) * 128;
        const int t = 32 * tm + r32;
        const float* bias = FIN(I_SGB) + (l * 4 + g) * 128 + 32 * tm;
        const int c0 = g * 128 + 32 * tn0 + r32;
        float uu0[16], uu1[16], bvv[16];
#pragma unroll
        for (int r = 0; r < 16; ++r) { const int tt = crow(r, hi); const size_t row = (size_t)(row0 + 32 * tm + tt); uu0[r] = (float)UU[row * 512 + c0]; uu1[r] = (float)UU[row * 512 + c0 + 32]; bvv[r] = bias[tt]; }
        { const float* wb = FIN(I_SGW) + (size_t)(l * 4 + g) * 128 * 128;
          f32x4 wv_[8];
#pragma unroll
          for (int k = 0; k < 8; ++k) wv_[k] = *(const f32x4*)(wb + (size_t)(F.tid + k * NTHREADS) * 4);
#pragma unroll
          for (int k = 0; k < 8; ++k) { const int e = (F.tid + k * NTHREADS) * 4, tr = e >> 7, sc_ = e & 127; *(LAS f32x4*)(wl + tr * 132 + sc_) = wv_[k]; } }
        for (int i = F.tid; i < 128 * 16; i += NTHREADS) { const int s = i >> 4, c8 = i & 15; *(LAS bf16x8*)(vs + s * 128 + c8 * 8) = *(const bf16x8*)(GV + (size_t)(row0 + s) * 512 + g * 128 + c8 * 8); }
        if (F.tid < 128) { const f32x4 p = *(const f32x4*)(SSQ + (size_t)(row0 + F.tid) * 16 + g * 4); rs[F.tid] = rsqrtf(((p.x + p.y) + (p.z + p.w)) * (1.f / 128) + EPS); }
        __syncthreads();
        f32x16 acc0 = f32x16{}, acc1 = f32x16{};
        const LAS float* wrow = wl + t * 132;
        for (int ks = 0; ks < 2 * (tm + 1); ++ks) {
            const int s0 = 16 * ks + 8 * hi;
            const f32x4 w0 = *(const LAS f32x4*)(wrow + s0), w1 = *(const LAS f32x4*)(wrow + s0 + 4);
            float wv[8] = {w0.x, w0.y, w0.z, w0.w, w1.x, w1.y, w1.z, w1.w};
            bf16x8 af, b0, b1;
#pragma unroll
            for (int j = 0; j < 8; ++j) { af[j] = (short)f2bf(s0 + j <= t ? wv[j] * rs[s0 + j] : 0.f);
                b0[j] = (short)vs[(s0 + j) * 128 + 32 * tn0 + r32]; b1[j] = (short)vs[(s0 + j) * 128 + 32 * (tn0 + 1) + r32]; }
            acc0 = __builtin_amdgcn_mfma_f32_32x32x16_bf16(af, b0, acc0, 0, 0, 0);
            acc1 = __builtin_amdgcn_mfma_f32_32x32x16_bf16(af, b1, acc1, 0, 0, 0);
        }
#pragma unroll
        for (int r = 0; r < 16; ++r) { const int tt = crow(r, hi); const size_t row = (size_t)(row0 + 32 * tm + tt);
            MIX[row * D + 1536 + c0] = (bf16)f2bf(uu0[r] * (acc0[r] + bvv[r]));
            MIX[row * D + 1536 + c0 + 32] = (bf16)f2bf(uu1[r] * (acc1[r] + bvv[r])); }
        __syncthreads();
    }
}
__device__ __forceinline__ void ph_convfix(Frame& F, int l) {
    const unsigned short* EDGE = WSP(unsigned short, WS_EDGE); bf16* U = WSP(bf16, WS_U);
    auto ldh4 = [](const unsigned short* p) { const uint2 w = *(const uint2*)p; return (f32x4){pg8::uph_lo(w.x), pg8::uph_hi(w.x), pg8::uph_lo(w.y), pg8::uph_hi(w.y)}; };
    const float* cw = FIN(I_CONVW) + (size_t)l * 3 * NUP; const float* cb = FIN(I_CONVB) + (size_t)l * NUP;
    const int gt = F.bid * NTHREADS + F.tid, nt = F.G * NTHREADS;
    constexpr int NIT = (M / 64) * 2 * (DFF / 4);
    auto item = [&](int i, unsigned long long& pk, size_t& dst) {
        const int ch = (i % (DFF / 4)) * 4, r = (i / (DFF / 4)) & 1, blk = i / (2 * (DFF / 4)); const bool first = (blk % (SEQ / 64)) == 0;
        f32x4 y[2];
#pragma unroll
        for (int bj = 0; bj < 2; ++bj) {
            const unsigned short* e0 = EDGE + ((size_t)(blk * 4) * 2 + bj) * DFF + ch;
            const f32x4 z = {0.f, 0.f, 0.f, 0.f};
            const f32x4 a0 = ldh4(e0 + (size_t)r * 2 * DFF);
            const f32x4 a1 = r == 1 ? ldh4(e0) : (first ? z : ldh4(e0 - (size_t)1 * 2 * DFF));
            const f32x4 a2 = first ? z : (r == 1 ? ldh4(e0 - (size_t)1 * 2 * DFF) : ldh4(e0 - (size_t)2 * 2 * DFF));
            y[bj] = *(const f32x4*)(cb + bj * DFF + ch) + *(const f32x4*)(cw + (size_t)2 * NUP + bj * DFF + ch) * a0 + *(const f32x4*)(cw + (size_t)NUP + bj * DFF + ch) * a1 + *(const f32x4*)(cw + bj * DFF + ch) * a2; }
        float o[4];
#pragma unroll
        for (int e = 0; e < 4; ++e) { const float g = y[0][e]; o[e] = g * __builtin_amdgcn_rcpf(1.0f + __expf(-g)) * y[1][e]; }
        pk = (unsigned long long)pk2(o[0], o[1]) | ((unsigned long long)pk2(o[2], o[3]) << 32); dst = (size_t)(blk * 64 + r) * DFF + ch; };
    for (int i = gt; i < NIT; i += 3 * nt) {
        unsigned long long p0 = 0, p1 = 0, p2 = 0; size_t d0 = 0, d1 = 0, d2 = 0;
        const bool h1 = i + nt < NIT, h2 = i + 2 * nt < NIT;
        item(i, p0, d0); if (h1) item(i + nt, p1, d1); if (h2) item(i + 2 * nt, p2, d2);
        *(unsigned long long*)(U + d0) = p0; if (h1) *(unsigned long long*)(U + d1) = p1; if (h2) *(unsigned long long*)(U + d2) = p2; }
}

__device__ __forceinline__ void ph_krope(Frame& F, int l) {
    const bf16* H = WSP(bf16, WS_H); const bf16* Wk = wptr(F, l, WL_IN) + (size_t)4096 * D; float* KR = WSP(float, WS_KR); float* SSQ = WSP(float, WS_SSQ_KR);
    constexpr int PITCH = 1024;
    LAS unsigned char* As = F.lds; LAS unsigned char* Bs = F.lds + 64 * PITCH;
    LAS float* red = (LAS float*)F.lds;
    const int lane = F.lane, r32 = lane & 31, hi = lane >> 5, w = F.wave;
    __syncthreads();
    for (int tb = F.bid; tb < M / 64; tb += F.G) {
        f32x16 acc[2][2];
#pragma unroll
        for (int i = 0; i < 2; ++i)
#pragma unroll
            for (int j = 0; j < 2; ++j) acc[i][j] = f32x16{};
        for (int kc = 0; kc < 4; ++kc) {
#pragma unroll
            for (int p = 0; p < 8; ++p) { const int q = p * NTHREADS + F.tid, row = q >> 6, c16 = q & 63;
                *(LAS v4u*)(As + row * PITCH + (c16 ^ (row & 7)) * 16) = *(const v4u*)(H + (size_t)(tb * 64 + row) * D + kc * 512 + c16 * 8);
                *(LAS v4u*)(Bs + row * PITCH + (c16 ^ (row & 7)) * 16) = *(const v4u*)(Wk + (size_t)row * D + kc * 512 + c16 * 8); }
            __syncthreads();
#pragma unroll
            for (int ks = 0; ks < 4; ++ks) { const int ko = (((w * 64 + ks * 16 + hi * 8) >> 3) ^ (r32 & 7)) * 16;
                const bf16x8 A0 = *(const LAS bf16x8*)(As + r32 * PITCH + ko), A1 = *(const LAS bf16x8*)(As + (32 + r32) * PITCH + ko);
                const bf16x8 B0 = *(const LAS bf16x8*)(Bs + r32 * PITCH + ko), B1 = *(const LAS bf16x8*)(Bs + (32 + r32) * PITCH + ko);
                acc[0][0] = __builtin_amdgcn_mfma_f32_32x32x16_bf16(A0, B0, acc[0][0], 0, 0, 0); acc[0][1] = __builtin_amdgcn_mfma_f32_32x32x16_bf16(A0, B1, acc[0][1], 0, 0, 0);
                acc[1][0] = __builtin_amdgcn_mfma_f32_32x32x16_bf16(A1, B0, acc[1][0], 0, 0, 0); acc[1][1] = __builtin_amdgcn_mfma_f32_32x32x16_bf16(A1, B1, acc[1][1], 0, 0, 0); }
            __syncthreads();
        }
#pragma unroll
        for (int i = 0; i < 2; ++i)
#pragma unroll
            for (int j = 0; j < 2; ++j)
#pragma unroll
                for (int r = 0; r < 16; ++r) red[(w * 64 + (i * 2 + j) * 16 + r) * 64 + lane] = acc[i][j][r];
        __syncthreads();
#pragma unroll
        for (int c = 0; c < 8; ++c) { const int cb = w * 8 + c, i = cb >> 5, j = (cb >> 4) & 1, r = cb & 15;
            float v = 0.f;
#pragma unroll
            for (int ww = 0; ww < 8; ++ww) v += red[(ww * 64 + cb) * 64 + lane];
            const int row = tb * 64 + 32 * i + crow(r, hi);
            KR[(size_t)row * 64 + 32 * j + r32] = v;
            const float ss = sum32(v * v);
            if (r32 == 0) SSQ[(size_t)row * 2 + j] = ss; }
        __syncthreads();
    }
}
__device__ __forceinline__ void frame_init(Frame& F, const Args& a, unsigned char* lds) {
    F.lds = (LAS unsigned char*)lds; F.tid = threadIdx.x; F.lane = F.tid & 63; F.wave = __builtin_amdgcn_readfirstlane(F.tid >> 6); F.wave0 = F.wave;
    F.bid = blockIdx.x; F.G = gridDim.x; F.gw = F.bid * NWAVES + F.wave; F.ngw = F.G * NWAVES;
    F.ka = (const __attribute__((address_space(4))) Args*)__builtin_amdgcn_kernarg_segment_ptr();
    F.pos = (const int*)a.in[I_POS]; F.out = a.out; F.ws = a.ws;
}
__device__ __forceinline__ void frame_retid(Frame& F) {
    int lane; asm volatile("v_mbcnt_lo_u32_b32 %0, -1, 0\n\tv_mbcnt_hi_u32_b32 %0, -1, %0" : "=v"(lane));
    int w = F.wave0; asm volatile("" : "+s"(w));
    F.lane = lane; F.wave = w; F.tid = w * 64 + lane;
    int bid = blockIdx.x, G = gridDim.x; asm volatile("" : "+s"(bid)); asm volatile("" : "+s"(G)); F.bid = bid; F.G = G;
    F.gw = bid * NWAVES + F.wave; F.ngw = G * NWAVES;
}
__device__ __forceinline__ void grid_bar(const XcdBarrier& bar, int wave0) {
    int lane_; asm volatile("v_mbcnt_lo_u32_b32 %0, -1, 0\n\tv_mbcnt_hi_u32_b32 %0, -1, %0" : "=v"(lane_)); const bool leader = (wave0 == 0) && (lane_ == 0);
    XcdBarrier b2 = bar; unsigned z_ = 0u; asm volatile("" : "+s"(b2.x), "+s"(z_)); b2.bar = bar.bar + z_; xcd_barrier(b2, leader); }
template <int PH> __device__ __forceinline__ void run_phase(Frame& F, int l) {
    frame_retid(F); asm volatile("; PHASE_BEGIN %0" :: "n"(PH));
    const float* mod = WSP(float, WS_MOD) + (size_t)l * 12 * D;
    if constexpr (PH == 0) ph_prologue(F);
    if constexpr (PH == 1) ph_modreduce(F);
    if constexpr (PH == 2) { if (l == 0) ph_norm<false>(F, l, FIN(I_X), 0, D); else ph_norm<true>(F, l, WSP(bf16, WS_XB), 0, D); }
    if constexpr (PH == 3) { pg8::Gemm g{WSP(bf16, WS_H), wptr(F, l, WL_IN), M, 4096, D}; pg8::StaticOrder S; S.init(M, 4096, F.G, F.bid);
        pg8::EpiInProj E{WSP(bf16, WS_QD), WSP(bf16, WS_KD), WSP(bf16, WS_VD), WSP(bf16, WS_QA), WSP(bf16, WS_KVA), WSP(bf16, WS_GV), WSP(unsigned short, WS_UU), WSP(float, WS_KR),
                         WSP(float, WS_SSQ_QA), WSP(float, WS_SSQ_KVA), WSP(float, WS_SSQ_SGV), WSP(float, WS_SSQ_KR), FIN(I_DAQG) + l * 64, FIN(I_DAKG) + l * 64, FIN(I_QAG) + l * 512, FIN(I_KVAG) + l * 256, FIN(I_SGVG) + l * 512};
        pg8::gemm_phase<pg8::EpiInProj, pg8::StaticOrder, true, true>(F.lds, g, S, E, F.tid); frame_retid(F); ph_krope(F, l); }
    if constexpr (PH == 5) {
        PG8_LAS float* X = (PG8_LAS float*)(F.lds + LDSCTL_OFF + 1024);
        { pg8::Gemm g{WSP(bf16, WS_QA), wptr(F, l, WL_UQ), M, UQ_PAD, QRANK}; pg8::StaticOrder S; S.init(M, UQ_PAD, F.G, F.bid);
          pg8::EpiMlaQ E{WSP(bf16, WS_QM), WSP(float, WS_SSQ_QA), WSP(float, WS_COS), WSP(float, WS_SIN), FIN(I_MQG) + l * 192, X};
          pg8::gemm_phase<pg8::EpiMlaQ, pg8::StaticOrder, true, true>(F.lds, g, S, E, F.tid); }
        __syncthreads(); frame_retid(F);
        { pg8::Gemm g{WSP(bf16, WS_KVA), wptr(F, l, WL_UKV), M, UKV_N, KVRANK}; pg8::StaticOrder S; S.init(M, UKV_N, F.G, F.G - 1 - F.bid);
          pg8::EpiMlaKV E{WSP(bf16, WS_KM), WSP(bf16, WS_VM), WSP(float, WS_SSQ_KVA), WSP(float, WS_SSQ_KR), WSP(float, WS_KR), WSP(float, WS_COS), WSP(float, WS_SIN), FIN(I_MKG) + l * 192, X};
          pg8::gemm_phase<pg8::EpiMlaKV, pg8::StaticOrder, true, true>(F.lds, g, S, E, F.tid); }
    }
#ifndef MLA_FRONT
#define MLA_FRONT 192
#endif
    if constexpr (PH == 7) { ph_attn_mla<5>(F, l, 0, 0, MLA_FRONT, 3, 1); frame_retid(F); ph_attn_mla<0>(F, l, 0, 0, MLA_FRONT, 3, 1); frame_retid(F);
        ph_attn_da<5>(F, l); frame_retid(F); ph_attn_da<0>(F, l); frame_retid(F); asm volatile("; PHASE_BEGIN 71");
        ph_attn_mla<5>(F, l, 0, MLA_FRONT, 384 - MLA_FRONT, 2); frame_retid(F); ph_attn_mla<0>(F, l, 0, MLA_FRONT, 384 - MLA_FRONT, 2); frame_retid(F); asm volatile("; PHASE_BEGIN 72"); ph_sgu(F, l); }
    if constexpr (PH == 8) { pg8::Gemm g{WSP(bf16, WS_MIX), wptr(F, l, WL_OUT), M, D, D}; pg8::StaticOrder S; S.init(M, D, F.G, F.bid);
        pg8::EpiResidP E{l == 0 ? (const void*)FIN(I_X) : (const void*)WSP(bf16, WS_XB), WSP(bf16, WS_XB), l != 0, 1, mod + 2 * D, 6 * D}; pg8::gemm_phase<pg8::EpiResidP, pg8::StaticOrder, true, true>(F.lds, g, S, E, F.tid); }
    if constexpr (PH == 9) ph_norm<true>(F, l, WSP(bf16, WS_XB), 3 * D, 4 * D);
    if constexpr (PH == 10) { pg8::Gemm g{WSP(bf16, WS_H), wptr(F, l, WL_UP), M, NUP, D}; pg8::StaticOrder S; S.init(M, NUP, F.G, F.bid);
        pg8::EpiConvGate E{WSP(bf16, WS_U), WSP(unsigned short, WS_EDGE), FIN(I_CONVW) + (size_t)l * 3 * NUP, FIN(I_CONVB) + (size_t)l * NUP}; pg8::gemm_phase<pg8::EpiConvGate, pg8::StaticOrder, true, true>(F.lds, g, S, E, F.tid); }
    if constexpr (PH == 11) ph_convfix(F, l);
    if constexpr (PH == 12) { pg8::Gemm g{WSP(bf16, WS_U), wptr(F, l, WL_DOWN), M, D, DFF}; pg8::StaticOrder S; S.init(M, D, F.G, F.bid);
        pg8::EpiResidP E{WSP(bf16, WS_XB), l + 1 < DEPTH ? (void*)WSP(bf16, WS_XB) : (void*)F.out, 1, l + 1 < DEPTH, mod + 5 * D, 6 * D}; pg8::gemm_phase<pg8::EpiResidP, pg8::StaticOrder, true, true>(F.lds, g, S, E, F.tid); }
}
__global__ void __launch_bounds__(NTHREADS, 2) mega_fwd(Args a) {
    extern __shared__ __attribute__((aligned(16))) unsigned char lds[];
    Frame F; frame_init(F, a, lds);
    if (F.tid < 16) ((LAS unsigned*)(F.lds + LDSCTL_OFF))[F.tid] = 0u;
    __syncthreads();
    XcdBarrier bar = xcd_barrier_post((unsigned*)(F.ws + WS_CTL) + CW_BAR, (volatile LAS unsigned*)(F.lds + LDSCTL_OFF + 32));
    run_phase<0>(F, 0); grid_bar(bar, F.wave0);
#if defined(PROBE_P0)
    run_phase<0>(F, 0); grid_bar(bar, F.wave0);
#endif
    run_phase<1>(F, 0); grid_bar(bar, F.wave0);
    for (int l = 0; l < DEPTH; ++l) {
        run_phase<2>(F, l); grid_bar(bar, F.wave0);
#if defined(PROBE_EW)
        run_phase<2>(F, l); grid_bar(bar, F.wave0);
#endif
        run_phase<3>(F, l); grid_bar(bar, F.wave0);
#if defined(PROBE_GEMM)
        run_phase<3>(F, l); grid_bar(bar, F.wave0);
#endif
        run_phase<5>(F, l); grid_bar(bar, F.wave0);
        run_phase<7>(F, l); grid_bar(bar, F.wave0);
#if defined(PROBE_P7)
        frame_retid(F); ph_attn_da<5>(F, l, 1); frame_retid(F); ph_attn_mla<5>(F, l, 1); grid_bar(bar, F.wave0);
#endif
#if defined(PROBE_LOC)
        frame_retid(F); ph_attn_da<5>(F, l, 2); frame_retid(F); ph_attn_mla<5>(F, l, 2); grid_bar(bar, F.wave0);
#endif
#if defined(PROBE_DA)
        frame_retid(F); ph_attn_da<5>(F, l, 1); grid_bar(bar, F.wave0);
#endif
#if defined(PROBE_VAR)
        frame_retid(F); ph_attn_mla<5>(F, l, 3); grid_bar(bar, F.wave0);
#endif
#if defined(PROBE_MLA)
        frame_retid(F); ph_attn_mla<5>(F, l, 1); grid_bar(bar, F.wave0);
#endif
#if defined(PROBE_SGU)
        frame_retid(F); ph_sgu(F, l, 1); grid_bar(bar, F.wave0);
#endif
        run_phase<8>(F, l); grid_bar(bar, F.wave0);
        run_phase<9>(F, l); grid_bar(bar, F.wave0);
        run_phase<10>(F, l); grid_bar(bar, F.wave0);
#if defined(PROBE_G10)
        frame_retid(F); run_phase<10>(F, l); grid_bar(bar, F.wave0);
#endif
#if defined(PROBE_G10N)
        frame_retid(F); { pg8::Gemm g{WSP(bf16, WS_H), wptr(F, l, WL_UP), M, NUP, D}; pg8::StaticOrder S; S.init(M, NUP, F.G, F.bid);
          pg8::EpiNull E{WSP(float, WS_MIX)}; pg8::gemm_phase<pg8::EpiNull, pg8::StaticOrder, true, true>(F.lds, g, S, E, F.tid); } grid_bar(bar, F.wave0);
#endif
#if defined(PROBE_GEMM)
        run_phase<10>(F, l); grid_bar(bar, F.wave0);
#endif
        run_phase<11>(F, l); grid_bar(bar, F.wave0);
#if defined(PROBE_EW)
        run_phase<11>(F, l); grid_bar(bar, F.wave0);
#endif
        run_phase<12>(F, l); if (l + 1 < DEPTH) grid_bar(bar, F.wave0);
    }
}

extern "C" void kernel_launch(void* const* d_in, const int* in_sizes, int n_in, void* d_out, int out_size, void* d_ws, size_t ws_size, hipStream_t stream) {
    static int grid = 0;
    if (grid == 0) {
        if (n_in != N_IN || in_sizes[0] != M * D || out_size != M * D || ws_size < WS_END) { fprintf(stderr, "kernel_launch: shape mismatch (n_in %d, ws %zu, need %zu)\n", n_in, ws_size, (size_t)WS_END); grid = -1; return; }
        int dev = 0, cus = 0, per_cu = 0;
        if (hipGetDevice(&dev) != hipSuccess || hipDeviceGetAttribute(&cus, hipDeviceAttributeMultiprocessorCount, dev) != hipSuccess) { grid = -1; return; }
        if (hipFuncSetAttribute((const void*)mega_fwd, hipFuncAttributeMaxDynamicSharedMemorySize, LDS_BYTES) != hipSuccess) { fprintf(stderr, "hipFuncSetAttribute failed\n"); grid = -1; return; }
        if (hipOccupancyMaxActiveBlocksPerMultiprocessor(&per_cu, (const void*)mega_fwd, NTHREADS, LDS_BYTES) != hipSuccess || per_cu < 1) fprintf(stderr, "kernel_launch: occupancy query reports %d\n", per_cu);
        (void)hipGetLastError();
        grid = cus > 0 ? cus : 256;
    }
    if (grid < 0) return;
    if (hipMemsetAsync((char*)d_ws + WS_CTL, 0, CTL_ZERO_BYTES, stream) != hipSuccess) { fprintf(stderr, "kernel_launch: memset failed\n"); return; }
    Args a{};
    for (int i = 0; i < N_IN; ++i) a.in[i] = d_in[i];
    a.out = (float*)d_out; a.ws = (unsigned char*)d_ws; a.ph = 0; a.l = 0;
    hipLaunchKernelGGL(mega_fwd, dim3(grid), dim3(NTHREADS), LDS_BYTES, stream, a);
    const hipError_t le = hipPeekAtLastError();
    if (le != hipSuccess) fprintf(stderr, "kernel_launch: launch failed: %s\n", hipGetErrorName(le));
}
```

```cpp
#include <hip/hip_runtime.h>
#include <cstdio>
#include <cstdint>
#include <cmath>
#define GAS __attribute__((address_space(1)))
#define LAS __attribute__((address_space(3)))
namespace pg8 {
#define PG8_LAS __attribute__((address_space(3)))
typedef unsigned short bf16_t;
typedef short bf16x8 __attribute__((ext_vector_type(8)));
typedef float f32x4 __attribute__((ext_vector_type(4)));
typedef unsigned u32x4 __attribute__((ext_vector_type(4)));
constexpr int BM = 256, BK = 64, HALF = 128, HTB = HALF * BK * 2  , STAGE_BYTES = 8 * HTB, NXCD = 8, WGM = 8;

__host__ __device__ __forceinline__ int lds_byte(int r, int c) { const int st = (r >> 4) * 2 + (c >> 5), rr = r & 15, cc = c & 31, ob = rr * 64 + cc * 2; return st * 1024 + (ob ^ (((ob >> 9) & 1) << 5)); }
__host__ __device__ __forceinline__ void stage_rc(int b, int& R, int& C) { const int st = b / 1024, sb = b % 1024, swz = sb ^ (((sb >> 9) & 1) << 5); R = (st >> 1) * 16 + swz / 64; C = (st & 1) * 32 + (swz % 64) / 2; }
__host__ __device__ __forceinline__ int perm32(int rho) { const int n = rho >> 4, i = rho & 15; return 8 * (i >> 2) + 4 * n + (i & 3); }

struct Unit { int pm, pn; };
struct Gemm { const bf16_t* A; const bf16_t* Bt; int M, N, K; };

struct StaticOrder {
    int nM, nN, nwg, G, c;
    __host__ __device__ void init(int M, int N, int G_, int c_) { nM = M / BM; nN = N / BM; nwg = nM * nN; G = G_; c = c_; }
    __host__ __device__ bool next(int i, Unit& u) const {
        const long L = (long)i * G + c; if (L >= nwg) return false;
        int wgid = (int)L; { const int q = nwg / NXCD, r = nwg % NXCD, xcd = wgid % NXCD, off = wgid / NXCD; wgid = (xcd < r ? xcd * (q + 1) : r * (q + 1) + (xcd - r) * q) + off; }
        const int nig = WGM * nN, gid = wgid / nig, fm = gid * WGM, gsz = (nM - fm) < WGM ? (nM - fm) : WGM;
        u.pm = fm + ((wgid % nig) % gsz); u.pn = (wgid % nig) / gsz; return true;
    }
    __device__ __forceinline__ void a_ready(const Unit&) const {}
    __device__ __forceinline__ void done(const Unit&) const {}
};

__device__ __forceinline__ unsigned cvt_pk_bf16(float lo, float hi) { unsigned r; asm volatile("v_cvt_pk_bf16_f32 %0, %1, %2" : "=v"(r) : "v"(lo), "v"(hi)); return r; }
typedef float f32x2 __attribute__((ext_vector_type(2)));
typedef _Float16 f16x2 __attribute__((ext_vector_type(2)));
__device__ __forceinline__ unsigned pkh2(float a, float b) { const f16x2 h = {(_Float16)a, (_Float16)b}; return __builtin_bit_cast(unsigned, h); }
__device__ __forceinline__ float uph_lo(unsigned w) { return (float)__builtin_bit_cast(f16x2, w).x; }
__device__ __forceinline__ float uph_hi(unsigned w) { return (float)__builtin_bit_cast(f16x2, w).y; }

template <class Epi, class Sched, bool ALIGN_EPI = false, bool SP2 = false>
__device__ __forceinline__ void gemm_phase(PG8_LAS unsigned char* lds, const Gemm g, const Sched& S, const Epi& E, int tid_in) {
    int tid_ = tid_in; asm volatile("" : "+v"(tid_));
    const int tid = tid_, wid = __builtin_amdgcn_readfirstlane(tid >> 6), lane = tid & 63, wr = wid >> 2, wc = wid & 3, fr = lane & 15, fq = lane >> 4;
    const int K = g.K, nt = K / BK;
    unsigned voffA[2], voffB[2];
#pragma unroll
    for (int i = 0; i < 2; ++i) { int R, C; stage_rc(tid * 16 + i * 8192, R, C); const int Rb = Epi::PERM ? ((R & ~31) + perm32(R & 31)) : R;
        voffA[i] = (unsigned)(R * K + C) * 2u; voffB[i] = (unsigned)(Rb * K + C) * 2u; }
    const size_t kstep = (size_t)(BK * 2);
    const size_t hstep = (size_t)HALF * K * 2;
    const size_t tstep = 2 * hstep;
    const unsigned ldsw = (unsigned)wid * 1024u;
    const int aoff = lds_byte(wr * 64 + fr, fq * 8), boff = lds_byte(wc * 32 + fr, fq * 8);
#define PG8_SA(b, h) (((b) * 2 + (h)) * HTB)
#define PG8_SB(b, h) ((4 + (b) * 2 + (h)) * HTB)
#define PG8_STAGE(bufoff, gbase, voff) do { _Pragma("unroll") for (int _i = 0; _i < 2; ++_i) \
        __builtin_amdgcn_global_load_lds((const unsigned*)((const char*)(gbase) + (voff)[_i]), (PG8_LAS unsigned*)(lds + (bufoff) + ldsw + _i * 8192), 16, 0, 0); } while (0)
#define PG8_LDA(dst, b, h) do { _Pragma("unroll") for (int m = 0; m < 4; ++m) _Pragma("unroll") for (int k = 0; k < 2; ++k) dst[m][k] = *(const PG8_LAS bf16x8*)(lds + PG8_SA(b, h) + aoff + m * 2048 + k * 1024); } while (0)
#define PG8_LDB(dst, b, h) do { _Pragma("unroll") for (int n = 0; n < 2; ++n) _Pragma("unroll") for (int k = 0; k < 2; ++k) dst[n][k] = *(const PG8_LAS bf16x8*)(lds + PG8_SB(b, h) + boff + n * 2048 + k * 1024); } while (0)
#define PG8_MMA(ai, bj, At, Bt) do { __builtin_amdgcn_s_setprio(1); _Pragma("unroll") for (int m = 0; m < 4; ++m) _Pragma("unroll") for (int n = 0; n < 2; ++n) _Pragma("unroll") for (int k = 0; k < 2; ++k) \
        acc[ai][bj][m][n] = __builtin_amdgcn_mfma_f32_16x16x32_bf16(Bt[n][k], At[m][k], acc[ai][bj][m][n], 0, 0, 0); __builtin_amdgcn_s_setprio(0); } while (0)
#define PG8_WAIT_V(n) asm volatile("s_waitcnt vmcnt(" #n ")" ::: "memory")
#define PG8_WAIT_L(n) asm volatile("s_waitcnt lgkmcnt(" #n ")" ::: "memory")
#define PG8_BAR __builtin_amdgcn_s_barrier()
#define PG8_SCHED __builtin_amdgcn_sched_barrier(0)
    Unit cur, nxt; int ui = 0;
    if (!S.next(0, cur)) return;
    f32x4 acc[2][2][4][2];
#pragma unroll
    for (int a = 0; a < 2; ++a)
#pragma unroll
        for (int b = 0; b < 2; ++b)
#pragma unroll
            for (int m = 0; m < 4; ++m)
#pragma unroll
                for (int n = 0; n < 2; ++n) acc[a][b][m][n] = (f32x4){0.f, 0.f, 0.f, 0.f};
    bf16x8 At[4][2], B0[2][2], B1[2][2];
    const char* cA = (const char*)g.A + (size_t)cur.pm * tstep; const char* cB = (const char*)g.Bt + (size_t)cur.pn * tstep;
    S.a_ready(cur);
    if constexpr (SP2) {
        PG8_STAGE(PG8_SB(0, 0), cB, voffB); PG8_STAGE(PG8_SB(0, 1), cB + hstep, voffB); PG8_STAGE(PG8_SA(0, 0), cA, voffA); PG8_STAGE(PG8_SA(0, 1), cA + hstep, voffA);
        if (wr == 1) PG8_BAR;
        PG8_WAIT_V(2); PG8_BAR;
        PG8_STAGE(PG8_SB(1, 0), cB + kstep, voffB); PG8_STAGE(PG8_SA(1, 0), cA + kstep, voffA); PG8_STAGE(PG8_SB(1, 1), cB + hstep + kstep, voffB);
        PG8_WAIT_V(6); PG8_BAR;
    } else {
        PG8_STAGE(PG8_SB(0, 0), cB, voffB); PG8_STAGE(PG8_SA(0, 0), cA, voffA); PG8_STAGE(PG8_SB(0, 1), cB + hstep, voffB); PG8_STAGE(PG8_SA(0, 1), cA + hstep, voffA);
        if (wr == 1) PG8_BAR;
        PG8_WAIT_V(4); PG8_BAR;
        PG8_STAGE(PG8_SB(1, 0), cB + kstep, voffB); PG8_STAGE(PG8_SA(1, 0), cA + kstep, voffA); PG8_STAGE(PG8_SB(1, 1), cB + hstep + kstep, voffB);
        PG8_WAIT_V(6); PG8_BAR;
    }
    for (;;) {
        const bool has_next = S.next(ui + 1, nxt);
        const char* nA = has_next ? (const char*)g.A + (size_t)nxt.pm * tstep : cA; const char* nB = has_next ? (const char*)g.Bt + (size_t)nxt.pn * tstep : cB;
        for (int t = 0; t < nt; t += 2) {
            const bool last = (t == nt - 2);
            const char* a1 = cA + (size_t)(t + 1) * kstep;
            const char* a2 = last ? nA : cA + (size_t)(t + 2) * kstep; const char* b2 = last ? nB : cB + (size_t)(t + 2) * kstep;
            const char* a3 = a2 + kstep; const char* b3 = b2 + kstep;
            if (last && has_next) S.a_ready(nxt);
            if constexpr (SP2) {
            PG8_LDB(B0, 0, 0); PG8_LDB(B1, 0, 1); PG8_SCHED; PG8_LDA(At, 0, 0); PG8_STAGE(PG8_SA(1, 1), a1 + hstep, voffA);
            PG8_WAIT_V(8); PG8_WAIT_L(0); PG8_BAR; PG8_MMA(0, 0, At, B0); PG8_MMA(0, 1, At, B1); PG8_BAR; PG8_SCHED;
            PG8_LDA(At, 0, 1); PG8_STAGE(PG8_SB(0, 0), b2, voffB); PG8_STAGE(PG8_SB(0, 1), b2 + hstep, voffB); PG8_STAGE(PG8_SA(0, 0), a2, voffA);
            PG8_WAIT_V(8); PG8_WAIT_L(0); PG8_BAR; PG8_MMA(1, 0, At, B0); PG8_MMA(1, 1, At, B1); PG8_BAR; PG8_SCHED;
            PG8_LDB(B0, 1, 0); PG8_LDB(B1, 1, 1); PG8_SCHED; PG8_LDA(At, 1, 0); PG8_STAGE(PG8_SA(0, 1), a2 + hstep, voffA);
            PG8_WAIT_V(8); PG8_WAIT_L(0); PG8_BAR; PG8_MMA(0, 0, At, B0); PG8_MMA(0, 1, At, B1); PG8_BAR; PG8_SCHED;
            PG8_LDA(At, 1, 1); PG8_STAGE(PG8_SB(1, 0), b3, voffB); PG8_STAGE(PG8_SB(1, 1), b3 + hstep, voffB); PG8_STAGE(PG8_SA(1, 0), a3, voffA);
            PG8_WAIT_V(8); PG8_WAIT_L(0); PG8_BAR; PG8_MMA(1, 0, At, B0); PG8_MMA(1, 1, At, B1); PG8_BAR; PG8_SCHED;
            } else {
            PG8_LDB(B0, 0, 0); PG8_SCHED; PG8_LDA(At, 0, 0); PG8_STAGE(PG8_SA(1, 1), a1 + hstep, voffA);
            PG8_WAIT_L(8); PG8_BAR; PG8_WAIT_L(0); PG8_MMA(0, 0, At, B0); PG8_BAR; PG8_SCHED;
            PG8_LDB(B1, 0, 1); PG8_STAGE(PG8_SB(0, 0), b2, voffB);
            PG8_BAR; PG8_WAIT_L(0); PG8_MMA(0, 1, At, B1); PG8_BAR;
            PG8_LDA(At, 0, 1); PG8_STAGE(PG8_SA(0, 0), a2, voffA);
            PG8_BAR; PG8_WAIT_L(0); PG8_MMA(1, 0, At, B0); PG8_BAR; PG8_SCHED;
            PG8_STAGE(PG8_SB(0, 1), b2 + hstep, voffB);
            PG8_WAIT_V(6); PG8_BAR; PG8_MMA(1, 1, At, B1); PG8_BAR;
            PG8_LDB(B0, 1, 0); PG8_SCHED; PG8_LDA(At, 1, 0); PG8_STAGE(PG8_SA(0, 1), a2 + hstep, voffA);
            PG8_WAIT_L(8); PG8_BAR; PG8_WAIT_L(0); PG8_MMA(0, 0, At, B0); PG8_BAR; PG8_SCHED;
            PG8_LDB(B1, 1, 1); PG8_STAGE(PG8_SB(1, 0), b3, voffB);
            PG8_BAR; PG8_WAIT_L(0); PG8_MMA(0, 1, At, B1); PG8_BAR;
            PG8_LDA(At, 1, 1); PG8_STAGE(PG8_SA(1, 0), a3, voffA);
            PG8_BAR; PG8_WAIT_L(0); PG8_MMA(1, 0, At, B0); PG8_BAR; PG8_SCHED;
            PG8_STAGE(PG8_SB(1, 1), b3 + hstep, voffB);
            PG8_WAIT_V(6); PG8_BAR; PG8_MMA(1, 1, At, B1); PG8_BAR;
            }
        }
        if constexpr (ALIGN_EPI) { if (wr == 0) PG8_BAR; }
        if constexpr (!Epi::AFTER_DRAIN) { E(acc, cur, wr, wc, fr, fq); S.done(cur); }
        if (!has_next) break;
#pragma unroll
        for (int a = 0; a < 2; ++a)
#pragma unroll
            for (int b = 0; b < 2; ++b)
#pragma unroll
                for (int m = 0; m < 4; ++m)
#pragma unroll
                    for (int n = 0; n < 2; ++n) acc[a][b][m][n] = (f32x4){0.f, 0.f, 0.f, 0.f};
        cur = nxt; cA = nA; cB = nB; ++ui;
        if constexpr (ALIGN_EPI) { if (wr == 1) PG8_BAR; }
    }
    PG8_WAIT_V(0);
    if constexpr (!ALIGN_EPI) { if (wr == 0) PG8_BAR; }
    PG8_BAR;
    if constexpr (Epi::AFTER_DRAIN) { E.fused(acc, cur, wr, wc, fr, fq, lds, wid, lane); S.done(cur); }
#undef PG8_SA
#undef PG8_SB
#undef PG8_STAGE
#undef PG8_LDA
#undef PG8_LDB
#undef PG8_MMA
#undef PG8_WAIT_V
#undef PG8_WAIT_L
#undef PG8_BAR
#undef PG8_SCHED
}
}
#define XB_TMO      128
#define XB_XCNT(j)  (256  + 64 * (j))
#define XB_XSUB(j)  (1280 + 64 * (j))
#define XB_XGEN(j)  (2304 + 64 * (j))
#define XB_TOP      3328
#define XB_TOPGEN   3392
#define XCD_BAR_WORDS 3456
#define XB_SPIN_CAP (1u << 18)

__device__ __forceinline__ unsigned xb_ld(unsigned* p)              { return __hip_atomic_load(p, __ATOMIC_RELAXED, __HIP_MEMORY_SCOPE_AGENT); }
__device__ __forceinline__ unsigned xb_add(unsigned* p, unsigned v) { return __hip_atomic_fetch_add(p, v, __ATOMIC_RELAXED, __HIP_MEMORY_SCOPE_AGENT); }
__device__ __forceinline__ unsigned xb_xcc_id() { return (unsigned)__builtin_amdgcn_s_getreg((3 << 11) | 20) & 0xFu; }
#define XB_SPIN(cond, bar) do { unsigned _sp = 0; while (cond) { __builtin_amdgcn_s_sleep(1); \
    if ((++_sp & 255u) == 0u) { if (xb_ld(&(bar)[XB_TMO])) break; if (_sp > XB_SPIN_CAP) { atomicAdd(&(bar)[XB_TMO], 1u); break; } } } } while (0)

struct XcdBarrier {
    unsigned* bar; unsigned x;
    volatile LAS unsigned* st;
};

__device__ __forceinline__ XcdBarrier xcd_barrier_post(unsigned* bar, volatile LAS unsigned* st) {
    XcdBarrier b; b.bar = bar; b.x = xb_xcc_id(); b.st = st;
    if (threadIdx.x == 0) (void)xb_add(&bar[XB_XCNT(b.x)], 1u);
    return b;
}
__device__ __forceinline__ void xcd_barrier_complete(unsigned* bar, unsigned x, unsigned& nloc, unsigned& nx) {
    const unsigned G = gridDim.x * gridDim.y * gridDim.z;
    unsigned sum, cnt, mine, sp = 0u;
    for (;;) {
        sum = 0u; cnt = 0u; mine = 0u;
#pragma unroll
        for (unsigned j = 0; j < 16; ++j) { const unsigned c = xb_ld(&bar[XB_XCNT(j)]); sum += c; cnt += (c > 0u) ? 1u : 0u; mine = (j == x) ? c : mine; }
        if (sum == G) break;
        __builtin_amdgcn_s_sleep(1);
        if ((++sp & 255u) == 0u) { if (xb_ld(&bar[XB_TMO])) break; if (sp > XB_SPIN_CAP) { atomicAdd(&bar[XB_TMO], 1u); break; } }
    }
    nloc = mine > 0u ? mine : 1u; nx = cnt > 0u ? cnt : 1u;
}

__device__ __forceinline__ void xcd_barrier(const XcdBarrier& b, bool leader) {
    asm volatile("s_waitcnt vmcnt(0)" ::: "memory");
    __syncthreads();
    if (leader) {
        unsigned* bar = b.bar;
        __builtin_amdgcn_s_waitcnt(0);
        unsigned nloc = b.st[0], nx = b.st[1];
        if (nloc == 0u) { xcd_barrier_complete(bar, b.x, nloc, nx); b.st[0] = nloc; b.st[1] = nx; }
        const unsigned old = xb_add(&bar[XB_XSUB(b.x)], 1u);
        const unsigned gen = old / nloc;
        if (old + 1u == (gen + 1u) * nloc) {
            __builtin_amdgcn_fence(__ATOMIC_RELEASE, "agent");
            asm volatile("s_waitcnt vmcnt(0)" ::: "memory");
            const unsigned og = xb_add(&bar[XB_TOP], 1u);
            const unsigned tg = og / nx;
            if (og + 1u == (tg + 1u) * nx) xb_add(&bar[XB_TOPGEN], 1u);
            else XB_SPIN(xb_ld(&bar[XB_TOPGEN]) == tg, bar);
            __builtin_amdgcn_fence(__ATOMIC_ACQUIRE, "agent");
            xb_add(&bar[XB_XGEN(b.x)], 1u);
            asm volatile("s_waitcnt vmcnt(0)" ::: "memory");
        } else {
            XB_SPIN(xb_ld(&bar[XB_XGEN(b.x)]) == gen, bar);
            __builtin_amdgcn_fence(__ATOMIC_ACQUIRE, "agent");
            asm volatile("s_waitcnt vmcnt(0)" ::: "memory");
        }
    }
    __syncthreads();
}

typedef unsigned short bf16;
typedef unsigned v4u __attribute__((ext_vector_type(4)));
typedef unsigned v2u __attribute__((ext_vector_type(2)));
typedef float f32x4 __attribute__((ext_vector_type(4)));
typedef float f32x16 __attribute__((ext_vector_type(16)));
typedef short bf16x8 __attribute__((ext_vector_type(8)));
#define LDS_WAIT() asm volatile("s_waitcnt lgkmcnt(0)" ::: "memory")
#define VM_WAIT() asm volatile("s_waitcnt vmcnt(0)" ::: "memory")

constexpr int NWAVES = 8, NTHREADS = 512;
constexpr int BATCH = 2, SEQ = 8192, M = BATCH * SEQ, D = 2048, DEPTH = 4;
constexpr int IN_COLS = 4160, IN_PAD = 4352;
constexpr int C_DAQ = 0, C_DAK = 768, C_DAV = 1536, C_QA = 2304, C_KVA = 2816, C_KR = 3072, C_SGU = 3136, C_SGV = 3648;
constexpr int DFF = 5632, NUP = 2 * DFF;
constexpr int UQ_N = 1152, UQ_PAD = 1536, UKV_N = 1536, QRANK = 512, KVRANK = 256;
constexpr int NH = 6;
constexpr float EPS = 1e-6f;
constexpr float LOG2E = 1.4426950408889634f;
constexpr float QS_DA = 0.125f * LOG2E;
constexpr float QS_MLA = 0.07216878364870322f * LOG2E;

enum { I_X = 0, I_C, I_POS, I_WADA, I_BADA, I_WIN, I_DAQG, I_DAKG, I_LQ1, I_LK1, I_LQ2, I_LK2, I_DAHG, I_QAG, I_WUQ, I_KVAG, I_WUKV, I_MQG, I_MKG, I_SGVG, I_SGW, I_SGB, I_WOUT, I_WUP, I_CONVW, I_CONVB, I_WDOWN, N_IN };

constexpr size_t MiB = 1u << 20;
constexpr size_t WS_CTL = 0, CTL_ZERO_BYTES = 1 * MiB;
constexpr size_t WS_MOD = 1 * MiB;
constexpr size_t WS_POSMM = 1 * MiB + 512 * 1024;
constexpr size_t WS_MODP = 2 * MiB;
constexpr size_t WS_W = 8 * MiB;
constexpr size_t WL_IN = 0, WL_UQ = 17 * MiB, WL_UKV = WL_UQ + 1572864, WL_OUT = 20 * MiB, WL_UP = 28 * MiB, WL_DOWN = 72 * MiB, WL_STRIDE = 94 * MiB;
constexpr size_t WS_H = 384 * MiB;
constexpr size_t WS_MIX = 448 * MiB;
constexpr size_t WS_U = 512 * MiB;
constexpr size_t WS_R = 688 * MiB;
constexpr size_t WS_KR = WS_R;
constexpr size_t WS_SSQ_QA = WS_R + 4 * MiB, WS_SSQ_KVA = WS_R + 5 * MiB, WS_SSQ_SGV = WS_R + 6 * MiB, WS_SSQ_KR = WS_R + 7 * MiB;
constexpr size_t WS_QD = WS_R + 272 * MiB, WS_KD = WS_R + 296 * MiB, WS_VD = WS_R + 320 * MiB;
constexpr size_t WS_QM = WS_R + 344 * MiB, WS_KM = WS_R + 380 * MiB, WS_VM = WS_R + 416 * MiB;
constexpr size_t WS_QA = WS_R + 440 * MiB, WS_KVA = WS_R + 456 * MiB;
constexpr size_t WS_MLQ = WS_R + 464 * MiB, WS_MLKV = WS_R + 544 * MiB;
constexpr size_t WS_XB = WS_R + 464 * MiB;
constexpr size_t WS_UU = WS_R + 640 * MiB, WS_GV = WS_R + 672 * MiB;
constexpr size_t WS_EDGE = WS_R;
constexpr size_t WS_A = WS_R;
constexpr size_t WS_O1 = WS_R + 704 * MiB;
constexpr size_t WS_COS = WS_R + 752 * MiB, WS_SIN = WS_R + 754 * MiB;
constexpr size_t WS_END = WS_R + 756 * MiB;

constexpr int RING_BYTES = 131072;
constexpr int LDSCTL_OFF = RING_BYTES;
constexpr int LDS_BYTES = 147456;

__device__ const float ROPE_INV[32] = {1.000000000e+00f, 7.498942614e-01f, 5.623413324e-01f, 4.216965139e-01f, 3.162277639e-01f, 2.371373773e-01f, 1.778279394e-01f, 1.333521307e-01f, 1.000000015e-01f, 7.498941571e-02f, 5.623413250e-02f, 4.216965288e-02f, 3.162277490e-02f, 2.371373773e-02f, 1.778279431e-02f, 1.333521493e-02f, 9.999999776e-03f, 7.498941850e-03f, 5.623413250e-03f, 4.216964822e-03f, 3.162277630e-03f, 2.371373586e-03f, 1.778279431e-03f, 1.333521446e-03f, 1.000000047e-03f, 7.498942432e-04f, 5.623413017e-04f, 4.216965172e-04f, 3.162277571e-04f, 2.371373703e-04f, 1.778279402e-04f, 1.333521504e-04f};
__device__ const float ALIBI_SLOPE[6] = {0.3968502629920499f, 0.15749013123685915f, 0.0625f, 0.024803141437003122f, 0.0098431332023036951f, 0.00390625f};
__device__ const float LAM_INIT[4] = {0.20000000000000007f, 0.35550906759096934f, 0.4707130183435842f, 0.5560582041556406f};

struct Args { const void* in[N_IN]; float* out; unsigned char* ws; int ph; int l; };

__device__ __forceinline__ unsigned f2bf(float f) { unsigned u = __builtin_bit_cast(unsigned, f); return (u + 0x7fffu + ((u >> 16) & 1u)) >> 16; }
__device__ __forceinline__ unsigned pk2(float lo, float hi) { return f2bf(lo) | (f2bf(hi) << 16); }
__device__ __forceinline__ float bf2f(unsigned short h) { return __builtin_bit_cast(float, (unsigned)h << 16); }
template <int CTRL> __device__ __forceinline__ float dpp_mov(float v) { return __builtin_bit_cast(float, __builtin_amdgcn_update_dpp(0, __builtin_bit_cast(int, v), CTRL, 0xF, 0xF, true)); }
__device__ __forceinline__ float sum16(float v) { v += dpp_mov<0xB1>(v); v += dpp_mov<0x4E>(v); v += dpp_mov<0x141>(v); v += dpp_mov<0x140>(v); return v; }
__device__ __forceinline__ float sum32(float v) { v = sum16(v); auto r = __builtin_amdgcn_permlane16_swap(__float_as_uint(v), __float_as_uint(v), false, false); return __uint_as_float(r[0]) + __uint_as_float(r[1]); }
__device__ __forceinline__ float wave_sum(float v) { v = sum32(v); auto r = __builtin_amdgcn_permlane32_swap(__float_as_uint(v), __float_as_uint(v), false, false); return __uint_as_float(r[0]) + __uint_as_float(r[1]); }
__device__ __forceinline__ float wave_max(float v) { v = fmaxf(v, dpp_mov<0xB1>(v)); v = fmaxf(v, dpp_mov<0x4E>(v)); v = fmaxf(v, dpp_mov<0x141>(v)); v = fmaxf(v, dpp_mov<0x140>(v));
    { auto r = __builtin_amdgcn_permlane16_swap(__float_as_uint(v), __float_as_uint(v), false, false); v = fmaxf(__uint_as_float(r[0]), __uint_as_float(r[1])); }
    { auto r = __builtin_amdgcn_permlane32_swap(__float_as_uint(v), __float_as_uint(v), false, false); v = fmaxf(__uint_as_float(r[0]), __uint_as_float(r[1])); } return v; }
__device__ __forceinline__ float xor32(float v, int lane) { auto r = __builtin_amdgcn_permlane32_swap(__float_as_uint(v), __float_as_uint(v), false, false); return lane < 32 ? __uint_as_float(r[1]) : __uint_as_float(r[0]); }
__device__ __forceinline__ float gelu_tanh(float x) {
    const float u = 0.7978845608028654f * (x + 0.044715f * x * x * x);
    const float e = __expf(2.0f * u);
    const float th = 1.0f - 2.0f / (e + 1.0f);
    return 0.5f * x * (1.0f + th);
}
__device__ __forceinline__ float silu_f(float x) { return x / (1.0f + __expf(-x)); }
__device__ __forceinline__ int crow(int r, int hi) { return (r & 3) + 8 * (r >> 2) + 4 * hi; }

namespace pg8 {
struct EpiF32 {
    static constexpr bool PERM = false, AFTER_DRAIN = false;
    float* C; int ldc;
    __device__ __forceinline__ void operator()(const f32x4 (&acc)[2][2][4][2], const Unit& u, int wr, int wc, int fr, int fq) const {
        const int row0 = u.pm * BM + wr * 64 + fr, col0 = u.pn * BM + wc * 32 + 4 * fq;
#pragma unroll
        for (int ai = 0; ai < 2; ++ai)
#pragma unroll
            for (int m = 0; m < 4; ++m) { float* rowp = C + (size_t)(row0 + ai * HALF + m * 16) * ldc + col0;
#pragma unroll
                for (int bj = 0; bj < 2; ++bj)
#pragma unroll
                    for (int n = 0; n < 2; ++n) *(f32x4*)(rowp + bj * HALF + n * 16) = acc[ai][bj][m][n]; }
    }
};
struct EpiNull {
    static constexpr bool PERM = true, AFTER_DRAIN = false;
    float* C;
    __device__ __forceinline__ void operator()(const f32x4 (&acc)[2][2][4][2], const Unit& u, int wr, int wc, int fr, int fq) const {
        f32x4 s = {0.f, 0.f, 0.f, 0.f};
#pragma unroll
        for (int ai = 0; ai < 2; ++ai)
#pragma unroll
            for (int bj = 0; bj < 2; ++bj)
#pragma unroll
                for (int m = 0; m < 4; ++m)
#pragma unroll
                    for (int n = 0; n < 2; ++n) s += acc[ai][bj][m][n];
        C[(size_t)(u.pm * 44 + u.pn) * 512 + (wr * 4 + wc) * 64 + fq * 16 + fr] = (s[0] + s[1]) + (s[2] + s[3]);
    }
};
struct EpiResid {
    static constexpr bool PERM = false, AFTER_DRAIN = false;
    const float* xin; float* out; int ldc; const float* gate; int gate_stride;
    __device__ __forceinline__ void operator()(const f32x4 (&acc)[2][2][4][2], const Unit& u, int wr, int wc, int fr, int fq) const {
        const int row0 = u.pm * BM + wr * 64 + fr, col0 = u.pn * BM + wc * 32 + 4 * fq;
        const float* gp = gate + (size_t)((u.pm * BM) / SEQ) * gate_stride + col0;
        f32x4 gv[2][2];
#pragma unroll
        for (int bj = 0; bj < 2; ++bj)
#pragma unroll
            for (int n = 0; n < 2; ++n) gv[bj][n] = *(const f32x4*)(gp + bj * HALF + n * 16);
#pragma unroll
        for (int ai = 0; ai < 2; ++ai) {
            f32x4 xv[4][2][2];
#pragma unroll
            for (int m = 0; m < 4; ++m) { const size_t off = (size_t)(row0 + ai * HALF + m * 16) * ldc + col0;
#pragma unroll
                for (int bj = 0; bj < 2; ++bj)
#pragma unroll
                    for (int n = 0; n < 2; ++n) xv[m][bj][n] = *(const f32x4*)(xin + off + bj * HALF + n * 16); }
#pragma unroll
            for (int m = 0; m < 4; ++m) { const size_t off = (size_t)(row0 + ai * HALF + m * 16) * ldc + col0;
#pragma unroll
                for (int bj = 0; bj < 2; ++bj)
#pragma unroll
                    for (int n = 0; n < 2; ++n) *(f32x4*)(out + off + bj * HALF + n * 16) = xv[m][bj][n] + gv[bj][n] * acc[ai][bj][m][n]; }
        }
    }
};
struct EpiResidP {
    static constexpr bool PERM = true, AFTER_DRAIN = false;
    const void* xin; void* out; int inb, outb; const float* gate; int gate_stride;
    __device__ __forceinline__ void put(unsigned eo, const f32x4 r0, const f32x4 r1) const {
        if (outb) *(u32x4*)((char*)out + eo * 2u) = (u32x4){pkh2(r0[0], r0[1]), pkh2(r0[2], r0[3]), pkh2(r1[0], r1[1]), pkh2(r1[2], r1[3])};
        else { *(f32x4*)((char*)out + eo * 4u) = r0; *(f32x4*)((char*)out + eo * 4u + 16u) = r1; } }
    __device__ __forceinline__ void operator()(const f32x4 (&acc)[2][2][4][2], const Unit& u, int wr, int wc, int fr_, int fq_) const {
        int fr = fr_, fq = fq_; asm volatile("" : "+v"(fr), "+v"(fq));
        const int row0 = u.pm * BM + wr * 64 + fr, col0 = u.pn * BM + wc * 32 + 8 * fq;
        const unsigned lo = (unsigned)(row0 * 2048 + col0);
        const float* gp = gate + (size_t)((u.pm * BM) / SEQ) * gate_stride + col0;
        f32x4 gv[2][2];
#pragma unroll
        for (int bj = 0; bj < 2; ++bj)
#pragma unroll
            for (int n = 0; n < 2; ++n) gv[bj][n] = *(const f32x4*)(gp + bj * HALF + 4 * n);
        if (inb) {
            u32x4 xb[2][4][2];
#pragma unroll
            for (int ai = 0; ai < 2; ++ai)
#pragma unroll
                for (int m = 0; m < 4; ++m)
#pragma unroll
                    for (int bj = 0; bj < 2; ++bj) xb[ai][m][bj] = *(const u32x4*)((const char*)xin + (lo + (unsigned)((ai * HALF + m * 16) * 2048 + bj * HALF)) * 2u);
#pragma unroll
            for (int ai = 0; ai < 2; ++ai)
#pragma unroll
                for (int m = 0; m < 4; ++m)
#pragma unroll
                    for (int bj = 0; bj < 2; ++bj) { const u32x4 w = xb[ai][m][bj];
                        const f32x4 x0 = {uph_lo(w.x), uph_hi(w.x), uph_lo(w.y), uph_hi(w.y)};
                        const f32x4 x1 = {uph_lo(w.z), uph_hi(w.z), uph_lo(w.w), uph_hi(w.w)};
                        put(lo + (unsigned)((ai * HALF + m * 16) * 2048 + bj * HALF), x0 + gv[bj][0] * acc[ai][bj][m][0], x1 + gv[bj][1] * acc[ai][bj][m][1]); }
        } else {
#pragma unroll
            for (int ai = 0; ai < 2; ++ai) {
                f32x4 xv[4][2][2];
#pragma unroll
                for (int m = 0; m < 4; ++m)
#pragma unroll
                    for (int bj = 0; bj < 2; ++bj)
#pragma unroll
                        for (int n = 0; n < 2; ++n) xv[m][bj][n] = *(const f32x4*)((const char*)xin + (lo + (unsigned)((ai * HALF + m * 16) * 2048 + bj * HALF + 4 * n)) * 4u);
#pragma unroll
                for (int m = 0; m < 4; ++m)
#pragma unroll
                    for (int bj = 0; bj < 2; ++bj) put(lo + (unsigned)((ai * HALF + m * 16) * 2048 + bj * HALF), xv[m][bj][0] + gv[bj][0] * acc[ai][bj][m][0], xv[m][bj][1] + gv[bj][1] * acc[ai][bj][m][1]);
            }
        }
    }
};
struct EpiBf16S {
    static constexpr bool PERM = true, AFTER_DRAIN = false;
    bf16_t* O; int ldc;
    __device__ __forceinline__ void operator()(const f32x4 (&acc)[2][2][4][2], const Unit& u, int wr, int wc, int fr, int fq) const {
        const int row0 = u.pm * BM + wr * 64 + fr, col0 = u.pn * BM + wc * 32 + 8 * fq;
#pragma unroll
        for (int ai = 0; ai < 2; ++ai)
#pragma unroll
            for (int m = 0; m < 4; ++m) { bf16_t* rowp = O + (size_t)(row0 + ai * HALF + m * 16) * ldc + col0;
#pragma unroll
                for (int bj = 0; bj < 2; ++bj) { const f32x4 v0 = acc[ai][bj][m][0], v1 = acc[ai][bj][m][1]; u32x4 w;
                    w.x = cvt_pk_bf16(v0[0], v0[1]); w.y = cvt_pk_bf16(v0[2], v0[3]); w.z = cvt_pk_bf16(v1[0], v1[1]); w.w = cvt_pk_bf16(v1[2], v1[3]);
                    *(u32x4*)(rowp + bj * HALF) = w; } }
    }
};
template <int CTRL> __device__ __forceinline__ float dppf(float old, float src) { return __builtin_bit_cast(float, __builtin_amdgcn_update_dpp(__builtin_bit_cast(int, old), __builtin_bit_cast(int, src), CTRL, 0xF, 0xF, false)); }
struct EpiConvGate {
    static constexpr bool PERM = true, AFTER_DRAIN = false;
    bf16_t* U; unsigned short* EDGE; const float* cw; const float* cb;
    __device__ __forceinline__ void operator()(const f32x4 (&acc)[2][2][4][2], const Unit& u, int wr, int wc, int fr, int fq) const {
        const int ch0 = u.pn * 128 + wc * 32 + 8 * fq, rowb = u.pm * BM + wr * 64;
#pragma unroll
        for (int ai = 0; ai < 2; ++ai) { const int blk = (rowb + ai * HALF) >> 6;
            if (fr < 2) { unsigned short* e = EDGE + ((size_t)(blk * 4 + fr) * 2) * DFF + ch0;
#pragma unroll
                for (int bj = 0; bj < 2; ++bj) { const f32x4 a0 = acc[ai][bj][0][0], a1 = acc[ai][bj][0][1]; *(u32x4*)(e + bj * DFF) = (u32x4){pkh2(a0[0], a0[1]), pkh2(a0[2], a0[3]), pkh2(a1[0], a1[1]), pkh2(a1[2], a1[3])}; } }
            if (fr >= 14) { unsigned short* e = EDGE + ((size_t)(blk * 4 + fr - 12) * 2) * DFF + ch0;
#pragma unroll
                for (int bj = 0; bj < 2; ++bj) { const f32x4 a0 = acc[ai][bj][3][0], a1 = acc[ai][bj][3][1]; *(u32x4*)(e + bj * DFF) = (u32x4){pkh2(a0[0], a0[1]), pkh2(a0[2], a0[3]), pkh2(a1[0], a1[1]), pkh2(a1[2], a1[3])}; } }
        }
        f32x4 w[2][2][3], bb[2][2];
#pragma unroll
        for (int n = 0; n < 2; ++n)
#pragma unroll
            for (int bj = 0; bj < 2; ++bj) { bb[n][bj] = *(const f32x4*)(cb + bj * DFF + ch0 + 4 * n);
#pragma unroll
                for (int j = 0; j < 3; ++j) w[n][bj][j] = *(const f32x4*)(cw + (size_t)j * (2 * DFF) + bj * DFF + ch0 + 4 * n); }
#pragma unroll
        for (int ai = 0; ai < 2; ++ai)
#pragma unroll
            for (int m = 0; m < 4; ++m) {
                unsigned pkw[4];
#pragma unroll
                for (int n = 0; n < 2; ++n) {
                    f32x4 y[2];
#pragma unroll
                    for (int bj = 0; bj < 2; ++bj) { const f32x4 cur = acc[ai][bj][m][n]; const f32x4 prv = m > 0 ? acc[ai][bj][m - 1][n] : (f32x4){0.f, 0.f, 0.f, 0.f};
                        f32x4 s1, s2;
#pragma unroll
                        for (int e = 0; e < 4; ++e) {
                            if (m > 0) { s1[e] = dppf<0x111>(dpp_mov<0x121>(prv[e]), cur[e]); s2[e] = dppf<0x112>(dpp_mov<0x122>(prv[e]), cur[e]); }
                            else { s1[e] = dpp_mov<0x111>(cur[e]); s2[e] = dpp_mov<0x112>(cur[e]); } }
                        y[bj] = bb[n][bj] + w[n][bj][2] * cur + w[n][bj][1] * s1 + w[n][bj][0] * s2; }
                    const f32x4 tg = y[0] * -1.4426950408889634f;
                    f32x4 ev; ev[0] = __builtin_amdgcn_exp2f(tg[0]); ev[1] = __builtin_amdgcn_exp2f(tg[1]); ev[2] = __builtin_amdgcn_exp2f(tg[2]); ev[3] = __builtin_amdgcn_exp2f(tg[3]);
                    const f32x4 dn = ev + 1.0f;
                    f32x4 rc; rc[0] = __builtin_amdgcn_rcpf(dn[0]); rc[1] = __builtin_amdgcn_rcpf(dn[1]); rc[2] = __builtin_amdgcn_rcpf(dn[2]); rc[3] = __builtin_amdgcn_rcpf(dn[3]);
                    const f32x4 o = (y[0] * rc) * y[1];
                    pkw[2 * n] = cvt_pk_bf16(o[0], o[1]); pkw[2 * n + 1] = cvt_pk_bf16(o[2], o[3]);
                }
                u32x4 pk; pk.x = pkw[0]; pk.y = pkw[1]; pk.z = pkw[2]; pk.w = pkw[3];
                *(u32x4*)(U + (size_t)(rowb + ai * HALF + m * 16 + fr) * DFF + ch0) = pk;
            }
    }
};
__device__ __forceinline__ float lane_xor16_sum(float v) { auto r = __builtin_amdgcn_permlane16_swap(__float_as_uint(v), __float_as_uint(v), false, false); return __uint_as_float(r[0]) + __uint_as_float(r[1]); }
__device__ __forceinline__ float lane_xor32_sum(float v) { auto r = __builtin_amdgcn_permlane32_swap(__float_as_uint(v), __float_as_uint(v), false, false); return __uint_as_float(r[0]) + __uint_as_float(r[1]); }
__device__ __forceinline__ float sq4(f32x4 v) { return (v[0] * v[0] + v[1] * v[1]) + (v[2] * v[2] + v[3] * v[3]); }
__device__ __forceinline__ u32x4 pk8(f32x4 a, f32x4 b) { u32x4 w; w.x = cvt_pk_bf16(a[0], a[1]); w.y = cvt_pk_bf16(a[2], a[3]); w.z = cvt_pk_bf16(b[0], b[1]); w.w = cvt_pk_bf16(b[2], b[3]); return w; }
__device__ __forceinline__ float gelu_t(float x) { const float u = 0.7978845608028654f * (x + 0.044715f * x * x * x); const float e = __expf(2.0f * u); return 0.5f * x * (2.0f - 2.0f * __builtin_amdgcn_rcpf(e + 1.0f)); }
__device__ __forceinline__ f32x4 gelu4(f32x4 v) { return (f32x4){gelu_t(v[0]), gelu_t(v[1]), gelu_t(v[2]), gelu_t(v[3])}; }
struct EpiInProj {
    static constexpr bool PERM = true, AFTER_DRAIN = false;
    bf16_t *QD, *KD, *VD, *QA, *KVA, *GV; unsigned short* UU; float *KR, *SSQ_QA, *SSQ_KVA, *SSQ_SGV, *SSQ_KR;
    const float *qg, *kg, *qag, *kvag, *sgvg;
    __device__ __forceinline__ void operator()(const f32x4 (&acc)[2][2][4][2], const Unit& u, int wr, int wc, int fr, int fq) const {
        const int pn = u.pn, rowb = u.pm * BM + wr * 64 + fr, b = (u.pm * BM) / SEQ, c8 = wc * 32 + 8 * fq;
        if (pn < 6) {
            const bool isk = pn >= 3; const int G = 4 * (isk ? pn - 3 : pn) + wc;
            const float* gp = isk ? kg : qg;
            const f32x4 g00 = *(const f32x4*)(gp + 8 * fq), g01 = *(const f32x4*)(gp + 8 * fq + 4), g10 = *(const f32x4*)(gp + 32 + 8 * fq), g11 = *(const f32x4*)(gp + 32 + 8 * fq + 4);
            bf16_t* dst = (isk ? KD : QD) + ((size_t)(b * 12 + G) * SEQ) * 64 + 8 * fq;
            const float post = isk ? 1.0f : QS_DA;
#pragma unroll
            for (int ai = 0; ai < 2; ++ai)
#pragma unroll
                for (int m = 0; m < 4; ++m) { const f32x4 v00 = acc[ai][0][m][0], v01 = acc[ai][0][m][1], v10 = acc[ai][1][m][0], v11 = acc[ai][1][m][1];
                    float ss = (sq4(v00) + sq4(v01)) + (sq4(v10) + sq4(v11)); ss = lane_xor16_sum(ss); ss = lane_xor32_sum(ss);
                    const float r = rsqrtf(ss * (1.f / 64) + EPS) * post;
                    bf16_t* d = dst + (size_t)((rowb + ai * HALF + m * 16) & (SEQ - 1)) * 64;
                    *(u32x4*)d = pk8(v00 * g00 * r, v01 * g01 * r); *(u32x4*)(d + 32) = pk8(v10 * g10 * r, v11 * g11 * r); }
        } else if (pn < 9) {
#pragma unroll
            for (int bj = 0; bj < 2; ++bj) { bf16_t* dst = VD + ((size_t)(b * NH + 2 * (pn - 6) + bj) * SEQ) * 128 + c8;
#pragma unroll
                for (int ai = 0; ai < 2; ++ai)
#pragma unroll
                    for (int m = 0; m < 4; ++m) *(u32x4*)(dst + (size_t)((rowb + ai * HALF + m * 16) & (SEQ - 1)) * 128) = pk8(acc[ai][bj][m][0], acc[ai][bj][m][1]); }
        } else if (pn < 12) {
            const bool iskv = pn == 11; const int ct = iskv ? 0 : 256 * (pn - 9);
            const float* gp = (iskv ? kvag : qag) + ct + c8;
            const f32x4 g00 = *(const f32x4*)gp, g01 = *(const f32x4*)(gp + 4), g10 = *(const f32x4*)(gp + HALF), g11 = *(const f32x4*)(gp + HALF + 4);
            bf16_t* dst = (iskv ? KVA : QA) + ct + c8; const int ld = iskv ? KVRANK : QRANK;
            float* sq = iskv ? SSQ_KVA + wc : SSQ_QA + (pn - 9) * 4 + wc; const int sld = iskv ? 4 : 8;
#pragma unroll
            for (int ai = 0; ai < 2; ++ai)
#pragma unroll
                for (int m = 0; m < 4; ++m) { const int row = rowb + ai * HALF + m * 16;
                    const f32x4 v00 = acc[ai][0][m][0], v01 = acc[ai][0][m][1], v10 = acc[ai][1][m][0], v11 = acc[ai][1][m][1];
                    float ss = (sq4(v00) + sq4(v01)) + (sq4(v10) + sq4(v11)); ss = lane_xor16_sum(ss); ss = lane_xor32_sum(ss);
                    if (fq == 0) sq[(size_t)row * sld] = ss;
                    *(u32x4*)(dst + (size_t)row * ld) = pk8(v00 * g00, v01 * g01); *(u32x4*)(dst + (size_t)row * ld + HALF) = pk8(v10 * g10, v11 * g11); }
        } else if (pn < 14) {
            unsigned short* dst = UU + 256 * (pn - 12) + c8;
#pragma unroll
            for (int ai = 0; ai < 2; ++ai)
#pragma unroll
                for (int m = 0; m < 4; ++m) { unsigned short* d = dst + (size_t)(rowb + ai * HALF + m * 16) * 512;
#pragma unroll
                    for (int bj = 0; bj < 2; ++bj) { const f32x4 a = gelu4(acc[ai][bj][m][0]), c = gelu4(acc[ai][bj][m][1]);
                        *(u32x4*)(d + bj * HALF) = (u32x4){pkh2(a[0], a[1]), pkh2(a[2], a[3]), pkh2(c[0], c[1]), pkh2(c[2], c[3])}; } }
        } else if (pn < 16) {
            const int g0 = 2 * (pn - 14);
#pragma unroll
            for (int bj = 0; bj < 2; ++bj) { const float* gp = sgvg + (g0 + bj) * 128 + c8; const f32x4 ga = *(const f32x4*)gp, gb = *(const f32x4*)(gp + 4);
                bf16_t* dst = GV + (g0 + bj) * 128 + c8; float* sq = SSQ_SGV + (g0 + bj) * 4 + wc;
#pragma unroll
                for (int ai = 0; ai < 2; ++ai)
#pragma unroll
                    for (int m = 0; m < 4; ++m) { const int row = rowb + ai * HALF + m * 16; const f32x4 a = gelu4(acc[ai][bj][m][0]), c = gelu4(acc[ai][bj][m][1]);
                        float ss = sq4(a) + sq4(c); ss = lane_xor16_sum(ss); ss = lane_xor32_sum(ss);
                        if (fq == 0) sq[(size_t)row * 16] = ss;
                        *(u32x4*)(dst + (size_t)row * 512) = pk8(a * ga, c * gb); } }
        } else {
            if (wc < 2) {
#pragma unroll
                for (int ai = 0; ai < 2; ++ai)
#pragma unroll
                    for (int m = 0; m < 4; ++m) { const int row = rowb + ai * HALF + m * 16; float* d = KR + (size_t)row * 64 + c8; *(f32x4*)d = acc[ai][0][m][0]; *(f32x4*)(d + 4) = acc[ai][0][m][1];
                        float ss = sq4(acc[ai][0][m][0]) + sq4(acc[ai][0][m][1]); ss = lane_xor16_sum(ss); ss = lane_xor32_sum(ss); if (fq == 0) SSQ_KR[(size_t)row * 2 + wc] = ss; } }
        }
    }
};
struct EpiMlaQ {
    static constexpr bool PERM = true, AFTER_DRAIN = false;
    bf16_t* QM; const float *SSQ_QA, *COS, *SIN, *qg; PG8_LAS float* X;
    __device__ __forceinline__ void operator()(const f32x4 (&acc)[2][2][4][2], const Unit& u, int wr, int wc, int fr_, int fq_) const {
        float eps_ = EPS, k192 = 1.f / 192; asm volatile("" : "+s"(eps_), "+s"(k192));
        int fr = fr_, fq = fq_; asm volatile("" : "+v"(fr), "+v"(fq));
        const int h = u.pn, rowb = u.pm * BM + wr * 64 + fr, b = (u.pm * BM) / SEQ, c8 = wc * 32 + 8 * fq, rt = wr * 64 + fr;
#pragma unroll
        for (int ai = 0; ai < 2; ++ai)
#pragma unroll
            for (int m = 0; m < 4; ++m) { float ss = (sq4(acc[ai][0][m][0]) + sq4(acc[ai][0][m][1])) + (sq4(acc[ai][1][m][0]) + sq4(acc[ai][1][m][1])); ss = lane_xor16_sum(ss); ss = lane_xor32_sum(ss);
                if (fq == 0) X[(ai * HALF + m * 16 + rt) * 4 + wc] = ss; }
        asm volatile("s_waitcnt lgkmcnt(0)" ::: "memory"); __builtin_amdgcn_s_barrier(); asm volatile("" ::: "memory");
        const f32x4 g0a = *(const f32x4*)(qg + c8), g0b = *(const f32x4*)(qg + c8 + 4);
        const int i0 = 16 * wc + 4 * fq;
        f32x4 g1 = {0.f, 0.f, 0.f, 0.f}, g2 = g1; if (wc < 2) { g1 = *(const f32x4*)(qg + 128 + i0); g2 = *(const f32x4*)(qg + 160 + i0); }
        bf16_t* dst = QM + ((size_t)(b * NH + h) * SEQ) * 192;
#pragma unroll
        for (int ai = 0; ai < 2; ++ai)
#pragma unroll
        for (int mh = 0; mh < 4; mh += 2) {
        float rr[2][4]; f32x4 csv[2][4], snv[2][4];
#pragma unroll
            for (int m = mh; m < mh + 2; ++m) { const int row = rowb + ai * HALF + m * 16; const f32x4 xs = *(const PG8_LAS f32x4*)(X + (ai * HALF + m * 16 + rt) * 4);
                const f32x4 pa = *(const f32x4*)(SSQ_QA + (size_t)row * 8), pb = *(const f32x4*)(SSQ_QA + (size_t)row * 8 + 4);
                const float msq = (((pa[0] + pa[1]) + (pa[2] + pa[3])) + ((pb[0] + pb[1]) + (pb[2] + pb[3]))) * (1.f / 512) + eps_;
                rr[ai][m] = rsqrtf(((xs[0] + xs[1]) + (xs[2] + xs[3])) * k192 + eps_ * msq) * QS_MLA;
                if (wc < 2) { csv[ai][m] = *(const f32x4*)(COS + (size_t)row * 32 + i0); snv[ai][m] = *(const f32x4*)(SIN + (size_t)row * 32 + i0); } }
#pragma unroll
            for (int m = mh; m < mh + 2; ++m) { const int row = rowb + ai * HALF + m * 16; const float r = rr[ai][m];
                bf16_t* d = dst + (size_t)(row & (SEQ - 1)) * 192;
                *(u32x4*)(d + c8) = pk8(acc[ai][0][m][0] * g0a * r, acc[ai][0][m][1] * g0b * r);
                if (wc < 2) { const f32x4 cs = csv[ai][m], sn = snv[ai][m];
                    const f32x4 va = acc[ai][1][m][0], vb = acc[ai][1][m][1];
                    const f32x4 y1 = (f32x4){va[0], va[2], vb[0], vb[2]} * g1 * r, y2 = (f32x4){va[1], va[3], vb[1], vb[3]} * g2 * r;
                    const f32x4 o1 = y1 * cs - y2 * sn, o2 = y2 * cs + y1 * sn;
                    *(u32x4*)(d + 128 + c8) = pk8((f32x4){o1[0], o2[0], o1[1], o2[1]}, (f32x4){o1[2], o2[2], o1[3], o2[3]}); } }
        }
        asm volatile("s_waitcnt lgkmcnt(0)" ::: "memory"); __builtin_amdgcn_s_barrier(); asm volatile("" ::: "memory");
    }
};
struct EpiMlaKV {
    static constexpr bool PERM = true, AFTER_DRAIN = false;
    bf16_t *KM, *VM; const float *SSQ_KVA, *SSQ_KR, *KR, *COS, *SIN, *kg; PG8_LAS float* X;
    __device__ __forceinline__ void operator()(const f32x4 (&acc)[2][2][4][2], const Unit& u, int wr, int wc, int fr_, int fq_) const {
        float eps_ = EPS, k192 = 1.f / 192; asm volatile("" : "+s"(eps_), "+s"(k192));
        int fr = fr_, fq = fq_; asm volatile("" : "+v"(fr), "+v"(fq));
        const int h = u.pn, rowb = u.pm * BM + wr * 64 + fr, b = (u.pm * BM) / SEQ, c8 = wc * 32 + 8 * fq, rt = wr * 64 + fr;
#pragma unroll
        for (int ai = 0; ai < 2; ++ai)
#pragma unroll
            for (int m = 0; m < 4; ++m) { float ss = sq4(acc[ai][0][m][0]) + sq4(acc[ai][0][m][1]); ss = lane_xor16_sum(ss); ss = lane_xor32_sum(ss);
                if (fq == 0) X[(ai * HALF + m * 16 + rt) * 4 + wc] = ss; }
        asm volatile("s_waitcnt lgkmcnt(0)" ::: "memory"); __builtin_amdgcn_s_barrier(); asm volatile("" ::: "memory");
        const f32x4 g0a = *(const f32x4*)(kg + c8), g0b = *(const f32x4*)(kg + c8 + 4);
        const int i0 = 8 * wc + 2 * fq;
        const float g1a = kg[128 + i0], g1b = kg[128 + i0 + 1], g2a = kg[160 + i0], g2b = kg[160 + i0 + 1];
        bf16_t* kd = KM + ((size_t)(b * NH + h) * SEQ) * 192; bf16_t* vd = VM + ((size_t)(b * NH + h) * SEQ) * 128;
#pragma unroll
        for (int ai = 0; ai < 2; ++ai) {
        float rr[2][4], cv[2][4]; float2 k1v[2][4], k2v[2][4], cpv[2][4], spv[2][4];
#pragma unroll
            for (int m = 0; m < 4; ++m) { const int row = rowb + ai * HALF + m * 16; const f32x4 xs = *(const PG8_LAS f32x4*)(X + (ai * HALF + m * 16 + rt) * 4);
                const f32x4 pc = *(const f32x4*)(SSQ_KVA + (size_t)row * 4);
                const float c2 = 1.0f / (((pc[0] + pc[1]) + (pc[2] + pc[3])) * (1.f / 256) + eps_);
                const float2 sk = *(const float2*)(SSQ_KR + (size_t)row * 2);
                cv[ai][m] = sqrtf(c2); rr[ai][m] = rsqrtf((c2 * ((xs[0] + xs[1]) + (xs[2] + xs[3])) + (sk.x + sk.y)) * k192 + eps_);
                const float* kr = KR + (size_t)row * 64 + i0;
                k1v[ai][m] = *(const float2*)kr; k2v[ai][m] = *(const float2*)(kr + 32); cpv[ai][m] = *(const float2*)(COS + (size_t)row * 32 + i0); spv[ai][m] = *(const float2*)(SIN + (size_t)row * 32 + i0); }
#pragma unroll
            for (int m = 0; m < 4; ++m) { const int row = rowb + ai * HALF + m * 16; const float r = rr[ai][m], ckv = cv[ai][m];
                const int srow = row & (SEQ - 1);
                *(u32x4*)(kd + (size_t)srow * 192 + c8) = pk8(acc[ai][0][m][0] * g0a * (ckv * r), acc[ai][0][m][1] * g0b * (ckv * r));
                *(u32x4*)(vd + (size_t)srow * 128 + c8) = pk8(acc[ai][1][m][0] * ckv, acc[ai][1][m][1] * ckv);
                const float2 cp = cpv[ai][m], sp = spv[ai][m];
                const float y1a = k1v[ai][m].x * r * g1a, y1b = k1v[ai][m].y * r * g1b, y2a = k2v[ai][m].x * r * g2a, y2b = k2v[ai][m].y * r * g2b;
                const float oa1 = y1a * cp.x - y2a * sp.x, oa2 = y2a * cp.x + y1a * sp.x, ob1 = y1b * cp.y - y2b * sp.y, ob2 = y2b * cp.y + y1b * sp.y;
                *(unsigned long long*)(kd + (size_t)srow * 192 + 128 + 2 * i0) = (unsigned long long)cvt_pk_bf16(oa1, oa2) | ((unsigned long long)cvt_pk_bf16(ob1, ob2) << 32); }
        }
        asm volatile("s_waitcnt lgkmcnt(0)" ::: "memory"); __builtin_amdgcn_s_barrier(); asm volatile("" ::: "memory");
    }
};
}

struct Frame {
    LAS unsigned char* lds;
    int tid, lane, wave, wave0, gw, ngw, bid, G;
    const __attribute__((address_space(4))) Args* ka; const int* pos;
    float* out; unsigned char* ws;
};
__device__ __forceinline__ size_t opq(size_t v) { asm volatile("" : "+s"(v)); return v; }
#define WSP(T, off) ((T*)(F.ws + opq(off)))
#define FIN(i) ((const float*)F.ka->in[i])
__device__ __forceinline__ const bf16* wptr(const Frame& F, int l, size_t off) { return (const bf16*)(F.ws + WS_W + (size_t)l * WL_STRIDE + off); }

__device__ __forceinline__ void p0_transpose_item(const float* W, int K, int N, bf16* WT, int row_off, LAS float* scr, int item, int lane, int rstride = 1) {
    const int nblk = N / 32, kb = item / nblk, nb = item % nblk, k0 = 64 * kb, n0 = 32 * nb;
    float wv_[32];
#pragma unroll
    for (int i = 0; i < 32; ++i) { const int kk = 2 * i + (lane >> 5); wv_[i] = W[(size_t)(k0 + kk) * N + n0 + (lane & 31)]; }
#pragma unroll
    for (int i = 0; i < 32; ++i) { const int kk = 2 * i + (lane >> 5); scr[kk * 33 + (lane & 31)] = wv_[i]; }
    LDS_WAIT(); asm volatile("" ::: "memory");
    const int c = lane & 7;
#pragma unroll
    for (int j = 0; j < 4; ++j) { const int n = (lane >> 3) + 8 * j; const LAS float* s = scr + (8 * c) * 33 + n;
        v4u o; o.x = pk2(s[0 * 33], s[1 * 33]); o.y = pk2(s[2 * 33], s[3 * 33]); o.z = pk2(s[4 * 33], s[5 * 33]); o.w = pk2(s[6 * 33], s[7 * 33]);
        *(v4u*)(WT + (size_t)(row_off + n0 + rstride * n) * K + k0 + 8 * c) = o; }
    LDS_WAIT(); asm volatile("" ::: "memory");
}
__device__ __forceinline__ void ph_prologue(Frame& F) {
    LAS float* scr = (LAS float*)(F.lds + F.wave * 16384);
    constexpr int I_IN = (D / 64) * (IN_COLS / 32), I_UQ = (QRANK / 64) * (UQ_N / 32), I_UKV = (KVRANK / 64) * (UKV_N / 32), I_OUT = (D / 64) * (D / 32), I_UP = (D / 64) * (NUP / 32), I_DN = (DFF / 64) * (D / 32);
    constexpr int I_L = I_IN + I_UQ + I_UKV + I_OUT + I_UP + I_DN;
    for (int it = F.gw; it < DEPTH * I_L; it += F.ngw) {
        const int l = it / I_L; int r = it % I_L;
        bf16* wl = (bf16*)(F.ws + WS_W + (size_t)l * WL_STRIDE);
        if (r < I_IN) { const int n0 = 32 * (r % (IN_COLS / 32)); int dst;
            if (n0 < C_DAV) { const int q = n0 % 768, G = q / 64, e = q % 64; dst = (n0 - q) + 256 * (G / 4) + 128 * (e / 32) + 32 * (G % 4) + (e % 32); }
            else if (n0 < C_KR) dst = n0;
            else if (n0 < C_SGU) dst = 4096 + (n0 - C_KR);
            else dst = n0 - 64;
            p0_transpose_item(FIN(I_WIN) + (size_t)l * D * IN_COLS, D, IN_COLS, (bf16*)((unsigned char*)wl + WL_IN), dst - n0, scr, r, F.lane); continue; } r -= I_IN;
        if (r < I_UQ) { const int n0 = 32 * (r % (UQ_N / 32)), hh = n0 / 192, e = n0 % 192;
            const int dst = 256 * hh + (e < 128 ? e : 128 + (e - 128) / 32);
            p0_transpose_item(FIN(I_WUQ) + (size_t)l * QRANK * UQ_N, QRANK, UQ_N, (bf16*)((unsigned char*)wl + WL_UQ), dst - n0, scr, r, F.lane, e < 128 ? 1 : 2); continue; } r -= I_UQ;
        if (r < I_UKV) { p0_transpose_item(FIN(I_WUKV) + (size_t)l * KVRANK * UKV_N, KVRANK, UKV_N, (bf16*)((unsigned char*)wl + WL_UKV), 0, scr, r, F.lane); continue; } r -= I_UKV;
        if (r < I_OUT) { p0_transpose_item(FIN(I_WOUT) + (size_t)l * D * D, D, D, (bf16*)((unsigned char*)wl + WL_OUT), 0, scr, r, F.lane); continue; } r -= I_OUT;
        if (r < I_UP) { const int n0 = 32 * (r % (NUP / 32)), chn = n0 % DFF, dst = 256 * (chn / 128) + 128 * (n0 / DFF) + (chn % 128);
            p0_transpose_item(FIN(I_WUP) + (size_t)l * D * NUP, D, NUP, (bf16*)((unsigned char*)wl + WL_UP), dst - n0, scr, r, F.lane); continue; } r -= I_UP;
        p0_transpose_item(FIN(I_WDOWN) + (size_t)l * DFF * D, DFF, D, (bf16*)((unsigned char*)wl + WL_DOWN), 0, scr, r, F.lane);
    }
    {
        const int gt = F.bid * NTHREADS + F.tid, nt = F.G * NTHREADS;
        constexpr int Z_IN = (IN_PAD - IN_COLS) * D / 8, Z_UQ = NH * 64 * QRANK / 8;
        for (int i = gt; i < DEPTH * (Z_IN + Z_UQ); i += nt) { const int l = i / (Z_IN + Z_UQ); int r = i % (Z_IN + Z_UQ);
            unsigned char* wl = F.ws + WS_W + (size_t)l * WL_STRIDE;
            v4u z = {0u, 0u, 0u, 0u};
            if (r < Z_IN) *(v4u*)(wl + WL_IN + (size_t)IN_COLS * D * 2 + (size_t)r * 16) = z;
            else { r -= Z_IN; const int hh = r / (64 * QRANK / 8), q = r % (64 * QRANK / 8); *(v4u*)(wl + WL_UQ + ((size_t)(256 * hh + 192) * QRANK) * 2 + (size_t)q * 16) = z; } }
    }
    __syncthreads();
    LAS float* cond = (LAS float*)F.lds;
    for (int i = F.tid; i < 2 * D; i += NTHREADS) cond[i] = silu_f(FIN(I_C)[i]);
    __syncthreads();
    {
        const int gt = F.bid * NTHREADS + F.tid, nt = F.G * NTHREADS;
        float* part = WSP(float, WS_MODP);
        for (int it = gt; it < DEPTH * 16 * 3072; it += nt) {
            const int n4 = it % 3072, ks = (it / 3072) % 16, l = it / (3072 * 16);
            const float* w = FIN(I_WADA) + ((size_t)l * D + ks * 128) * (6 * D) + n4 * 4;
            f32x4 a0 = {0.f, 0.f, 0.f, 0.f}, a1 = {0.f, 0.f, 0.f, 0.f};
#pragma unroll 8
            for (int k = 0; k < 128; ++k) { const f32x4 wv = *(const f32x4*)(w + (size_t)k * (6 * D)); a0 += cond[ks * 128 + k] * wv; a1 += cond[D + ks * 128 + k] * wv; }
            *(f32x4*)(part + ((size_t)(l * 16 + ks) * 2 + 0) * (6 * D) + n4 * 4) = a0;
            *(f32x4*)(part + ((size_t)(l * 16 + ks) * 2 + 1) * (6 * D) + n4 * 4) = a1;
        }
    }
    __syncthreads();
}
__device__ __forceinline__ void ph_modreduce(Frame& F) {
    const int gt = F.bid * NTHREADS + F.tid, nt = F.G * NTHREADS;
    const float* part = WSP(float, WS_MODP); float* mod = WSP(float, WS_MOD);
    for (int i = gt; i < DEPTH * 2 * 6 * D; i += nt) { const int n = i % (6 * D), b = (i / (6 * D)) & 1, l = i / (12 * D);
        float s = FIN(I_BADA)[l * 6 * D + n];
#pragma unroll
        for (int ks = 0; ks < 16; ++ks) s += part[((size_t)(l * 16 + ks) * 2 + b) * (6 * D) + n];
        mod[i] = s; }
    { float* ct = WSP(float, WS_COS); float* st = WSP(float, WS_SIN);
      for (int i = gt; i < M * 32; i += nt) { const float ang = (float)F.pos[i >> 5] * ROPE_INV[i & 31];
          const double rev = (double)ang * 0.15915494309189535; const float fr = (float)(rev - floor(rev));
          ct[i] = __builtin_amdgcn_cosf(fr); st[i] = __builtin_amdgcn_sinf(fr); } }
    if (gt < M / 64) { int mn = 0x7fffffff, mx = -0x7fffffff - 1;
        for (int i = 0; i < 64; ++i) { const int p = F.pos[gt * 64 + i]; mn = p < mn ? p : mn; mx = p > mx ? p : mx; }
        int* mm = WSP(int, WS_POSMM); mm[gt * 2] = mn; mm[gt * 2 + 1] = mx; }
}
template <bool XBF> __device__ __forceinline__ void ph_norm(Frame& F, int l, const void* xsrc, int sh_off, int sc_off) {
    const float* mod = WSP(float, WS_MOD) + (size_t)l * 12 * D; bf16* H = WSP(bf16, WS_H);
    for (int row = F.gw; row < M; row += F.ngw) {
        const int b = row >> 13;
        const float* mb = mod + (size_t)b * 6 * D;
        if constexpr (XBF) {
            const v4u* xr = (const v4u*)((const bf16*)xsrc + (size_t)row * D) + F.lane;
            v4u w[4]; float v[4][8]; float s = 0.f;
#pragma unroll
            for (int j = 0; j < 4; ++j) w[j] = xr[64 * j];
#pragma unroll
            for (int j = 0; j < 4; ++j) { const unsigned ww[4] = {w[j].x, w[j].y, w[j].z, w[j].w};
#pragma unroll
                for (int q = 0; q < 4; ++q) { v[j][2 * q] = pg8::uph_lo(ww[q]); v[j][2 * q + 1] = pg8::uph_hi(ww[q]); s += v[j][2 * q] * v[j][2 * q] + v[j][2 * q + 1] * v[j][2 * q + 1]; } }
            const float r = rsqrtf(wave_sum(s) * (1.f / D) + EPS);
            v4u* o16 = (v4u*)(H + (size_t)row * D) + F.lane;
#pragma unroll
            for (int j = 0; j < 4; ++j) { const int c = 8 * F.lane + 512 * j;
                const f32x4 sc0 = *(const f32x4*)(mb + sc_off + c), sc1 = *(const f32x4*)(mb + sc_off + c + 4), sh0 = *(const f32x4*)(mb + sh_off + c), sh1 = *(const f32x4*)(mb + sh_off + c + 4);
                v4u o; o.x = pk2(v[j][0] * r * (1.0f + sc0.x) + sh0.x, v[j][1] * r * (1.0f + sc0.y) + sh0.y); o.y = pk2(v[j][2] * r * (1.0f + sc0.z) + sh0.z, v[j][3] * r * (1.0f + sc0.w) + sh0.w);
                o.z = pk2(v[j][4] * r * (1.0f + sc1.x) + sh1.x, v[j][5] * r * (1.0f + sc1.y) + sh1.y); o.w = pk2(v[j][6] * r * (1.0f + sc1.z) + sh1.z, v[j][7] * r * (1.0f + sc1.w) + sh1.w);
                o16[64 * j] = o; }
        } else {
        const f32x4* xr = (const f32x4*)((const float*)xsrc + (size_t)row * D) + F.lane;
        f32x4 v[8]; float s = 0.f;
#pragma unroll
        for (int j = 0; j < 8; ++j) { v[j] = xr[64 * j]; s += (v[j].x * v[j].x + v[j].y * v[j].y) + (v[j].z * v[j].z + v[j].w * v[j].w); }
        const float r = rsqrtf(wave_sum(s) * (1.f / D) + EPS);
        unsigned long long* o8 = (unsigned long long*)(H + (size_t)row * D) + F.lane;
#pragma unroll
        for (int j = 0; j < 8; ++j) { const int c = 4 * F.lane + 256 * j;
            const f32x4 sc = *(const f32x4*)(mb + sc_off + c), sh = *(const f32x4*)(mb + sh_off + c);
            const f32x4 y = v[j] * r * (1.0f + sc) + sh;
            o8[64 * j] = (unsigned long long)pk2(y.x, y.y) | ((unsigned long long)pk2(y.z, y.w) << 32); }
        }
    }
}

namespace fa {
#ifndef PIPE_MLA
#define PIPE_MLA 1
#endif
#ifndef PIPE_LIN
#define PIPE_LIN 0
#endif
#ifndef PIPE_GEN
#define PIPE_GEN 0
#endif
#ifndef PIPE_OLD64
#define PIPE_OLD64 0
#endif
template <typename T> __device__ __forceinline__ T ldg(const void* base, unsigned off) { return *(const T*)((const char*)base + off); }
template <typename T> __device__ __forceinline__ void stg(void* base, unsigned off, T v) { *(T*)((char*)base + off) = v; }
constexpr int crowc(int r) { return (r & 3) + 8 * (r >> 2); }
using s16x4 = __attribute__((ext_vector_type(4))) short;
using f32x8 = __attribute__((ext_vector_type(8))) float;
constexpr int QBLK = 32, KVBLK = 64, DV = 128;
constexpr int SHM_V = KVBLK * DV * 2;
constexpr float THR = 11.5f;
#define FA_SBAR() __builtin_amdgcn_sched_barrier(0)
__device__ __forceinline__ unsigned cvtpk(float lo, float hi) { unsigned r; asm volatile("v_cvt_pk_bf16_f32 %0, %1, %2" : "=v"(r) : "v"(lo), "v"(hi)); return r; }
__device__ __forceinline__ int kswz(int row, int colB) { return (colB >> 7) * 8192 + row * 128 + ((colB & 127) ^ (((row >> 1) & 7) << 4)); }
__device__ __forceinline__ int v_st(int k, int c) { const int kk = (k & ~0xC) | ((k & 4) << 1) | ((k & 8) >> 1); return ((kk >> 3) * 4 + (c >> 5)) * 512 + ((kk & 7) * 32 + (c & 31)) * 2; }
__device__ __forceinline__ int v_st_nat(int k, int c) { return ((k >> 3) * 4 + (c >> 5)) * 512 + ((k & 7) * 32 + (c & 31)) * 2; }
__device__ __forceinline__ int v_rd_base(int lane) { return ((lane & 3) << 3) | (((lane >> 2) & 3) << 6) | (((lane >> 4) & 1) << 5) | (((lane >> 5) & 1) << 8); }
constexpr int v_rd_off(int d0, int ks, int half) { return d0 * 512 + ks * 4096 + half * 2048; }
template <int OFF> __device__ __forceinline__ s16x4 tr_read(int vb) { s16x4 r; asm volatile("ds_read_b64_tr_b16 %0, %1 offset:%2" : "=&v"(r) : "v"(vb), "i"(OFF) : "memory"); return r; }
template <int D0> __device__ __forceinline__ void pv_one(f32x16& od, int vb, bf16x8 pa0, bf16x8 pa1, bf16x8 pa2, bf16x8 pa3) {
    const s16x4 l0 = tr_read<v_rd_off(D0, 0, 0)>(vb), h0 = tr_read<v_rd_off(D0, 0, 1)>(vb), l1 = tr_read<v_rd_off(D0, 1, 0)>(vb), h1 = tr_read<v_rd_off(D0, 1, 1)>(vb);
    const s16x4 l2 = tr_read<v_rd_off(D0, 2, 0)>(vb), h2 = tr_read<v_rd_off(D0, 2, 1)>(vb), l3 = tr_read<v_rd_off(D0, 3, 0)>(vb), h3 = tr_read<v_rd_off(D0, 3, 1)>(vb);
    asm volatile("s_waitcnt lgkmcnt(0)" ::: "memory"); FA_SBAR();
#define FA_PK(L, H) (bf16x8){L[0], L[1], L[2], L[3], H[0], H[1], H[2], H[3]}
    od = __builtin_amdgcn_mfma_f32_32x32x16_bf16(pa0, FA_PK(l0, h0), od, 0, 0, 0);
    od = __builtin_amdgcn_mfma_f32_32x32x16_bf16(pa1, FA_PK(l1, h1), od, 0, 0, 0);
    od = __builtin_amdgcn_mfma_f32_32x32x16_bf16(pa2, FA_PK(l2, h2), od, 0, 0, 0);
    od = __builtin_amdgcn_mfma_f32_32x32x16_bf16(pa3, FA_PK(l3, h3), od, 0, 0, 0);
#undef FA_PK
}
__device__ __forceinline__ void pv_d0(f32x16* o, int vb, bf16x8 pa0, bf16x8 pa1, bf16x8 pa2, bf16x8 pa3) {
    pv_one<0>(o[0], vb, pa0, pa1, pa2, pa3); pv_one<1>(o[1], vb, pa0, pa1, pa2, pa3); pv_one<2>(o[2], vb, pa0, pa1, pa2, pa3); pv_one<3>(o[3], vb, pa0, pa1, pa2, pa3);
}
template <int D0> __device__ __forceinline__ void pv_reads(s16x4 (&l)[4], s16x4 (&h)[4], int vb) {
    l[0] = tr_read<v_rd_off(D0, 0, 0)>(vb); h[0] = tr_read<v_rd_off(D0, 0, 1)>(vb); l[1] = tr_read<v_rd_off(D0, 1, 0)>(vb); h[1] = tr_read<v_rd_off(D0, 1, 1)>(vb);
    l[2] = tr_read<v_rd_off(D0, 2, 0)>(vb); h[2] = tr_read<v_rd_off(D0, 2, 1)>(vb); l[3] = tr_read<v_rd_off(D0, 3, 0)>(vb); h[3] = tr_read<v_rd_off(D0, 3, 1)>(vb);
}
__device__ __forceinline__ void pv_mfma(f32x16& od, const s16x4 (&l)[4], const s16x4 (&h)[4], bf16x8 pa0, bf16x8 pa1, bf16x8 pa2, bf16x8 pa3) {
#define FA_PK(L, H) (bf16x8){L[0], L[1], L[2], L[3], H[0], H[1], H[2], H[3]}
    od = __builtin_amdgcn_mfma_f32_32x32x16_bf16(pa0, FA_PK(l[0], h[0]), od, 0, 0, 0);
    od = __builtin_amdgcn_mfma_f32_32x32x16_bf16(pa1, FA_PK(l[1], h[1]), od, 0, 0, 0);
    od = __builtin_amdgcn_mfma_f32_32x32x16_bf16(pa2, FA_PK(l[2], h[2]), od, 0, 0, 0);
    od = __builtin_amdgcn_mfma_f32_32x32x16_bf16(pa3, FA_PK(l[3], h[3]), od, 0, 0, 0);
#undef FA_PK
}
__device__ __forceinline__ void pv_d0_pipe(f32x16* o, int vb, bf16x8 pa0, bf16x8 pa1, bf16x8 pa2, bf16x8 pa3) {
    s16x4 la[4], ha[4], lb[4], hb[4];
    pv_reads<0>(la, ha, vb); pv_reads<1>(lb, hb, vb);
    asm volatile("s_waitcnt lgkmcnt(8)" ::: "memory"); FA_SBAR(); pv_mfma(o[0], la, ha, pa0, pa1, pa2, pa3); FA_SBAR();
    pv_reads<2>(la, ha, vb);
    asm volatile("s_waitcnt lgkmcnt(8)" ::: "memory"); FA_SBAR(); pv_mfma(o[1], lb, hb, pa0, pa1, pa2, pa3); FA_SBAR();
    pv_reads<3>(lb, hb, vb);
    asm volatile("s_waitcnt lgkmcnt(8)" ::: "memory"); FA_SBAR(); pv_mfma(o[2], la, ha, pa0, pa1, pa2, pa3); FA_SBAR();
    asm volatile("s_waitcnt lgkmcnt(0)" ::: "memory"); FA_SBAR(); pv_mfma(o[3], lb, hb, pa0, pa1, pa2, pa3);
}
__device__ __forceinline__ void partialSM(f32x16& p0, f32x16& p1, float& m_reg, float& alpha) {
    float pmax = p0[0];
#pragma unroll
    for (int r = 1; r < 16; ++r) pmax = fmaxf(pmax, p0[r]);
#pragma unroll
    for (int r = 0; r < 16; ++r) pmax = fmaxf(pmax, p1[r]);
    { auto rr = __builtin_amdgcn_permlane32_swap(__float_as_uint(pmax), __float_as_uint(pmax), false, false); pmax = fmaxf(__uint_as_float(rr[0]), __uint_as_float(rr[1])); }
    float mn;
    if (__builtin_expect(__all(pmax - m_reg <= THR), 1)) { mn = m_reg; alpha = 1.f; }
    else { mn = fmaxf(m_reg, pmax); alpha = __builtin_amdgcn_exp2f(m_reg - mn); m_reg = mn; }
#pragma unroll
    for (int r = 0; r < 16; ++r) { p0[r] -= mn; p1[r] -= mn; }
#pragma unroll
    for (int r = 0; r < 16; ++r) p0[r] = __builtin_amdgcn_exp2f(p0[r]);
}
__device__ __forceinline__ void finishSM(f32x16& p0, f32x16& p1, float alpha, float& l_reg, bf16x8& pa0, bf16x8& pa1, bf16x8& pa2, bf16x8& pa3) {
#pragma unroll
    for (int r = 0; r < 16; ++r) p1[r] = __builtin_amdgcn_exp2f(p1[r]);
    float ps = 0;
#pragma unroll
    for (int r = 0; r < 16; ++r) ps += p0[r];
#pragma unroll
    for (int r = 0; r < 16; ++r) ps += p1[r];
    { auto rr = __builtin_amdgcn_permlane32_swap(__float_as_uint(ps), __float_as_uint(ps), false, false); ps = __uint_as_float(rr[0]) + __uint_as_float(rr[1]); }
    l_reg = l_reg * alpha + ps;
#define FA_PK4(P, BASE, OUT) do { unsigned a0 = cvtpk(P[BASE + 0], P[BASE + 1]), a1 = cvtpk(P[BASE + 2], P[BASE + 3]);   \
    unsigned b0 = cvtpk(P[BASE + 4], P[BASE + 5]), b1 = cvtpk(P[BASE + 6], P[BASE + 7]);                              \
    auto r0 = __builtin_amdgcn_permlane32_swap(a0, b0, false, false); auto r1 = __builtin_amdgcn_permlane32_swap(a1, b1, false, false); \
    u32x4_t w = {r0[0], r1[0], r0[1], r1[1]}; OUT = __builtin_bit_cast(bf16x8, w); } while (0)
    typedef unsigned u32x4_t __attribute__((ext_vector_type(4)));
    FA_PK4(p0, 0, pa0); FA_PK4(p0, 8, pa1); FA_PK4(p1, 0, pa2); FA_PK4(p1, 8, pa3);
#undef FA_PK4
}
template <bool ALIBI> __device__ __forceinline__ void fr_init(f32x16& p0, f32x16& p1, const LAS float* posl, float posq, float slope2, bool linear, int hi) {
    if (linear) {
        const float cl = -slope2 * posq;
#pragma unroll
        for (int g = 0; g < 4; ++g) { const f32x4 k0 = *(const LAS f32x4*)(posl + 8 * g + 4 * hi), k1 = *(const LAS f32x4*)(posl + 32 + 8 * g + 4 * hi);
#pragma unroll
            for (int e = 0; e < 4; ++e) { p0[4 * g + e] = fmaf(slope2, k0[e], cl); p1[4 * g + e] = fmaf(slope2, k1[e], cl); } }
    } else {
#pragma unroll
        for (int g = 0; g < 4; ++g) { const f32x4 k0 = *(const LAS f32x4*)(posl + 8 * g + 4 * hi), k1 = *(const LAS f32x4*)(posl + 32 + 8 * g + 4 * hi);
#pragma unroll
            for (int e = 0; e < 4; ++e) { p0[4 * g + e] = -slope2 * fabsf(posq - k0[e]); p1[4 * g + e] = -slope2 * fabsf(posq - k1[e]); } }
    }
}
__device__ __forceinline__ float add_np(float a, float b) { asm("v_add_f32 %0, %0, %1" : "+v"(a) : "v"(b)); return a; }
__device__ __forceinline__ void fr_softmax(f32x16& p0, f32x16& p1, float& l_reg, bf16x8& pa0, bf16x8& pa1, bf16x8& pa2, bf16x8& pa3) {
#pragma unroll
    for (int r = 0; r < 16; ++r) { p0[r] = __builtin_amdgcn_exp2f(p0[r]); p1[r] = __builtin_amdgcn_exp2f(p1[r]); }
    float sa = 0.f, sb = 0.f;
#pragma unroll
    for (int r = 0; r < 16; ++r) { sa += p0[r]; sa += p1[r]; }
    l_reg += sa + sb;
    typedef unsigned u32x4_t __attribute__((ext_vector_type(4)));
#define FA_PKS(P, BASE, OUT) do { u32x4_t w = {cvtpk(P[BASE + 0], P[BASE + 1]), cvtpk(P[BASE + 2], P[BASE + 3]), cvtpk(P[BASE + 4], P[BASE + 5]), cvtpk(P[BASE + 6], P[BASE + 7])}; OUT = __builtin_bit_cast(bf16x8, w); } while (0)
    FA_PKS(p0, 0, pa0); FA_PKS(p0, 8, pa1); FA_PKS(p1, 0, pa2); FA_PKS(p1, 8, pa3);
#undef FA_PKS
}
template <int DQK> struct Lds {
    static constexpr int SHM_K = KVBLK * DQK * 2;
    static constexpr int V_OFF = 0, K_OFF = 2 * SHM_V, POS_OFF = K_OFF + 2 * SHM_K, WS_OFF = POS_OFF + 2 * 256, END = WS_OFF + 8 * 256;
};
template <int DQK, bool INIT = true> __device__ __forceinline__ void qkt(f32x16& p0, f32x16& p1, const LAS unsigned char* Ks, const bf16x8* qr, int r32, int hi) {
    if (INIT) { p0 = f32x16{}; p1 = f32x16{}; }
#pragma unroll
    for (int d0 = 0; d0 < DQK / 16; ++d0) { const int cb = (d0 * 16 + hi * 8) * 2;
        const bf16x8 b0 = *(const LAS bf16x8*)(Ks + kswz(r32, cb));
        const bf16x8 b1 = *(const LAS bf16x8*)(Ks + kswz(32 + r32, cb));
        p0 = __builtin_amdgcn_mfma_f32_32x32x16_bf16(b0, qr[d0], p0, 0, 0, 0);
        p1 = __builtin_amdgcn_mfma_f32_32x32x16_bf16(b1, qr[d0], p1, 0, 0, 0);
        if (DQK > 64 && (d0 & 3) == 3) FA_SBAR(); }
}
template <int OFF> __device__ __forceinline__ bf16x8 k_read(int addr) { bf16x8 r; asm volatile("ds_read_b128 %0, %1 offset:%2" : "=&v"(r) : "v"(addr), "i"(OFF) : "memory"); return r; }
__device__ __forceinline__ void k_bases(int (&ka)[4], const LAS unsigned char* K_lds, int r32, int hi) {
#pragma unroll
    for (int j = 0; j < 4; ++j) ka[j] = (int)(uintptr_t)K_lds + r32 * 128 + ((j * 32 + hi * 16) ^ (((r32 >> 1) & 7) << 4));
}
#define FA_LGK(n) asm volatile("s_waitcnt lgkmcnt(" #n ")" ::: "memory")
template <int DQK, int BOFF, int VAR = 0> __device__ __forceinline__ void qkt_pipe(f32x16& p0, f32x16& p1, const int (&ka)[4], const bf16x8* qr) {
    if constexpr (DQK == 64) {
        bf16x8 a0 = k_read<BOFF>(ka[0]), b0 = k_read<BOFF + 4096>(ka[0]), a1 = k_read<BOFF>(ka[1]), b1 = k_read<BOFF + 4096>(ka[1]);
        bf16x8 a2 = k_read<BOFF>(ka[2]), b2 = k_read<BOFF + 4096>(ka[2]), a3 = k_read<BOFF>(ka[3]), b3 = k_read<BOFF + 4096>(ka[3]);
        FA_LGK(6); FA_SBAR(); p0 = __builtin_amdgcn_mfma_f32_32x32x16_bf16(a0, qr[0], p0, 0, 0, 0); p1 = __builtin_amdgcn_mfma_f32_32x32x16_bf16(b0, qr[0], p1, 0, 0, 0); FA_SBAR();
        FA_LGK(4); FA_SBAR(); p0 = __builtin_amdgcn_mfma_f32_32x32x16_bf16(a1, qr[1], p0, 0, 0, 0); p1 = __builtin_amdgcn_mfma_f32_32x32x16_bf16(b1, qr[1], p1, 0, 0, 0); FA_SBAR();
        FA_LGK(2); FA_SBAR(); p0 = __builtin_amdgcn_mfma_f32_32x32x16_bf16(a2, qr[2], p0, 0, 0, 0); p1 = __builtin_amdgcn_mfma_f32_32x32x16_bf16(b2, qr[2], p1, 0, 0, 0); FA_SBAR();
        FA_LGK(0); FA_SBAR(); p0 = __builtin_amdgcn_mfma_f32_32x32x16_bf16(a3, qr[3], p0, 0, 0, 0); p1 = __builtin_amdgcn_mfma_f32_32x32x16_bf16(b3, qr[3], p1, 0, 0, 0); FA_SBAR();
    } else {
        static_assert(DQK == 192, "qkt_pipe: d = 64 or 192");
#define FA_KG(G, x0, y0, x1, y1) do { x0 = k_read<BOFF + ((2 * (G)) >> 2) * 8192>(ka[(2 * (G)) & 3]); y0 = k_read<BOFF + ((2 * (G)) >> 2) * 8192 + 4096>(ka[(2 * (G)) & 3]); \
        x1 = k_read<BOFF + ((2 * (G) + 1) >> 2) * 8192>(ka[(2 * (G) + 1) & 3]); y1 = k_read<BOFF + ((2 * (G) + 1) >> 2) * 8192 + 4096>(ka[(2 * (G) + 1) & 3]); } while (0)
#define FA_KM(G, x0, y0, x1, y1) do { FA_SBAR(); if (VAR == 6) { p0 = __builtin_amdgcn_mfma_f32_32x32x16_bf16(x0 ^ y0 ^ x1 ^ y1, qr[2 * (G)], p0, 0, 0, 0); } else { \
        p0 = __builtin_amdgcn_mfma_f32_32x32x16_bf16(x0, qr[2 * (G)], p0, 0, 0, 0); p1 = __builtin_amdgcn_mfma_f32_32x32x16_bf16(y0, qr[2 * (G)], p1, 0, 0, 0); \
        p0 = __builtin_amdgcn_mfma_f32_32x32x16_bf16(x1, qr[2 * (G) + 1], p0, 0, 0, 0); p1 = __builtin_amdgcn_mfma_f32_32x32x16_bf16(y1, qr[2 * (G) + 1], p1, 0, 0, 0); } FA_SBAR(); } while (0)
        bf16x8 a0, b0, a1, b1, c0, d0, c1, d1;
        if constexpr (VAR == 5) {
#pragma unroll
            for (int g = 0; g < 12; ++g) { FA_SBAR(); p0 = __builtin_amdgcn_mfma_f32_32x32x16_bf16(qr[(g + 1) % 12], qr[g], p0, 0, 0, 0); p1 = __builtin_amdgcn_mfma_f32_32x32x16_bf16(qr[(g + 5) % 12], qr[g], p1, 0, 0, 0); FA_SBAR(); }
            return; }
        FA_KG(0, a0, b0, a1, b1); FA_KG(1, c0, d0, c1, d1);
        FA_LGK(4); FA_KM(0, a0, b0, a1, b1); FA_KG(2, a0, b0, a1, b1);
        FA_LGK(4); FA_KM(1, c0, d0, c1, d1); FA_KG(3, c0, d0, c1, d1);
        FA_LGK(4); FA_KM(2, a0, b0, a1, b1); FA_KG(4, a0, b0, a1, b1);
        FA_LGK(4); FA_KM(3, c0, d0, c1, d1); FA_KG(5, c0, d0, c1, d1);
        FA_LGK(4); FA_KM(4, a0, b0, a1, b1);
        FA_LGK(0); FA_KM(5, c0, d0, c1, d1);
#undef FA_KG
#undef FA_KM
    }
}
template <bool ALIBI> __device__ __forceinline__ void fixup(f32x16& p0, f32x16& p1, const LAS float* posl, float posq, float slope2, bool masked, int hi) {
    if (ALIBI) {
#pragma unroll
        for (int g = 0; g < 4; ++g) { const f32x4 k0 = *(const LAS f32x4*)(posl + 8 * g + 4 * hi), k1 = *(const LAS f32x4*)(posl + 32 + 8 * g + 4 * hi);
#pragma unroll
            for (int e = 0; e < 4; ++e) { p0[4 * g + e] = fmaf(-slope2, fabsf(posq - k0[e]), p0[4 * g + e]); p1[4 * g + e] = fmaf(-slope2, fabsf(posq - k1[e]), p1[4 * g + e]); } }
    }
    if (masked) {
#pragma unroll
        for (int r = 0; r < 16; ++r) { p0[r] = -INFINITY; p1[r] = -INFINITY; }
    }
}
template <int DQK, bool ALIBI, int NSLOT, int MODE = 0, int VAR = 0>
__device__ __forceinline__ void attn_pass(const bf16* __restrict__ Qb, const bf16* __restrict__ Kh, const bf16* __restrict__ Vh, const int* __restrict__ posb, float slope2, float cref, int TL, int q0, int T0, int NT,
                                          LAS unsigned char* lds, int tid_, f32x16 (&o)[4], float& l_out) {
    typedef Lds<DQK> L; constexpr int KSUB = DQK / 64, SHM_K = L::SHM_K;
    const int wid = __builtin_amdgcn_readfirstlane(tid_ >> 6); int lane; asm volatile("v_mbcnt_lo_u32_b32 %0, -1, 0\n\tv_mbcnt_hi_u32_b32 %0, -1, %0" : "=v"(lane));
    const int tid = wid * 64 + lane, r32 = lane & 31, hi = lane >> 5;
    if (wid >= 4) __builtin_amdgcn_s_setprio(1);
    LAS unsigned char* V_lds = lds + L::V_OFF; LAS unsigned char* K_lds = lds + L::K_OFF; LAS float* P_lds = (LAS float*)(lds + L::POS_OFF);
    LAS float* al_l = (LAS float*)(lds + L::WS_OFF) + wid * 64;
    float m_reg = -1e30f, l_reg = 0.f;
#pragma unroll
    for (int d = 0; d < 4; ++d) o[d] = f32x16{};
    bf16x8 qr[DQK / 16];
    { const bf16* Qw = Qb + (size_t)(wid * QBLK) * DQK; unsigned qgo = (unsigned)(r32 * DQK + hi * 8) * 2u; asm volatile("" : "+v"(qgo));
#pragma unroll
      for (int d0 = 0; d0 < DQK / 16; ++d0) qr[d0] = ldg<bf16x8>(Qw + d0 * 16, qgo); }
    const float posq = ALIBI ? (float)posb[q0 + wid * QBLK + r32] : 0.f;
    const int tmax = NT - 4 + (wid >> 1);
    const int sr = tid >> 4, sc = (tid & 15) * 8, vst0 = MODE == 5 ? v_st_nat(sr, sc) : v_st(sr, sc), vst1 = MODE == 5 ? v_st_nat(32 + sr, sc) : v_st(32 + sr, sc);
    const int kr = tid >> 3, kc = (tid & 7) * 8, kst = kswz(kr, kc * 2);
    unsigned vgo = (unsigned)(sr * DV + sc) * 2u, kgo = (unsigned)(kr * DQK + kc) * 2u, pgo = (unsigned)(tid & 63) * 4u; asm volatile("" : "+v"(vgo), "+v"(kgo), "+v"(pgo));
    const int vb0 = (int)(uintptr_t)V_lds + v_rd_base(lane);
    int ka[4]; k_bases(ka, K_lds, r32, hi);
    struct Slot { bf16x8 vs0, vs1, ks[KSUB]; int ps; } sl_[NSLOT];
#define FA_SLOAD(i, k0) do { unsigned kk_ = (unsigned)__builtin_amdgcn_readfirstlane((int)(k0)); asm volatile("" : "+s"(kk_));     \
    const bf16* Vt_ = Vh + (size_t)kk_ * DV; const bf16* Kt_ = Kh + (size_t)kk_ * DQK; \
    sl_[i].vs0 = ldg<bf16x8>(Vt_, vgo); sl_[i].vs1 = ldg<bf16x8>(Vt_ + 32 * DV, vgo); \
    _Pragma("unroll") for (int s_ = 0; s_ < KSUB; ++s_) sl_[i].ks[s_] = ldg<bf16x8>(Kt_ + s_ * 64, kgo); \
    if (ALIBI) sl_[i].ps = ldg<int>(posb + kk_, pgo); } while (0)
#define FA_SWRITE(b, i) do { *(LAS bf16x8*)(V_lds + (b) * SHM_V + vst0) = sl_[i].vs0; *(LAS bf16x8*)(V_lds + (b) * SHM_V + vst1) = sl_[i].vs1; \
    _Pragma("unroll") for (int s_ = 0; s_ < KSUB; ++s_) *(LAS bf16x8*)(K_lds + (b) * SHM_K + s_ * 8192 + kst) = sl_[i].ks[s_]; \
    if (ALIBI) { if (tid < 64) P_lds[(b) * 64 + tid] = (float)sl_[i].ps; } } while (0)
#define FA_RESC(a) do { if (__any((a) < 1.f)) { if (hi == 0) al_l[r32] = (a); asm volatile("s_waitcnt lgkmcnt(0)" ::: "memory"); \
    _Pragma("unroll") for (int d = 0; d < 4; ++d) _Pragma("unroll") for (int r = 0; r < 16; ++r) o[d][r] *= al_l[crow(r, hi)]; } } while (0)
#define FA_COMPUTE(b, t, STAGE) do { bf16x8 pa0, pa1, pa2, pa3; const bool vis_ = (t) <= tmax;     \
    if (vis_) { f32x16 p0, p1; \
    if (MODE == 5) { if (VAR == 3) { p0 = f32x16{}; p1 = f32x16{}; _Pragma("unroll") for (int r_ = 0; r_ < 16; ++r_) { p0[r_] = l_reg; p1[r_] = l_reg; } } \
        else if ((DQK == 192 && PIPE_MLA) || (DQK == 64 && PIPE_OLD64)) { p0 = f32x16{}; p1 = f32x16{}; qkt_pipe<DQK, (b) * SHM_K, (VAR == 5 || VAR == 6) ? VAR : 0>(p0, p1, ka, qr); } else qkt<DQK, true>(p0, p1, K_lds + (b) * SHM_K, qr, r32, hi); fixup<ALIBI>(p0, p1, P_lds + (b) * 64, posq, slope2, false, hi); \
        if (VAR == 1) { l_reg += p0[0] + p1[5]; typedef unsigned u32x4_t __attribute__((ext_vector_type(4))); \
            u32x4_t w0_ = {cvtpk(p0[0], p0[1]), cvtpk(p0[2], p0[3]), cvtpk(p0[4], p0[5]), cvtpk(p0[6], p0[7])}, w1_ = {cvtpk(p0[8], p0[9]), cvtpk(p0[10], p0[11]), cvtpk(p0[12], p0[13]), cvtpk(p0[14], p0[15])}; \
            u32x4_t w2_ = {cvtpk(p1[0], p1[1]), cvtpk(p1[2], p1[3]), cvtpk(p1[4], p1[5]), cvtpk(p1[6], p1[7])}, w3_ = {cvtpk(p1[8], p1[9]), cvtpk(p1[10], p1[11]), cvtpk(p1[12], p1[13]), cvtpk(p1[14], p1[15])}; \
            pa0 = __builtin_bit_cast(bf16x8, w0_); pa1 = __builtin_bit_cast(bf16x8, w1_); pa2 = __builtin_bit_cast(bf16x8, w2_); pa3 = __builtin_bit_cast(bf16x8, w3_); } \
        else fr_softmax(p0, p1, l_reg, pa0, pa1, pa2, pa3); } \
    else { float alpha; qkt<DQK>(p0, p1, K_lds + (b) * SHM_K, qr, r32, hi); fixup<ALIBI>(p0, p1, P_lds + (b) * 64, posq, slope2, false, hi); \
        partialSM(p0, p1, m_reg, alpha); finishSM(p0, p1, alpha, l_reg, pa0, pa1, pa2, pa3); FA_RESC(alpha); } } \
    FA_SBAR(); STAGE; FA_SBAR();     \
    if (vis_) { \
    if (VAR == 2) { l_reg += __builtin_bit_cast(float, pa0[0] | (pa1[1] << 16)) + __builtin_bit_cast(float, pa2[0] | (pa3[1] << 16)); } else \
    if (MODE == 5 && DQK == 64) pv_d0_pipe(o, vb0 + (b) * SHM_V, pa0, pa1, pa2, pa3); else pv_d0(o, vb0 + (b) * SHM_V, pa0, pa1, pa2, pa3); } } while (0)
    constexpr int S1 = NSLOT - 1;
    FA_SLOAD(0, T0 * KVBLK); FA_SWRITE(0, 0); FA_SLOAD(S1, (T0 + 1) * KVBLK); FA_SWRITE(1, S1); FA_SLOAD(0, (T0 + 2) * KVBLK);
    if (NSLOT == 2) FA_SLOAD(1, (T0 + 3) * KVBLK);
    __syncthreads();
    static_assert(NSLOT == 1, "attn_pass: one staging slot");
    for (int j = T0; j < NT; j += 2) {
        FA_COMPUTE(0, j, { if (VAR != 4) if (j > T0) { FA_SWRITE(1, 0); if (j + 2 < NT) FA_SLOAD(0, (j + 2) * KVBLK); } });
        __syncthreads();
        FA_COMPUTE(1, j + 1, { if (VAR != 4) if (j + 2 < NT) { FA_SWRITE(0, 0); FA_SLOAD(0, (j + 3) * KVBLK); } });
        __syncthreads();
    }
    if (MODE == 5) { auto rr = __builtin_amdgcn_permlane32_swap(__float_as_uint(l_reg), __float_as_uint(l_reg), false, false); l_reg = __uint_as_float(rr[0]) + __uint_as_float(rr[1]); }
    __builtin_amdgcn_s_setprio(0);
    l_out = l_reg;
#undef FA_SLOAD
#undef FA_SWRITE
#undef FA_RESC
#undef FA_COMPUTE
}
template <int DQK> struct Lds3 {
    static constexpr int SHM_K = KVBLK * DQK * 2;
    static constexpr int V_OFF = 0, K_OFF = 3 * SHM_V, POS_OFF = K_OFF + 3 * SHM_K, WS_OFF = POS_OFF + 3 * 256, END = WS_OFF + 8 * 256;
};
template <int DQK, bool ALIBI>
__device__ __forceinline__ void attn_pass_stag(const bf16* __restrict__ Qb, const bf16* __restrict__ Kh, const bf16* __restrict__ Vh, const int* __restrict__ posb, float slope2, int q0, int T0, int NT,
                                               LAS unsigned char* lds, int tid, f32x16 (&o)[4], float& l_out) {
    typedef Lds3<DQK> L; constexpr int KSUB = DQK / 64, SHM_K = L::SHM_K;
    const int wid = __builtin_amdgcn_readfirstlane(tid >> 6), lane = tid & 63, r32 = lane & 31, hi = lane >> 5, grp = wid >> 2;
    LAS unsigned char* V_lds = lds + L::V_OFF; LAS unsigned char* K_lds = lds + L::K_OFF; LAS float* P_lds = (LAS float*)(lds + L::POS_OFF);
    float l_reg = 0.f;
#pragma unroll
    for (int d = 0; d < 4; ++d) o[d] = f32x16{};
    bf16x8 qr[DQK / 16];
    { const bf16* Qw = Qb + (size_t)(wid * QBLK) * DQK; unsigned qgo = (unsigned)(r32 * DQK + hi * 8) * 2u; asm volatile("" : "+v"(qgo));
#pragma unroll
      for (int d0 = 0; d0 < DQK / 16; ++d0) qr[d0] = ldg<bf16x8>(Qw + d0 * 16, qgo); }
    const float posq = ALIBI ? (float)posb[q0 + wid * QBLK + r32] : 0.f;
    const int tmax = NT - 4 + (wid >> 1);
    const int sr = tid >> 4, sc = (tid & 15) * 8, vst0 = v_st(sr, sc), vst1 = v_st(32 + sr, sc);
    const int kr = tid >> 3, kc = (tid & 7) * 8, kst = kswz(kr, kc * 2);
    unsigned vgo = (unsigned)(sr * DV + sc) * 2u, kgo = (unsigned)(kr * DQK + kc) * 2u, pgo = (unsigned)(tid & 63) * 4u; asm volatile("" : "+v"(vgo), "+v"(kgo), "+v"(pgo));
    const int vb0 = (int)(uintptr_t)V_lds + v_rd_base(lane);
    struct Slot { bf16x8 vs0, vs1, ks[KSUB]; int ps; } sl_;
#define FS_SLOAD(k0) do { unsigned kk_ = (unsigned)__builtin_amdgcn_readfirstlane((int)(k0)); asm volatile("" : "+s"(kk_)); \
    const bf16* Vt_ = Vh + (size_t)kk_ * DV; const bf16* Kt_ = Kh + (size_t)kk_ * DQK; \
    sl_.vs0 = ldg<bf16x8>(Vt_, vgo); sl_.vs1 = ldg<bf16x8>(Vt_ + 32 * DV, vgo); \
    _Pragma("unroll") for (int s_ = 0; s_ < KSUB; ++s_) sl_.ks[s_] = ldg<bf16x8>(Kt_ + s_ * 64, kgo); \
    if (ALIBI) sl_.ps = ldg<int>(posb + kk_, pgo); } while (0)
#define FS_SWRITE(b) do { *(LAS bf16x8*)(V_lds + (b) * SHM_V + vst0) = sl_.vs0; *(LAS bf16x8*)(V_lds + (b) * SHM_V + vst1) = sl_.vs1; \
    _Pragma("unroll") for (int s_ = 0; s_ < KSUB; ++s_) *(LAS bf16x8*)(K_lds + (b) * SHM_K + s_ * 8192 + kst) = sl_.ks[s_]; \
    if (ALIBI) { if (tid < 64) P_lds[(b) * 64 + tid] = (float)sl_.ps; } } while (0)
    const int nt = NT - T0;
    FS_SLOAD(T0 * KVBLK); FS_SWRITE(0); FS_SLOAD((T0 + 1) * KVBLK); FS_SWRITE(1); FS_SLOAD((T0 + 2) * KVBLK);
    __syncthreads();
#define FS_QKS(j_) do { int b_ = (j_) % 3; asm volatile("" : "+s"(b_)); f32x16 p0, p1; \
    qkt<DQK, true>(p0, p1, K_lds + b_ * SHM_K, qr, r32, hi); fixup<ALIBI>(p0, p1, P_lds + b_ * 64, posq, slope2, T0 + (j_) > tmax, hi); \
    fr_softmax(p0, p1, l_reg, pa0, pa1, pa2, pa3); } while (0)
#define FS_PV(j_) do { int b_ = (j_) % 3; asm volatile("" : "+s"(b_)); pv_d0(o, vb0 + b_ * SHM_V, pa0, pa1, pa2, pa3); } while (0)
#define FS_STAGE(j_) do { const int jn_ = (j_) + 2; if (jn_ < nt) { int bw_ = jn_ % 3; asm volatile("" : "+s"(bw_)); FS_SWRITE(bw_); if (jn_ + 1 < nt) FS_SLOAD((T0 + jn_ + 1) * KVBLK); } } while (0)
    bf16x8 pa0, pa1, pa2, pa3;
    if (grp == 0) {
        for (int j = 0; j < nt; ++j) { FS_QKS(j); __syncthreads(); FS_PV(j); __syncthreads(); FS_STAGE(j); }
        __syncthreads();
    } else {
        pa0 = bf16x8{}; pa1 = bf16x8{}; pa2 = bf16x8{}; pa3 = bf16x8{};
        for (int j = 0; j < nt; ++j) { if (j > 0) FS_PV(j - 1); __syncthreads(); FS_QKS(j); __syncthreads(); FS_STAGE(j); }
        FS_PV(nt - 1); __syncthreads();
    }
#undef FS_QKS
#undef FS_PV
#undef FS_STAGE
    { auto rr = __builtin_amdgcn_permlane32_swap(__float_as_uint(l_reg), __float_as_uint(l_reg), false, false); l_reg = __uint_as_float(rr[0]) + __uint_as_float(rr[1]); }
    l_out = l_reg;
#undef FS_SLOAD
#undef FS_SWRITE
}
template <int DQK, bool ALIBI>
__device__ __forceinline__ void attn_pass_p2(const bf16* __restrict__ Qb, const bf16* __restrict__ Kh, const bf16* __restrict__ Vh, const int* __restrict__ posb, float slope2, int q0, int T0, int NT,
                                             LAS unsigned char* lds, int tid, f32x16 (&o)[4], float& l_out) {
    typedef Lds<DQK> L; constexpr int KSUB = DQK / 64, SHM_K = L::SHM_K;
    const int wid = __builtin_amdgcn_readfirstlane(tid >> 6), lane = tid & 63, r32 = lane & 31, hi = lane >> 5;
    LAS unsigned char* V_lds = lds + L::V_OFF; LAS unsigned char* K_lds = lds + L::K_OFF; LAS float* P_lds = (LAS float*)(lds + L::POS_OFF);
    float l_reg = 0.f;
#pragma unroll
    for (int d = 0; d < 4; ++d) o[d] = f32x16{};
    bf16x8 qr[DQK / 16];
    { const bf16* Qw = Qb + (size_t)(wid * QBLK) * DQK; unsigned qgo = (unsigned)(r32 * DQK + hi * 8) * 2u; asm volatile("" : "+v"(qgo));
#pragma unroll
      for (int d0 = 0; d0 < DQK / 16; ++d0) qr[d0] = ldg<bf16x8>(Qw + d0 * 16, qgo); }
    const float posq = ALIBI ? (float)posb[q0 + wid * QBLK + r32] : 0.f;
    const int tmax = NT - 4 + (wid >> 1);
    const int sr = tid >> 4, sc = (tid & 15) * 8, vst0 = v_st(sr, sc), vst1 = v_st(32 + sr, sc);
    const int kr = tid >> 3, kc = (tid & 7) * 8, kst = kswz(kr, kc * 2);
    unsigned vgo = (unsigned)(sr * DV + sc) * 2u, kgo = (unsigned)(kr * DQK + kc) * 2u, pgo = (unsigned)(tid & 63) * 4u; asm volatile("" : "+v"(vgo), "+v"(kgo), "+v"(pgo));
    const int vb0 = (int)(uintptr_t)V_lds + v_rd_base(lane);
    struct Slot { bf16x8 vs0, vs1, ks[KSUB]; int ps; } sl_;
#define FP_LOADK(t) do { unsigned kk_ = (unsigned)__builtin_amdgcn_readfirstlane((int)((t) * KVBLK)); asm volatile("" : "+s"(kk_)); const bf16* Kt_ = Kh + (size_t)kk_ * DQK; \
    _Pragma("unroll") for (int s_ = 0; s_ < KSUB; ++s_) sl_.ks[s_] = ldg<bf16x8>(Kt_ + s_ * 64, kgo); if (ALIBI) sl_.ps = ldg<int>(posb + kk_, pgo); } while (0)
#define FP_LOADV(t) do { unsigned kk_ = (unsigned)__builtin_amdgcn_readfirstlane((int)((t) * KVBLK)); asm volatile("" : "+s"(kk_)); const bf16* Vt_ = Vh + (size_t)kk_ * DV; \
    sl_.vs0 = ldg<bf16x8>(Vt_, vgo); sl_.vs1 = ldg<bf16x8>(Vt_ + 32 * DV, vgo); } while (0)
#define FP_WRITEK(b) do { _Pragma("unroll") for (int s_ = 0; s_ < KSUB; ++s_) *(LAS bf16x8*)(K_lds + (b) * SHM_K + s_ * 8192 + kst) = sl_.ks[s_]; \
    if (ALIBI) { if (tid < 64) P_lds[(b) * 64 + tid] = (float)sl_.ps; } } while (0)
#define FP_WRITEV(b) do { *(LAS bf16x8*)(V_lds + (b) * SHM_V + vst0) = sl_.vs0; *(LAS bf16x8*)(V_lds + (b) * SHM_V + vst1) = sl_.vs1; } while (0)
#define FP_QK(P0, P1, b, t) do { qkt<DQK, true>(P0, P1, K_lds + (b) * SHM_K, qr, r32, hi); fixup<ALIBI>(P0, P1, P_lds + (b) * 64, posq, slope2, (t) > tmax, hi); } while (0)
    f32x16 pA0, pA1, pB0, pB1; bf16x8 pa0, pa1, pa2, pa3;
    const int nt = NT - T0;
    FP_LOADK(T0); FP_LOADV(T0); FP_WRITEK(0); FP_WRITEV(0); FP_LOADK(T0 + 1); FP_WRITEK(1); FP_LOADK(T0 + 2); FP_LOADV(T0 + 1);
    __syncthreads();
    FP_QK(pA0, pA1, 0, T0);
    __syncthreads();
    for (int r = 0; r < nt; r += 2) {
        if (r + 2 < nt) FP_WRITEK(0);
        FP_WRITEV(1);
        if (r + 3 < nt) FP_LOADK(T0 + r + 3);
        if (r + 2 < nt) FP_LOADV(T0 + r + 2);
        FA_SBAR(); FP_QK(pB0, pB1, 1, T0 + r + 1);
        fr_softmax(pA0, pA1, l_reg, pa0, pa1, pa2, pa3); FA_SBAR();
        pv_d0(o, vb0, pa0, pa1, pa2, pa3);
        __syncthreads();
        if (r + 3 < nt) FP_WRITEK(1);
        if (r + 2 < nt) FP_WRITEV(0);
        if (r + 4 < nt) FP_LOADK(T0 + r + 4);
        if (r + 3 < nt) FP_LOADV(T0 + r + 3);
        FA_SBAR(); if (r + 2 < nt) FP_QK(pA0, pA1, 0, T0 + r + 2);
        fr_softmax(pB0, pB1, l_reg, pa0, pa1, pa2, pa3); FA_SBAR();
        pv_d0(o, vb0 + SHM_V, pa0, pa1, pa2, pa3);
        __syncthreads();
    }
    { auto rr = __builtin_amdgcn_permlane32_swap(__float_as_uint(l_reg), __float_as_uint(l_reg), false, false); l_reg = __uint_as_float(rr[0]) + __uint_as_float(rr[1]); }
    l_out = l_reg;
#undef FP_LOADK
#undef FP_LOADV
#undef FP_WRITEK
#undef FP_WRITEV
#undef FP_QK
}
template <int DQK, bool ALIBI>
__device__ __forceinline__ void attn_pass_dma(const bf16* __restrict__ Qb, const bf16* __restrict__ Kh, const bf16* __restrict__ Vh, const int* __restrict__ posb, const float* __restrict__ posfb,
                                              float slope2, int q0, int T0, int NT, LAS unsigned char* lds, int tid_, f32x16 (&o)[4], float& l_out) {
    typedef Lds3<DQK> L; constexpr int KSUB = DQK / 64, SHM_K = L::SHM_K, NPT = KSUB + 2 + (ALIBI ? 1 : 0);
    const int wid = __builtin_amdgcn_readfirstlane(tid_ >> 6); int lane; asm volatile("v_mbcnt_lo_u32_b32 %0, -1, 0\n\tv_mbcnt_hi_u32_b32 %0, -1, %0" : "=v"(lane));
    const int r32 = lane & 31, hi = lane >> 5;
    LAS unsigned char* V_lds = lds + L::V_OFF; LAS unsigned char* K_lds = lds + L::K_OFF; LAS float* P_lds = (LAS float*)(lds + L::POS_OFF);
    float l_reg = 0.f;
#pragma unroll
    for (int d = 0; d < 4; ++d) o[d] = f32x16{};
    bf16x8 qr[DQK / 16];
    { const bf16* Qw = Qb + (size_t)(wid * QBLK) * DQK; unsigned qgo = (unsigned)(r32 * DQK + hi * 8) * 2u; asm volatile("" : "+v"(qgo));
#pragma unroll
      for (int d0 = 0; d0 < DQK / 16; ++d0) qr[d0] = ldg<bf16x8>(Qw + d0 * 16, qgo); }
    const float posq = ALIBI ? (float)posb[q0 + wid * QBLK + r32] : 0.f;
    const int tmax = NT - 4 + (wid >> 1);
    unsigned ksrc, vsrc, psrc;
    { const int kr = 8 * wid + (lane >> 3), kc = (lane & 7) ^ ((kr >> 1) & 7); ksrc = (unsigned)(kr * DQK + kc * 8) * 2u;
      const int vk = 8 * wid + ((lane & 31) >> 2), vc = (lane >> 5) * 32 + (lane & 3) * 8; vsrc = (unsigned)(vk * DV + vc) * 2u; psrc = (unsigned)lane * 4u;
      asm volatile("" : "+v"(ksrc), "+v"(vsrc), "+v"(psrc)); }
    const int vb0 = (int)(uintptr_t)V_lds + v_rd_base(lane);
#define FD_DMA(t, slot) do { unsigned kk_ = (unsigned)__builtin_amdgcn_readfirstlane((int)((t) * KVBLK)); asm volatile("" : "+s"(kk_)); const int sl_ = (slot); \
    const char* Kt_ = (const char*)(Kh + (size_t)kk_ * DQK); const char* Vt_ = (const char*)(Vh + (size_t)kk_ * DV); \
    _Pragma("unroll") for (int s_ = 0; s_ < KSUB; ++s_) __builtin_amdgcn_global_load_lds((const unsigned*)(Kt_ + s_ * 128 + ksrc), (LAS unsigned*)(K_lds + sl_ * SHM_K + s_ * 8192 + wid * 1024), 16, 0, 0); \
    _Pragma("unroll") for (int q_ = 0; q_ < 2; ++q_) __builtin_amdgcn_global_load_lds((const unsigned*)(Vt_ + q_ * 128 + vsrc), (LAS unsigned*)(V_lds + sl_ * SHM_V + (2 * wid + q_) * 1024), 16, 0, 0); \
    if (ALIBI) __builtin_amdgcn_global_load_lds((const unsigned*)((const char*)(posfb + kk_) + psrc), (LAS unsigned*)(P_lds + sl_ * 64), 4, 0, 0); } while (0)
    const int nt = NT - T0;
    FD_DMA(T0, 0); FD_DMA(T0 + 1, 1);
    asm volatile("s_waitcnt vmcnt(0) lgkmcnt(0)\n\ts_barrier" ::: "memory");
    int slot = 0;
    for (int j = 0; j < nt; ++j) {
        int b = slot; asm volatile("" : "+s"(b));
        if (j + 2 < nt) { int bn = b + 2; bn = bn >= 3 ? bn - 3 : bn; FD_DMA(T0 + j + 2, bn); }
        { f32x16 p0, p1; bf16x8 pa0, pa1, pa2, pa3;
          qkt<DQK, true>(p0, p1, K_lds + b * SHM_K, qr, r32, hi); fixup<ALIBI>(p0, p1, P_lds + b * 64, posq, slope2, T0 + j > tmax, hi);
          fr_softmax(p0, p1, l_reg, pa0, pa1, pa2, pa3); FA_SBAR();
          pv_d0(o, vb0 + b * SHM_V, pa0, pa1, pa2, pa3); }
        if (j + 2 < nt) asm volatile("s_waitcnt vmcnt(%0) lgkmcnt(0)\n\ts_barrier" :: "n"(NPT) : "memory");
        else asm volatile("s_waitcnt vmcnt(0) lgkmcnt(0)\n\ts_barrier" ::: "memory");
        slot = slot == 2 ? 0 : slot + 1;
    }
    { auto rr = __builtin_amdgcn_permlane32_swap(__float_as_uint(l_reg), __float_as_uint(l_reg), false, false); l_reg = __uint_as_float(rr[0]) + __uint_as_float(rr[1]); }
    l_out = l_reg;
#undef FD_DMA
}
__device__ __forceinline__ void row_bcast(float f, LAS float* al, int r32, int hi, float (&rf)[16]) {
    asm volatile("s_waitcnt lgkmcnt(0)" ::: "memory");
    if (hi == 0) al[r32] = f;
    asm volatile("s_waitcnt lgkmcnt(0)" ::: "memory");
#pragma unroll
    for (int r = 0; r < 16; ++r) rf[r] = al[crow(r, hi)];
    asm volatile("s_waitcnt lgkmcnt(0)" ::: "memory");
}

__device__ __forceinline__ void attn_pass_da5(const bf16* __restrict__ Qb, const bf16* __restrict__ Kh, const bf16* __restrict__ Vh, const int* __restrict__ posb, float slope2, int cw, int q0, int T0, int NT,
                                              LAS unsigned char* lds, int tid_, f32x16 (&o)[4], float& l_out) {
    typedef Lds<64> L; constexpr int DQK = 64, SHM_K = L::SHM_K, B_OFF = L::END;
    const int wid = __builtin_amdgcn_readfirstlane(tid_ >> 6); int lane; asm volatile("v_mbcnt_lo_u32_b32 %0, -1, 0\n\tv_mbcnt_hi_u32_b32 %0, -1, %0" : "=v"(lane));
    const int tid = wid * 64 + lane, r32 = lane & 31, hi = lane >> 5;
    LAS unsigned char* V_lds = lds + L::V_OFF; LAS unsigned char* K_lds = lds + L::K_OFF; LAS float* P_lds = (LAS float*)(lds + L::POS_OFF); LAS float* B_lds = (LAS float*)(lds + B_OFF);
    float l_reg = 0.f;
#pragma unroll
    for (int d = 0; d < 4; ++d) o[d] = f32x16{};
    bf16x8 qr[4];
    { const bf16* Qw = Qb + (size_t)(wid * QBLK) * DQK; unsigned qgo = (unsigned)(r32 * DQK + hi * 8) * 2u; asm volatile("" : "+v"(qgo));
#pragma unroll
      for (int d0 = 0; d0 < 4; ++d0) qr[d0] = ldg<bf16x8>(Qw + d0 * 16, qgo); }
    const float posq = (float)posb[q0 + wid * QBLK + r32];
    const float dl = slope2 * (posq - (float)cw);
    const int tmax = NT - 4 + (wid >> 1);
    const int sr = tid >> 4, sc = (tid & 15) * 8, vst0 = v_st_nat(sr, sc), vst1 = v_st_nat(32 + sr, sc);
    const int kr = tid >> 3, kc = (tid & 7) * 8, kst = kswz(kr, kc * 2);
    unsigned vgo = (unsigned)(sr * DV + sc) * 2u, kgo = (unsigned)(kr * DQK + kc) * 2u, pgo = (unsigned)(tid & 63) * 4u; asm volatile("" : "+v"(vgo), "+v"(kgo), "+v"(pgo));
    const int vb0 = (int)(uintptr_t)V_lds + v_rd_base(lane);
    int ka[4]; k_bases(ka, K_lds, r32, hi);
    bf16x8 vs0, vs1, ks0; int ps;
#define FD_SLOAD(k0) do { unsigned kk_ = (unsigned)__builtin_amdgcn_readfirstlane((int)(k0)); asm volatile("" : "+s"(kk_)); \
    const bf16* Vt_ = Vh + (size_t)kk_ * DV; const bf16* Kt_ = Kh + (size_t)kk_ * DQK; \
    vs0 = ldg<bf16x8>(Vt_, vgo); vs1 = ldg<bf16x8>(Vt_ + 32 * DV, vgo); ks0 = ldg<bf16x8>(Kt_, kgo); ps = ldg<int>(posb + kk_, pgo); } while (0)
#define FD_SWRITE(b) do { *(LAS bf16x8*)(V_lds + (b) * SHM_V + vst0) = vs0; *(LAS bf16x8*)(V_lds + (b) * SHM_V + vst1) = vs1; *(LAS bf16x8*)(K_lds + (b) * SHM_K + kst) = ks0; \
    B_lds[(b) * 512 + tid] = slope2 * (float)(ps - cw); if (tid < 64) P_lds[(b) * 64 + tid] = (float)ps; } while (0)
#define FD_LIN(b) do { f32x16 p0, p1; bf16x8 pa0, pa1, pa2, pa3; const LAS float* bl_ = B_lds + (b) * 512 + wid * 64 + 4 * hi; \
    _Pragma("unroll") for (int g = 0; g < 4; ++g) { const f32x4 k0 = *(const LAS f32x4*)(bl_ + 8 * g), k1 = *(const LAS f32x4*)(bl_ + 32 + 8 * g); \
        _Pragma("unroll") for (int e = 0; e < 4; ++e) { p0[4 * g + e] = k0[e]; p1[4 * g + e] = k1[e]; } } \
    if (PIPE_LIN) qkt_pipe<DQK, (b) * SHM_K>(p0, p1, ka, qr); else qkt<DQK, false>(p0, p1, K_lds + (b) * SHM_K, qr, r32, hi); fr_softmax(p0, p1, l_reg, pa0, pa1, pa2, pa3); FA_SBAR(); \
    pv_d0_pipe(o, vb0 + (b) * SHM_V, pa0, pa1, pa2, pa3); } while (0)
#define FD_GEN(b, t) do { if ((t) <= tmax) { f32x16 p0, p1; bf16x8 pa0, pa1, pa2, pa3; \
    _Pragma("unroll") for (int r = 0; r < 16; ++r) { p0[r] = dl; p1[r] = dl; } \
    if (PIPE_GEN) qkt_pipe<DQK, (b) * SHM_K>(p0, p1, ka, qr); else qkt<DQK, false>(p0, p1, K_lds + (b) * SHM_K, qr, r32, hi); fixup<true>(p0, p1, P_lds + (b) * 64, posq, slope2, false, hi); fr_softmax(p0, p1, l_reg, pa0, pa1, pa2, pa3); FA_SBAR(); \
    pv_d0_pipe(o, vb0 + (b) * SHM_V, pa0, pa1, pa2, pa3); } } while (0)
    FD_SLOAD(T0 * KVBLK); FD_SWRITE(0); FD_SLOAD((T0 + 1) * KVBLK); FD_SWRITE(1); FD_SLOAD((T0 + 2) * KVBLK);
    __syncthreads();
    int j = T0;
    for (; j < NT - 4; j += 2) {
        FD_LIN(0);
        __syncthreads();
        FD_SWRITE(0); FD_SLOAD((j + 3) * KVBLK);
        FD_LIN(1);
        __syncthreads();
        FD_SWRITE(1); FD_SLOAD((j + 4) * KVBLK);
    }
    for (; j < NT; j += 2) {
        FD_GEN(0, j);
        __syncthreads();
        if (j + 2 < NT) { FD_SWRITE(0); FD_SLOAD((j + 3) * KVBLK); }
        FD_GEN(1, j + 1);
        __syncthreads();
        if (j + 2 < NT) { FD_SWRITE(1); }
    }
    { auto rr = __builtin_amdgcn_permlane32_swap(__float_as_uint(l_reg), __float_as_uint(l_reg), false, false); l_reg = __uint_as_float(rr[0]) + __uint_as_float(rr[1]); }
    l_out = l_reg;
#undef FD_SLOAD
#undef FD_SWRITE
#undef FD_LIN
#undef FD_GEN
}

__device__ __forceinline__ void attn_pass_da5p(const bf16* __restrict__ Qb, const bf16* __restrict__ Kh, const bf16* __restrict__ Vh, const int* __restrict__ posb, float slope2, int cw, int q0, int T0, int NT,
                                               LAS unsigned char* lds, int tid_, f32x16 (&o)[4], float& l_out) {
    typedef Lds<64> L; constexpr int DQK = 64, SHM_K = L::SHM_K, B_OFF = L::END;
    const int wid = __builtin_amdgcn_readfirstlane(tid_ >> 6); int lane; asm volatile("v_mbcnt_lo_u32_b32 %0, -1, 0\n\tv_mbcnt_hi_u32_b32 %0, -1, %0" : "=v"(lane));
    const int tid = wid * 64 + lane, r32 = lane & 31, hi = lane >> 5;
    if (wid >= 4) __builtin_amdgcn_s_setprio(1);
    LAS unsigned char* V_lds = lds + L::V_OFF; LAS unsigned char* K_lds = lds + L::K_OFF; LAS float* P_lds = (LAS float*)(lds + L::POS_OFF); LAS float* B_lds = (LAS float*)(lds + B_OFF);
    float l_reg = 0.f;
#pragma unroll
    for (int d = 0; d < 4; ++d) o[d] = f32x16{};
    bf16x8 qr[4];
    { const bf16* Qw = Qb + (size_t)(wid * QBLK) * DQK; unsigned qgo = (unsigned)(r32 * DQK + hi * 8) * 2u; asm volatile("" : "+v"(qgo));
#pragma unroll
      for (int d0 = 0; d0 < 4; ++d0) qr[d0] = ldg<bf16x8>(Qw + d0 * 16, qgo); }
    const float posq = (float)posb[q0 + wid * QBLK + r32];
    const float dl = slope2 * (posq - (float)cw);
    const int tmax = NT - 4 + (wid >> 1);
    const int sr = tid >> 4, sc = (tid & 15) * 8, vst0 = v_st_nat(sr, sc), vst1 = v_st_nat(32 + sr, sc);
    const int kr = tid >> 3, kc = (tid & 7) * 8, kst = kswz(kr, kc * 2);
    unsigned vgo = (unsigned)(sr * DV + sc) * 2u, kgo = (unsigned)(kr * DQK + kc) * 2u, pgo = (unsigned)(tid & 63) * 4u; asm volatile("" : "+v"(vgo), "+v"(kgo), "+v"(pgo));
    const int vb0 = (int)(uintptr_t)V_lds + v_rd_base(lane);
    int ka[4]; k_bases(ka, K_lds, r32, hi);
    bf16x8 vs0, vs1, ks0; int ps;
#define FP_LOADV(t) do { unsigned kk_ = (unsigned)__builtin_amdgcn_readfirstlane((int)((t) * KVBLK)); asm volatile("" : "+s"(kk_)); const bf16* Vt_ = Vh + (size_t)kk_ * DV; \
    vs0 = ldg<bf16x8>(Vt_, vgo); vs1 = ldg<bf16x8>(Vt_ + 32 * DV, vgo); } while (0)
#define FP_LOADK(t) do { unsigned kk_ = (unsigned)__builtin_amdgcn_readfirstlane((int)((t) * KVBLK)); asm volatile("" : "+s"(kk_)); ks0 = ldg<bf16x8>(Kh + (size_t)kk_ * DQK, kgo); ps = ldg<int>(posb + kk_, pgo); } while (0)
#define FP_WRITEV(b) do { *(LAS bf16x8*)(V_lds + (b) * SHM_V + vst0) = vs0; *(LAS bf16x8*)(V_lds + (b) * SHM_V + vst1) = vs1; } while (0)
#define FP_WRITEK(b) do { *(LAS bf16x8*)(K_lds + (b) * SHM_K + kst) = ks0; B_lds[(b) * 512 + tid] = slope2 * (float)(ps - cw); if (tid < 64) P_lds[(b) * 64 + tid] = (float)ps; } while (0)
#define FP_BINIT(x0, x1, b) do { const LAS float* bl_ = B_lds + (b) * 512 + wid * 64 + 4 * hi; \
    _Pragma("unroll") for (int g = 0; g < 4; ++g) { const f32x4 k0 = *(const LAS f32x4*)(bl_ + 8 * g), k1 = *(const LAS f32x4*)(bl_ + 32 + 8 * g); \
        _Pragma("unroll") for (int e = 0; e < 4; ++e) { x0[4 * g + e] = k0[e]; x1[4 * g + e] = k1[e]; } } } while (0)
#define FP_QK(x0, x1, t, b) do { if ((t) < NT - 4) { FP_BINIT(x0, x1, b); qkt<DQK, false>(x0, x1, K_lds + (b) * SHM_K, qr, r32, hi); } \
    else { _Pragma("unroll") for (int r = 0; r < 16; ++r) { x0[r] = dl; x1[r] = dl; } qkt<DQK, false>(x0, x1, K_lds + (b) * SHM_K, qr, r32, hi); fixup<true>(x0, x1, P_lds + (b) * 64, posq, slope2, false, hi); } } while (0)
    f32x16 c0, c1;
    {
        FP_LOADV(T0); FP_LOADK(T0);
        bf16x8 vB0, vB1, kB; int pB;
        { unsigned kk_ = (unsigned)__builtin_amdgcn_readfirstlane((int)((T0 + 1) * KVBLK)); asm volatile("" : "+s"(kk_)); const bf16* Vt_ = Vh + (size_t)kk_ * DV;
          vB0 = ldg<bf16x8>(Vt_, vgo); vB1 = ldg<bf16x8>(Vt_ + 32 * DV, vgo); kB = ldg<bf16x8>(Kh + (size_t)kk_ * DQK, kgo); pB = ldg<int>(posb + kk_, pgo); }
        FP_WRITEV(0); FP_WRITEK(0);
        *(LAS bf16x8*)(V_lds + SHM_V + vst0) = vB0; *(LAS bf16x8*)(V_lds + SHM_V + vst1) = vB1; *(LAS bf16x8*)(K_lds + SHM_K + kst) = kB;
        B_lds[512 + tid] = slope2 * (float)(pB - cw); if (tid < 64) P_lds[64 + tid] = (float)pB;
        FP_LOADK(T0 + 2); FP_LOADV(T0 + 2);
        __syncthreads();
        FP_QK(c0, c1, T0, 0);
        __syncthreads();
        FP_WRITEK(0); FP_LOADK(T0 + 3);
    }
    int s = T0;
    for (; s <= NT - 6; ++s) {
        const int b = s & 1, nb = b ^ 1, kof = nb * SHM_K;
        f32x16 n0, n1; bf16x8 pa0, pa1, pa2, pa3;
        FP_BINIT(n0, n1, nb);
        const bf16x8 a0 = k_read<0>(ka[0] + kof), b0 = k_read<4096>(ka[0] + kof), a1 = k_read<0>(ka[1] + kof), b1 = k_read<4096>(ka[1] + kof);
        const bf16x8 a2 = k_read<0>(ka[2] + kof), b2 = k_read<4096>(ka[2] + kof), a3 = k_read<0>(ka[3] + kof), b3 = k_read<4096>(ka[3] + kof);
        float sa = 0.f, sb = 0.f;
#define FP_SM(d) do { _Pragma("unroll") for (int r = 4 * (d); r < 4 * (d) + 4; ++r) { c0[r] = __builtin_amdgcn_exp2f(c0[r]); c1[r] = __builtin_amdgcn_exp2f(c1[r]); sa += c0[r]; sa += c1[r]; } } while (0)
        FA_LGK(6); FA_SBAR(); n0 = __builtin_amdgcn_mfma_f32_32x32x16_bf16(a0, qr[0], n0, 0, 0, 0); n1 = __builtin_amdgcn_mfma_f32_32x32x16_bf16(b0, qr[0], n1, 0, 0, 0); FP_SM(0); FA_SBAR();
        FA_LGK(4); FA_SBAR(); n0 = __builtin_amdgcn_mfma_f32_32x32x16_bf16(a1, qr[1], n0, 0, 0, 0); n1 = __builtin_amdgcn_mfma_f32_32x32x16_bf16(b1, qr[1], n1, 0, 0, 0); FP_SM(1); FA_SBAR();
        FA_LGK(2); FA_SBAR(); n0 = __builtin_amdgcn_mfma_f32_32x32x16_bf16(a2, qr[2], n0, 0, 0, 0); n1 = __builtin_amdgcn_mfma_f32_32x32x16_bf16(b2, qr[2], n1, 0, 0, 0); FP_SM(2); FA_SBAR();
        FA_LGK(0); FA_SBAR(); n0 = __builtin_amdgcn_mfma_f32_32x32x16_bf16(a3, qr[3], n0, 0, 0, 0); n1 = __builtin_amdgcn_mfma_f32_32x32x16_bf16(b3, qr[3], n1, 0, 0, 0); FP_SM(3); FA_SBAR();
#undef FP_SM
        l_reg += sa + sb;
        typedef unsigned u32x4_t __attribute__((ext_vector_type(4)));
#define FA_PKS(P, BASE, OUT) do { u32x4_t w = {cvtpk(P[BASE + 0], P[BASE + 1]), cvtpk(P[BASE + 2], P[BASE + 3]), cvtpk(P[BASE + 4], P[BASE + 5]), cvtpk(P[BASE + 6], P[BASE + 7])}; OUT = __builtin_bit_cast(bf16x8, w); } while (0)
        FA_PKS(c0, 0, pa0); FA_PKS(c0, 8, pa1); FA_PKS(c1, 0, pa2); FA_PKS(c1, 8, pa3);
#undef FA_PKS
        FA_SBAR();
        pv_d0_pipe(o, vb0 + b * SHM_V, pa0, pa1, pa2, pa3);
        __syncthreads();
        FP_WRITEV(b); FP_WRITEK(nb); FP_LOADV(s + 3); FP_LOADK(s + 4);
        c0 = n0; c1 = n1;
    }
    for (; s < NT; ++s) {
        const int b = s & 1, nb = b ^ 1;
        f32x16 n0 = f32x16{}, n1 = f32x16{};
        if (s + 1 < NT && s + 1 <= tmax) FP_QK(n0, n1, s + 1, nb);
        if (s <= tmax) { bf16x8 pa0, pa1, pa2, pa3; fr_softmax(c0, c1, l_reg, pa0, pa1, pa2, pa3); FA_SBAR(); pv_d0_pipe(o, vb0 + b * SHM_V, pa0, pa1, pa2, pa3); }
        __syncthreads();
        if (s + 2 < NT) FP_WRITEV(b);
        if (s + 3 < NT) { FP_WRITEK(nb); FP_LOADV(s + 3); }
        if (s + 4 < NT) FP_LOADK(s + 4);
        c0 = n0; c1 = n1;
    }
    { auto rr = __builtin_amdgcn_permlane32_swap(__float_as_uint(l_reg), __float_as_uint(l_reg), false, false); l_reg = __uint_as_float(rr[0]) + __uint_as_float(rr[1]); }
    __builtin_amdgcn_s_setprio(0);
    l_out = l_reg;
#undef FP_LOADV
#undef FP_LOADK
#undef FP_WRITEV
#undef FP_WRITEK
#undef FP_BINIT
#undef FP_QK
}
}

constexpr int CW_BAR = 4096;
constexpr int CW_Q = 8192;
__device__ __forceinline__ int next_unit(Frame& F, unsigned* ctr) {
    LAS unsigned* uq = (LAS unsigned*)(F.lds + LDSCTL_OFF + 16);
    __syncthreads();
    if (F.tid == 0) *uq = atomicAdd(ctr, 1u);
    __syncthreads();
    return __builtin_amdgcn_readfirstlane((int)*uq);
}
template <int MODE = 0> __device__ __forceinline__ void ph_attn_da(Frame& F, int l, int rep = 0) {
    const bf16 *QD = WSP(bf16, WS_QD), *KD = WSP(bf16, WS_KD), *VD = WSP(bf16, WS_VD);
    bf16* MIX = rep == 2 ? WSP(bf16, WS_U) : WSP(bf16, WS_MIX); float* O1 = WSP(float, WS_O1);
    const int lane = F.lane;
    LAS float* al = (LAS float*)(F.lds + fa::Lds<64>::WS_OFF) + F.wave * 64;
    const float s1 = wave_sum(FIN(I_LQ1)[l * 64 + lane] * FIN(I_LK1)[l * 64 + lane]);
    const float s2 = wave_sum(FIN(I_LQ2)[l * 64 + lane] * FIN(I_LK2)[l * 64 + lane]);
    const float lam_init = __int_as_float(__builtin_amdgcn_readfirstlane(__float_as_int(LAM_INIT[l])));
    const float lam = __int_as_float(__builtin_amdgcn_readfirstlane(__float_as_int(expf(s1) - expf(s2) + lam_init)));
    float gqm = fabsf(FIN(I_DAQG)[l * 64 + lane]), gkm = fabsf(FIN(I_DAKG)[l * 64 + lane]);
    gqm = wave_max(gqm); gkm = wave_max(gkm);
    const float bound = __int_as_float(__builtin_amdgcn_readfirstlane(__float_as_int(1.01f * 11.5416f * gqm * gkm)));
    const float reach = __int_as_float(__builtin_amdgcn_readfirstlane(__float_as_int(2.0f * bound + 160.0f)));
    if ((MODE == 5) != (bound < 40.0f)) return;
    const int* posmm = WSP(int, WS_POSMM);
    unsigned* ctr = (unsigned*)(F.ws + WS_CTL) + (rep == 2 ? 20000 + 64 * (l * 2) : CW_Q + 64 * 8 * (l * 4 + 0 + rep));
    for (;;) {
        const int u = next_unit(F, ctr); if (u >= 384) break;
        const int qb = 31 - u / 12, bh = u % 12, b = bh / NH, h = bh % NH, q0 = qb * 256, NT = q0 / 64 + 4;
        const int* posb = F.pos + b * SEQ;
        const float slope2 = __int_as_float(__builtin_amdgcn_readfirstlane(__float_as_int(ALIBI_SLOPE[h] * LOG2E)));
        const size_t orow = (size_t)(b * SEQ + q0 + F.wave * 32);
        int T0 = 0, TL = 0; bool lin = false;
        { const int* qm = posmm + (size_t)(b * 128 + qb * 4) * 2; int qmin = qm[0], qmax = qm[1];
#pragma unroll
          for (int c = 1; c < 4; ++c) { qmin = qm[2 * c] < qmin ? qm[2 * c] : qmin; qmax = qm[2 * c + 1] > qmax ? qm[2 * c + 1] : qmax; }
          const int* km = posmm + (size_t)(b * 128) * 2;
          for (; T0 < NT - 4; ++T0) { const int kmin = km[2 * T0], kmax = km[2 * T0 + 1]; int dmin = qmin - kmax; if (kmin - qmax > dmin) dmin = kmin - qmax; if (dmin < 0) dmin = 0;
              if (!(slope2 * (float)dmin > reach)) break; }
          T0 &= ~1;
          for (TL = T0; TL < NT; ++TL) if (km[2 * TL + 1] > qmin) break;
          if (TL < NT - 4) TL = T0;
          int span = qm[1] - qm[0];
#pragma unroll
          for (int c = 1; c < 4; ++c) { const int sp = qm[2 * c + 1] - qm[2 * c]; span = sp > span ? sp : span; }
          lin = TL >= NT - 4 && slope2 * (float)span <= 24.0f;
        }
        for (int mp = 0; mp < 2; ++mp) {
            f32x16 o[4]; float l1;
            const bf16* Qp = QD + ((size_t)(bh * 2 + mp) * SEQ + q0) * 64; const int bhk = rep == 2 ? 0 : bh; const bf16* Kp = KD + (size_t)(bhk * 2 + mp) * SEQ * 64; const bf16* Vp = VD + (size_t)bhk * SEQ * 128;
            if (MODE == 5 && lin) { const int cw = posmm[(size_t)(b * 128 + qb * 4 + (__builtin_amdgcn_readfirstlane(F.tid >> 6) >> 1)) * 2];
                fa::attn_pass_da5p(Qp, Kp, Vp, posb, slope2, cw, q0, T0, NT, F.lds, F.tid, o, l1); }
            else fa::attn_pass<64, true, 1, MODE>(Qp, Kp, Vp, posb, slope2, bound, TL, q0, T0, NT, F.lds, F.tid, o, l1);
            int le_; asm volatile("v_mbcnt_lo_u32_b32 %0, -1, 0\n\tv_mbcnt_hi_u32_b32 %0, -1, %0" : "=v"(le_)); const int r32 = le_ & 31, hi = le_ >> 5;
            float f[16];
            if (mp == 0) {
                fa::row_bcast(1.0f / l1, al, r32, hi, f);
                unsigned lo = (unsigned)(((u * 8 + F.wave) * 8) * 64 + le_) * 16u; asm volatile("" : "+v"(lo));
#pragma unroll
                for (int j = 0; j < 8; ++j) { const int d = j >> 1, rb = (j & 1) * 8; v4u w;
                    w.x = pg8::pkh2(o[d][rb + 0] * f[rb + 0], o[d][rb + 1] * f[rb + 1]); w.y = pg8::pkh2(o[d][rb + 2] * f[rb + 2], o[d][rb + 3] * f[rb + 3]);
                    w.z = pg8::pkh2(o[d][rb + 4] * f[rb + 4], o[d][rb + 5] * f[rb + 5]); w.w = pg8::pkh2(o[d][rb + 6] * f[rb + 6], o[d][rb + 7] * f[rb + 7]);
                    fa::stg<v4u>(O1, lo + j * 1024, w); }
            } else {
                fa::row_bcast(lam / l1, al, r32, hi, f);
                const float* hg = FIN(I_DAHG) + (size_t)l * 768 + h * 128;
                float hgv[4];
#pragma unroll
                for (int d = 0; d < 4; ++d) hgv[d] = fa::ldg<float>(hg + d * 32, (unsigned)r32 * 4u) * (1.0f - lam_init);
                unsigned lo = (unsigned)(((u * 8 + F.wave) * 8) * 64 + le_) * 16u; asm volatile("" : "+v"(lo));
                bf16* mb = MIX + orow * D + h * 128; unsigned mo = (unsigned)(4 * hi * D + r32) * 2u; asm volatile("" : "+v"(mo));
                v4u w1[8];
#pragma unroll
                for (int j = 0; j < 8; ++j) w1[j] = fa::ldg<v4u>(O1, lo + j * 1024);
#pragma unroll
                for (int j = 0; j < 8; ++j) { const int d = j >> 1, rb = (j & 1) * 8; const unsigned ww[4] = {w1[j].x, w1[j].y, w1[j].z, w1[j].w};
#pragma unroll
                    for (int q = 0; q < 4; ++q) { o[d][rb + 2 * q] = pg8::uph_lo(ww[q]) - o[d][rb + 2 * q] * f[rb + 2 * q]; o[d][rb + 2 * q + 1] = pg8::uph_hi(ww[q]) - o[d][rb + 2 * q + 1] * f[rb + 2 * q + 1]; } }
#pragma unroll
                for (int r2 = 0; r2 < 16; ++r2) {
                    float ss = 0.f;
#pragma unroll
                    for (int d = 0; d < 4; ++d) ss += o[d][r2] * o[d][r2];
                    ss = sum32(ss);
                    const float rn = rsqrtf(ss * (1.f / 128) + EPS);
#pragma unroll
                    for (int d = 0; d < 4; ++d) fa::stg<bf16>(mb, mo + (fa::crowc(r2) * D + d * 32) * 2, (bf16)f2bf(o[d][r2] * rn * hgv[d]));
                }
            }
        }
    }
}
template <int MODE> __device__ __forceinline__ void ph_attn_mla(Frame& F, int l, int rep = 0, int ubase = 0, int ucount = 384, int cslot = 2, int xstat = 0) {
    const bf16 *QM = WSP(bf16, WS_QM), *KM = WSP(bf16, WS_KM), *VM = WSP(bf16, WS_VM);
    bf16* MIX = rep >= 2 ? WSP(bf16, WS_U) : WSP(bf16, WS_MIX);
    const int lane = F.lane;
    LAS float* al = (LAS float*)(F.lds + fa::Lds<192>::WS_OFF) + F.wave * 64;
    float gqm = fmaxf(fmaxf(fabsf(FIN(I_MQG)[l * 192 + lane]), fabsf(FIN(I_MQG)[l * 192 + 64 + lane])), fabsf(FIN(I_MQG)[l * 192 + 128 + lane]));
    float gkm = fmaxf(fmaxf(fabsf(FIN(I_MKG)[l * 192 + lane]), fabsf(FIN(I_MKG)[l * 192 + 64 + lane])), fabsf(FIN(I_MKG)[l * 192 + 128 + lane]));
    gqm = wave_max(gqm); gkm = wave_max(gkm);
    const float bound = __int_as_float(__builtin_amdgcn_readfirstlane(__float_as_int(1.01f * 19.9907f * gqm * gkm)));
    if ((MODE == 5) != (bound < 60.0f)) return;
    unsigned* ctr = (unsigned*)(F.ws + WS_CTL) + (rep >= 2 ? 20000 + 64 * (l * 2 + 1) : CW_Q + 64 * 8 * (l * 4 + cslot + rep));
    const bool xs = xstat != 0 && F.G == 256;
    for (int it_ = 0;; ++it_) {
        int qb, bh;
        if (xs) { if (it_ > 0 || F.bid >= 192) break; const int idx = (F.bid & 7) * 24 + (F.bid >> 3); bh = idx >> 4; qb = 31 - (idx & 15); __syncthreads(); }
        else { const int ui = next_unit(F, ctr); if (ui >= ucount) break; const int u = ubase + ui; qb = 31 - u / 12; bh = u % 12; }
        const int b = bh / NH, h = bh % NH, q0 = qb * 256, NT = q0 / 64 + 4;
        const size_t orow = (size_t)(b * SEQ + q0 + F.wave * 32);
        f32x16 o[4]; float l1;
        const int bhk = rep == 2 ? 0 : bh;
#if defined(PROBE_VAR)
        if (rep == 3) fa::attn_pass<192, false, 1, MODE, PROBE_VAR>(QM + ((size_t)bh * SEQ + q0) * 192, KM + (size_t)bhk * SEQ * 192, VM + (size_t)bhk * SEQ * 128, nullptr, 0.f, bound, 0, q0, 0, NT, F.lds, F.tid, o, l1); else
#endif
        fa::attn_pass<192, false, 1, MODE>(QM + ((size_t)bh * SEQ + q0) * 192, KM + (size_t)bhk * SEQ * 192, VM + (size_t)bhk * SEQ * 128, nullptr, 0.f, bound, 0, q0, 0, NT, F.lds, F.tid, o, l1);
        int le_; asm volatile("v_mbcnt_lo_u32_b32 %0, -1, 0\n\tv_mbcnt_hi_u32_b32 %0, -1, %0" : "=v"(le_)); const int r32 = le_ & 31, hi = le_ >> 5;
        float f[16]; fa::row_bcast(1.0f / l1, al, r32, hi, f);
        bf16* mb = MIX + orow * D + 768 + h * 128; unsigned mo = (unsigned)(4 * hi * D + r32) * 2u; asm volatile("" : "+v"(mo));
#pragma unroll
        for (int r2 = 0; r2 < 16; ++r2)
#pragma unroll
            for (int d = 0; d < 4; ++d) fa::stg<bf16>(mb, mo + (fa::crowc(r2) * D + d * 32) * 2, (bf16)f2bf(o[d][r2] * f[r2]));
    }
}
__device__ __forceinline__ void ph_sgu(Frame& F, int l, int rep = 0) {
    const _Float16* UU = WSP(_Float16, WS_UU); const bf16* GV = WSP(bf16, WS_GV); const float* SSQ = WSP(float, WS_SSQ_SGV); bf16* MIX = WSP(bf16, WS_MIX);
    LAS unsigned short* vs = (LAS unsigned short*)F.lds;
    LAS float* rs = (LAS float*)(F.lds + 128 * 128 * 2);
    const int lane = F.lane, r32 = lane & 31, hi = lane >> 5, tm = F.wave >> 1, tn0 = (F.wave & 1) * 2;
    __syncthreads();
    unsigned* sctr = (unsigned*)(F.ws + WS_CTL) + CW_Q + 64 * 8 * 16 + 64 * (l + 4 * rep);
    LAS float* wl = rs + 128;
    for (;;) { const int u = next_unit(F, sctr); if (u >= 512) break;
        const int g = u & 3, row0 = (u >> 2) * 128;
        const int t = 32 * tm + r32;
        const float* bias = FIN(I_SGB) + (l * 4 + g) * 128 + 32 * tm;
        const int c0 = g * 128 + 32 * tn0 + r32;
        float uu0[16], uu1[16], bvv[16];
#pragma unroll
        for (int r = 0; r < 16; ++r) { const int tt = crow(r, hi); const size_t row = (size_t)(row0 + 32 * tm + tt); uu0[r] = (float)UU[row * 512 + c0]; uu1[r] = (float)UU[row * 512 + c0 + 32]; bvv[r] = bias[tt]; }
        { const float* wb = FIN(I_SGW) + (size_t)(l * 4 + g) * 128 * 128;
          f32x4 wv_[8];
#pragma unroll
          for (int k = 0; k < 8; ++k) wv_[k] = *(const f32x4*)(wb + (size_t)(F.tid + k * NTHREADS) * 4);
#pragma unroll
          for (int k = 0; k < 8; ++k) { const int e = (F.tid + k * NTHREADS) * 4, tr = e >> 7, sc_ = e & 127; *(LAS f32x4*)(wl + tr * 132 + sc_) = wv_[k]; } }
        for (int i = F.tid; i < 128 * 16; i += NTHREADS) { const int s = i >> 4, c8 = i & 15; *(LAS bf16x8*)(vs + s * 128 + c8 * 8) = *(const bf16x8*)(GV + (size_t)(row0 + s) * 512 + g * 128 + c8 * 8); }
        if (F.tid < 128) { const f32x4 p = *(const f32x4*)(SSQ + (size_t)(row0 + F.tid) * 16 + g * 4); rs[F.tid] = rsqrtf(((p.x + p.y) + (p.z + p.w)) * (1.f / 128) + EPS); }
        __syncthreads();
        f32x16 acc0 = f32x16{}, acc1 = f32x16{};
        const LAS float* wrow = wl + t * 132;
        for (int ks = 0; ks < 2 * (tm + 1); ++ks) {
            const int s0 = 16 * ks + 8 * hi;
            const f32x4 w0 = *(const LAS f32x4*)(wrow + s0), w1 = *(const LAS f32x4*)(wrow + s0 + 4);
            float wv[8] = {w0.x, w0.y, w0.z, w0.w, w1.x, w1.y, w1.z, w1.w};
            bf16x8 af, b0, b1;
#pragma unroll
            for (int j = 0; j < 8; ++j) { af[j] = (short)f2bf(s0 + j <= t ? wv[j] * rs[s0 + j] : 0.f);
                b0[j] = (short)vs[(s0 + j) * 128 + 32 * tn0 + r32]; b1[j] = (short)vs[(s0 + j) * 128 + 32 * (tn0 + 1) + r32]; }
            acc0 = __builtin_amdgcn_mfma_f32_32x32x16_bf16(af, b0, acc0, 0, 0, 0);
            acc1 = __builtin_amdgcn_mfma_f32_32x32x16_bf16(af, b1, acc1, 0, 0, 0);
        }
#pragma unroll
        for (int r = 0; r < 16; ++r) { const int tt = crow(r, hi); const size_t row = (size_t)(row0 + 32 * tm + tt);
            MIX[row * D + 1536 + c0] = (bf16)f2bf(uu0[r] * (acc0[r] + bvv[r]));
            MIX[row * D + 1536 + c0 + 32] = (bf16)f2bf(uu1[r] * (acc1[r] + bvv[r])); }
        __syncthreads();
    }
}
__device__ __forceinline__ void ph_convfix(Frame& F, int l) {
    const unsigned short* EDGE = WSP(unsigned short, WS_EDGE); bf16* U = WSP(bf16, WS_U);
    auto ldh4o = [&](unsigned eo) { const uint2 w = *(const uint2*)((const char*)EDGE + (size_t)eo * 2u); return (f32x4){pg8::uph_lo(w.x), pg8::uph_hi(w.x), pg8::uph_lo(w.y), pg8::uph_hi(w.y)}; };
    const float* cw = FIN(I_CONVW) + (size_t)l * 3 * NUP; const float* cb = FIN(I_CONVB) + (size_t)l * NUP;
    const int gt = F.bid * NTHREADS + F.tid, nt = F.G * NTHREADS;
    constexpr int NIT = (M / 64) * 2 * (DFF / 4);
    auto item = [&](int i, unsigned long long& pk, size_t& dst) {
        const int ch = (i % (DFF / 4)) * 4, r = (i / (DFF / 4)) & 1, blk = i / (2 * (DFF / 4)); const bool first = (blk % (SEQ / 64)) == 0;
        f32x4 y[2];
#pragma unroll
        for (int bj = 0; bj < 2; ++bj) {
            const unsigned eo = (unsigned)(((blk * 4) * 2 + bj) * DFF + ch);
            const f32x4 z = {0.f, 0.f, 0.f, 0.f};
            const f32x4 a0 = ldh4o(eo + (unsigned)(r * 2 * DFF));
            const f32x4 a1 = r == 1 ? ldh4o(eo) : (first ? z : ldh4o(eo - (unsigned)(2 * DFF)));
            const f32x4 a2 = first ? z : (r == 1 ? ldh4o(eo - (unsigned)(2 * DFF)) : ldh4o(eo - (unsigned)(4 * DFF)));
            y[bj] = *(const f32x4*)(cb + bj * DFF + ch) + *(const f32x4*)(cw + (size_t)2 * NUP + bj * DFF + ch) * a0 + *(const f32x4*)(cw + (size_t)NUP + bj * DFF + ch) * a1 + *(const f32x4*)(cw + bj * DFF + ch) * a2; }
        float o[4];
#pragma unroll
        for (int e = 0; e < 4; ++e) { const float g = y[0][e]; o[e] = g * __builtin_amdgcn_rcpf(1.0f + __expf(-g)) * y[1][e]; }
        pk = (unsigned long long)pk2(o[0], o[1]) | ((unsigned long long)pk2(o[2], o[3]) << 32); dst = (size_t)(blk * 64 + r) * DFF + ch; };
    for (int i = gt; i < NIT; i += 3 * nt) {
        unsigned long long p0 = 0, p1 = 0, p2 = 0; size_t d0 = 0, d1 = 0, d2 = 0;
        const bool h1 = i + nt < NIT, h2 = i + 2 * nt < NIT;
        item(i, p0, d0); if (h1) item(i + nt, p1, d1); if (h2) item(i + 2 * nt, p2, d2);
        *(unsigned long long*)(U + d0) = p0; if (h1) *(unsigned long long*)(U + d1) = p1; if (h2) *(unsigned long long*)(U + d2) = p2; }
}

__device__ __forceinline__ void ph_krope(Frame& F, int l) {
    const bf16* H = WSP(bf16, WS_H); const bf16* Wk = wptr(F, l, WL_IN) + (size_t)4096 * D; float* KR = WSP(float, WS_KR); float* SSQ = WSP(float, WS_SSQ_KR);
    constexpr int PITCH = 1024;
    LAS unsigned char* As = F.lds; LAS unsigned char* Bs = F.lds + 64 * PITCH;
    LAS float* red = (LAS float*)F.lds;
    const int lane = F.lane, r32 = lane & 31, hi = lane >> 5, w = F.wave;
    __syncthreads();
    for (int tb = F.bid; tb < M / 64; tb += F.G) {
        f32x16 acc[2][2];
#pragma unroll
        for (int i = 0; i < 2; ++i)
#pragma unroll
            for (int j = 0; j < 2; ++j) acc[i][j] = f32x16{};
        for (int kc = 0; kc < 4; ++kc) {
#pragma unroll
            for (int p = 0; p < 8; ++p) { const int q = p * NTHREADS + F.tid, row = q >> 6, c16 = q & 63;
                *(LAS v4u*)(As + row * PITCH + (c16 ^ (row & 7)) * 16) = *(const v4u*)(H + (size_t)(tb * 64 + row) * D + kc * 512 + c16 * 8);
                *(LAS v4u*)(Bs + row * PITCH + (c16 ^ (row & 7)) * 16) = *(const v4u*)(Wk + (size_t)row * D + kc * 512 + c16 * 8); }
            __syncthreads();
#pragma unroll
            for (int ks = 0; ks < 4; ++ks) { const int ko = (((w * 64 + ks * 16 + hi * 8) >> 3) ^ (r32 & 7)) * 16;
                const bf16x8 A0 = *(const LAS bf16x8*)(As + r32 * PITCH + ko), A1 = *(const LAS bf16x8*)(As + (32 + r32) * PITCH + ko);
                const bf16x8 B0 = *(const LAS bf16x8*)(Bs + r32 * PITCH + ko), B1 = *(const LAS bf16x8*)(Bs + (32 + r32) * PITCH + ko);
                acc[0][0] = __builtin_amdgcn_mfma_f32_32x32x16_bf16(A0, B0, acc[0][0], 0, 0, 0); acc[0][1] = __builtin_amdgcn_mfma_f32_32x32x16_bf16(A0, B1, acc[0][1], 0, 0, 0);
                acc[1][0] = __builtin_amdgcn_mfma_f32_32x32x16_bf16(A1, B0, acc[1][0], 0, 0, 0); acc[1][1] = __builtin_amdgcn_mfma_f32_32x32x16_bf16(A1, B1, acc[1][1], 0, 0, 0); }
            __syncthreads();
        }
#pragma unroll
        for (int i = 0; i < 2; ++i)
#pragma unroll
            for (int j = 0; j < 2; ++j)
#pragma unroll
                for (int r = 0; r < 16; ++r) red[(w * 64 + (i * 2 + j) * 16 + r) * 64 + lane] = acc[i][j][r];
        __syncthreads();
#pragma unroll
        for (int c = 0; c < 8; ++c) { const int cb = w * 8 + c, i = cb >> 5, j = (cb >> 4) & 1, r = cb & 15;
            float v = 0.f;
#pragma unroll
            for (int ww = 0; ww < 8; ++ww) v += red[(ww * 64 + cb) * 64 + lane];
            const int row = tb * 64 + 32 * i + crow(r, hi);
            KR[(size_t)row * 64 + 32 * j + r32] = v;
            const float ss = sum32(v * v);
            if (r32 == 0) SSQ[(size_t)row * 2 + j] = ss; }
        __syncthreads();
    }
}
__device__ __forceinline__ void frame_init(Frame& F, const Args& a, unsigned char* lds) {
    F.lds = (LAS unsigned char*)lds; F.tid = threadIdx.x; F.lane = F.tid & 63; F.wave = __builtin_amdgcn_readfirstlane(F.tid >> 6); F.wave0 = F.wave;
    F.bid = blockIdx.x; F.G = gridDim.x; F.gw = F.bid * NWAVES + F.wave; F.ngw = F.G * NWAVES;
    F.ka = (const __attribute__((address_space(4))) Args*)__builtin_amdgcn_kernarg_segment_ptr();
    F.pos = (const int*)a.in[I_POS]; F.out = a.out; F.ws = a.ws;
}
__device__ __forceinline__ void frame_retid(Frame& F) {
    int lane; asm volatile("v_mbcnt_lo_u32_b32 %0, -1, 0\n\tv_mbcnt_hi_u32_b32 %0, -1, %0" : "=v"(lane));
    int w = F.wave0; asm volatile("" : "+s"(w));
    F.lane = lane; F.wave = w; F.tid = w * 64 + lane;
    int bid = blockIdx.x, G = gridDim.x; asm volatile("" : "+s"(bid)); asm volatile("" : "+s"(G)); F.bid = bid; F.G = G;
    F.gw = bid * NWAVES + F.wave; F.ngw = G * NWAVES;
}
__device__ __forceinline__ void grid_bar(const XcdBarrier& bar, int wave0) {
    int lane_; asm volatile("v_mbcnt_lo_u32_b32 %0, -1, 0\n\tv_mbcnt_hi_u32_b32 %0, -1, %0" : "=v"(lane_)); const bool leader = (wave0 == 0) && (lane_ == 0);
    XcdBarrier b2 = bar; unsigned z_ = 0u; asm volatile("" : "+s"(b2.x), "+s"(z_)); b2.bar = bar.bar + z_; xcd_barrier(b2, leader); }
template <int PH> __device__ __forceinline__ void run_phase(Frame& F, int l) {
    frame_retid(F); asm volatile("; PHASE_BEGIN %0" :: "n"(PH));
    const float* mod = WSP(float, WS_MOD) + (size_t)l * 12 * D;
    if constexpr (PH == 0) ph_prologue(F);
    if constexpr (PH == 1) ph_modreduce(F);
    if constexpr (PH == 2) { if (l == 0) ph_norm<false>(F, l, FIN(I_X), 0, D); else ph_norm<true>(F, l, WSP(bf16, WS_XB), 0, D); }
    if constexpr (PH == 3) { pg8::Gemm g{WSP(bf16, WS_H), wptr(F, l, WL_IN), M, 4096, D}; pg8::StaticOrder S; S.init(M, 4096, F.G, F.bid);
        pg8::EpiInProj E{WSP(bf16, WS_QD), WSP(bf16, WS_KD), WSP(bf16, WS_VD), WSP(bf16, WS_QA), WSP(bf16, WS_KVA), WSP(bf16, WS_GV), WSP(unsigned short, WS_UU), WSP(float, WS_KR),
                         WSP(float, WS_SSQ_QA), WSP(float, WS_SSQ_KVA), WSP(float, WS_SSQ_SGV), WSP(float, WS_SSQ_KR), FIN(I_DAQG) + l * 64, FIN(I_DAKG) + l * 64, FIN(I_QAG) + l * 512, FIN(I_KVAG) + l * 256, FIN(I_SGVG) + l * 512};
        pg8::gemm_phase<pg8::EpiInProj, pg8::StaticOrder, true, true>(F.lds, g, S, E, F.tid); frame_retid(F); ph_krope(F, l); }
    if constexpr (PH == 5) {
        PG8_LAS float* X = (PG8_LAS float*)(F.lds + LDSCTL_OFF + 1024);
        { pg8::Gemm g{WSP(bf16, WS_QA), wptr(F, l, WL_UQ), M, UQ_PAD, QRANK}; pg8::StaticOrder S; S.init(M, UQ_PAD, F.G, F.bid);
          pg8::EpiMlaQ E{WSP(bf16, WS_QM), WSP(float, WS_SSQ_QA), WSP(float, WS_COS), WSP(float, WS_SIN), FIN(I_MQG) + l * 192, X};
          pg8::gemm_phase<pg8::EpiMlaQ, pg8::StaticOrder, true, true>(F.lds, g, S, E, F.tid); }
        __syncthreads(); frame_retid(F);
        { pg8::Gemm g{WSP(bf16, WS_KVA), wptr(F, l, WL_UKV), M, UKV_N, KVRANK}; pg8::StaticOrder S; S.init(M, UKV_N, F.G, F.G - 1 - F.bid);
          pg8::EpiMlaKV E{WSP(bf16, WS_KM), WSP(bf16, WS_VM), WSP(float, WS_SSQ_KVA), WSP(float, WS_SSQ_KR), WSP(float, WS_KR), WSP(float, WS_COS), WSP(float, WS_SIN), FIN(I_MKG) + l * 192, X};
          pg8::gemm_phase<pg8::EpiMlaKV, pg8::StaticOrder, true, true>(F.lds, g, S, E, F.tid); }
    }
#ifndef MLA_FRONT
#define MLA_FRONT 192
#endif
    if constexpr (PH == 7) { ph_attn_mla<5>(F, l, 0, 0, MLA_FRONT, 3, 1); frame_retid(F); ph_attn_mla<0>(F, l, 0, 0, MLA_FRONT, 3, 1); frame_retid(F);
        ph_attn_da<5>(F, l); frame_retid(F); ph_attn_da<0>(F, l); frame_retid(F); asm volatile("; PHASE_BEGIN 71");
        ph_attn_mla<5>(F, l, 0, MLA_FRONT, 384 - MLA_FRONT, 2); frame_retid(F); ph_attn_mla<0>(F, l, 0, MLA_FRONT, 384 - MLA_FRONT, 2); frame_retid(F); asm volatile("; PHASE_BEGIN 72"); ph_sgu(F, l); }
    if constexpr (PH == 8) { pg8::Gemm g{WSP(bf16, WS_MIX), wptr(F, l, WL_OUT), M, D, D}; pg8::StaticOrder S; S.init(M, D, F.G, F.bid);
        pg8::EpiResidP E{l == 0 ? (const void*)FIN(I_X) : (const void*)WSP(bf16, WS_XB), WSP(bf16, WS_XB), l != 0, 1, mod + 2 * D, 6 * D}; pg8::gemm_phase<pg8::EpiResidP, pg8::StaticOrder, true, true>(F.lds, g, S, E, F.tid); }
    if constexpr (PH == 9) ph_norm<true>(F, l, WSP(bf16, WS_XB), 3 * D, 4 * D);
    if constexpr (PH == 10) { pg8::Gemm g{WSP(bf16, WS_H), wptr(F, l, WL_UP), M, NUP, D}; pg8::StaticOrder S; S.init(M, NUP, F.G, F.bid);
        pg8::EpiConvGate E{WSP(bf16, WS_U), WSP(unsigned short, WS_EDGE), FIN(I_CONVW) + (size_t)l * 3 * NUP, FIN(I_CONVB) + (size_t)l * NUP}; pg8::gemm_phase<pg8::EpiConvGate, pg8::StaticOrder, true, true>(F.lds, g, S, E, F.tid); }
    if constexpr (PH == 11) ph_convfix(F, l);
    if constexpr (PH == 12) { pg8::Gemm g{WSP(bf16, WS_U), wptr(F, l, WL_DOWN), M, D, DFF}; pg8::StaticOrder S; S.init(M, D, F.G, F.bid);
        pg8::EpiResidP E{WSP(bf16, WS_XB), l + 1 < DEPTH ? (void*)WSP(bf16, WS_XB) : (void*)F.out, 1, l + 1 < DEPTH, mod + 5 * D, 6 * D}; pg8::gemm_phase<pg8::EpiResidP, pg8::StaticOrder, true, true>(F.lds, g, S, E, F.tid); }
}
__global__ void __launch_bounds__(NTHREADS, 2) mega_fwd(Args a) {
    extern __shared__ __attribute__((aligned(16))) unsigned char lds[];
    Frame F; frame_init(F, a, lds);
    if (F.tid < 16) ((LAS unsigned*)(F.lds + LDSCTL_OFF))[F.tid] = 0u;
    __syncthreads();
    XcdBarrier bar = xcd_barrier_post((unsigned*)(F.ws + WS_CTL) + CW_BAR, (volatile LAS unsigned*)(F.lds + LDSCTL_OFF + 32));
    run_phase<0>(F, 0); grid_bar(bar, F.wave0);
#if defined(PROBE_P0)
    run_phase<0>(F, 0); grid_bar(bar, F.wave0);
#endif
    run_phase<1>(F, 0); grid_bar(bar, F.wave0);
    for (int l = 0; l < DEPTH; ++l) {
        run_phase<2>(F, l); grid_bar(bar, F.wave0);
#if defined(PROBE_EW)
        run_phase<2>(F, l); grid_bar(bar, F.wave0);
#endif
        run_phase<3>(F, l); grid_bar(bar, F.wave0);
#if defined(PROBE_GEMM)
        run_phase<3>(F, l); grid_bar(bar, F.wave0);
#endif
        run_phase<5>(F, l); grid_bar(bar, F.wave0);
        run_phase<7>(F, l); grid_bar(bar, F.wave0);
#if defined(PROBE_P7)
        frame_retid(F); ph_attn_da<5>(F, l, 1); frame_retid(F); ph_attn_mla<5>(F, l, 1); grid_bar(bar, F.wave0);
#endif
#if defined(PROBE_LOC)
        frame_retid(F); ph_attn_da<5>(F, l, 2); frame_retid(F); ph_attn_mla<5>(F, l, 2); grid_bar(bar, F.wave0);
#endif
#if defined(PROBE_DA)
        frame_retid(F); ph_attn_da<5>(F, l, 1); grid_bar(bar, F.wave0);
#endif
#if defined(PROBE_VAR)
        frame_retid(F); ph_attn_mla<5>(F, l, 3); grid_bar(bar, F.wave0);
#endif
#if defined(PROBE_MLA)
        frame_retid(F); ph_attn_mla<5>(F, l, 1); grid_bar(bar, F.wave0);
#endif
#if defined(PROBE_SGU)
        frame_retid(F); ph_sgu(F, l, 1); grid_bar(bar, F.wave0);
#endif
        run_phase<8>(F, l); grid_bar(bar, F.wave0);
        run_phase<9>(F, l); grid_bar(bar, F.wave0);
        run_phase<10>(F, l); grid_bar(bar, F.wave0);
#if defined(PROBE_G10)
        frame_retid(F); run_phase<10>(F, l); grid_bar(bar, F.wave0);
#endif
#if defined(PROBE_G10N)
        frame_retid(F); { pg8::Gemm g{WSP(bf16, WS_H), wptr(F, l, WL_UP), M, NUP, D}; pg8::StaticOrder S; S.init(M, NUP, F.G, F.bid);
          pg8::EpiNull E{WSP(float, WS_MIX)}; pg8::gemm_phase<pg8::EpiNull, pg8::StaticOrder, true, true>(F.lds, g, S, E, F.tid); } grid_bar(bar, F.wave0);
#endif
#if defined(PROBE_GEMM)
        run_phase<10>(F, l); grid_bar(bar, F.wave0);
#endif
        run_phase<11>(F, l); grid_bar(bar, F.wave0);
#if defined(PROBE_EW)
        run_phase<11>(F, l); grid_bar(bar, F.wave0);
#endif
        run_phase<12>(F, l); if (l + 1 < DEPTH) grid_bar(bar, F.wave0);
    }
}

extern "C" void kernel_launch(void* const* d_in, const int* in_sizes, int n_in, void* d_out, int out_size, void* d_ws, size_t ws_size, hipStream_t stream) {
    static int grid = 0;
    if (grid == 0) {
        if (n_in != N_IN || in_sizes[0] != M * D || out_size != M * D || ws_size < WS_END) { fprintf(stderr, "kernel_launch: shape mismatch (n_in %d, ws %zu, need %zu)\n", n_in, ws_size, (size_t)WS_END); grid = -1; return; }
        int dev = 0, cus = 0, per_cu = 0;
        if (hipGetDevice(&dev) != hipSuccess || hipDeviceGetAttribute(&cus, hipDeviceAttributeMultiprocessorCount, dev) != hipSuccess) { grid = -1; return; }
        if (hipFuncSetAttribute((const void*)mega_fwd, hipFuncAttributeMaxDynamicSharedMemorySize, LDS_BYTES) != hipSuccess) { fprintf(stderr, "hipFuncSetAttribute failed\n"); grid = -1; return; }
        if (hipOccupancyMaxActiveBlocksPerMultiprocessor(&per_cu, (const void*)mega_fwd, NTHREADS, LDS_BYTES) != hipSuccess || per_cu < 1) fprintf(stderr, "kernel_launch: occupancy query reports %d\n", per_cu);
        (void)hipGetLastError();
        grid = cus > 0 ? cus : 256;
    }
    if (grid < 0) return;
    if (hipMemsetAsync((char*)d_ws + WS_CTL, 0, CTL_ZERO_BYTES, stream) != hipSuccess) { fprintf(stderr, "kernel_launch: memset failed\n"); return; }
    Args a{};
    for (int i = 0; i < N_IN; ++i) a.in[i] = d_in[i];
    a.out = (float*)d_out; a.ws = (unsigned char*)d_ws; a.ph = 0; a.l = 0;
    hipLaunchKernelGGL(mega_fwd, dim3(grid), dim3(NTHREADS), LDS_BYTES, stream, a);
    const hipError_t le = hipPeekAtLastError();
    if (le != hipSuccess) fprintf(stderr, "kernel_launch: launch failed: %s\n", hipGetErrorName(le));
}
```

```cpp
#include <hip/hip_runtime.h>
#include <cstdio>
#include <cstdint>
#include <cmath>
#define GAS __attribute__((address_space(1)))
#define LAS __attribute__((address_space(3)))
namespace pg8 {
#define PG8_LAS __attribute__((address_space(3)))
typedef unsigned short bf16_t;
typedef short bf16x8 __attribute__((ext_vector_type(8)));
typedef float f32x4 __attribute__((ext_vector_type(4)));
typedef unsigned u32x4 __attribute__((ext_vector_type(4)));
constexpr int BM = 256, BK = 64, HALF = 128, HTB = HALF * BK * 2  , STAGE_BYTES = 8 * HTB, NXCD = 8, WGM = 8;

__host__ __device__ __forceinline__ int lds_byte(int r, int c) { const int st = (r >> 4) * 2 + (c >> 5), rr = r & 15, cc = c & 31, ob = rr * 64 + cc * 2; return st * 1024 + (ob ^ (((ob >> 9) & 1) << 5)); }
__host__ __device__ __forceinline__ void stage_rc(int b, int& R, int& C) { const int st = b / 1024, sb = b % 1024, swz = sb ^ (((sb >> 9) & 1) << 5); R = (st >> 1) * 16 + swz / 64; C = (st & 1) * 32 + (swz % 64) / 2; }
__host__ __device__ __forceinline__ int perm32(int rho) { const int n = rho >> 4, i = rho & 15; return 8 * (i >> 2) + 4 * n + (i & 3); }

struct Unit { int pm, pn; };
struct Gemm { const bf16_t* A; const bf16_t* Bt; int M, N, K; };

struct StaticOrder {
    int nM, nN, nwg, G, c;
    __host__ __device__ void init(int M, int N, int G_, int c_) { nM = M / BM; nN = N / BM; nwg = nM * nN; G = G_; c = c_; }
    __host__ __device__ bool next(int i, Unit& u) const {
        const long L = (long)i * G + c; if (L >= nwg) return false;
        int wgid = (int)L; { const int q = nwg / NXCD, r = nwg % NXCD, xcd = wgid % NXCD, off = wgid / NXCD; wgid = (xcd < r ? xcd * (q + 1) : r * (q + 1) + (xcd - r) * q) + off; }
        const int nig = WGM * nN, gid = wgid / nig, fm = gid * WGM, gsz = (nM - fm) < WGM ? (nM - fm) : WGM;
        u.pm = fm + ((wgid % nig) % gsz); u.pn = (wgid % nig) / gsz; return true;
    }
    __device__ __forceinline__ void a_ready(const Unit&) const {}
    __device__ __forceinline__ void done(const Unit&) const {}
};

__device__ __forceinline__ unsigned cvt_pk_bf16(float lo, float hi) { unsigned r; asm volatile("v_cvt_pk_bf16_f32 %0, %1, %2" : "=v"(r) : "v"(lo), "v"(hi)); return r; }
typedef float f32x2 __attribute__((ext_vector_type(2)));
typedef _Float16 f16x2 __attribute__((ext_vector_type(2)));
__device__ __forceinline__ unsigned pkh2(float a, float b) { const f16x2 h = {(_Float16)a, (_Float16)b}; return __builtin_bit_cast(unsigned, h); }
__device__ __forceinline__ float uph_lo(unsigned w) { return (float)__builtin_bit_cast(f16x2, w).x; }
__device__ __forceinline__ float uph_hi(unsigned w) { return (float)__builtin_bit_cast(f16x2, w).y; }

template <class Epi, class Sched, bool ALIGN_EPI = false, bool SP2 = false>
__device__ __forceinline__ void gemm_phase(PG8_LAS unsigned char* lds, const Gemm g, const Sched& S, const Epi& E, int tid_in) {
    int tid_ = tid_in; asm volatile("" : "+v"(tid_));
    const int tid = tid_, wid = __builtin_amdgcn_readfirstlane(tid >> 6), lane = tid & 63, wr = wid >> 2, wc = wid & 3, fr = lane & 15, fq = lane >> 4;
    const int K = g.K, nt = K / BK;
    unsigned voffA[2], voffB[2];
#pragma unroll
    for (int i = 0; i < 2; ++i) { int R, C; stage_rc(tid * 16 + i * 8192, R, C); const int Rb = Epi::PERM ? ((R & ~31) + perm32(R & 31)) : R;
        voffA[i] = (unsigned)(R * K + C) * 2u; voffB[i] = (unsigned)(Rb * K + C) * 2u; }
    const size_t kstep = (size_t)(BK * 2);
    const size_t hstep = (size_t)HALF * K * 2;
    const size_t tstep = 2 * hstep;
    const unsigned ldsw = (unsigned)wid * 1024u;
    const int aoff = lds_byte(wr * 64 + fr, fq * 8), boff = lds_byte(wc * 32 + fr, fq * 8);
#define PG8_SA(b, h) (((b) * 2 + (h)) * HTB)
#define PG8_SB(b, h) ((4 + (b) * 2 + (h)) * HTB)
#define PG8_STAGE(bufoff, gbase, voff) do { _Pragma("unroll") for (int _i = 0; _i < 2; ++_i) \
        __builtin_amdgcn_global_load_lds((const unsigned*)((const char*)(gbase) + (voff)[_i]), (PG8_LAS unsigned*)(lds + (bufoff) + ldsw + _i * 8192), 16, 0, 0); } while (0)
#define PG8_LDA(dst, b, h) do { _Pragma("unroll") for (int m = 0; m < 4; ++m) _Pragma("unroll") for (int k = 0; k < 2; ++k) dst[m][k] = *(const PG8_LAS bf16x8*)(lds + PG8_SA(b, h) + aoff + m * 2048 + k * 1024); } while (0)
#define PG8_LDB(dst, b, h) do { _Pragma("unroll") for (int n = 0; n < 2; ++n) _Pragma("unroll") for (int k = 0; k < 2; ++k) dst[n][k] = *(const PG8_LAS bf16x8*)(lds + PG8_SB(b, h) + boff + n * 2048 + k * 1024); } while (0)
#define PG8_MMA(ai, bj, At, Bt) do { __builtin_amdgcn_s_setprio(1); _Pragma("unroll") for (int m = 0; m < 4; ++m) _Pragma("unroll") for (int n = 0; n < 2; ++n) _Pragma("unroll") for (int k = 0; k < 2; ++k) \
        acc[ai][bj][m][n] = __builtin_amdgcn_mfma_f32_16x16x32_bf16(Bt[n][k], At[m][k], acc[ai][bj][m][n], 0, 0, 0); __builtin_amdgcn_s_setprio(0); } while (0)
#define PG8_WAIT_V(n) asm volatile("s_waitcnt vmcnt(" #n ")" ::: "memory")
#define PG8_WAIT_L(n) asm volatile("s_waitcnt lgkmcnt(" #n ")" ::: "memory")
#define PG8_BAR __builtin_amdgcn_s_barrier()
#define PG8_SCHED __builtin_amdgcn_sched_barrier(0)
    Unit cur, nxt; int ui = 0;
    if (!S.next(0, cur)) return;
    f32x4 acc[2][2][4][2];
#pragma unroll
    for (int a = 0; a < 2; ++a)
#pragma unroll
        for (int b = 0; b < 2; ++b)
#pragma unroll
            for (int m = 0; m < 4; ++m)
#pragma unroll
                for (int n = 0; n < 2; ++n) acc[a][b][m][n] = (f32x4){0.f, 0.f, 0.f, 0.f};
    bf16x8 At[4][2], B0[2][2], B1[2][2];
    const char* cA = (const char*)g.A + (size_t)cur.pm * tstep; const char* cB = (const char*)g.Bt + (size_t)cur.pn * tstep;
    S.a_ready(cur);
    if constexpr (SP2) {
        PG8_STAGE(PG8_SB(0, 0), cB, voffB); PG8_STAGE(PG8_SB(0, 1), cB + hstep, voffB); PG8_STAGE(PG8_SA(0, 0), cA, voffA); PG8_STAGE(PG8_SA(0, 1), cA + hstep, voffA);
        if (wr == 1) PG8_BAR;
        PG8_WAIT_V(2); PG8_BAR;
        PG8_STAGE(PG8_SB(1, 0), cB + kstep, voffB); PG8_STAGE(PG8_SA(1, 0), cA + kstep, voffA); PG8_STAGE(PG8_SB(1, 1), cB + hstep + kstep, voffB);
        PG8_WAIT_V(6); PG8_BAR;
    } else {
        PG8_STAGE(PG8_SB(0, 0), cB, voffB); PG8_STAGE(PG8_SA(0, 0), cA, voffA); PG8_STAGE(PG8_SB(0, 1), cB + hstep, voffB); PG8_STAGE(PG8_SA(0, 1), cA + hstep, voffA);
        if (wr == 1) PG8_BAR;
        PG8_WAIT_V(4); PG8_BAR;
        PG8_STAGE(PG8_SB(1, 0), cB + kstep, voffB); PG8_STAGE(PG8_SA(1, 0), cA + kstep, voffA); PG8_STAGE(PG8_SB(1, 1), cB + hstep + kstep, voffB);
        PG8_WAIT_V(6); PG8_BAR;
    }
    for (;;) {
        const bool has_next = S.next(ui + 1, nxt);
        const char* nA = has_next ? (const char*)g.A + (size_t)nxt.pm * tstep : cA; const char* nB = has_next ? (const char*)g.Bt + (size_t)nxt.pn * tstep : cB;
        for (int t = 0; t < nt; t += 2) {
            const bool last = (t == nt - 2);
            const char* a1 = cA + (size_t)(t + 1) * kstep;
            const char* a2 = last ? nA : cA + (size_t)(t + 2) * kstep; const char* b2 = last ? nB : cB + (size_t)(t + 2) * kstep;
            const char* a3 = a2 + kstep; const char* b3 = b2 + kstep;
            if (last && has_next) S.a_ready(nxt);
            if constexpr (SP2) {
            PG8_LDB(B0, 0, 0); PG8_LDB(B1, 0, 1); PG8_SCHED; PG8_LDA(At, 0, 0); PG8_STAGE(PG8_SA(1, 1), a1 + hstep, voffA);
            PG8_WAIT_V(8); PG8_WAIT_L(0); PG8_BAR; PG8_MMA(0, 0, At, B0); PG8_MMA(0, 1, At, B1); PG8_BAR; PG8_SCHED;
            PG8_LDA(At, 0, 1); PG8_STAGE(PG8_SB(0, 0), b2, voffB); PG8_STAGE(PG8_SB(0, 1), b2 + hstep, voffB); PG8_STAGE(PG8_SA(0, 0), a2, voffA);
            PG8_WAIT_V(8); PG8_WAIT_L(0); PG8_BAR; PG8_MMA(1, 0, At, B0); PG8_MMA(1, 1, At, B1); PG8_BAR; PG8_SCHED;
            PG8_LDB(B0, 1, 0); PG8_LDB(B1, 1, 1); PG8_SCHED; PG8_LDA(At, 1, 0); PG8_STAGE(PG8_SA(0, 1), a2 + hstep, voffA);
            PG8_WAIT_V(8); PG8_WAIT_L(0); PG8_BAR; PG8_MMA(0, 0, At, B0); PG8_MMA(0, 1, At, B1); PG8_BAR; PG8_SCHED;
            PG8_LDA(At, 1, 1); PG8_STAGE(PG8_SB(1, 0), b3, voffB); PG8_STAGE(PG8_SB(1, 1), b3 + hstep, voffB); PG8_STAGE(PG8_SA(1, 0), a3, voffA);
            PG8_WAIT_V(8); PG8_WAIT_L(0); PG8_BAR; PG8_MMA(1, 0, At, B0); PG8_MMA(1, 1, At, B1); PG8_BAR; PG8_SCHED;
            } else {
            PG8_LDB(B0, 0, 0); PG8_SCHED; PG8_LDA(At, 0, 0); PG8_STAGE(PG8_SA(1, 1), a1 + hstep, voffA);
            PG8_WAIT_L(8); PG8_BAR; PG8_WAIT_L(0); PG8_MMA(0, 0, At, B0); PG8_BAR; PG8_SCHED;
            PG8_LDB(B1, 0, 1); PG8_STAGE(PG8_SB(0, 0), b2, voffB);
            PG8_BAR; PG8_WAIT_L(0); PG8_MMA(0, 1, At, B1); PG8_BAR;
            PG8_LDA(At, 0, 1); PG8_STAGE(PG8_SA(0, 0), a2, voffA);
            PG8_BAR; PG8_WAIT_L(0); PG8_MMA(1, 0, At, B0); PG8_BAR; PG8_SCHED;
            PG8_STAGE(PG8_SB(0, 1), b2 + hstep, voffB);
            PG8_WAIT_V(6); PG8_BAR; PG8_MMA(1, 1, At, B1); PG8_BAR;
            PG8_LDB(B0, 1, 0); PG8_SCHED; PG8_LDA(At, 1, 0); PG8_STAGE(PG8_SA(0, 1), a2 + hstep, voffA);
            PG8_WAIT_L(8); PG8_BAR; PG8_WAIT_L(0); PG8_MMA(0, 0, At, B0); PG8_BAR; PG8_SCHED;
            PG8_LDB(B1, 1, 1); PG8_STAGE(PG8_SB(1, 0), b3, voffB);
            PG8_BAR; PG8_WAIT_L(0); PG8_MMA(0, 1, At, B1); PG8_BAR;
            PG8_LDA(At, 1, 1); PG8_STAGE(PG8_SA(1, 0), a3, voffA);
            PG8_BAR; PG8_WAIT_L(0); PG8_MMA(1, 0, At, B0); PG8_BAR; PG8_SCHED;
            PG8_STAGE(PG8_SB(1, 1), b3 + hstep, voffB);
            PG8_WAIT_V(6); PG8_BAR; PG8_MMA(1, 1, At, B1); PG8_BAR;
            }
        }
        if constexpr (ALIGN_EPI) { if (wr == 0) PG8_BAR; }
        if constexpr (!Epi::AFTER_DRAIN) { E(acc, cur, wr, wc, fr, fq); S.done(cur); }
        if (!has_next) break;
#pragma unroll
        for (int a = 0; a < 2; ++a)
#pragma unroll
            for (int b = 0; b < 2; ++b)
#pragma unroll
                for (int m = 0; m < 4; ++m)
#pragma unroll
                    for (int n = 0; n < 2; ++n) acc[a][b][m][n] = (f32x4){0.f, 0.f, 0.f, 0.f};
        cur = nxt; cA = nA; cB = nB; ++ui;
        if constexpr (ALIGN_EPI) { if (wr == 1) PG8_BAR; }
    }
    PG8_WAIT_V(0);
    if constexpr (!ALIGN_EPI) { if (wr == 0) PG8_BAR; }
    PG8_BAR;
    if constexpr (Epi::AFTER_DRAIN) { E.fused(acc, cur, wr, wc, fr, fq, lds, wid, lane); S.done(cur); }
#undef PG8_SA
#undef PG8_SB
#undef PG8_STAGE
#undef PG8_LDA
#undef PG8_LDB
#undef PG8_MMA
#undef PG8_WAIT_V
#undef PG8_WAIT_L
#undef PG8_BAR
#undef PG8_SCHED
}
}
#define XB_TMO      128
#define XB_XCNT(j)  (256  + 64 * (j))
#define XB_XSUB(j)  (1280 + 64 * (j))
#define XB_XGEN(j)  (2304 + 64 * (j))
#define XB_TOP      3328
#define XB_TOPGEN   3392
#define XCD_BAR_WORDS 3456
#define XB_SPIN_CAP (1u << 18)

__device__ __forceinline__ unsigned xb_ld(unsigned* p)              { return __hip_atomic_load(p, __ATOMIC_RELAXED, __HIP_MEMORY_SCOPE_AGENT); }
__device__ __forceinline__ unsigned xb_add(unsigned* p, unsigned v) { return __hip_atomic_fetch_add(p, v, __ATOMIC_RELAXED, __HIP_MEMORY_SCOPE_AGENT); }
__device__ __forceinline__ unsigned xb_xcc_id() { return (unsigned)__builtin_amdgcn_s_getreg((3 << 11) | 20) & 0xFu; }
#define XB_SPIN(cond, bar) do { unsigned _sp = 0; while (cond) { __builtin_amdgcn_s_sleep(1); \
    if ((++_sp & 255u) == 0u) { if (xb_ld(&(bar)[XB_TMO])) break; if (_sp > XB_SPIN_CAP) { atomicAdd(&(bar)[XB_TMO], 1u); break; } } } } while (0)

struct XcdBarrier {
    unsigned* bar; unsigned x;
    volatile LAS unsigned* st;
};

__device__ __forceinline__ XcdBarrier xcd_barrier_post(unsigned* bar, volatile LAS unsigned* st) {
    XcdBarrier b; b.bar = bar; b.x = xb_xcc_id(); b.st = st;
    if (threadIdx.x == 0) (void)xb_add(&bar[XB_XCNT(b.x)], 1u);
    return b;
}
__device__ __forceinline__ void xcd_barrier_complete(unsigned* bar, unsigned x, unsigned& nloc, unsigned& nx) {
    const unsigned G = gridDim.x * gridDim.y * gridDim.z;
    unsigned sum, cnt, mine, sp = 0u;
    for (;;) {
        sum = 0u; cnt = 0u; mine = 0u;
#pragma unroll
        for (unsigned j = 0; j < 16; ++j) { const unsigned c = xb_ld(&bar[XB_XCNT(j)]); sum += c; cnt += (c > 0u) ? 1u : 0u; mine = (j == x) ? c : mine; }
        if (sum == G) break;
        __builtin_amdgcn_s_sleep(1);
        if ((++sp & 255u) == 0u) { if (xb_ld(&bar[XB_TMO])) break; if (sp > XB_SPIN_CAP) { atomicAdd(&bar[XB_TMO], 1u); break; } }
    }
    nloc = mine > 0u ? mine : 1u; nx = cnt > 0u ? cnt : 1u;
}

__device__ __forceinline__ void xcd_barrier(const XcdBarrier& b, bool leader) {
    asm volatile("s_waitcnt vmcnt(0)" ::: "memory");
    __syncthreads();
    if (leader) {
        unsigned* bar = b.bar;
        __builtin_amdgcn_s_waitcnt(0);
        unsigned nloc = b.st[0], nx = b.st[1];
        if (nloc == 0u) { xcd_barrier_complete(bar, b.x, nloc, nx); b.st[0] = nloc; b.st[1] = nx; }
        const unsigned old = xb_add(&bar[XB_XSUB(b.x)], 1u);
        const unsigned gen = old / nloc;
        if (old + 1u == (gen + 1u) * nloc) {
            __builtin_amdgcn_fence(__ATOMIC_RELEASE, "agent");
            asm volatile("s_waitcnt vmcnt(0)" ::: "memory");
            const unsigned og = xb_add(&bar[XB_TOP], 1u);
            const unsigned tg = og / nx;
            if (og + 1u == (tg + 1u) * nx) xb_add(&bar[XB_TOPGEN], 1u);
            else XB_SPIN(xb_ld(&bar[XB_TOPGEN]) == tg, bar);
            __builtin_amdgcn_fence(__ATOMIC_ACQUIRE, "agent");
            xb_add(&bar[XB_XGEN(b.x)], 1u);
            asm volatile("s_waitcnt vmcnt(0)" ::: "memory");
        } else {
            XB_SPIN(xb_ld(&bar[XB_XGEN(b.x)]) == gen, bar);
            __builtin_amdgcn_fence(__ATOMIC_ACQUIRE, "agent");
            asm volatile("s_waitcnt vmcnt(0)" ::: "memory");
        }
    }
    __syncthreads();
}

typedef unsigned short bf16;
typedef unsigned v4u __attribute__((ext_vector_type(4)));
typedef unsigned v2u __attribute__((ext_vector_type(2)));
typedef float f32x4 __attribute__((ext_vector_type(4)));
typedef float f32x16 __attribute__((ext_vector_type(16)));
typedef short bf16x8 __attribute__((ext_vector_type(8)));
#define LDS_WAIT() asm volatile("s_waitcnt lgkmcnt(0)" ::: "memory")
#define VM_WAIT() asm volatile("s_waitcnt vmcnt(0)" ::: "memory")

constexpr int NWAVES = 8, NTHREADS = 512;
constexpr int BATCH = 2, SEQ = 8192, M = BATCH * SEQ, D = 2048, DEPTH = 4;
constexpr int IN_COLS = 4160, IN_PAD = 4352;
constexpr int C_DAQ = 0, C_DAK = 768, C_DAV = 1536, C_QA = 2304, C_KVA = 2816, C_KR = 3072, C_SGU = 3136, C_SGV = 3648;
constexpr int DFF = 5632, NUP = 2 * DFF;
constexpr int UQ_N = 1152, UQ_PAD = 1536, UKV_N = 1536, QRANK = 512, KVRANK = 256;
constexpr int NH = 6;
constexpr float EPS = 1e-6f;
constexpr float LOG2E = 1.4426950408889634f;
constexpr float QS_DA = 0.125f * LOG2E;
constexpr float QS_MLA = 0.07216878364870322f * LOG2E;

enum { I_X = 0, I_C, I_POS, I_WADA, I_BADA, I_WIN, I_DAQG, I_DAKG, I_LQ1, I_LK1, I_LQ2, I_LK2, I_DAHG, I_QAG, I_WUQ, I_KVAG, I_WUKV, I_MQG, I_MKG, I_SGVG, I_SGW, I_SGB, I_WOUT, I_WUP, I_CONVW, I_CONVB, I_WDOWN, N_IN };

constexpr size_t MiB = 1u << 20;
constexpr size_t WS_CTL = 0, CTL_ZERO_BYTES = 1 * MiB;
constexpr size_t WS_MOD = 1 * MiB;
constexpr size_t WS_POSMM = 1 * MiB + 512 * 1024;
constexpr size_t WS_MODP = 2 * MiB;
constexpr size_t WS_W = 8 * MiB;
constexpr size_t WL_IN = 0, WL_UQ = 17 * MiB, WL_UKV = WL_UQ + 1572864, WL_OUT = 20 * MiB, WL_UP = 28 * MiB, WL_DOWN = 72 * MiB, WL_STRIDE = 94 * MiB;
constexpr size_t WS_H = 384 * MiB;
constexpr size_t WS_MIX = 448 * MiB;
constexpr size_t WS_U = 512 * MiB;
constexpr size_t WS_R = 688 * MiB;
constexpr size_t WS_KR = WS_R;
constexpr size_t WS_SSQ_QA = WS_R + 4 * MiB, WS_SSQ_KVA = WS_R + 5 * MiB, WS_SSQ_SGV = WS_R + 6 * MiB, WS_SSQ_KR = WS_R + 7 * MiB;
constexpr size_t WS_QD = WS_R + 272 * MiB, WS_KD = WS_R + 296 * MiB, WS_VD = WS_R + 320 * MiB;
constexpr size_t WS_QM = WS_R + 344 * MiB, WS_KM = WS_R + 380 * MiB, WS_VM = WS_R + 416 * MiB;
constexpr size_t WS_QA = WS_R + 440 * MiB, WS_KVA = WS_R + 456 * MiB;
constexpr size_t WS_MLQ = WS_R + 464 * MiB, WS_MLKV = WS_R + 544 * MiB;
constexpr size_t WS_XB = WS_R + 464 * MiB;
constexpr size_t WS_UU = WS_R + 640 * MiB, WS_GV = WS_R + 672 * MiB;
constexpr size_t WS_EDGE = WS_R;
constexpr size_t WS_A = WS_R;
constexpr size_t WS_O1 = WS_R + 704 * MiB;
constexpr size_t WS_COS = WS_R + 752 * MiB, WS_SIN = WS_R + 754 * MiB;
constexpr size_t WS_END = WS_R + 756 * MiB;

constexpr int RING_BYTES = 131072;
constexpr int LDSCTL_OFF = RING_BYTES;
constexpr int LDS_BYTES = 147456;

__device__ const float ROPE_INV[32] = {1.000000000e+00f, 7.498942614e-01f, 5.623413324e-01f, 4.216965139e-01f, 3.162277639e-01f, 2.371373773e-01f, 1.778279394e-01f, 1.333521307e-01f, 1.000000015e-01f, 7.498941571e-02f, 5.623413250e-02f, 4.216965288e-02f, 3.162277490e-02f, 2.371373773e-02f, 1.778279431e-02f, 1.333521493e-02f, 9.999999776e-03f, 7.498941850e-03f, 5.623413250e-03f, 4.216964822e-03f, 3.162277630e-03f, 2.371373586e-03f, 1.778279431e-03f, 1.333521446e-03f, 1.000000047e-03f, 7.498942432e-04f, 5.623413017e-04f, 4.216965172e-04f, 3.162277571e-04f, 2.371373703e-04f, 1.778279402e-04f, 1.333521504e-04f};
__device__ const float ALIBI_SLOPE[6] = {0.3968502629920499f, 0.15749013123685915f, 0.0625f, 0.024803141437003122f, 0.0098431332023036951f, 0.00390625f};
__device__ const float LAM_INIT[4] = {0.20000000000000007f, 0.35550906759096934f, 0.4707130183435842f, 0.5560582041556406f};

struct Args { const void* in[N_IN]; float* out; unsigned char* ws; int ph; int l; };

__device__ __forceinline__ unsigned f2bf(float f) { unsigned u = __builtin_bit_cast(unsigned, f); return (u + 0x7fffu + ((u >> 16) & 1u)) >> 16; }
__device__ __forceinline__ unsigned pk2(float lo, float hi) { return f2bf(lo) | (f2bf(hi) << 16); }
__device__ __forceinline__ float bf2f(unsigned short h) { return __builtin_bit_cast(float, (unsigned)h << 16); }
template <int CTRL> __device__ __forceinline__ float dpp_mov(float v) { return __builtin_bit_cast(float, __builtin_amdgcn_update_dpp(0, __builtin_bit_cast(int, v), CTRL, 0xF, 0xF, true)); }
__device__ __forceinline__ float sum16(float v) { v += dpp_mov<0xB1>(v); v += dpp_mov<0x4E>(v); v += dpp_mov<0x141>(v); v += dpp_mov<0x140>(v); return v; }
__device__ __forceinline__ float sum32(float v) { v = sum16(v); auto r = __builtin_amdgcn_permlane16_swap(__float_as_uint(v), __float_as_uint(v), false, false); return __uint_as_float(r[0]) + __uint_as_float(r[1]); }
__device__ __forceinline__ float wave_sum(float v) { v = sum32(v); auto r = __builtin_amdgcn_permlane32_swap(__float_as_uint(v), __float_as_uint(v), false, false); return __uint_as_float(r[0]) + __uint_as_float(r[1]); }
__device__ __forceinline__ float wave_max(float v) { v = fmaxf(v, dpp_mov<0xB1>(v)); v = fmaxf(v, dpp_mov<0x4E>(v)); v = fmaxf(v, dpp_mov<0x141>(v)); v = fmaxf(v, dpp_mov<0x140>(v));
    { auto r = __builtin_amdgcn_permlane16_swap(__float_as_uint(v), __float_as_uint(v), false, false); v = fmaxf(__uint_as_float(r[0]), __uint_as_float(r[1])); }
    { auto r = __builtin_amdgcn_permlane32_swap(__float_as_uint(v), __float_as_uint(v), false, false); v = fmaxf(__uint_as_float(r[0]), __uint_as_float(r[1])); } return v; }
__device__ __forceinline__ float xor32(float v, int lane) { auto r = __builtin_amdgcn_permlane32_swap(__float_as_uint(v), __float_as_uint(v), false, false); return lane < 32 ? __uint_as_float(r[1]) : __uint_as_float(r[0]); }
__device__ __forceinline__ float gelu_tanh(float x) {
    const float u = 0.7978845608028654f * (x + 0.044715f * x * x * x);
    const float e = __expf(2.0f * u);
    const float th = 1.0f - 2.0f / (e + 1.0f);
    return 0.5f * x * (1.0f + th);
}
__device__ __forceinline__ float silu_f(float x) { return x / (1.0f + __expf(-x)); }
__device__ __forceinline__ int crow(int r, int hi) { return (r & 3) + 8 * (r >> 2) + 4 * hi; }

namespace pg8 {
struct EpiF32 {
    static constexpr bool PERM = false, AFTER_DRAIN = false;
    float* C; int ldc;
    __device__ __forceinline__ void operator()(const f32x4 (&acc)[2][2][4][2], const Unit& u, int wr, int wc, int fr, int fq) const {
        const int row0 = u.pm * BM + wr * 64 + fr, col0 = u.pn * BM + wc * 32 + 4 * fq;
#pragma unroll
        for (int ai = 0; ai < 2; ++ai)
#pragma unroll
            for (int m = 0; m < 4; ++m) { float* rowp = C + (size_t)(row0 + ai * HALF + m * 16) * ldc + col0;
#pragma unroll
                for (int bj = 0; bj < 2; ++bj)
#pragma unroll
                    for (int n = 0; n < 2; ++n) *(f32x4*)(rowp + bj * HALF + n * 16) = acc[ai][bj][m][n]; }
    }
};
struct EpiNull {
    static constexpr bool PERM = true, AFTER_DRAIN = false;
    float* C;
    __device__ __forceinline__ void operator()(const f32x4 (&acc)[2][2][4][2], const Unit& u, int wr, int wc, int fr, int fq) const {
        f32x4 s = {0.f, 0.f, 0.f, 0.f};
#pragma unroll
        for (int ai = 0; ai < 2; ++ai)
#pragma unroll
            for (int bj = 0; bj < 2; ++bj)
#pragma unroll
                for (int m = 0; m < 4; ++m)
#pragma unroll
                    for (int n = 0; n < 2; ++n) s += acc[ai][bj][m][n];
        C[(size_t)(u.pm * 44 + u.pn) * 512 + (wr * 4 + wc) * 64 + fq * 16 + fr] = (s[0] + s[1]) + (s[2] + s[3]);
    }
};
struct EpiResid {
    static constexpr bool PERM = false, AFTER_DRAIN = false;
    const float* xin; float* out; int ldc; const float* gate; int gate_stride;
    __device__ __forceinline__ void operator()(const f32x4 (&acc)[2][2][4][2], const Unit& u, int wr, int wc, int fr, int fq) const {
        const int row0 = u.pm * BM + wr * 64 + fr, col0 = u.pn * BM + wc * 32 + 4 * fq;
        const float* gp = gate + (size_t)((u.pm * BM) / SEQ) * gate_stride + col0;
        f32x4 gv[2][2];
#pragma unroll
        for (int bj = 0; bj < 2; ++bj)
#pragma unroll
            for (int n = 0; n < 2; ++n) gv[bj][n] = *(const f32x4*)(gp + bj * HALF + n * 16);
#pragma unroll
        for (int ai = 0; ai < 2; ++ai) {
            f32x4 xv[4][2][2];
#pragma unroll
            for (int m = 0; m < 4; ++m) { const size_t off = (size_t)(row0 + ai * HALF + m * 16) * ldc + col0;
#pragma unroll
                for (int bj = 0; bj < 2; ++bj)
#pragma unroll
                    for (int n = 0; n < 2; ++n) xv[m][bj][n] = *(const f32x4*)(xin + off + bj * HALF + n * 16); }
#pragma unroll
            for (int m = 0; m < 4; ++m) { const size_t off = (size_t)(row0 + ai * HALF + m * 16) * ldc + col0;
#pragma unroll
                for (int bj = 0; bj < 2; ++bj)
#pragma unroll
                    for (int n = 0; n < 2; ++n) *(f32x4*)(out + off + bj * HALF + n * 16) = xv[m][bj][n] + gv[bj][n] * acc[ai][bj][m][n]; }
        }
    }
};
struct EpiResidP {
    static constexpr bool PERM = true, AFTER_DRAIN = false;
    const void* xin; void* out; int inb, outb; const float* gate; int gate_stride;
    __device__ __forceinline__ void put(unsigned eo, const f32x4 r0, const f32x4 r1) const {
        if (outb) *(u32x4*)((char*)out + eo * 2u) = (u32x4){pkh2(r0[0], r0[1]), pkh2(r0[2], r0[3]), pkh2(r1[0], r1[1]), pkh2(r1[2], r1[3])};
        else { *(f32x4*)((char*)out + eo * 4u) = r0; *(f32x4*)((char*)out + eo * 4u + 16u) = r1; } }
    __device__ __forceinline__ void operator()(const f32x4 (&acc)[2][2][4][2], const Unit& u, int wr, int wc, int fr_, int fq_) const {
        int fr = fr_, fq = fq_; asm volatile("" : "+v"(fr), "+v"(fq));
        const int row0 = u.pm * BM + wr * 64 + fr, col0 = u.pn * BM + wc * 32 + 8 * fq;
        const unsigned lo = (unsigned)(row0 * 2048 + col0);
        const float* gp = gate + (size_t)((u.pm * BM) / SEQ) * gate_stride + col0;
        f32x4 gv[2][2];
#pragma unroll
        for (int bj = 0; bj < 2; ++bj)
#pragma unroll
            for (int n = 0; n < 2; ++n) gv[bj][n] = *(const f32x4*)(gp + bj * HALF + 4 * n);
        if (inb) {
            u32x4 xb[2][4][2];
#pragma unroll
            for (int ai = 0; ai < 2; ++ai)
#pragma unroll
                for (int m = 0; m < 4; ++m)
#pragma unroll
                    for (int bj = 0; bj < 2; ++bj) xb[ai][m][bj] = *(const u32x4*)((const char*)xin + (lo + (unsigned)((ai * HALF + m * 16) * 2048 + bj * HALF)) * 2u);
#pragma unroll
            for (int ai = 0; ai < 2; ++ai)
#pragma unroll
                for (int m = 0; m < 4; ++m)
#pragma unroll
                    for (int bj = 0; bj < 2; ++bj) { const u32x4 w = xb[ai][m][bj];
                        const f32x4 x0 = {uph_lo(w.x), uph_hi(w.x), uph_lo(w.y), uph_hi(w.y)};
                        const f32x4 x1 = {uph_lo(w.z), uph_hi(w.z), uph_lo(w.w), uph_hi(w.w)};
                        put(lo + (unsigned)((ai * HALF + m * 16) * 2048 + bj * HALF), x0 + gv[bj][0] * acc[ai][bj][m][0], x1 + gv[bj][1] * acc[ai][bj][m][1]); }
        } else {
#pragma unroll
            for (int ai = 0; ai < 2; ++ai) {
                f32x4 xv[4][2][2];
#pragma unroll
                for (int m = 0; m < 4; ++m)
#pragma unroll
                    for (int bj = 0; bj < 2; ++bj)
#pragma unroll
                        for (int n = 0; n < 2; ++n) xv[m][bj][n] = *(const f32x4*)((const char*)xin + (lo + (unsigned)((ai * HALF + m * 16) * 2048 + bj * HALF + 4 * n)) * 4u);
#pragma unroll
                for (int m = 0; m < 4; ++m)
#pragma unroll
                    for (int bj = 0; bj < 2; ++bj) put(lo + (unsigned)((ai * HALF + m * 16) * 2048 + bj * HALF), xv[m][bj][0] + gv[bj][0] * acc[ai][bj][m][0], xv[m][bj][1] + gv[bj][1] * acc[ai][bj][m][1]);
            }
        }
    }
};
struct EpiBf16S {
    static constexpr bool PERM = true, AFTER_DRAIN = false;
    bf16_t* O; int ldc;
    __device__ __forceinline__ void operator()(const f32x4 (&acc)[2][2][4][2], const Unit& u, int wr, int wc, int fr, int fq) const {
        const int row0 = u.pm * BM + wr * 64 + fr, col0 = u.pn * BM + wc * 32 + 8 * fq;
#pragma unroll
        for (int ai = 0; ai < 2; ++ai)
#pragma unroll
            for (int m = 0; m < 4; ++m) { bf16_t* rowp = O + (size_t)(row0 + ai * HALF + m * 16) * ldc + col0;
#pragma unroll
                for (int bj = 0; bj < 2; ++bj) { const f32x4 v0 = acc[ai][bj][m][0], v1 = acc[ai][bj][m][1]; u32x4 w;
                    w.x = cvt_pk_bf16(v0[0], v0[1]); w.y = cvt_pk_bf16(v0[2], v0[3]); w.z = cvt_pk_bf16(v1[0], v1[1]); w.w = cvt_pk_bf16(v1[2], v1[3]);
                    *(u32x4*)(rowp + bj * HALF) = w; } }
    }
};
template <int CTRL> __device__ __forceinline__ float dppf(float old, float src) { return __builtin_bit_cast(float, __builtin_amdgcn_update_dpp(__builtin_bit_cast(int, old), __builtin_bit_cast(int, src), CTRL, 0xF, 0xF, false)); }
struct EpiConvGate {
    static constexpr bool PERM = true, AFTER_DRAIN = false;
    bf16_t* U; unsigned short* EDGE; const float* cw; const float* cb;
    __device__ __forceinline__ void operator()(const f32x4 (&acc)[2][2][4][2], const Unit& u, int wr, int wc, int fr, int fq) const {
        const int ch0 = u.pn * 128 + wc * 32 + 8 * fq, rowb = u.pm * BM + wr * 64;
#pragma unroll
        for (int ai = 0; ai < 2; ++ai) { const int blk = (rowb + ai * HALF) >> 6;
            if (fr < 2) { unsigned short* e = EDGE + ((size_t)(blk * 4 + fr) * 2) * DFF + ch0;
#pragma unroll
                for (int bj = 0; bj < 2; ++bj) { const f32x4 a0 = acc[ai][bj][0][0], a1 = acc[ai][bj][0][1]; *(u32x4*)(e + bj * DFF) = (u32x4){pkh2(a0[0], a0[1]), pkh2(a0[2], a0[3]), pkh2(a1[0], a1[1]), pkh2(a1[2], a1[3])}; } }
            if (fr >= 14) { unsigned short* e = EDGE + ((size_t)(blk * 4 + fr - 12) * 2) * DFF + ch0;
#pragma unroll
                for (int bj = 0; bj < 2; ++bj) { const f32x4 a0 = acc[ai][bj][3][0], a1 = acc[ai][bj][3][1]; *(u32x4*)(e + bj * DFF) = (u32x4){pkh2(a0[0], a0[1]), pkh2(a0[2], a0[3]), pkh2(a1[0], a1[1]), pkh2(a1[2], a1[3])}; } }
        }
        f32x4 w[2][2][3], bb[2][2];
#pragma unroll
        for (int n = 0; n < 2; ++n)
#pragma unroll
            for (int bj = 0; bj < 2; ++bj) { bb[n][bj] = *(const f32x4*)(cb + bj * DFF + ch0 + 4 * n);
#pragma unroll
                for (int j = 0; j < 3; ++j) w[n][bj][j] = *(const f32x4*)(cw + (size_t)j * (2 * DFF) + bj * DFF + ch0 + 4 * n); }
#pragma unroll
        for (int ai = 0; ai < 2; ++ai)
#pragma unroll
            for (int m = 0; m < 4; ++m) {
                unsigned pkw[4];
#pragma unroll
                for (int n = 0; n < 2; ++n) {
                    f32x4 y[2];
#pragma unroll
                    for (int bj = 0; bj < 2; ++bj) { const f32x4 cur = acc[ai][bj][m][n]; const f32x4 prv = m > 0 ? acc[ai][bj][m - 1][n] : (f32x4){0.f, 0.f, 0.f, 0.f};
                        f32x4 s1, s2;
#pragma unroll
                        for (int e = 0; e < 4; ++e) {
                            if (m > 0) { s1[e] = dppf<0x111>(dpp_mov<0x121>(prv[e]), cur[e]); s2[e] = dppf<0x112>(dpp_mov<0x122>(prv[e]), cur[e]); }
                            else { s1[e] = dpp_mov<0x111>(cur[e]); s2[e] = dpp_mov<0x112>(cur[e]); } }
                        y[bj] = bb[n][bj] + w[n][bj][2] * cur + w[n][bj][1] * s1 + w[n][bj][0] * s2; }
                    const f32x4 tg = y[0] * -1.4426950408889634f;
                    f32x4 ev; ev[0] = __builtin_amdgcn_exp2f(tg[0]); ev[1] = __builtin_amdgcn_exp2f(tg[1]); ev[2] = __builtin_amdgcn_exp2f(tg[2]); ev[3] = __builtin_amdgcn_exp2f(tg[3]);
                    const f32x4 dn = ev + 1.0f;
                    f32x4 rc; rc[0] = __builtin_amdgcn_rcpf(dn[0]); rc[1] = __builtin_amdgcn_rcpf(dn[1]); rc[2] = __builtin_amdgcn_rcpf(dn[2]); rc[3] = __builtin_amdgcn_rcpf(dn[3]);
                    const f32x4 o = (y[0] * rc) * y[1];
                    pkw[2 * n] = cvt_pk_bf16(o[0], o[1]); pkw[2 * n + 1] = cvt_pk_bf16(o[2], o[3]);
                }
                u32x4 pk; pk.x = pkw[0]; pk.y = pkw[1]; pk.z = pkw[2]; pk.w = pkw[3];
                *(u32x4*)(U + (size_t)(rowb + ai * HALF + m * 16 + fr) * DFF + ch0) = pk;
            }
    }
};
__device__ __forceinline__ float lane_xor16_sum(float v) { auto r = __builtin_amdgcn_permlane16_swap(__float_as_uint(v), __float_as_uint(v), false, false); return __uint_as_float(r[0]) + __uint_as_float(r[1]); }
__device__ __forceinline__ float lane_xor32_sum(float v) { auto r = __builtin_amdgcn_permlane32_swap(__float_as_uint(v), __float_as_uint(v), false, false); return __uint_as_float(r[0]) + __uint_as_float(r[1]); }
__device__ __forceinline__ float sq4(f32x4 v) { return (v[0] * v[0] + v[1] * v[1]) + (v[2] * v[2] + v[3] * v[3]); }
__device__ __forceinline__ u32x4 pk8(f32x4 a, f32x4 b) { u32x4 w; w.x = cvt_pk_bf16(a[0], a[1]); w.y = cvt_pk_bf16(a[2], a[3]); w.z = cvt_pk_bf16(b[0], b[1]); w.w = cvt_pk_bf16(b[2], b[3]); return w; }
__device__ __forceinline__ float gelu_t(float x) { const float u = 0.7978845608028654f * (x + 0.044715f * x * x * x); const float e = __expf(2.0f * u); return 0.5f * x * (2.0f - 2.0f * __builtin_amdgcn_rcpf(e + 1.0f)); }
__device__ __forceinline__ f32x4 gelu4(f32x4 v) { return (f32x4){gelu_t(v[0]), gelu_t(v[1]), gelu_t(v[2]), gelu_t(v[3])}; }
struct EpiInProj {
    static constexpr bool PERM = true, AFTER_DRAIN = false;
    bf16_t *QD, *KD, *VD, *QA, *KVA, *GV; unsigned short* UU; float *KR, *SSQ_QA, *SSQ_KVA, *SSQ_SGV, *SSQ_KR;
    const float *qg, *kg, *qag, *kvag, *sgvg;
    __device__ __forceinline__ void operator()(const f32x4 (&acc)[2][2][4][2], const Unit& u, int wr, int wc, int fr, int fq) const {
        const int pn = u.pn, rowb = u.pm * BM + wr * 64 + fr, b = (u.pm * BM) / SEQ, c8 = wc * 32 + 8 * fq;
        if (pn < 6) {
            const bool isk = pn >= 3; const int G = 4 * (isk ? pn - 3 : pn) + wc;
            const float* gp = isk ? kg : qg;
            const f32x4 g00 = *(const f32x4*)(gp + 8 * fq), g01 = *(const f32x4*)(gp + 8 * fq + 4), g10 = *(const f32x4*)(gp + 32 + 8 * fq), g11 = *(const f32x4*)(gp + 32 + 8 * fq + 4);
            bf16_t* dst = (isk ? KD : QD) + ((size_t)(b * 12 + G) * SEQ) * 64 + 8 * fq;
            const float post = isk ? 1.0f : QS_DA;
#pragma unroll
            for (int ai = 0; ai < 2; ++ai)
#pragma unroll
                for (int m = 0; m < 4; ++m) { const f32x4 v00 = acc[ai][0][m][0], v01 = acc[ai][0][m][1], v10 = acc[ai][1][m][0], v11 = acc[ai][1][m][1];
                    float ss = (sq4(v00) + sq4(v01)) + (sq4(v10) + sq4(v11)); ss = lane_xor16_sum(ss); ss = lane_xor32_sum(ss);
                    const float r = rsqrtf(ss * (1.f / 64) + EPS) * post;
                    bf16_t* d = dst + (size_t)((rowb + ai * HALF + m * 16) & (SEQ - 1)) * 64;
                    *(u32x4*)d = pk8(v00 * g00 * r, v01 * g01 * r); *(u32x4*)(d + 32) = pk8(v10 * g10 * r, v11 * g11 * r); }
        } else if (pn < 9) {
#pragma unroll
            for (int bj = 0; bj < 2; ++bj) { bf16_t* dst = VD + ((size_t)(b * NH + 2 * (pn - 6) + bj) * SEQ) * 128 + c8;
#pragma unroll
                for (int ai = 0; ai < 2; ++ai)
#pragma unroll
                    for (int m = 0; m < 4; ++m) *(u32x4*)(dst + (size_t)((rowb + ai * HALF + m * 16) & (SEQ - 1)) * 128) = pk8(acc[ai][bj][m][0], acc[ai][bj][m][1]); }
        } else if (pn < 12) {
            const bool iskv = pn == 11; const int ct = iskv ? 0 : 256 * (pn - 9);
            const float* gp = (iskv ? kvag : qag) + ct + c8;
            const f32x4 g00 = *(const f32x4*)gp, g01 = *(const f32x4*)(gp + 4), g10 = *(const f32x4*)(gp + HALF), g11 = *(const f32x4*)(gp + HALF + 4);
            bf16_t* dst = (iskv ? KVA : QA) + ct + c8; const int ld = iskv ? KVRANK : QRANK;
            float* sq = iskv ? SSQ_KVA + wc : SSQ_QA + (pn - 9) * 4 + wc; const int sld = iskv ? 4 : 8;
#pragma unroll
            for (int ai = 0; ai < 2; ++ai)
#pragma unroll
                for (int m = 0; m < 4; ++m) { const int row = rowb + ai * HALF + m * 16;
                    const f32x4 v00 = acc[ai][0][m][0], v01 = acc[ai][0][m][1], v10 = acc[ai][1][m][0], v11 = acc[ai][1][m][1];
                    float ss = (sq4(v00) + sq4(v01)) + (sq4(v10) + sq4(v11)); ss = lane_xor16_sum(ss); ss = lane_xor32_sum(ss);
                    if (fq == 0) sq[(size_t)row * sld] = ss;
                    *(u32x4*)(dst + (size_t)row * ld) = pk8(v00 * g00, v01 * g01); *(u32x4*)(dst + (size_t)row * ld + HALF) = pk8(v10 * g10, v11 * g11); }
        } else if (pn < 14) {
            unsigned short* dst = UU + 256 * (pn - 12) + c8;
#pragma unroll
            for (int ai = 0; ai < 2; ++ai)
#pragma unroll
                for (int m = 0; m < 4; ++m) { unsigned short* d = dst + (size_t)(rowb + ai * HALF + m * 16) * 512;
#pragma unroll
                    for (int bj = 0; bj < 2; ++bj) { const f32x4 a = gelu4(acc[ai][bj][m][0]), c = gelu4(acc[ai][bj][m][1]);
                        *(u32x4*)(d + bj * HALF) = (u32x4){pkh2(a[0], a[1]), pkh2(a[2], a[3]), pkh2(c[0], c[1]), pkh2(c[2], c[3])}; } }
        } else if (pn < 16) {
            const int g0 = 2 * (pn - 14);
#pragma unroll
            for (int bj = 0; bj < 2; ++bj) { const float* gp = sgvg + (g0 + bj) * 128 + c8; const f32x4 ga = *(const f32x4*)gp, gb = *(const f32x4*)(gp + 4);
                bf16_t* dst = GV + (g0 + bj) * 128 + c8; float* sq = SSQ_SGV + (g0 + bj) * 4 + wc;
#pragma unroll
                for (int ai = 0; ai < 2; ++ai)
#pragma unroll
                    for (int m = 0; m < 4; ++m) { const int row = rowb + ai * HALF + m * 16; const f32x4 a = gelu4(acc[ai][bj][m][0]), c = gelu4(acc[ai][bj][m][1]);
                        float ss = sq4(a) + sq4(c); ss = lane_xor16_sum(ss); ss = lane_xor32_sum(ss);
                        if (fq == 0) sq[(size_t)row * 16] = ss;
                        *(u32x4*)(dst + (size_t)row * 512) = pk8(a * ga, c * gb); } }
        } else {
            if (wc < 2) {
#pragma unroll
                for (int ai = 0; ai < 2; ++ai)
#pragma unroll
                    for (int m = 0; m < 4; ++m) { const int row = rowb + ai * HALF + m * 16; float* d = KR + (size_t)row * 64 + c8; *(f32x4*)d = acc[ai][0][m][0]; *(f32x4*)(d + 4) = acc[ai][0][m][1];
                        float ss = sq4(acc[ai][0][m][0]) + sq4(acc[ai][0][m][1]); ss = lane_xor16_sum(ss); ss = lane_xor32_sum(ss); if (fq == 0) SSQ_KR[(size_t)row * 2 + wc] = ss; } }
        }
    }
};
struct EpiMlaQ {
    static constexpr bool PERM = true, AFTER_DRAIN = false;
    bf16_t* QM; const float *SSQ_QA, *COS, *SIN, *qg; PG8_LAS float* X;
    __device__ __forceinline__ void operator()(const f32x4 (&acc)[2][2][4][2], const Unit& u, int wr, int wc, int fr_, int fq_) const {
        float eps_ = EPS, k192 = 1.f / 192; asm volatile("" : "+s"(eps_), "+s"(k192));
        int fr = fr_, fq = fq_; asm volatile("" : "+v"(fr), "+v"(fq));
        const int h = u.pn, rowb = u.pm * BM + wr * 64 + fr, b = (u.pm * BM) / SEQ, c8 = wc * 32 + 8 * fq, rt = wr * 64 + fr;
#pragma unroll
        for (int ai = 0; ai < 2; ++ai)
#pragma unroll
            for (int m = 0; m < 4; ++m) { float ss = (sq4(acc[ai][0][m][0]) + sq4(acc[ai][0][m][1])) + (sq4(acc[ai][1][m][0]) + sq4(acc[ai][1][m][1])); ss = lane_xor16_sum(ss); ss = lane_xor32_sum(ss);
                if (fq == 0) X[(ai * HALF + m * 16 + rt) * 4 + wc] = ss; }
        asm volatile("s_waitcnt lgkmcnt(0)" ::: "memory"); __builtin_amdgcn_s_barrier(); asm volatile("" ::: "memory");
        const f32x4 g0a = *(const f32x4*)(qg + c8), g0b = *(const f32x4*)(qg + c8 + 4);
        const int i0 = 16 * wc + 4 * fq;
        f32x4 g1 = {0.f, 0.f, 0.f, 0.f}, g2 = g1; if (wc < 2) { g1 = *(const f32x4*)(qg + 128 + i0); g2 = *(const f32x4*)(qg + 160 + i0); }
        bf16_t* dst = QM + ((size_t)(b * NH + h) * SEQ) * 192;
#pragma unroll
        for (int ai = 0; ai < 2; ++ai)
#pragma unroll
        for (int mh = 0; mh < 4; mh += 2) {
        float rr[2][4]; f32x4 csv[2][4], snv[2][4];
#pragma unroll
            for (int m = mh; m < mh + 2; ++m) { const int row = rowb + ai * HALF + m * 16; const f32x4 xs = *(const PG8_LAS f32x4*)(X + (ai * HALF + m * 16 + rt) * 4);
                const f32x4 pa = *(const f32x4*)(SSQ_QA + (size_t)row * 8), pb = *(const f32x4*)(SSQ_QA + (size_t)row * 8 + 4);
                const float msq = (((pa[0] + pa[1]) + (pa[2] + pa[3])) + ((pb[0] + pb[1]) + (pb[2] + pb[3]))) * (1.f / 512) + eps_;
                rr[ai][m] = rsqrtf(((xs[0] + xs[1]) + (xs[2] + xs[3])) * k192 + eps_ * msq) * QS_MLA;
                if (wc < 2) { csv[ai][m] = *(const f32x4*)(COS + (size_t)row * 32 + i0); snv[ai][m] = *(const f32x4*)(SIN + (size_t)row * 32 + i0); } }
#pragma unroll
            for (int m = mh; m < mh + 2; ++m) { const int row = rowb + ai * HALF + m * 16; const float r = rr[ai][m];
                bf16_t* d = dst + (size_t)(row & (SEQ - 1)) * 192;
                *(u32x4*)(d + c8) = pk8(acc[ai][0][m][0] * g0a * r, acc[ai][0][m][1] * g0b * r);
                if (wc < 2) { const f32x4 cs = csv[ai][m], sn = snv[ai][m];
                    const f32x4 va = acc[ai][1][m][0], vb = acc[ai][1][m][1];
                    const f32x4 y1 = (f32x4){va[0], va[2], vb[0], vb[2]} * g1 * r, y2 = (f32x4){va[1], va[3], vb[1], vb[3]} * g2 * r;
                    const f32x4 o1 = y1 * cs - y2 * sn, o2 = y2 * cs + y1 * sn;
                    *(u32x4*)(d + 128 + c8) = pk8((f32x4){o1[0], o2[0], o1[1], o2[1]}, (f32x4){o1[2], o2[2], o1[3], o2[3]}); } }
        }
        asm volatile("s_waitcnt lgkmcnt(0)" ::: "memory"); __builtin_amdgcn_s_barrier(); asm volatile("" ::: "memory");
    }
};
struct EpiMlaKV {
    static constexpr bool PERM = true, AFTER_DRAIN = false;
    bf16_t *KM, *VM; const float *SSQ_KVA, *SSQ_KR, *KR, *COS, *SIN, *kg; PG8_LAS float* X;
    __device__ __forceinline__ void operator()(const f32x4 (&acc)[2][2][4][2], const Unit& u, int wr, int wc, int fr_, int fq_) const {
        float eps_ = EPS, k192 = 1.f / 192; asm volatile("" : "+s"(eps_), "+s"(k192));
        int fr = fr_, fq = fq_; asm volatile("" : "+v"(fr), "+v"(fq));
        const int h = u.pn, rowb = u.pm * BM + wr * 64 + fr, b = (u.pm * BM) / SEQ, c8 = wc * 32 + 8 * fq, rt = wr * 64 + fr;
#pragma unroll
        for (int ai = 0; ai < 2; ++ai)
#pragma unroll
            for (int m = 0; m < 4; ++m) { float ss = sq4(acc[ai][0][m][0]) + sq4(acc[ai][0][m][1]); ss = lane_xor16_sum(ss); ss = lane_xor32_sum(ss);
                if (fq == 0) X[(ai * HALF + m * 16 + rt) * 4 + wc] = ss; }
        asm volatile("s_waitcnt lgkmcnt(0)" ::: "memory"); __builtin_amdgcn_s_barrier(); asm volatile("" ::: "memory");
        const f32x4 g0a = *(const f32x4*)(kg + c8), g0b = *(const f32x4*)(kg + c8 + 4);
        const int i0 = 8 * wc + 2 * fq;
        const float g1a = kg[128 + i0], g1b = kg[128 + i0 + 1], g2a = kg[160 + i0], g2b = kg[160 + i0 + 1];
        bf16_t* kd = KM + ((size_t)(b * NH + h) * SEQ) * 192; bf16_t* vd = VM + ((size_t)(b * NH + h) * SEQ) * 128;
#pragma unroll
        for (int ai = 0; ai < 2; ++ai) {
        float rr[2][4], cv[2][4]; float2 k1v[2][4], k2v[2][4], cpv[2][4], spv[2][4];
#pragma unroll
            for (int m = 0; m < 4; ++m) { const int row = rowb + ai * HALF + m * 16; const f32x4 xs = *(const PG8_LAS f32x4*)(X + (ai * HALF + m * 16 + rt) * 4);
                const f32x4 pc = *(const f32x4*)(SSQ_KVA + (size_t)row * 4);
                const float c2 = 1.0f / (((pc[0] + pc[1]) + (pc[2] + pc[3])) * (1.f / 256) + eps_);
                const float2 sk = *(const float2*)(SSQ_KR + (size_t)row * 2);
                cv[ai][m] = sqrtf(c2); rr[ai][m] = rsqrtf((c2 * ((xs[0] + xs[1]) + (xs[2] + xs[3])) + (sk.x + sk.y)) * k192 + eps_);
                const float* kr = KR + (size_t)row * 64 + i0;
                k1v[ai][m] = *(const float2*)kr; k2v[ai][m] = *(const float2*)(kr + 32); cpv[ai][m] = *(const float2*)(COS + (size_t)row * 32 + i0); spv[ai][m] = *(const float2*)(SIN + (size_t)row * 32 + i0); }
#pragma unroll
            for (int m = 0; m < 4; ++m) { const int row = rowb + ai * HALF + m * 16; const float r = rr[ai][m], ckv = cv[ai][m];
                const int srow = row & (SEQ - 1);
                *(u32x4*)(kd + (size_t)srow * 192 + c8) = pk8(acc[ai][0][m][0] * g0a * (ckv * r), acc[ai][0][m][1] * g0b * (ckv * r));
                *(u32x4*)(vd + (size_t)srow * 128 + c8) = pk8(acc[ai][1][m][0] * ckv, acc[ai][1][m][1] * ckv);
                const float2 cp = cpv[ai][m], sp = spv[ai][m];
                const float y1a = k1v[ai][m].x * r * g1a, y1b = k1v[ai][m].y * r * g1b, y2a = k2v[ai][m].x * r * g2a, y2b = k2v[ai][m].y * r * g2b;
                const float oa1 = y1a * cp.x - y2a * sp.x, oa2 = y2a * cp.x + y1a * sp.x, ob1 = y1b * cp.y - y2b * sp.y, ob2 = y2b * cp.y + y1b * sp.y;
                *(unsigned long long*)(kd + (size_t)srow * 192 + 128 + 2 * i0) = (unsigned long long)cvt_pk_bf16(oa1, oa2) | ((unsigned long long)cvt_pk_bf16(ob1, ob2) << 32); }
        }
        asm volatile("s_waitcnt lgkmcnt(0)" ::: "memory"); __builtin_amdgcn_s_barrier(); asm volatile("" ::: "memory");
    }
};
}

struct Frame {
    LAS unsigned char* lds;
    int tid, lane, wave, wave0, gw, ngw, bid, G;
    const __attribute__((address_space(4))) Args* ka; const int* pos;
    float* out; unsigned char* ws;
};
__device__ __forceinline__ size_t opq(size_t v) { asm volatile("" : "+s"(v)); return v; }
#define WSP(T, off) ((T*)(F.ws + opq(off)))
#define FIN(i) ((const float*)F.ka->in[i])
__device__ __forceinline__ const bf16* wptr(const Frame& F, int l, size_t off) { return (const bf16*)(F.ws + WS_W + (size_t)l * WL_STRIDE + off); }

__device__ __forceinline__ void p0_transpose_item(const float* W, int K, int N, bf16* WT, int row_off, LAS float* scr, int item, int lane, int rstride = 1) {
    const int nblk = N / 32, kb = item / nblk, nb = item % nblk, k0 = 64 * kb, n0 = 32 * nb;
    float wv_[32];
#pragma unroll
    for (int i = 0; i < 32; ++i) { const int kk = 2 * i + (lane >> 5); wv_[i] = W[(size_t)(k0 + kk) * N + n0 + (lane & 31)]; }
#pragma unroll
    for (int i = 0; i < 32; ++i) { const int kk = 2 * i + (lane >> 5); scr[kk * 33 + (lane & 31)] = wv_[i]; }
    LDS_WAIT(); asm volatile("" ::: "memory");
    const int c = lane & 7;
#pragma unroll
    for (int j = 0; j < 4; ++j) { const int n = (lane >> 3) + 8 * j; const LAS float* s = scr + (8 * c) * 33 + n;
        v4u o; o.x = pk2(s[0 * 33], s[1 * 33]); o.y = pk2(s[2 * 33], s[3 * 33]); o.z = pk2(s[4 * 33], s[5 * 33]); o.w = pk2(s[6 * 33], s[7 * 33]);
        *(v4u*)(WT + (size_t)(row_off + n0 + rstride * n) * K + k0 + 8 * c) = o; }
    LDS_WAIT(); asm volatile("" ::: "memory");
}
__device__ __forceinline__ void ph_prologue(Frame& F) {
    LAS float* scr = (LAS float*)(F.lds + F.wave * 16384);
    constexpr int I_IN = (D / 64) * (IN_COLS / 32), I_UQ = (QRANK / 64) * (UQ_N / 32), I_UKV = (KVRANK / 64) * (UKV_N / 32), I_OUT = (D / 64) * (D / 32), I_UP = (D / 64) * (NUP / 32), I_DN = (DFF / 64) * (D / 32);
    constexpr int I_L = I_IN + I_UQ + I_UKV + I_OUT + I_UP + I_DN;
    for (int it = F.gw; it < DEPTH * I_L; it += F.ngw) {
        const int l = it / I_L; int r = it % I_L;
        bf16* wl = (bf16*)(F.ws + WS_W + (size_t)l * WL_STRIDE);
        if (r < I_IN) { const int n0 = 32 * (r % (IN_COLS / 32)); int dst;
            if (n0 < C_DAV) { const int q = n0 % 768, G = q / 64, e = q % 64; dst = (n0 - q) + 256 * (G / 4) + 128 * (e / 32) + 32 * (G % 4) + (e % 32); }
            else if (n0 < C_KR) dst = n0;
            else if (n0 < C_SGU) dst = 4096 + (n0 - C_KR);
            else dst = n0 - 64;
            p0_transpose_item(FIN(I_WIN) + (size_t)l * D * IN_COLS, D, IN_COLS, (bf16*)((unsigned char*)wl + WL_IN), dst - n0, scr, r, F.lane); continue; } r -= I_IN;
        if (r < I_UQ) { const int n0 = 32 * (r % (UQ_N / 32)), hh = n0 / 192, e = n0 % 192;
            const int dst = 256 * hh + (e < 128 ? e : 128 + (e - 128) / 32);
            p0_transpose_item(FIN(I_WUQ) + (size_t)l * QRANK * UQ_N, QRANK, UQ_N, (bf16*)((unsigned char*)wl + WL_UQ), dst - n0, scr, r, F.lane, e < 128 ? 1 : 2); continue; } r -= I_UQ;
        if (r < I_UKV) { p0_transpose_item(FIN(I_WUKV) + (size_t)l * KVRANK * UKV_N, KVRANK, UKV_N, (bf16*)((unsigned char*)wl + WL_UKV), 0, scr, r, F.lane); continue; } r -= I_UKV;
        if (r < I_OUT) { p0_transpose_item(FIN(I_WOUT) + (size_t)l * D * D, D, D, (bf16*)((unsigned char*)wl + WL_OUT), 0, scr, r, F.lane); continue; } r -= I_OUT;
        if (r < I_UP) { const int n0 = 32 * (r % (NUP / 32)), chn = n0 % DFF, dst = 256 * (chn / 128) + 128 * (n0 / DFF) + (chn % 128);
            p0_transpose_item(FIN(I_WUP) + (size_t)l * D * NUP, D, NUP, (bf16*)((unsigned char*)wl + WL_UP), dst - n0, scr, r, F.lane); continue; } r -= I_UP;
        p0_transpose_item(FIN(I_WDOWN) + (size_t)l * DFF * D, DFF, D, (bf16*)((unsigned char*)wl + WL_DOWN), 0, scr, r, F.lane);
    }
    {
        const int gt = F.bid * NTHREADS + F.tid, nt = F.G * NTHREADS;
        constexpr int Z_IN = (IN_PAD - IN_COLS) * D / 8, Z_UQ = NH * 64 * QRANK / 8;
        for (int i = gt; i < DEPTH * (Z_IN + Z_UQ); i += nt) { const int l = i / (Z_IN + Z_UQ); int r = i % (Z_IN + Z_UQ);
            unsigned char* wl = F.ws + WS_W + (size_t)l * WL_STRIDE;
            v4u z = {0u, 0u, 0u, 0u};
            if (r < Z_IN) *(v4u*)(wl + WL_IN + (size_t)IN_COLS * D * 2 + (size_t)r * 16) = z;
            else { r -= Z_IN; const int hh = r / (64 * QRANK / 8), q = r % (64 * QRANK / 8); *(v4u*)(wl + WL_UQ + ((size_t)(256 * hh + 192) * QRANK) * 2 + (size_t)q * 16) = z; } }
    }
    __syncthreads();
    LAS float* cond = (LAS float*)F.lds;
    for (int i = F.tid; i < 2 * D; i += NTHREADS) cond[i] = silu_f(FIN(I_C)[i]);
    __syncthreads();
    {
        const int gt = F.bid * NTHREADS + F.tid, nt = F.G * NTHREADS;
        float* part = WSP(float, WS_MODP);
        for (int it = gt; it < DEPTH * 16 * 3072; it += nt) {
            const int n4 = it % 3072, ks = (it / 3072) % 16, l = it / (3072 * 16);
            const float* w = FIN(I_WADA) + ((size_t)l * D + ks * 128) * (6 * D) + n4 * 4;
            f32x4 a0 = {0.f, 0.f, 0.f, 0.f}, a1 = {0.f, 0.f, 0.f, 0.f};
#pragma unroll 8
            for (int k = 0; k < 128; ++k) { const f32x4 wv = *(const f32x4*)(w + (size_t)k * (6 * D)); a0 += cond[ks * 128 + k] * wv; a1 += cond[D + ks * 128 + k] * wv; }
            *(f32x4*)(part + ((size_t)(l * 16 + ks) * 2 + 0) * (6 * D) + n4 * 4) = a0;
            *(f32x4*)(part + ((size_t)(l * 16 + ks) * 2 + 1) * (6 * D) + n4 * 4) = a1;
        }
    }
    __syncthreads();
}
__device__ __forceinline__ void ph_modreduce(Frame& F) {
    const int gt = F.bid * NTHREADS + F.tid, nt = F.G * NTHREADS;
    const float* part = WSP(float, WS_MODP); float* mod = WSP(float, WS_MOD);
    for (int i = gt; i < DEPTH * 2 * 6 * D; i += nt) { const int n = i % (6 * D), b = (i / (6 * D)) & 1, l = i / (12 * D);
        float s = FIN(I_BADA)[l * 6 * D + n];
#pragma unroll
        for (int ks = 0; ks < 16; ++ks) s += part[((size_t)(l * 16 + ks) * 2 + b) * (6 * D) + n];
        mod[i] = s; }
    { float* ct = WSP(float, WS_COS); float* st = WSP(float, WS_SIN);
      for (int i = gt; i < M * 32; i += nt) { const float ang = (float)F.pos[i >> 5] * ROPE_INV[i & 31];
          const double rev = (double)ang * 0.15915494309189535; const float fr = (float)(rev - floor(rev));
          ct[i] = __builtin_amdgcn_cosf(fr); st[i] = __builtin_amdgcn_sinf(fr); } }
    if (gt < M / 64) { int mn = 0x7fffffff, mx = -0x7fffffff - 1;
        for (int i = 0; i < 64; ++i) { const int p = F.pos[gt * 64 + i]; mn = p < mn ? p : mn; mx = p > mx ? p : mx; }
        int* mm = WSP(int, WS_POSMM); mm[gt * 2] = mn; mm[gt * 2 + 1] = mx; }
}
template <bool XBF> __device__ __forceinline__ void ph_norm(Frame& F, int l, const void* xsrc, int sh_off, int sc_off) {
    const float* mod = WSP(float, WS_MOD) + (size_t)l * 12 * D; bf16* H = WSP(bf16, WS_H);
    for (int row = F.gw; row < M; row += F.ngw) {
        const int b = row >> 13;
        const float* mb = mod + (size_t)b * 6 * D;
        if constexpr (XBF) {
            const v4u* xr = (const v4u*)((const bf16*)xsrc + (size_t)row * D) + F.lane;
            v4u w[4]; float v[4][8]; float s = 0.f;
#pragma unroll
            for (int j = 0; j < 4; ++j) w[j] = xr[64 * j];
#pragma unroll
            for (int j = 0; j < 4; ++j) { const unsigned ww[4] = {w[j].x, w[j].y, w[j].z, w[j].w};
#pragma unroll
                for (int q = 0; q < 4; ++q) { v[j][2 * q] = pg8::uph_lo(ww[q]); v[j][2 * q + 1] = pg8::uph_hi(ww[q]); s += v[j][2 * q] * v[j][2 * q] + v[j][2 * q + 1] * v[j][2 * q + 1]; } }
            const float r = rsqrtf(wave_sum(s) * (1.f / D) + EPS);
            v4u* o16 = (v4u*)(H + (size_t)row * D) + F.lane;
#pragma unroll
            for (int j = 0; j < 4; ++j) { const int c = 8 * F.lane + 512 * j;
                const f32x4 sc0 = *(const f32x4*)(mb + sc_off + c), sc1 = *(const f32x4*)(mb + sc_off + c + 4), sh0 = *(const f32x4*)(mb + sh_off + c), sh1 = *(const f32x4*)(mb + sh_off + c + 4);
                v4u o; o.x = pk2(v[j][0] * r * (1.0f + sc0.x) + sh0.x, v[j][1] * r * (1.0f + sc0.y) + sh0.y); o.y = pk2(v[j][2] * r * (1.0f + sc0.z) + sh0.z, v[j][3] * r * (1.0f + sc0.w) + sh0.w);
                o.z = pk2(v[j][4] * r * (1.0f + sc1.x) + sh1.x, v[j][5] * r * (1.0f + sc1.y) + sh1.y); o.w = pk2(v[j][6] * r * (1.0f + sc1.z) + sh1.z, v[j][7] * r * (1.0f + sc1.w) + sh1.w);
                o16[64 * j] = o; }
        } else {
        const f32x4* xr = (const f32x4*)((const float*)xsrc + (size_t)row * D) + F.lane;
        f32x4 v[8]; float s = 0.f;
#pragma unroll
        for (int j = 0; j < 8; ++j) { v[j] = xr[64 * j]; s += (v[j].x * v[j].x + v[j].y * v[j].y) + (v[j].z * v[j].z + v[j].w * v[j].w); }
        const float r = rsqrtf(wave_sum(s) * (1.f / D) + EPS);
        unsigned long long* o8 = (unsigned long long*)(H + (size_t)row * D) + F.lane;
#pragma unroll
        for (int j = 0; j < 8; ++j) { const int c = 4 * F.lane + 256 * j;
            const f32x4 sc = *(const f32x4*)(mb + sc_off + c), sh = *(const f32x4*)(mb + sh_off + c);
            const f32x4 y = v[j] * r * (1.0f + sc) + sh;
            o8[64 * j] = (unsigned long long)pk2(y.x, y.y) | ((unsigned long long)pk2(y.z, y.w) << 32); }
        }
    }
}

namespace fa {
#ifndef PIPE_MLA
#define PIPE_MLA 1
#endif
#ifndef PIPE_LIN
#define PIPE_LIN 0
#endif
#ifndef PIPE_GEN
#define PIPE_GEN 0
#endif
#ifndef PIPE_OLD64
#define PIPE_OLD64 0
#endif
template <typename T> __device__ __forceinline__ T ldg(const void* base, unsigned off) { return *(const T*)((const char*)base + off); }
template <typename T> __device__ __forceinline__ void stg(void* base, unsigned off, T v) { *(T*)((char*)base + off) = v; }
constexpr int crowc(int r) { return (r & 3) + 8 * (r >> 2); }
using s16x4 = __attribute__((ext_vector_type(4))) short;
using f32x8 = __attribute__((ext_vector_type(8))) float;
constexpr int QBLK = 32, KVBLK = 64, DV = 128;
constexpr int SHM_V = KVBLK * DV * 2;
constexpr float THR = 11.5f;
#define FA_SBAR() __builtin_amdgcn_sched_barrier(0)
__device__ __forceinline__ unsigned cvtpk(float lo, float hi) { unsigned r; asm volatile("v_cvt_pk_bf16_f32 %0, %1, %2" : "=v"(r) : "v"(lo), "v"(hi)); return r; }
__device__ __forceinline__ int kswz(int row, int colB) { return (colB >> 7) * 8192 + row * 128 + ((colB & 127) ^ (((row >> 1) & 7) << 4)); }
__device__ __forceinline__ int v_st(int k, int c) { const int kk = (k & ~0xC) | ((k & 4) << 1) | ((k & 8) >> 1); return ((kk >> 3) * 4 + (c >> 5)) * 512 + ((kk & 7) * 32 + (c & 31)) * 2; }
__device__ __forceinline__ int v_st_nat(int k, int c) { return ((k >> 3) * 4 + (c >> 5)) * 512 + ((k & 7) * 32 + (c & 31)) * 2; }
__device__ __forceinline__ int v_rd_base(int lane) { return ((lane & 3) << 3) | (((lane >> 2) & 3) << 6) | (((lane >> 4) & 1) << 5) | (((lane >> 5) & 1) << 8); }
constexpr int v_rd_off(int d0, int ks, int half) { return d0 * 512 + ks * 4096 + half * 2048; }
template <int OFF> __device__ __forceinline__ s16x4 tr_read(int vb) { s16x4 r; asm volatile("ds_read_b64_tr_b16 %0, %1 offset:%2" : "=&v"(r) : "v"(vb), "i"(OFF) : "memory"); return r; }
template <int D0> __device__ __forceinline__ void pv_one(f32x16& od, int vb, bf16x8 pa0, bf16x8 pa1, bf16x8 pa2, bf16x8 pa3) {
    const s16x4 l0 = tr_read<v_rd_off(D0, 0, 0)>(vb), h0 = tr_read<v_rd_off(D0, 0, 1)>(vb), l1 = tr_read<v_rd_off(D0, 1, 0)>(vb), h1 = tr_read<v_rd_off(D0, 1, 1)>(vb);
    const s16x4 l2 = tr_read<v_rd_off(D0, 2, 0)>(vb), h2 = tr_read<v_rd_off(D0, 2, 1)>(vb), l3 = tr_read<v_rd_off(D0, 3, 0)>(vb), h3 = tr_read<v_rd_off(D0, 3, 1)>(vb);
    asm volatile("s_waitcnt lgkmcnt(0)" ::: "memory"); FA_SBAR();
#define FA_PK(L, H) (bf16x8){L[0], L[1], L[2], L[3], H[0], H[1], H[2], H[3]}
    od = __builtin_amdgcn_mfma_f32_32x32x16_bf16(pa0, FA_PK(l0, h0), od, 0, 0, 0);
    od = __builtin_amdgcn_mfma_f32_32x32x16_bf16(pa1, FA_PK(l1, h1), od, 0, 0, 0);
    od = __builtin_amdgcn_mfma_f32_32x32x16_bf16(pa2, FA_PK(l2, h2), od, 0, 0, 0);
    od = __builtin_amdgcn_mfma_f32_32x32x16_bf16(pa3, FA_PK(l3, h3), od, 0, 0, 0);
#undef FA_PK
}
__device__ __forceinline__ void pv_d0(f32x16* o, int vb, bf16x8 pa0, bf16x8 pa1, bf16x8 pa2, bf16x8 pa3) {
    pv_one<0>(o[0], vb, pa0, pa1, pa2, pa3); pv_one<1>(o[1], vb, pa0, pa1, pa2, pa3); pv_one<2>(o[2], vb, pa0, pa1, pa2, pa3); pv_one<3>(o[3], vb, pa0, pa1, pa2, pa3);
}
template <int D0> __device__ __forceinline__ void pv_reads(s16x4 (&l)[4], s16x4 (&h)[4], int vb) {
    l[0] = tr_read<v_rd_off(D0, 0, 0)>(vb); h[0] = tr_read<v_rd_off(D0, 0, 1)>(vb); l[1] = tr_read<v_rd_off(D0, 1, 0)>(vb); h[1] = tr_read<v_rd_off(D0, 1, 1)>(vb);
    l[2] = tr_read<v_rd_off(D0, 2, 0)>(vb); h[2] = tr_read<v_rd_off(D0, 2, 1)>(vb); l[3] = tr_read<v_rd_off(D0, 3, 0)>(vb); h[3] = tr_read<v_rd_off(D0, 3, 1)>(vb);
}
__device__ __forceinline__ void pv_mfma(f32x16& od, const s16x4 (&l)[4], const s16x4 (&h)[4], bf16x8 pa0, bf16x8 pa1, bf16x8 pa2, bf16x8 pa3) {
#define FA_PK(L, H) (bf16x8){L[0], L[1], L[2], L[3], H[0], H[1], H[2], H[3]}
    od = __builtin_amdgcn_mfma_f32_32x32x16_bf16(pa0, FA_PK(l[0], h[0]), od, 0, 0, 0);
    od = __builtin_amdgcn_mfma_f32_32x32x16_bf16(pa1, FA_PK(l[1], h[1]), od, 0, 0, 0);
    od = __builtin_amdgcn_mfma_f32_32x32x16_bf16(pa2, FA_PK(l[2], h[2]), od, 0, 0, 0);
    od = __builtin_amdgcn_mfma_f32_32x32x16_bf16(pa3, FA_PK(l[3], h[3]), od, 0, 0, 0);
#undef FA_PK
}
__device__ __forceinline__ void pv_d0_pipe(f32x16* o, int vb, bf16x8 pa0, bf16x8 pa1, bf16x8 pa2, bf16x8 pa3) {
    s16x4 la[4], ha[4], lb[4], hb[4];
    pv_reads<0>(la, ha, vb); pv_reads<1>(lb, hb, vb);
    asm volatile("s_waitcnt lgkmcnt(8)" ::: "memory"); FA_SBAR(); pv_mfma(o[0], la, ha, pa0, pa1, pa2, pa3); FA_SBAR();
    pv_reads<2>(la, ha, vb);
    asm volatile("s_waitcnt lgkmcnt(8)" ::: "memory"); FA_SBAR(); pv_mfma(o[1], lb, hb, pa0, pa1, pa2, pa3); FA_SBAR();
    pv_reads<3>(lb, hb, vb);
    asm volatile("s_waitcnt lgkmcnt(8)" ::: "memory"); FA_SBAR(); pv_mfma(o[2], la, ha, pa0, pa1, pa2, pa3); FA_SBAR();
    asm volatile("s_waitcnt lgkmcnt(0)" ::: "memory"); FA_SBAR(); pv_mfma(o[3], lb, hb, pa0, pa1, pa2, pa3);
}
__device__ __forceinline__ void partialSM(f32x16& p0, f32x16& p1, float& m_reg, float& alpha) {
    float pmax = p0[0];
#pragma unroll
    for (int r = 1; r < 16; ++r) pmax = fmaxf(pmax, p0[r]);
#pragma unroll
    for (int r = 0; r < 16; ++r) pmax = fmaxf(pmax, p1[r]);
    { auto rr = __builtin_amdgcn_permlane32_swap(__float_as_uint(pmax), __float_as_uint(pmax), false, false); pmax = fmaxf(__uint_as_float(rr[0]), __uint_as_float(rr[1])); }
    float mn;
    if (__builtin_expect(__all(pmax - m_reg <= THR), 1)) { mn = m_reg; alpha = 1.f; }
    else { mn = fmaxf(m_reg, pmax); alpha = __builtin_amdgcn_exp2f(m_reg - mn); m_reg = mn; }
#pragma unroll
    for (int r = 0; r < 16; ++r) { p0[r] -= mn; p1[r] -= mn; }
#pragma unroll
    for (int r = 0; r < 16; ++r) p0[r] = __builtin_amdgcn_exp2f(p0[r]);
}
__device__ __forceinline__ void finishSM(f32x16& p0, f32x16& p1, float alpha, float& l_reg, bf16x8& pa0, bf16x8& pa1, bf16x8& pa2, bf16x8& pa3) {
#pragma unroll
    for (int r = 0; r < 16; ++r) p1[r] = __builtin_amdgcn_exp2f(p1[r]);
    float ps = 0;
#pragma unroll
    for (int r = 0; r < 16; ++r) ps += p0[r];
#pragma unroll
    for (int r = 0; r < 16; ++r) ps += p1[r];
    { auto rr = __builtin_amdgcn_permlane32_swap(__float_as_uint(ps), __float_as_uint(ps), false, false); ps = __uint_as_float(rr[0]) + __uint_as_float(rr[1]); }
    l_reg = l_reg * alpha + ps;
#define FA_PK4(P, BASE, OUT) do { unsigned a0 = cvtpk(P[BASE + 0], P[BASE + 1]), a1 = cvtpk(P[BASE + 2], P[BASE + 3]);   \
    unsigned b0 = cvtpk(P[BASE + 4], P[BASE + 5]), b1 = cvtpk(P[BASE + 6], P[BASE + 7]);                              \
    auto r0 = __builtin_amdgcn_permlane32_swap(a0, b0, false, false); auto r1 = __builtin_amdgcn_permlane32_swap(a1, b1, false, false); \
    u32x4_t w = {r0[0], r1[0], r0[1], r1[1]}; OUT = __builtin_bit_cast(bf16x8, w); } while (0)
    typedef unsigned u32x4_t __attribute__((ext_vector_type(4)));
    FA_PK4(p0, 0, pa0); FA_PK4(p0, 8, pa1); FA_PK4(p1, 0, pa2); FA_PK4(p1, 8, pa3);
#undef FA_PK4
}
__device__ __forceinline__ float fma_np(float a, float b, float c) { float r; asm("v_fma_f32 %0, %1, %2, %3" : "=v"(r) : "v"(a), "v"(b), "v"(c)); return r; }
template <bool ALIBI> __device__ __forceinline__ void fr_init(f32x16& p0, f32x16& p1, const LAS float* posl, float posq, float slope2, bool linear, int hi) {
    if (linear) {
        const float cl = -slope2 * posq;
#pragma unroll
        for (int g = 0; g < 4; ++g) { const f32x4 k0 = *(const LAS f32x4*)(posl + 8 * g + 4 * hi), k1 = *(const LAS f32x4*)(posl + 32 + 8 * g + 4 * hi);
#pragma unroll
            for (int e = 0; e < 4; ++e) { p0[4 * g + e] = fma_np(slope2, k0[e], cl); p1[4 * g + e] = fma_np(slope2, k1[e], cl); } }
    } else {
#pragma unroll
        for (int g = 0; g < 4; ++g) { const f32x4 k0 = *(const LAS f32x4*)(posl + 8 * g + 4 * hi), k1 = *(const LAS f32x4*)(posl + 32 + 8 * g + 4 * hi);
#pragma unroll
            for (int e = 0; e < 4; ++e) { p0[4 * g + e] = -slope2 * fabsf(posq - k0[e]); p1[4 * g + e] = -slope2 * fabsf(posq - k1[e]); } }
    }
}
__device__ __forceinline__ float add_np(float a, float b) { asm("v_add_f32 %0, %0, %1" : "+v"(a) : "v"(b)); return a; }
__device__ __forceinline__ void fr_softmax(f32x16& p0, f32x16& p1, float& l_reg, bf16x8& pa0, bf16x8& pa1, bf16x8& pa2, bf16x8& pa3) {
#pragma unroll
    for (int r = 0; r < 16; ++r) { p0[r] = __builtin_amdgcn_exp2f(p0[r]); p1[r] = __builtin_amdgcn_exp2f(p1[r]); }
    float sa = 0.f, sb = 0.f;
#pragma unroll
    for (int r = 0; r < 16; ++r) { sa += p0[r]; sa += p1[r]; }
    l_reg += sa + sb;
    typedef unsigned u32x4_t __attribute__((ext_vector_type(4)));
#define FA_PKS(P, BASE, OUT) do { u32x4_t w = {cvtpk(P[BASE + 0], P[BASE + 1]), cvtpk(P[BASE + 2], P[BASE + 3]), cvtpk(P[BASE + 4], P[BASE + 5]), cvtpk(P[BASE + 6], P[BASE + 7])}; OUT = __builtin_bit_cast(bf16x8, w); } while (0)
    FA_PKS(p0, 0, pa0); FA_PKS(p0, 8, pa1); FA_PKS(p1, 0, pa2); FA_PKS(p1, 8, pa3);
#undef FA_PKS
}
template <int DQK> struct Lds {
    static constexpr int SHM_K = KVBLK * DQK * 2;
    static constexpr int V_OFF = 0, K_OFF = 2 * SHM_V, POS_OFF = K_OFF + 2 * SHM_K, WS_OFF = POS_OFF + 2 * 256, END = WS_OFF + 8 * 256;
};
template <int DQK, bool INIT = true> __device__ __forceinline__ void qkt(f32x16& p0, f32x16& p1, const LAS unsigned char* Ks, const bf16x8* qr, int r32, int hi) {
    if (INIT) { p0 = f32x16{}; p1 = f32x16{}; }
#pragma unroll
    for (int d0 = 0; d0 < DQK / 16; ++d0) { const int cb = (d0 * 16 + hi * 8) * 2;
        const bf16x8 b0 = *(const LAS bf16x8*)(Ks + kswz(r32, cb));
        const bf16x8 b1 = *(const LAS bf16x8*)(Ks + kswz(32 + r32, cb));
        p0 = __builtin_amdgcn_mfma_f32_32x32x16_bf16(b0, qr[d0], p0, 0, 0, 0);
        p1 = __builtin_amdgcn_mfma_f32_32x32x16_bf16(b1, qr[d0], p1, 0, 0, 0);
        if (DQK > 64 && (d0 & 3) == 3) FA_SBAR(); }
}
template <int OFF> __device__ __forceinline__ bf16x8 k_read(int addr) { bf16x8 r; asm volatile("ds_read_b128 %0, %1 offset:%2" : "=&v"(r) : "v"(addr), "i"(OFF) : "memory"); return r; }
__device__ __forceinline__ void k_bases(int (&ka)[4], const LAS unsigned char* K_lds, int r32, int hi) {
#pragma unroll
    for (int j = 0; j < 4; ++j) ka[j] = (int)(uintptr_t)K_lds + r32 * 128 + ((j * 32 + hi * 16) ^ (((r32 >> 1) & 7) << 4));
}
#define FA_LGK(n) asm volatile("s_waitcnt lgkmcnt(" #n ")" ::: "memory")
template <int DQK, int BOFF, int VAR = 0> __device__ __forceinline__ void qkt_pipe(f32x16& p0, f32x16& p1, const int (&ka)[4], const bf16x8* qr) {
    if constexpr (DQK == 64) {
        bf16x8 a0 = k_read<BOFF>(ka[0]), b0 = k_read<BOFF + 4096>(ka[0]), a1 = k_read<BOFF>(ka[1]), b1 = k_read<BOFF + 4096>(ka[1]);
        bf16x8 a2 = k_read<BOFF>(ka[2]), b2 = k_read<BOFF + 4096>(ka[2]), a3 = k_read<BOFF>(ka[3]), b3 = k_read<BOFF + 4096>(ka[3]);
        FA_LGK(6); FA_SBAR(); p0 = __builtin_amdgcn_mfma_f32_32x32x16_bf16(a0, qr[0], p0, 0, 0, 0); p1 = __builtin_amdgcn_mfma_f32_32x32x16_bf16(b0, qr[0], p1, 0, 0, 0); FA_SBAR();
        FA_LGK(4); FA_SBAR(); p0 = __builtin_amdgcn_mfma_f32_32x32x16_bf16(a1, qr[1], p0, 0, 0, 0); p1 = __builtin_amdgcn_mfma_f32_32x32x16_bf16(b1, qr[1], p1, 0, 0, 0); FA_SBAR();
        FA_LGK(2); FA_SBAR(); p0 = __builtin_amdgcn_mfma_f32_32x32x16_bf16(a2, qr[2], p0, 0, 0, 0); p1 = __builtin_amdgcn_mfma_f32_32x32x16_bf16(b2, qr[2], p1, 0, 0, 0); FA_SBAR();
        FA_LGK(0); FA_SBAR(); p0 = __builtin_amdgcn_mfma_f32_32x32x16_bf16(a3, qr[3], p0, 0, 0, 0); p1 = __builtin_amdgcn_mfma_f32_32x32x16_bf16(b3, qr[3], p1, 0, 0, 0); FA_SBAR();
    } else {
        static_assert(DQK == 192, "qkt_pipe: d = 64 or 192");
#define FA_KG(G, x0, y0, x1, y1) do { x0 = k_read<BOFF + ((2 * (G)) >> 2) * 8192>(ka[(2 * (G)) & 3]); y0 = k_read<BOFF + ((2 * (G)) >> 2) * 8192 + 4096>(ka[(2 * (G)) & 3]); \
        x1 = k_read<BOFF + ((2 * (G) + 1) >> 2) * 8192>(ka[(2 * (G) + 1) & 3]); y1 = k_read<BOFF + ((2 * (G) + 1) >> 2) * 8192 + 4096>(ka[(2 * (G) + 1) & 3]); } while (0)
#define FA_KM(G, x0, y0, x1, y1) do { FA_SBAR(); if (VAR == 6) { p0 = __builtin_amdgcn_mfma_f32_32x32x16_bf16(x0 ^ y0 ^ x1 ^ y1, qr[2 * (G)], p0, 0, 0, 0); } else { \
        p0 = __builtin_amdgcn_mfma_f32_32x32x16_bf16(x0, qr[2 * (G)], p0, 0, 0, 0); p1 = __builtin_amdgcn_mfma_f32_32x32x16_bf16(y0, qr[2 * (G)], p1, 0, 0, 0); \
        p0 = __builtin_amdgcn_mfma_f32_32x32x16_bf16(x1, qr[2 * (G) + 1], p0, 0, 0, 0); p1 = __builtin_amdgcn_mfma_f32_32x32x16_bf16(y1, qr[2 * (G) + 1], p1, 0, 0, 0); } FA_SBAR(); } while (0)
        bf16x8 a0, b0, a1, b1, c0, d0, c1, d1;
        if constexpr (VAR == 5) {
#pragma unroll
            for (int g = 0; g < 12; ++g) { FA_SBAR(); p0 = __builtin_amdgcn_mfma_f32_32x32x16_bf16(qr[(g + 1) % 12], qr[g], p0, 0, 0, 0); p1 = __builtin_amdgcn_mfma_f32_32x32x16_bf16(qr[(g + 5) % 12], qr[g], p1, 0, 0, 0); FA_SBAR(); }
            return; }
        FA_KG(0, a0, b0, a1, b1); FA_KG(1, c0, d0, c1, d1);
        FA_LGK(4); FA_KM(0, a0, b0, a1, b1); FA_KG(2, a0, b0, a1, b1);
        FA_LGK(4); FA_KM(1, c0, d0, c1, d1); FA_KG(3, c0, d0, c1, d1);
        FA_LGK(4); FA_KM(2, a0, b0, a1, b1); FA_KG(4, a0, b0, a1, b1);
        FA_LGK(4); FA_KM(3, c0, d0, c1, d1); FA_KG(5, c0, d0, c1, d1);
        FA_LGK(4); FA_KM(4, a0, b0, a1, b1);
        FA_LGK(0); FA_KM(5, c0, d0, c1, d1);
#undef FA_KG
#undef FA_KM
    }
}
template <bool ALIBI> __device__ __forceinline__ void fixup(f32x16& p0, f32x16& p1, const LAS float* posl, float posq, float slope2, bool masked, int hi) {
    if (ALIBI) {
#pragma unroll
        for (int g = 0; g < 4; ++g) { const f32x4 k0 = *(const LAS f32x4*)(posl + 8 * g + 4 * hi), k1 = *(const LAS f32x4*)(posl + 32 + 8 * g + 4 * hi);
#pragma unroll
            for (int e = 0; e < 4; ++e) { p0[4 * g + e] = fmaf(-slope2, fabsf(posq - k0[e]), p0[4 * g + e]); p1[4 * g + e] = fmaf(-slope2, fabsf(posq - k1[e]), p1[4 * g + e]); } }
    }
    if (masked) {
#pragma unroll
        for (int r = 0; r < 16; ++r) { p0[r] = -INFINITY; p1[r] = -INFINITY; }
    }
}
template <int DQK, bool ALIBI, int NSLOT, int MODE = 0, int VAR = 0>
__device__ __forceinline__ void attn_pass(const bf16* __restrict__ Qb, const bf16* __restrict__ Kh, const bf16* __restrict__ Vh, const int* __restrict__ posb, float slope2, float cref, int TL, int q0, int T0, int NT,
                                          LAS unsigned char* lds, int tid_, f32x16 (&o)[4], float& l_out) {
    typedef Lds<DQK> L; constexpr int KSUB = DQK / 64, SHM_K = L::SHM_K;
    const int wid = __builtin_amdgcn_readfirstlane(tid_ >> 6); int lane; asm volatile("v_mbcnt_lo_u32_b32 %0, -1, 0\n\tv_mbcnt_hi_u32_b32 %0, -1, %0" : "=v"(lane));
    const int tid = wid * 64 + lane, r32 = lane & 31, hi = lane >> 5;
    if (wid >= 4) __builtin_amdgcn_s_setprio(1);
    LAS unsigned char* V_lds = lds + L::V_OFF; LAS unsigned char* K_lds = lds + L::K_OFF; LAS float* P_lds = (LAS float*)(lds + L::POS_OFF);
    LAS float* al_l = (LAS float*)(lds + L::WS_OFF) + wid * 64;
    float m_reg = -1e30f, l_reg = 0.f;
#pragma unroll
    for (int d = 0; d < 4; ++d) o[d] = f32x16{};
    bf16x8 qr[DQK / 16];
    { const bf16* Qw = Qb + (size_t)(wid * QBLK) * DQK; unsigned qgo = (unsigned)(r32 * DQK + hi * 8) * 2u; asm volatile("" : "+v"(qgo));
#pragma unroll
      for (int d0 = 0; d0 < DQK / 16; ++d0) qr[d0] = ldg<bf16x8>(Qw + d0 * 16, qgo); }
    const float posq = ALIBI ? (float)posb[q0 + wid * QBLK + r32] : 0.f;
    const int tmax = NT - 4 + (wid >> 1);
    const int sr = tid >> 4, sc = (tid & 15) * 8, vst0 = MODE == 5 ? v_st_nat(sr, sc) : v_st(sr, sc), vst1 = MODE == 5 ? v_st_nat(32 + sr, sc) : v_st(32 + sr, sc);
    const int kr = tid >> 3, kc = (tid & 7) * 8, kst = kswz(kr, kc * 2);
    unsigned vgo = (unsigned)(sr * DV + sc) * 2u, kgo = (unsigned)(kr * DQK + kc) * 2u, pgo = (unsigned)(tid & 63) * 4u; asm volatile("" : "+v"(vgo), "+v"(kgo), "+v"(pgo));
    const int vb0 = (int)(uintptr_t)V_lds + v_rd_base(lane);
    int ka[4]; k_bases(ka, K_lds, r32, hi);
    struct Slot { bf16x8 vs0, vs1, ks[KSUB]; int ps; } sl_[NSLOT];
#define FA_SLOAD(i, k0) do { unsigned kk_ = (unsigned)__builtin_amdgcn_readfirstlane((int)(k0)); asm volatile("" : "+s"(kk_));     \
    const bf16* Vt_ = Vh + (size_t)kk_ * DV; const bf16* Kt_ = Kh + (size_t)kk_ * DQK; \
    sl_[i].vs0 = ldg<bf16x8>(Vt_, vgo); sl_[i].vs1 = ldg<bf16x8>(Vt_ + 32 * DV, vgo); \
    _Pragma("unroll") for (int s_ = 0; s_ < KSUB; ++s_) sl_[i].ks[s_] = ldg<bf16x8>(Kt_ + s_ * 64, kgo); \
    if (ALIBI) sl_[i].ps = ldg<int>(posb + kk_, pgo); } while (0)
#define FA_SWRITE(b, i) do { *(LAS bf16x8*)(V_lds + (b) * SHM_V + vst0) = sl_[i].vs0; *(LAS bf16x8*)(V_lds + (b) * SHM_V + vst1) = sl_[i].vs1; \
    _Pragma("unroll") for (int s_ = 0; s_ < KSUB; ++s_) *(LAS bf16x8*)(K_lds + (b) * SHM_K + s_ * 8192 + kst) = sl_[i].ks[s_]; \
    if (ALIBI) { if (tid < 64) P_lds[(b) * 64 + tid] = (float)sl_[i].ps; } } while (0)
#define FA_RESC(a) do { if (__any((a) < 1.f)) { if (hi == 0) al_l[r32] = (a); asm volatile("s_waitcnt lgkmcnt(0)" ::: "memory"); \
    _Pragma("unroll") for (int d = 0; d < 4; ++d) _Pragma("unroll") for (int r = 0; r < 16; ++r) o[d][r] *= al_l[crow(r, hi)]; } } while (0)
#define FA_COMPUTE(b, t, STAGE) do { bf16x8 pa0, pa1, pa2, pa3; const bool vis_ = (t) <= tmax;     \
    if (vis_) { f32x16 p0, p1; \
    if (MODE == 5) { if (VAR == 3) { p0 = f32x16{}; p1 = f32x16{}; _Pragma("unroll") for (int r_ = 0; r_ < 16; ++r_) { p0[r_] = l_reg; p1[r_] = l_reg; } } \
        else if ((DQK == 192 && PIPE_MLA) || (DQK == 64 && PIPE_OLD64)) { p0 = f32x16{}; p1 = f32x16{}; qkt_pipe<DQK, (b) * SHM_K, (VAR == 5 || VAR == 6) ? VAR : 0>(p0, p1, ka, qr); } else qkt<DQK, true>(p0, p1, K_lds + (b) * SHM_K, qr, r32, hi); fixup<ALIBI>(p0, p1, P_lds + (b) * 64, posq, slope2, false, hi); \
        if (VAR == 1) { l_reg += p0[0] + p1[5]; typedef unsigned u32x4_t __attribute__((ext_vector_type(4))); \
            u32x4_t w0_ = {cvtpk(p0[0], p0[1]), cvtpk(p0[2], p0[3]), cvtpk(p0[4], p0[5]), cvtpk(p0[6], p0[7])}, w1_ = {cvtpk(p0[8], p0[9]), cvtpk(p0[10], p0[11]), cvtpk(p0[12], p0[13]), cvtpk(p0[14], p0[15])}; \
            u32x4_t w2_ = {cvtpk(p1[0], p1[1]), cvtpk(p1[2], p1[3]), cvtpk(p1[4], p1[5]), cvtpk(p1[6], p1[7])}, w3_ = {cvtpk(p1[8], p1[9]), cvtpk(p1[10], p1[11]), cvtpk(p1[12], p1[13]), cvtpk(p1[14], p1[15])}; \
            pa0 = __builtin_bit_cast(bf16x8, w0_); pa1 = __builtin_bit_cast(bf16x8, w1_); pa2 = __builtin_bit_cast(bf16x8, w2_); pa3 = __builtin_bit_cast(bf16x8, w3_); } \
        else fr_softmax(p0, p1, l_reg, pa0, pa1, pa2, pa3); } \
    else { float alpha; qkt<DQK>(p0, p1, K_lds + (b) * SHM_K, qr, r32, hi); fixup<ALIBI>(p0, p1, P_lds + (b) * 64, posq, slope2, false, hi); \
        partialSM(p0, p1, m_reg, alpha); finishSM(p0, p1, alpha, l_reg, pa0, pa1, pa2, pa3); FA_RESC(alpha); } } \
    FA_SBAR(); STAGE; FA_SBAR();     \
    if (vis_) { \
    if (VAR == 2) { l_reg += __builtin_bit_cast(float, pa0[0] | (pa1[1] << 16)) + __builtin_bit_cast(float, pa2[0] | (pa3[1] << 16)); } else \
    if (MODE == 5 && DQK == 64) pv_d0_pipe(o, vb0 + (b) * SHM_V, pa0, pa1, pa2, pa3); else pv_d0(o, vb0 + (b) * SHM_V, pa0, pa1, pa2, pa3); } } while (0)
    constexpr int S1 = NSLOT - 1;
    FA_SLOAD(0, T0 * KVBLK); FA_SWRITE(0, 0); FA_SLOAD(S1, (T0 + 1) * KVBLK); FA_SWRITE(1, S1); FA_SLOAD(0, (T0 + 2) * KVBLK);
    if (NSLOT == 2) FA_SLOAD(1, (T0 + 3) * KVBLK);
    __syncthreads();
    static_assert(NSLOT == 1, "attn_pass: one staging slot");
    for (int j = T0; j < NT; j += 2) {
        FA_COMPUTE(0, j, { if (VAR != 4) if (j > T0) { FA_SWRITE(1, 0); if (j + 2 < NT) FA_SLOAD(0, (j + 2) * KVBLK); } });
        __syncthreads();
        FA_COMPUTE(1, j + 1, { if (VAR != 4) if (j + 2 < NT) { FA_SWRITE(0, 0); FA_SLOAD(0, (j + 3) * KVBLK); } });
        __syncthreads();
    }
    if (MODE == 5) { auto rr = __builtin_amdgcn_permlane32_swap(__float_as_uint(l_reg), __float_as_uint(l_reg), false, false); l_reg = __uint_as_float(rr[0]) + __uint_as_float(rr[1]); }
    __builtin_amdgcn_s_setprio(0);
    l_out = l_reg;
#undef FA_SLOAD
#undef FA_SWRITE
#undef FA_RESC
#undef FA_COMPUTE
}
template <int DQK> struct Lds3 {
    static constexpr int SHM_K = KVBLK * DQK * 2;
    static constexpr int V_OFF = 0, K_OFF = 3 * SHM_V, POS_OFF = K_OFF + 3 * SHM_K, WS_OFF = POS_OFF + 3 * 256, END = WS_OFF + 8 * 256;
};
template <int DQK, bool ALIBI>
__device__ __forceinline__ void attn_pass_stag(const bf16* __restrict__ Qb, const bf16* __restrict__ Kh, const bf16* __restrict__ Vh, const int* __restrict__ posb, float slope2, int q0, int T0, int NT,
                                               LAS unsigned char* lds, int tid, f32x16 (&o)[4], float& l_out) {
    typedef Lds3<DQK> L; constexpr int KSUB = DQK / 64, SHM_K = L::SHM_K;
    const int wid = __builtin_amdgcn_readfirstlane(tid >> 6), lane = tid & 63, r32 = lane & 31, hi = lane >> 5, grp = wid >> 2;
    LAS unsigned char* V_lds = lds + L::V_OFF; LAS unsigned char* K_lds = lds + L::K_OFF; LAS float* P_lds = (LAS float*)(lds + L::POS_OFF);
    float l_reg = 0.f;
#pragma unroll
    for (int d = 0; d < 4; ++d) o[d] = f32x16{};
    bf16x8 qr[DQK / 16];
    { const bf16* Qw = Qb + (size_t)(wid * QBLK) * DQK; unsigned qgo = (unsigned)(r32 * DQK + hi * 8) * 2u; asm volatile("" : "+v"(qgo));
#pragma unroll
      for (int d0 = 0; d0 < DQK / 16; ++d0) qr[d0] = ldg<bf16x8>(Qw + d0 * 16, qgo); }
    const float posq = ALIBI ? (float)posb[q0 + wid * QBLK + r32] : 0.f;
    const int tmax = NT - 4 + (wid >> 1);
    const int sr = tid >> 4, sc = (tid & 15) * 8, vst0 = v_st(sr, sc), vst1 = v_st(32 + sr, sc);
    const int kr = tid >> 3, kc = (tid & 7) * 8, kst = kswz(kr, kc * 2);
    unsigned vgo = (unsigned)(sr * DV + sc) * 2u, kgo = (unsigned)(kr * DQK + kc) * 2u, pgo = (unsigned)(tid & 63) * 4u; asm volatile("" : "+v"(vgo), "+v"(kgo), "+v"(pgo));
    const int vb0 = (int)(uintptr_t)V_lds + v_rd_base(lane);
    struct Slot { bf16x8 vs0, vs1, ks[KSUB]; int ps; } sl_;
#define FS_SLOAD(k0) do { unsigned kk_ = (unsigned)__builtin_amdgcn_readfirstlane((int)(k0)); asm volatile("" : "+s"(kk_)); \
    const bf16* Vt_ = Vh + (size_t)kk_ * DV; const bf16* Kt_ = Kh + (size_t)kk_ * DQK; \
    sl_.vs0 = ldg<bf16x8>(Vt_, vgo); sl_.vs1 = ldg<bf16x8>(Vt_ + 32 * DV, vgo); \
    _Pragma("unroll") for (int s_ = 0; s_ < KSUB; ++s_) sl_.ks[s_] = ldg<bf16x8>(Kt_ + s_ * 64, kgo); \
    if (ALIBI) sl_.ps = ldg<int>(posb + kk_, pgo); } while (0)
#define FS_SWRITE(b) do { *(LAS bf16x8*)(V_lds + (b) * SHM_V + vst0) = sl_.vs0; *(LAS bf16x8*)(V_lds + (b) * SHM_V + vst1) = sl_.vs1; \
    _Pragma("unroll") for (int s_ = 0; s_ < KSUB; ++s_) *(LAS bf16x8*)(K_lds + (b) * SHM_K + s_ * 8192 + kst) = sl_.ks[s_]; \
    if (ALIBI) { if (tid < 64) P_lds[(b) * 64 + tid] = (float)sl_.ps; } } while (0)
    const int nt = NT - T0;
    FS_SLOAD(T0 * KVBLK); FS_SWRITE(0); FS_SLOAD((T0 + 1) * KVBLK); FS_SWRITE(1); FS_SLOAD((T0 + 2) * KVBLK);
    __syncthreads();
#define FS_QKS(j_) do { int b_ = (j_) % 3; asm volatile("" : "+s"(b_)); f32x16 p0, p1; \
    qkt<DQK, true>(p0, p1, K_lds + b_ * SHM_K, qr, r32, hi); fixup<ALIBI>(p0, p1, P_lds + b_ * 64, posq, slope2, T0 + (j_) > tmax, hi); \
    fr_softmax(p0, p1, l_reg, pa0, pa1, pa2, pa3); } while (0)
#define FS_PV(j_) do { int b_ = (j_) % 3; asm volatile("" : "+s"(b_)); pv_d0(o, vb0 + b_ * SHM_V, pa0, pa1, pa2, pa3); } while (0)
#define FS_STAGE(j_) do { const int jn_ = (j_) + 2; if (jn_ < nt) { int bw_ = jn_ % 3; asm volatile("" : "+s"(bw_)); FS_SWRITE(bw_); if (jn_ + 1 < nt) FS_SLOAD((T0 + jn_ + 1) * KVBLK); } } while (0)
    bf16x8 pa0, pa1, pa2, pa3;
    if (grp == 0) {
        for (int j = 0; j < nt; ++j) { FS_QKS(j); __syncthreads(); FS_PV(j); __syncthreads(); FS_STAGE(j); }
        __syncthreads();
    } else {
        pa0 = bf16x8{}; pa1 = bf16x8{}; pa2 = bf16x8{}; pa3 = bf16x8{};
        for (int j = 0; j < nt; ++j) { if (j > 0) FS_PV(j - 1); __syncthreads(); FS_QKS(j); __syncthreads(); FS_STAGE(j); }
        FS_PV(nt - 1); __syncthreads();
    }
#undef FS_QKS
#undef FS_PV
#undef FS_STAGE
    { auto rr = __builtin_amdgcn_permlane32_swap(__float_as_uint(l_reg), __float_as_uint(l_reg), false, false); l_reg = __uint_as_float(rr[0]) + __uint_as_float(rr[1]); }
    l_out = l_reg;
#undef FS_SLOAD
#undef FS_SWRITE
}
template <int DQK, bool ALIBI>
__device__ __forceinline__ void attn_pass_p2(const bf16* __restrict__ Qb, const bf16* __restrict__ Kh, const bf16* __restrict__ Vh, const int* __restrict__ posb, float slope2, int q0, int T0, int NT,
                                             LAS unsigned char* lds, int tid, f32x16 (&o)[4], float& l_out) {
    typedef Lds<DQK> L; constexpr int KSUB = DQK / 64, SHM_K = L::SHM_K;
    const int wid = __builtin_amdgcn_readfirstlane(tid >> 6), lane = tid & 63, r32 = lane & 31, hi = lane >> 5;
    LAS unsigned char* V_lds = lds + L::V_OFF; LAS unsigned char* K_lds = lds + L::K_OFF; LAS float* P_lds = (LAS float*)(lds + L::POS_OFF);
    float l_reg = 0.f;
#pragma unroll
    for (int d = 0; d < 4; ++d) o[d] = f32x16{};
    bf16x8 qr[DQK / 16];
    { const bf16* Qw = Qb + (size_t)(wid * QBLK) * DQK; unsigned qgo = (unsigned)(r32 * DQK + hi * 8) * 2u; asm volatile("" : "+v"(qgo));
#pragma unroll
      for (int d0 = 0; d0 < DQK / 16; ++d0) qr[d0] = ldg<bf16x8>(Qw + d0 * 16, qgo); }
    const float posq = ALIBI ? (float)posb[q0 + wid * QBLK + r32] : 0.f;
    const int tmax = NT - 4 + (wid >> 1);
    const int sr = tid >> 4, sc = (tid & 15) * 8, vst0 = v_st(sr, sc), vst1 = v_st(32 + sr, sc);
    const int kr = tid >> 3, kc = (tid & 7) * 8, kst = kswz(kr, kc * 2);
    unsigned vgo = (unsigned)(sr * DV + sc) * 2u, kgo = (unsigned)(kr * DQK + kc) * 2u, pgo = (unsigned)(tid & 63) * 4u; asm volatile("" : "+v"(vgo), "+v"(kgo), "+v"(pgo));
    const int vb0 = (int)(uintptr_t)V_lds + v_rd_base(lane);
    struct Slot { bf16x8 vs0, vs1, ks[KSUB]; int ps; } sl_;
#define FP_LOADK(t) do { unsigned kk_ = (unsigned)__builtin_amdgcn_readfirstlane((int)((t) * KVBLK)); asm volatile("" : "+s"(kk_)); const bf16* Kt_ = Kh + (size_t)kk_ * DQK; \
    _Pragma("unroll") for (int s_ = 0; s_ < KSUB; ++s_) sl_.ks[s_] = ldg<bf16x8>(Kt_ + s_ * 64, kgo); if (ALIBI) sl_.ps = ldg<int>(posb + kk_, pgo); } while (0)
#define FP_LOADV(t) do { unsigned kk_ = (unsigned)__builtin_amdgcn_readfirstlane((int)((t) * KVBLK)); asm volatile("" : "+s"(kk_)); const bf16* Vt_ = Vh + (size_t)kk_ * DV; \
    sl_.vs0 = ldg<bf16x8>(Vt_, vgo); sl_.vs1 = ldg<bf16x8>(Vt_ + 32 * DV, vgo); } while (0)
#define FP_WRITEK(b) do { _Pragma("unroll") for (int s_ = 0; s_ < KSUB; ++s_) *(LAS bf16x8*)(K_lds + (b) * SHM_K + s_ * 8192 + kst) = sl_.ks[s_]; \
    if (ALIBI) { if (tid < 64) P_lds[(b) * 64 + tid] = (float)sl_.ps; } } while (0)
#define FP_WRITEV(b) do { *(LAS bf16x8*)(V_lds + (b) * SHM_V + vst0) = sl_.vs0; *(LAS bf16x8*)(V_lds + (b) * SHM_V + vst1) = sl_.vs1; } while (0)
#define FP_QK(P0, P1, b, t) do { qkt<DQK, true>(P0, P1, K_lds + (b) * SHM_K, qr, r32, hi); fixup<ALIBI>(P0, P1, P_lds + (b) * 64, posq, slope2, (t) > tmax, hi); } while (0)
    f32x16 pA0, pA1, pB0, pB1; bf16x8 pa0, pa1, pa2, pa3;
    const int nt = NT - T0;
    FP_LOADK(T0); FP_LOADV(T0); FP_WRITEK(0); FP_WRITEV(0); FP_LOADK(T0 + 1); FP_WRITEK(1); FP_LOADK(T0 + 2); FP_LOADV(T0 + 1);
    __syncthreads();
    FP_QK(pA0, pA1, 0, T0);
    __syncthreads();
    for (int r = 0; r < nt; r += 2) {
        if (r + 2 < nt) FP_WRITEK(0);
        FP_WRITEV(1);
        if (r + 3 < nt) FP_LOADK(T0 + r + 3);
        if (r + 2 < nt) FP_LOADV(T0 + r + 2);
        FA_SBAR(); FP_QK(pB0, pB1, 1, T0 + r + 1);
        fr_softmax(pA0, pA1, l_reg, pa0, pa1, pa2, pa3); FA_SBAR();
        pv_d0(o, vb0, pa0, pa1, pa2, pa3);
        __syncthreads();
        if (r + 3 < nt) FP_WRITEK(1);
        if (r + 2 < nt) FP_WRITEV(0);
        if (r + 4 < nt) FP_LOADK(T0 + r + 4);
        if (r + 3 < nt) FP_LOADV(T0 + r + 3);
        FA_SBAR(); if (r + 2 < nt) FP_QK(pA0, pA1, 0, T0 + r + 2);
        fr_softmax(pB0, pB1, l_reg, pa0, pa1, pa2, pa3); FA_SBAR();
        pv_d0(o, vb0 + SHM_V, pa0, pa1, pa2, pa3);
        __syncthreads();
    }
    { auto rr = __builtin_amdgcn_permlane32_swap(__float_as_uint(l_reg), __float_as_uint(l_reg), false, false); l_reg = __uint_as_float(rr[0]) + __uint_as_float(rr[1]); }
    l_out = l_reg;
#undef FP_LOADK
#undef FP_LOADV
#undef FP_WRITEK
#undef FP_WRITEV
#undef FP_QK
}
template <int DQK, bool ALIBI>
__device__ __forceinline__ void attn_pass_dma(const bf16* __restrict__ Qb, const bf16* __restrict__ Kh, const bf16* __restrict__ Vh, const int* __restrict__ posb, const float* __restrict__ posfb,
                                              float slope2, int q0, int T0, int NT, LAS unsigned char* lds, int tid_, f32x16 (&o)[4], float& l_out) {
    typedef Lds3<DQK> L; constexpr int KSUB = DQK / 64, SHM_K = L::SHM_K, NPT = KSUB + 2 + (ALIBI ? 1 : 0);
    const int wid = __builtin_amdgcn_readfirstlane(tid_ >> 6); int lane; asm volatile("v_mbcnt_lo_u32_b32 %0, -1, 0\n\tv_mbcnt_hi_u32_b32 %0, -1, %0" : "=v"(lane));
    const int r32 = lane & 31, hi = lane >> 5;
    LAS unsigned char* V_lds = lds + L::V_OFF; LAS unsigned char* K_lds = lds + L::K_OFF; LAS float* P_lds = (LAS float*)(lds + L::POS_OFF);
    float l_reg = 0.f;
#pragma unroll
    for (int d = 0; d < 4; ++d) o[d] = f32x16{};
    bf16x8 qr[DQK / 16];
    { const bf16* Qw = Qb + (size_t)(wid * QBLK) * DQK; unsigned qgo = (unsigned)(r32 * DQK + hi * 8) * 2u; asm volatile("" : "+v"(qgo));
#pragma unroll
      for (int d0 = 0; d0 < DQK / 16; ++d0) qr[d0] = ldg<bf16x8>(Qw + d0 * 16, qgo); }
    const float posq = ALIBI ? (float)posb[q0 + wid * QBLK + r32] : 0.f;
    const int tmax = NT - 4 + (wid >> 1);
    unsigned ksrc, vsrc, psrc;
    { const int kr = 8 * wid + (lane >> 3), kc = (lane & 7) ^ ((kr >> 1) & 7); ksrc = (unsigned)(kr * DQK + kc * 8) * 2u;
      const int vk = 8 * wid + ((lane & 31) >> 2), vc = (lane >> 5) * 32 + (lane & 3) * 8; vsrc = (unsigned)(vk * DV + vc) * 2u; psrc = (unsigned)lane * 4u;
      asm volatile("" : "+v"(ksrc), "+v"(vsrc), "+v"(psrc)); }
    const int vb0 = (int)(uintptr_t)V_lds + v_rd_base(lane);
#define FD_DMA(t, slot) do { unsigned kk_ = (unsigned)__builtin_amdgcn_readfirstlane((int)((t) * KVBLK)); asm volatile("" : "+s"(kk_)); const int sl_ = (slot); \
    const char* Kt_ = (const char*)(Kh + (size_t)kk_ * DQK); const char* Vt_ = (const char*)(Vh + (size_t)kk_ * DV); \
    _Pragma("unroll") for (int s_ = 0; s_ < KSUB; ++s_) __builtin_amdgcn_global_load_lds((const unsigned*)(Kt_ + s_ * 128 + ksrc), (LAS unsigned*)(K_lds + sl_ * SHM_K + s_ * 8192 + wid * 1024), 16, 0, 0); \
    _Pragma("unroll") for (int q_ = 0; q_ < 2; ++q_) __builtin_amdgcn_global_load_lds((const unsigned*)(Vt_ + q_ * 128 + vsrc), (LAS unsigned*)(V_lds + sl_ * SHM_V + (2 * wid + q_) * 1024), 16, 0, 0); \
    if (ALIBI) __builtin_amdgcn_global_load_lds((const unsigned*)((const char*)(posfb + kk_) + psrc), (LAS unsigned*)(P_lds + sl_ * 64), 4, 0, 0); } while (0)
    const int nt = NT - T0;
    FD_DMA(T0, 0); FD_DMA(T0 + 1, 1);
    asm volatile("s_waitcnt vmcnt(0) lgkmcnt(0)\n\ts_barrier" ::: "memory");
    int slot = 0;
    for (int j = 0; j < nt; ++j) {
        int b = slot; asm volatile("" : "+s"(b));
        if (j + 2 < nt) { int bn = b + 2; bn = bn >= 3 ? bn - 3 : bn; FD_DMA(T0 + j + 2, bn); }
        { f32x16 p0, p1; bf16x8 pa0, pa1, pa2, pa3;
          qkt<DQK, true>(p0, p1, K_lds + b * SHM_K, qr, r32, hi); fixup<ALIBI>(p0, p1, P_lds + b * 64, posq, slope2, T0 + j > tmax, hi);
          fr_softmax(p0, p1, l_reg, pa0, pa1, pa2, pa3); FA_SBAR();
          pv_d0(o, vb0 + b * SHM_V, pa0, pa1, pa2, pa3); }
        if (j + 2 < nt) asm volatile("s_waitcnt vmcnt(%0) lgkmcnt(0)\n\ts_barrier" :: "n"(NPT) : "memory");
        else asm volatile("s_waitcnt vmcnt(0) lgkmcnt(0)\n\ts_barrier" ::: "memory");
        slot = slot == 2 ? 0 : slot + 1;
    }
    { auto rr = __builtin_amdgcn_permlane32_swap(__float_as_uint(l_reg), __float_as_uint(l_reg), false, false); l_reg = __uint_as_float(rr[0]) + __uint_as_float(rr[1]); }
    l_out = l_reg;
#undef FD_DMA
}
__device__ __forceinline__ void row_bcast(float f, LAS float* al, int r32, int hi, float (&rf)[16]) {
    asm volatile("s_waitcnt lgkmcnt(0)" ::: "memory");
    if (hi == 0) al[r32] = f;
    asm volatile("s_waitcnt lgkmcnt(0)" ::: "memory");
#pragma unroll
    for (int r = 0; r < 16; ++r) rf[r] = al[crow(r, hi)];
    asm volatile("s_waitcnt lgkmcnt(0)" ::: "memory");
}

__device__ __forceinline__ void attn_pass_da5(const bf16* __restrict__ Qb, const bf16* __restrict__ Kh, const bf16* __restrict__ Vh, const int* __restrict__ posb, float slope2, int cw, int q0, int T0, int NT,
                                              LAS unsigned char* lds, int tid_, f32x16 (&o)[4], float& l_out) {
    typedef Lds<64> L; constexpr int DQK = 64, SHM_K = L::SHM_K, B_OFF = L::END;
    const int wid = __builtin_amdgcn_readfirstlane(tid_ >> 6); int lane; asm volatile("v_mbcnt_lo_u32_b32 %0, -1, 0\n\tv_mbcnt_hi_u32_b32 %0, -1, %0" : "=v"(lane));
    const int tid = wid * 64 + lane, r32 = lane & 31, hi = lane >> 5;
    LAS unsigned char* V_lds = lds + L::V_OFF; LAS unsigned char* K_lds = lds + L::K_OFF; LAS float* P_lds = (LAS float*)(lds + L::POS_OFF); LAS float* B_lds = (LAS float*)(lds + B_OFF);
    float l_reg = 0.f;
#pragma unroll
    for (int d = 0; d < 4; ++d) o[d] = f32x16{};
    bf16x8 qr[4];
    { const bf16* Qw = Qb + (size_t)(wid * QBLK) * DQK; unsigned qgo = (unsigned)(r32 * DQK + hi * 8) * 2u; asm volatile("" : "+v"(qgo));
#pragma unroll
      for (int d0 = 0; d0 < 4; ++d0) qr[d0] = ldg<bf16x8>(Qw + d0 * 16, qgo); }
    const float posq = (float)posb[q0 + wid * QBLK + r32];
    const float dl = slope2 * (posq - (float)cw);
    const int tmax = NT - 4 + (wid >> 1);
    const int sr = tid >> 4, sc = (tid & 15) * 8, vst0 = v_st_nat(sr, sc), vst1 = v_st_nat(32 + sr, sc);
    const int kr = tid >> 3, kc = (tid & 7) * 8, kst = kswz(kr, kc * 2);
    unsigned vgo = (unsigned)(sr * DV + sc) * 2u, kgo = (unsigned)(kr * DQK + kc) * 2u, pgo = (unsigned)(tid & 63) * 4u; asm volatile("" : "+v"(vgo), "+v"(kgo), "+v"(pgo));
    const int vb0 = (int)(uintptr_t)V_lds + v_rd_base(lane);
    int ka[4]; k_bases(ka, K_lds, r32, hi);
    bf16x8 vs0, vs1, ks0; int ps;
#define FD_SLOAD(k0) do { unsigned kk_ = (unsigned)__builtin_amdgcn_readfirstlane((int)(k0)); asm volatile("" : "+s"(kk_)); \
    const bf16* Vt_ = Vh + (size_t)kk_ * DV; const bf16* Kt_ = Kh + (size_t)kk_ * DQK; \
    vs0 = ldg<bf16x8>(Vt_, vgo); vs1 = ldg<bf16x8>(Vt_ + 32 * DV, vgo); ks0 = ldg<bf16x8>(Kt_, kgo); ps = ldg<int>(posb + kk_, pgo); } while (0)
#define FD_SWRITE(b) do { *(LAS bf16x8*)(V_lds + (b) * SHM_V + vst0) = vs0; *(LAS bf16x8*)(V_lds + (b) * SHM_V + vst1) = vs1; *(LAS bf16x8*)(K_lds + (b) * SHM_K + kst) = ks0; \
    B_lds[(b) * 512 + tid] = slope2 * (float)(ps - cw); if (tid < 64) P_lds[(b) * 64 + tid] = (float)ps; } while (0)
#define FD_LIN(b) do { f32x16 p0, p1; bf16x8 pa0, pa1, pa2, pa3; const LAS float* bl_ = B_lds + (b) * 512 + wid * 64 + 4 * hi; \
    _Pragma("unroll") for (int g = 0; g < 4; ++g) { const f32x4 k0 = *(const LAS f32x4*)(bl_ + 8 * g), k1 = *(const LAS f32x4*)(bl_ + 32 + 8 * g); \
        _Pragma("unroll") for (int e = 0; e < 4; ++e) { p0[4 * g + e] = k0[e]; p1[4 * g + e] = k1[e]; } } \
    if (PIPE_LIN) qkt_pipe<DQK, (b) * SHM_K>(p0, p1, ka, qr); else qkt<DQK, false>(p0, p1, K_lds + (b) * SHM_K, qr, r32, hi); fr_softmax(p0, p1, l_reg, pa0, pa1, pa2, pa3); FA_SBAR(); \
    pv_d0_pipe(o, vb0 + (b) * SHM_V, pa0, pa1, pa2, pa3); } while (0)
#define FD_GEN(b, t) do { if ((t) <= tmax) { f32x16 p0, p1; bf16x8 pa0, pa1, pa2, pa3; \
    _Pragma("unroll") for (int r = 0; r < 16; ++r) { p0[r] = dl; p1[r] = dl; } \
    if (PIPE_GEN) qkt_pipe<DQK, (b) * SHM_K>(p0, p1, ka, qr); else qkt<DQK, false>(p0, p1, K_lds + (b) * SHM_K, qr, r32, hi); fixup<true>(p0, p1, P_lds + (b) * 64, posq, slope2, false, hi); fr_softmax(p0, p1, l_reg, pa0, pa1, pa2, pa3); FA_SBAR(); \
    pv_d0_pipe(o, vb0 + (b) * SHM_V, pa0, pa1, pa2, pa3); } } while (0)
    FD_SLOAD(T0 * KVBLK); FD_SWRITE(0); FD_SLOAD((T0 + 1) * KVBLK); FD_SWRITE(1); FD_SLOAD((T0 + 2) * KVBLK);
    __syncthreads();
    int j = T0;
    for (; j < NT - 4; j += 2) {
        FD_LIN(0);
        __syncthreads();
        FD_SWRITE(0); FD_SLOAD((j + 3) * KVBLK);
        FD_LIN(1);
        __syncthreads();
        FD_SWRITE(1); FD_SLOAD((j + 4) * KVBLK);
    }
    for (; j < NT; j += 2) {
        FD_GEN(0, j);
        __syncthreads();
        if (j + 2 < NT) { FD_SWRITE(0); FD_SLOAD((j + 3) * KVBLK); }
        FD_GEN(1, j + 1);
        __syncthreads();
        if (j + 2 < NT) { FD_SWRITE(1); }
    }
    { auto rr = __builtin_amdgcn_permlane32_swap(__float_as_uint(l_reg), __float_as_uint(l_reg), false, false); l_reg = __uint_as_float(rr[0]) + __uint_as_float(rr[1]); }
    l_out = l_reg;
#undef FD_SLOAD
#undef FD_SWRITE
#undef FD_LIN
#undef FD_GEN
}

__device__ __forceinline__ void attn_pass_da5p(const bf16* __restrict__ Qb, const bf16* __restrict__ Kh, const bf16* __restrict__ Vh, const int* __restrict__ posb, float slope2, int cw, int q0, int T0, int NT,
                                               LAS unsigned char* lds, int tid_, f32x16 (&o)[4], float& l_out) {
    typedef Lds<64> L; constexpr int DQK = 64, SHM_K = L::SHM_K, B_OFF = L::END;
    const int wid = __builtin_amdgcn_readfirstlane(tid_ >> 6); int lane; asm volatile("v_mbcnt_lo_u32_b32 %0, -1, 0\n\tv_mbcnt_hi_u32_b32 %0, -1, %0" : "=v"(lane));
    const int tid = wid * 64 + lane, r32 = lane & 31, hi = lane >> 5;
    if (wid >= 4) __builtin_amdgcn_s_setprio(1);
    LAS unsigned char* V_lds = lds + L::V_OFF; LAS unsigned char* K_lds = lds + L::K_OFF; LAS float* P_lds = (LAS float*)(lds + L::POS_OFF); LAS float* B_lds = (LAS float*)(lds + B_OFF);
    float l_reg = 0.f;
#pragma unroll
    for (int d = 0; d < 4; ++d) o[d] = f32x16{};
    bf16x8 qr[4];
    { const bf16* Qw = Qb + (size_t)(wid * QBLK) * DQK; unsigned qgo = (unsigned)(r32 * DQK + hi * 8) * 2u; asm volatile("" : "+v"(qgo));
#pragma unroll
      for (int d0 = 0; d0 < 4; ++d0) qr[d0] = ldg<bf16x8>(Qw + d0 * 16, qgo); }
    const float posq = (float)posb[q0 + wid * QBLK + r32];
    const float dl = slope2 * (posq - (float)cw);
    const int tmax = NT - 4 + (wid >> 1);
    const int sr = tid >> 4, sc = (tid & 15) * 8, vst0 = v_st_nat(sr, sc), vst1 = v_st_nat(32 + sr, sc);
    const int kr = tid >> 3, kc = (tid & 7) * 8, kst = kswz(kr, kc * 2);
    unsigned vgo = (unsigned)(sr * DV + sc) * 2u, kgo = (unsigned)(kr * DQK + kc) * 2u, pgo = (unsigned)(tid & 63) * 4u; asm volatile("" : "+v"(vgo), "+v"(kgo), "+v"(pgo));
    const int vb0 = (int)(uintptr_t)V_lds + v_rd_base(lane);
    int ka[4]; k_bases(ka, K_lds, r32, hi);
    bf16x8 vs0, vs1, ks0; int ps;
#define FP_LOADV(t) do { unsigned kk_ = (unsigned)__builtin_amdgcn_readfirstlane((int)((t) * KVBLK)); asm volatile("" : "+s"(kk_)); const bf16* Vt_ = Vh + (size_t)kk_ * DV; \
    vs0 = ldg<bf16x8>(Vt_, vgo); vs1 = ldg<bf16x8>(Vt_ + 32 * DV, vgo); } while (0)
#define FP_LOADK(t) do { unsigned kk_ = (unsigned)__builtin_amdgcn_readfirstlane((int)((t) * KVBLK)); asm volatile("" : "+s"(kk_)); ks0 = ldg<bf16x8>(Kh + (size_t)kk_ * DQK, kgo); ps = ldg<int>(posb + kk_, pgo); } while (0)
#define FP_WRITEV(b) do { *(LAS bf16x8*)(V_lds + (b) * SHM_V + vst0) = vs0; *(LAS bf16x8*)(V_lds + (b) * SHM_V + vst1) = vs1; } while (0)
#define FP_WRITEK(b) do { *(LAS bf16x8*)(K_lds + (b) * SHM_K + kst) = ks0; B_lds[(b) * 512 + tid] = slope2 * (float)(ps - cw); if (tid < 64) P_lds[(b) * 64 + tid] = (float)ps; } while (0)
#define FP_BINIT(x0, x1, b) do { const LAS float* bl_ = B_lds + (b) * 512 + wid * 64 + 4 * hi; \
    _Pragma("unroll") for (int g = 0; g < 4; ++g) { const f32x4 k0 = *(const LAS f32x4*)(bl_ + 8 * g), k1 = *(const LAS f32x4*)(bl_ + 32 + 8 * g); \
        _Pragma("unroll") for (int e = 0; e < 4; ++e) { x0[4 * g + e] = k0[e]; x1[4 * g + e] = k1[e]; } } } while (0)
#define FP_QK(x0, x1, t, b) do { if ((t) < NT - 4) { FP_BINIT(x0, x1, b); qkt<DQK, false>(x0, x1, K_lds + (b) * SHM_K, qr, r32, hi); } \
    else { _Pragma("unroll") for (int r = 0; r < 16; ++r) { x0[r] = dl; x1[r] = dl; } qkt<DQK, false>(x0, x1, K_lds + (b) * SHM_K, qr, r32, hi); fixup<true>(x0, x1, P_lds + (b) * 64, posq, slope2, false, hi); } } while (0)
    f32x16 c0, c1;
    {
        FP_LOADV(T0); FP_LOADK(T0);
        bf16x8 vB0, vB1, kB; int pB;
        { unsigned kk_ = (unsigned)__builtin_amdgcn_readfirstlane((int)((T0 + 1) * KVBLK)); asm volatile("" : "+s"(kk_)); const bf16* Vt_ = Vh + (size_t)kk_ * DV;
          vB0 = ldg<bf16x8>(Vt_, vgo); vB1 = ldg<bf16x8>(Vt_ + 32 * DV, vgo); kB = ldg<bf16x8>(Kh + (size_t)kk_ * DQK, kgo); pB = ldg<int>(posb + kk_, pgo); }
        FP_WRITEV(0); FP_WRITEK(0);
        *(LAS bf16x8*)(V_lds + SHM_V + vst0) = vB0; *(LAS bf16x8*)(V_lds + SHM_V + vst1) = vB1; *(LAS bf16x8*)(K_lds + SHM_K + kst) = kB;
        B_lds[512 + tid] = slope2 * (float)(pB - cw); if (tid < 64) P_lds[64 + tid] = (float)pB;
        FP_LOADK(T0 + 2); FP_LOADV(T0 + 2);
        __syncthreads();
        FP_QK(c0, c1, T0, 0);
        __syncthreads();
        FP_WRITEK(0); FP_LOADK(T0 + 3);
    }
    int s = T0;
    for (; s <= NT - 6; ++s) {
        const int b = s & 1, nb = b ^ 1, kof = nb * SHM_K;
        f32x16 n0, n1; bf16x8 pa0, pa1, pa2, pa3;
        FP_BINIT(n0, n1, nb);
        const bf16x8 a0 = k_read<0>(ka[0] + kof), b0 = k_read<4096>(ka[0] + kof), a1 = k_read<0>(ka[1] + kof), b1 = k_read<4096>(ka[1] + kof);
        const bf16x8 a2 = k_read<0>(ka[2] + kof), b2 = k_read<4096>(ka[2] + kof), a3 = k_read<0>(ka[3] + kof), b3 = k_read<4096>(ka[3] + kof);
        float sa = 0.f, sb = 0.f;
#define FP_SM(d) do { _Pragma("unroll") for (int r = 4 * (d); r < 4 * (d) + 4; ++r) { c0[r] = __builtin_amdgcn_exp2f(c0[r]); c1[r] = __builtin_amdgcn_exp2f(c1[r]); sa += c0[r]; sa += c1[r]; } } while (0)
        FA_LGK(6); FA_SBAR(); n0 = __builtin_amdgcn_mfma_f32_32x32x16_bf16(a0, qr[0], n0, 0, 0, 0); n1 = __builtin_amdgcn_mfma_f32_32x32x16_bf16(b0, qr[0], n1, 0, 0, 0); FP_SM(0); FA_SBAR();
        FA_LGK(4); FA_SBAR(); n0 = __builtin_amdgcn_mfma_f32_32x32x16_bf16(a1, qr[1], n0, 0, 0, 0); n1 = __builtin_amdgcn_mfma_f32_32x32x16_bf16(b1, qr[1], n1, 0, 0, 0); FP_SM(1); FA_SBAR();
        FA_LGK(2); FA_SBAR(); n0 = __builtin_amdgcn_mfma_f32_32x32x16_bf16(a2, qr[2], n0, 0, 0, 0); n1 = __builtin_amdgcn_mfma_f32_32x32x16_bf16(b2, qr[2], n1, 0, 0, 0); FP_SM(2); FA_SBAR();
        FA_LGK(0); FA_SBAR(); n0 = __builtin_amdgcn_mfma_f32_32x32x16_bf16(a3, qr[3], n0, 0, 0, 0); n1 = __builtin_amdgcn_mfma_f32_32x32x16_bf16(b3, qr[3], n1, 0, 0, 0); FP_SM(3); FA_SBAR();
#undef FP_SM
        l_reg += sa + sb;
        typedef unsigned u32x4_t __attribute__((ext_vector_type(4)));
#define FA_PKS(P, BASE, OUT) do { u32x4_t w = {cvtpk(P[BASE + 0], P[BASE + 1]), cvtpk(P[BASE + 2], P[BASE + 3]), cvtpk(P[BASE + 4], P[BASE + 5]), cvtpk(P[BASE + 6], P[BASE + 7])}; OUT = __builtin_bit_cast(bf16x8, w); } while (0)
        FA_PKS(c0, 0, pa0); FA_PKS(c0, 8, pa1); FA_PKS(c1, 0, pa2); FA_PKS(c1, 8, pa3);
#undef FA_PKS
        FA_SBAR();
        pv_d0_pipe(o, vb0 + b * SHM_V, pa0, pa1, pa2, pa3);
        __syncthreads();
        FP_WRITEV(b); FP_WRITEK(nb); FP_LOADV(s + 3); FP_LOADK(s + 4);
        c0 = n0; c1 = n1;
    }
    for (; s < NT; ++s) {
        const int b = s & 1, nb = b ^ 1;
        f32x16 n0 = f32x16{}, n1 = f32x16{};
        if (s + 1 < NT && s + 1 <= tmax) FP_QK(n0, n1, s + 1, nb);
        if (s <= tmax) { bf16x8 pa0, pa1, pa2, pa3; fr_softmax(c0, c1, l_reg, pa0, pa1, pa2, pa3); FA_SBAR(); pv_d0_pipe(o, vb0 + b * SHM_V, pa0, pa1, pa2, pa3); }
        __syncthreads();
        if (s + 2 < NT) FP_WRITEV(b);
        if (s + 3 < NT) { FP_WRITEK(nb); FP_LOADV(s + 3); }
        if (s + 4 < NT) FP_LOADK(s + 4);
        c0 = n0; c1 = n1;
    }
    { auto rr = __builtin_amdgcn_permlane32_swap(__float_as_uint(l_reg), __float_as_uint(l_reg), false, false); l_reg = __uint_as_float(rr[0]) + __uint_as_float(rr[1]); }
    __builtin_amdgcn_s_setprio(0);
    l_out = l_reg;
#undef FP_LOADV
#undef FP_LOADK
#undef FP_WRITEV
#undef FP_WRITEK
#undef FP_BINIT
#undef FP_QK
}
}

constexpr int CW_BAR = 4096;
constexpr int CW_Q = 8192;
__device__ __forceinline__ int next_unit(Frame& F, unsigned* ctr) {
    LAS unsigned* uq = (LAS unsigned*)(F.lds + LDSCTL_OFF + 16);
    __syncthreads();
    if (F.tid == 0) *uq = atomicAdd(ctr, 1u);
    __syncthreads();
    return __builtin_amdgcn_readfirstlane((int)*uq);
}
template <int MODE = 0> __device__ __forceinline__ void ph_attn_da(Frame& F, int l, int rep = 0) {
    const bf16 *QD = WSP(bf16, WS_QD), *KD = WSP(bf16, WS_KD), *VD = WSP(bf16, WS_VD);
    bf16* MIX = rep == 2 ? WSP(bf16, WS_U) : WSP(bf16, WS_MIX); float* O1 = WSP(float, WS_O1);
    const int lane = F.lane;
    LAS float* al = (LAS float*)(F.lds + fa::Lds<64>::WS_OFF) + F.wave * 64;
    const float s1 = wave_sum(FIN(I_LQ1)[l * 64 + lane] * FIN(I_LK1)[l * 64 + lane]);
    const float s2 = wave_sum(FIN(I_LQ2)[l * 64 + lane] * FIN(I_LK2)[l * 64 + lane]);
    const float lam_init = __int_as_float(__builtin_amdgcn_readfirstlane(__float_as_int(LAM_INIT[l])));
    const float lam = __int_as_float(__builtin_amdgcn_readfirstlane(__float_as_int(expf(s1) - expf(s2) + lam_init)));
    float gqm = fabsf(FIN(I_DAQG)[l * 64 + lane]), gkm = fabsf(FIN(I_DAKG)[l * 64 + lane]);
    gqm = wave_max(gqm); gkm = wave_max(gkm);
    const float bound = __int_as_float(__builtin_amdgcn_readfirstlane(__float_as_int(1.01f * 11.5416f * gqm * gkm)));
    const float reach = __int_as_float(__builtin_amdgcn_readfirstlane(__float_as_int(2.0f * bound + 160.0f)));
    if ((MODE == 5) != (bound < 40.0f)) return;
    const int* posmm = WSP(int, WS_POSMM);
    unsigned* ctr = (unsigned*)(F.ws + WS_CTL) + (rep == 2 ? 20000 + 64 * (l * 2) : CW_Q + 64 * 8 * (l * 4 + 0 + rep));
    for (;;) {
        const int u = next_unit(F, ctr); if (u >= 384) break;
        const int qb = 31 - u / 12, bh = u % 12, b = bh / NH, h = bh % NH, q0 = qb * 256, NT = q0 / 64 + 4;
        const int* posb = F.pos + b * SEQ;
        const float slope2 = __int_as_float(__builtin_amdgcn_readfirstlane(__float_as_int(ALIBI_SLOPE[h] * LOG2E)));
        const size_t orow = (size_t)(b * SEQ + q0 + F.wave * 32);
        int T0 = 0, TL = 0; bool lin = false;
        { const int* qm = posmm + (size_t)(b * 128 + qb * 4) * 2; int qmin = qm[0], qmax = qm[1];
#pragma unroll
          for (int c = 1; c < 4; ++c) { qmin = qm[2 * c] < qmin ? qm[2 * c] : qmin; qmax = qm[2 * c + 1] > qmax ? qm[2 * c + 1] : qmax; }
          const int* km = posmm + (size_t)(b * 128) * 2;
          for (; T0 < NT - 4; ++T0) { const int kmin = km[2 * T0], kmax = km[2 * T0 + 1]; int dmin = qmin - kmax; if (kmin - qmax > dmin) dmin = kmin - qmax; if (dmin < 0) dmin = 0;
              if (!(slope2 * (float)dmin > reach)) break; }
          T0 &= ~1;
          for (TL = T0; TL < NT; ++TL) if (km[2 * TL + 1] > qmin) break;
          if (TL < NT - 4) TL = T0;
          int span = qm[1] - qm[0];
#pragma unroll
          for (int c = 1; c < 4; ++c) { const int sp = qm[2 * c + 1] - qm[2 * c]; span = sp > span ? sp : span; }
          lin = TL >= NT - 4 && slope2 * (float)span <= 24.0f;
        }
        for (int mp = 0; mp < 2; ++mp) {
            f32x16 o[4]; float l1;
            const bf16* Qp = QD + ((size_t)(bh * 2 + mp) * SEQ + q0) * 64; const int bhk = rep == 2 ? 0 : bh; const bf16* Kp = KD + (size_t)(bhk * 2 + mp) * SEQ * 64; const bf16* Vp = VD + (size_t)bhk * SEQ * 128;
            if (MODE == 5 && lin) { const int cw = posmm[(size_t)(b * 128 + qb * 4 + (__builtin_amdgcn_readfirstlane(F.tid >> 6) >> 1)) * 2];
                fa::attn_pass_da5p(Qp, Kp, Vp, posb, slope2, cw, q0, T0, NT, F.lds, F.tid, o, l1); }
            else fa::attn_pass<64, true, 1, MODE>(Qp, Kp, Vp, posb, slope2, bound, TL, q0, T0, NT, F.lds, F.tid, o, l1);
            int le_; asm volatile("v_mbcnt_lo_u32_b32 %0, -1, 0\n\tv_mbcnt_hi_u32_b32 %0, -1, %0" : "=v"(le_)); const int r32 = le_ & 31, hi = le_ >> 5;
            float f[16];
            if (mp == 0) {
                fa::row_bcast(1.0f / l1, al, r32, hi, f);
                unsigned lo = (unsigned)(((u * 8 + F.wave) * 8) * 64 + le_) * 16u; asm volatile("" : "+v"(lo));
#pragma unroll
                for (int j = 0; j < 8; ++j) { const int d = j >> 1, rb = (j & 1) * 8; v4u w;
                    w.x = pg8::pkh2(o[d][rb + 0] * f[rb + 0], o[d][rb + 1] * f[rb + 1]); w.y = pg8::pkh2(o[d][rb + 2] * f[rb + 2], o[d][rb + 3] * f[rb + 3]);
                    w.z = pg8::pkh2(o[d][rb + 4] * f[rb + 4], o[d][rb + 5] * f[rb + 5]); w.w = pg8::pkh2(o[d][rb + 6] * f[rb + 6], o[d][rb + 7] * f[rb + 7]);
                    fa::stg<v4u>(O1, lo + j * 1024, w); }
            } else {
                fa::row_bcast(lam / l1, al, r32, hi, f);
                const float* hg = FIN(I_DAHG) + (size_t)l * 768 + h * 128;
                float hgv[4];
#pragma unroll
                for (int d = 0; d < 4; ++d) hgv[d] = fa::ldg<float>(hg + d * 32, (unsigned)r32 * 4u) * (1.0f - lam_init);
                unsigned lo = (unsigned)(((u * 8 + F.wave) * 8) * 64 + le_) * 16u; asm volatile("" : "+v"(lo));
                bf16* mb = MIX + orow * D + h * 128; unsigned mo = (unsigned)(4 * hi * D + r32) * 2u; asm volatile("" : "+v"(mo));
                v4u w1[8];
#pragma unroll
                for (int j = 0; j < 8; ++j) w1[j] = fa::ldg<v4u>(O1, lo + j * 1024);
#pragma unroll
                for (int j = 0; j < 8; ++j) { const int d = j >> 1, rb = (j & 1) * 8; const unsigned ww[4] = {w1[j].x, w1[j].y, w1[j].z, w1[j].w};
#pragma unroll
                    for (int q = 0; q < 4; ++q) { o[d][rb + 2 * q] = pg8::uph_lo(ww[q]) - o[d][rb + 2 * q] * f[rb + 2 * q]; o[d][rb + 2 * q + 1] = pg8::uph_hi(ww[q]) - o[d][rb + 2 * q + 1] * f[rb + 2 * q + 1]; } }
#pragma unroll
                for (int r2 = 0; r2 < 16; ++r2) {
                    float ss = 0.f;
#pragma unroll
                    for (int d = 0; d < 4; ++d) ss += o[d][r2] * o[d][r2];
                    ss = sum32(ss);
                    const float rn = rsqrtf(ss * (1.f / 128) + EPS);
#pragma unroll
                    for (int d = 0; d < 4; ++d) fa::stg<bf16>(mb, mo + (fa::crowc(r2) * D + d * 32) * 2, (bf16)f2bf(o[d][r2] * rn * hgv[d]));
                }
            }
        }
    }
}
template <int MODE> __device__ __forceinline__ void ph_attn_mla(Frame& F, int l, int rep = 0, int ubase = 0, int ucount = 384, int cslot = 2, int xstat = 0) {
    const bf16 *QM = WSP(bf16, WS_QM), *KM = WSP(bf16, WS_KM), *VM = WSP(bf16, WS_VM);
    bf16* MIX = rep >= 2 ? WSP(bf16, WS_U) : WSP(bf16, WS_MIX);
    const int lane = F.lane;
    LAS float* al = (LAS float*)(F.lds + fa::Lds<192>::WS_OFF) + F.wave * 64;
    float gqm = fmaxf(fmaxf(fabsf(FIN(I_MQG)[l * 192 + lane]), fabsf(FIN(I_MQG)[l * 192 + 64 + lane])), fabsf(FIN(I_MQG)[l * 192 + 128 + lane]));
    float gkm = fmaxf(fmaxf(fabsf(FIN(I_MKG)[l * 192 + lane]), fabsf(FIN(I_MKG)[l * 192 + 64 + lane])), fabsf(FIN(I_MKG)[l * 192 + 128 + lane]));
    gqm = wave_max(gqm); gkm = wave_max(gkm);
    const float bound = __int_as_float(__builtin_amdgcn_readfirstlane(__float_as_int(1.01f * 19.9907f * gqm * gkm)));
    if ((MODE == 5) != (bound < 60.0f)) return;
    unsigned* ctr = (unsigned*)(F.ws + WS_CTL) + (rep >= 2 ? 20000 + 64 * (l * 2 + 1) : CW_Q + 64 * 8 * (l * 4 + cslot + rep));
    const bool xs = xstat != 0 && F.G == 256;
    for (int it_ = 0;; ++it_) {
        int qb, bh;
        if (xs) { if (it_ > 0 || F.bid >= 192) break; const int idx = (F.bid & 7) * 24 + (F.bid >> 3); bh = idx >> 4; qb = 31 - (idx & 15); __syncthreads(); }
        else { const int ui = next_unit(F, ctr); if (ui >= ucount) break; const int u = ubase + ui; qb = 31 - u / 12; bh = u % 12; }
        const int b = bh / NH, h = bh % NH, q0 = qb * 256, NT = q0 / 64 + 4;
        const size_t orow = (size_t)(b * SEQ + q0 + F.wave * 32);
        f32x16 o[4]; float l1;
        const int bhk = rep == 2 ? 0 : bh;
#if defined(PROBE_VAR)
        if (rep == 3) fa::attn_pass<192, false, 1, MODE, PROBE_VAR>(QM + ((size_t)bh * SEQ + q0) * 192, KM + (size_t)bhk * SEQ * 192, VM + (size_t)bhk * SEQ * 128, nullptr, 0.f, bound, 0, q0, 0, NT, F.lds, F.tid, o, l1); else
#endif
        fa::attn_pass<192, false, 1, MODE>(QM + ((size_t)bh * SEQ + q0) * 192, KM + (size_t)bhk * SEQ * 192, VM + (size_t)bhk * SEQ * 128, nullptr, 0.f, bound, 0, q0, 0, NT, F.lds, F.tid, o, l1);
        int le_; asm volatile("v_mbcnt_lo_u32_b32 %0, -1, 0\n\tv_mbcnt_hi_u32_b32 %0, -1, %0" : "=v"(le_)); const int r32 = le_ & 31, hi = le_ >> 5;
        float f[16]; fa::row_bcast(1.0f / l1, al, r32, hi, f);
        bf16* mb = MIX + orow * D + 768 + h * 128; unsigned mo = (unsigned)(4 * hi * D + r32) * 2u; asm volatile("" : "+v"(mo));
#pragma unroll
        for (int r2 = 0; r2 < 16; ++r2)
#pragma unroll
            for (int d = 0; d < 4; ++d) fa::stg<bf16>(mb, mo + (fa::crowc(r2) * D + d * 32) * 2, (bf16)f2bf(o[d][r2] * f[r2]));
    }
}
__device__ __forceinline__ void ph_sgu(Frame& F, int l, int rep = 0) {
    const _Float16* UU = WSP(_Float16, WS_UU); const bf16* GV = WSP(bf16, WS_GV); const float* SSQ = WSP(float, WS_SSQ_SGV); bf16* MIX = WSP(bf16, WS_MIX);
    LAS unsigned short* vs = (LAS unsigned short*)F.lds;
    LAS float* rs = (LAS float*)(F.lds + 128 * 128 * 2);
    const int lane = F.lane, r32 = lane & 31, hi = lane >> 5, tm = F.wave >> 1, tn0 = (F.wave & 1) * 2;
    __syncthreads();
    unsigned* sctr = (unsigned*)(F.ws + WS_CTL) + CW_Q + 64 * 8 * 16 + 64 * (l + 4 * rep);
    LAS float* wl = rs + 128;
    for (;;) { const int u = next_unit(F, sctr); if (u >= 512) break;
        const int g = u & 3, row0 = (u >> 2) * 128;
        const int t = 32 * tm + r32;
        const float* bias = FIN(I_SGB) + (l * 4 + g) * 128 + 32 * tm;
        const int c0 = g * 128 + 32 * tn0 + r32;
        float uu0[16], uu1[16], bvv[16];
#pragma unroll
        for (int r = 0; r < 16; ++r) { const int tt = crow(r, hi); const size_t row = (size_t)(row0 + 32 * tm + tt); uu0[r] = (float)UU[row * 512 + c0]; uu1[r] = (float)UU[row * 512 + c0 + 32]; bvv[r] = bias[tt]; }
        { const float* wb = FIN(I_SGW) + (size_t)(l * 4 + g) * 128 * 128;
          f32x4 wv_[8];
#pragma unroll
          for (int k = 0; k < 8; ++k) wv_[k] = *(const f32x4*)(wb + (size_t)(F.tid + k * NTHREADS) * 4);
#pragma unroll
          for (int k = 0; k < 8; ++k) { const int e = (F.tid + k * NTHREADS) * 4, tr = e >> 7, sc_ = e & 127; *(LAS f32x4*)(wl + tr * 132 + sc_) = wv_[k]; } }
        for (int i = F.tid; i < 128 * 16; i += NTHREADS) { const int s = i >> 4, c8 = i & 15; *(LAS bf16x8*)(vs + s * 128 + c8 * 8) = *(const bf16x8*)(GV + (size_t)(row0 + s) * 512 + g * 128 + c8 * 8); }
        if (F.tid < 128) { const f32x4 p = *(const f32x4*)(SSQ + (size_t)(row0 + F.tid) * 16 + g * 4); rs[F.tid] = rsqrtf(((p.x + p.y) + (p.z + p.w)) * (1.f / 128) + EPS); }
        __syncthreads();
        f32x16 acc0 = f32x16{}, acc1 = f32x16{};
        const LAS float* wrow = wl + t * 132;
        for (int ks = 0; ks < 2 * (tm + 1); ++ks) {
            const int s0 = 16 * ks + 8 * hi;
            const f32x4 w0 = *(const LAS f32x4*)(wrow + s0), w1 = *(const LAS f32x4*)(wrow + s0 + 4);
            float wv[8] = {w0.x, w0.y, w0.z, w0.w, w1.x, w1.y, w1.z, w1.w};
            bf16x8 af, b0, b1;
#pragma unroll
            for (int j = 0; j < 8; ++j) { af[j] = (short)f2bf(s0 + j <= t ? wv[j] * rs[s0 + j] : 0.f);
                b0[j] = (short)vs[(s0 + j) * 128 + 32 * tn0 + r32]; b1[j] = (short)vs[(s0 + j) * 128 + 32 * (tn0 + 1) + r32]; }
            acc0 = __builtin_amdgcn_mfma_f32_32x32x16_bf16(af, b0, acc0, 0, 0, 0);
            acc1 = __builtin_amdgcn_mfma_f32_32x32x16_bf16(af, b1, acc1, 0, 0, 0);
        }
#pragma unroll
        for (int r = 0; r < 16; ++r) { const int tt = crow(r, hi); const size_t row = (size_t)(row0 + 32 * tm + tt);
            MIX[row * D + 1536 + c0] = (bf16)f2bf(uu0[r] * (acc0[r] + bvv[r]));
            MIX[row * D + 1536 + c0 + 32] = (bf16)f2bf(uu1[r] * (acc1[r] + bvv[r])); }
        __syncthreads();
    }
}
__device__ __forceinline__ void ph_convfix(Frame& F, int l) {
    const unsigned short* EDGE = WSP(unsigned short, WS_EDGE); bf16* U = WSP(bf16, WS_U);
    auto ldh4o = [&](unsigned eo) { const uint2 w = *(const uint2*)((const char*)EDGE + (size_t)eo * 2u); return (f32x4){pg8::uph_lo(w.x), pg8::uph_hi(w.x), pg8::uph_lo(w.y), pg8::uph_hi(w.y)}; };
    const float* cw = FIN(I_CONVW) + (size_t)l * 3 * NUP; const float* cb = FIN(I_CONVB) + (size_t)l * NUP;
    const int gt = F.bid * NTHREADS + F.tid, nt = F.G * NTHREADS;
    constexpr int NIT = (M / 64) * 2 * (DFF / 4);
    auto item = [&](int i, unsigned long long& pk, size_t& dst) {
        const int ch = (i % (DFF / 4)) * 4, r = (i / (DFF / 4)) & 1, blk = i / (2 * (DFF / 4)); const bool first = (blk % (SEQ / 64)) == 0;
        f32x4 y[2];
#pragma unroll
        for (int bj = 0; bj < 2; ++bj) {
            const unsigned eo = (unsigned)(((blk * 4) * 2 + bj) * DFF + ch);
            const f32x4 z = {0.f, 0.f, 0.f, 0.f};
            const f32x4 a0 = ldh4o(eo + (unsigned)(r * 2 * DFF));
            const f32x4 a1 = r == 1 ? ldh4o(eo) : (first ? z : ldh4o(eo - (unsigned)(2 * DFF)));
            const f32x4 a2 = first ? z : (r == 1 ? ldh4o(eo - (unsigned)(2 * DFF)) : ldh4o(eo - (unsigned)(4 * DFF)));
            y[bj] = *(const f32x4*)(cb + bj * DFF + ch) + *(const f32x4*)(cw + (size_t)2 * NUP + bj * DFF + ch) * a0 + *(const f32x4*)(cw + (size_t)NUP + bj * DFF + ch) * a1 + *(const f32x4*)(cw + bj * DFF + ch) * a2; }
        float o[4];
#pragma unroll
        for (int e = 0; e < 4; ++e) { const float g = y[0][e]; o[e] = g * __builtin_amdgcn_rcpf(1.0f + __expf(-g)) * y[1][e]; }
        pk = (unsigned long long)pk2(o[0], o[1]) | ((unsigned long long)pk2(o[2], o[3]) << 32); dst = (size_t)(blk * 64 + r) * DFF + ch; };
    for (int i = gt; i < NIT; i += 3 * nt) {
        unsigned long long p0 = 0, p1 = 0, p2 = 0; size_t d0 = 0, d1 = 0, d2 = 0;
        const bool h1 = i + nt < NIT, h2 = i + 2 * nt < NIT;
        item(i, p0, d0); if (h1) item(i + nt, p1, d1); if (h2) item(i + 2 * nt, p2, d2);
        *(unsigned long long*)(U + d0) = p0; if (h1) *(unsigned long long*)(U + d1) = p1; if (h2) *(unsigned long long*)(U + d2) = p2; }
}

__device__ __forceinline__ void ph_krope(Frame& F, int l) {
    const bf16* H = WSP(bf16, WS_H); const bf16* Wk = wptr(F, l, WL_IN) + (size_t)4096 * D; float* KR = WSP(float, WS_KR); float* SSQ = WSP(float, WS_SSQ_KR);
    constexpr int PITCH = 1024;
    LAS unsigned char* As = F.lds; LAS unsigned char* Bs = F.lds + 64 * PITCH;
    LAS float* red = (LAS float*)F.lds;
    const int lane = F.lane, r32 = lane & 31, hi = lane >> 5, w = F.wave;
    __syncthreads();
    for (int tb = F.bid; tb < M / 64; tb += F.G) {
        f32x16 acc[2][2];
#pragma unroll
        for (int i = 0; i < 2; ++i)
#pragma unroll
            for (int j = 0; j < 2; ++j) acc[i][j] = f32x16{};
        for (int kc = 0; kc < 4; ++kc) {
#pragma unroll
            for (int p = 0; p < 8; ++p) { const int q = p * NTHREADS + F.tid, row = q >> 6, c16 = q & 63;
                *(LAS v4u*)(As + row * PITCH + (c16 ^ (row & 7)) * 16) = *(const v4u*)(H + (size_t)(tb * 64 + row) * D + kc * 512 + c16 * 8);
                *(LAS v4u*)(Bs + row * PITCH + (c16 ^ (row & 7)) * 16) = *(const v4u*)(Wk + (size_t)row * D + kc * 512 + c16 * 8); }
            __syncthreads();
#pragma unroll
            for (int ks = 0; ks < 4; ++ks) { const int ko = (((w * 64 + ks * 16 + hi * 8) >> 3) ^ (r32 & 7)) * 16;
                const bf16x8 A0 = *(const LAS bf16x8*)(As + r32 * PITCH + ko), A1 = *(const LAS bf16x8*)(As + (32 + r32) * PITCH + ko);
                const bf16x8 B0 = *(const LAS bf16x8*)(Bs + r32 * PITCH + ko), B1 = *(const LAS bf16x8*)(Bs + (32 + r32) * PITCH + ko);
                acc[0][0] = __builtin_amdgcn_mfma_f32_32x32x16_bf16(A0, B0, acc[0][0], 0, 0, 0); acc[0][1] = __builtin_amdgcn_mfma_f32_32x32x16_bf16(A0, B1, acc[0][1], 0, 0, 0);
                acc[1][0] = __builtin_amdgcn_mfma_f32_32x32x16_bf16(A1, B0, acc[1][0], 0, 0, 0); acc[1][1] = __builtin_amdgcn_mfma_f32_32x32x16_bf16(A1, B1, acc[1][1], 0, 0, 0); }
            __syncthreads();
        }
#pragma unroll
        for (int i = 0; i < 2; ++i)
#pragma unroll
            for (int j = 0; j < 2; ++j)
#pragma unroll
                for (int r = 0; r < 16; ++r) red[(w * 64 + (i * 2 + j) * 16 + r) * 64 + lane] = acc[i][j][r];
        __syncthreads();
#pragma unroll
        for (int c = 0; c < 8; ++c) { const int cb = w * 8 + c, i = cb >> 5, j = (cb >> 4) & 1, r = cb & 15;
            float v = 0.f;
#pragma unroll
            for (int ww = 0; ww < 8; ++ww) v += red[(ww * 64 + cb) * 64 + lane];
            const int row = tb * 64 + 32 * i + crow(r, hi);
            KR[(size_t)row * 64 + 32 * j + r32] = v;
            const float ss = sum32(v * v);
            if (r32 == 0) SSQ[(size_t)row * 2 + j] = ss; }
        __syncthreads();
    }
}
__device__ __forceinline__ void frame_init(Frame& F, const Args& a, unsigned char* lds) {
    F.lds = (LAS unsigned char*)lds; F.tid = threadIdx.x; F.lane = F.tid & 63; F.wave = __builtin_amdgcn_readfirstlane(F.tid >> 6); F.wave0 = F.wave;
    F.bid = blockIdx.x; F.G = gridDim.x; F.gw = F.bid * NWAVES + F.wave; F.ngw = F.G * NWAVES;
    F.ka = (const __attribute__((address_space(4))) Args*)__builtin_amdgcn_kernarg_segment_ptr();
    F.pos = (const int*)a.in[I_POS]; F.out = a.out; F.ws = a.ws;
}
__device__ __forceinline__ void frame_retid(Frame& F) {
    int lane; asm volatile("v_mbcnt_lo_u32_b32 %0, -1, 0\n\tv_mbcnt_hi_u32_b32 %0, -1, %0" : "=v"(lane));
    int w = F.wave0; asm volatile("" : "+s"(w));
    F.lane = lane; F.wave = w; F.tid = w * 64 + lane;
    int bid = blockIdx.x, G = gridDim.x; asm volatile("" : "+s"(bid)); asm volatile("" : "+s"(G)); F.bid = bid; F.G = G;
    F.gw = bid * NWAVES + F.wave; F.ngw = G * NWAVES;
}
__device__ __forceinline__ void grid_bar(const XcdBarrier& bar, int wave0) {
    int lane_; asm volatile("v_mbcnt_lo_u32_b32 %0, -1, 0\n\tv_mbcnt_hi_u32_b32 %0, -1, %0" : "=v"(lane_)); const bool leader = (wave0 == 0) && (lane_ == 0);
    XcdBarrier b2 = bar; unsigned z_ = 0u; asm volatile("" : "+s"(b2.x), "+s"(z_)); b2.bar = bar.bar + z_; xcd_barrier(b2, leader); }
template <int PH> __device__ __forceinline__ void run_phase(Frame& F, int l) {
    frame_retid(F); asm volatile("; PHASE_BEGIN %0" :: "n"(PH));
    const float* mod = WSP(float, WS_MOD) + (size_t)l * 12 * D;
    if constexpr (PH == 0) ph_prologue(F);
    if constexpr (PH == 1) ph_modreduce(F);
    if constexpr (PH == 2) { if (l == 0) ph_norm<false>(F, l, FIN(I_X), 0, D); else ph_norm<true>(F, l, WSP(bf16, WS_XB), 0, D); }
    if constexpr (PH == 3) { pg8::Gemm g{WSP(bf16, WS_H), wptr(F, l, WL_IN), M, 4096, D}; pg8::StaticOrder S; S.init(M, 4096, F.G, F.bid);
        pg8::EpiInProj E{WSP(bf16, WS_QD), WSP(bf16, WS_KD), WSP(bf16, WS_VD), WSP(bf16, WS_QA), WSP(bf16, WS_KVA), WSP(bf16, WS_GV), WSP(unsigned short, WS_UU), WSP(float, WS_KR),
                         WSP(float, WS_SSQ_QA), WSP(float, WS_SSQ_KVA), WSP(float, WS_SSQ_SGV), WSP(float, WS_SSQ_KR), FIN(I_DAQG) + l * 64, FIN(I_DAKG) + l * 64, FIN(I_QAG) + l * 512, FIN(I_KVAG) + l * 256, FIN(I_SGVG) + l * 512};
        pg8::gemm_phase<pg8::EpiInProj, pg8::StaticOrder, true, true>(F.lds, g, S, E, F.tid); frame_retid(F); ph_krope(F, l); }
    if constexpr (PH == 5) {
        PG8_LAS float* X = (PG8_LAS float*)(F.lds + LDSCTL_OFF + 1024);
        { pg8::Gemm g{WSP(bf16, WS_QA), wptr(F, l, WL_UQ), M, UQ_PAD, QRANK}; pg8::StaticOrder S; S.init(M, UQ_PAD, F.G, F.bid);
          pg8::EpiMlaQ E{WSP(bf16, WS_QM), WSP(float, WS_SSQ_QA), WSP(float, WS_COS), WSP(float, WS_SIN), FIN(I_MQG) + l * 192, X};
          pg8::gemm_phase<pg8::EpiMlaQ, pg8::StaticOrder, true, true>(F.lds, g, S, E, F.tid); }
        __syncthreads(); frame_retid(F);
        { pg8::Gemm g{WSP(bf16, WS_KVA), wptr(F, l, WL_UKV), M, UKV_N, KVRANK}; pg8::StaticOrder S; S.init(M, UKV_N, F.G, F.G - 1 - F.bid);
          pg8::EpiMlaKV E{WSP(bf16, WS_KM), WSP(bf16, WS_VM), WSP(float, WS_SSQ_KVA), WSP(float, WS_SSQ_KR), WSP(float, WS_KR), WSP(float, WS_COS), WSP(float, WS_SIN), FIN(I_MKG) + l * 192, X};
          pg8::gemm_phase<pg8::EpiMlaKV, pg8::StaticOrder, true, true>(F.lds, g, S, E, F.tid); }
    }
#ifndef MLA_FRONT
#define MLA_FRONT 192
#endif
    if constexpr (PH == 7) { ph_attn_mla<5>(F, l, 0, 0, MLA_FRONT, 3, 1); frame_retid(F); ph_attn_mla<0>(F, l, 0, 0, MLA_FRONT, 3, 1); frame_retid(F);
        ph_attn_da<5>(F, l); frame_retid(F); ph_attn_da<0>(F, l); frame_retid(F); asm volatile("; PHASE_BEGIN 71");
        ph_attn_mla<5>(F, l, 0, MLA_FRONT, 384 - MLA_FRONT, 2); frame_retid(F); ph_attn_mla<0>(F, l, 0, MLA_FRONT, 384 - MLA_FRONT, 2); frame_retid(F); asm volatile("; PHASE_BEGIN 72"); ph_sgu(F, l); }
    if constexpr (PH == 8) { pg8::Gemm g{WSP(bf16, WS_MIX), wptr(F, l, WL_OUT), M, D, D}; pg8::StaticOrder S; S.init(M, D, F.G, F.bid);
        pg8::EpiResidP E{l == 0 ? (const void*)FIN(I_X) : (const void*)WSP(bf16, WS_XB), WSP(bf16, WS_XB), l != 0, 1, mod + 2 * D, 6 * D}; pg8::gemm_phase<pg8::EpiResidP, pg8::StaticOrder, true, true>(F.lds, g, S, E, F.tid); }
    if constexpr (PH == 9) ph_norm<true>(F, l, WSP(bf16, WS_XB), 3 * D, 4 * D);
    if constexpr (PH == 10) { pg8::Gemm g{WSP(bf16, WS_H), wptr(F, l, WL_UP), M, NUP, D}; pg8::StaticOrder S; S.init(M, NUP, F.G, F.bid);
        pg8::EpiConvGate E{WSP(bf16, WS_U), WSP(unsigned short, WS_EDGE), FIN(I_CONVW) + (size_t)l * 3 * NUP, FIN(I_CONVB) + (size_t)l * NUP}; pg8::gemm_phase<pg8::EpiConvGate, pg8::StaticOrder, true, true>(F.lds, g, S, E, F.tid); }
    if constexpr (PH == 11) ph_convfix(F, l);
    if constexpr (PH == 12) { pg8::Gemm g{WSP(bf16, WS_U), wptr(F, l, WL_DOWN), M, D, DFF}; pg8::StaticOrder S; S.init(M, D, F.G, F.bid);
        pg8::EpiResidP E{WSP(bf16, WS_XB), l + 1 < DEPTH ? (void*)WSP(bf16, WS_XB) : (void*)F.out, 1, l + 1 < DEPTH, mod + 5 * D, 6 * D}; pg8::gemm_phase<pg8::EpiResidP, pg8::StaticOrder, true, true>(F.lds, g, S, E, F.tid); }
}
__global__ void __launch_bounds__(NTHREADS, 2) mega_fwd(Args a) {
    extern __shared__ __attribute__((aligned(16))) unsigned char lds[];
    Frame F; frame_init(F, a, lds);
    if (F.tid < 16) ((LAS unsigned*)(F.lds + LDSCTL_OFF))[F.tid] = 0u;
    __syncthreads();
    XcdBarrier bar = xcd_barrier_post((unsigned*)(F.ws + WS_CTL) + CW_BAR, (volatile LAS unsigned*)(F.lds + LDSCTL_OFF + 32));
    run_phase<0>(F, 0); grid_bar(bar, F.wave0);
#if defined(PROBE_P0)
    run_phase<0>(F, 0); grid_bar(bar, F.wave0);
#endif
    run_phase<1>(F, 0); grid_bar(bar, F.wave0);
    for (int l = 0; l < DEPTH; ++l) {
        run_phase<2>(F, l); grid_bar(bar, F.wave0);
#if defined(PROBE_EW)
        run_phase<2>(F, l); grid_bar(bar, F.wave0);
#endif
        run_phase<3>(F, l); grid_bar(bar, F.wave0);
#if defined(PROBE_GEMM)
        run_phase<3>(F, l); grid_bar(bar, F.wave0);
#endif
        run_phase<5>(F, l); grid_bar(bar, F.wave0);
        run_phase<7>(F, l); grid_bar(bar, F.wave0);
#if defined(PROBE_P7)
        frame_retid(F); ph_attn_da<5>(F, l, 1); frame_retid(F); ph_attn_mla<5>(F, l, 1); grid_bar(bar, F.wave0);
#endif
#if defined(PROBE_LOC)
        frame_retid(F); ph_attn_da<5>(F, l, 2); frame_retid(F); ph_attn_mla<5>(F, l, 2); grid_bar(bar, F.wave0);
#endif
#if defined(PROBE_DA)
        frame_retid(F); ph_attn_da<5>(F, l, 1); grid_bar(bar, F.wave0);
#endif
#if defined(PROBE_VAR)
        frame_retid(F); ph_attn_mla<5>(F, l, 3); grid_bar(bar, F.wave0);
#endif
#if defined(PROBE_MLA)
        frame_retid(F); ph_attn_mla<5>(F, l, 1); grid_bar(bar, F.wave0);
#endif
#if defined(PROBE_SGU)
        frame_retid(F); ph_sgu(F, l, 1); grid_bar(bar, F.wave0);
#endif
        run_phase<8>(F, l); grid_bar(bar, F.wave0);
        run_phase<9>(F, l); grid_bar(bar, F.wave0);
        run_phase<10>(F, l); grid_bar(bar, F.wave0);
#if defined(PROBE_G10)
        frame_retid(F); run_phase<10>(F, l); grid_bar(bar, F.wave0);
#endif
#if defined(PROBE_G10N)
        frame_retid(F); { pg8::Gemm g{WSP(bf16, WS_H), wptr(F, l, WL_UP), M, NUP, D}; pg8::StaticOrder S; S.init(M, NUP, F.G, F.bid);
          pg8::EpiNull E{WSP(float, WS_MIX)}; pg8::gemm_phase<pg8::EpiNull, pg8::StaticOrder, true, true>(F.lds, g, S, E, F.tid); } grid_bar(bar, F.wave0);
#endif
#if defined(PROBE_GEMM)
        run_phase<10>(F, l); grid_bar(bar, F.wave0);
#endif
        run_phase<11>(F, l); grid_bar(bar, F.wave0);
#if defined(PROBE_EW)
        run_phase<11>(F, l); grid_bar(bar, F.wave0);
#endif
        run_phase<12>(F, l); if (l + 1 < DEPTH) grid_bar(bar, F.wave0);
    }
}

extern "C" void kernel_launch(void* const* d_in, const int* in_sizes, int n_in, void* d_out, int out_size, void* d_ws, size_t ws_size, hipStream_t stream) {
    static int grid = 0;
    if (grid == 0) {
        if (n_in != N_IN || in_sizes[0] != M * D || out_size != M * D || ws_size < WS_END) { fprintf(stderr, "kernel_launch: shape mismatch (n_in %d, ws %zu, need %zu)\n", n_in, ws_size, (size_t)WS_END); grid = -1; return; }
        int dev = 0, cus = 0, per_cu = 0;
        if (hipGetDevice(&dev) != hipSuccess || hipDeviceGetAttribute(&cus, hipDeviceAttributeMultiprocessorCount, dev) != hipSuccess) { grid = -1; return; }
        if (hipFuncSetAttribute((const void*)mega_fwd, hipFuncAttributeMaxDynamicSharedMemorySize, LDS_BYTES) != hipSuccess) { fprintf(stderr, "hipFuncSetAttribute failed\n"); grid = -1; return; }
        if (hipOccupancyMaxActiveBlocksPerMultiprocessor(&per_cu, (const void*)mega_fwd, NTHREADS, LDS_BYTES) != hipSuccess || per_cu < 1) fprintf(stderr, "kernel_launch: occupancy query reports %d\n", per_cu);
        (void)hipGetLastError();
        grid = cus > 0 ? cus : 256;
    }
    if (grid < 0) return;
    if (hipMemsetAsync((char*)d_ws + WS_CTL, 0, CTL_ZERO_BYTES, stream) != hipSuccess) { fprintf(stderr, "kernel_launch: memset failed\n"); return; }
    Args a{};
    for (int i = 0; i < N_IN; ++i) a.in[i] = d_in[i];
    a.out = (float*)d_out; a.ws = (unsigned char*)d_ws; a.ph = 0; a.l = 0;
    hipLaunchKernelGGL(mega_fwd, dim3(grid), dim3(NTHREADS), LDS_BYTES, stream, a);
    const hipError_t le = hipPeekAtLastError();
    if (le != hipSuccess) fprintf(stderr, "kernel_launch: launch failed: %s\n", hipGetErrorName(le));
}
```
